# Optimizing an MI355X kernel written in HIP

```python
import jax, jax.numpy as jnp
from jax import lax
import numpy as np

D_MODEL = 1024
BATCH = 4
SEQ = 4096
DEPTH = 1

HG_HEADS = 4
HG_DK = 128
HG_DV = 128
HG_WIDTH = HG_HEADS * HG_DK
HG_CHUNK = 64
ATT_GROUPS = ((128, 1), (512, 4), (2048, 16))
N_ATT_GROUPS = 3
ATT_HEADS = 8
ATT_HD = 64
ATT_WIDTH = ATT_HEADS * ATT_HD
QKV_WIDTH = N_ATT_GROUPS * ATT_WIDTH
ROPE_THETA = 500000.0
ROT_DIM = ATT_HD // 4
IN_WIDTH = 4 * HG_WIDTH + 3 * QKV_WIDTH + 2 * D_MODEL
N_EXPERTS = 256
TOP_K = 8
N_GROUP = 8
TOPK_GROUP = 4
EXPERT_FF = 256
SHARED_FF = 256
ROUTED_SCALE = 2.5
ROUTE_BLOCK = 128
EPS = 1e-6

kernel_name = 'hybrid_hgrn2_dilated_attn_moe_block'


def rms_norm(x, g):
    xf = x.astype(jnp.float32)
    y = xf * lax.rsqrt(jnp.mean(xf * xf, axis=-1, keepdims=True) + EPS)
    return (y * g.astype(jnp.float32)).astype(x.dtype)


def split_points(sizes):
    pts, acc = [], 0
    for s in sizes[:-1]:
        acc += s
        pts.append(acc)
    return pts


def partial_rope(t, cos, sin):
    half = ROT_DIM // 2
    tf = t.astype(jnp.float32)
    t1, t2, rest = tf[..., :half], tf[..., half:ROT_DIM], tf[..., ROT_DIM:]
    out = jnp.concatenate([t1 * cos - t2 * sin, t2 * cos + t1 * sin, rest], axis=-1)
    return out.astype(t.dtype)


def hgrn2_mixer(q, f_pre, i_in, g_out, lb, g_norm):
    Bsz, S, _ = q.shape
    N = S // HG_CHUNK
    shp = (Bsz, N, HG_CHUNK, HG_HEADS, HG_DK)
    f_pre = f_pre.astype(jnp.float32)
    log_f = jnp.log(lb + (1.0 - lb) * jax.nn.sigmoid(f_pre)).reshape(shp)
    k = ((1.0 - lb) * jax.nn.sigmoid(-f_pre)).reshape(shp)
    qf = q.astype(jnp.float32).reshape(shp)
    v = i_in.astype(jnp.float32).reshape(Bsz, N, HG_CHUNK, HG_HEADS, HG_DV)
    b = jnp.cumsum(log_f, axis=2)
    b_ref = b[:, :, HG_CHUNK // 2:HG_CHUNK // 2 + 1]
    b_last = b[:, :, -1:]
    scores = jnp.einsum('bnthk,bnshk->bnhts', qf * jnp.exp(b - b_ref), k * jnp.exp(b_ref - b))
    causal = jnp.tril(jnp.ones((HG_CHUNK, HG_CHUNK), dtype=bool))
    o_intra = jnp.einsum('bnhts,bnshv->bnthv', jnp.where(causal, scores, 0.0), v)
    q_in = qf * jnp.exp(b)
    k_out = k * jnp.exp(b_last - b)
    decay = jnp.exp(b_last[:, :, 0])

    def step(state, inp):
        qn, kn, vn, dn = inp
        o = jnp.einsum('bthk,bhkv->bthv', qn, state)
        state = dn[..., None] * state + jnp.einsum('bshk,bshv->bhkv', kn, vn)
        return state, o

    xs = (jnp.moveaxis(q_in, 1, 0), jnp.moveaxis(k_out, 1, 0), jnp.moveaxis(v, 1, 0), jnp.moveaxis(decay, 1, 0))
    _, o_inter = lax.scan(step, jnp.zeros((Bsz, HG_HEADS, HG_DK, HG_DV), jnp.float32), xs)
    o = (o_intra + jnp.moveaxis(o_inter, 0, 1)).reshape(Bsz, S, HG_HEADS, HG_DV)
    o = o * lax.rsqrt(jnp.mean(o * o, axis=-1, keepdims=True) + EPS) * g_norm.astype(jnp.float32).reshape(HG_HEADS, HG_DV)
    o = o * jax.nn.silu(g_out.astype(jnp.float32)).reshape(Bsz, S, HG_HEADS, HG_DV)
    return o.reshape(Bsz, S, HG_WIDTH).astype(q.dtype)


def dilated_window_attn(q, k, v, window, dil):
    Bsz, S, H, E = q.shape
    W = window // dil
    span = dil * W
    Sp = -(-S // span) * span
    M = Sp // dil
    nb = M // W

    def to_blocks(t):
        t = jnp.pad(t.astype(jnp.float32), ((0, 0), (0, Sp - S), (0, 0), (0, 0)))
        return t.reshape(Bsz, M, dil, H, E).transpose(0, 2, 1, 3, 4).reshape(Bsz, dil, nb, W, H, E)

    def with_prev(t):
        prev = jnp.pad(t[:, :, :-1], ((0, 0), (0, 0), (1, 0), (0, 0), (0, 0), (0, 0)))
        return jnp.concatenate([prev, t], axis=3)

    qb = to_blocks(q)
    kk = with_prev(to_blocks(k))
    vv = with_prev(to_blocks(v))
    s = jnp.einsum('brnihe,brnjhe->brnhij', qb, kk) * (E ** -0.5)
    i_idx = jnp.arange(W)[:, None]
    j_idx = jnp.arange(2 * W)[None, :]
    band = (j_idx >= i_idx) & (j_idx <= i_idx + W)
    blk = jnp.arange(nb)[:, None, None]
    valid = band[None] & ((blk > 0) | (j_idx >= W)[None])
    s = jnp.where(valid[None, None, :, None], s, -jnp.inf)
    m = jnp.max(s, axis=-1, keepdims=True)
    p = jnp.exp(s - m)
    l = jnp.sum(p, axis=-1, keepdims=True)
    o = jnp.einsum('brnhij,brnjhe->brnihe', p, vv) / jnp.swapaxes(l, 3, 4)
    lse = jnp.swapaxes((m + jnp.log(l))[..., 0], 3, 4)
    o = o.reshape(Bsz, dil, M, H, E).transpose(0, 2, 1, 3, 4).reshape(Bsz, Sp, H, E)[:, :S]
    lse = lse.reshape(Bsz, dil, M, H).transpose(0, 2, 1, 3).reshape(Bsz, Sp, H)[:, :S]
    return o, lse


def moe_ffn(h, w_router, router_bias, w_gu, w_down, w_sh_gu, w_sh_down):
    Bsz, S, D = h.shape
    T = Bsz * S
    hf = h.reshape(T, D)
    scores = jax.nn.sigmoid(jnp.matmul(hf, w_router).astype(jnp.float32))
    biased = scores + router_bias.astype(jnp.float32)
    grp_score = lax.top_k(biased.reshape(T, N_GROUP, N_EXPERTS // N_GROUP), 2)[0].sum(-1)
    _, gidx = lax.top_k(grp_score, TOPK_GROUP)
    gsel = jax.nn.one_hot(gidx, N_GROUP, dtype=jnp.float32).sum(1) > 0
    emask = jnp.repeat(gsel, N_EXPERTS // N_GROUP, axis=1)
    _, eidx = lax.top_k(jnp.where(emask, biased, -jnp.inf), TOP_K)
    gate = jnp.take_along_axis(scores, eidx, axis=-1)
    gate = gate / jnp.sum(gate, axis=-1, keepdims=True) * ROUTED_SCALE

    A = T * TOP_K
    flat_e = eidx.reshape(A).astype(jnp.int32)
    flat_tok = jnp.arange(A, dtype=jnp.int32) // TOP_K
    flat_w = gate.reshape(A)
    order = jnp.argsort(flat_e)
    s_e, s_tok, s_w = flat_e[order], flat_tok[order], flat_w[order]
    counts = jax.ops.segment_sum(jnp.ones((A,), jnp.int32), flat_e, num_segments=N_EXPERTS)
    starts = jnp.cumsum(counts) - counts
    pcounts = (counts + ROUTE_BLOCK - 1) // ROUTE_BLOCK * ROUTE_BLOCK
    pends = jnp.cumsum(pcounts)
    pstarts = pends - pcounts
    dest = pstarts[s_e] + jnp.arange(A, dtype=jnp.int32) - starts[s_e]
    n_blocks = -(-A // ROUTE_BLOCK) + N_EXPERTS
    P = n_blocks * ROUTE_BLOCK
    row_tok = jnp.full((P,), T, jnp.int32).at[dest].set(s_tok)
    row_w = jnp.zeros((P,), jnp.float32).at[dest].set(s_w)
    block_e = jnp.minimum(jnp.searchsorted(pends, jnp.arange(n_blocks, dtype=jnp.int32) * ROUTE_BLOCK, side='right'), N_EXPERTS - 1).astype(jnp.int32)
    x_pad = jnp.concatenate([hf, jnp.zeros((1, D), hf.dtype)], axis=0)

    def expert_block(acc, blk):
        rows, wts, e = blk
        xb = x_pad[rows]
        a, b = jnp.split(jnp.matmul(xb, w_gu[e]), 2, axis=-1)
        yb = jnp.matmul(jax.nn.silu(a) * b, w_down[e])
        return acc.at[rows].add(yb.astype(jnp.float32) * wts[:, None]), None

    routed, _ = lax.scan(expert_block, jnp.zeros((T + 1, D), jnp.float32),
                         (row_tok.reshape(n_blocks, ROUTE_BLOCK), row_w.reshape(n_blocks, ROUTE_BLOCK), block_e))
    sa, sb = jnp.split(jnp.matmul(hf, w_sh_gu), 2, axis=-1)
    shared = jnp.matmul(jax.nn.silu(sa) * sb, w_sh_down)
    return (routed[:T].astype(h.dtype) + shared).reshape(Bsz, S, D)


def setup_inputs(seed: int = 0) -> dict:
    key = jax.random.key(seed)
    ks = jax.random.split(key, 24)

    def nrm(k, shape, scale):
        return jax.random.normal(k, shape, jnp.float32) * scale

    L, D, E = DEPTH, D_MODEL, N_EXPERTS
    positions = (jnp.arange(SEQ, dtype=jnp.int32)[None, :] + jax.random.randint(ks[2], (BATCH, 1), 0, 1024, dtype=jnp.int32)).astype(jnp.int32)
    return {
        'x': nrm(ks[0], (BATCH, SEQ, D), 1.0),
        'c': nrm(ks[1], (BATCH, D), 1.0),
        'positions': positions,
        'w_ada': nrm(ks[3], (L, D, 6 * D), 0.5 * D ** -0.5),
        'b_ada': nrm(ks[4], (L, 6 * D), 0.02),
        'g_norm1': 1.0 + nrm(ks[5], (L, D), 0.02),
        'w_in': nrm(ks[6], (L, D, IN_WIDTH), D ** -0.5),
        'lb_logits': nrm(ks[7], (L + 1, HG_WIDTH), 0.1),
        'g_hgrn': 1.0 + nrm(ks[8], (L, HG_WIDTH), 0.02),
        'w_proj_a': nrm(ks[9], (L, HG_WIDTH, D), HG_WIDTH ** -0.5),
        'w_proj_b': nrm(ks[10], (L, ATT_WIDTH, D), ATT_WIDTH ** -0.5),
        'w_out': nrm(ks[11], (L, D, D), D ** -0.5),
        'g_norm2': 1.0 + nrm(ks[12], (L, D), 0.02),
        'w_router': nrm(ks[13], (L, D, E), D ** -0.5),
        'router_bias': nrm(ks[14], (L, E), 0.01),
        'w_exp_gu': nrm(ks[15], (L, E, D, 2 * EXPERT_FF), D ** -0.5),
        'w_exp_down': nrm(ks[16], (L, E, EXPERT_FF, D), EXPERT_FF ** -0.5),
        'w_sh_gu': nrm(ks[17], (L, D, 2 * SHARED_FF), D ** -0.5),
        'w_sh_down': nrm(ks[18], (L, SHARED_FF, D), SHARED_FF ** -0.5),
        'g_final': 1.0 + nrm(ks[19], (D,), 0.02),
    }


def reference(x, c, positions, w_ada, b_ada, g_norm1, w_in, lb_logits, g_hgrn, w_proj_a, w_proj_b, w_out,
              g_norm2, w_router, router_bias, w_exp_gu, w_exp_down, w_sh_gu, w_sh_down, g_final):
    Bsz, S, _ = x.shape
    lower_bounds = jnp.cumsum(jax.nn.softmax(lb_logits.astype(jnp.float32), axis=0), axis=0)
    inv_freq = 1.0 / (ROPE_THETA ** (jnp.arange(0, ROT_DIM, 2, dtype=jnp.float32) / ROT_DIM))
    ang = positions.astype(jnp.float32)[..., None] * inv_freq
    cos = jnp.cos(ang)[:, :, None, None, :]
    sin = jnp.sin(ang)[:, :, None, None, :]
    pts = split_points([HG_WIDTH] * 4 + [QKV_WIDTH] * 3 + [D_MODEL] * 2)
    att_shape = (Bsz, S, N_ATT_GROUPS, ATT_HEADS, ATT_HD)
    for l in range(DEPTH):
        mod = jnp.matmul(jax.nn.silu(c), w_ada[l]) + b_ada[l]
        shift1, scale1, gate1, shift2, scale2, gate2 = jnp.split(mod[:, None, :], 6, axis=-1)
        h = rms_norm(x, g_norm1[l]) * (1.0 + scale1) + shift1
        proj = jnp.matmul(h, w_in[l])
        hq, hfg, hi, hg, aq, ak, av, ga, gb = jnp.split(proj, pts, axis=-1)
        y_a = hgrn2_mixer(hq, hfg, hi, hg, lower_bounds[l], g_hgrn[l])
        aq = partial_rope(aq.reshape(att_shape), cos, sin)
        ak = partial_rope(ak.reshape(att_shape), cos, sin)
        av = av.reshape(att_shape)
        outs, lses = [], []
        for gi, (win, dil) in enumerate(ATT_GROUPS):
            o_g, lse_g = dilated_window_attn(aq[:, :, gi], ak[:, :, gi], av[:, :, gi], win, dil)
            outs.append(o_g)
            lses.append(lse_g)
        wgt = jax.nn.softmax(jnp.stack(lses, axis=0), axis=0)
        y_b = jnp.sum(wgt[..., None] * jnp.stack(outs, axis=0), axis=0).reshape(Bsz, S, ATT_WIDTH).astype(x.dtype)
        mixed = jax.nn.sigmoid(ga) * jnp.matmul(y_a, w_proj_a[l]) + jax.nn.sigmoid(gb) * jnp.matmul(y_b, w_proj_b[l])
        x = x + gate1 * jnp.matmul(mixed, w_out[l])
        h2 = rms_norm(x, g_norm2[l]) * (1.0 + scale2) + shift2
        x = x + gate2 * moe_ffn(h2, w_router[l], router_bias[l], w_exp_gu[l], w_exp_down[l], w_sh_gu[l], w_sh_down[l])
    return rms_norm(x, g_final)
```

```cpp
#include <hip/hip_runtime.h>
#include <cstdio>
#include <cstdint>

#ifndef MK_PER_PHASE
#define MK_PER_PHASE 0
#endif

#define GAS __attribute__((address_space(1)))
#define LAS __attribute__((address_space(3)))
typedef unsigned short bf16_t;
typedef short bf16x8 __attribute__((ext_vector_type(8)));
typedef short s16x4 __attribute__((ext_vector_type(4)));
typedef float f32x4 __attribute__((ext_vector_type(4)));
typedef float f32x2 __attribute__((ext_vector_type(2)));
typedef float f32x16 __attribute__((ext_vector_type(16)));
typedef unsigned u32x4 __attribute__((ext_vector_type(4)));
typedef unsigned u32x2 __attribute__((ext_vector_type(2)));
typedef long l64x2 __attribute__((ext_vector_type(2)));

constexpr int NB = 4, SEQ = 4096, T = NB * SEQ, D = 1024, INW = 8704;
constexpr int C_HQ = 0, C_HK = 512, C_HV = 1024, C_HG = 1536, C_AQ = 2048, C_AK = 3584, C_AV = 5120, C_GA = 6656, C_GB = 7680;
constexpr int NE = 256, NEX = 257, TOPK = 8, NSLOT = 9, EFF = 256;
constexpr float EPS = 1e-6f;
constexpr float WGU_SCALE = 64.0f, WD_SCALE = 32.0f;
constexpr float YSCALE = 16.0f;
constexpr int NWAVES = 8, NTHREADS = 512;

constexpr size_t MiB = 1u << 20;
constexpr size_t WS_CTL = 0, CTL_ZERO_BYTES = 1 * MiB;
constexpr size_t WS_MODP = 2 * MiB;
constexpr size_t WS_MOD = 4 * MiB;
constexpr size_t WS_LB = 4 * MiB + 128 * 1024;
constexpr size_t WS_ROPE = 5 * MiB;
constexpr size_t WS_DECAY = 6 * MiB;
constexpr size_t WS_GATEW = 7 * MiB;
constexpr size_t WS_LISTS = 16 * MiB;
constexpr size_t WS_WIN = 34 * MiB;
constexpr size_t WS_WPA = 51 * MiB, WS_WPB = 52 * MiB, WS_WOUT = 53 * MiB, WS_WR = 55 * MiB;
constexpr size_t WS_H = 56 * MiB;
constexpr size_t WS_LOGF = 88 * MiB;
constexpr size_t WS_H8 = 120 * MiB;
constexpr size_t WS_MIXED = 136 * MiB;
constexpr size_t WS_YCAT = 168 * MiB;
constexpr size_t WS_X1 = 200 * MiB;
constexpr size_t WS_OG = 264 * MiB;
constexpr size_t WS_LSE = 312 * MiB;
constexpr size_t WS_KVT = 314 * MiB;
constexpr size_t WS_SPT = 378 * MiB;
constexpr size_t WS_PROJ = 410 * MiB;
constexpr size_t WS_WGU = 682 * MiB;
constexpr size_t WS_WD = 939 * MiB;
constexpr size_t WS_ACT = 1068 * MiB;
constexpr size_t WS_YBUF = 1172 * MiB;
constexpr size_t WS_END = 1460 * MiB;
constexpr int CW_BAR = 4096;
constexpr int CW_PANEL = 65536;
constexpr int CW_CNT = 16384;

constexpr int RING_BYTES = 131072;
constexpr int TBL_OFF = RING_BYTES;
constexpr int TCNT_OFF = TBL_OFF + 4096;
constexpr int MISC_OFF = TCNT_OFF + 2560;
constexpr int LDS_BYTES = 147456;

#define LDS_WAIT() asm volatile("s_waitcnt lgkmcnt(0)" ::: "memory")
#define VM_WAIT() asm volatile("s_waitcnt vmcnt(0)" ::: "memory")
__device__ __forceinline__ unsigned f2bf(float f) { unsigned u = __builtin_bit_cast(unsigned, f); return (u + 0x7fffu + ((u >> 16) & 1u)) >> 16; }
__device__ __forceinline__ float bf2f(unsigned b) { return __builtin_bit_cast(float, b << 16); }
__device__ __forceinline__ unsigned pk2(float lo, float hi) { return f2bf(lo) | (f2bf(hi) << 16); }
__device__ __forceinline__ float bflo(unsigned w) { return __builtin_bit_cast(float, w << 16); }
__device__ __forceinline__ float bfhi(unsigned w) { return __builtin_bit_cast(float, w & 0xffff0000u); }
__device__ __forceinline__ float sigmoidf_(float x) { return 1.0f / (1.0f + __expf(-x)); }
__device__ __forceinline__ float wave_sum(float v) {
#pragma unroll
    for (int o = 1; o < 64; o <<= 1) v += __shfl_xor(v, o);
    return v;
}

__device__ __forceinline__ float clamp_e4m3(float x) { return __builtin_amdgcn_fmed3f(x, -448.0f, 448.0f); }
__device__ __forceinline__ unsigned pk4_fp8(float a, float b, float c, float d) { int w = 0; w = __builtin_amdgcn_cvt_pk_fp8_f32(clamp_e4m3(a), clamp_e4m3(b), w, false); w = __builtin_amdgcn_cvt_pk_fp8_f32(clamp_e4m3(c), clamp_e4m3(d), w, true); return (unsigned)w; }
__device__ __forceinline__ void st_wt8(void* p, unsigned long long v) { __hip_atomic_store((unsigned long long*)p, v, __ATOMIC_RELAXED, __HIP_MEMORY_SCOPE_AGENT); }
__device__ __forceinline__ void st_wt16(void* p, u32x4 v) { asm volatile("global_store_dwordx4 %0, %1, off sc1\n\ts_nop 1" :: "v"(p), "v"(v) : "memory"); }
__device__ __forceinline__ void st_wt4(void* p, unsigned v) { __hip_atomic_store((unsigned*)p, v, __ATOMIC_RELAXED, __HIP_MEMORY_SCOPE_AGENT); }
namespace pg8 {
constexpr int BM = 256, BK = 64, HALF = 128, HTB = HALF * BK * 2, STAGE_BYTES = 8 * HTB, NXCD = 8, WGM = 8;
__host__ __device__ __forceinline__ int lds_byte(int r, int c) { const int st = (r >> 4) * 2 + (c >> 5), rr = r & 15, cc = c & 31, ob = rr * 64 + cc * 2; return st * 1024 + (ob ^ (((ob >> 9) & 1) << 5)); }
__host__ __device__ __forceinline__ void stage_rc(int b, int& R, int& C) { const int st = b / 1024, sb = b % 1024, swz = sb ^ (((sb >> 9) & 1) << 5); R = (st >> 1) * 16 + swz / 64; C = (st & 1) * 32 + (swz % 64) / 2; }
__host__ __device__ __forceinline__ int perm32(int rho) { const int n = rho >> 4, i = rho & 15; return 8 * (i >> 2) + 4 * n + (i & 3); }

struct Unit { const char* a; const char* b; const int* rows; int pm, pn, aux, nvalid; };

__device__ __forceinline__ void swz_tile(int L, int nM, int nN, int& pm, int& pn) {
    const int nwg = nM * nN; int wgid = L;
    { const int q = nwg / NXCD, r = nwg % NXCD, xcd = wgid % NXCD, off = wgid / NXCD; wgid = (xcd < r ? xcd * (q + 1) : r * (q + 1) + (xcd - r) * q) + off; }
    const int nig = WGM * nN, gid = wgid / nig, fm = gid * WGM, gsz = (nM - fm) < WGM ? (nM - fm) : WGM;
    pm = fm + ((wgid % nig) % gsz); pn = (wgid % nig) / gsz;
}

__device__ __forceinline__ unsigned cvt_pk_bf16(float lo, float hi) { unsigned r; asm volatile("v_cvt_pk_bf16_f32 %0, %1, %2" : "=v"(r) : "v"(lo), "v"(hi)); return r; }

template <bool GATHER>
__device__ __forceinline__ void gather_offs(const Unit& u, int tid, int lda, unsigned (&v)[2][2]) {
    if constexpr (GATHER) {
#pragma unroll
        for (int i = 0; i < 2; ++i) { int R, C; stage_rc(tid * 16 + i * 8192, R, C);
#pragma unroll
            for (int hh = 0; hh < 2; ++hh) { const int ri = hh * HALF + R; int slot = 0; if (ri < u.nvalid) slot = u.rows[ri];
                const unsigned tok = (unsigned)slot / 9u; v[hh][i] = (tok * (unsigned)lda + (unsigned)C) * 2u; } }
    }
}

template <class Epi, class Sched, bool ALIGN_EPI, bool GATHER, bool FP8 = false>
__device__ __forceinline__ void gemm_phase(LAS unsigned char* lds, const int lda, const int ldb, const int K, const Sched& S, const Epi& E) {
    const int tid = threadIdx.x, wid = __builtin_amdgcn_readfirstlane(tid >> 6), lane = tid & 63, wr = wid >> 2, wc = wid & 3, fr = lane & 15, fq = lane >> 4;
    const int nt = K / BK;
    unsigned voffA[2], voffB[2];
#pragma unroll
    for (int i = 0; i < 2; ++i) { int R, C; stage_rc(tid * 16 + i * 8192, R, C); const int Rb = Epi::PERM ? ((R & ~31) + perm32(R & 31)) : R;
        voffA[i] = (unsigned)(R * lda + C) * 2u; voffB[i] = (unsigned)(Rb * ldb + C) * 2u; }
    const size_t kstep = (size_t)(BK * 2);
    const size_t hstepA = GATHER ? 0 : (size_t)HALF * lda * 2, hstepB = (size_t)HALF * ldb * 2;
    const unsigned ldsw = (unsigned)wid * 1024u;
    const int aoff = lds_byte(wr * 64 + fr, fq * 8), boff = lds_byte(wc * 32 + fr, fq * 8);
#define PG8_SA(b, h) (((b) * 2 + (h)) * HTB)
#define PG8_SB(b, h) ((4 + (b) * 2 + (h)) * HTB)
#define PG8_STAGE(bufoff, gbase, voff) do { _Pragma("unroll") for (int _i = 0; _i < 2; ++_i) \
        __builtin_amdgcn_global_load_lds((const unsigned*)((const char*)(gbase) + (voff)[_i]), (LAS unsigned*)(lds + (bufoff) + ldsw + _i * 8192), 16, 0, 0); } while (0)
#define PG8_STAGE_A(bufoff, gb, hh, nx) do { if constexpr (GATHER) { unsigned _v[2]; _v[0] = (nx) ? vn[hh][0] : vc[hh][0]; _v[1] = (nx) ? vn[hh][1] : vc[hh][1]; PG8_STAGE(bufoff, gb, _v); } \
        else { PG8_STAGE(bufoff, (gb) + (hh) * hstepA, voffA); } } while (0)
#define PG8_LDA(dst, b, h) do { _Pragma("unroll") for (int m = 0; m < 4; ++m) _Pragma("unroll") for (int k = 0; k < 2; ++k) dst[m][k] = *(const LAS bf16x8*)(lds + PG8_SA(b, h) + aoff + m * 2048 + k * 1024); } while (0)
#define PG8_LDB(dst, b, h) do { _Pragma("unroll") for (int n = 0; n < 2; ++n) _Pragma("unroll") for (int k = 0; k < 2; ++k) dst[n][k] = *(const LAS bf16x8*)(lds + PG8_SB(b, h) + boff + n * 2048 + k * 1024); } while (0)
#define PG8_MMA(ai, bj, At, Bt) do { __builtin_amdgcn_s_setprio(1); _Pragma("unroll") for (int m = 0; m < 4; ++m) _Pragma("unroll") for (int n = 0; n < 2; ++n) _Pragma("unroll") for (int k = 0; k < 2; ++k) { \
        if constexpr (FP8) { const l64x2 _b = __builtin_bit_cast(l64x2, Bt[n][k]), _a = __builtin_bit_cast(l64x2, At[m][k]); \
            acc[ai][bj][m][n] = __builtin_amdgcn_mfma_f32_16x16x32_fp8_fp8(_b[0], _a[0], acc[ai][bj][m][n], 0, 0, 0); acc[ai][bj][m][n] = __builtin_amdgcn_mfma_f32_16x16x32_fp8_fp8(_b[1], _a[1], acc[ai][bj][m][n], 0, 0, 0); } \
        else acc[ai][bj][m][n] = __builtin_amdgcn_mfma_f32_16x16x32_bf16(Bt[n][k], At[m][k], acc[ai][bj][m][n], 0, 0, 0); } __builtin_amdgcn_s_setprio(0); } while (0)
#define PG8_WAIT_V(n) asm volatile("s_waitcnt vmcnt(" #n ")" ::: "memory")
#define PG8_WAIT_L(n) asm volatile("s_waitcnt lgkmcnt(" #n ")" ::: "memory")
#define PG8_BAR __builtin_amdgcn_s_barrier()
#define PG8_SCHED __builtin_amdgcn_sched_barrier(0)
    Unit cur, nxt; int ui = 0;
    if (!S.next(0, cur)) return;
    unsigned vc[2][2] = {{0u, 0u}, {0u, 0u}}, vn[2][2] = {{0u, 0u}, {0u, 0u}};
    gather_offs<GATHER>(cur, tid, lda, vc);
    f32x4 acc[2][2][4][2];
#pragma unroll
    for (int a = 0; a < 2; ++a)
#pragma unroll
        for (int b = 0; b < 2; ++b)
#pragma unroll
            for (int m = 0; m < 4; ++m)
#pragma unroll
                for (int n = 0; n < 2; ++n) acc[a][b][m][n] = (f32x4){0.f, 0.f, 0.f, 0.f};
    bf16x8 At[4][2], B0[2][2], B1[2][2];
    const char* cA = cur.a; const char* cB = cur.b;
    PG8_STAGE(PG8_SB(0, 0), cB, voffB); PG8_STAGE(PG8_SB(0, 1), cB + hstepB, voffB); PG8_STAGE_A(PG8_SA(0, 0), cA, 0, false); PG8_STAGE_A(PG8_SA(0, 1), cA, 1, false);
    if (wr == 1) PG8_BAR;
    PG8_WAIT_V(2); PG8_BAR;
    PG8_STAGE(PG8_SB(1, 0), cB + kstep, voffB); PG8_STAGE_A(PG8_SA(1, 0), cA + kstep, 0, false); PG8_STAGE(PG8_SB(1, 1), cB + hstepB + kstep, voffB);
    PG8_WAIT_V(6); PG8_BAR;
    for (;;) {
        const bool has_next = S.next(ui + 1, nxt);
        if (has_next) gather_offs<GATHER>(nxt, tid, lda, vn);
        const char* nA = has_next ? nxt.a : cA; const char* nB = has_next ? nxt.b : cB;
        const bool do0 = !Sched::HALFSKIP || cur.nvalid > 64 * wr, do1 = !Sched::HALFSKIP || cur.nvalid > 128 + 64 * wr;
        for (int t = 0; t < nt; t += 2) {
            const bool last = (t == nt - 2);
            const bool lnx = last && has_next;
            const char* a1 = cA + (size_t)(t + 1) * kstep;
            const char* a2 = last ? nA : cA + (size_t)(t + 2) * kstep; const char* b2 = last ? nB : cB + (size_t)(t + 2) * kstep;
            const char* a3 = a2 + kstep; const char* b3 = b2 + kstep;
            PG8_LDB(B0, 0, 0); PG8_LDB(B1, 0, 1); PG8_SCHED; PG8_LDA(At, 0, 0); PG8_STAGE_A(PG8_SA(1, 1), a1, 1, false);
            PG8_WAIT_V(8); PG8_WAIT_L(0); PG8_BAR; if (do0) { PG8_MMA(0, 0, At, B0); PG8_MMA(0, 1, At, B1); } PG8_BAR; PG8_SCHED;
            PG8_LDA(At, 0, 1); PG8_STAGE(PG8_SB(0, 0), b2, voffB); PG8_STAGE(PG8_SB(0, 1), b2 + hstepB, voffB); PG8_STAGE_A(PG8_SA(0, 0), a2, 0, lnx);
            PG8_WAIT_V(8); PG8_WAIT_L(0); PG8_BAR; if (do1) { PG8_MMA(1, 0, At, B0); PG8_MMA(1, 1, At, B1); } PG8_BAR; PG8_SCHED;
            PG8_LDB(B0, 1, 0); PG8_LDB(B1, 1, 1); PG8_SCHED; PG8_LDA(At, 1, 0); PG8_STAGE_A(PG8_SA(0, 1), a2, 1, lnx);
            PG8_WAIT_V(8); PG8_WAIT_L(0); PG8_BAR; if (do0) { PG8_MMA(0, 0, At, B0); PG8_MMA(0, 1, At, B1); } PG8_BAR; PG8_SCHED;
            PG8_LDA(At, 1, 1); PG8_STAGE(PG8_SB(1, 0), b3, voffB); PG8_STAGE(PG8_SB(1, 1), b3 + hstepB, voffB); PG8_STAGE_A(PG8_SA(1, 0), a3, 0, lnx);
            PG8_WAIT_V(8); PG8_WAIT_L(0); PG8_BAR; if (do1) { PG8_MMA(1, 0, At, B0); PG8_MMA(1, 1, At, B1); } PG8_BAR; PG8_SCHED;
        }
        if constexpr (ALIGN_EPI) { if (wr == 0) PG8_BAR; }
        E(acc, cur, wr, wc, fr, fq);
        __builtin_amdgcn_s_waitcnt(0x0F70);
        if (!has_next) break;
        if (!E.keep(cur)) {
#pragma unroll
            for (int a = 0; a < 2; ++a)
#pragma unroll
                for (int b = 0; b < 2; ++b)
#pragma unroll
                    for (int m = 0; m < 4; ++m)
#pragma unroll
                        for (int n = 0; n < 2; ++n) acc[a][b][m][n] = (f32x4){0.f, 0.f, 0.f, 0.f};
        }
        cur = nxt; cA = nA; cB = nB; ++ui;
        if constexpr (GATHER) {
#pragma unroll
            for (int hh = 0; hh < 2; ++hh) { vc[hh][0] = vn[hh][0]; vc[hh][1] = vn[hh][1]; }
        }
        if constexpr (ALIGN_EPI) { if (wr == 1) PG8_BAR; }
    }
    PG8_WAIT_V(0);
    if constexpr (!ALIGN_EPI) { if (wr == 0) PG8_BAR; }
    PG8_BAR;
#undef PG8_SA
#undef PG8_SB
#undef PG8_STAGE
#undef PG8_STAGE_A
#undef PG8_LDA
#undef PG8_LDB
#undef PG8_MMA
#undef PG8_WAIT_V
#undef PG8_WAIT_L
#undef PG8_BAR
#undef PG8_SCHED
}
}

#define XB_TMO      128
#define XB_XCNT(j)  (256  + 64 * (j))
#define XB_XSUB(j)  (1280 + 64 * (j))
#define XB_XGEN(j)  (2304 + 64 * (j))
#define XB_TOP      3328
#define XB_TOPGEN   3392
#define XCD_BAR_WORDS 3456
#define XB_SPIN_CAP (1u << 20)
__device__ __forceinline__ unsigned xb_ld(unsigned* p)              { return __hip_atomic_load(p, __ATOMIC_RELAXED, __HIP_MEMORY_SCOPE_AGENT); }
__device__ __forceinline__ unsigned xb_add(unsigned* p, unsigned v) { return __hip_atomic_fetch_add(p, v, __ATOMIC_RELAXED, __HIP_MEMORY_SCOPE_AGENT); }
__device__ __forceinline__ unsigned xb_xcc_id() { return (unsigned)__builtin_amdgcn_s_getreg((3 << 11) | 20) & 0xFu; }
#define XB_SPIN(cond, bar) do { unsigned _sp = 0; while (cond) { __builtin_amdgcn_s_sleep(1); \
    if ((++_sp & 255u) == 0u) { if (xb_ld(&(bar)[XB_TMO])) break; if (_sp > XB_SPIN_CAP) { atomicAdd(&(bar)[XB_TMO], 1u); break; } } } } while (0)
struct XcdBarrier { unsigned* bar; unsigned x; volatile LAS unsigned* st; };
__device__ __forceinline__ XcdBarrier xcd_barrier_post(unsigned* bar, volatile LAS unsigned* st) {
    XcdBarrier b; b.bar = bar; b.x = xb_xcc_id(); b.st = st;
    if (threadIdx.x == 0) (void)xb_add(&bar[XB_XCNT(b.x)], 1u);
    return b;
}
__device__ __forceinline__ void xcd_barrier_complete(unsigned* bar, unsigned x, unsigned& nloc, unsigned& nx) {
    const unsigned G = gridDim.x * gridDim.y * gridDim.z;
    unsigned sum, cnt, mine, sp = 0u;
    for (;;) {
        sum = 0u; cnt = 0u; mine = 0u;
#pragma unroll
        for (unsigned j = 0; j < 16; ++j) { const unsigned c = xb_ld(&bar[XB_XCNT(j)]); sum += c; cnt += (c > 0u) ? 1u : 0u; mine = (j == x) ? c : mine; }
        if (sum == G) break;
        __builtin_amdgcn_s_sleep(1);
        if ((++sp & 255u) == 0u) { if (xb_ld(&bar[XB_TMO])) break; if (sp > XB_SPIN_CAP) { atomicAdd(&bar[XB_TMO], 1u); break; } }
    }
    nloc = mine > 0u ? mine : 1u; nx = cnt > 0u ? cnt : 1u;
}
__device__ __forceinline__ void xcd_barrier(const XcdBarrier& b) {
    asm volatile("s_waitcnt vmcnt(0)" ::: "memory");
    __syncthreads();
    if (threadIdx.x == 0) {
        unsigned* bar = b.bar;
        __builtin_amdgcn_s_waitcnt(0);
        unsigned nloc = b.st[0], nx = b.st[1];
        if (nloc == 0u) { xcd_barrier_complete(bar, b.x, nloc, nx); b.st[0] = nloc; b.st[1] = nx; }
        const unsigned old = xb_add(&bar[XB_XSUB(b.x)], 1u);
        const unsigned gen = old / nloc;
        if (old + 1u == (gen + 1u) * nloc) {
            __builtin_amdgcn_fence(__ATOMIC_RELEASE, "agent");
            asm volatile("s_waitcnt vmcnt(0)" ::: "memory");
            const unsigned og = xb_add(&bar[XB_TOP], 1u);
            const unsigned tg = og / nx;
            if (og + 1u == (tg + 1u) * nx) xb_add(&bar[XB_TOPGEN], 1u);
            else XB_SPIN(xb_ld(&bar[XB_TOPGEN]) == tg, bar);
            __builtin_amdgcn_fence(__ATOMIC_ACQUIRE, "agent");
            asm volatile("s_waitcnt vmcnt(0)" ::: "memory");
        } else {
            XB_SPIN(xb_ld(&bar[XB_TOPGEN]) == gen, bar);
            __builtin_amdgcn_fence(__ATOMIC_ACQUIRE, "agent");
            asm volatile("s_waitcnt vmcnt(0)" ::: "memory");
        }
    }
    __syncthreads();
}

struct Ctx {
    LAS unsigned char* lds;
    int tid, lane, wave, wg, G;
    const float *x, *c, *w_ada, *b_ada, *g1, *w_in, *lb_logits, *g_hgrn, *w_pa, *w_pb, *w_out, *g2, *w_router, *rbias, *w_egu, *w_edown, *w_sgu, *w_sdown, *g_final;
    const int* positions;
    float* out;
    unsigned char* ws;
};
#define WSP(type, off) ((type*)(X.ws + (off)))

__device__ __forceinline__ void transpose_item(const float* W, int K, int N, bf16_t* WT, int dst_row0, int src_col0, int k0, LAS float* scr, int lane) {
#pragma unroll 16
    for (int i = 0; i < 32; ++i) { const int kk = 2 * i + (lane >> 5); scr[kk * 33 + (lane & 31)] = W[(size_t)(k0 + kk) * N + src_col0 + (lane & 31)]; }
    LDS_WAIT(); asm volatile("" ::: "memory");
    const int c = lane & 7;
#pragma unroll
    for (int j = 0; j < 4; ++j) { const int n = (lane >> 3) + 8 * j; const LAS float* s = scr + (8 * c) * 33 + n;
        u32x4 o; o.x = pk2(s[0 * 33], s[1 * 33]); o.y = pk2(s[2 * 33], s[3 * 33]); o.z = pk2(s[4 * 33], s[5 * 33]); o.w = pk2(s[6 * 33], s[7 * 33]);
        *(u32x4*)(WT + (size_t)(dst_row0 + n) * K + k0 + 8 * c) = o; }
    LDS_WAIT(); asm volatile("" ::: "memory");
}
__device__ __forceinline__ void transpose_plain(const float* W, int K, int N, bf16_t* WT, int item, LAS float* scr, int lane) {
    const int nblk = N / 32, kb = item / nblk, nb = item % nblk;
    transpose_item(W, K, N, WT, nb * 32, nb * 32, kb * 64, scr, lane);
}
__device__ __forceinline__ void p0_prologue(Ctx& X) {
    LAS float* scr = (LAS float*)(X.lds + X.wave * 16384);
    const int gw = X.wg * NWAVES + X.wave, NGW = X.G * NWAVES;
    {
        float* MODP = WSP(float, WS_MODP);
        for (int it = gw; it < 96 * 16; it += NGW) {
            const int jc = it % 96, kc = it / 96, j = jc * 64 + X.lane;
            float a0 = 0.f, a1 = 0.f, a2 = 0.f, a3 = 0.f;
#pragma unroll 16
            for (int kk = 0; kk < 64; ++kk) { const int k = kc * 64 + kk; const float w = X.w_ada[(size_t)k * 6144 + j];
                const float c0 = X.c[k], c1 = X.c[1024 + k], c2 = X.c[2048 + k], c3 = X.c[3072 + k];
                a0 += c0 * sigmoidf_(c0) * w; a1 += c1 * sigmoidf_(c1) * w; a2 += c2 * sigmoidf_(c2) * w; a3 += c3 * sigmoidf_(c3) * w; }
            float* o = MODP + (size_t)kc * 24576 + j;
            o[0] = a0; o[6144] = a1; o[12288] = a2; o[18432] = a3;
        }
    }
    {
        float* ROPE = WSP(float, WS_ROPE);
        const int gt = X.wg * NTHREADS + X.tid, NGT = X.G * NTHREADS;
        for (int idx = gt; idx < T * 8; idx += NGT) { const int t = idx >> 3, i = idx & 7;
            const float inv_freq = 1.0f / powf(500000.0f, (float)(2 * i) / 16.0f);
            const float ang = (float)X.positions[t] * inv_freq;
            ROPE[t * 16 + i] = cosf(ang); ROPE[t * 16 + 8 + i] = sinf(ang); }
        if (X.wg == 0) { float* LB = WSP(float, WS_LB);
            for (int j = X.tid; j < 512; j += NTHREADS) { const float l0 = X.lb_logits[j], l1 = X.lb_logits[512 + j], m = fmaxf(l0, l1), e0 = __expf(l0 - m), e1 = __expf(l1 - m); LB[j] = e0 / (e0 + e1); } }
    }
}
struct CvtItem { const float* src; bf16_t* dst; };
template <bool GU> __device__ __forceinline__ CvtItem cvt_item(const Ctx& X, int it) {
    CvtItem c;
    if constexpr (GU) { const int e = it >> 7, q = it & 127, w8 = q & 7, sq = q >> 3, kb = 4 * (sq >> 2) + (w8 & 3), nb = 2 * (sq & 3) + (w8 >> 2);
        const int n0 = nb * 64, pn = n0 >> 8, bj = (n0 >> 7) & 1, idx = n0 & 127, srcc = bj * 256 + pn * 128 + idx;
        const float* W = (e < NE) ? X.w_egu + (size_t)e * 1024 * 512 : X.w_sgu;
        c.src = W + (size_t)(kb * 64) * 512 + srcc; c.dst = (bf16_t*)(X.ws + WS_WGU + ((size_t)e * 512 + n0) * 1024 + kb * 64); }
    else { const int e = it >> 6, q = it & 63, w8 = q & 7, sq = q >> 3, kb = w8 & 3, nb = 2 * sq + (w8 >> 2);
        const float* W = (e < NE) ? X.w_edown + (size_t)e * 256 * 1024 : X.w_sdown;
        c.src = W + (size_t)(kb * 64) * 1024 + nb * 64; c.dst = (bf16_t*)(X.ws + WS_WD + ((size_t)e * 1024 + nb * 64) * 256 + kb * 64); }
    return c;
}
template <int KB> __device__ __forceinline__ void cvt_store8(const CvtItem& c, int lane, const f32x4 (&v)[16], LAS unsigned char* tl, float sc) {
    const int kq = lane >> 4, nq = lane & 15;
#pragma unroll
    for (int i = 0; i < 4; ++i) { u32x4 w;
        w.x = pk4_fp8(v[0][i] * sc, v[1][i] * sc, v[2][i] * sc, v[3][i] * sc); w.y = pk4_fp8(v[4][i] * sc, v[5][i] * sc, v[6][i] * sc, v[7][i] * sc);
        w.z = pk4_fp8(v[8][i] * sc, v[9][i] * sc, v[10][i] * sc, v[11][i] * sc); w.w = pk4_fp8(v[12][i] * sc, v[13][i] * sc, v[14][i] * sc, v[15][i] * sc);
        *(LAS u32x4*)(tl + (4 * nq + i) * 80 + kq * 16) = w; }
    LDS_WAIT(); asm volatile("" ::: "memory");
    const int ch = lane & 3, r = lane >> 2;
    unsigned char* d8 = (unsigned char*)c.dst;
#pragma unroll
    for (int j = 0; j < 4; ++j) { const int n = 16 * j + r; const u32x4 w = *(const LAS u32x4*)(tl + n * 80 + ch * 16); __builtin_nontemporal_store(w, (u32x4*)(d8 + (size_t)n * KB + 16 * ch)); }
    LDS_WAIT(); asm volatile("" ::: "memory");
}
template <int N> __device__ __forceinline__ void cvt_load(const CvtItem& c, int lane, f32x4 (&v)[16]) {
    const float* p = c.src + (size_t)(16 * (lane >> 4)) * N + 4 * (lane & 15);
#pragma unroll
    for (int j = 0; j < 16; ++j) v[j] = __builtin_nontemporal_load((const f32x4*)(p + (size_t)j * N));
}
template <int K> __device__ __forceinline__ void cvt_store(const CvtItem& c, int lane, const f32x4 (&v)[16], LAS unsigned char* tl) {
    const int kq = lane >> 4, nq = lane & 15;
#pragma unroll
    for (int i = 0; i < 4; ++i) { u32x4 w0, w1;
        w0.x = pk2(v[0][i], v[1][i]); w0.y = pk2(v[2][i], v[3][i]); w0.z = pk2(v[4][i], v[5][i]); w0.w = pk2(v[6][i], v[7][i]);
        w1.x = pk2(v[8][i], v[9][i]); w1.y = pk2(v[10][i], v[11][i]); w1.z = pk2(v[12][i], v[13][i]); w1.w = pk2(v[14][i], v[15][i]);
        LAS unsigned char* q = tl + (4 * nq + i) * 144 + kq * 32; *(LAS u32x4*)q = w0; *(LAS u32x4*)(q + 16) = w1; }
    LDS_WAIT(); asm volatile("" ::: "memory");
    const int ch = lane & 7, r = lane >> 3;
#pragma unroll
    for (int j = 0; j < 8; ++j) { const int n = 8 * j + r; const u32x4 w = *(const LAS u32x4*)(tl + n * 144 + ch * 16); __builtin_nontemporal_store(w, (u32x4*)(c.dst + (size_t)n * K + 8 * ch)); }
    LDS_WAIT(); asm volatile("" ::: "memory");
}
struct CvtPair { const float* src; unsigned char* dst; };
template <bool GU> __device__ __forceinline__ CvtPair cvt_pair(const Ctx& X, int di) {
    CvtPair c;
    if constexpr (GU) { const int e = di >> 6, q = di & 63, nb = q & 7, kb2 = q >> 3;
        const int n0 = nb * 64, pn = n0 >> 8, bj = (n0 >> 7) & 1, idx = n0 & 127, srcc = bj * 256 + pn * 128 + idx;
        const float* W = (e < NE) ? X.w_egu + (size_t)e * 1024 * 512 : X.w_sgu;
        c.src = W + (size_t)(kb2 * 128) * 512 + srcc; c.dst = X.ws + WS_WGU + ((size_t)e * 512 + n0) * 1024 + kb2 * 128; }
    else { const int e = di >> 5, q = di & 31, nb = q & 15, kb2 = q >> 4;
        const float* W = (e < NE) ? X.w_edown + (size_t)e * 256 * 1024 : X.w_sdown;
        c.src = W + (size_t)(kb2 * 128) * 1024 + nb * 64; c.dst = X.ws + WS_WD + ((size_t)e * 1024 + nb * 64) * 256 + kb2 * 128; }
    return c;
}
template <int N> __device__ __forceinline__ void cvt_load_half(const CvtPair& c, int half, int lane, f32x4 (&v)[16]) {
    const float* p = c.src + (size_t)(64 * half + 16 * (lane >> 4)) * N + 4 * (lane & 15);
#pragma unroll
    for (int j = 0; j < 16; ++j) v[j] = __builtin_nontemporal_load((const f32x4*)(p + (size_t)j * N));
}
__device__ __forceinline__ void cvt_half_to_lds(int half, int lane, const f32x4 (&v)[16], LAS unsigned char* tl, float sc) {
    const int kq = lane >> 4, nq = lane & 15;
#pragma unroll
    for (int i = 0; i < 4; ++i) { u32x4 w;
        w.x = pk4_fp8(v[0][i] * sc, v[1][i] * sc, v[2][i] * sc, v[3][i] * sc); w.y = pk4_fp8(v[4][i] * sc, v[5][i] * sc, v[6][i] * sc, v[7][i] * sc);
        w.z = pk4_fp8(v[8][i] * sc, v[9][i] * sc, v[10][i] * sc, v[11][i] * sc); w.w = pk4_fp8(v[12][i] * sc, v[13][i] * sc, v[14][i] * sc, v[15][i] * sc);
        *(LAS u32x4*)(tl + (4 * nq + i) * 144 + half * 64 + kq * 16) = w; }
}
template <int KB> __device__ __forceinline__ void cvt_flush(const CvtPair& c, int lane, LAS unsigned char* tl) {
    LDS_WAIT(); asm volatile("" ::: "memory");
    const int ch = lane & 7, r = lane >> 3;
#pragma unroll
    for (int j = 0; j < 8; ++j) { const int n = 8 * j + r; const u32x4 w = *(const LAS u32x4*)(tl + n * 144 + ch * 16); __builtin_nontemporal_store(w, (u32x4*)(c.dst + (size_t)n * KB + 16 * ch)); }
    LDS_WAIT(); asm volatile("" ::: "memory");
}
template <bool GU> __device__ __forceinline__ void expert_convert_set(Ctx& X, int gw, int NGW, LAS unsigned char* tl) {
    constexpr int NIT = GU ? NEX * 64 : NEX * 32, N = GU ? 512 : 1024, K = GU ? 1024 : 256; constexpr float SC = GU ? WGU_SCALE : WD_SCALE;
    if (gw >= NIT) return;
    const int nmine = (NIT - gw + NGW - 1) / NGW;
    f32x4 va[16], vb[16];
    CvtPair cur = cvt_pair<GU>(X, gw);
    cvt_load_half<N>(cur, 0, X.lane, va); cvt_load_half<N>(cur, 1, X.lane, vb);
    for (int j = 0; j < nmine; ++j) {
        const CvtPair nxt = cvt_pair<GU>(X, gw + (j + 1 < nmine ? j + 1 : j) * NGW);
        __builtin_amdgcn_sched_barrier(0);
        cvt_half_to_lds(0, X.lane, va, tl, SC);
        __builtin_amdgcn_sched_barrier(0);
        cvt_load_half<N>(nxt, 0, X.lane, va);
        __builtin_amdgcn_sched_barrier(0);
        cvt_half_to_lds(1, X.lane, vb, tl, SC);
        cvt_flush<K>(cur, X.lane, tl);
        __builtin_amdgcn_sched_barrier(0);
        cvt_load_half<N>(nxt, 1, X.lane, vb);
        __builtin_amdgcn_sched_barrier(0);
        cur = nxt;
    }
}
__device__ __forceinline__ void expert_convert(Ctx& X, int cw, int ncw) {
    LAS unsigned char* tl = X.lds + X.wave * 16384;
    const int gw = cw * NWAVES + X.wave, NGW = ncw * NWAVES;
    expert_convert_set<true>(X, gw, NGW, tl);
    expert_convert_set<false>(X, gw, NGW, tl);
}

__device__ __forceinline__ void small_transposes(Ctx& X) {
    LAS float* scr = (LAS float*)(X.lds + 16384 + X.wave * 12288);
    const int gw = X.wg * NWAVES + X.wave, NGW = X.G * NWAVES;
    {
        constexpr int I_IN = 16 * 272, I_PA = 8 * 32, I_PB = 8 * 32, I_OUT = 16 * 32, I_R = 16 * 8;
        constexpr int NITEMS = I_IN + I_PA + I_PB + I_OUT + I_R;
        for (int it = gw; it < NITEMS; it += NGW) {
            int r = it;
            if (r < I_IN) { transpose_plain(X.w_in, 1024, INW, WSP(bf16_t, WS_WIN), r, scr, X.lane); continue; } r -= I_IN;
            if (r < I_PA) { transpose_plain(X.w_pa, 512, 1024, WSP(bf16_t, WS_WPA), r, scr, X.lane); continue; } r -= I_PA;
            if (r < I_PB) { transpose_plain(X.w_pb, 512, 1024, WSP(bf16_t, WS_WPB), r, scr, X.lane); continue; } r -= I_PB;
            if (r < I_OUT) { transpose_plain(X.w_out, 1024, 1024, WSP(bf16_t, WS_WOUT), r, scr, X.lane); continue; } r -= I_OUT;
            transpose_plain(X.w_router, 1024, 256, WSP(bf16_t, WS_WR), r, scr, X.lane);
        }
    }
}

__device__ __forceinline__ void norm_rows(Ctx& X, int which) {
    LAS float* sm = (LAS float*)X.lds;
    const float* MODP = WSP(float, WS_MODP); float* MOD = WSP(float, WS_MOD);
    const int rows_per_wg = T / X.G, row0 = X.wg * rows_per_wg, b = row0 / SEQ;
    if (which == 0) {
        for (int i = X.tid; i < 2048; i += NTHREADS) { const int j = b * 6144 + i; float s = X.b_ada[i];
#pragma unroll
            for (int p = 0; p < 16; ++p) s += MODP[(size_t)p * 24576 + j];
            sm[i] = s; }
        const int per = 24576 / X.G;
        for (int i = X.tid; i < per; i += NTHREADS) { const int j = X.wg * per + i; float s = X.b_ada[j % 6144];
#pragma unroll
            for (int p = 0; p < 16; ++p) s += MODP[(size_t)p * 24576 + j];
            MOD[j] = s; }
    } else {
        for (int i = X.tid; i < 2048; i += NTHREADS) sm[i] = MOD[b * 6144 + 3072 + i];
    }
    __syncthreads();
    const float* src = X.x; const bf16_t* srcb = WSP(bf16_t, WS_X1); const float* g = which == 0 ? X.g1 : X.g2;
    bf16_t* H = WSP(bf16_t, WS_H);
    for (int r = X.wave; r < rows_per_wg; r += NWAVES) {
        const int row = row0 + r;
        f32x4 v[2][2]; float s = 0.f;
#pragma unroll
        for (int j = 0; j < 2; ++j) { const int col = 8 * X.lane + 512 * j;
            if (which == 0) { v[j][0] = *(const f32x4*)(src + (size_t)row * D + col); v[j][1] = *(const f32x4*)(src + (size_t)row * D + col + 4); }
            else { const u32x4 wv = *(const u32x4*)(srcb + (size_t)row * D + col); v[j][0] = (f32x4){bflo(wv.x), bfhi(wv.x), bflo(wv.y), bfhi(wv.y)}; v[j][1] = (f32x4){bflo(wv.z), bfhi(wv.z), bflo(wv.w), bfhi(wv.w)}; }
#pragma unroll
            for (int q = 0; q < 2; ++q) s += (v[j][q].x * v[j][q].x + v[j][q].y * v[j][q].y) + (v[j][q].z * v[j][q].z + v[j][q].w * v[j][q].w); }
        const float rstd = rsqrtf(wave_sum(s) * (1.f / D) + EPS);
#pragma unroll
        for (int j = 0; j < 2; ++j) { const int col = 8 * X.lane + 512 * j; float y[8];
#pragma unroll
            for (int q = 0; q < 2; ++q) { const f32x4 gg = *(const f32x4*)(g + col + 4 * q), sh = *(const LAS f32x4*)(sm + col + 4 * q), sc = *(const LAS f32x4*)(sm + 1024 + col + 4 * q);
#pragma unroll
                for (int e = 0; e < 4; ++e) y[4 * q + e] = v[j][q][e] * rstd * gg[e] * (1.f + sc[e]) + sh[e]; }
            u32x4 hw; hw.x = pk2(y[0], y[1]); hw.y = pk2(y[2], y[3]); hw.z = pk2(y[4], y[5]); hw.w = pk2(y[6], y[7]);
            if (which == 1) { st_wt16(H + (size_t)row * D + col, hw);
                st_wt8(WSP(unsigned char, WS_H8) + (size_t)row * D + col, (unsigned long long)pk4_fp8(y[0], y[1], y[2], y[3]) | ((unsigned long long)pk4_fp8(y[4], y[5], y[6], y[7]) << 32)); }
            else *(u32x4*)(H + (size_t)row * D + col) = hw; }
    }
    __syncthreads();
}

struct RegSched {
    static constexpr bool HALFSKIP = false;
    const char* A; const char* Bt; size_t a_tile, b_tile; int nM, nN, G, c;
    __device__ __forceinline__ bool next(int i, pg8::Unit& u) const {
        const int L = i * G + c; if (L >= nM * nN) return false;
        int pm, pn; pg8::swz_tile(L, nM, nN, pm, pn);
        u.a = A + (size_t)pm * a_tile; u.b = Bt + (size_t)pn * b_tile; u.rows = nullptr; u.pm = pm; u.pn = pn; u.aux = 0; u.nvalid = 256; return true;
    }
};
struct TwoPartSched {      static constexpr bool HALFSKIP = false;
    const char* Y; const char* Wa; const char* Wb; int nM, nN, G, c;
    __device__ __forceinline__ bool next(int i, pg8::Unit& u) const {
        const int L = (i >> 1) * G + c, part = i & 1; if (L >= nM * nN) return false;
        int pm, pn; pg8::swz_tile(L, nM, nN, pm, pn);
        u.a = Y + (size_t)pm * 256 * 2048 + part * 1024; u.b = (part ? Wb : Wa) + (size_t)pn * 256 * 1024; u.rows = nullptr; u.pm = pm; u.pn = pn; u.aux = part; u.nvalid = 256; return true;
    }
};
struct MoeSched {
    static constexpr bool HALFSKIP = true;
    const LAS int* tbl; const LAS int* cnts; int nent; const char* A; const char* W; const int* lists; int ncol  , wtile  , wexp  , atile  , G, c;
    __device__ __forceinline__ bool next(int i, pg8::Unit& u) const {
        const int un = i * (G >> 3) + (c >> 3); if (un >= nent * ncol) return false;
        const int pn = un % ncol; const int ent = __builtin_amdgcn_readfirstlane(tbl[un / ncol]), e = (ent >> 7) & 511, r = ent & 127, rt = ent >> 16;
        u.a = A + (size_t)rt * atile; u.b = W + (size_t)e * wexp + (size_t)pn * wtile; u.rows = lists + (size_t)e * 16384 + r * 256;
        u.pm = rt; u.pn = pn; u.aux = e; const int left = __builtin_amdgcn_readfirstlane(cnts[e]) - r * 256; u.nvalid = left < 256 ? left : 256; return true;
    }
};

struct EpiInproj {
    static constexpr bool PERM = true;
    bf16_t* PROJ; float* LOGF; const float* LB; const float* ROPE;
    __device__ __forceinline__ bool keep(const pg8::Unit&) const { return false; }
    __device__ __forceinline__ void operator()(f32x4 (&acc)[2][2][4][2], const pg8::Unit& u, int wr, int wc, int fr, int fq) const {
        const int pn = u.pn;
        const int mode = pn < 2 ? 0 : pn < 4 ? 1 : pn < 6 ? 0 : pn < 8 ? 2 : pn < 20 ? 3 : pn < 26 ? 0 : 4;
        const int row0 = u.pm * 256 + wr * 64 + fr, colb = pn * 256 + wc * 32 + 8 * fq;
        const bool rot = (mode == 3) && ((wc & 1) == 0);
#pragma unroll
        for (int ai = 0; ai < 2; ++ai)
#pragma unroll
            for (int m = 0; m < 4; ++m) {
                const int row = row0 + ai * 128 + m * 16;
                f32x4 cs0, cs1, sn0, sn1;
                if (rot) { const f32x4* rp = (const f32x4*)(ROPE + (size_t)row * 16); cs0 = rp[0]; cs1 = rp[1]; sn0 = rp[2]; sn1 = rp[3]; }
#pragma unroll
                for (int bj = 0; bj < 2; ++bj) {
                    const int col = colb + bj * 128;
                    f32x4 v0 = acc[ai][bj][m][0], v1 = acc[ai][bj][m][1];
                    if (mode == 1) {
                        const int cf = col - 512; const f32x4 l0 = *(const f32x4*)(LB + cf), l1 = *(const f32x4*)(LB + cf + 4);
                        f32x4 lf0, lf1;
#pragma unroll
                        for (int j = 0; j < 4; ++j) { float sg = sigmoidf_(v0[j]); float f = l0[j] + (1.f - l0[j]) * sg; lf0[j] = __logf(f); v0[j] = (1.f - l0[j]) * (1.f - sg);
                            sg = sigmoidf_(v1[j]); f = l1[j] + (1.f - l1[j]) * sg; lf1[j] = __logf(f); v1[j] = (1.f - l1[j]) * (1.f - sg); }
                        acc[ai][bj][m][0] = lf0; acc[ai][bj][m][1] = lf1;
                    } else if (mode == 2) {
#pragma unroll
                        for (int j = 0; j < 4; ++j) { v0[j] = v0[j] * sigmoidf_(v0[j]); v1[j] = v1[j] * sigmoidf_(v1[j]); }
                    } else if (mode == 4) {
#pragma unroll
                        for (int j = 0; j < 4; ++j) { v0[j] = sigmoidf_(v0[j]); v1[j] = sigmoidf_(v1[j]); }
                    } else if (rot) {
                        f32x4 p0, p1;
#pragma unroll
                        for (int j = 0; j < 4; ++j) { p0[j] = __shfl_xor(v0[j], 16); p1[j] = __shfl_xor(v1[j], 16); }
                        if (fq == 0) { v0 = v0 * cs0 - p0 * sn0; v1 = v1 * cs1 - p1 * sn1; }
                        else if (fq == 1) { v0 = v0 * cs0 + p0 * sn0; v1 = v1 * cs1 + p1 * sn1; }
                    }
                    u32x4 w; w.x = pg8::cvt_pk_bf16(v0[0], v0[1]); w.y = pg8::cvt_pk_bf16(v0[2], v0[3]); w.z = pg8::cvt_pk_bf16(v1[0], v1[1]); w.w = pg8::cvt_pk_bf16(v1[2], v1[3]);
                    *(u32x4*)(PROJ + (size_t)row * INW + col) = w;
                }
            }
        if (mode == 1) {
            const int lane = fq * 16 + fr;
#pragma unroll
            for (int ai = 0; ai < 2; ++ai)
#pragma unroll
                for (int bj = 0; bj < 2; ++bj)
#pragma unroll
                    for (int n = 0; n < 2; ++n)
#pragma unroll
                        for (int j = 0; j < 4; ++j) { float carry = 0.f;
#pragma unroll
                            for (int m = 0; m < 4; ++m) { float v = acc[ai][bj][m][n][j];
                                v += __builtin_bit_cast(float, __builtin_amdgcn_update_dpp(0, __builtin_bit_cast(int, v), 0x111, 0xF, 0xF, true));
                                v += __builtin_bit_cast(float, __builtin_amdgcn_update_dpp(0, __builtin_bit_cast(int, v), 0x112, 0xF, 0xF, true));
                                v += __builtin_bit_cast(float, __builtin_amdgcn_update_dpp(0, __builtin_bit_cast(int, v), 0x114, 0xF, 0xF, true));
                                v += __builtin_bit_cast(float, __builtin_amdgcn_update_dpp(0, __builtin_bit_cast(int, v), 0x118, 0xF, 0xF, true));
                                v += carry; acc[ai][bj][m][n][j] = v; carry = __shfl(v, (lane & 48) | 15); } }
#pragma unroll
            for (int ai = 0; ai < 2; ++ai)
#pragma unroll
                for (int m = 0; m < 4; ++m)
#pragma unroll
                    for (int bj = 0; bj < 2; ++bj) { float* lp = LOGF + (size_t)(row0 + ai * 128 + m * 16) * 512 + (colb + bj * 128 - 512); *(f32x4*)lp = acc[ai][bj][m][0]; *(f32x4*)(lp + 4) = acc[ai][bj][m][1]; }
        }
    }
};
struct EpiMixed {
    static constexpr bool PERM = true;
    const bf16_t* PROJ; bf16_t* MIXED;
    __device__ __forceinline__ bool keep(const pg8::Unit& u) const { return u.aux == 0; }
    __device__ __forceinline__ void operator()(f32x4 (&acc)[2][2][4][2], const pg8::Unit& u, int wr, int wc, int fr, int fq) const {
        const int row0 = u.pm * 256 + wr * 64 + fr, colb = u.pn * 256 + wc * 32 + 8 * fq;
#pragma unroll
        for (int ai = 0; ai < 2; ++ai)
#pragma unroll
            for (int m = 0; m < 4; ++m) {
                const int row = row0 + ai * 128 + m * 16;
#pragma unroll
                for (int bj = 0; bj < 2; ++bj) {
                    const int col = colb + bj * 128;
                    const u32x4 gb = *(const u32x4*)(PROJ + (size_t)row * INW + C_GB + col);
                    f32x4 b0 = {bflo(gb.x), bfhi(gb.x), bflo(gb.y), bfhi(gb.y)}, b1 = {bflo(gb.z), bfhi(gb.z), bflo(gb.w), bfhi(gb.w)};
                    if (u.aux == 0) {
                        const u32x4 ga = *(const u32x4*)(PROJ + (size_t)row * INW + C_GA + col);
                        f32x4 a0 = {bflo(ga.x), bfhi(ga.x), bflo(ga.y), bfhi(ga.y)}, a1 = {bflo(ga.z), bfhi(ga.z), bflo(ga.w), bfhi(ga.w)};
#pragma unroll
                        for (int j = 0; j < 4; ++j) { acc[ai][bj][m][0][j] *= a0[j] / b0[j]; acc[ai][bj][m][1][j] *= a1[j] / b1[j]; }
                    } else {
                        const f32x4 v0 = acc[ai][bj][m][0] * b0, v1 = acc[ai][bj][m][1] * b1;
                        u32x4 w; w.x = pg8::cvt_pk_bf16(v0[0], v0[1]); w.y = pg8::cvt_pk_bf16(v0[2], v0[3]); w.z = pg8::cvt_pk_bf16(v1[0], v1[1]); w.w = pg8::cvt_pk_bf16(v1[2], v1[3]);
                        st_wt16(MIXED + (size_t)row * D + col, w);
                    }
                }
            }
    }
};
struct EpiOutproj {
    static constexpr bool PERM = true;
    const float* x; const float* MOD; bf16_t* X1;
    __device__ __forceinline__ bool keep(const pg8::Unit&) const { return false; }
    __device__ __forceinline__ void operator()(f32x4 (&acc)[2][2][4][2], const pg8::Unit& u, int wr, int wc, int fr, int fq) const {
        const int row0 = u.pm * 256 + wr * 64 + fr, colb = u.pn * 256 + wc * 32 + 8 * fq;
        const int b = (u.pm * 256) / SEQ;
#pragma unroll
        for (int bj = 0; bj < 2; ++bj) {
            const int col = colb + bj * 128;
            const f32x4 g0 = *(const f32x4*)(MOD + b * 6144 + 2048 + col), g1 = *(const f32x4*)(MOD + b * 6144 + 2048 + col + 4);
#pragma unroll
            for (int ai = 0; ai < 2; ++ai)
#pragma unroll
                for (int m = 0; m < 4; ++m) { const size_t off = (size_t)(row0 + ai * 128 + m * 16) * D + col;
                    const f32x4 v0 = *(const f32x4*)(x + off) + g0 * acc[ai][bj][m][0], v1 = *(const f32x4*)(x + off + 4) + g1 * acc[ai][bj][m][1];
                    u32x4 w; w.x = pg8::cvt_pk_bf16(v0[0], v0[1]); w.y = pg8::cvt_pk_bf16(v0[2], v0[3]); w.z = pg8::cvt_pk_bf16(v1[0], v1[1]); w.w = pg8::cvt_pk_bf16(v1[2], v1[3]);
                    st_wt16(X1 + off, w); }
        }
    }
};
struct EpiRouter {
    static constexpr bool PERM = false;
    float* LOGITS4;
    __device__ __forceinline__ bool keep(const pg8::Unit&) const { return false; }
    __device__ __forceinline__ void operator()(f32x4 (&acc)[2][2][4][2], const pg8::Unit& u, int wr, int wc, int fr, int fq) const {
        const int row0 = u.pm * 256 + wr * 64 + fr, colb = wc * 32 + 4 * fq;
        float* base = LOGITS4 + (size_t)u.aux * T * 256;
#pragma unroll
        for (int ai = 0; ai < 2; ++ai)
#pragma unroll
            for (int m = 0; m < 4; ++m)
#pragma unroll
                for (int bj = 0; bj < 2; ++bj) {
                    const bool lo8 = fr < 8;
                    const f32x4 mine0 = acc[ai][bj][m][0], mine1 = acc[ai][bj][m][1], give = lo8 ? mine1 : mine0; f32x4 got;
#pragma unroll
                    for (int j = 0; j < 4; ++j) got[j] = __shfl_xor(give[j], 8);
                    float* rowp = base + (size_t)(row0 + ai * 128 + m * 16) * 256 + colb + bj * 128;
                    st_wt16(lo8 ? rowp : rowp - 8 * 256 + 16, __builtin_bit_cast(u32x4, lo8 ? mine0 : got));
                    st_wt16(lo8 ? rowp + 8 * 256 : rowp + 16, __builtin_bit_cast(u32x4, lo8 ? got : mine1)); }
    }
};
struct RouterSched {
    static constexpr bool HALFSKIP = false;
    const char* A; const char* Bt; int G, c;
    __device__ __forceinline__ bool next(int i, pg8::Unit& u) const {
        const int L = i * G + c; if (L >= 256) return false;
        const int pm = L >> 2, ks = L & 3;
        u.a = A + (size_t)pm * 256 * 2048 + ks * 512; u.b = Bt + ks * 512; u.rows = nullptr; u.pm = pm; u.pn = 0; u.aux = ks; u.nvalid = 256; return true;
    }
};
struct EpiGU {
    static constexpr bool PERM = true;
    unsigned char* ACT;
    __device__ __forceinline__ bool keep(const pg8::Unit&) const { return false; }
    __device__ __forceinline__ void operator()(f32x4 (&acc)[2][2][4][2], const pg8::Unit& u, int wr, int wc, int fr, int fq) const {
        const int rl0 = wr * 64 + fr, col = u.pn * 128 + wc * 32 + 8 * fq;
        constexpr float is = 1.0f / WGU_SCALE;
#pragma unroll
        for (int ai = 0; ai < 2; ++ai)
#pragma unroll
            for (int m = 0; m < 4; ++m) {
                const int rl = rl0 + ai * 128 + m * 16;
                f32x4 v0, v1;
#pragma unroll
                for (int j = 0; j < 4; ++j) { const float a0 = acc[ai][0][m][0][j] * is, a1 = acc[ai][0][m][1][j] * is;
                    v0[j] = a0 * sigmoidf_(a0) * (acc[ai][1][m][0][j] * is); v1[j] = a1 * sigmoidf_(a1) * (acc[ai][1][m][1][j] * is); }
                *(u32x2*)(ACT + ((size_t)u.pm * 256 + rl) * EFF + col) = (u32x2){pk4_fp8(v0[0], v0[1], v0[2], v0[3]), pk4_fp8(v1[0], v1[1], v1[2], v1[3])};
                asm volatile("" ::: "memory");
            }
    }
};
struct EpiDown {
    static constexpr bool PERM = true;
    unsigned char* YBUF; const float* GATEW;
    __device__ __forceinline__ bool keep(const pg8::Unit&) const { return false; }
    __device__ __forceinline__ void operator()(f32x4 (&acc)[2][2][4][2], const pg8::Unit& u, int wr, int wc, int fr, int fq) const {
        const int rl0 = wr * 64 + fr, colb = u.pn * 256 + wc * 32 + 8 * fq;
#pragma unroll
        for (int ai = 0; ai < 2; ++ai)
#pragma unroll
            for (int m = 0; m < 4; ++m) {
                const int rl = rl0 + ai * 128 + m * 16;
                if (rl < u.nvalid) {
                    const int slot = u.rows[rl]; const float gw = GATEW[slot] * (YSCALE / WD_SCALE);
#pragma unroll
                    for (int bj = 0; bj < 2; ++bj) { const f32x4 v0 = acc[ai][bj][m][0] * gw, v1 = acc[ai][bj][m][1] * gw;
                        *(u32x2*)(YBUF + (size_t)slot * D + colb + bj * 128) = (u32x2){pk4_fp8(v0[0], v0[1], v0[2], v0[3]), pk4_fp8(v1[0], v1[1], v1[2], v1[3])}; }
                }
                asm volatile("" ::: "memory");
            }
    }
};

#define MFMA16(a, b, c) __builtin_amdgcn_mfma_f32_16x16x32_bf16((a), (b), (c), 0, 0, 0)
#define MFMA32(a, b, c) __builtin_amdgcn_mfma_f32_32x32x16_bf16((a), (b), (c), 0, 0, 0)
__device__ __forceinline__ s16x4 tr16(const LAS unsigned char* p) { return __builtin_amdgcn_ds_read_tr16_b64_v4i16((LAS s16x4*)p); }
__device__ __forceinline__ bf16x8 cat8(s16x4 a, s16x4 b) { bf16x8 r; r[0] = a[0]; r[1] = a[1]; r[2] = a[2]; r[3] = a[3]; r[4] = b[0]; r[5] = b[1]; r[6] = b[2]; r[7] = b[3]; return r; }
__device__ __forceinline__ u32x4 pack8(const float (&v)[8]) { u32x4 w; w.x = pg8::cvt_pk_bf16(v[0], v[1]); w.y = pg8::cvt_pk_bf16(v[2], v[3]); w.z = pg8::cvt_pk_bf16(v[4], v[5]); w.w = pg8::cvt_pk_bf16(v[6], v[7]); return w; }
__device__ __forceinline__ void unpack8(u32x4 w, float (&v)[8]) { v[0] = bflo(w.x); v[1] = bfhi(w.x); v[2] = bflo(w.y); v[3] = bfhi(w.y); v[4] = bflo(w.z); v[5] = bfhi(w.z); v[6] = bflo(w.w); v[7] = bfhi(w.w); }
__device__ __forceinline__ int swzA(int row) { return (row & 3) | (((row >> 3) & 1) << 2); }
__device__ __forceinline__ void hgrn_kv_unit(Ctx& X, int bn) {
    const int t0 = bn * 64;
    const bf16_t* PROJ = WSP(bf16_t, WS_PROJ); const float* BC = WSP(float, WS_LOGF);
#pragma unroll 2
    for (int j = 0; j < 8; ++j) {
        const int p = X.tid + NTHREADS * j, row = p >> 6, c64 = p & 63, h = c64 >> 4, ch = c64 & 15;
        const size_t prow = (size_t)(t0 + row) * INW + h * 128 + 8 * ch;
        const u32x4 kraw = *(const u32x4*)(PROJ + prow + C_HK), vraw = *(const u32x4*)(PROJ + prow + C_HV);
        const float* bp = BC + (size_t)(t0 + row) * 512 + h * 128 + 8 * ch; const float* bl = BC + (size_t)(t0 + 63) * 512 + h * 128 + 8 * ch;
        const f32x4 b0 = *(const f32x4*)bp, b1 = *(const f32x4*)(bp + 4), l0 = *(const f32x4*)bl, l1 = *(const f32x4*)(bl + 4);
        float kv[8]; unpack8(kraw, kv);
#pragma unroll
        for (int e = 0; e < 4; ++e) { kv[e] *= __expf(l0[e] - b0[e]); kv[4 + e] *= __expf(l1[e] - b1[e]); }
        const int off = row * 256 + (((ch >> 1) ^ swzA(row)) * 32) + (ch & 1) * 16;
        *(LAS u32x4*)(X.lds + h * 32768 + off) = vraw; *(LAS u32x4*)(X.lds + h * 32768 + 16384 + off) = pack8(kv);
    }
    WSP(float, WS_DECAY)[bn * 512 + X.tid] = __expf(BC[(size_t)(t0 + 63) * 512 + X.tid]);
    __syncthreads();
    const int l = X.lane, w = X.wave, fr = l & 15, fq = l >> 4, r = fr >> 2, p4 = l & 3, h = w >> 1, vt0 = 4 * (w & 1);
    const LAS unsigned char* VI = X.lds + h * 32768; const LAS unsigned char* KI = VI + 16384;
    bf16x8 af[4][2];
#pragma unroll
    for (int vt = 0; vt < 4; ++vt)
#pragma unroll
        for (int kk = 0; kk < 2; ++kk) { const int r0 = 32 * kk + 8 * fq + r, r1 = r0 + 4;
            af[vt][kk] = cat8(tr16(VI + r0 * 256 + (((vt0 + vt) ^ swzA(r0)) * 32) + p4 * 8), tr16(VI + r1 * 256 + (((vt0 + vt) ^ swzA(r1)) * 32) + p4 * 8)); }
    bf16_t* KVT = WSP(bf16_t, WS_KVT) + (size_t)(bn * 4 + h) * 16384;
#pragma unroll 2
    for (int ct = 0; ct < 8; ++ct) {
        bf16x8 bfr[2];
#pragma unroll
        for (int kk = 0; kk < 2; ++kk) { const int r0 = 32 * kk + 8 * fq + r, r1 = r0 + 4;
            bfr[kk] = cat8(tr16(KI + r0 * 256 + ((ct ^ swzA(r0)) * 32) + p4 * 8), tr16(KI + r1 * 256 + ((ct ^ swzA(r1)) * 32) + p4 * 8)); }
#pragma unroll
        for (int vt = 0; vt < 4; ++vt) { f32x4 acc = {0.f, 0.f, 0.f, 0.f}; acc = MFMA16(bfr[0], af[vt][0], acc); acc = MFMA16(bfr[1], af[vt][1], acc);
            u32x2 wv; wv.x = pg8::cvt_pk_bf16(acc[0], acc[1]); wv.y = pg8::cvt_pk_bf16(acc[2], acc[3]);
            *(u32x2*)(KVT + (16 * (vt0 + vt) + fr) * 128 + 16 * ct + 4 * fq) = wv; }
    }
    __syncthreads();
}
__device__ __forceinline__ void hgrn_passB(Ctx& X) {
    const unsigned* KVT = WSP(unsigned, WS_KVT); const float* DECAY = WSP(float, WS_DECAY); unsigned* SPT = WSP(unsigned, WS_SPT);
    const int gt = X.wg * NTHREADS + X.tid, NGT = X.G * NTHREADS;
    for (int item = gt; item < 16 * 128 * 64; item += NGT) {
        const int bh = item >> 13, rem = item & 8191, vd = rem >> 6, c = (rem & 63) * 2, b = bh >> 2, h = bh & 3;
        float s0 = 0.f, s1 = 0.f;
#pragma unroll 8
        for (int n = 0; n < 64; ++n) {
            const int unit = (b * 64 + n) * 4 + h;
            const unsigned kw = KVT[((size_t)unit * 16384 + vd * 128 + c) >> 1]; const f32x2 kv = {bflo(kw), bfhi(kw)};
            const f32x2 dc = *(const f32x2*)(DECAY + unit * 128 + c);
            SPT[((size_t)unit * 16384 + vd * 128 + c) >> 1] = pk2(s0, s1);
            s0 = dc.x * s0 + kv.x; s1 = dc.y * s1 + kv.y;
        }
    }
}
__device__ __forceinline__ void hgrn_out_unit(Ctx& X, int u2) {
    const int bn = u2 >> 1, hp = u2 & 1, t0 = bn * 64;
    const bf16_t* PROJ = WSP(bf16_t, WS_PROJ); const float* BCg = WSP(float, WS_LOGF);
#pragma unroll 2
    for (int j = 0; j < 4; ++j) { const int p = X.tid + NTHREADS * j, row = p >> 5, c32 = p & 31, hh = c32 >> 4, ch = c32 & 15, h = 2 * hp + hh;
        const size_t prow = (size_t)(t0 + row) * INW + h * 128 + 8 * ch;
        const u32x4 qraw = *(const u32x4*)(PROJ + prow + C_HQ), kraw = *(const u32x4*)(PROJ + prow + C_HK), vraw = *(const u32x4*)(PROJ + prow + C_HV);
        const float* bp = BCg + (size_t)(t0 + row) * 512 + h * 128 + 8 * ch; const float* br = BCg + (size_t)(t0 + 32) * 512 + h * 128 + 8 * ch;
        const f32x4 b0 = *(const f32x4*)bp, b1 = *(const f32x4*)(bp + 4), r0 = *(const f32x4*)br, r1 = *(const f32x4*)(br + 4);
        float qv[8], kv[8], a[8], bq[8]; unpack8(qraw, qv); unpack8(kraw, kv);
#pragma unroll
        for (int e = 0; e < 4; ++e) { const float e0 = __expf(b0[e] - r0[e]), e1 = __expf(b1[e] - r1[e]);
            a[e] = qv[e] * e0; a[4 + e] = qv[4 + e] * e1; kv[e] *= __builtin_amdgcn_rcpf(e0); kv[4 + e] *= __builtin_amdgcn_rcpf(e1);
            bq[e] = qv[e] * __expf(b0[e]); bq[4 + e] = qv[4 + e] * __expf(b1[e]); }
        LAS unsigned char* hb = X.lds + hh * 65536; const int o16 = row * 256 + ((ch ^ (row & 15)) * 16);
        *(LAS u32x4*)(hb + o16) = pack8(a); *(LAS u32x4*)(hb + 16384 + o16) = pack8(kv); *(LAS u32x4*)(hb + 32768 + o16) = pack8(bq);
        *(LAS u32x4*)(hb + 49152 + row * 256 + (((ch >> 1) ^ (row & 7)) * 32) + (ch & 1) * 16) = vraw; }
    const int l = X.lane, w = X.wave, fr = l & 15, fq = l >> 4, r = fr >> 2, p4 = l & 3, hh = w >> 2, h = 2 * hp + hh, ti = w & 3;
    const int tq = 16 * ti + fr;
    const bf16_t* SPT = WSP(bf16_t, WS_SPT) + (size_t)(bn * 4 + h) * 16384;
    __syncthreads();
    const LAS unsigned char* QSI = X.lds + hh * 65536; const LAS unsigned char* KSI = QSI + 16384; const LAS unsigned char* QNI = QSI + 32768; const LAS unsigned char* VI = QSI + 49152;
    bf16x8 QS[4];
#pragma unroll
    for (int ks = 0; ks < 4; ++ks) QS[ks] = *(const LAS bf16x8*)(QSI + tq * 256 + (((4 * ks + fq) ^ (tq & 15)) * 16));
    f32x4 ST[4];
#pragma unroll
    for (int si = 0; si < 4; ++si) {
        f32x4 acc = {0.f, 0.f, 0.f, 0.f};
        if (si <= ti) {
            const int sr = 16 * si + fr;
#pragma unroll
            for (int ks = 0; ks < 4; ++ks) { const bf16x8 kf = *(const LAS bf16x8*)(KSI + sr * 256 + (((4 * ks + fq) ^ (sr & 15)) * 16)); acc = MFMA16(kf, QS[ks], acc); }
            if (si == ti) {
#pragma unroll
                for (int q = 0; q < 4; ++q) acc[q] = (4 * fq + q <= fr) ? acc[q] : 0.f; }
        }
        ST[si] = acc;
    }
    f32x4 o[8];
#pragma unroll
    for (int vt = 0; vt < 8; ++vt) o[vt] = (f32x4){0.f, 0.f, 0.f, 0.f};
#pragma unroll
    for (int kk = 0; kk < 2; ++kk) {
        if (2 * kk <= ti) {
            float pv[8];
#pragma unroll
            for (int q = 0; q < 4; ++q) { pv[q] = ST[2 * kk][q]; pv[4 + q] = ST[2 * kk + 1][q]; }
            const bf16x8 pf = __builtin_bit_cast(bf16x8, pack8(pv));
            const int r0 = 32 * kk + 4 * fq + r, r1 = r0 + 16;
#pragma unroll
            for (int vt = 0; vt < 8; ++vt) { const bf16x8 va = cat8(tr16(VI + r0 * 256 + ((vt ^ (r0 & 7)) * 32) + p4 * 8), tr16(VI + r1 * 256 + ((vt ^ (r1 & 7)) * 32) + p4 * 8));
                o[vt] = MFMA16(va, pf, o[vt]); }
        }
    }
#pragma unroll
    for (int ks = 0; ks < 4; ++ks) { const bf16x8 qn = *(const LAS bf16x8*)(QNI + tq * 256 + (((4 * ks + fq) ^ (tq & 15)) * 16));
#pragma unroll
        for (int vt = 0; vt < 8; ++vt) { const bf16x8 sa = *(const bf16x8*)(SPT + (16 * vt + fr) * 128 + 32 * ks + 8 * fq); o[vt] = MFMA16(sa, qn, o[vt]); } }
    float ss = 0.f;
#pragma unroll
    for (int vt = 0; vt < 8; ++vt) ss += (o[vt][0] * o[vt][0] + o[vt][1] * o[vt][1]) + (o[vt][2] * o[vt][2] + o[vt][3] * o[vt][3]);
    ss += __shfl_xor(ss, 16); ss += __shfl_xor(ss, 32);
    const float rstd = rsqrtf(ss * (1.f / 128.f) + EPS);
    bf16_t* YCAT = WSP(bf16_t, WS_YCAT);
#pragma unroll
    for (int vt = 0; vt < 8; ++vt) { const int vd = 16 * vt + 4 * fq;
        const u32x2 sg = *(const u32x2*)(PROJ + (size_t)(t0 + tq) * INW + C_HG + h * 128 + vd); const f32x4 gn = *(const f32x4*)(X.g_hgrn + h * 128 + vd);
        u32x2 wv; wv.x = pg8::cvt_pk_bf16(o[vt][0] * rstd * gn[0] * bflo(sg.x), o[vt][1] * rstd * gn[1] * bfhi(sg.x)); wv.y = pg8::cvt_pk_bf16(o[vt][2] * rstd * gn[2] * bflo(sg.y), o[vt][3] * rstd * gn[3] * bfhi(sg.y));
        *(u32x2*)(YCAT + (size_t)(t0 + tq) * D + h * 128 + vd) = wv; }
    __syncthreads();
}

struct AttnRegs { u32x4 k[6], v[6]; bf16x8 q[4]; };
__device__ __forceinline__ void attn_load(Ctx& X, int unit, AttnRegs& R) {
    const int u16 = unit & 15, h = (unit >> 4) & 7, g = (unit >> 7) % 3, b = unit / 384;
    const int d = g == 0 ? 1 : g == 1 ? 4 : 16, nblk = 16 / d, r = u16 / nblk, blk = u16 % nblk;
    const int qcol = C_AQ + g * 512 + h * 64, kcol = C_AK + g * 512 + h * 64, vcol = C_AV + g * 512 + h * 64;
    const int mk0 = blk * 256 - 128;
    const bf16_t* PROJ = WSP(bf16_t, WS_PROJ);
#pragma unroll
    for (int j = 0; j < 6; ++j) { const int idx = X.tid + NTHREADS * j, row = idx >> 3, ch = idx & 7, m = mk0 + row;
        R.k[j] = (u32x4){0u, 0u, 0u, 0u}; R.v[j] = (u32x4){0u, 0u, 0u, 0u};
        if (m >= 0) { const size_t tok = (size_t)b * SEQ + (size_t)m * d + r; R.k[j] = *(const u32x4*)(PROJ + tok * INW + kcol + ch * 8); R.v[j] = *(const u32x4*)(PROJ + tok * INW + vcol + ch * 8); } }
    const int l = X.lane, w = X.wave, q = l & 31, hi = l >> 5;
    const size_t tokq = (size_t)b * SEQ + (size_t)(blk * 256 + 32 * w + q) * d + r;
#pragma unroll
    for (int ds = 0; ds < 4; ++ds) R.q[ds] = *(const bf16x8*)(PROJ + tokq * INW + qcol + ds * 16 + hi * 8);
}
__device__ __forceinline__ void attn_stage(Ctx& X, const AttnRegs& R) {
    LAS unsigned char* KL = X.lds; LAS unsigned char* VL = X.lds + 55296;
#pragma unroll
    for (int j = 0; j < 6; ++j) { const int idx = X.tid + NTHREADS * j, row = idx >> 3, ch = idx & 7;
        *(LAS u32x4*)(KL + row * 144 + ch * 16) = R.k[j]; *(LAS u32x4*)(VL + row * 128 + ch * 16) = R.v[j]; }
}
__device__ __forceinline__ void attn_compute(Ctx& X, int unit, const bf16x8 (&qf)[4]) {
    const int u16 = unit & 15, h = (unit >> 4) & 7, g = (unit >> 7) % 3, b = unit / 384;
    const int d = g == 0 ? 1 : g == 1 ? 4 : 16, nblk = 16 / d, r = u16 / nblk, blk = u16 % nblk;
    const int mk0 = blk * 256 - 128;
    LAS unsigned char* KL = X.lds; LAS unsigned char* VL = X.lds + 55296;
    const int l = X.lane, w = X.wave, q = l & 31, hi = l >> 5;
    const size_t tokq = (size_t)b * SEQ + (size_t)(blk * 256 + 32 * w + q) * d + r;
    f32x16 s[5];
#pragma unroll
    for (int kt = 0; kt < 5; ++kt) {
        f32x16 acc;
#pragma unroll
        for (int i = 0; i < 16; ++i) acc[i] = 0.f;
#pragma unroll
        for (int ds = 0; ds < 4; ++ds) { const bf16x8 kf = *(const LAS bf16x8*)(KL + (32 * w + 32 * kt + q) * 144 + ds * 32 + hi * 16); acc = MFMA32(kf, qf[ds], acc); }
        s[kt] = acc;
    }
    const int iq = 32 * w + q;
    const int jmin = iq > -mk0 ? iq : -mk0; const unsigned jspan = (unsigned)(iq + 128 - jmin);
    float mx = -INFINITY;
#pragma unroll
    for (int kt = 0; kt < 5; ++kt)
#pragma unroll
        for (int rg = 0; rg < 16; ++rg) { const int j = 32 * w + 32 * kt + (rg & 3) + 8 * (rg >> 2) + 4 * hi;
            const bool valid = (unsigned)(j - jmin) <= jspan;
            s[kt][rg] = valid ? s[kt][rg] : -INFINITY; mx = fmaxf(mx, s[kt][rg]); if ((rg & 3) == 3) __builtin_amdgcn_sched_barrier(0); }
    mx = fmaxf(mx, __shfl_xor(mx, 32));
    const float c2 = 0.125f * 1.4426950408889634f;
    float lsum = 0.f;
#pragma unroll
    for (int kt = 0; kt < 5; ++kt)
#pragma unroll
        for (int rg = 0; rg < 16; ++rg) { const float p = exp2f((s[kt][rg] - mx) * c2); s[kt][rg] = p; lsum += p; }
    lsum += __shfl_xor(lsum, 32);
    f32x16 o[2];
#pragma unroll
    for (int dt = 0; dt < 2; ++dt)
#pragma unroll
        for (int i = 0; i < 16; ++i) o[dt][i] = 0.f;
    const int vlane = ((l & 15) >> 2) * 128 + (((l >> 4) & 1) * 16 + (l & 3) * 4) * 2;
#pragma unroll
    for (int kt = 0; kt < 5; ++kt)
#pragma unroll
        for (int s2 = 0; s2 < 2; ++s2) {
            bf16x8 pb;
#pragma unroll
            for (int j = 0; j < 8; j += 2) { const unsigned pw = pg8::cvt_pk_bf16(s[kt][8 * s2 + j], s[kt][8 * s2 + j + 1]); pb[j] = (short)(pw & 0xffffu); pb[j + 1] = (short)(pw >> 16); }
            const int key0 = 32 * w + 32 * kt + 16 * s2 + 4 * hi;
#pragma unroll
            for (int dt = 0; dt < 2; ++dt) {
                LAS unsigned char* vp = VL + key0 * 128 + dt * 64 + vlane;
                const s16x4 t0 = __builtin_amdgcn_ds_read_tr16_b64_v4i16((LAS s16x4*)vp);
                const s16x4 t1 = __builtin_amdgcn_ds_read_tr16_b64_v4i16((LAS s16x4*)(vp + 8 * 128));
                bf16x8 va; va[0] = t0[0]; va[1] = t0[1]; va[2] = t0[2]; va[3] = t0[3]; va[4] = t1[0]; va[5] = t1[1]; va[6] = t1[2]; va[7] = t1[3];
                o[dt] = MFMA32(va, pb, o[dt]);
            }
        }
    const float inv = 1.0f / lsum;
    bf16_t* OG = WSP(bf16_t, WS_OG) + (size_t)g * T * 512;
#pragma unroll
    for (int dt = 0; dt < 2; ++dt)
#pragma unroll
        for (int rg = 0; rg < 4; ++rg) { const int d0 = 32 * dt + 8 * rg + 4 * hi;
            u32x2 wv; wv.x = pg8::cvt_pk_bf16(o[dt][4 * rg] * inv, o[dt][4 * rg + 1] * inv); wv.y = pg8::cvt_pk_bf16(o[dt][4 * rg + 2] * inv, o[dt][4 * rg + 3] * inv);
            *(u32x2*)(OG + tokq * 512 + h * 64 + d0) = wv; }
    if (hi == 0) WSP(float, WS_LSE)[((size_t)g * T + tokq) * 8 + h] = mx * 0.125f + __logf(lsum);
}
__device__ __forceinline__ void attn_combine(Ctx& X) {
    const bf16_t* OG = WSP(bf16_t, WS_OG); const float* LSE = WSP(float, WS_LSE); bf16_t* YCAT = WSP(bf16_t, WS_YCAT);
    const int gt = X.wg * NTHREADS + X.tid, NGT = X.G * NTHREADS;
    for (int item = gt; item < T * 64; item += NGT) {
        const int t = item >> 6, ch = item & 63, h = ch >> 3;
        const float l0 = LSE[(size_t)t * 8 + h], l1 = LSE[((size_t)T + t) * 8 + h], l2 = LSE[((size_t)2 * T + t) * 8 + h];
        const float m = fmaxf(l0, fmaxf(l1, l2)); float w0 = __expf(l0 - m), w1 = __expf(l1 - m), w2 = __expf(l2 - m); const float inv = 1.f / (w0 + w1 + w2); w0 *= inv; w1 *= inv; w2 *= inv;
        const u32x4 a = *(const u32x4*)(OG + (size_t)t * 512 + ch * 8), bq = *(const u32x4*)(OG + ((size_t)T + t) * 512 + ch * 8), cq = *(const u32x4*)(OG + ((size_t)2 * T + t) * 512 + ch * 8);
        u32x4 o;
#pragma unroll
        for (int j = 0; j < 4; ++j) o[j] = pk2(w0 * bflo(a[j]) + w1 * bflo(bq[j]) + w2 * bflo(cq[j]), w0 * bfhi(a[j]) + w1 * bfhi(bq[j]) + w2 * bfhi(cq[j]));
        *(u32x4*)(YCAT + (size_t)t * D + 512 + ch * 8) = o;
    }
}

__device__ __forceinline__ unsigned sortable_key(float f) { const unsigned u = __builtin_bit_cast(unsigned, f); return (u & 0x80000000u) ? ~u : (u | 0x80000000u); }
__device__ __forceinline__ void moe_route(Ctx& X, bool local) {
    const float* LG = WSP(float, WS_KVT); unsigned* CNT = WSP(unsigned, WS_CTL) + CW_CNT; int* LISTS = WSP(int, WS_LISTS); float* GATEW = WSP(float, WS_GATEW);
    const int gw = X.wg * NWAVES + X.wave, NGW = X.G * NWAVES, l = X.lane, grp = l >> 3;
    const f32x4 bias = *(const f32x4*)(X.rbias + 4 * l);
    const unsigned long long ltmask = (1ull << l) - 1ull;
    const int tbeg = local ? X.wg * 64 + X.wave : gw, tend = local ? X.wg * 64 + 64 : T, tstep = local ? NWAVES : NGW;
    for (int t = tbeg; t < tend; t += tstep) {
        f32x4 lg = *(const f32x4*)(LG + (size_t)t * 256 + 4 * l);
#pragma unroll
        for (int ks = 1; ks < 4; ++ks) lg += *(const f32x4*)(LG + ((size_t)ks * T + t) * 256 + 4 * l);
        float sc[4], mb[4];
#pragma unroll
        for (int i = 0; i < 4; ++i) { sc[i] = sigmoidf_(lg[i]); mb[i] = sc[i] + bias[i]; }
        float m1 = fmaxf(mb[0], mb[1]), m2 = fminf(mb[0], mb[1]);
        { const float a1 = fmaxf(mb[2], mb[3]), a2 = fminf(mb[2], mb[3]); const float n1 = fmaxf(m1, a1), n2 = fmaxf(fminf(m1, a1), fmaxf(m2, a2)); m1 = n1; m2 = n2; }
#pragma unroll
        for (int o = 1; o < 8; o <<= 1) { const float a1 = __shfl_xor(m1, o), a2 = __shfl_xor(m2, o); const float n1 = fmaxf(m1, a1), n2 = fmaxf(fminf(m1, a1), fmaxf(m2, a2)); m1 = n1; m2 = n2; }
        const float gs = m1 + m2;
        int rank = 0;
#pragma unroll
        for (int gg = 0; gg < 8; ++gg) { const float og = __builtin_bit_cast(float, __builtin_amdgcn_readlane(__builtin_bit_cast(int, gs), gg * 8)); rank += (og > gs || (og == gs && gg < grp)) ? 1 : 0; }
        const bool sel = rank < 4;
        unsigned key[4];
#pragma unroll
        for (int i = 0; i < 4; ++i) key[i] = sel ? sortable_key(mb[i]) : 0u;
        unsigned pre = 0u;
#pragma unroll 1
        for (int bit = 31; bit >= 0; --bit) { const unsigned cand = pre | (1u << bit);
            const int cnt = __popcll(__ballot(key[0] >= cand)) + __popcll(__ballot(key[1] >= cand)) + __popcll(__ballot(key[2] >= cand)) + __popcll(__ballot(key[3] >= cand));
            if (cnt >= TOPK) pre = cand; }
        int ngt = 0, eqb = 0, tkb = 0; bool take[4];
#pragma unroll
        for (int i = 0; i < 4; ++i) ngt += __popcll(__ballot(key[i] > pre));
        const int need = TOPK - ngt;
#pragma unroll
        for (int i = 0; i < 4; ++i) eqb += __popcll(__ballot(key[i] == pre) & ltmask);
        int eqrun = eqb;
#pragma unroll
        for (int i = 0; i < 4; ++i) { const bool eq = key[i] == pre; take[i] = (key[i] > pre) || (eq && eqrun < need); eqrun += eq ? 1 : 0; }
#pragma unroll
        for (int i = 0; i < 4; ++i) tkb += __popcll(__ballot(take[i]) & ltmask);
        float part = 0.f;
#pragma unroll
        for (int i = 0; i < 4; ++i) part += take[i] ? sc[i] : 0.f;
        const float scale = 2.5f / wave_sum(part);
        int slot = tkb;
#pragma unroll
        for (int i = 0; i < 4; ++i) if (take[i]) { const int e = 4 * l + i; const unsigned pos = atomicAdd(&CNT[e * 64], 1u); LISTS[(size_t)e * 16384 + pos] = t * NSLOT + slot; GATEW[t * NSLOT + slot] = sc[i] * scale; ++slot; }
        if (l == 0) { LISTS[(size_t)NE * 16384 + t] = t * NSLOT + TOPK; GATEW[t * NSLOT + TOPK] = 1.0f; }
    }
}
__device__ __forceinline__ int moe_table(Ctx& X) {
    LAS int* tbl = (LAS int*)(X.lds + TBL_OFF); LAS int* cnts = (LAS int*)(X.lds + TCNT_OFF); LAS int* pref = cnts + 320;
    const unsigned* CNT = WSP(unsigned, WS_CTL) + CW_CNT;
    const int x = X.wg & 7;
    if (X.tid < NEX) cnts[X.tid] = X.tid < NE ? (int)__hip_atomic_load(CNT + X.tid * 64, __ATOMIC_RELAXED, __HIP_MEMORY_SCOPE_AGENT) : T;
    __syncthreads();
    if (X.tid < NEX) { int pre = 0; for (int e = 0; e < X.tid; ++e) pre += (cnts[e] + 255) >> 8; pref[X.tid] = pre; }
    __syncthreads();
    if (X.tid < 33) {
        const int i = X.tid; int lp = 0; for (int k = 0; k < i && k < 32; ++k) lp += (cnts[x + 8 * k] + 255) >> 8;
        if (i < 32) { const int e = x + 8 * i, n = (cnts[e] + 255) >> 8, p0 = pref[e]; for (int r = 0; r < n; ++r) tbl[lp + r] = ((p0 + r) << 16) | (e << 7) | r; }
        else { const int p0 = pref[NE]; for (int r8 = 0; r8 < 8; ++r8) { const int r = 8 * x + r8; tbl[lp + r8] = ((p0 + r) << 16) | (NE << 7) | r; } cnts[600] = lp + 8; }
    }
    __syncthreads();
    return __builtin_amdgcn_readfirstlane(cnts[600]);
}
__device__ __forceinline__ void final_rows(Ctx& X) {
    const bf16_t* X1 = WSP(bf16_t, WS_X1); const float* MOD = WSP(float, WS_MOD); const unsigned char* YBUF = WSP(unsigned char, WS_YBUF);
    const int gw = X.wg * NWAVES + X.wave, NGW = X.G * NWAVES, l = X.lane;
    for (int t = gw; t < T; t += NGW) {
        const int b = t / SEQ; f32x4 v[2][2]; float s = 0.f;
#pragma unroll
        for (int j = 0; j < 2; ++j) { const int col = 8 * l + 512 * j; f32x4 m0 = {0.f, 0.f, 0.f, 0.f}, m1 = {0.f, 0.f, 0.f, 0.f};
#pragma unroll
            for (int k = 0; k < NSLOT; ++k) { const u32x2 y = *(const u32x2*)(YBUF + ((size_t)t * NSLOT + k) * D + col);
                const f32x2 a = __builtin_amdgcn_cvt_pk_f32_fp8((int)y.x, false), bq = __builtin_amdgcn_cvt_pk_f32_fp8((int)y.x, true), c = __builtin_amdgcn_cvt_pk_f32_fp8((int)y.y, false), d = __builtin_amdgcn_cvt_pk_f32_fp8((int)y.y, true);
                m0.x += a[0]; m0.y += a[1]; m0.z += bq[0]; m0.w += bq[1]; m1.x += c[0]; m1.y += c[1]; m1.z += d[0]; m1.w += d[1]; }
            const f32x4 g0 = *(const f32x4*)(MOD + b * 6144 + 5120 + col) * (1.0f / YSCALE), g1 = *(const f32x4*)(MOD + b * 6144 + 5120 + col + 4) * (1.0f / YSCALE);
            const u32x4 xw = *(const u32x4*)(X1 + (size_t)t * D + col); const f32x4 x0 = {bflo(xw.x), bfhi(xw.x), bflo(xw.y), bfhi(xw.y)}, x1 = {bflo(xw.z), bfhi(xw.z), bflo(xw.w), bfhi(xw.w)};
            v[j][0] = x0 + g0 * m0; v[j][1] = x1 + g1 * m1;
#pragma unroll
            for (int q = 0; q < 2; ++q) s += (v[j][q].x * v[j][q].x + v[j][q].y * v[j][q].y) + (v[j][q].z * v[j][q].z + v[j][q].w * v[j][q].w); }
        const float rstd = rsqrtf(wave_sum(s) * (1.f / D) + EPS);
#pragma unroll
        for (int j = 0; j < 2; ++j) { const int col = 8 * l + 512 * j;
            *(f32x4*)(X.out + (size_t)t * D + col) = v[j][0] * rstd * *(const f32x4*)(X.g_final + col); *(f32x4*)(X.out + (size_t)t * D + col + 4) = v[j][1] * rstd * *(const f32x4*)(X.g_final + col + 4); }
    }
}

__device__ __forceinline__ unsigned* panel_word(Ctx& X, int bank, int pm) { return WSP(unsigned, WS_CTL) + CW_PANEL + (bank * 64 + pm) * 64; }
__device__ __forceinline__ void panel_signal(Ctx& X, int bank, int pm) {
    asm volatile("s_waitcnt vmcnt(0)" ::: "memory"); __syncthreads();
    if (X.tid == 0) (void)xb_add(panel_word(X, bank, pm), 1u);
}
__device__ __forceinline__ void panel_wait(Ctx& X, int bank, int pm, unsigned target) {
    if (X.tid == 0) { unsigned* p = panel_word(X, bank, pm); unsigned sp = 0u;
        while (xb_ld(p) < target) { __builtin_amdgcn_s_sleep(2); if (++sp > (1u << 22)) break; }
        __builtin_amdgcn_fence(__ATOMIC_ACQUIRE, "agent"); asm volatile("s_waitcnt vmcnt(0)" ::: "memory"); }
    __syncthreads();
}

constexpr int NG_INPROJ = 176;
__device__ __forceinline__ void ph_inproj(Ctx& X) {
    const int ng = X.G > NG_INPROJ + 8 ? NG_INPROJ : X.G;
    if (X.wg < ng) {
        RegSched S{(const char*)WSP(bf16_t, WS_H), (const char*)WSP(bf16_t, WS_WIN), (size_t)256 * 2048, (size_t)256 * 2048, T / 256, INW / 256, ng, X.wg};
        EpiInproj E{WSP(bf16_t, WS_PROJ), WSP(float, WS_LOGF), WSP(float, WS_LB), WSP(float, WS_ROPE)};
        pg8::gemm_phase<EpiInproj, RegSched, true, false>(X.lds, 1024, 1024, 1024, S, E);
    }
    if (ng == X.G) expert_convert(X, X.wg, X.G);
    else if (X.wg >= ng) expert_convert(X, X.wg - ng, X.G - ng);
}
__device__ __forceinline__ void ph_mix_a(Ctx& X) {
    for (int it = X.wg; it < 256; it += X.G) hgrn_kv_unit(X, it);
    AttnRegs R; int unit = X.wg; bf16x8 qf[4];
    if (unit < 1536) attn_load(X, unit, R);
    while (unit < 1536) {
        attn_stage(X, R);
#pragma unroll
        for (int ds = 0; ds < 4; ++ds) qf[ds] = R.q[ds];
        __syncthreads();
        const int nu = unit + X.G;
        if (nu < 1536) attn_load(X, nu, R);
        attn_compute(X, unit, qf);
        __syncthreads();
        unit = nu;
    }
}
__device__ __forceinline__ void ph_mix_c(Ctx& X) { for (int it = X.wg; it < 512; it += X.G) hgrn_out_unit(X, it); attn_combine(X); }
__device__ __forceinline__ void ph_mixed(Ctx& X, bool chain) {
    TwoPartSched S{(const char*)WSP(bf16_t, WS_YCAT), (const char*)WSP(bf16_t, WS_WPA), (const char*)WSP(bf16_t, WS_WPB), T / 256, D / 256, X.G, X.wg};
    EpiMixed E{WSP(bf16_t, WS_PROJ), WSP(bf16_t, WS_MIXED)};
    pg8::gemm_phase<EpiMixed, TwoPartSched, false, false>(X.lds, 1024, 512, 512, S, E);
    if (chain) { int pm, pn; pg8::swz_tile(X.wg, T / 256, D / 256, pm, pn); panel_signal(X, 0, pm); }
}
__device__ __forceinline__ void ph_outproj(Ctx& X, bool chain) {
    int pm = 0, pn = 0; pg8::swz_tile(X.wg < 256 ? X.wg : 0, T / 256, D / 256, pm, pn);
    if (chain) panel_wait(X, 0, pm, 4u);
    RegSched S{(const char*)WSP(bf16_t, WS_MIXED), (const char*)WSP(bf16_t, WS_WOUT), (size_t)256 * 2048, (size_t)256 * 2048, T / 256, D / 256, X.G, X.wg};
    EpiOutproj E{X.x, WSP(float, WS_MOD), WSP(bf16_t, WS_X1)};
    pg8::gemm_phase<EpiOutproj, RegSched, false, false>(X.lds, 1024, 1024, 1024, S, E);
    if (chain) panel_signal(X, 1, pm);
}
__device__ __forceinline__ void ph_norm2(Ctx& X, bool chain) {
    if (chain) panel_wait(X, 1, X.wg >> 2, 4u);
    norm_rows(X, 1);
    if (chain) panel_signal(X, 2, X.wg >> 2);
}
__device__ __forceinline__ void ph_router(Ctx& X, bool chain) {
    if (chain) panel_wait(X, 2, X.wg >> 2, 4u);
    RouterSched S{(const char*)WSP(bf16_t, WS_H), (const char*)WSP(bf16_t, WS_WR), X.G, X.wg};
    EpiRouter E{WSP(float, WS_KVT)};
    pg8::gemm_phase<EpiRouter, RouterSched, false, false>(X.lds, 1024, 1024, 256, S, E);
    if (chain) panel_signal(X, 3, X.wg >> 2);
}
__device__ __forceinline__ void ph_route(Ctx& X, bool chain) {
    if (chain) panel_wait(X, 3, X.wg >> 2, 4u);
    moe_route(X, chain);
}
__device__ __forceinline__ void ph_gu(Ctx& X) {
    const int nent = moe_table(X);
    MoeSched S{(const LAS int*)(X.lds + TBL_OFF), (const LAS int*)(X.lds + TCNT_OFF), nent, (const char*)WSP(unsigned char, WS_H8), (const char*)WSP(unsigned char, WS_WGU), WSP(int, WS_LISTS), 2, 256 * 1024, 512 * 1024, 0, X.G, X.wg};
    EpiGU E{WSP(unsigned char, WS_ACT)};
    pg8::gemm_phase<EpiGU, MoeSched, true, true, true>(X.lds, 512, 512, 512, S, E);
}
__device__ __forceinline__ void ph_down(Ctx& X) {
    const int nent = moe_table(X);
    MoeSched S{(const LAS int*)(X.lds + TBL_OFF), (const LAS int*)(X.lds + TCNT_OFF), nent, (const char*)WSP(unsigned char, WS_ACT), (const char*)WSP(unsigned char, WS_WD), WSP(int, WS_LISTS), 4, 256 * 256, 1024 * 256, 256 * 256, X.G, X.wg};
    EpiDown E{WSP(unsigned char, WS_YBUF), WSP(float, WS_GATEW)};
    pg8::gemm_phase<EpiDown, MoeSched, true, false, true>(X.lds, 128, 128, 128, S, E);
}

constexpr int NPHASE = 14;
struct Args { const void* in[20]; float* out; unsigned char* ws; int ph_lo, ph_hi; };
__global__ void __launch_bounds__(NTHREADS, 2) mega_fwd(Args args) {
    extern __shared__ __attribute__((aligned(16))) unsigned char lds_raw[];
    Ctx X;
    X.lds = (LAS unsigned char*)lds_raw;
    X.tid = threadIdx.x; X.lane = X.tid & 63; X.wave = __builtin_amdgcn_readfirstlane(X.tid >> 6); X.wg = blockIdx.x; X.G = gridDim.x;
    X.x = (const float*)args.in[0]; X.c = (const float*)args.in[1]; X.positions = (const int*)args.in[2]; X.w_ada = (const float*)args.in[3]; X.b_ada = (const float*)args.in[4];
    X.g1 = (const float*)args.in[5]; X.w_in = (const float*)args.in[6]; X.lb_logits = (const float*)args.in[7]; X.g_hgrn = (const float*)args.in[8]; X.w_pa = (const float*)args.in[9];
    X.w_pb = (const float*)args.in[10]; X.w_out = (const float*)args.in[11]; X.g2 = (const float*)args.in[12]; X.w_router = (const float*)args.in[13]; X.rbias = (const float*)args.in[14];
    X.w_egu = (const float*)args.in[15]; X.w_edown = (const float*)args.in[16]; X.w_sgu = (const float*)args.in[17]; X.w_sdown = (const float*)args.in[18]; X.g_final = (const float*)args.in[19];
    X.out = args.out; X.ws = args.ws;
    volatile LAS unsigned* MISC = (volatile LAS unsigned*)(X.lds + MISC_OFF);
    if (X.tid < 32) MISC[X.tid] = 0u;
    __syncthreads();
    const int lo = args.ph_lo, hi = args.ph_hi;
    XcdBarrier bar; bar.bar = WSP(unsigned, WS_CTL) + CW_BAR; bar.x = 0; bar.st = nullptr;
    if (hi - lo > 1) bar = xcd_barrier_post(WSP(unsigned, WS_CTL) + CW_BAR, MISC + 8);
#ifndef PH_MASK
#define PH_MASK 0xffffffffu
#endif
#define IN(k) ((((PH_MASK) >> (k)) & 1u) && lo <= (k) && (k) < hi)
#ifndef REPEAT_MASK
#define REPEAT_MASK 0u
#endif
#define SEAM(k) do { if (IN(k) && IN((k) + 1)) xcd_barrier(bar); } while (0)
#define RUN(k, call) do { if (IN(k)) { call; if (((REPEAT_MASK) >> (k)) & 1u) { xcd_barrier(bar); call; } } } while (0)

    RUN(0, p0_prologue(X)); SEAM(0);
    RUN(1, { small_transposes(X); norm_rows(X, 0); }); SEAM(1);
    RUN(2, ph_inproj(X)); SEAM(2);
    RUN(3, ph_mix_a(X)); SEAM(3);
    RUN(4, hgrn_passB(X)); SEAM(4);
    RUN(5, ph_mix_c(X)); SEAM(5);
    const bool chain = (X.G == 256);
    RUN(6, ph_mixed(X, chain)); if (!chain) SEAM(6);
    RUN(7, ph_outproj(X, chain)); if (!chain) SEAM(7);
    RUN(8, ph_norm2(X, chain)); if (!chain) SEAM(8);
    RUN(9, ph_router(X, chain)); if (!chain) SEAM(9);
    RUN(10, ph_route(X, chain)); SEAM(10);
    RUN(11, ph_gu(X)); SEAM(11);
    RUN(12, ph_down(X)); SEAM(12);
    RUN(13, final_rows(X));
#undef IN
#undef SEAM
}

extern "C" void kernel_launch(void* const* d_in, const int* in_sizes, int n_in, void* d_out, int out_size, void* d_ws, size_t ws_size, hipStream_t stream) {
    static int grid = 0;
    if (grid == 0) {
        if (n_in != 20 || out_size != T * D || ws_size < WS_END) { fprintf(stderr, "kernel_launch: unexpected shapes (n_in %d, out %d, ws %zu); nothing launched\n", n_in, out_size, ws_size); grid = -1; return; }
        int dev = 0, cus = 0, per_cu = 0;
        if (hipGetDevice(&dev) != hipSuccess || hipDeviceGetAttribute(&cus, hipDeviceAttributeMultiprocessorCount, dev) != hipSuccess) { grid = -1; return; }
        if (hipFuncSetAttribute((const void*)mega_fwd, hipFuncAttributeMaxDynamicSharedMemorySize, LDS_BYTES) != hipSuccess) { fprintf(stderr, "kernel_launch: hipFuncSetAttribute failed\n"); grid = -1; return; }
        if (hipOccupancyMaxActiveBlocksPerMultiprocessor(&per_cu, (const void*)mega_fwd, NTHREADS, LDS_BYTES) != hipSuccess || per_cu < 1) { fprintf(stderr, "kernel_launch: occupancy query says %d blocks/CU; nothing launched\n", per_cu); (void)hipGetLastError(); grid = -1; return; }
        grid = cus;
        if (T % grid != 0 || 24576 % grid != 0 || grid % 8 != 0) { fprintf(stderr, "kernel_launch: grid %d does not divide the row count; nothing launched\n", grid); grid = -1; return; }
    }
    if (grid < 0) return;
    (void)hipMemsetAsync((char*)d_ws + WS_CTL, 0, CTL_ZERO_BYTES, stream);
    Args a{};
    for (int i = 0; i < 20; ++i) a.in[i] = d_in[i];
    a.out = (float*)d_out; a.ws = (unsigned char*)d_ws;
#if MK_PER_PHASE
    for (int p = 0; p < NPHASE; ++p) { a.ph_lo = p; a.ph_hi = p + 1; hipLaunchKernelGGL(mega_fwd, dim3(grid), dim3(NTHREADS), LDS_BYTES, stream, a); }
#else
    a.ph_lo = 0; a.ph_hi = NPHASE;
    hipLaunchKernelGGL(mega_fwd, dim3(grid), dim3(NTHREADS), LDS_BYTES, stream, a);
#endif
}
```

```cpp
#include <hip/hip_runtime.h>
#include <cstdio>
#include <cstdint>

#ifndef MK_PER_PHASE
#define MK_PER_PHASE 0
#endif

#define GAS __attribute__((address_space(1)))
#define LAS __attribute__((address_space(3)))
typedef unsigned short bf16_t;
typedef short bf16x8 __attribute__((ext_vector_type(8)));
typedef short s16x4 __attribute__((ext_vector_type(4)));
typedef float f32x4 __attribute__((ext_vector_type(4)));
typedef float f32x2 __attribute__((ext_vector_type(2)));
typedef float f32x16 __attribute__((ext_vector_type(16)));
typedef unsigned u32x4 __attribute__((ext_vector_type(4)));
typedef unsigned u32x2 __attribute__((ext_vector_type(2)));
typedef long l64x2 __attribute__((ext_vector_type(2)));

constexpr int NB = 4, SEQ = 4096, T = NB * SEQ, D = 1024, INW = 8704;
constexpr int C_HQ = 0, C_HK = 512, C_HV = 1024, C_HG = 1536, C_AQ = 2048, C_AK = 3584, C_AV = 5120, C_GA = 6656, C_GB = 7680;
constexpr int NE = 256, NEX = 257, TOPK = 8, NSLOT = 9, EFF = 256;
constexpr float EPS = 1e-6f;
constexpr float WGU_SCALE = 64.0f, WD_SCALE = 32.0f;
constexpr float YSCALE = 16.0f;
constexpr int NWAVES = 8, NTHREADS = 512;

constexpr size_t MiB = 1u << 20;
constexpr size_t WS_CTL = 0, CTL_ZERO_BYTES = 1 * MiB;
constexpr size_t WS_MODP = 2 * MiB;
constexpr size_t WS_MOD = 4 * MiB;
constexpr size_t WS_LB = 4 * MiB + 128 * 1024;
constexpr size_t WS_XB = 4 * MiB + 256 * 1024;
constexpr size_t WS_ROPE = 5 * MiB;
constexpr size_t WS_DECAY = 6 * MiB;
constexpr size_t WS_GATEW = 7 * MiB;
constexpr size_t WS_LISTS = 16 * MiB;
constexpr size_t WS_WIN = 34 * MiB;
constexpr size_t WS_WPA = 51 * MiB, WS_WPB = 52 * MiB, WS_WOUT = 53 * MiB, WS_WR = 55 * MiB;
constexpr size_t WS_H = 56 * MiB;
constexpr size_t WS_LOGF = 88 * MiB;
constexpr size_t WS_H8 = 120 * MiB;
constexpr size_t WS_MIXED = 136 * MiB;
constexpr size_t WS_YCAT = 168 * MiB;
constexpr size_t WS_X1 = 200 * MiB;
constexpr size_t WS_OG = 264 * MiB;
constexpr size_t WS_LSE = 312 * MiB;
constexpr size_t WS_KVT = 314 * MiB;
constexpr size_t WS_SPT = 378 * MiB;
constexpr size_t WS_PROJ = 410 * MiB;
constexpr size_t WS_WGU = 682 * MiB;
constexpr size_t WS_WD = 939 * MiB;
constexpr size_t WS_ACT = 1068 * MiB;
constexpr size_t WS_YBUF = 1172 * MiB;
constexpr size_t WS_END = 1460 * MiB;
constexpr int CW_BAR = 4096;
constexpr int CW_PANEL = 65536;
constexpr int CW_CNT = 16384;

constexpr int RING_BYTES = 131072;
constexpr int TBL_OFF = RING_BYTES;
constexpr int TCNT_OFF = TBL_OFF + 4096;
constexpr int MISC_OFF = TCNT_OFF + 2560;
constexpr int LDS_BYTES = 147456;

#define LDS_WAIT() asm volatile("s_waitcnt lgkmcnt(0)" ::: "memory")
#define VM_WAIT() asm volatile("s_waitcnt vmcnt(0)" ::: "memory")
__device__ __forceinline__ unsigned f2bf(float f) { unsigned u = __builtin_bit_cast(unsigned, f); return (u + 0x7fffu + ((u >> 16) & 1u)) >> 16; }
__device__ __forceinline__ float bf2f(unsigned b) { return __builtin_bit_cast(float, b << 16); }
__device__ __forceinline__ unsigned pk2(float lo, float hi) { return f2bf(lo) | (f2bf(hi) << 16); }
__device__ __forceinline__ float bflo(unsigned w) { return __builtin_bit_cast(float, w << 16); }
__device__ __forceinline__ float bfhi(unsigned w) { return __builtin_bit_cast(float, w & 0xffff0000u); }
__device__ __forceinline__ float sigmoidf_(float x) { return 1.0f / (1.0f + __expf(-x)); }
__device__ __forceinline__ float wave_sum(float v) {
#pragma unroll
    for (int o = 1; o < 64; o <<= 1) v += __shfl_xor(v, o);
    return v;
}

__device__ __forceinline__ float clamp_e4m3(float x) { return __builtin_amdgcn_fmed3f(x, -448.0f, 448.0f); }
__device__ __forceinline__ unsigned pk4_fp8(float a, float b, float c, float d) { int w = 0; w = __builtin_amdgcn_cvt_pk_fp8_f32(clamp_e4m3(a), clamp_e4m3(b), w, false); w = __builtin_amdgcn_cvt_pk_fp8_f32(clamp_e4m3(c), clamp_e4m3(d), w, true); return (unsigned)w; }
__device__ __forceinline__ void st_wt8(void* p, unsigned long long v) { __hip_atomic_store((unsigned long long*)p, v, __ATOMIC_RELAXED, __HIP_MEMORY_SCOPE_AGENT); }
__device__ __forceinline__ void st_wt16(void* p, u32x4 v) { asm volatile("global_store_dwordx4 %0, %1, off sc1\n\ts_nop 1" :: "v"(p), "v"(v) : "memory"); }
__device__ __forceinline__ void st_wt4(void* p, unsigned v) { __hip_atomic_store((unsigned*)p, v, __ATOMIC_RELAXED, __HIP_MEMORY_SCOPE_AGENT); }
namespace pg8 {
constexpr int BM = 256, BK = 64, HALF = 128, HTB = HALF * BK * 2, STAGE_BYTES = 8 * HTB, NXCD = 8, WGM = 8;
__host__ __device__ __forceinline__ int lds_byte(int r, int c) { const int st = (r >> 4) * 2 + (c >> 5), rr = r & 15, cc = c & 31, ob = rr * 64 + cc * 2; return st * 1024 + (ob ^ (((ob >> 9) & 1) << 5)); }
__host__ __device__ __forceinline__ void stage_rc(int b, int& R, int& C) { const int st = b / 1024, sb = b % 1024, swz = sb ^ (((sb >> 9) & 1) << 5); R = (st >> 1) * 16 + swz / 64; C = (st & 1) * 32 + (swz % 64) / 2; }
__host__ __device__ __forceinline__ int perm32(int rho) { const int n = rho >> 4, i = rho & 15; return 8 * (i >> 2) + 4 * n + (i & 3); }

struct Unit { const char* a; const char* b; const int* rows; int pm, pn, aux, nvalid; };

__device__ __forceinline__ void swz_tile(int L, int nM, int nN, int& pm, int& pn) {
    const int nwg = nM * nN; int wgid = L;
    { const int q = nwg / NXCD, r = nwg % NXCD, xcd = wgid % NXCD, off = wgid / NXCD; wgid = (xcd < r ? xcd * (q + 1) : r * (q + 1) + (xcd - r) * q) + off; }
    const int nig = WGM * nN, gid = wgid / nig, fm = gid * WGM, gsz = (nM - fm) < WGM ? (nM - fm) : WGM;
    pm = fm + ((wgid % nig) % gsz); pn = (wgid % nig) / gsz;
}

__device__ __forceinline__ unsigned cvt_pk_bf16(float lo, float hi) { unsigned r; asm volatile("v_cvt_pk_bf16_f32 %0, %1, %2" : "=v"(r) : "v"(lo), "v"(hi)); return r; }

template <bool GATHER>
__device__ __forceinline__ void gather_offs(const Unit& u, int tid, int lda, unsigned (&v)[2][2]) {
    if constexpr (GATHER) {
#pragma unroll
        for (int i = 0; i < 2; ++i) { int R, C; stage_rc(tid * 16 + i * 8192, R, C);
#pragma unroll
            for (int hh = 0; hh < 2; ++hh) { const int ri = hh * HALF + R; int slot = 0; if (ri < u.nvalid) slot = u.rows[ri];
                const unsigned tok = (unsigned)slot / 9u; v[hh][i] = (tok * (unsigned)lda + (unsigned)C) * 2u; } }
    }
}

template <class Epi, class Sched, bool ALIGN_EPI, bool GATHER, bool FP8 = false>
__device__ __forceinline__ void gemm_phase(LAS unsigned char* lds, const int lda, const int ldb, const int K, const Sched& S, const Epi& E) {
    const int tid = threadIdx.x, wid = __builtin_amdgcn_readfirstlane(tid >> 6), lane = tid & 63, wr = wid >> 2, wc = wid & 3, fr = lane & 15, fq = lane >> 4;
    const int nt = K / BK;
    unsigned voffA[2], voffB[2];
#pragma unroll
    for (int i = 0; i < 2; ++i) { int R, C; stage_rc(tid * 16 + i * 8192, R, C); const int Rb = Epi::PERM ? ((R & ~31) + perm32(R & 31)) : R;
        voffA[i] = (unsigned)(R * lda + C) * 2u; voffB[i] = (unsigned)(Rb * ldb + C) * 2u; }
    const size_t kstep = (size_t)(BK * 2);
    const size_t hstepA = GATHER ? 0 : (size_t)HALF * lda * 2, hstepB = (size_t)HALF * ldb * 2;
    const unsigned ldsw = (unsigned)wid * 1024u;
    const int aoff = lds_byte(wr * 64 + fr, fq * 8), boff = lds_byte(wc * 32 + fr, fq * 8);
#define PG8_SA(b, h) (((b) * 2 + (h)) * HTB)
#define PG8_SB(b, h) ((4 + (b) * 2 + (h)) * HTB)
#define PG8_STAGE(bufoff, gbase, voff) do { _Pragma("unroll") for (int _i = 0; _i < 2; ++_i) \
        __builtin_amdgcn_global_load_lds((const unsigned*)((const char*)(gbase) + (voff)[_i]), (LAS unsigned*)(lds + (bufoff) + ldsw + _i * 8192), 16, 0, 0); } while (0)
#define PG8_STAGE_A(bufoff, gb, hh, nx) do { if constexpr (GATHER) { unsigned _v[2]; _v[0] = (nx) ? vn[hh][0] : vc[hh][0]; _v[1] = (nx) ? vn[hh][1] : vc[hh][1]; PG8_STAGE(bufoff, gb, _v); } \
        else { PG8_STAGE(bufoff, (gb) + (hh) * hstepA, voffA); } } while (0)
#define PG8_LDA(dst, b, h) do { _Pragma("unroll") for (int m = 0; m < 4; ++m) _Pragma("unroll") for (int k = 0; k < 2; ++k) dst[m][k] = *(const LAS bf16x8*)(lds + PG8_SA(b, h) + aoff + m * 2048 + k * 1024); } while (0)
#define PG8_LDB(dst, b, h) do { _Pragma("unroll") for (int n = 0; n < 2; ++n) _Pragma("unroll") for (int k = 0; k < 2; ++k) dst[n][k] = *(const LAS bf16x8*)(lds + PG8_SB(b, h) + boff + n * 2048 + k * 1024); } while (0)
#define PG8_MMA(ai, bj, At, Bt) do { __builtin_amdgcn_s_setprio(1); _Pragma("unroll") for (int m = 0; m < 4; ++m) _Pragma("unroll") for (int n = 0; n < 2; ++n) _Pragma("unroll") for (int k = 0; k < 2; ++k) { \
        if constexpr (FP8) { const l64x2 _b = __builtin_bit_cast(l64x2, Bt[n][k]), _a = __builtin_bit_cast(l64x2, At[m][k]); \
            acc[ai][bj][m][n] = __builtin_amdgcn_mfma_f32_16x16x32_fp8_fp8(_b[0], _a[0], acc[ai][bj][m][n], 0, 0, 0); acc[ai][bj][m][n] = __builtin_amdgcn_mfma_f32_16x16x32_fp8_fp8(_b[1], _a[1], acc[ai][bj][m][n], 0, 0, 0); } \
        else acc[ai][bj][m][n] = __builtin_amdgcn_mfma_f32_16x16x32_bf16(Bt[n][k], At[m][k], acc[ai][bj][m][n], 0, 0, 0); } __builtin_amdgcn_s_setprio(0); } while (0)
#define PG8_WAIT_V(n) asm volatile("s_waitcnt vmcnt(" #n ")" ::: "memory")
#define PG8_WAIT_L(n) asm volatile("s_waitcnt lgkmcnt(" #n ")" ::: "memory")
#define PG8_BAR __builtin_amdgcn_s_barrier()
#define PG8_SCHED __builtin_amdgcn_sched_barrier(0)
    Unit cur, nxt; int ui = 0;
    if (!S.next(0, cur)) return;
    unsigned vc[2][2] = {{0u, 0u}, {0u, 0u}}, vn[2][2] = {{0u, 0u}, {0u, 0u}};
    gather_offs<GATHER>(cur, tid, lda, vc);
    f32x4 acc[2][2][4][2];
#pragma unroll
    for (int a = 0; a < 2; ++a)
#pragma unroll
        for (int b = 0; b < 2; ++b)
#pragma unroll
            for (int m = 0; m < 4; ++m)
#pragma unroll
                for (int n = 0; n < 2; ++n) acc[a][b][m][n] = (f32x4){0.f, 0.f, 0.f, 0.f};
    bf16x8 At[4][2], B0[2][2], B1[2][2];
    const char* cA = cur.a; const char* cB = cur.b;
    PG8_STAGE(PG8_SB(0, 0), cB, voffB); PG8_STAGE(PG8_SB(0, 1), cB + hstepB, voffB); PG8_STAGE_A(PG8_SA(0, 0), cA, 0, false); PG8_STAGE_A(PG8_SA(0, 1), cA, 1, false);
    if (wr == 1) PG8_BAR;
    PG8_WAIT_V(2); PG8_BAR;
    PG8_STAGE(PG8_SB(1, 0), cB + kstep, voffB); PG8_STAGE_A(PG8_SA(1, 0), cA + kstep, 0, false); PG8_STAGE(PG8_SB(1, 1), cB + hstepB + kstep, voffB);
    PG8_WAIT_V(6); PG8_BAR;
    for (;;) {
        const bool has_next = S.next(ui + 1, nxt);
        if (has_next) gather_offs<GATHER>(nxt, tid, lda, vn);
        const char* nA = has_next ? nxt.a : cA; const char* nB = has_next ? nxt.b : cB;
        const bool do0 = !Sched::HALFSKIP || cur.nvalid > 64 * wr, do1 = !Sched::HALFSKIP || cur.nvalid > 128 + 64 * wr;
        for (int t = 0; t < nt; t += 2) {
            const bool last = (t == nt - 2);
            const bool lnx = last && has_next;
            const char* a1 = cA + (size_t)(t + 1) * kstep;
            const char* a2 = last ? nA : cA + (size_t)(t + 2) * kstep; const char* b2 = last ? nB : cB + (size_t)(t + 2) * kstep;
            const char* a3 = a2 + kstep; const char* b3 = b2 + kstep;
            PG8_LDB(B0, 0, 0); PG8_LDB(B1, 0, 1); PG8_SCHED; PG8_LDA(At, 0, 0); PG8_STAGE_A(PG8_SA(1, 1), a1, 1, false);
            PG8_WAIT_V(8); PG8_WAIT_L(0); PG8_BAR; if (do0) { PG8_MMA(0, 0, At, B0); PG8_MMA(0, 1, At, B1); } PG8_BAR; PG8_SCHED;
            PG8_LDA(At, 0, 1); PG8_STAGE(PG8_SB(0, 0), b2, voffB); PG8_STAGE(PG8_SB(0, 1), b2 + hstepB, voffB); PG8_STAGE_A(PG8_SA(0, 0), a2, 0, lnx);
            PG8_WAIT_V(8); PG8_WAIT_L(0); PG8_BAR; if (do1) { PG8_MMA(1, 0, At, B0); PG8_MMA(1, 1, At, B1); } PG8_BAR; PG8_SCHED;
            PG8_LDB(B0, 1, 0); PG8_LDB(B1, 1, 1); PG8_SCHED; PG8_LDA(At, 1, 0); PG8_STAGE_A(PG8_SA(0, 1), a2, 1, lnx);
            PG8_WAIT_V(8); PG8_WAIT_L(0); PG8_BAR; if (do0) { PG8_MMA(0, 0, At, B0); PG8_MMA(0, 1, At, B1); } PG8_BAR; PG8_SCHED;
            PG8_LDA(At, 1, 1); PG8_STAGE(PG8_SB(1, 0), b3, voffB); PG8_STAGE(PG8_SB(1, 1), b3 + hstepB, voffB); PG8_STAGE_A(PG8_SA(1, 0), a3, 0, lnx);
            PG8_WAIT_V(8); PG8_WAIT_L(0); PG8_BAR; if (do1) { PG8_MMA(1, 0, At, B0); PG8_MMA(1, 1, At, B1); } PG8_BAR; PG8_SCHED;
        }
        if constexpr (ALIGN_EPI) { if (wr == 0) PG8_BAR; }
        E(acc, cur, wr, wc, fr, fq);
        __builtin_amdgcn_s_waitcnt(0x0F70);
        if (!has_next) break;
        if (!E.keep(cur)) {
#pragma unroll
            for (int a = 0; a < 2; ++a)
#pragma unroll
                for (int b = 0; b < 2; ++b)
#pragma unroll
                    for (int m = 0; m < 4; ++m)
#pragma unroll
                        for (int n = 0; n < 2; ++n) acc[a][b][m][n] = (f32x4){0.f, 0.f, 0.f, 0.f};
        }
        cur = nxt; cA = nA; cB = nB; ++ui;
        if constexpr (GATHER) {
#pragma unroll
            for (int hh = 0; hh < 2; ++hh) { vc[hh][0] = vn[hh][0]; vc[hh][1] = vn[hh][1]; }
        }
        if constexpr (ALIGN_EPI) { if (wr == 1) PG8_BAR; }
    }
    PG8_WAIT_V(0);
    if constexpr (!ALIGN_EPI) { if (wr == 0) PG8_BAR; }
    PG8_BAR;
#undef PG8_SA
#undef PG8_SB
#undef PG8_STAGE
#undef PG8_STAGE_A
#undef PG8_LDA
#undef PG8_LDB
#undef PG8_MMA
#undef PG8_WAIT_V
#undef PG8_WAIT_L
#undef PG8_BAR
#undef PG8_SCHED
}
}

#define XB_TMO      128
#define XB_XCNT(j)  (256  + 64 * (j))
#define XB_XSUB(j)  (1280 + 64 * (j))
#define XB_XGEN(j)  (2304 + 64 * (j))
#define XB_TOP      3328
#define XB_TOPGEN   3392
#define XCD_BAR_WORDS 3456
#define XB_SPIN_CAP (1u << 20)
__device__ __forceinline__ unsigned xb_ld(unsigned* p)              { return __hip_atomic_load(p, __ATOMIC_RELAXED, __HIP_MEMORY_SCOPE_AGENT); }
__device__ __forceinline__ unsigned xb_add(unsigned* p, unsigned v) { return __hip_atomic_fetch_add(p, v, __ATOMIC_RELAXED, __HIP_MEMORY_SCOPE_AGENT); }
__device__ __forceinline__ unsigned xb_xcc_id() { return (unsigned)__builtin_amdgcn_s_getreg((3 << 11) | 20) & 0xFu; }
#define XB_SPIN(cond, bar) do { unsigned _sp = 0; while (cond) { __builtin_amdgcn_s_sleep(1); \
    if ((++_sp & 255u) == 0u) { if (xb_ld(&(bar)[XB_TMO])) break; if (_sp > XB_SPIN_CAP) { atomicAdd(&(bar)[XB_TMO], 1u); break; } } } } while (0)
struct XcdBarrier { unsigned* bar; unsigned x; volatile LAS unsigned* st; };
__device__ __forceinline__ XcdBarrier xcd_barrier_post(unsigned* bar, volatile LAS unsigned* st) {
    XcdBarrier b; b.bar = bar; b.x = xb_xcc_id(); b.st = st;
    if (threadIdx.x == 0) (void)xb_add(&bar[XB_XCNT(b.x)], 1u);
    return b;
}
__device__ __forceinline__ void xcd_barrier_complete(unsigned* bar, unsigned x, unsigned& nloc, unsigned& nx) {
    const unsigned G = gridDim.x * gridDim.y * gridDim.z;
    unsigned sum, cnt, mine, sp = 0u;
    for (;;) {
        sum = 0u; cnt = 0u; mine = 0u;
#pragma unroll
        for (unsigned j = 0; j < 16; ++j) { const unsigned c = xb_ld(&bar[XB_XCNT(j)]); sum += c; cnt += (c > 0u) ? 1u : 0u; mine = (j == x) ? c : mine; }
        if (sum == G) break;
        __builtin_amdgcn_s_sleep(1);
        if ((++sp & 255u) == 0u) { if (xb_ld(&bar[XB_TMO])) break; if (sp > XB_SPIN_CAP) { atomicAdd(&bar[XB_TMO], 1u); break; } }
    }
    nloc = mine > 0u ? mine : 1u; nx = cnt > 0u ? cnt : 1u;
}
__device__ __forceinline__ void xcd_barrier(const XcdBarrier& b) {
    asm volatile("s_waitcnt vmcnt(0)" ::: "memory");
    __syncthreads();
    if (threadIdx.x == 0) {
        unsigned* bar = b.bar;
        __builtin_amdgcn_s_waitcnt(0);
        unsigned nloc = b.st[0], nx = b.st[1];
        if (nloc == 0u) { xcd_barrier_complete(bar, b.x, nloc, nx); b.st[0] = nloc; b.st[1] = nx; }
        const unsigned old = xb_add(&bar[XB_XSUB(b.x)], 1u);
        const unsigned gen = old / nloc;
        if (old + 1u == (gen + 1u) * nloc) {
            __builtin_amdgcn_fence(__ATOMIC_RELEASE, "agent");
            asm volatile("s_waitcnt vmcnt(0)" ::: "memory");
            const unsigned og = xb_add(&bar[XB_TOP], 1u);
            const unsigned tg = og / nx;
            if (og + 1u == (tg + 1u) * nx) xb_add(&bar[XB_TOPGEN], 1u);
            else XB_SPIN(xb_ld(&bar[XB_TOPGEN]) == tg, bar);
            __builtin_amdgcn_fence(__ATOMIC_ACQUIRE, "agent");
            asm volatile("s_waitcnt vmcnt(0)" ::: "memory");
        } else {
            XB_SPIN(xb_ld(&bar[XB_TOPGEN]) == gen, bar);
            __builtin_amdgcn_fence(__ATOMIC_ACQUIRE, "agent");
            asm volatile("s_waitcnt vmcnt(0)" ::: "memory");
        }
    }
    __syncthreads();
}

struct Ctx {
    LAS unsigned char* lds;
    int tid, lane, wave, wg, G;
    const float *x, *c, *w_ada, *b_ada, *g1, *w_in, *lb_logits, *g_hgrn, *w_pa, *w_pb, *w_out, *g2, *w_router, *rbias, *w_egu, *w_edown, *w_sgu, *w_sdown, *g_final;
    const int* positions;
    float* out;
    unsigned char* ws;
};
#define WSP(type, off) ((type*)(X.ws + (off)))

__device__ __forceinline__ void transpose_item(const float* W, int K, int N, bf16_t* WT, int dst_row0, int src_col0, int k0, LAS float* scr, int lane) {
#pragma unroll 16
    for (int i = 0; i < 32; ++i) { const int kk = 2 * i + (lane >> 5); scr[kk * 33 + (lane & 31)] = W[(size_t)(k0 + kk) * N + src_col0 + (lane & 31)]; }
    LDS_WAIT(); asm volatile("" ::: "memory");
    const int c = lane & 7;
#pragma unroll
    for (int j = 0; j < 4; ++j) { const int n = (lane >> 3) + 8 * j; const LAS float* s = scr + (8 * c) * 33 + n;
        u32x4 o; o.x = pk2(s[0 * 33], s[1 * 33]); o.y = pk2(s[2 * 33], s[3 * 33]); o.z = pk2(s[4 * 33], s[5 * 33]); o.w = pk2(s[6 * 33], s[7 * 33]);
        *(u32x4*)(WT + (size_t)(dst_row0 + n) * K + k0 + 8 * c) = o; }
    LDS_WAIT(); asm volatile("" ::: "memory");
}
__device__ __forceinline__ void transpose_plain(const float* W, int K, int N, bf16_t* WT, int item, LAS float* scr, int lane) {
    const int nblk = N / 32, kb = item / nblk, nb = item % nblk;
    transpose_item(W, K, N, WT, nb * 32, nb * 32, kb * 64, scr, lane);
}
__device__ __forceinline__ void p0_prologue(Ctx& X) {
    LAS float* scr = (LAS float*)(X.lds + X.wave * 16384);
    const int gw = X.wg * NWAVES + X.wave, NGW = X.G * NWAVES;
    {
        float* MODP = WSP(float, WS_MODP);
        for (int it = gw; it < 96 * 16; it += NGW) {
            const int jc = it % 96, kc = it / 96, j = jc * 64 + X.lane;
            float a0 = 0.f, a1 = 0.f, a2 = 0.f, a3 = 0.f;
#pragma unroll 16
            for (int kk = 0; kk < 64; ++kk) { const int k = kc * 64 + kk; const float w = X.w_ada[(size_t)k * 6144 + j];
                const float c0 = X.c[k], c1 = X.c[1024 + k], c2 = X.c[2048 + k], c3 = X.c[3072 + k];
                a0 += c0 * sigmoidf_(c0) * w; a1 += c1 * sigmoidf_(c1) * w; a2 += c2 * sigmoidf_(c2) * w; a3 += c3 * sigmoidf_(c3) * w; }
            float* o = MODP + (size_t)kc * 24576 + j;
            o[0] = a0; o[6144] = a1; o[12288] = a2; o[18432] = a3;
        }
    }
    {
        float* ROPE = WSP(float, WS_ROPE);
        const int gt = X.wg * NTHREADS + X.tid, NGT = X.G * NTHREADS;
        for (int idx = gt; idx < T * 8; idx += NGT) { const int t = idx >> 3, i = idx & 7;
            const float inv_freq = 1.0f / powf(500000.0f, (float)(2 * i) / 16.0f);
            const float ang = (float)X.positions[t] * inv_freq;
            ROPE[t * 16 + i] = cosf(ang); ROPE[t * 16 + 8 + i] = sinf(ang); }
        if (X.wg == 0) { float* LB = WSP(float, WS_LB);
            for (int j = X.tid; j < 512; j += NTHREADS) { const float l0 = X.lb_logits[j], l1 = X.lb_logits[512 + j], m = fmaxf(l0, l1), e0 = __expf(l0 - m), e1 = __expf(l1 - m); LB[j] = e0 / (e0 + e1); } }
    }
}
struct CvtItem { const float* src; bf16_t* dst; };
template <bool GU> __device__ __forceinline__ CvtItem cvt_item(const Ctx& X, int it) {
    CvtItem c;
    if constexpr (GU) { const int e = it >> 7, q = it & 127, w8 = q & 7, sq = q >> 3, kb = 4 * (sq >> 2) + (w8 & 3), nb = 2 * (sq & 3) + (w8 >> 2);
        const int n0 = nb * 64, pn = n0 >> 8, bj = (n0 >> 7) & 1, idx = n0 & 127, srcc = bj * 256 + pn * 128 + idx;
        const float* W = (e < NE) ? X.w_egu + (size_t)e * 1024 * 512 : X.w_sgu;
        c.src = W + (size_t)(kb * 64) * 512 + srcc; c.dst = (bf16_t*)(X.ws + WS_WGU + ((size_t)e * 512 + n0) * 1024 + kb * 64); }
    else { const int e = it >> 6, q = it & 63, w8 = q & 7, sq = q >> 3, kb = w8 & 3, nb = 2 * sq + (w8 >> 2);
        const float* W = (e < NE) ? X.w_edown + (size_t)e * 256 * 1024 : X.w_sdown;
        c.src = W + (size_t)(kb * 64) * 1024 + nb * 64; c.dst = (bf16_t*)(X.ws + WS_WD + ((size_t)e * 1024 + nb * 64) * 256 + kb * 64); }
    return c;
}
template <int KB> __device__ __forceinline__ void cvt_store8(const CvtItem& c, int lane, const f32x4 (&v)[16], LAS unsigned char* tl, float sc) {
    const int kq = lane >> 4, nq = lane & 15;
#pragma unroll
    for (int i = 0; i < 4; ++i) { u32x4 w;
        w.x = pk4_fp8(v[0][i] * sc, v[1][i] * sc, v[2][i] * sc, v[3][i] * sc); w.y = pk4_fp8(v[4][i] * sc, v[5][i] * sc, v[6][i] * sc, v[7][i] * sc);
        w.z = pk4_fp8(v[8][i] * sc, v[9][i] * sc, v[10][i] * sc, v[11][i] * sc); w.w = pk4_fp8(v[12][i] * sc, v[13][i] * sc, v[14][i] * sc, v[15][i] * sc);
        *(LAS u32x4*)(tl + (4 * nq + i) * 80 + kq * 16) = w; }
    LDS_WAIT(); asm volatile("" ::: "memory");
    const int ch = lane & 3, r = lane >> 2;
    unsigned char* d8 = (unsigned char*)c.dst;
#pragma unroll
    for (int j = 0; j < 4; ++j) { const int n = 16 * j + r; const u32x4 w = *(const LAS u32x4*)(tl + n * 80 + ch * 16); __builtin_nontemporal_store(w, (u32x4*)(d8 + (size_t)n * KB + 16 * ch)); }
    LDS_WAIT(); asm volatile("" ::: "memory");
}
template <int N> __device__ __forceinline__ void cvt_load(const CvtItem& c, int lane, f32x4 (&v)[16]) {
    const float* p = c.src + (size_t)(16 * (lane >> 4)) * N + 4 * (lane & 15);
#pragma unroll
    for (int j = 0; j < 16; ++j) v[j] = __builtin_nontemporal_load((const f32x4*)(p + (size_t)j * N));
}
template <int K> __device__ __forceinline__ void cvt_store(const CvtItem& c, int lane, const f32x4 (&v)[16], LAS unsigned char* tl) {
    const int kq = lane >> 4, nq = lane & 15;
#pragma unroll
    for (int i = 0; i < 4; ++i) { u32x4 w0, w1;
        w0.x = pk2(v[0][i], v[1][i]); w0.y = pk2(v[2][i], v[3][i]); w0.z = pk2(v[4][i], v[5][i]); w0.w = pk2(v[6][i], v[7][i]);
        w1.x = pk2(v[8][i], v[9][i]); w1.y = pk2(v[10][i], v[11][i]); w1.z = pk2(v[12][i], v[13][i]); w1.w = pk2(v[14][i], v[15][i]);
        LAS unsigned char* q = tl + (4 * nq + i) * 144 + kq * 32; *(LAS u32x4*)q = w0; *(LAS u32x4*)(q + 16) = w1; }
    LDS_WAIT(); asm volatile("" ::: "memory");
    const int ch = lane & 7, r = lane >> 3;
#pragma unroll
    for (int j = 0; j < 8; ++j) { const int n = 8 * j + r; const u32x4 w = *(const LAS u32x4*)(tl + n * 144 + ch * 16); __builtin_nontemporal_store(w, (u32x4*)(c.dst + (size_t)n * K + 8 * ch)); }
    LDS_WAIT(); asm volatile("" ::: "memory");
}
struct CvtPair { const float* src; unsigned char* dst; };
template <bool GU> __device__ __forceinline__ CvtPair cvt_pair(const Ctx& X, int di) {
    CvtPair c;
    if constexpr (GU) { const int e = di >> 6, q = di & 63, nb = q & 7, kb2 = q >> 3;
        const int n0 = nb * 64, pn = n0 >> 8, bj = (n0 >> 7) & 1, idx = n0 & 127, srcc = bj * 256 + pn * 128 + idx;
        const float* W = (e < NE) ? X.w_egu + (size_t)e * 1024 * 512 : X.w_sgu;
        c.src = W + (size_t)(kb2 * 128) * 512 + srcc; c.dst = X.ws + WS_WGU + ((size_t)e * 512 + n0) * 1024 + kb2 * 128; }
    else { const int e = di >> 5, q = di & 31, nb = q & 15, kb2 = q >> 4;
        const float* W = (e < NE) ? X.w_edown + (size_t)e * 256 * 1024 : X.w_sdown;
        c.src = W + (size_t)(kb2 * 128) * 1024 + nb * 64; c.dst = X.ws + WS_WD + ((size_t)e * 1024 + nb * 64) * 256 + kb2 * 128; }
    return c;
}
template <int N> __device__ __forceinline__ void cvt_load_half(const CvtPair& c, int half, int lane, f32x4 (&v)[16]) {
    const float* p = c.src + (size_t)(64 * half + 16 * (lane >> 4)) * N + 4 * (lane & 15);
#pragma unroll
    for (int j = 0; j < 16; ++j) v[j] = __builtin_nontemporal_load((const f32x4*)(p + (size_t)j * N));
}
__device__ __forceinline__ void cvt_half_to_lds(int half, int lane, const f32x4 (&v)[16], LAS unsigned char* tl, float sc) {
    const int kq = lane >> 4, nq = lane & 15;
#pragma unroll
    for (int i = 0; i < 4; ++i) { u32x4 w;
        w.x = pk4_fp8(v[0][i] * sc, v[1][i] * sc, v[2][i] * sc, v[3][i] * sc); w.y = pk4_fp8(v[4][i] * sc, v[5][i] * sc, v[6][i] * sc, v[7][i] * sc);
        w.z = pk4_fp8(v[8][i] * sc, v[9][i] * sc, v[10][i] * sc, v[11][i] * sc); w.w = pk4_fp8(v[12][i] * sc, v[13][i] * sc, v[14][i] * sc, v[15][i] * sc);
        *(LAS u32x4*)(tl + (4 * nq + i) * 144 + half * 64 + kq * 16) = w; }
}
template <int KB> __device__ __forceinline__ void cvt_flush(const CvtPair& c, int lane, LAS unsigned char* tl) {
    LDS_WAIT(); asm volatile("" ::: "memory");
    const int ch = lane & 7, r = lane >> 3;
#pragma unroll
    for (int j = 0; j < 8; ++j) { const int n = 8 * j + r; const u32x4 w = *(const LAS u32x4*)(tl + n * 144 + ch * 16); __builtin_nontemporal_store(w, (u32x4*)(c.dst + (size_t)n * KB + 16 * ch)); }
    LDS_WAIT(); asm volatile("" ::: "memory");
}
template <bool GU> __device__ __forceinline__ void expert_convert_set(Ctx& X, int gw, int NGW, LAS unsigned char* tl) {
    constexpr int NIT = GU ? NEX * 64 : NEX * 32, N = GU ? 512 : 1024, K = GU ? 1024 : 256; constexpr float SC = GU ? WGU_SCALE : WD_SCALE;
    if (gw >= NIT) return;
    const int nmine = (NIT - gw + NGW - 1) / NGW;
    f32x4 va[16], vb[16];
    CvtPair cur = cvt_pair<GU>(X, gw);
    cvt_load_half<N>(cur, 0, X.lane, va); cvt_load_half<N>(cur, 1, X.lane, vb);
    for (int j = 0; j < nmine; ++j) {
        const CvtPair nxt = cvt_pair<GU>(X, gw + (j + 1 < nmine ? j + 1 : j) * NGW);
        __builtin_amdgcn_sched_barrier(0);
        cvt_half_to_lds(0, X.lane, va, tl, SC);
        __builtin_amdgcn_sched_barrier(0);
        cvt_load_half<N>(nxt, 0, X.lane, va);
        __builtin_amdgcn_sched_barrier(0);
        cvt_half_to_lds(1, X.lane, vb, tl, SC);
        cvt_flush<K>(cur, X.lane, tl);
        __builtin_amdgcn_sched_barrier(0);
        cvt_load_half<N>(nxt, 1, X.lane, vb);
        __builtin_amdgcn_sched_barrier(0);
        cur = nxt;
    }
}
__device__ __forceinline__ void expert_convert(Ctx& X, int cw, int ncw) {
    LAS unsigned char* tl = X.lds + X.wave * 16384;
    const int gw = cw * NWAVES + X.wave, NGW = ncw * NWAVES;
    expert_convert_set<true>(X, gw, NGW, tl);
    expert_convert_set<false>(X, gw, NGW, tl);
}

__device__ __forceinline__ void small_transposes(Ctx& X) {
    LAS float* scr = (LAS float*)(X.lds + 16384 + X.wave * 12288);
    const int gw = X.wg * NWAVES + X.wave, NGW = X.G * NWAVES;
    {
        constexpr int I_IN = 16 * 272, I_PA = 8 * 32, I_PB = 8 * 32, I_OUT = 16 * 32, I_R = 16 * 8;
        constexpr int NITEMS = I_IN + I_PA + I_PB + I_OUT + I_R;
        for (int it = gw; it < NITEMS; it += NGW) {
            int r = it;
            if (r < I_IN) { transpose_plain(X.w_in, 1024, INW, WSP(bf16_t, WS_WIN), r, scr, X.lane); continue; } r -= I_IN;
            if (r < I_PA) { transpose_plain(X.w_pa, 512, 1024, WSP(bf16_t, WS_WPA), r, scr, X.lane); continue; } r -= I_PA;
            if (r < I_PB) { transpose_plain(X.w_pb, 512, 1024, WSP(bf16_t, WS_WPB), r, scr, X.lane); continue; } r -= I_PB;
            if (r < I_OUT) { transpose_plain(X.w_out, 1024, 1024, WSP(bf16_t, WS_WOUT), r, scr, X.lane); continue; } r -= I_OUT;
            transpose_plain(X.w_router, 1024, 256, WSP(bf16_t, WS_WR), r, scr, X.lane);
        }
    }
}

__device__ __forceinline__ void norm_rows(Ctx& X, int which) {
    LAS float* sm = (LAS float*)X.lds;
    const float* MODP = WSP(float, WS_MODP); float* MOD = WSP(float, WS_MOD);
    const int rows_per_wg = T / X.G, row0 = X.wg * rows_per_wg, b = row0 / SEQ;
    if (which == 0) {
        for (int i = X.tid; i < 2048; i += NTHREADS) { const int j = b * 6144 + i; float s = X.b_ada[i];
#pragma unroll
            for (int p = 0; p < 16; ++p) s += MODP[(size_t)p * 24576 + j];
            sm[i] = s; }
        const int per = 24576 / X.G;
        for (int i = X.tid; i < per; i += NTHREADS) { const int j = X.wg * per + i; float s = X.b_ada[j % 6144];
#pragma unroll
            for (int p = 0; p < 16; ++p) s += MODP[(size_t)p * 24576 + j];
            MOD[j] = s; }
    } else {
        for (int i = X.tid; i < 2048; i += NTHREADS) sm[i] = MOD[b * 6144 + 3072 + i];
    }
    __syncthreads();
    const float* src = X.x; const bf16_t* srcb = WSP(bf16_t, WS_X1); const float* g = which == 0 ? X.g1 : X.g2;
    bf16_t* H = WSP(bf16_t, WS_H);
    for (int r = X.wave; r < rows_per_wg; r += NWAVES) {
        const int row = row0 + r;
        f32x4 v[2][2]; float s = 0.f;
#pragma unroll
        for (int j = 0; j < 2; ++j) { const int col = 8 * X.lane + 512 * j;
            if (which == 0) { v[j][0] = *(const f32x4*)(src + (size_t)row * D + col); v[j][1] = *(const f32x4*)(src + (size_t)row * D + col + 4); }
            else { const u32x4 wv = *(const u32x4*)(srcb + (size_t)row * D + col); v[j][0] = (f32x4){bflo(wv.x), bfhi(wv.x), bflo(wv.y), bfhi(wv.y)}; v[j][1] = (f32x4){bflo(wv.z), bfhi(wv.z), bflo(wv.w), bfhi(wv.w)}; }
#pragma unroll
            for (int q = 0; q < 2; ++q) s += (v[j][q].x * v[j][q].x + v[j][q].y * v[j][q].y) + (v[j][q].z * v[j][q].z + v[j][q].w * v[j][q].w); }
        const float rstd = rsqrtf(wave_sum(s) * (1.f / D) + EPS);
#pragma unroll
        for (int j = 0; j < 2; ++j) { const int col = 8 * X.lane + 512 * j; float y[8];
#pragma unroll
            for (int q = 0; q < 2; ++q) { const f32x4 gg = *(const f32x4*)(g + col + 4 * q), sh = *(const LAS f32x4*)(sm + col + 4 * q), sc = *(const LAS f32x4*)(sm + 1024 + col + 4 * q);
#pragma unroll
                for (int e = 0; e < 4; ++e) y[4 * q + e] = v[j][q][e] * rstd * gg[e] * (1.f + sc[e]) + sh[e]; }
            u32x4 hw; hw.x = pk2(y[0], y[1]); hw.y = pk2(y[2], y[3]); hw.z = pk2(y[4], y[5]); hw.w = pk2(y[6], y[7]);
            if (which == 1) { st_wt16(H + (size_t)row * D + col, hw);
                st_wt8(WSP(unsigned char, WS_H8) + (size_t)row * D + col, (unsigned long long)pk4_fp8(y[0], y[1], y[2], y[3]) | ((unsigned long long)pk4_fp8(y[4], y[5], y[6], y[7]) << 32)); }
            else *(u32x4*)(H + (size_t)row * D + col) = hw; }
    }
    __syncthreads();
}

struct RegSched {
    static constexpr bool HALFSKIP = false;
    const char* A; const char* Bt; size_t a_tile, b_tile; int nM, nN, G, c;
    __device__ __forceinline__ bool next(int i, pg8::Unit& u) const {
        const int L = i * G + c; if (L >= nM * nN) return false;
        int pm, pn; pg8::swz_tile(L, nM, nN, pm, pn);
        u.a = A + (size_t)pm * a_tile; u.b = Bt + (size_t)pn * b_tile; u.rows = nullptr; u.pm = pm; u.pn = pn; u.aux = 0; u.nvalid = 256; return true;
    }
};
struct TwoPartSched {      static constexpr bool HALFSKIP = false;
    const char* Y; const char* Wa; const char* Wb; int nM, nN, G, c;
    __device__ __forceinline__ bool next(int i, pg8::Unit& u) const {
        const int L = (i >> 1) * G + c, part = i & 1; if (L >= nM * nN) return false;
        int pm, pn; pg8::swz_tile(L, nM, nN, pm, pn);
        u.a = Y + (size_t)pm * 256 * 2048 + part * 1024; u.b = (part ? Wb : Wa) + (size_t)pn * 256 * 1024; u.rows = nullptr; u.pm = pm; u.pn = pn; u.aux = part; u.nvalid = 256; return true;
    }
};
struct MoeSched {
    static constexpr bool HALFSKIP = true;
    const LAS int* tbl; const LAS int* cnts; int nent; const char* A; const char* W; const int* lists; int ncol  , wtile  , wexp  , atile  , G, c;
    __device__ __forceinline__ bool next(int i, pg8::Unit& u) const {
        const int un = i * (G >> 3) + (c >> 3); if (un >= nent * ncol) return false;
        const int pn = un % ncol; const int ent = __builtin_amdgcn_readfirstlane(tbl[un / ncol]), e = (ent >> 7) & 511, r = ent & 127, rt = ent >> 16;
        u.a = A + (size_t)rt * atile; u.b = W + (size_t)e * wexp + (size_t)pn * wtile; u.rows = lists + (size_t)e * 16384 + r * 256;
        u.pm = rt; u.pn = pn; u.aux = e; const int left = __builtin_amdgcn_readfirstlane(cnts[e]) - r * 256; u.nvalid = left < 256 ? left : 256; return true;
    }
};

struct EpiInproj {
    static constexpr bool PERM = true;
    bf16_t* PROJ; float* LOGF; const float* LB; const float* ROPE;
    __device__ __forceinline__ bool keep(const pg8::Unit&) const { return false; }
    __device__ __forceinline__ void operator()(f32x4 (&acc)[2][2][4][2], const pg8::Unit& u, int wr, int wc, int fr, int fq) const {
        const int pn = u.pn;
        const int mode = pn < 2 ? 0 : pn < 4 ? 1 : pn < 6 ? 0 : pn < 8 ? 2 : pn < 20 ? 3 : pn < 26 ? 0 : 4;
        const int row0 = u.pm * 256 + wr * 64 + fr, colb = pn * 256 + wc * 32 + 8 * fq;
        const bool rot = (mode == 3) && ((wc & 1) == 0);
#pragma unroll
        for (int ai = 0; ai < 2; ++ai)
#pragma unroll
            for (int m = 0; m < 4; ++m) {
                const int row = row0 + ai * 128 + m * 16;
                f32x4 cs0, cs1, sn0, sn1;
                if (rot) { const f32x4* rp = (const f32x4*)(ROPE + (size_t)row * 16); cs0 = rp[0]; cs1 = rp[1]; sn0 = rp[2]; sn1 = rp[3]; }
#pragma unroll
                for (int bj = 0; bj < 2; ++bj) {
                    const int col = colb + bj * 128;
                    f32x4 v0 = acc[ai][bj][m][0], v1 = acc[ai][bj][m][1];
                    if (mode == 1) {
                        const int cf = col - 512; const f32x4 l0 = *(const f32x4*)(LB + cf), l1 = *(const f32x4*)(LB + cf + 4);
                        f32x4 lf0, lf1;
#pragma unroll
                        for (int j = 0; j < 4; ++j) { float sg = sigmoidf_(v0[j]); float f = l0[j] + (1.f - l0[j]) * sg; lf0[j] = __logf(f); v0[j] = (1.f - l0[j]) * (1.f - sg);
                            sg = sigmoidf_(v1[j]); f = l1[j] + (1.f - l1[j]) * sg; lf1[j] = __logf(f); v1[j] = (1.f - l1[j]) * (1.f - sg); }
                        acc[ai][bj][m][0] = lf0; acc[ai][bj][m][1] = lf1;
                    } else if (mode == 2) {
#pragma unroll
                        for (int j = 0; j < 4; ++j) { v0[j] = v0[j] * sigmoidf_(v0[j]); v1[j] = v1[j] * sigmoidf_(v1[j]); }
                    } else if (mode == 4) {
#pragma unroll
                        for (int j = 0; j < 4; ++j) { v0[j] = sigmoidf_(v0[j]); v1[j] = sigmoidf_(v1[j]); }
                    } else if (rot) {
                        f32x4 p0, p1;
#pragma unroll
                        for (int j = 0; j < 4; ++j) { p0[j] = __shfl_xor(v0[j], 16); p1[j] = __shfl_xor(v1[j], 16); }
                        if (fq == 0) { v0 = v0 * cs0 - p0 * sn0; v1 = v1 * cs1 - p1 * sn1; }
                        else if (fq == 1) { v0 = v0 * cs0 + p0 * sn0; v1 = v1 * cs1 + p1 * sn1; }
                    }
                    u32x4 w; w.x = pg8::cvt_pk_bf16(v0[0], v0[1]); w.y = pg8::cvt_pk_bf16(v0[2], v0[3]); w.z = pg8::cvt_pk_bf16(v1[0], v1[1]); w.w = pg8::cvt_pk_bf16(v1[2], v1[3]);
                    *(u32x4*)(PROJ + (size_t)row * INW + col) = w;
                }
            }
        if (mode == 1) {
            const int lane = fq * 16 + fr;
#pragma unroll
            for (int ai = 0; ai < 2; ++ai)
#pragma unroll
                for (int bj = 0; bj < 2; ++bj)
#pragma unroll
                    for (int n = 0; n < 2; ++n)
#pragma unroll
                        for (int j = 0; j < 4; ++j) { float carry = 0.f;
#pragma unroll
                            for (int m = 0; m < 4; ++m) { float v = acc[ai][bj][m][n][j];
                                v += __builtin_bit_cast(float, __builtin_amdgcn_update_dpp(0, __builtin_bit_cast(int, v), 0x111, 0xF, 0xF, true));
                                v += __builtin_bit_cast(float, __builtin_amdgcn_update_dpp(0, __builtin_bit_cast(int, v), 0x112, 0xF, 0xF, true));
                                v += __builtin_bit_cast(float, __builtin_amdgcn_update_dpp(0, __builtin_bit_cast(int, v), 0x114, 0xF, 0xF, true));
                                v += __builtin_bit_cast(float, __builtin_amdgcn_update_dpp(0, __builtin_bit_cast(int, v), 0x118, 0xF, 0xF, true));
                                v += carry; acc[ai][bj][m][n][j] = v; carry = __shfl(v, (lane & 48) | 15); } }
#pragma unroll
            for (int ai = 0; ai < 2; ++ai)
#pragma unroll
                for (int m = 0; m < 4; ++m)
#pragma unroll
                    for (int bj = 0; bj < 2; ++bj) { float* lp = LOGF + (size_t)(row0 + ai * 128 + m * 16) * 512 + (colb + bj * 128 - 512); *(f32x4*)lp = acc[ai][bj][m][0]; *(f32x4*)(lp + 4) = acc[ai][bj][m][1]; }
        }
    }
};
struct EpiMixed {
    static constexpr bool PERM = true;
    const bf16_t* PROJ; bf16_t* MIXED;
    __device__ __forceinline__ bool keep(const pg8::Unit& u) const { return u.aux == 0; }
    __device__ __forceinline__ void operator()(f32x4 (&acc)[2][2][4][2], const pg8::Unit& u, int wr, int wc, int fr, int fq) const {
        const int row0 = u.pm * 256 + wr * 64 + fr, colb = u.pn * 256 + wc * 32 + 8 * fq;
#pragma unroll
        for (int ai = 0; ai < 2; ++ai)
#pragma unroll
            for (int m = 0; m < 4; ++m) {
                const int row = row0 + ai * 128 + m * 16;
#pragma unroll
                for (int bj = 0; bj < 2; ++bj) {
                    const int col = colb + bj * 128;
                    const u32x4 gb = *(const u32x4*)(PROJ + (size_t)row * INW + C_GB + col);
                    f32x4 b0 = {bflo(gb.x), bfhi(gb.x), bflo(gb.y), bfhi(gb.y)}, b1 = {bflo(gb.z), bfhi(gb.z), bflo(gb.w), bfhi(gb.w)};
                    if (u.aux == 0) {
                        const u32x4 ga = *(const u32x4*)(PROJ + (size_t)row * INW + C_GA + col);
                        f32x4 a0 = {bflo(ga.x), bfhi(ga.x), bflo(ga.y), bfhi(ga.y)}, a1 = {bflo(ga.z), bfhi(ga.z), bflo(ga.w), bfhi(ga.w)};
#pragma unroll
                        for (int j = 0; j < 4; ++j) { acc[ai][bj][m][0][j] *= a0[j] / b0[j]; acc[ai][bj][m][1][j] *= a1[j] / b1[j]; }
                    } else {
                        const f32x4 v0 = acc[ai][bj][m][0] * b0, v1 = acc[ai][bj][m][1] * b1;
                        u32x4 w; w.x = pg8::cvt_pk_bf16(v0[0], v0[1]); w.y = pg8::cvt_pk_bf16(v0[2], v0[3]); w.z = pg8::cvt_pk_bf16(v1[0], v1[1]); w.w = pg8::cvt_pk_bf16(v1[2], v1[3]);
                        st_wt16(MIXED + (size_t)row * D + col, w);
                    }
                }
            }
    }
};
struct EpiOutproj {
    static constexpr bool PERM = true;
    const float* x; const float* MOD; bf16_t* X1;
    __device__ __forceinline__ bool keep(const pg8::Unit&) const { return false; }
    __device__ __forceinline__ void operator()(f32x4 (&acc)[2][2][4][2], const pg8::Unit& u, int wr, int wc, int fr, int fq) const {
        const int row0 = u.pm * 256 + wr * 64 + fr, colb = u.pn * 256 + wc * 32 + 8 * fq;
        const int b = (u.pm * 256) / SEQ;
#pragma unroll
        for (int bj = 0; bj < 2; ++bj) {
            const int col = colb + bj * 128;
            const f32x4 g0 = *(const f32x4*)(MOD + b * 6144 + 2048 + col), g1 = *(const f32x4*)(MOD + b * 6144 + 2048 + col + 4);
#pragma unroll
            for (int ai = 0; ai < 2; ++ai)
#pragma unroll
                for (int m = 0; m < 4; ++m) { const size_t off = (size_t)(row0 + ai * 128 + m * 16) * D + col;
                    const f32x4 v0 = *(const f32x4*)(x + off) + g0 * acc[ai][bj][m][0], v1 = *(const f32x4*)(x + off + 4) + g1 * acc[ai][bj][m][1];
                    u32x4 w; w.x = pg8::cvt_pk_bf16(v0[0], v0[1]); w.y = pg8::cvt_pk_bf16(v0[2], v0[3]); w.z = pg8::cvt_pk_bf16(v1[0], v1[1]); w.w = pg8::cvt_pk_bf16(v1[2], v1[3]);
                    st_wt16(X1 + off, w); }
        }
    }
};
struct EpiOutNorm {
    static constexpr bool PERM = true;
    const float* x; const float* MOD; const float* g2; bf16_t* X1; bf16_t* H; unsigned char* H8; float* XB; unsigned* cnt; LAS unsigned char* sl;
    __device__ __forceinline__ bool keep(const pg8::Unit&) const { return false; }
    __device__ __forceinline__ void operator()(f32x4 (&acc)[2][2][4][2], const pg8::Unit& u, int wr, int wc, int fr, int fq) const {
        const int tid = threadIdx.x;
        const int rl0 = wr * 64 + fr, row0 = u.pm * 256 + rl0, colb = u.pn * 256 + wc * 32 + 8 * fq;
        const int b = (u.pm * 256) / SEQ;
        LAS float* Pt = (LAS float*)sl; LAS float* Rs = (LAS float*)(sl + 4096);
#pragma unroll
        for (int bj = 0; bj < 2; ++bj) {
            const int col = colb + bj * 128;
            const f32x4 g0 = *(const f32x4*)(MOD + b * 6144 + 2048 + col), g1 = *(const f32x4*)(MOD + b * 6144 + 2048 + col + 4);
#pragma unroll
            for (int ai = 0; ai < 2; ++ai)
#pragma unroll
                for (int m = 0; m < 4; ++m) { const size_t off = (size_t)(row0 + ai * 128 + m * 16) * D + col;
                    acc[ai][bj][m][0] = *(const f32x4*)(x + off) + g0 * acc[ai][bj][m][0]; acc[ai][bj][m][1] = *(const f32x4*)(x + off + 4) + g1 * acc[ai][bj][m][1];
                    asm volatile("" : "+v"(acc[ai][bj][m][0]), "+v"(acc[ai][bj][m][1]));
                    if (m & 1) asm volatile("" ::: "memory"); }
        }
#pragma unroll
        for (int ai = 0; ai < 2; ++ai)
#pragma unroll
            for (int m = 0; m < 4; ++m) { float q = 0.f;
#pragma unroll
                for (int bj = 0; bj < 2; ++bj)
#pragma unroll
                    for (int n = 0; n < 2; ++n) { const f32x4 v = acc[ai][bj][m][n]; q += (v[0] * v[0] + v[1] * v[1]) + (v[2] * v[2] + v[3] * v[3]); }
                q += __shfl_xor(q, 16); q += __shfl_xor(q, 32);
                if (fq == 0) Pt[(ai * 128 + rl0 + m * 16) * 4 + wc] = q; }
        asm volatile("s_waitcnt lgkmcnt(0)" ::: "memory"); __builtin_amdgcn_s_barrier(); asm volatile("" ::: "memory");
        if (tid < 256) { const f32x4 p = *(const LAS f32x4*)(Pt + tid * 4); st_wt4(XB + ((size_t)u.pm * 256 + tid) * 4 + u.pn, __builtin_bit_cast(unsigned, (p[0] + p[1]) + (p[2] + p[3]))); }
        asm volatile("s_waitcnt vmcnt(0)" ::: "memory"); __builtin_amdgcn_s_barrier(); asm volatile("" ::: "memory");
        if (tid == 0) { unsigned* p = cnt + (size_t)u.pm * 64; (void)xb_add(p, 1u); unsigned sp = 0u;
            while (xb_ld(p) < 4u) { __builtin_amdgcn_s_sleep(2); if (++sp > (1u << 22)) break; }
            __builtin_amdgcn_fence(__ATOMIC_ACQUIRE, "agent"); asm volatile("s_waitcnt vmcnt(0)" ::: "memory"); }
        __builtin_amdgcn_s_barrier(); asm volatile("" ::: "memory");
        if (tid < 256) { const f32x4 q = *(const f32x4*)(XB + ((size_t)u.pm * 256 + tid) * 4); Rs[tid] = rsqrtf(((q[0] + q[1]) + (q[2] + q[3])) * (1.f / D) + EPS); }
        asm volatile("s_waitcnt vmcnt(0) lgkmcnt(0)" ::: "memory"); __builtin_amdgcn_s_barrier(); asm volatile("" ::: "memory");
#pragma unroll
        for (int bj = 0; bj < 2; ++bj) {
            const int col = colb + bj * 128;
            f32x4 gg[2], sc[2], sh[2];
#pragma unroll
            for (int q = 0; q < 2; ++q) { gg[q] = *(const f32x4*)(g2 + col + 4 * q); sh[q] = *(const f32x4*)(MOD + b * 6144 + 3072 + col + 4 * q); sc[q] = *(const f32x4*)(MOD + b * 6144 + 4096 + col + 4 * q) + 1.0f; gg[q] = gg[q] * sc[q]; }
#pragma unroll
            for (int ai = 0; ai < 2; ++ai)
#pragma unroll
                for (int m = 0; m < 4; ++m) { const int rl = ai * 128 + rl0 + m * 16; const size_t off = (size_t)(u.pm * 256 + rl) * D + col; const float rs = Rs[rl];
                    const f32x4 v0 = acc[ai][bj][m][0], v1 = acc[ai][bj][m][1];
                    u32x4 w; w.x = pg8::cvt_pk_bf16(v0[0], v0[1]); w.y = pg8::cvt_pk_bf16(v0[2], v0[3]); w.z = pg8::cvt_pk_bf16(v1[0], v1[1]); w.w = pg8::cvt_pk_bf16(v1[2], v1[3]);
                    *(u32x4*)(X1 + off) = w;
                    const f32x4 h0 = v0 * rs * gg[0] + sh[0], h1 = v1 * rs * gg[1] + sh[1];
                    u32x4 hw; hw.x = pg8::cvt_pk_bf16(h0[0], h0[1]); hw.y = pg8::cvt_pk_bf16(h0[2], h0[3]); hw.z = pg8::cvt_pk_bf16(h1[0], h1[1]); hw.w = pg8::cvt_pk_bf16(h1[2], h1[3]);
                    st_wt16(H + off, hw);
                    st_wt8(H8 + off, (unsigned long long)pk4_fp8(h0[0], h0[1], h0[2], h0[3]) | ((unsigned long long)pk4_fp8(h1[0], h1[1], h1[2], h1[3]) << 32));
                    asm volatile("" ::: "memory"); }
        }
    }
};
struct EpiRouter {
    static constexpr bool PERM = false;
    float* LOGITS4;
    __device__ __forceinline__ bool keep(const pg8::Unit&) const { return false; }
    __device__ __forceinline__ void operator()(f32x4 (&acc)[2][2][4][2], const pg8::Unit& u, int wr, int wc, int fr, int fq) const {
        const int row0 = u.pm * 256 + wr * 64 + fr, colb = wc * 32 + 4 * fq;
        float* base = LOGITS4 + (size_t)u.aux * T * 256;
#pragma unroll
        for (int ai = 0; ai < 2; ++ai)
#pragma unroll
            for (int m = 0; m < 4; ++m)
#pragma unroll
                for (int bj = 0; bj < 2; ++bj)
#pragma unroll
                    for (int n = 0; n < 2; ++n) st_wt16(base + (size_t)(row0 + ai * 128 + m * 16) * 256 + colb + bj * 128 + n * 16, __builtin_bit_cast(u32x4, acc[ai][bj][m][n]));
    }
};
struct RouterSched {
    static constexpr bool HALFSKIP = false;
    const char* A; const char* Bt; int G, c;
    __device__ __forceinline__ bool next(int i, pg8::Unit& u) const {
        const int L = i * G + c; if (L >= 256) return false;
        const int pm = L >> 2, ks = L & 3;
        u.a = A + (size_t)pm * 256 * 2048 + ks * 512; u.b = Bt + ks * 512; u.rows = nullptr; u.pm = pm; u.pn = 0; u.aux = ks; u.nvalid = 256; return true;
    }
};
struct EpiGU {
    static constexpr bool PERM = true;
    unsigned char* ACT;
    __device__ __forceinline__ bool keep(const pg8::Unit&) const { return false; }
    __device__ __forceinline__ void operator()(f32x4 (&acc)[2][2][4][2], const pg8::Unit& u, int wr, int wc, int fr, int fq) const {
        const int rl0 = wr * 64 + fr, col = u.pn * 128 + wc * 32 + 8 * fq;
        constexpr float is = 1.0f / WGU_SCALE;
#pragma unroll
        for (int ai = 0; ai < 2; ++ai)
#pragma unroll
            for (int m = 0; m < 4; ++m) {
                const int rl = rl0 + ai * 128 + m * 16;
                f32x4 v0, v1;
#pragma unroll
                for (int j = 0; j < 4; ++j) { const float a0 = acc[ai][0][m][0][j] * is, a1 = acc[ai][0][m][1][j] * is;
                    v0[j] = a0 * sigmoidf_(a0) * (acc[ai][1][m][0][j] * is); v1[j] = a1 * sigmoidf_(a1) * (acc[ai][1][m][1][j] * is); }
                *(u32x2*)(ACT + ((size_t)u.pm * 256 + rl) * EFF + col) = (u32x2){pk4_fp8(v0[0], v0[1], v0[2], v0[3]), pk4_fp8(v1[0], v1[1], v1[2], v1[3])};
                asm volatile("" ::: "memory");
            }
    }
};
struct EpiDown {
    static constexpr bool PERM = true;
    unsigned char* YBUF; const float* GATEW;
    __device__ __forceinline__ bool keep(const pg8::Unit&) const { return false; }
    __device__ __forceinline__ void operator()(f32x4 (&acc)[2][2][4][2], const pg8::Unit& u, int wr, int wc, int fr, int fq) const {
        const int rl0 = wr * 64 + fr, colb = u.pn * 256 + wc * 32 + 8 * fq;
#pragma unroll
        for (int ai = 0; ai < 2; ++ai)
#pragma unroll
            for (int m = 0; m < 4; ++m) {
                const int rl = rl0 + ai * 128 + m * 16;
                if (rl < u.nvalid) {
                    const int slot = u.rows[rl]; const float gw = GATEW[slot] * (YSCALE / WD_SCALE);
#pragma unroll
                    for (int bj = 0; bj < 2; ++bj) { const f32x4 v0 = acc[ai][bj][m][0] * gw, v1 = acc[ai][bj][m][1] * gw;
                        *(u32x2*)(YBUF + (size_t)slot * D + colb + bj * 128) = (u32x2){pk4_fp8(v0[0], v0[1], v0[2], v0[3]), pk4_fp8(v1[0], v1[1], v1[2], v1[3])}; }
                }
                asm volatile("" ::: "memory");
            }
    }
};

#define MFMA16(a, b, c) __builtin_amdgcn_mfma_f32_16x16x32_bf16((a), (b), (c), 0, 0, 0)
#define MFMA32(a, b, c) __builtin_amdgcn_mfma_f32_32x32x16_bf16((a), (b), (c), 0, 0, 0)
__device__ __forceinline__ s16x4 tr16(const LAS unsigned char* p) { return __builtin_amdgcn_ds_read_tr16_b64_v4i16((LAS s16x4*)p); }
__device__ __forceinline__ bf16x8 cat8(s16x4 a, s16x4 b) { bf16x8 r; r[0] = a[0]; r[1] = a[1]; r[2] = a[2]; r[3] = a[3]; r[4] = b[0]; r[5] = b[1]; r[6] = b[2]; r[7] = b[3]; return r; }
__device__ __forceinline__ u32x4 pack8(const float (&v)[8]) { u32x4 w; w.x = pg8::cvt_pk_bf16(v[0], v[1]); w.y = pg8::cvt_pk_bf16(v[2], v[3]); w.z = pg8::cvt_pk_bf16(v[4], v[5]); w.w = pg8::cvt_pk_bf16(v[6], v[7]); return w; }
__device__ __forceinline__ void unpack8(u32x4 w, float (&v)[8]) { v[0] = bflo(w.x); v[1] = bfhi(w.x); v[2] = bflo(w.y); v[3] = bfhi(w.y); v[4] = bflo(w.z); v[5] = bfhi(w.z); v[6] = bflo(w.w); v[7] = bfhi(w.w); }
__device__ __forceinline__ int swzA(int row) { return (row & 3) | (((row >> 3) & 1) << 2); }
__device__ __forceinline__ void hgrn_kv_unit(Ctx& X, int bn) {
    const int t0 = bn * 64;
    const bf16_t* PROJ = WSP(bf16_t, WS_PROJ); const float* BC = WSP(float, WS_LOGF);
#pragma unroll 2
    for (int j = 0; j < 8; ++j) {
        const int p = X.tid + NTHREADS * j, row = p >> 6, c64 = p & 63, h = c64 >> 4, ch = c64 & 15;
        const size_t prow = (size_t)(t0 + row) * INW + h * 128 + 8 * ch;
        const u32x4 kraw = *(const u32x4*)(PROJ + prow + C_HK), vraw = *(const u32x4*)(PROJ + prow + C_HV);
        const float* bp = BC + (size_t)(t0 + row) * 512 + h * 128 + 8 * ch; const float* bl = BC + (size_t)(t0 + 63) * 512 + h * 128 + 8 * ch;
        const f32x4 b0 = *(const f32x4*)bp, b1 = *(const f32x4*)(bp + 4), l0 = *(const f32x4*)bl, l1 = *(const f32x4*)(bl + 4);
        float kv[8]; unpack8(kraw, kv);
#pragma unroll
        for (int e = 0; e < 4; ++e) { kv[e] *= __expf(l0[e] - b0[e]); kv[4 + e] *= __expf(l1[e] - b1[e]); }
        const int off = row * 256 + (((ch >> 1) ^ swzA(row)) * 32) + (ch & 1) * 16;
        *(LAS u32x4*)(X.lds + h * 32768 + off) = vraw; *(LAS u32x4*)(X.lds + h * 32768 + 16384 + off) = pack8(kv);
    }
    WSP(float, WS_DECAY)[bn * 512 + X.tid] = __expf(BC[(size_t)(t0 + 63) * 512 + X.tid]);
    __syncthreads();
    const int l = X.lane, w = X.wave, fr = l & 15, fq = l >> 4, r = fr >> 2, p4 = l & 3, h = w >> 1, vt0 = 4 * (w & 1);
    const LAS unsigned char* VI = X.lds + h * 32768; const LAS unsigned char* KI = VI + 16384;
    bf16x8 af[4][2];
#pragma unroll
    for (int vt = 0; vt < 4; ++vt)
#pragma unroll
        for (int kk = 0; kk < 2; ++kk) { const int r0 = 32 * kk + 8 * fq + r, r1 = r0 + 4;
            af[vt][kk] = cat8(tr16(VI + r0 * 256 + (((vt0 + vt) ^ swzA(r0)) * 32) + p4 * 8), tr16(VI + r1 * 256 + (((vt0 + vt) ^ swzA(r1)) * 32) + p4 * 8)); }
    bf16_t* KVT = WSP(bf16_t, WS_KVT) + (size_t)(bn * 4 + h) * 16384;
#pragma unroll 2
    for (int ct = 0; ct < 8; ++ct) {
        bf16x8 bfr[2];
#pragma unroll
        for (int kk = 0; kk < 2; ++kk) { const int r0 = 32 * kk + 8 * fq + r, r1 = r0 + 4;
            bfr[kk] = cat8(tr16(KI + r0 * 256 + ((ct ^ swzA(r0)) * 32) + p4 * 8), tr16(KI + r1 * 256 + ((ct ^ swzA(r1)) * 32) + p4 * 8)); }
#pragma unroll
        for (int vt = 0; vt < 4; ++vt) { f32x4 acc = {0.f, 0.f, 0.f, 0.f}; acc = MFMA16(bfr[0], af[vt][0], acc); acc = MFMA16(bfr[1], af[vt][1], acc);
            u32x2 wv; wv.x = pg8::cvt_pk_bf16(acc[0], acc[1]); wv.y = pg8::cvt_pk_bf16(acc[2], acc[3]);
            *(u32x2*)(KVT + (16 * (vt0 + vt) + fr) * 128 + 16 * ct + 4 * fq) = wv; }
    }
    __syncthreads();
}
__device__ __forceinline__ void hgrn_passB(Ctx& X) {
    const unsigned* KVT = WSP(unsigned, WS_KVT); const float* DECAY = WSP(float, WS_DECAY); unsigned* SPT = WSP(unsigned, WS_SPT);
    const int gt = X.wg * NTHREADS + X.tid, NGT = X.G * NTHREADS;
    for (int item = gt; item < 16 * 128 * 64; item += NGT) {
        const int bh = item >> 13, rem = item & 8191, vd = rem >> 6, c = (rem & 63) * 2, b = bh >> 2, h = bh & 3;
        float s0 = 0.f, s1 = 0.f;
#pragma unroll 8
        for (int n = 0; n < 64; ++n) {
            const int unit = (b * 64 + n) * 4 + h;
            const unsigned kw = KVT[((size_t)unit * 16384 + vd * 128 + c) >> 1]; const f32x2 kv = {bflo(kw), bfhi(kw)};
            const f32x2 dc = *(const f32x2*)(DECAY + unit * 128 + c);
            SPT[((size_t)unit * 16384 + vd * 128 + c) >> 1] = pk2(s0, s1);
            s0 = dc.x * s0 + kv.x; s1 = dc.y * s1 + kv.y;
        }
    }
}
__device__ __forceinline__ void hgrn_out_unit(Ctx& X, int u2) {
    const int bn = u2 >> 1, hp = u2 & 1, t0 = bn * 64;
    const bf16_t* PROJ = WSP(bf16_t, WS_PROJ); const float* BCg = WSP(float, WS_LOGF);
#pragma unroll 2
    for (int j = 0; j < 4; ++j) { const int p = X.tid + NTHREADS * j, row = p >> 5, c32 = p & 31, hh = c32 >> 4, ch = c32 & 15, h = 2 * hp + hh;
        const size_t prow = (size_t)(t0 + row) * INW + h * 128 + 8 * ch;
        const u32x4 qraw = *(const u32x4*)(PROJ + prow + C_HQ), kraw = *(const u32x4*)(PROJ + prow + C_HK), vraw = *(const u32x4*)(PROJ + prow + C_HV);
        const float* bp = BCg + (size_t)(t0 + row) * 512 + h * 128 + 8 * ch; const float* br = BCg + (size_t)(t0 + 32) * 512 + h * 128 + 8 * ch;
        const f32x4 b0 = *(const f32x4*)bp, b1 = *(const f32x4*)(bp + 4), r0 = *(const f32x4*)br, r1 = *(const f32x4*)(br + 4);
        float qv[8], kv[8], a[8], bq[8]; unpack8(qraw, qv); unpack8(kraw, kv);
#pragma unroll
        for (int e = 0; e < 4; ++e) { const float e0 = __expf(b0[e] - r0[e]), e1 = __expf(b1[e] - r1[e]);
            a[e] = qv[e] * e0; a[4 + e] = qv[4 + e] * e1; kv[e] *= __builtin_amdgcn_rcpf(e0); kv[4 + e] *= __builtin_amdgcn_rcpf(e1);
            bq[e] = qv[e] * __expf(b0[e]); bq[4 + e] = qv[4 + e] * __expf(b1[e]); }
        LAS unsigned char* hb = X.lds + hh * 65536; const int o16 = row * 256 + ((ch ^ (row & 15)) * 16);
        *(LAS u32x4*)(hb + o16) = pack8(a); *(LAS u32x4*)(hb + 16384 + o16) = pack8(kv); *(LAS u32x4*)(hb + 32768 + o16) = pack8(bq);
        *(LAS u32x4*)(hb + 49152 + row * 256 + (((ch >> 1) ^ (row & 7)) * 32) + (ch & 1) * 16) = vraw; }
    const int l = X.lane, w = X.wave, fr = l & 15, fq = l >> 4, r = fr >> 2, p4 = l & 3, hh = w >> 2, h = 2 * hp + hh, ti = w & 3;
    const int tq = 16 * ti + fr;
    const bf16_t* SPT = WSP(bf16_t, WS_SPT) + (size_t)(bn * 4 + h) * 16384;
    __syncthreads();
    const LAS unsigned char* QSI = X.lds + hh * 65536; const LAS unsigned char* KSI = QSI + 16384; const LAS unsigned char* QNI = QSI + 32768; const LAS unsigned char* VI = QSI + 49152;
    bf16x8 QS[4];
#pragma unroll
    for (int ks = 0; ks < 4; ++ks) QS[ks] = *(const LAS bf16x8*)(QSI + tq * 256 + (((4 * ks + fq) ^ (tq & 15)) * 16));
    f32x4 ST[4];
#pragma unroll
    for (int si = 0; si < 4; ++si) {
        f32x4 acc = {0.f, 0.f, 0.f, 0.f};
        if (si <= ti) {
            const int sr = 16 * si + fr;
#pragma unroll
            for (int ks = 0; ks < 4; ++ks) { const bf16x8 kf = *(const LAS bf16x8*)(KSI + sr * 256 + (((4 * ks + fq) ^ (sr & 15)) * 16)); acc = MFMA16(kf, QS[ks], acc); }
            if (si == ti) {
#pragma unroll
                for (int q = 0; q < 4; ++q) acc[q] = (4 * fq + q <= fr) ? acc[q] : 0.f; }
        }
        ST[si] = acc;
    }
    f32x4 o[8];
#pragma unroll
    for (int vt = 0; vt < 8; ++vt) o[vt] = (f32x4){0.f, 0.f, 0.f, 0.f};
#pragma unroll
    for (int kk = 0; kk < 2; ++kk) {
        if (2 * kk <= ti) {
            float pv[8];
#pragma unroll
            for (int q = 0; q < 4; ++q) { pv[q] = ST[2 * kk][q]; pv[4 + q] = ST[2 * kk + 1][q]; }
            const bf16x8 pf = __builtin_bit_cast(bf16x8, pack8(pv));
            const int r0 = 32 * kk + 4 * fq + r, r1 = r0 + 16;
#pragma unroll
            for (int vt = 0; vt < 8; ++vt) { const bf16x8 va = cat8(tr16(VI + r0 * 256 + ((vt ^ (r0 & 7)) * 32) + p4 * 8), tr16(VI + r1 * 256 + ((vt ^ (r1 & 7)) * 32) + p4 * 8));
                o[vt] = MFMA16(va, pf, o[vt]); }
        }
    }
#pragma unroll
    for (int ks = 0; ks < 4; ++ks) { const bf16x8 qn = *(const LAS bf16x8*)(QNI + tq * 256 + (((4 * ks + fq) ^ (tq & 15)) * 16));
#pragma unroll
        for (int vt = 0; vt < 8; ++vt) { const bf16x8 sa = *(const bf16x8*)(SPT + (16 * vt + fr) * 128 + 32 * ks + 8 * fq); o[vt] = MFMA16(sa, qn, o[vt]); } }
    float ss = 0.f;
#pragma unroll
    for (int vt = 0; vt < 8; ++vt) ss += (o[vt][0] * o[vt][0] + o[vt][1] * o[vt][1]) + (o[vt][2] * o[vt][2] + o[vt][3] * o[vt][3]);
    ss += __shfl_xor(ss, 16); ss += __shfl_xor(ss, 32);
    const float rstd = rsqrtf(ss * (1.f / 128.f) + EPS);
    bf16_t* YCAT = WSP(bf16_t, WS_YCAT);
#pragma unroll
    for (int vt = 0; vt < 8; ++vt) { const int vd = 16 * vt + 4 * fq;
        const u32x2 sg = *(const u32x2*)(PROJ + (size_t)(t0 + tq) * INW + C_HG + h * 128 + vd); const f32x4 gn = *(const f32x4*)(X.g_hgrn + h * 128 + vd);
        u32x2 wv; wv.x = pg8::cvt_pk_bf16(o[vt][0] * rstd * gn[0] * bflo(sg.x), o[vt][1] * rstd * gn[1] * bfhi(sg.x)); wv.y = pg8::cvt_pk_bf16(o[vt][2] * rstd * gn[2] * bflo(sg.y), o[vt][3] * rstd * gn[3] * bfhi(sg.y));
        *(u32x2*)(YCAT + (size_t)(t0 + tq) * D + h * 128 + vd) = wv; }
    __syncthreads();
}

struct AttnRegs { u32x4 k[6], v[6]; bf16x8 q[4]; };
__device__ __forceinline__ void attn_load(Ctx& X, int unit, AttnRegs& R) {
    const int u16 = unit & 15, h = (unit >> 4) & 7, g = (unit >> 7) % 3, b = unit / 384;
    const int d = g == 0 ? 1 : g == 1 ? 4 : 16, nblk = 16 / d, r = u16 / nblk, blk = u16 % nblk;
    const int qcol = C_AQ + g * 512 + h * 64, kcol = C_AK + g * 512 + h * 64, vcol = C_AV + g * 512 + h * 64;
    const int mk0 = blk * 256 - 128;
    const bf16_t* PROJ = WSP(bf16_t, WS_PROJ);
#pragma unroll
    for (int j = 0; j < 6; ++j) { const int idx = X.tid + NTHREADS * j, row = idx >> 3, ch = idx & 7, m = mk0 + row;
        R.k[j] = (u32x4){0u, 0u, 0u, 0u}; R.v[j] = (u32x4){0u, 0u, 0u, 0u};
        if (m >= 0) { const size_t tok = (size_t)b * SEQ + (size_t)m * d + r; R.k[j] = *(const u32x4*)(PROJ + tok * INW + kcol + ch * 8); R.v[j] = *(const u32x4*)(PROJ + tok * INW + vcol + ch * 8); } }
    const int l = X.lane, w = X.wave, q = l & 31, hi = l >> 5;
    const size_t tokq = (size_t)b * SEQ + (size_t)(blk * 256 + 32 * w + q) * d + r;
#pragma unroll
    for (int ds = 0; ds < 4; ++ds) R.q[ds] = *(const bf16x8*)(PROJ + tokq * INW + qcol + ds * 16 + hi * 8);
}
__device__ __forceinline__ void attn_stage(Ctx& X, const AttnRegs& R) {
    LAS unsigned char* KL = X.lds; LAS unsigned char* VL = X.lds + 55296;
#pragma unroll
    for (int j = 0; j < 6; ++j) { const int idx = X.tid + NTHREADS * j, row = idx >> 3, ch = idx & 7;
        *(LAS u32x4*)(KL + row * 144 + ch * 16) = R.k[j]; *(LAS u32x4*)(VL + row * 128 + ch * 16) = R.v[j]; }
}
__device__ __forceinline__ void attn_compute(Ctx& X, int unit, const bf16x8 (&qf)[4]) {
    const int u16 = unit & 15, h = (unit >> 4) & 7, g = (unit >> 7) % 3, b = unit / 384;
    const int d = g == 0 ? 1 : g == 1 ? 4 : 16, nblk = 16 / d, r = u16 / nblk, blk = u16 % nblk;
    const int mk0 = blk * 256 - 128;
    LAS unsigned char* KL = X.lds; LAS unsigned char* VL = X.lds + 55296;
    const int l = X.lane, w = X.wave, q = l & 31, hi = l >> 5;
    const size_t tokq = (size_t)b * SEQ + (size_t)(blk * 256 + 32 * w + q) * d + r;
    f32x16 s[5];
#pragma unroll
    for (int kt = 0; kt < 5; ++kt) {
        f32x16 acc;
#pragma unroll
        for (int i = 0; i < 16; ++i) acc[i] = 0.f;
#pragma unroll
        for (int ds = 0; ds < 4; ++ds) { const bf16x8 kf = *(const LAS bf16x8*)(KL + (32 * w + 32 * kt + q) * 144 + ds * 32 + hi * 16); acc = MFMA32(kf, qf[ds], acc); }
        s[kt] = acc;
    }
    const int iq = 32 * w + q;
    const int jmin = iq > -mk0 ? iq : -mk0; const unsigned jspan = (unsigned)(iq + 128 - jmin);
    float mx = -INFINITY;
#pragma unroll
    for (int kt = 0; kt < 5; ++kt)
#pragma unroll
        for (int rg = 0; rg < 16; ++rg) { const int j = 32 * w + 32 * kt + (rg & 3) + 8 * (rg >> 2) + 4 * hi;
            const bool valid = (unsigned)(j - jmin) <= jspan;
            s[kt][rg] = valid ? s[kt][rg] : -INFINITY; mx = fmaxf(mx, s[kt][rg]); if ((rg & 3) == 3) __builtin_amdgcn_sched_barrier(0); }
    mx = fmaxf(mx, __shfl_xor(mx, 32));
    const float c2 = 0.125f * 1.4426950408889634f;
    float lsum = 0.f;
#pragma unroll
    for (int kt = 0; kt < 5; ++kt)
#pragma unroll
        for (int rg = 0; rg < 16; ++rg) { const float p = exp2f((s[kt][rg] - mx) * c2); s[kt][rg] = p; lsum += p; }
    lsum += __shfl_xor(lsum, 32);
    f32x16 o[2];
#pragma unroll
    for (int dt = 0; dt < 2; ++dt)
#pragma unroll
        for (int i = 0; i < 16; ++i) o[dt][i] = 0.f;
    const int vlane = ((l & 15) >> 2) * 128 + (((l >> 4) & 1) * 16 + (l & 3) * 4) * 2;
#pragma unroll
    for (int kt = 0; kt < 5; ++kt)
#pragma unroll
        for (int s2 = 0; s2 < 2; ++s2) {
            bf16x8 pb;
#pragma unroll
            for (int j = 0; j < 8; j += 2) { const unsigned pw = pg8::cvt_pk_bf16(s[kt][8 * s2 + j], s[kt][8 * s2 + j + 1]); pb[j] = (short)(pw & 0xffffu); pb[j + 1] = (short)(pw >> 16); }
            const int key0 = 32 * w + 32 * kt + 16 * s2 + 4 * hi;
#pragma unroll
            for (int dt = 0; dt < 2; ++dt) {
                LAS unsigned char* vp = VL + key0 * 128 + dt * 64 + vlane;
                const s16x4 t0 = __builtin_amdgcn_ds_read_tr16_b64_v4i16((LAS s16x4*)vp);
                const s16x4 t1 = __builtin_amdgcn_ds_read_tr16_b64_v4i16((LAS s16x4*)(vp + 8 * 128));
                bf16x8 va; va[0] = t0[0]; va[1] = t0[1]; va[2] = t0[2]; va[3] = t0[3]; va[4] = t1[0]; va[5] = t1[1]; va[6] = t1[2]; va[7] = t1[3];
                o[dt] = MFMA32(va, pb, o[dt]);
            }
        }
    const float inv = 1.0f / lsum;
    bf16_t* OG = WSP(bf16_t, WS_OG) + (size_t)g * T * 512;
#pragma unroll
    for (int dt = 0; dt < 2; ++dt)
#pragma unroll
        for (int rg = 0; rg < 4; ++rg) { const int d0 = 32 * dt + 8 * rg + 4 * hi;
            u32x2 wv; wv.x = pg8::cvt_pk_bf16(o[dt][4 * rg] * inv, o[dt][4 * rg + 1] * inv); wv.y = pg8::cvt_pk_bf16(o[dt][4 * rg + 2] * inv, o[dt][4 * rg + 3] * inv);
            *(u32x2*)(OG + tokq * 512 + h * 64 + d0) = wv; }
    if (hi == 0) WSP(float, WS_LSE)[((size_t)g * T + tokq) * 8 + h] = mx * 0.125f + __logf(lsum);
}
__device__ __forceinline__ void attn_combine(Ctx& X) {
    const bf16_t* OG = WSP(bf16_t, WS_OG); const float* LSE = WSP(float, WS_LSE); bf16_t* YCAT = WSP(bf16_t, WS_YCAT);
    const int gt = X.wg * NTHREADS + X.tid, NGT = X.G * NTHREADS;
    for (int item = gt; item < T * 64; item += NGT) {
        const int t = item >> 6, ch = item & 63, h = ch >> 3;
        const float l0 = LSE[(size_t)t * 8 + h], l1 = LSE[((size_t)T + t) * 8 + h], l2 = LSE[((size_t)2 * T + t) * 8 + h];
        const float m = fmaxf(l0, fmaxf(l1, l2)); float w0 = __expf(l0 - m), w1 = __expf(l1 - m), w2 = __expf(l2 - m); const float inv = 1.f / (w0 + w1 + w2); w0 *= inv; w1 *= inv; w2 *= inv;
        const u32x4 a = *(const u32x4*)(OG + (size_t)t * 512 + ch * 8), bq = *(const u32x4*)(OG + ((size_t)T + t) * 512 + ch * 8), cq = *(const u32x4*)(OG + ((size_t)2 * T + t) * 512 + ch * 8);
        u32x4 o;
#pragma unroll
        for (int j = 0; j < 4; ++j) o[j] = pk2(w0 * bflo(a[j]) + w1 * bflo(bq[j]) + w2 * bflo(cq[j]), w0 * bfhi(a[j]) + w1 * bfhi(bq[j]) + w2 * bfhi(cq[j]));
        *(u32x4*)(YCAT + (size_t)t * D + 512 + ch * 8) = o;
    }
}

__device__ __forceinline__ unsigned sortable_key(float f) { const unsigned u = __builtin_bit_cast(unsigned, f); return (u & 0x80000000u) ? ~u : (u | 0x80000000u); }
__device__ __forceinline__ void moe_route(Ctx& X, bool local) {
    const float* LG = WSP(float, WS_KVT); unsigned* CNT = WSP(unsigned, WS_CTL) + CW_CNT; int* LISTS = WSP(int, WS_LISTS); float* GATEW = WSP(float, WS_GATEW);
    const int gw = X.wg * NWAVES + X.wave, NGW = X.G * NWAVES, l = X.lane, grp = l >> 3;
    const f32x4 bias = *(const f32x4*)(X.rbias + 4 * l);
    const unsigned long long ltmask = (1ull << l) - 1ull;
    const int tbeg = local ? X.wg * 64 + X.wave : gw, tend = local ? X.wg * 64 + 64 : T, tstep = local ? NWAVES : NGW;
    for (int t = tbeg; t < tend; t += tstep) {
        f32x4 lg = *(const f32x4*)(LG + (size_t)t * 256 + 4 * l);
#pragma unroll
        for (int ks = 1; ks < 4; ++ks) lg += *(const f32x4*)(LG + ((size_t)ks * T + t) * 256 + 4 * l);
        float sc[4], mb[4];
#pragma unroll
        for (int i = 0; i < 4; ++i) { sc[i] = sigmoidf_(lg[i]); mb[i] = sc[i] + bias[i]; }
        float m1 = fmaxf(mb[0], mb[1]), m2 = fminf(mb[0], mb[1]);
        { const float a1 = fmaxf(mb[2], mb[3]), a2 = fminf(mb[2], mb[3]); const float n1 = fmaxf(m1, a1), n2 = fmaxf(fminf(m1, a1), fmaxf(m2, a2)); m1 = n1; m2 = n2; }
#pragma unroll
        for (int o = 1; o < 8; o <<= 1) { const float a1 = __shfl_xor(m1, o), a2 = __shfl_xor(m2, o); const float n1 = fmaxf(m1, a1), n2 = fmaxf(fminf(m1, a1), fmaxf(m2, a2)); m1 = n1; m2 = n2; }
        const float gs = m1 + m2;
        int rank = 0;
#pragma unroll
        for (int gg = 0; gg < 8; ++gg) { const float og = __builtin_bit_cast(float, __builtin_amdgcn_readlane(__builtin_bit_cast(int, gs), gg * 8)); rank += (og > gs || (og == gs && gg < grp)) ? 1 : 0; }
        const bool sel = rank < 4;
        unsigned key[4];
#pragma unroll
        for (int i = 0; i < 4; ++i) key[i] = sel ? sortable_key(mb[i]) : 0u;
        unsigned pre = 0u;
#pragma unroll 1
        for (int bit = 31; bit >= 0; --bit) { const unsigned cand = pre | (1u << bit);
            const int cnt = __popcll(__ballot(key[0] >= cand)) + __popcll(__ballot(key[1] >= cand)) + __popcll(__ballot(key[2] >= cand)) + __popcll(__ballot(key[3] >= cand));
            if (cnt >= TOPK) pre = cand; }
        int ngt = 0, eqb = 0, tkb = 0; bool take[4];
#pragma unroll
        for (int i = 0; i < 4; ++i) ngt += __popcll(__ballot(key[i] > pre));
        const int need = TOPK - ngt;
#pragma unroll
        for (int i = 0; i < 4; ++i) eqb += __popcll(__ballot(key[i] == pre) & ltmask);
        int eqrun = eqb;
#pragma unroll
        for (int i = 0; i < 4; ++i) { const bool eq = key[i] == pre; take[i] = (key[i] > pre) || (eq && eqrun < need); eqrun += eq ? 1 : 0; }
#pragma unroll
        for (int i = 0; i < 4; ++i) tkb += __popcll(__ballot(take[i]) & ltmask);
        float part = 0.f;
#pragma unroll
        for (int i = 0; i < 4; ++i) part += take[i] ? sc[i] : 0.f;
        const float scale = 2.5f / wave_sum(part);
        int slot = tkb;
#pragma unroll
        for (int i = 0; i < 4; ++i) if (take[i]) { const int e = 4 * l + i; const unsigned pos = atomicAdd(&CNT[e * 64], 1u); LISTS[(size_t)e * 16384 + pos] = t * NSLOT + slot; GATEW[t * NSLOT + slot] = sc[i] * scale; ++slot; }
        if (l == 0) { LISTS[(size_t)NE * 16384 + t] = t * NSLOT + TOPK; GATEW[t * NSLOT + TOPK] = 1.0f; }
    }
}
__device__ __forceinline__ int moe_table(Ctx& X) {
    LAS int* tbl = (LAS int*)(X.lds + TBL_OFF); LAS int* cnts = (LAS int*)(X.lds + TCNT_OFF); LAS int* pref = cnts + 320;
    const unsigned* CNT = WSP(unsigned, WS_CTL) + CW_CNT;
    const int x = X.wg & 7;
    if (X.tid < NEX) cnts[X.tid] = X.tid < NE ? (int)__hip_atomic_load(CNT + X.tid * 64, __ATOMIC_RELAXED, __HIP_MEMORY_SCOPE_AGENT) : T;
    __syncthreads();
    if (X.tid < NEX) { int pre = 0; for (int e = 0; e < X.tid; ++e) pre += (cnts[e] + 255) >> 8; pref[X.tid] = pre; }
    __syncthreads();
    if (X.tid < 33) {
        const int i = X.tid; int lp = 0; for (int k = 0; k < i && k < 32; ++k) lp += (cnts[x + 8 * k] + 255) >> 8;
        if (i < 32) { const int e = x + 8 * i, n = (cnts[e] + 255) >> 8, p0 = pref[e]; for (int r = 0; r < n; ++r) tbl[lp + r] = ((p0 + r) << 16) | (e << 7) | r; }
        else { const int p0 = pref[NE]; for (int r8 = 0; r8 < 8; ++r8) { const int r = 8 * x + r8; tbl[lp + r8] = ((p0 + r) << 16) | (NE << 7) | r; } cnts[600] = lp + 8; }
    }
    __syncthreads();
    return __builtin_amdgcn_readfirstlane(cnts[600]);
}
__device__ __forceinline__ void final_rows(Ctx& X) {
    const bf16_t* X1 = WSP(bf16_t, WS_X1); const float* MOD = WSP(float, WS_MOD); const unsigned char* YBUF = WSP(unsigned char, WS_YBUF);
    const int gw = X.wg * NWAVES + X.wave, NGW = X.G * NWAVES, l = X.lane;
    for (int t = gw; t < T; t += NGW) {
        const int b = t / SEQ; f32x4 v[2][2]; float s = 0.f;
#pragma unroll
        for (int j = 0; j < 2; ++j) { const int col = 8 * l + 512 * j; f32x4 m0 = {0.f, 0.f, 0.f, 0.f}, m1 = {0.f, 0.f, 0.f, 0.f};
#pragma unroll
            for (int k = 0; k < NSLOT; ++k) { const u32x2 y = *(const u32x2*)(YBUF + ((size_t)t * NSLOT + k) * D + col);
                const f32x2 a = __builtin_amdgcn_cvt_pk_f32_fp8((int)y.x, false), bq = __builtin_amdgcn_cvt_pk_f32_fp8((int)y.x, true), c = __builtin_amdgcn_cvt_pk_f32_fp8((int)y.y, false), d = __builtin_amdgcn_cvt_pk_f32_fp8((int)y.y, true);
                m0.x += a[0]; m0.y += a[1]; m0.z += bq[0]; m0.w += bq[1]; m1.x += c[0]; m1.y += c[1]; m1.z += d[0]; m1.w += d[1]; }
            const f32x4 g0 = *(const f32x4*)(MOD + b * 6144 + 5120 + col) * (1.0f / YSCALE), g1 = *(const f32x4*)(MOD + b * 6144 + 5120 + col + 4) * (1.0f / YSCALE);
            const u32x4 xw = *(const u32x4*)(X1 + (size_t)t * D + col); const f32x4 x0 = {bflo(xw.x), bfhi(xw.x), bflo(xw.y), bfhi(xw.y)}, x1 = {bflo(xw.z), bfhi(xw.z), bflo(xw.w), bfhi(xw.w)};
            v[j][0] = x0 + g0 * m0; v[j][1] = x1 + g1 * m1;
#pragma unroll
            for (int q = 0; q < 2; ++q) s += (v[j][q].x * v[j][q].x + v[j][q].y * v[j][q].y) + (v[j][q].z * v[j][q].z + v[j][q].w * v[j][q].w); }
        const float rstd = rsqrtf(wave_sum(s) * (1.f / D) + EPS);
#pragma unroll
        for (int j = 0; j < 2; ++j) { const int col = 8 * l + 512 * j;
            *(f32x4*)(X.out + (size_t)t * D + col) = v[j][0] * rstd * *(const f32x4*)(X.g_final + col); *(f32x4*)(X.out + (size_t)t * D + col + 4) = v[j][1] * rstd * *(const f32x4*)(X.g_final + col + 4); }
    }
}

__device__ __forceinline__ unsigned* panel_word(Ctx& X, int bank, int pm) { return WSP(unsigned, WS_CTL) + CW_PANEL + (bank * 64 + pm) * 64; }
__device__ __forceinline__ void panel_signal(Ctx& X, int bank, int pm) {
    asm volatile("s_waitcnt vmcnt(0)" ::: "memory"); __syncthreads();
    if (X.tid == 0) (void)xb_add(panel_word(X, bank, pm), 1u);
}
__device__ __forceinline__ void panel_wait(Ctx& X, int bank, int pm, unsigned target) {
    if (X.tid == 0) { unsigned* p = panel_word(X, bank, pm); unsigned sp = 0u;
        while (xb_ld(p) < target) { __builtin_amdgcn_s_sleep(2); if (++sp > (1u << 22)) break; }
        __builtin_amdgcn_fence(__ATOMIC_ACQUIRE, "agent"); asm volatile("s_waitcnt vmcnt(0)" ::: "memory"); }
    __syncthreads();
}

constexpr int NG_INPROJ = 176;
__device__ __forceinline__ void ph_inproj(Ctx& X) {
    const int ng = X.G > NG_INPROJ + 8 ? NG_INPROJ : X.G;
    if (X.wg < ng) {
        RegSched S{(const char*)WSP(bf16_t, WS_H), (const char*)WSP(bf16_t, WS_WIN), (size_t)256 * 2048, (size_t)256 * 2048, T / 256, INW / 256, ng, X.wg};
        EpiInproj E{WSP(bf16_t, WS_PROJ), WSP(float, WS_LOGF), WSP(float, WS_LB), WSP(float, WS_ROPE)};
        pg8::gemm_phase<EpiInproj, RegSched, true, false>(X.lds, 1024, 1024, 1024, S, E);
    }
    if (ng == X.G) expert_convert(X, X.wg, X.G);
    else if (X.wg >= ng) expert_convert(X, X.wg - ng, X.G - ng);
}
__device__ __forceinline__ void ph_mix_a(Ctx& X) {
    for (int it = X.wg; it < 256; it += X.G) hgrn_kv_unit(X, it);
    AttnRegs R; int unit = X.wg; bf16x8 qf[4];
    if (unit < 1536) attn_load(X, unit, R);
    while (unit < 1536) {
        attn_stage(X, R);
#pragma unroll
        for (int ds = 0; ds < 4; ++ds) qf[ds] = R.q[ds];
        __syncthreads();
        const int nu = unit + X.G;
        if (nu < 1536) attn_load(X, nu, R);
        attn_compute(X, unit, qf);
        __syncthreads();
        unit = nu;
    }
}
__device__ __forceinline__ void ph_mix_c(Ctx& X) { for (int it = X.wg; it < 512; it += X.G) hgrn_out_unit(X, it); attn_combine(X); }
__device__ __forceinline__ void ph_mixed(Ctx& X, bool chain) {
    TwoPartSched S{(const char*)WSP(bf16_t, WS_YCAT), (const char*)WSP(bf16_t, WS_WPA), (const char*)WSP(bf16_t, WS_WPB), T / 256, D / 256, X.G, X.wg};
    EpiMixed E{WSP(bf16_t, WS_PROJ), WSP(bf16_t, WS_MIXED)};
    pg8::gemm_phase<EpiMixed, TwoPartSched, false, false>(X.lds, 1024, 512, 512, S, E);
    if (chain) { int pm, pn; pg8::swz_tile(X.wg, T / 256, D / 256, pm, pn); panel_signal(X, 0, pm); }
}
__device__ __forceinline__ void ph_outproj(Ctx& X, bool chain) {
    int pm = 0, pn = 0; pg8::swz_tile(X.wg < 256 ? X.wg : 0, T / 256, D / 256, pm, pn);
    RegSched S{(const char*)WSP(bf16_t, WS_MIXED), (const char*)WSP(bf16_t, WS_WOUT), (size_t)256 * 2048, (size_t)256 * 2048, T / 256, D / 256, X.G, X.wg};
    if (chain) {
        panel_wait(X, 0, pm, 4u);
        EpiOutNorm E{X.x, WSP(float, WS_MOD), X.g2, WSP(bf16_t, WS_X1), WSP(bf16_t, WS_H), WSP(unsigned char, WS_H8), WSP(float, WS_XB), panel_word(X, 1, 0), X.lds + 139264};
        pg8::gemm_phase<EpiOutNorm, RegSched, true, false>(X.lds, 1024, 1024, 1024, S, E);
        panel_signal(X, 2, pm);
    } else {
        EpiOutproj E{X.x, WSP(float, WS_MOD), WSP(bf16_t, WS_X1)};
        pg8::gemm_phase<EpiOutproj, RegSched, false, false>(X.lds, 1024, 1024, 1024, S, E);
    }
}
__device__ __forceinline__ void ph_norm2(Ctx& X, bool chain) { if (!chain) norm_rows(X, 1); }
__device__ __forceinline__ void ph_router(Ctx& X, bool chain) {
    if (chain) panel_wait(X, 2, X.wg >> 2, 4u);
    RouterSched S{(const char*)WSP(bf16_t, WS_H), (const char*)WSP(bf16_t, WS_WR), X.G, X.wg};
    EpiRouter E{WSP(float, WS_KVT)};
    pg8::gemm_phase<EpiRouter, RouterSched, false, false>(X.lds, 1024, 1024, 256, S, E);
    if (chain) panel_signal(X, 3, X.wg >> 2);
}
__device__ __forceinline__ void ph_route(Ctx& X, bool chain) {
    if (chain) panel_wait(X, 3, X.wg >> 2, 4u);
    moe_route(X, chain);
}
__device__ __forceinline__ void ph_gu(Ctx& X) {
    const int nent = moe_table(X);
    MoeSched S{(const LAS int*)(X.lds + TBL_OFF), (const LAS int*)(X.lds + TCNT_OFF), nent, (const char*)WSP(unsigned char, WS_H8), (const char*)WSP(unsigned char, WS_WGU), WSP(int, WS_LISTS), 2, 256 * 1024, 512 * 1024, 0, X.G, X.wg};
    EpiGU E{WSP(unsigned char, WS_ACT)};
    pg8::gemm_phase<EpiGU, MoeSched, true, true, true>(X.lds, 512, 512, 512, S, E);
}
__device__ __forceinline__ void ph_down(Ctx& X) {
    const int nent = moe_table(X);
    MoeSched S{(const LAS int*)(X.lds + TBL_OFF), (const LAS int*)(X.lds + TCNT_OFF), nent, (const char*)WSP(unsigned char, WS_ACT), (const char*)WSP(unsigned char, WS_WD), WSP(int, WS_LISTS), 4, 256 * 256, 1024 * 256, 256 * 256, X.G, X.wg};
    EpiDown E{WSP(unsigned char, WS_YBUF), WSP(float, WS_GATEW)};
    pg8::gemm_phase<EpiDown, MoeSched, true, false, true>(X.lds, 128, 128, 128, S, E);
}

constexpr int NPHASE = 14;
struct Args { const void* in[20]; float* out; unsigned char* ws; int ph_lo, ph_hi; };
__global__ void __launch_bounds__(NTHREADS, 2) mega_fwd(Args args) {
    extern __shared__ __attribute__((aligned(16))) unsigned char lds_raw[];
    Ctx X;
    X.lds = (LAS unsigned char*)lds_raw;
    X.tid = threadIdx.x; X.lane = X.tid & 63; X.wave = __builtin_amdgcn_readfirstlane(X.tid >> 6); X.wg = blockIdx.x; X.G = gridDim.x;
    X.x = (const float*)args.in[0]; X.c = (const float*)args.in[1]; X.positions = (const int*)args.in[2]; X.w_ada = (const float*)args.in[3]; X.b_ada = (const float*)args.in[4];
    X.g1 = (const float*)args.in[5]; X.w_in = (const float*)args.in[6]; X.lb_logits = (const float*)args.in[7]; X.g_hgrn = (const float*)args.in[8]; X.w_pa = (const float*)args.in[9];
    X.w_pb = (const float*)args.in[10]; X.w_out = (const float*)args.in[11]; X.g2 = (const float*)args.in[12]; X.w_router = (const float*)args.in[13]; X.rbias = (const float*)args.in[14];
    X.w_egu = (const float*)args.in[15]; X.w_edown = (const float*)args.in[16]; X.w_sgu = (const float*)args.in[17]; X.w_sdown = (const float*)args.in[18]; X.g_final = (const float*)args.in[19];
    X.out = args.out; X.ws = args.ws;
    volatile LAS unsigned* MISC = (volatile LAS unsigned*)(X.lds + MISC_OFF);
    if (X.tid < 32) MISC[X.tid] = 0u;
    __syncthreads();
    const int lo = args.ph_lo, hi = args.ph_hi;
    XcdBarrier bar; bar.bar = WSP(unsigned, WS_CTL) + CW_BAR; bar.x = 0; bar.st = nullptr;
    if (hi - lo > 1) bar = xcd_barrier_post(WSP(unsigned, WS_CTL) + CW_BAR, MISC + 8);
#ifndef PH_MASK
#define PH_MASK 0xffffffffu
#endif
#define IN(k) ((((PH_MASK) >> (k)) & 1u) && lo <= (k) && (k) < hi)
#ifndef REPEAT_MASK
#define REPEAT_MASK 0u
#endif
#define SEAM(k) do { if (IN(k) && IN((k) + 1)) xcd_barrier(bar); } while (0)
#define RUN(k, call) do { if (IN(k)) { call; if (((REPEAT_MASK) >> (k)) & 1u) { xcd_barrier(bar); call; } } } while (0)

    RUN(0, p0_prologue(X)); SEAM(0);
    RUN(1, { small_transposes(X); norm_rows(X, 0); }); SEAM(1);
    RUN(2, ph_inproj(X)); SEAM(2);
    RUN(3, ph_mix_a(X)); SEAM(3);
    RUN(4, hgrn_passB(X)); SEAM(4);
    RUN(5, ph_mix_c(X)); SEAM(5);
    const bool chain = (X.G == 256);
    RUN(6, ph_mixed(X, chain)); if (!chain) SEAM(6);
    RUN(7, ph_outproj(X, chain)); if (!chain) SEAM(7);
    RUN(8, ph_norm2(X, chain)); if (!chain) SEAM(8);
    RUN(9, ph_router(X, chain)); if (!chain) SEAM(9);
    RUN(10, ph_route(X, chain)); SEAM(10);
    RUN(11, ph_gu(X)); SEAM(11);
    RUN(12, ph_down(X)); SEAM(12);
    RUN(13, final_rows(X));
#undef IN
#undef SEAM
}

extern "C" void kernel_launch(void* const* d_in, const int* in_sizes, int n_in, void* d_out, int out_size, void* d_ws, size_t ws_size, hipStream_t stream) {
    static int grid = 0;
    if (grid == 0) {
        if (n_in != 20 || out_size != T * D || ws_size < WS_END) { fprintf(stderr, "kernel_launch: unexpected shapes (n_in %d, out %d, ws %zu); nothing launched\n", n_in, out_size, ws_size); grid = -1; return; }
        int dev = 0, cus = 0, per_cu = 0;
        if (hipGetDevice(&dev) != hipSuccess || hipDeviceGetAttribute(&cus, hipDeviceAttributeMultiprocessorCount, dev) != hipSuccess) { grid = -1; return; }
        if (hipFuncSetAttribute((const void*)mega_fwd, hipFuncAttributeMaxDynamicSharedMemorySize, LDS_BYTES) != hipSuccess) { fprintf(stderr, "kernel_launch: hipFuncSetAttribute failed\n"); grid = -1; return; }
        if (hipOccupancyMaxActiveBlocksPerMultiprocessor(&per_cu, (const void*)mega_fwd, NTHREADS, LDS_BYTES) != hipSuccess || per_cu < 1) { fprintf(stderr, "kernel_launch: occupancy query says %d blocks/CU; nothing launched\n", per_cu); (void)hipGetLastError(); grid = -1; return; }
        grid = cus;
        if (T % grid != 0 || 24576 % grid != 0 || grid % 8 != 0) { fprintf(stderr, "kernel_launch: grid %d does not divide the row count; nothing launched\n", grid); grid = -1; return; }
    }
    if (grid < 0) return;
    (void)hipMemsetAsync((char*)d_ws + WS_CTL, 0, CTL_ZERO_BYTES, stream);
    Args a{};
    for (int i = 0; i < 20; ++i) a.in[i] = d_in[i];
    a.out = (float*)d_out; a.ws = (unsigned char*)d_ws;
#if MK_PER_PHASE
    for (int p = 0; p < NPHASE; ++p) { a.ph_lo = p; a.ph_hi = p + 1; hipLaunchKernelGGL(mega_fwd, dim3(grid), dim3(NTHREADS), LDS_BYTES, stream, a); }
#else
    a.ph_lo = 0; a.ph_hi = NPHASE;
    hipLaunchKernelGGL(mega_fwd, dim3(grid), dim3(NTHREADS), LDS_BYTES, stream, a);
#endif
}
```

```cpp
#include <hip/hip_runtime.h>
#include <cstdio>
#include <cstdint>

#ifndef MK_PER_PHASE
#define MK_PER_PHASE 0
#endif

#define GAS __attribute__((address_space(1)))
#define LAS __attribute__((address_space(3)))
typedef unsigned short bf16_t;
typedef short bf16x8 __attribute__((ext_vector_type(8)));
typedef short s16x4 __attribute__((ext_vector_type(4)));
typedef float f32x4 __attribute__((ext_vector_type(4)));
typedef float f32x2 __attribute__((ext_vector_type(2)));
typedef float f32x16 __attribute__((ext_vector_type(16)));
typedef unsigned u32x4 __attribute__((ext_vector_type(4)));
typedef unsigned u32x2 __attribute__((ext_vector_type(2)));
typedef long l64x2 __attribute__((ext_vector_type(2)));

constexpr int NB = 4, SEQ = 4096, T = NB * SEQ, D = 1024, INW = 8704;
constexpr int C_HQ = 0, C_HK = 512, C_HV = 1024, C_HG = 1536, C_AQ = 2048, C_AK = 3584, C_AV = 5120, C_GA = 6656, C_GB = 7680;
constexpr int NE = 256, NEX = 257, TOPK = 8, NSLOT = 9, EFF = 256;
constexpr float EPS = 1e-6f;
constexpr float WGU_SCALE = 64.0f, WD_SCALE = 32.0f;
constexpr float YSCALE = 16.0f;
constexpr int NWAVES = 8, NTHREADS = 512;

constexpr size_t MiB = 1u << 20;
constexpr size_t WS_CTL = 0, CTL_ZERO_BYTES = 1 * MiB;
constexpr size_t WS_MODP = 2 * MiB;
constexpr size_t WS_MOD = 4 * MiB;
constexpr size_t WS_LB = 4 * MiB + 128 * 1024;
constexpr size_t WS_XB = 4 * MiB + 256 * 1024;
constexpr size_t WS_ROPE = 5 * MiB;
constexpr size_t WS_DECAY = 6 * MiB;
constexpr size_t WS_GATEW = 7 * MiB;
constexpr size_t WS_LISTS = 16 * MiB;
constexpr size_t WS_WIN = 34 * MiB;
constexpr size_t WS_WPA = 51 * MiB, WS_WPB = 52 * MiB, WS_WOUT = 53 * MiB, WS_WR = 55 * MiB;
constexpr size_t WS_H = 56 * MiB;
constexpr size_t WS_LOGF = 88 * MiB;
constexpr size_t WS_H8 = 120 * MiB;
constexpr size_t WS_MIXED = 136 * MiB;
constexpr size_t WS_YCAT = 168 * MiB;
constexpr size_t WS_X1 = 200 * MiB;
constexpr size_t WS_G8 = 232 * MiB;
constexpr size_t WS_OG = 264 * MiB;
constexpr size_t WS_LSE = 312 * MiB;
constexpr size_t WS_KVT = 314 * MiB;
constexpr size_t WS_SPT = 378 * MiB;
constexpr size_t WS_PROJ = 410 * MiB;
constexpr size_t WS_WGU = 682 * MiB;
constexpr size_t WS_WD = 939 * MiB;
constexpr size_t WS_ACT = 1068 * MiB;
constexpr size_t WS_YBUF = 1172 * MiB;
constexpr size_t WS_END = 1460 * MiB;
constexpr int CW_BAR = 4096;
constexpr int CW_PANEL = 65536;
constexpr int CW_CNT = 16384;

constexpr int RING_BYTES = 131072;
constexpr int TBL_OFF = RING_BYTES;
constexpr int TCNT_OFF = TBL_OFF + 4096;
constexpr int MISC_OFF = TCNT_OFF + 2560;
constexpr int LDS_BYTES = 147456;

#define LDS_WAIT() asm volatile("s_waitcnt lgkmcnt(0)" ::: "memory")
#define VM_WAIT() asm volatile("s_waitcnt vmcnt(0)" ::: "memory")
__device__ __forceinline__ unsigned f2bf(float f) { unsigned u = __builtin_bit_cast(unsigned, f); return (u + 0x7fffu + ((u >> 16) & 1u)) >> 16; }
__device__ __forceinline__ float bf2f(unsigned b) { return __builtin_bit_cast(float, b << 16); }
__device__ __forceinline__ unsigned pk2(float lo, float hi) { return f2bf(lo) | (f2bf(hi) << 16); }
__device__ __forceinline__ float bflo(unsigned w) { return __builtin_bit_cast(float, w << 16); }
__device__ __forceinline__ float bfhi(unsigned w) { return __builtin_bit_cast(float, w & 0xffff0000u); }
__device__ __forceinline__ float sigmoidf_(float x) { return 1.0f / (1.0f + __expf(-x)); }
__device__ __forceinline__ float wave_sum(float v) {
#pragma unroll
    for (int o = 1; o < 64; o <<= 1) v += __shfl_xor(v, o);
    return v;
}

__device__ __forceinline__ float clamp_e4m3(float x) { return __builtin_amdgcn_fmed3f(x, -448.0f, 448.0f); }
__device__ __forceinline__ unsigned pk4_fp8(float a, float b, float c, float d) { int w = 0; w = __builtin_amdgcn_cvt_pk_fp8_f32(clamp_e4m3(a), clamp_e4m3(b), w, false); w = __builtin_amdgcn_cvt_pk_fp8_f32(clamp_e4m3(c), clamp_e4m3(d), w, true); return (unsigned)w; }
__device__ __forceinline__ void st_wt8(void* p, unsigned long long v) { __hip_atomic_store((unsigned long long*)p, v, __ATOMIC_RELAXED, __HIP_MEMORY_SCOPE_AGENT); }
__device__ __forceinline__ void st_wt16(void* p, u32x4 v) { asm volatile("global_store_dwordx4 %0, %1, off sc1\n\ts_nop 1" :: "v"(p), "v"(v) : "memory"); }
__device__ __forceinline__ void st_wt4(void* p, unsigned v) { __hip_atomic_store((unsigned*)p, v, __ATOMIC_RELAXED, __HIP_MEMORY_SCOPE_AGENT); }
namespace pg8 {
constexpr int BM = 256, BK = 64, HALF = 128, HTB = HALF * BK * 2, STAGE_BYTES = 8 * HTB, NXCD = 8, WGM = 8;
__host__ __device__ __forceinline__ int lds_byte(int r, int c) { const int st = (r >> 4) * 2 + (c >> 5), rr = r & 15, cc = c & 31, ob = rr * 64 + cc * 2; return st * 1024 + (ob ^ (((ob >> 9) & 1) << 5)); }
__host__ __device__ __forceinline__ void stage_rc(int b, int& R, int& C) { const int st = b / 1024, sb = b % 1024, swz = sb ^ (((sb >> 9) & 1) << 5); R = (st >> 1) * 16 + swz / 64; C = (st & 1) * 32 + (swz % 64) / 2; }
__host__ __device__ __forceinline__ int perm32(int rho) { const int n = rho >> 4, i = rho & 15; return 8 * (i >> 2) + 4 * n + (i & 3); }

struct Unit { const char* a; const char* b; const int* rows; int pm, pn, aux, nvalid; };

__device__ __forceinline__ void swz_tile(int L, int nM, int nN, int& pm, int& pn) {
    const int nwg = nM * nN; int wgid = L;
    { const int q = nwg / NXCD, r = nwg % NXCD, xcd = wgid % NXCD, off = wgid / NXCD; wgid = (xcd < r ? xcd * (q + 1) : r * (q + 1) + (xcd - r) * q) + off; }
    const int nig = WGM * nN, gid = wgid / nig, fm = gid * WGM, gsz = (nM - fm) < WGM ? (nM - fm) : WGM;
    pm = fm + ((wgid % nig) % gsz); pn = (wgid % nig) / gsz;
}

__device__ __forceinline__ unsigned cvt_pk_bf16(float lo, float hi) { unsigned r; asm volatile("v_cvt_pk_bf16_f32 %0, %1, %2" : "=v"(r) : "v"(lo), "v"(hi)); return r; }

template <bool GATHER>
__device__ __forceinline__ void gather_offs(const Unit& u, int tid, int lda, unsigned (&v)[2][2]) {
    if constexpr (GATHER) {
#pragma unroll
        for (int i = 0; i < 2; ++i) { int R, C; stage_rc(tid * 16 + i * 8192, R, C);
#pragma unroll
            for (int hh = 0; hh < 2; ++hh) { const int ri = hh * HALF + R; int slot = 0; if (ri < u.nvalid) slot = u.rows[ri];
                const unsigned tok = (unsigned)slot / 9u; v[hh][i] = (tok * (unsigned)lda + (unsigned)C) * 2u; } }
    }
}

template <class Epi, class Sched, bool ALIGN_EPI, bool GATHER, bool FP8 = false>
__device__ __forceinline__ void gemm_phase(LAS unsigned char* lds, const int lda, const int ldb, const int K, const Sched& S, const Epi& E) {
    const int tid = threadIdx.x, wid = __builtin_amdgcn_readfirstlane(tid >> 6), lane = tid & 63, wr = wid >> 2, wc = wid & 3, fr = lane & 15, fq = lane >> 4;
    const int nt = K / BK;
    unsigned voffA[2], voffB[2];
#pragma unroll
    for (int i = 0; i < 2; ++i) { int R, C; stage_rc(tid * 16 + i * 8192, R, C); const int Rb = Epi::PERM ? ((R & ~31) + perm32(R & 31)) : R;
        voffA[i] = (unsigned)(R * lda + C) * 2u; voffB[i] = (unsigned)(Rb * ldb + C) * 2u; }
    const size_t kstep = (size_t)(BK * 2);
    const size_t hstepA = GATHER ? 0 : (size_t)HALF * lda * 2, hstepB = (size_t)HALF * ldb * 2;
    const unsigned ldsw = (unsigned)wid * 1024u;
    const int aoff = lds_byte(wr * 64 + fr, fq * 8), boff = lds_byte(wc * 32 + fr, fq * 8);
#define PG8_SA(b, h) (((b) * 2 + (h)) * HTB)
#define PG8_SB(b, h) ((4 + (b) * 2 + (h)) * HTB)
#define PG8_STAGE(bufoff, gbase, voff) do { _Pragma("unroll") for (int _i = 0; _i < 2; ++_i) \
        __builtin_amdgcn_global_load_lds((const unsigned*)((const char*)(gbase) + (voff)[_i]), (LAS unsigned*)(lds + (bufoff) + ldsw + _i * 8192), 16, 0, 0); } while (0)
#define PG8_STAGE_A(bufoff, gb, hh, nx) do { if constexpr (GATHER) { unsigned _v[2]; _v[0] = (nx) ? vn[hh][0] : vc[hh][0]; _v[1] = (nx) ? vn[hh][1] : vc[hh][1]; PG8_STAGE(bufoff, gb, _v); } \
        else { PG8_STAGE(bufoff, (gb) + (hh) * hstepA, voffA); } } while (0)
#define PG8_LDA(dst, b, h) do { _Pragma("unroll") for (int m = 0; m < 4; ++m) _Pragma("unroll") for (int k = 0; k < 2; ++k) dst[m][k] = *(const LAS bf16x8*)(lds + PG8_SA(b, h) + aoff + m * 2048 + k * 1024); } while (0)
#define PG8_LDB(dst, b, h) do { _Pragma("unroll") for (int n = 0; n < 2; ++n) _Pragma("unroll") for (int k = 0; k < 2; ++k) dst[n][k] = *(const LAS bf16x8*)(lds + PG8_SB(b, h) + boff + n * 2048 + k * 1024); } while (0)
#define PG8_MMA(ai, bj, At, Bt) do { __builtin_amdgcn_s_setprio(1); _Pragma("unroll") for (int m = 0; m < 4; ++m) _Pragma("unroll") for (int n = 0; n < 2; ++n) _Pragma("unroll") for (int k = 0; k < 2; ++k) { \
        if constexpr (FP8) { const l64x2 _b = __builtin_bit_cast(l64x2, Bt[n][k]), _a = __builtin_bit_cast(l64x2, At[m][k]); \
            acc[ai][bj][m][n] = __builtin_amdgcn_mfma_f32_16x16x32_fp8_fp8(_b[0], _a[0], acc[ai][bj][m][n], 0, 0, 0); acc[ai][bj][m][n] = __builtin_amdgcn_mfma_f32_16x16x32_fp8_fp8(_b[1], _a[1], acc[ai][bj][m][n], 0, 0, 0); } \
        else acc[ai][bj][m][n] = __builtin_amdgcn_mfma_f32_16x16x32_bf16(Bt[n][k], At[m][k], acc[ai][bj][m][n], 0, 0, 0); } __builtin_amdgcn_s_setprio(0); } while (0)
#define PG8_WAIT_V(n) asm volatile("s_waitcnt vmcnt(" #n ")" ::: "memory")
#define PG8_WAIT_L(n) asm volatile("s_waitcnt lgkmcnt(" #n ")" ::: "memory")
#define PG8_BAR __builtin_amdgcn_s_barrier()
#define PG8_SCHED __builtin_amdgcn_sched_barrier(0)
    Unit cur, nxt; int ui = 0;
    if (!S.next(0, cur)) return;
    unsigned vc[2][2] = {{0u, 0u}, {0u, 0u}}, vn[2][2] = {{0u, 0u}, {0u, 0u}};
    gather_offs<GATHER>(cur, tid, lda, vc);
    f32x4 acc[2][2][4][2];
#pragma unroll
    for (int a = 0; a < 2; ++a)
#pragma unroll
        for (int b = 0; b < 2; ++b)
#pragma unroll
            for (int m = 0; m < 4; ++m)
#pragma unroll
                for (int n = 0; n < 2; ++n) acc[a][b][m][n] = (f32x4){0.f, 0.f, 0.f, 0.f};
    bf16x8 At[4][2], B0[2][2], B1[2][2];
    const char* cA = cur.a; const char* cB = cur.b;
    PG8_STAGE(PG8_SB(0, 0), cB, voffB); PG8_STAGE(PG8_SB(0, 1), cB + hstepB, voffB); PG8_STAGE_A(PG8_SA(0, 0), cA, 0, false); PG8_STAGE_A(PG8_SA(0, 1), cA, 1, false);
    if (wr == 1) PG8_BAR;
    PG8_WAIT_V(2); PG8_BAR;
    PG8_STAGE(PG8_SB(1, 0), cB + kstep, voffB); PG8_STAGE_A(PG8_SA(1, 0), cA + kstep, 0, false); PG8_STAGE(PG8_SB(1, 1), cB + hstepB + kstep, voffB);
    PG8_WAIT_V(6); PG8_BAR;
    for (;;) {
        const bool has_next = S.next(ui + 1, nxt);
        if (has_next) gather_offs<GATHER>(nxt, tid, lda, vn);
        const char* nA = has_next ? nxt.a : cA; const char* nB = has_next ? nxt.b : cB;
        const bool do0 = !Sched::HALFSKIP || cur.nvalid > 64 * wr, do1 = !Sched::HALFSKIP || cur.nvalid > 128 + 64 * wr;
        for (int t = 0; t < nt; t += 2) {
            const bool last = (t == nt - 2);
            const bool lnx = last && has_next;
            const char* a1 = cA + (size_t)(t + 1) * kstep;
            const char* a2 = last ? nA : cA + (size_t)(t + 2) * kstep; const char* b2 = last ? nB : cB + (size_t)(t + 2) * kstep;
            const char* a3 = a2 + kstep; const char* b3 = b2 + kstep;
            PG8_LDB(B0, 0, 0); PG8_LDB(B1, 0, 1); PG8_SCHED; PG8_LDA(At, 0, 0); PG8_STAGE_A(PG8_SA(1, 1), a1, 1, false);
            PG8_WAIT_V(8); PG8_WAIT_L(0); PG8_BAR; if (do0) { PG8_MMA(0, 0, At, B0); PG8_MMA(0, 1, At, B1); } PG8_BAR; PG8_SCHED;
            PG8_LDA(At, 0, 1); PG8_STAGE(PG8_SB(0, 0), b2, voffB); PG8_STAGE(PG8_SB(0, 1), b2 + hstepB, voffB); PG8_STAGE_A(PG8_SA(0, 0), a2, 0, lnx);
            PG8_WAIT_V(8); PG8_WAIT_L(0); PG8_BAR; if (do1) { PG8_MMA(1, 0, At, B0); PG8_MMA(1, 1, At, B1); } PG8_BAR; PG8_SCHED;
            PG8_LDB(B0, 1, 0); PG8_LDB(B1, 1, 1); PG8_SCHED; PG8_LDA(At, 1, 0); PG8_STAGE_A(PG8_SA(0, 1), a2, 1, lnx);
            PG8_WAIT_V(8); PG8_WAIT_L(0); PG8_BAR; if (do0) { PG8_MMA(0, 0, At, B0); PG8_MMA(0, 1, At, B1); } PG8_BAR; PG8_SCHED;
            PG8_LDA(At, 1, 1); PG8_STAGE(PG8_SB(1, 0), b3, voffB); PG8_STAGE(PG8_SB(1, 1), b3 + hstepB, voffB); PG8_STAGE_A(PG8_SA(1, 0), a3, 0, lnx);
            PG8_WAIT_V(8); PG8_WAIT_L(0); PG8_BAR; if (do1) { PG8_MMA(1, 0, At, B0); PG8_MMA(1, 1, At, B1); } PG8_BAR; PG8_SCHED;
        }
        if constexpr (ALIGN_EPI) { if (wr == 0) PG8_BAR; }
        E(acc, cur, wr, wc, fr, fq);
        __builtin_amdgcn_s_waitcnt(0x0F70);
        if (!has_next) break;
        if (!E.keep(cur)) {
#pragma unroll
            for (int a = 0; a < 2; ++a)
#pragma unroll
                for (int b = 0; b < 2; ++b)
#pragma unroll
                    for (int m = 0; m < 4; ++m)
#pragma unroll
                        for (int n = 0; n < 2; ++n) acc[a][b][m][n] = (f32x4){0.f, 0.f, 0.f, 0.f};
        }
        cur = nxt; cA = nA; cB = nB; ++ui;
        if constexpr (GATHER) {
#pragma unroll
            for (int hh = 0; hh < 2; ++hh) { vc[hh][0] = vn[hh][0]; vc[hh][1] = vn[hh][1]; }
        }
        if constexpr (ALIGN_EPI) { if (wr == 1) PG8_BAR; }
    }
    PG8_WAIT_V(0);
    if constexpr (!ALIGN_EPI) { if (wr == 0) PG8_BAR; }
    PG8_BAR;
#undef PG8_SA
#undef PG8_SB
#undef PG8_STAGE
#undef PG8_STAGE_A
#undef PG8_LDA
#undef PG8_LDB
#undef PG8_MMA
#undef PG8_WAIT_V
#undef PG8_WAIT_L
#undef PG8_BAR
#undef PG8_SCHED
}
}

#define XB_TMO      128
#define XB_XCNT(j)  (256  + 64 * (j))
#define XB_XSUB(j)  (1280 + 64 * (j))
#define XB_XGEN(j)  (2304 + 64 * (j))
#define XB_TOP      3328
#define XB_TOPGEN   3392
#define XCD_BAR_WORDS 3456
#define XB_SPIN_CAP (1u << 20)
__device__ __forceinline__ unsigned xb_ld(unsigned* p)              { return __hip_atomic_load(p, __ATOMIC_RELAXED, __HIP_MEMORY_SCOPE_AGENT); }
__device__ __forceinline__ unsigned xb_add(unsigned* p, unsigned v) { return __hip_atomic_fetch_add(p, v, __ATOMIC_RELAXED, __HIP_MEMORY_SCOPE_AGENT); }
__device__ __forceinline__ unsigned xb_xcc_id() { return (unsigned)__builtin_amdgcn_s_getreg((3 << 11) | 20) & 0xFu; }
#define XB_SPIN(cond, bar) do { unsigned _sp = 0; while (cond) { __builtin_amdgcn_s_sleep(1); \
    if ((++_sp & 255u) == 0u) { if (xb_ld(&(bar)[XB_TMO])) break; if (_sp > XB_SPIN_CAP) { atomicAdd(&(bar)[XB_TMO], 1u); break; } } } } while (0)
struct XcdBarrier { unsigned* bar; unsigned x; volatile LAS unsigned* st; };
__device__ __forceinline__ XcdBarrier xcd_barrier_post(unsigned* bar, volatile LAS unsigned* st) {
    XcdBarrier b; b.bar = bar; b.x = xb_xcc_id(); b.st = st;
    if (threadIdx.x == 0) (void)xb_add(&bar[XB_XCNT(b.x)], 1u);
    return b;
}
__device__ __forceinline__ void xcd_barrier_complete(unsigned* bar, unsigned x, unsigned& nloc, unsigned& nx) {
    const unsigned G = gridDim.x * gridDim.y * gridDim.z;
    unsigned sum, cnt, mine, sp = 0u;
    for (;;) {
        sum = 0u; cnt = 0u; mine = 0u;
#pragma unroll
        for (unsigned j = 0; j < 16; ++j) { const unsigned c = xb_ld(&bar[XB_XCNT(j)]); sum += c; cnt += (c > 0u) ? 1u : 0u; mine = (j == x) ? c : mine; }
        if (sum == G) break;
        __builtin_amdgcn_s_sleep(1);
        if ((++sp & 255u) == 0u) { if (xb_ld(&bar[XB_TMO])) break; if (sp > XB_SPIN_CAP) { atomicAdd(&bar[XB_TMO], 1u); break; } }
    }
    nloc = mine > 0u ? mine : 1u; nx = cnt > 0u ? cnt : 1u;
}
__device__ __forceinline__ void xcd_barrier(const XcdBarrier& b) {
    asm volatile("s_waitcnt vmcnt(0)" ::: "memory");
    __syncthreads();
    if (threadIdx.x == 0) {
        unsigned* bar = b.bar;
        __builtin_amdgcn_s_waitcnt(0);
        unsigned nloc = b.st[0], nx = b.st[1];
        if (nloc == 0u) { xcd_barrier_complete(bar, b.x, nloc, nx); b.st[0] = nloc; b.st[1] = nx; }
        const unsigned old = xb_add(&bar[XB_XSUB(b.x)], 1u);
        const unsigned gen = old / nloc;
        if (old + 1u == (gen + 1u) * nloc) {
            __builtin_amdgcn_fence(__ATOMIC_RELEASE, "agent");
            asm volatile("s_waitcnt vmcnt(0)" ::: "memory");
            const unsigned og = xb_add(&bar[XB_TOP], 1u);
            const unsigned tg = og / nx;
            if (og + 1u == (tg + 1u) * nx) xb_add(&bar[XB_TOPGEN], 1u);
            else XB_SPIN(xb_ld(&bar[XB_TOPGEN]) == tg, bar);
            __builtin_amdgcn_fence(__ATOMIC_ACQUIRE, "agent");
            asm volatile("s_waitcnt vmcnt(0)" ::: "memory");
        } else {
            XB_SPIN(xb_ld(&bar[XB_TOPGEN]) == gen, bar);
            __builtin_amdgcn_fence(__ATOMIC_ACQUIRE, "agent");
            asm volatile("s_waitcnt vmcnt(0)" ::: "memory");
        }
    }
    __syncthreads();
}

struct Ctx {
    LAS unsigned char* lds;
    int tid, lane, wave, wg, G;
    const float *x, *c, *w_ada, *b_ada, *g1, *w_in, *lb_logits, *g_hgrn, *w_pa, *w_pb, *w_out, *g2, *w_router, *rbias, *w_egu, *w_edown, *w_sgu, *w_sdown, *g_final;
    const int* positions;
    float* out;
    unsigned char* ws;
};
#define WSP(type, off) ((type*)(X.ws + (off)))

__device__ __forceinline__ void transpose_item(const float* W, int K, int N, bf16_t* WT, int dst_row0, int src_col0, int k0, LAS float* scr, int lane) {
#pragma unroll 16
    for (int i = 0; i < 32; ++i) { const int kk = 2 * i + (lane >> 5); scr[kk * 33 + (lane & 31)] = W[(size_t)(k0 + kk) * N + src_col0 + (lane & 31)]; }
    LDS_WAIT(); asm volatile("" ::: "memory");
    const int c = lane & 7;
#pragma unroll
    for (int j = 0; j < 4; ++j) { const int n = (lane >> 3) + 8 * j; const LAS float* s = scr + (8 * c) * 33 + n;
        u32x4 o; o.x = pk2(s[0 * 33], s[1 * 33]); o.y = pk2(s[2 * 33], s[3 * 33]); o.z = pk2(s[4 * 33], s[5 * 33]); o.w = pk2(s[6 * 33], s[7 * 33]);
        *(u32x4*)(WT + (size_t)(dst_row0 + n) * K + k0 + 8 * c) = o; }
    LDS_WAIT(); asm volatile("" ::: "memory");
}
__device__ __forceinline__ void transpose_plain(const float* W, int K, int N, bf16_t* WT, int item, LAS float* scr, int lane) {
    const int nblk = N / 32, kb = item / nblk, nb = item % nblk;
    transpose_item(W, K, N, WT, nb * 32, nb * 32, kb * 64, scr, lane);
}
__device__ __forceinline__ void p0_prologue(Ctx& X) {
    LAS float* scr = (LAS float*)(X.lds + X.wave * 16384);
    const int gw = X.wg * NWAVES + X.wave, NGW = X.G * NWAVES;
    {
        float* MODP = WSP(float, WS_MODP);
        for (int it = gw; it < 96 * 16; it += NGW) {
            const int jc = it % 96, kc = it / 96, j = jc * 64 + X.lane;
            float a0 = 0.f, a1 = 0.f, a2 = 0.f, a3 = 0.f;
#pragma unroll 16
            for (int kk = 0; kk < 64; ++kk) { const int k = kc * 64 + kk; const float w = X.w_ada[(size_t)k * 6144 + j];
                const float c0 = X.c[k], c1 = X.c[1024 + k], c2 = X.c[2048 + k], c3 = X.c[3072 + k];
                a0 += c0 * sigmoidf_(c0) * w; a1 += c1 * sigmoidf_(c1) * w; a2 += c2 * sigmoidf_(c2) * w; a3 += c3 * sigmoidf_(c3) * w; }
            float* o = MODP + (size_t)kc * 24576 + j;
            o[0] = a0; o[6144] = a1; o[12288] = a2; o[18432] = a3;
        }
    }
    {
        float* ROPE = WSP(float, WS_ROPE);
        const int gt = X.wg * NTHREADS + X.tid, NGT = X.G * NTHREADS;
        for (int idx = gt; idx < T * 8; idx += NGT) { const int t = idx >> 3, i = idx & 7;
            const float inv_freq = 1.0f / powf(500000.0f, (float)(2 * i) / 16.0f);
            const float ang = (float)X.positions[t] * inv_freq;
            ROPE[t * 16 + i] = cosf(ang); ROPE[t * 16 + 8 + i] = sinf(ang); }
        if (X.wg == 0) { float* LB = WSP(float, WS_LB);
            for (int j = X.tid; j < 512; j += NTHREADS) { const float l0 = X.lb_logits[j], l1 = X.lb_logits[512 + j], m = fmaxf(l0, l1), e0 = __expf(l0 - m), e1 = __expf(l1 - m); LB[j] = e0 / (e0 + e1); } }
    }
}
struct CvtItem { const float* src; bf16_t* dst; };
template <bool GU> __device__ __forceinline__ CvtItem cvt_item(const Ctx& X, int it) {
    CvtItem c;
    if constexpr (GU) { const int e = it >> 7, q = it & 127, w8 = q & 7, sq = q >> 3, kb = 4 * (sq >> 2) + (w8 & 3), nb = 2 * (sq & 3) + (w8 >> 2);
        const int n0 = nb * 64, pn = n0 >> 8, bj = (n0 >> 7) & 1, idx = n0 & 127, srcc = bj * 256 + pn * 128 + idx;
        const float* W = (e < NE) ? X.w_egu + (size_t)e * 1024 * 512 : X.w_sgu;
        c.src = W + (size_t)(kb * 64) * 512 + srcc; c.dst = (bf16_t*)(X.ws + WS_WGU + ((size_t)e * 512 + n0) * 1024 + kb * 64); }
    else { const int e = it >> 6, q = it & 63, w8 = q & 7, sq = q >> 3, kb = w8 & 3, nb = 2 * sq + (w8 >> 2);
        const float* W = (e < NE) ? X.w_edown + (size_t)e * 256 * 1024 : X.w_sdown;
        c.src = W + (size_t)(kb * 64) * 1024 + nb * 64; c.dst = (bf16_t*)(X.ws + WS_WD + ((size_t)e * 1024 + nb * 64) * 256 + kb * 64); }
    return c;
}
template <int KB> __device__ __forceinline__ void cvt_store8(const CvtItem& c, int lane, const f32x4 (&v)[16], LAS unsigned char* tl, float sc) {
    const int kq = lane >> 4, nq = lane & 15;
#pragma unroll
    for (int i = 0; i < 4; ++i) { u32x4 w;
        w.x = pk4_fp8(v[0][i] * sc, v[1][i] * sc, v[2][i] * sc, v[3][i] * sc); w.y = pk4_fp8(v[4][i] * sc, v[5][i] * sc, v[6][i] * sc, v[7][i] * sc);
        w.z = pk4_fp8(v[8][i] * sc, v[9][i] * sc, v[10][i] * sc, v[11][i] * sc); w.w = pk4_fp8(v[12][i] * sc, v[13][i] * sc, v[14][i] * sc, v[15][i] * sc);
        *(LAS u32x4*)(tl + (4 * nq + i) * 80 + kq * 16) = w; }
    LDS_WAIT(); asm volatile("" ::: "memory");
    const int ch = lane & 3, r = lane >> 2;
    unsigned char* d8 = (unsigned char*)c.dst;
#pragma unroll
    for (int j = 0; j < 4; ++j) { const int n = 16 * j + r; const u32x4 w = *(const LAS u32x4*)(tl + n * 80 + ch * 16); __builtin_nontemporal_store(w, (u32x4*)(d8 + (size_t)n * KB + 16 * ch)); }
    LDS_WAIT(); asm volatile("" ::: "memory");
}
template <int N> __device__ __forceinline__ void cvt_load(const CvtItem& c, int lane, f32x4 (&v)[16]) {
    const float* p = c.src + (size_t)(16 * (lane >> 4)) * N + 4 * (lane & 15);
#pragma unroll
    for (int j = 0; j < 16; ++j) v[j] = __builtin_nontemporal_load((const f32x4*)(p + (size_t)j * N));
}
template <int K> __device__ __forceinline__ void cvt_store(const CvtItem& c, int lane, const f32x4 (&v)[16], LAS unsigned char* tl) {
    const int kq = lane >> 4, nq = lane & 15;
#pragma unroll
    for (int i = 0; i < 4; ++i) { u32x4 w0, w1;
        w0.x = pk2(v[0][i], v[1][i]); w0.y = pk2(v[2][i], v[3][i]); w0.z = pk2(v[4][i], v[5][i]); w0.w = pk2(v[6][i], v[7][i]);
        w1.x = pk2(v[8][i], v[9][i]); w1.y = pk2(v[10][i], v[11][i]); w1.z = pk2(v[12][i], v[13][i]); w1.w = pk2(v[14][i], v[15][i]);
        LAS unsigned char* q = tl + (4 * nq + i) * 144 + kq * 32; *(LAS u32x4*)q = w0; *(LAS u32x4*)(q + 16) = w1; }
    LDS_WAIT(); asm volatile("" ::: "memory");
    const int ch = lane & 7, r = lane >> 3;
#pragma unroll
    for (int j = 0; j < 8; ++j) { const int n = 8 * j + r; const u32x4 w = *(const LAS u32x4*)(tl + n * 144 + ch * 16); __builtin_nontemporal_store(w, (u32x4*)(c.dst + (size_t)n * K + 8 * ch)); }
    LDS_WAIT(); asm volatile("" ::: "memory");
}
struct CvtPair { const float* src; unsigned char* dst; };
template <bool GU> __device__ __forceinline__ CvtPair cvt_pair(const Ctx& X, int di) {
    CvtPair c;
    if constexpr (GU) { const int e = di >> 6, q = di & 63, nb = q & 7, kb2 = q >> 3;
        const int n0 = nb * 64, pn = n0 >> 8, bj = (n0 >> 7) & 1, idx = n0 & 127, srcc = bj * 256 + pn * 128 + idx;
        const float* W = (e < NE) ? X.w_egu + (size_t)e * 1024 * 512 : X.w_sgu;
        c.src = W + (size_t)(kb2 * 128) * 512 + srcc; c.dst = X.ws + WS_WGU + ((size_t)e * 512 + n0) * 1024 + kb2 * 128; }
    else { const int e = di >> 5, q = di & 31, nb = q & 15, kb2 = q >> 4;
        const float* W = (e < NE) ? X.w_edown + (size_t)e * 256 * 1024 : X.w_sdown;
        c.src = W + (size_t)(kb2 * 128) * 1024 + nb * 64; c.dst = X.ws + WS_WD + ((size_t)e * 1024 + nb * 64) * 256 + kb2 * 128; }
    return c;
}
template <int N> __device__ __forceinline__ void cvt_load_half(const CvtPair& c, int half, int lane, f32x4 (&v)[16]) {
    const float* p = c.src + (size_t)(64 * half + 16 * (lane >> 4)) * N + 4 * (lane & 15);
#pragma unroll
    for (int j = 0; j < 16; ++j) v[j] = __builtin_nontemporal_load((const f32x4*)(p + (size_t)j * N));
}
__device__ __forceinline__ void cvt_half_to_lds(int half, int lane, const f32x4 (&v)[16], LAS unsigned char* tl, float sc) {
    const int kq = lane >> 4, nq = lane & 15;
#pragma unroll
    for (int i = 0; i < 4; ++i) { u32x4 w;
        w.x = pk4_fp8(v[0][i] * sc, v[1][i] * sc, v[2][i] * sc, v[3][i] * sc); w.y = pk4_fp8(v[4][i] * sc, v[5][i] * sc, v[6][i] * sc, v[7][i] * sc);
        w.z = pk4_fp8(v[8][i] * sc, v[9][i] * sc, v[10][i] * sc, v[11][i] * sc); w.w = pk4_fp8(v[12][i] * sc, v[13][i] * sc, v[14][i] * sc, v[15][i] * sc);
        *(LAS u32x4*)(tl + (4 * nq + i) * 144 + half * 64 + kq * 16) = w; }
}
template <int KB> __device__ __forceinline__ void cvt_flush(const CvtPair& c, int lane, LAS unsigned char* tl) {
    LDS_WAIT(); asm volatile("" ::: "memory");
    const int ch = lane & 7, r = lane >> 3;
#pragma unroll
    for (int j = 0; j < 8; ++j) { const int n = 8 * j + r; const u32x4 w = *(const LAS u32x4*)(tl + n * 144 + ch * 16); __builtin_nontemporal_store(w, (u32x4*)(c.dst + (size_t)n * KB + 16 * ch)); }
    LDS_WAIT(); asm volatile("" ::: "memory");
}
template <bool GU> __device__ __forceinline__ void expert_convert_set(Ctx& X, int gw, int NGW, LAS unsigned char* tl) {
    constexpr int NIT = GU ? NEX * 64 : NEX * 32, N = GU ? 512 : 1024, K = GU ? 1024 : 256; constexpr float SC = GU ? WGU_SCALE : WD_SCALE;
    if (gw >= NIT) return;
    const int nmine = (NIT - gw + NGW - 1) / NGW;
    f32x4 va[16], vb[16];
    CvtPair cur = cvt_pair<GU>(X, gw);
    cvt_load_half<N>(cur, 0, X.lane, va); cvt_load_half<N>(cur, 1, X.lane, vb);
    for (int j = 0; j < nmine; ++j) {
        const CvtPair nxt = cvt_pair<GU>(X, gw + (j + 1 < nmine ? j + 1 : j) * NGW);
        __builtin_amdgcn_sched_barrier(0);
        cvt_half_to_lds(0, X.lane, va, tl, SC);
        __builtin_amdgcn_sched_barrier(0);
        cvt_load_half<N>(nxt, 0, X.lane, va);
        __builtin_amdgcn_sched_barrier(0);
        cvt_half_to_lds(1, X.lane, vb, tl, SC);
        cvt_flush<K>(cur, X.lane, tl);
        __builtin_amdgcn_sched_barrier(0);
        cvt_load_half<N>(nxt, 1, X.lane, vb);
        __builtin_amdgcn_sched_barrier(0);
        cur = nxt;
    }
}
__device__ __forceinline__ void expert_convert(Ctx& X, int cw, int ncw) {
    LAS unsigned char* tl = X.lds + X.wave * 16384;
    const int gw = cw * NWAVES + X.wave, NGW = ncw * NWAVES;
    expert_convert_set<true>(X, gw, NGW, tl);
    expert_convert_set<false>(X, gw, NGW, tl);
}

__device__ __forceinline__ void small_transposes(Ctx& X) {
    LAS float* scr = (LAS float*)(X.lds + 16384 + X.wave * 12288);
    const int gw = X.wg * NWAVES + X.wave, NGW = X.G * NWAVES;
    {
        constexpr int I_IN = 16 * 272, I_PA = 8 * 32, I_PB = 8 * 32, I_OUT = 16 * 32, I_R = 16 * 8;
        constexpr int NITEMS = I_IN + I_PA + I_PB + I_OUT + I_R;
        for (int it = gw; it < NITEMS; it += NGW) {
            int r = it;
            if (r < I_IN) { transpose_plain(X.w_in, 1024, INW, WSP(bf16_t, WS_WIN), r, scr, X.lane); continue; } r -= I_IN;
            if (r < I_PA) { transpose_plain(X.w_pa, 512, 1024, WSP(bf16_t, WS_WPA), r, scr, X.lane); continue; } r -= I_PA;
            if (r < I_PB) { transpose_plain(X.w_pb, 512, 1024, WSP(bf16_t, WS_WPB), r, scr, X.lane); continue; } r -= I_PB;
            if (r < I_OUT) { transpose_plain(X.w_out, 1024, 1024, WSP(bf16_t, WS_WOUT), r, scr, X.lane); continue; } r -= I_OUT;
            transpose_plain(X.w_router, 1024, 256, WSP(bf16_t, WS_WR), r, scr, X.lane);
        }
    }
}

__device__ __forceinline__ void norm_rows(Ctx& X, int which) {
    LAS float* sm = (LAS float*)X.lds;
    const float* MODP = WSP(float, WS_MODP); float* MOD = WSP(float, WS_MOD);
    const int rows_per_wg = T / X.G, row0 = X.wg * rows_per_wg, b = row0 / SEQ;
    if (which == 0) {
        for (int i = X.tid; i < 2048; i += NTHREADS) { const int j = b * 6144 + i; float s = X.b_ada[i];
#pragma unroll
            for (int p = 0; p < 16; ++p) s += MODP[(size_t)p * 24576 + j];
            sm[i] = s; }
        const int per = 24576 / X.G;
        for (int i = X.tid; i < per; i += NTHREADS) { const int j = X.wg * per + i; float s = X.b_ada[j % 6144];
#pragma unroll
            for (int p = 0; p < 16; ++p) s += MODP[(size_t)p * 24576 + j];
            MOD[j] = s; }
    } else {
        for (int i = X.tid; i < 2048; i += NTHREADS) sm[i] = MOD[b * 6144 + 3072 + i];
    }
    __syncthreads();
    const float* src = X.x; const bf16_t* srcb = WSP(bf16_t, WS_X1); const float* g = which == 0 ? X.g1 : X.g2;
    bf16_t* H = WSP(bf16_t, WS_H);
    for (int r = X.wave; r < rows_per_wg; r += NWAVES) {
        const int row = row0 + r;
        f32x4 v[2][2]; float s = 0.f;
#pragma unroll
        for (int j = 0; j < 2; ++j) { const int col = 8 * X.lane + 512 * j;
            if (which == 0) { v[j][0] = *(const f32x4*)(src + (size_t)row * D + col); v[j][1] = *(const f32x4*)(src + (size_t)row * D + col + 4); }
            else { const u32x4 wv = *(const u32x4*)(srcb + (size_t)row * D + col); v[j][0] = (f32x4){bflo(wv.x), bfhi(wv.x), bflo(wv.y), bfhi(wv.y)}; v[j][1] = (f32x4){bflo(wv.z), bfhi(wv.z), bflo(wv.w), bfhi(wv.w)}; }
#pragma unroll
            for (int q = 0; q < 2; ++q) s += (v[j][q].x * v[j][q].x + v[j][q].y * v[j][q].y) + (v[j][q].z * v[j][q].z + v[j][q].w * v[j][q].w); }
        const float rstd = rsqrtf(wave_sum(s) * (1.f / D) + EPS);
#pragma unroll
        for (int j = 0; j < 2; ++j) { const int col = 8 * X.lane + 512 * j; float y[8];
#pragma unroll
            for (int q = 0; q < 2; ++q) { const f32x4 gg = *(const f32x4*)(g + col + 4 * q), sh = *(const LAS f32x4*)(sm + col + 4 * q), sc = *(const LAS f32x4*)(sm + 1024 + col + 4 * q);
#pragma unroll
                for (int e = 0; e < 4; ++e) y[4 * q + e] = v[j][q][e] * rstd * gg[e] * (1.f + sc[e]) + sh[e]; }
            u32x4 hw; hw.x = pk2(y[0], y[1]); hw.y = pk2(y[2], y[3]); hw.z = pk2(y[4], y[5]); hw.w = pk2(y[6], y[7]);
            if (which == 1) { st_wt16(H + (size_t)row * D + col, hw);
                st_wt8(WSP(unsigned char, WS_H8) + (size_t)row * D + col, (unsigned long long)pk4_fp8(y[0], y[1], y[2], y[3]) | ((unsigned long long)pk4_fp8(y[4], y[5], y[6], y[7]) << 32)); }
            else *(u32x4*)(H + (size_t)row * D + col) = hw; }
    }
    __syncthreads();
}

struct RegSched {
    static constexpr bool HALFSKIP = false;
    const char* A; const char* Bt; size_t a_tile, b_tile; int nM, nN, G, c;
    __device__ __forceinline__ bool next(int i, pg8::Unit& u) const {
        const int L = i * G + c; if (L >= nM * nN) return false;
        int pm, pn; pg8::swz_tile(L, nM, nN, pm, pn);
        u.a = A + (size_t)pm * a_tile; u.b = Bt + (size_t)pn * b_tile; u.rows = nullptr; u.pm = pm; u.pn = pn; u.aux = 0; u.nvalid = 256; return true;
    }
};
struct TwoPartSched {      static constexpr bool HALFSKIP = false;
    const char* Y; const char* Wa; const char* Wb; int nM, nN, G, c;
    __device__ __forceinline__ bool next(int i, pg8::Unit& u) const {
        const int L = (i >> 1) * G + c, part = i & 1; if (L >= nM * nN) return false;
        int pm, pn; pg8::swz_tile(L, nM, nN, pm, pn);
        u.a = Y + (size_t)pm * 256 * 2048 + part * 1024; u.b = (part ? Wb : Wa) + (size_t)pn * 256 * 1024; u.rows = nullptr; u.pm = pm; u.pn = pn; u.aux = part; u.nvalid = 256; return true;
    }
};
struct MoeSched {
    static constexpr bool HALFSKIP = true;
    const LAS int* tbl; const LAS int* cnts; int nent; const char* A; const char* W; const int* lists; int ncol  , wtile  , wexp  , atile  , G, c;
    __device__ __forceinline__ bool next(int i, pg8::Unit& u) const {
        const int un = i * (G >> 3) + (c >> 3); if (un >= nent * ncol) return false;
        const int pn = un % ncol; const int ent = __builtin_amdgcn_readfirstlane(tbl[un / ncol]), e = (ent >> 7) & 511, r = ent & 127, rt = ent >> 16;
        u.a = A + (size_t)rt * atile; u.b = W + (size_t)e * wexp + (size_t)pn * wtile; u.rows = lists + (size_t)e * 16384 + r * 256;
        u.pm = rt; u.pn = pn; u.aux = e; const int left = __builtin_amdgcn_readfirstlane(cnts[e]) - r * 256; u.nvalid = left < 256 ? left : 256; return true;
    }
};

struct EpiInproj {
    static constexpr bool PERM = true;
    bf16_t* PROJ; float* LOGF; const float* LB; const float* ROPE; unsigned char* G8;
    __device__ __forceinline__ bool keep(const pg8::Unit&) const { return false; }
    __device__ __forceinline__ void operator()(f32x4 (&acc)[2][2][4][2], const pg8::Unit& u, int wr, int wc, int fr, int fq) const {
        const int pn = u.pn;
        const int mode = pn < 2 ? 0 : pn < 4 ? 1 : pn < 6 ? 0 : pn < 8 ? 2 : pn < 20 ? 3 : pn < 26 ? 0 : 4;
        const int row0 = u.pm * 256 + wr * 64 + fr, colb = pn * 256 + wc * 32 + 8 * fq;
        const bool rot = (mode == 3) && ((wc & 1) == 0);
#pragma unroll
        for (int ai = 0; ai < 2; ++ai)
#pragma unroll
            for (int m = 0; m < 4; ++m) {
                const int row = row0 + ai * 128 + m * 16;
                f32x4 cs0, cs1, sn0, sn1;
                if (rot) { const f32x4* rp = (const f32x4*)(ROPE + (size_t)row * 16); cs0 = rp[0]; cs1 = rp[1]; sn0 = rp[2]; sn1 = rp[3]; }
#pragma unroll
                for (int bj = 0; bj < 2; ++bj) {
                    const int col = colb + bj * 128;
                    f32x4 v0 = acc[ai][bj][m][0], v1 = acc[ai][bj][m][1];
                    if (mode == 1) {
                        const int cf = col - 512; const f32x4 l0 = *(const f32x4*)(LB + cf), l1 = *(const f32x4*)(LB + cf + 4);
                        f32x4 lf0, lf1;
#pragma unroll
                        for (int j = 0; j < 4; ++j) { float sg = sigmoidf_(v0[j]); float f = l0[j] + (1.f - l0[j]) * sg; lf0[j] = __logf(f); v0[j] = (1.f - l0[j]) * (1.f - sg);
                            sg = sigmoidf_(v1[j]); f = l1[j] + (1.f - l1[j]) * sg; lf1[j] = __logf(f); v1[j] = (1.f - l1[j]) * (1.f - sg); }
                        acc[ai][bj][m][0] = lf0; acc[ai][bj][m][1] = lf1;
                    } else if (mode == 2) {
#pragma unroll
                        for (int j = 0; j < 4; ++j) { v0[j] = v0[j] * sigmoidf_(v0[j]); v1[j] = v1[j] * sigmoidf_(v1[j]); }
                    } else if (mode == 4) {
#pragma unroll
                        for (int j = 0; j < 4; ++j) { v0[j] = sigmoidf_(v0[j]); v1[j] = sigmoidf_(v1[j]); }
                    } else if (rot) {
                        f32x4 p0, p1;
#pragma unroll
                        for (int j = 0; j < 4; ++j) { p0[j] = __shfl_xor(v0[j], 16); p1[j] = __shfl_xor(v1[j], 16); }
                        if (fq == 0) { v0 = v0 * cs0 - p0 * sn0; v1 = v1 * cs1 - p1 * sn1; }
                        else if (fq == 1) { v0 = v0 * cs0 + p0 * sn0; v1 = v1 * cs1 + p1 * sn1; }
                    }
                    if (mode == 4) {
                        int g0 = 0, g1 = 0;
#pragma unroll
                        for (int j = 0; j < 4; ++j) { g0 = __builtin_amdgcn_cvt_pk_u8_f32(fmaxf(v0[j] * 255.0f, 1.0f), j, g0); g1 = __builtin_amdgcn_cvt_pk_u8_f32(fmaxf(v1[j] * 255.0f, 1.0f), j, g1); }
                        *(u32x2*)(G8 + (size_t)row * 2048 + (col - C_GA)) = (u32x2){(unsigned)g0, (unsigned)g1};
                        continue; }
                    u32x4 w; w.x = pg8::cvt_pk_bf16(v0[0], v0[1]); w.y = pg8::cvt_pk_bf16(v0[2], v0[3]); w.z = pg8::cvt_pk_bf16(v1[0], v1[1]); w.w = pg8::cvt_pk_bf16(v1[2], v1[3]);
                    *(u32x4*)(PROJ + (size_t)row * INW + col) = w;
                }
            }
        if (mode == 1) {
            const int lane = fq * 16 + fr;
#pragma unroll
            for (int ai = 0; ai < 2; ++ai)
#pragma unroll
                for (int bj = 0; bj < 2; ++bj)
#pragma unroll
                    for (int n = 0; n < 2; ++n)
#pragma unroll
                        for (int j = 0; j < 4; ++j) { float carry = 0.f;
#pragma unroll
                            for (int m = 0; m < 4; ++m) { float v = acc[ai][bj][m][n][j];
                                v += __builtin_bit_cast(float, __builtin_amdgcn_update_dpp(0, __builtin_bit_cast(int, v), 0x111, 0xF, 0xF, true));
                                v += __builtin_bit_cast(float, __builtin_amdgcn_update_dpp(0, __builtin_bit_cast(int, v), 0x112, 0xF, 0xF, true));
                                v += __builtin_bit_cast(float, __builtin_amdgcn_update_dpp(0, __builtin_bit_cast(int, v), 0x114, 0xF, 0xF, true));
                                v += __builtin_bit_cast(float, __builtin_amdgcn_update_dpp(0, __builtin_bit_cast(int, v), 0x118, 0xF, 0xF, true));
                                v += carry; acc[ai][bj][m][n][j] = v; carry = __shfl(v, (lane & 48) | 15); } }
#pragma unroll
            for (int ai = 0; ai < 2; ++ai)
#pragma unroll
                for (int m = 0; m < 4; ++m)
#pragma unroll
                    for (int bj = 0; bj < 2; ++bj) { float* lp = LOGF + (size_t)(row0 + ai * 128 + m * 16) * 512 + (colb + bj * 128 - 512); *(f32x4*)lp = acc[ai][bj][m][0]; *(f32x4*)(lp + 4) = acc[ai][bj][m][1]; }
        }
    }
};
__device__ __forceinline__ void gate8(u32x2 w, f32x4& lo, f32x4& hi) {
    constexpr float s = 1.0f / 255.0f;
    lo = (f32x4){(float)(w.x & 255u), (float)((w.x >> 8) & 255u), (float)((w.x >> 16) & 255u), (float)(w.x >> 24)} * s;
    hi = (f32x4){(float)(w.y & 255u), (float)((w.y >> 8) & 255u), (float)((w.y >> 16) & 255u), (float)(w.y >> 24)} * s;
}
struct EpiMixed {
    static constexpr bool PERM = true;
    const unsigned char* G8; bf16_t* MIXED;
    __device__ __forceinline__ bool keep(const pg8::Unit& u) const { return u.aux == 0; }
    __device__ __forceinline__ void operator()(f32x4 (&acc)[2][2][4][2], const pg8::Unit& u, int wr, int wc, int fr, int fq) const {
        const int row0 = u.pm * 256 + wr * 64 + fr, colb = u.pn * 256 + wc * 32 + 8 * fq;
#pragma unroll
        for (int ai = 0; ai < 2; ++ai)
#pragma unroll
            for (int m = 0; m < 4; ++m) {
                const int row = row0 + ai * 128 + m * 16;
#pragma unroll
                for (int bj = 0; bj < 2; ++bj) {
                    const int col = colb + bj * 128;
                    f32x4 b0, b1; gate8(*(const u32x2*)(G8 + (size_t)row * 2048 + 1024 + col), b0, b1);
                    if (u.aux == 0) {
                        f32x4 a0, a1; gate8(*(const u32x2*)(G8 + (size_t)row * 2048 + col), a0, a1);
#pragma unroll
                        for (int j = 0; j < 4; ++j) { acc[ai][bj][m][0][j] *= a0[j] / b0[j]; acc[ai][bj][m][1][j] *= a1[j] / b1[j]; }
                    } else {
                        const f32x4 v0 = acc[ai][bj][m][0] * b0, v1 = acc[ai][bj][m][1] * b1;
                        u32x4 w; w.x = pg8::cvt_pk_bf16(v0[0], v0[1]); w.y = pg8::cvt_pk_bf16(v0[2], v0[3]); w.z = pg8::cvt_pk_bf16(v1[0], v1[1]); w.w = pg8::cvt_pk_bf16(v1[2], v1[3]);
                        st_wt16(MIXED + (size_t)row * D + col, w);
                    }
                }
            }
    }
};
struct EpiOutproj {
    static constexpr bool PERM = true;
    const float* x; const float* MOD; bf16_t* X1;
    __device__ __forceinline__ bool keep(const pg8::Unit&) const { return false; }
    __device__ __forceinline__ void operator()(f32x4 (&acc)[2][2][4][2], const pg8::Unit& u, int wr, int wc, int fr, int fq) const {
        const int row0 = u.pm * 256 + wr * 64 + fr, colb = u.pn * 256 + wc * 32 + 8 * fq;
        const int b = (u.pm * 256) / SEQ;
#pragma unroll
        for (int bj = 0; bj < 2; ++bj) {
            const int col = colb + bj * 128;
            const f32x4 g0 = *(const f32x4*)(MOD + b * 6144 + 2048 + col), g1 = *(const f32x4*)(MOD + b * 6144 + 2048 + col + 4);
#pragma unroll
            for (int ai = 0; ai < 2; ++ai)
#pragma unroll
                for (int m = 0; m < 4; ++m) { const size_t off = (size_t)(row0 + ai * 128 + m * 16) * D + col;
                    const f32x4 v0 = *(const f32x4*)(x + off) + g0 * acc[ai][bj][m][0], v1 = *(const f32x4*)(x + off + 4) + g1 * acc[ai][bj][m][1];
                    u32x4 w; w.x = pg8::cvt_pk_bf16(v0[0], v0[1]); w.y = pg8::cvt_pk_bf16(v0[2], v0[3]); w.z = pg8::cvt_pk_bf16(v1[0], v1[1]); w.w = pg8::cvt_pk_bf16(v1[2], v1[3]);
                    st_wt16(X1 + off, w); }
        }
    }
};
struct EpiOutNorm {
    static constexpr bool PERM = true;
    const float* x; const float* MOD; const float* g2; bf16_t* X1; bf16_t* H; unsigned char* H8; float* XB; unsigned* cnt; LAS unsigned char* sl;
    __device__ __forceinline__ bool keep(const pg8::Unit&) const { return false; }
    __device__ __forceinline__ void operator()(f32x4 (&acc)[2][2][4][2], const pg8::Unit& u, int wr, int wc, int fr, int fq) const {
        const int tid = threadIdx.x;
        const int rl0 = wr * 64 + fr, row0 = u.pm * 256 + rl0, colb = u.pn * 256 + wc * 32 + 8 * fq;
        const int b = (u.pm * 256) / SEQ;
        LAS float* Pt = (LAS float*)sl; LAS float* Rs = (LAS float*)(sl + 4096);
#pragma unroll
        for (int bj = 0; bj < 2; ++bj) {
            const int col = colb + bj * 128;
            const f32x4 g0 = *(const f32x4*)(MOD + b * 6144 + 2048 + col), g1 = *(const f32x4*)(MOD + b * 6144 + 2048 + col + 4);
#pragma unroll
            for (int ai = 0; ai < 2; ++ai)
#pragma unroll
                for (int m = 0; m < 4; ++m) { const size_t off = (size_t)(row0 + ai * 128 + m * 16) * D + col;
                    acc[ai][bj][m][0] = *(const f32x4*)(x + off) + g0 * acc[ai][bj][m][0]; acc[ai][bj][m][1] = *(const f32x4*)(x + off + 4) + g1 * acc[ai][bj][m][1];
                    asm volatile("" : "+v"(acc[ai][bj][m][0]), "+v"(acc[ai][bj][m][1]));
                    if (m & 1) asm volatile("" ::: "memory"); }
        }
#pragma unroll
        for (int ai = 0; ai < 2; ++ai)
#pragma unroll
            for (int m = 0; m < 4; ++m) { float q = 0.f;
#pragma unroll
                for (int bj = 0; bj < 2; ++bj)
#pragma unroll
                    for (int n = 0; n < 2; ++n) { const f32x4 v = acc[ai][bj][m][n]; q += (v[0] * v[0] + v[1] * v[1]) + (v[2] * v[2] + v[3] * v[3]); }
                q += __shfl_xor(q, 16); q += __shfl_xor(q, 32);
                if (fq == 0) Pt[(ai * 128 + rl0 + m * 16) * 4 + wc] = q; }
        asm volatile("s_waitcnt lgkmcnt(0)" ::: "memory"); __builtin_amdgcn_s_barrier(); asm volatile("" ::: "memory");
        if (tid < 256) { const f32x4 p = *(const LAS f32x4*)(Pt + tid * 4); st_wt4(XB + ((size_t)u.pm * 256 + tid) * 4 + u.pn, __builtin_bit_cast(unsigned, (p[0] + p[1]) + (p[2] + p[3]))); }
        asm volatile("s_waitcnt vmcnt(0)" ::: "memory"); __builtin_amdgcn_s_barrier(); asm volatile("" ::: "memory");
        if (tid == 0) { unsigned* p = cnt + (size_t)u.pm * 64; (void)xb_add(p, 1u); unsigned sp = 0u;
            while (xb_ld(p) < 4u) { __builtin_amdgcn_s_sleep(2); if (++sp > (1u << 22)) break; }
            __builtin_amdgcn_fence(__ATOMIC_ACQUIRE, "agent"); asm volatile("s_waitcnt vmcnt(0)" ::: "memory"); }
        __builtin_amdgcn_s_barrier(); asm volatile("" ::: "memory");
        if (tid < 256) { const f32x4 q = *(const f32x4*)(XB + ((size_t)u.pm * 256 + tid) * 4); Rs[tid] = rsqrtf(((q[0] + q[1]) + (q[2] + q[3])) * (1.f / D) + EPS); }
        asm volatile("s_waitcnt vmcnt(0) lgkmcnt(0)" ::: "memory"); __builtin_amdgcn_s_barrier(); asm volatile("" ::: "memory");
#pragma unroll
        for (int bj = 0; bj < 2; ++bj) {
            const int col = colb + bj * 128;
            f32x4 gg[2], sc[2], sh[2];
#pragma unroll
            for (int q = 0; q < 2; ++q) { gg[q] = *(const f32x4*)(g2 + col + 4 * q); sh[q] = *(const f32x4*)(MOD + b * 6144 + 3072 + col + 4 * q); sc[q] = *(const f32x4*)(MOD + b * 6144 + 4096 + col + 4 * q) + 1.0f; gg[q] = gg[q] * sc[q]; }
#pragma unroll
            for (int ai = 0; ai < 2; ++ai)
#pragma unroll
                for (int m = 0; m < 4; ++m) { const int rl = ai * 128 + rl0 + m * 16; const size_t off = (size_t)(u.pm * 256 + rl) * D + col; const float rs = Rs[rl];
                    const f32x4 v0 = acc[ai][bj][m][0], v1 = acc[ai][bj][m][1];
                    u32x4 w; w.x = pg8::cvt_pk_bf16(v0[0], v0[1]); w.y = pg8::cvt_pk_bf16(v0[2], v0[3]); w.z = pg8::cvt_pk_bf16(v1[0], v1[1]); w.w = pg8::cvt_pk_bf16(v1[2], v1[3]);
                    *(u32x4*)(X1 + off) = w;
                    const f32x4 h0 = v0 * rs * gg[0] + sh[0], h1 = v1 * rs * gg[1] + sh[1];
                    u32x4 hw; hw.x = pg8::cvt_pk_bf16(h0[0], h0[1]); hw.y = pg8::cvt_pk_bf16(h0[2], h0[3]); hw.z = pg8::cvt_pk_bf16(h1[0], h1[1]); hw.w = pg8::cvt_pk_bf16(h1[2], h1[3]);
                    st_wt16(H + off, hw);
                    st_wt8(H8 + off, (unsigned long long)pk4_fp8(h0[0], h0[1], h0[2], h0[3]) | ((unsigned long long)pk4_fp8(h1[0], h1[1], h1[2], h1[3]) << 32));
                    asm volatile("" ::: "memory"); }
        }
    }
};
struct EpiRouter {
    static constexpr bool PERM = false;
    float* LOGITS4;
    __device__ __forceinline__ bool keep(const pg8::Unit&) const { return false; }
    __device__ __forceinline__ void operator()(f32x4 (&acc)[2][2][4][2], const pg8::Unit& u, int wr, int wc, int fr, int fq) const {
        const int row0 = u.pm * 256 + wr * 64 + fr, colb = wc * 32 + 4 * fq;
        float* base = LOGITS4 + (size_t)u.aux * T * 256;
#pragma unroll
        for (int ai = 0; ai < 2; ++ai)
#pragma unroll
            for (int m = 0; m < 4; ++m)
#pragma unroll
                for (int bj = 0; bj < 2; ++bj)
#pragma unroll
                    for (int n = 0; n < 2; ++n) st_wt16(base + (size_t)(row0 + ai * 128 + m * 16) * 256 + colb + bj * 128 + n * 16, __builtin_bit_cast(u32x4, acc[ai][bj][m][n]));
    }
};
struct RouterSched {
    static constexpr bool HALFSKIP = false;
    const char* A; const char* Bt; int G, c;
    __device__ __forceinline__ bool next(int i, pg8::Unit& u) const {
        const int L = i * G + c; if (L >= 256) return false;
        const int pm = L >> 2, ks = L & 3;
        u.a = A + (size_t)pm * 256 * 2048 + ks * 512; u.b = Bt + ks * 512; u.rows = nullptr; u.pm = pm; u.pn = 0; u.aux = ks; u.nvalid = 256; return true;
    }
};
struct EpiGU {
    static constexpr bool PERM = true;
    unsigned char* ACT;
    __device__ __forceinline__ bool keep(const pg8::Unit&) const { return false; }
    __device__ __forceinline__ void operator()(f32x4 (&acc)[2][2][4][2], const pg8::Unit& u, int wr, int wc, int fr, int fq) const {
        const int rl0 = wr * 64 + fr, col = u.pn * 128 + wc * 32 + 8 * fq;
        constexpr float is = 1.0f / WGU_SCALE;
#pragma unroll
        for (int ai = 0; ai < 2; ++ai)
#pragma unroll
            for (int m = 0; m < 4; ++m) {
                const int rl = rl0 + ai * 128 + m * 16;
                f32x4 v0, v1;
#pragma unroll
                for (int j = 0; j < 4; ++j) { const float a0 = acc[ai][0][m][0][j] * is, a1 = acc[ai][0][m][1][j] * is;
                    v0[j] = a0 * sigmoidf_(a0) * (acc[ai][1][m][0][j] * is); v1[j] = a1 * sigmoidf_(a1) * (acc[ai][1][m][1][j] * is); }
                *(u32x2*)(ACT + ((size_t)u.pm * 256 + rl) * EFF + col) = (u32x2){pk4_fp8(v0[0], v0[1], v0[2], v0[3]), pk4_fp8(v1[0], v1[1], v1[2], v1[3])};
                asm volatile("" ::: "memory");
            }
    }
};
struct EpiDown {
    static constexpr bool PERM = true;
    unsigned char* YBUF; const float* GATEW;
    __device__ __forceinline__ bool keep(const pg8::Unit&) const { return false; }
    __device__ __forceinline__ void operator()(f32x4 (&acc)[2][2][4][2], const pg8::Unit& u, int wr, int wc, int fr, int fq) const {
        const int rl0 = wr * 64 + fr, colb = u.pn * 256 + wc * 32 + 8 * fq;
#pragma unroll
        for (int ai = 0; ai < 2; ++ai)
#pragma unroll
            for (int m = 0; m < 4; ++m) {
                const int rl = rl0 + ai * 128 + m * 16;
                if (rl < u.nvalid) {
                    const int slot = u.rows[rl]; const float gw = GATEW[slot] * (YSCALE / WD_SCALE);
#pragma unroll
                    for (int bj = 0; bj < 2; ++bj) { const f32x4 v0 = acc[ai][bj][m][0] * gw, v1 = acc[ai][bj][m][1] * gw;
                        *(u32x2*)(YBUF + (size_t)slot * D + colb + bj * 128) = (u32x2){pk4_fp8(v0[0], v0[1], v0[2], v0[3]), pk4_fp8(v1[0], v1[1], v1[2], v1[3])}; }
                }
                asm volatile("" ::: "memory");
            }
    }
};

#define MFMA16(a, b, c) __builtin_amdgcn_mfma_f32_16x16x32_bf16((a), (b), (c), 0, 0, 0)
#define MFMA32(a, b, c) __builtin_amdgcn_mfma_f32_32x32x16_bf16((a), (b), (c), 0, 0, 0)
__device__ __forceinline__ s16x4 tr16(const LAS unsigned char* p) { return __builtin_amdgcn_ds_read_tr16_b64_v4i16((LAS s16x4*)p); }
__device__ __forceinline__ bf16x8 cat8(s16x4 a, s16x4 b) { bf16x8 r; r[0] = a[0]; r[1] = a[1]; r[2] = a[2]; r[3] = a[3]; r[4] = b[0]; r[5] = b[1]; r[6] = b[2]; r[7] = b[3]; return r; }
__device__ __forceinline__ u32x4 pack8(const float (&v)[8]) { u32x4 w; w.x = pg8::cvt_pk_bf16(v[0], v[1]); w.y = pg8::cvt_pk_bf16(v[2], v[3]); w.z = pg8::cvt_pk_bf16(v[4], v[5]); w.w = pg8::cvt_pk_bf16(v[6], v[7]); return w; }
__device__ __forceinline__ void unpack8(u32x4 w, float (&v)[8]) { v[0] = bflo(w.x); v[1] = bfhi(w.x); v[2] = bflo(w.y); v[3] = bfhi(w.y); v[4] = bflo(w.z); v[5] = bfhi(w.z); v[6] = bflo(w.w); v[7] = bfhi(w.w); }
__device__ __forceinline__ int swzA(int row) { return (row & 3) | (((row >> 3) & 1) << 2); }
__device__ __forceinline__ void hgrn_kv_unit(Ctx& X, int bn) {
    const int t0 = bn * 64;
    const bf16_t* PROJ = WSP(bf16_t, WS_PROJ); const float* BC = WSP(float, WS_LOGF);
#pragma unroll 2
    for (int j = 0; j < 8; ++j) {
        const int p = X.tid + NTHREADS * j, row = p >> 6, c64 = p & 63, h = c64 >> 4, ch = c64 & 15;
        const size_t prow = (size_t)(t0 + row) * INW + h * 128 + 8 * ch;
        const u32x4 kraw = *(const u32x4*)(PROJ + prow + C_HK), vraw = *(const u32x4*)(PROJ + prow + C_HV);
        const float* bp = BC + (size_t)(t0 + row) * 512 + h * 128 + 8 * ch; const float* bl = BC + (size_t)(t0 + 63) * 512 + h * 128 + 8 * ch;
        const f32x4 b0 = *(const f32x4*)bp, b1 = *(const f32x4*)(bp + 4), l0 = *(const f32x4*)bl, l1 = *(const f32x4*)(bl + 4);
        float kv[8]; unpack8(kraw, kv);
#pragma unroll
        for (int e = 0; e < 4; ++e) { kv[e] *= __expf(l0[e] - b0[e]); kv[4 + e] *= __expf(l1[e] - b1[e]); }
        const int off = row * 256 + (((ch >> 1) ^ swzA(row)) * 32) + (ch & 1) * 16;
        *(LAS u32x4*)(X.lds + h * 32768 + off) = vraw; *(LAS u32x4*)(X.lds + h * 32768 + 16384 + off) = pack8(kv);
    }
    WSP(float, WS_DECAY)[bn * 512 + X.tid] = __expf(BC[(size_t)(t0 + 63) * 512 + X.tid]);
    __syncthreads();
    const int l = X.lane, w = X.wave, fr = l & 15, fq = l >> 4, r = fr >> 2, p4 = l & 3, h = w >> 1, vt0 = 4 * (w & 1);
    const LAS unsigned char* VI = X.lds + h * 32768; const LAS unsigned char* KI = VI + 16384;
    bf16x8 af[4][2];
#pragma unroll
    for (int vt = 0; vt < 4; ++vt)
#pragma unroll
        for (int kk = 0; kk < 2; ++kk) { const int r0 = 32 * kk + 8 * fq + r, r1 = r0 + 4;
            af[vt][kk] = cat8(tr16(VI + r0 * 256 + (((vt0 + vt) ^ swzA(r0)) * 32) + p4 * 8), tr16(VI + r1 * 256 + (((vt0 + vt) ^ swzA(r1)) * 32) + p4 * 8)); }
    bf16_t* KVT = WSP(bf16_t, WS_KVT) + (size_t)(bn * 4 + h) * 16384;
#pragma unroll 2
    for (int ct = 0; ct < 8; ++ct) {
        bf16x8 bfr[2];
#pragma unroll
        for (int kk = 0; kk < 2; ++kk) { const int r0 = 32 * kk + 8 * fq + r, r1 = r0 + 4;
            bfr[kk] = cat8(tr16(KI + r0 * 256 + ((ct ^ swzA(r0)) * 32) + p4 * 8), tr16(KI + r1 * 256 + ((ct ^ swzA(r1)) * 32) + p4 * 8)); }
#pragma unroll
        for (int vt = 0; vt < 4; ++vt) { f32x4 acc = {0.f, 0.f, 0.f, 0.f}; acc = MFMA16(bfr[0], af[vt][0], acc); acc = MFMA16(bfr[1], af[vt][1], acc);
            u32x2 wv; wv.x = pg8::cvt_pk_bf16(acc[0], acc[1]); wv.y = pg8::cvt_pk_bf16(acc[2], acc[3]);
            *(u32x2*)(KVT + (16 * (vt0 + vt) + fr) * 128 + 16 * ct + 4 * fq) = wv; }
    }
    __syncthreads();
}
__device__ __forceinline__ void hgrn_passB(Ctx& X) {
    const unsigned* KVT = WSP(unsigned, WS_KVT); const float* DECAY = WSP(float, WS_DECAY); unsigned* SPT = WSP(unsigned, WS_SPT);
    const int gt = X.wg * NTHREADS + X.tid, NGT = X.G * NTHREADS;
    for (int item = gt; item < 16 * 128 * 64; item += NGT) {
        const int bh = item >> 13, rem = item & 8191, vd = rem >> 6, c = (rem & 63) * 2, b = bh >> 2, h = bh & 3;
        float s0 = 0.f, s1 = 0.f;
#pragma unroll 8
        for (int n = 0; n < 64; ++n) {
            const int unit = (b * 64 + n) * 4 + h;
            const unsigned kw = KVT[((size_t)unit * 16384 + vd * 128 + c) >> 1]; const f32x2 kv = {bflo(kw), bfhi(kw)};
            const f32x2 dc = *(const f32x2*)(DECAY + unit * 128 + c);
            SPT[((size_t)unit * 16384 + vd * 128 + c) >> 1] = pk2(s0, s1);
            s0 = dc.x * s0 + kv.x; s1 = dc.y * s1 + kv.y;
        }
    }
}
__device__ __forceinline__ void hgrn_out_unit(Ctx& X, int u2) {
    const int bn = u2 >> 1, hp = u2 & 1, t0 = bn * 64;
    const bf16_t* PROJ = WSP(bf16_t, WS_PROJ); const float* BCg = WSP(float, WS_LOGF);
#pragma unroll 2
    for (int j = 0; j < 4; ++j) { const int p = X.tid + NTHREADS * j, row = p >> 5, c32 = p & 31, hh = c32 >> 4, ch = c32 & 15, h = 2 * hp + hh;
        const size_t prow = (size_t)(t0 + row) * INW + h * 128 + 8 * ch;
        const u32x4 qraw = *(const u32x4*)(PROJ + prow + C_HQ), kraw = *(const u32x4*)(PROJ + prow + C_HK), vraw = *(const u32x4*)(PROJ + prow + C_HV);
        const float* bp = BCg + (size_t)(t0 + row) * 512 + h * 128 + 8 * ch; const float* br = BCg + (size_t)(t0 + 32) * 512 + h * 128 + 8 * ch;
        const f32x4 b0 = *(const f32x4*)bp, b1 = *(const f32x4*)(bp + 4), r0 = *(const f32x4*)br, r1 = *(const f32x4*)(br + 4);
        float qv[8], kv[8], a[8], bq[8]; unpack8(qraw, qv); unpack8(kraw, kv);
#pragma unroll
        for (int e = 0; e < 4; ++e) { const float e0 = __expf(b0[e] - r0[e]), e1 = __expf(b1[e] - r1[e]);
            a[e] = qv[e] * e0; a[4 + e] = qv[4 + e] * e1; kv[e] *= __builtin_amdgcn_rcpf(e0); kv[4 + e] *= __builtin_amdgcn_rcpf(e1);
            bq[e] = qv[e] * __expf(b0[e]); bq[4 + e] = qv[4 + e] * __expf(b1[e]); }
        LAS unsigned char* hb = X.lds + hh * 65536; const int o16 = row * 256 + ((ch ^ (row & 15)) * 16);
        *(LAS u32x4*)(hb + o16) = pack8(a); *(LAS u32x4*)(hb + 16384 + o16) = pack8(kv); *(LAS u32x4*)(hb + 32768 + o16) = pack8(bq);
        *(LAS u32x4*)(hb + 49152 + row * 256 + (((ch >> 1) ^ (row & 7)) * 32) + (ch & 1) * 16) = vraw; }
    const int l = X.lane, w = X.wave, fr = l & 15, fq = l >> 4, r = fr >> 2, p4 = l & 3, hh = w >> 2, h = 2 * hp + hh, ti = w & 3;
    const int tq = 16 * ti + fr;
    const bf16_t* SPT = WSP(bf16_t, WS_SPT) + (size_t)(bn * 4 + h) * 16384;
    __syncthreads();
    const LAS unsigned char* QSI = X.lds + hh * 65536; const LAS unsigned char* KSI = QSI + 16384; const LAS unsigned char* QNI = QSI + 32768; const LAS unsigned char* VI = QSI + 49152;
    bf16x8 QS[4];
#pragma unroll
    for (int ks = 0; ks < 4; ++ks) QS[ks] = *(const LAS bf16x8*)(QSI + tq * 256 + (((4 * ks + fq) ^ (tq & 15)) * 16));
    f32x4 ST[4];
#pragma unroll
    for (int si = 0; si < 4; ++si) {
        f32x4 acc = {0.f, 0.f, 0.f, 0.f};
        if (si <= ti) {
            const int sr = 16 * si + fr;
#pragma unroll
            for (int ks = 0; ks < 4; ++ks) { const bf16x8 kf = *(const LAS bf16x8*)(KSI + sr * 256 + (((4 * ks + fq) ^ (sr & 15)) * 16)); acc = MFMA16(kf, QS[ks], acc); }
            if (si == ti) {
#pragma unroll
                for (int q = 0; q < 4; ++q) acc[q] = (4 * fq + q <= fr) ? acc[q] : 0.f; }
        }
        ST[si] = acc;
    }
    f32x4 o[8];
#pragma unroll
    for (int vt = 0; vt < 8; ++vt) o[vt] = (f32x4){0.f, 0.f, 0.f, 0.f};
#pragma unroll
    for (int kk = 0; kk < 2; ++kk) {
        if (2 * kk <= ti) {
            float pv[8];
#pragma unroll
            for (int q = 0; q < 4; ++q) { pv[q] = ST[2 * kk][q]; pv[4 + q] = ST[2 * kk + 1][q]; }
            const bf16x8 pf = __builtin_bit_cast(bf16x8, pack8(pv));
            const int r0 = 32 * kk + 4 * fq + r, r1 = r0 + 16;
#pragma unroll
            for (int vt = 0; vt < 8; ++vt) { const bf16x8 va = cat8(tr16(VI + r0 * 256 + ((vt ^ (r0 & 7)) * 32) + p4 * 8), tr16(VI + r1 * 256 + ((vt ^ (r1 & 7)) * 32) + p4 * 8));
                o[vt] = MFMA16(va, pf, o[vt]); }
        }
    }
#pragma unroll
    for (int ks = 0; ks < 4; ++ks) { const bf16x8 qn = *(const LAS bf16x8*)(QNI + tq * 256 + (((4 * ks + fq) ^ (tq & 15)) * 16));
#pragma unroll
        for (int vt = 0; vt < 8; ++vt) { const bf16x8 sa = *(const bf16x8*)(SPT + (16 * vt + fr) * 128 + 32 * ks + 8 * fq); o[vt] = MFMA16(sa, qn, o[vt]); } }
    float ss = 0.f;
#pragma unroll
    for (int vt = 0; vt < 8; ++vt) ss += (o[vt][0] * o[vt][0] + o[vt][1] * o[vt][1]) + (o[vt][2] * o[vt][2] + o[vt][3] * o[vt][3]);
    ss += __shfl_xor(ss, 16); ss += __shfl_xor(ss, 32);
    const float rstd = rsqrtf(ss * (1.f / 128.f) + EPS);
    bf16_t* YCAT = WSP(bf16_t, WS_YCAT);
#pragma unroll
    for (int vt = 0; vt < 8; ++vt) { const int vd = 16 * vt + 4 * fq;
        const u32x2 sg = *(const u32x2*)(PROJ + (size_t)(t0 + tq) * INW + C_HG + h * 128 + vd); const f32x4 gn = *(const f32x4*)(X.g_hgrn + h * 128 + vd);
        u32x2 wv; wv.x = pg8::cvt_pk_bf16(o[vt][0] * rstd * gn[0] * bflo(sg.x), o[vt][1] * rstd * gn[1] * bfhi(sg.x)); wv.y = pg8::cvt_pk_bf16(o[vt][2] * rstd * gn[2] * bflo(sg.y), o[vt][3] * rstd * gn[3] * bfhi(sg.y));
        *(u32x2*)(YCAT + (size_t)(t0 + tq) * D + h * 128 + vd) = wv; }
    __syncthreads();
}

struct AttnRegs { u32x4 k[6], v[6]; bf16x8 q[4]; };
__device__ __forceinline__ void attn_load(Ctx& X, int unit, AttnRegs& R) {
    const int u16 = unit & 15, h = (unit >> 4) & 7, g = (unit >> 7) % 3, b = unit / 384;
    const int d = g == 0 ? 1 : g == 1 ? 4 : 16, nblk = 16 / d, r = u16 / nblk, blk = u16 % nblk;
    const int qcol = C_AQ + g * 512 + h * 64, kcol = C_AK + g * 512 + h * 64, vcol = C_AV + g * 512 + h * 64;
    const int mk0 = blk * 256 - 128;
    const bf16_t* PROJ = WSP(bf16_t, WS_PROJ);
#pragma unroll
    for (int j = 0; j < 6; ++j) { const int idx = X.tid + NTHREADS * j, row = idx >> 3, ch = idx & 7, m = mk0 + row;
        R.k[j] = (u32x4){0u, 0u, 0u, 0u}; R.v[j] = (u32x4){0u, 0u, 0u, 0u};
        if (m >= 0) { const size_t tok = (size_t)b * SEQ + (size_t)m * d + r; R.k[j] = *(const u32x4*)(PROJ + tok * INW + kcol + ch * 8); R.v[j] = *(const u32x4*)(PROJ + tok * INW + vcol + ch * 8); } }
    const int l = X.lane, w = X.wave, q = l & 31, hi = l >> 5;
    const size_t tokq = (size_t)b * SEQ + (size_t)(blk * 256 + 32 * w + q) * d + r;
#pragma unroll
    for (int ds = 0; ds < 4; ++ds) R.q[ds] = *(const bf16x8*)(PROJ + tokq * INW + qcol + ds * 16 + hi * 8);
}
__device__ __forceinline__ void attn_stage(Ctx& X, const AttnRegs& R) {
    LAS unsigned char* KL = X.lds; LAS unsigned char* VL = X.lds + 55296;
#pragma unroll
    for (int j = 0; j < 6; ++j) { const int idx = X.tid + NTHREADS * j, row = idx >> 3, ch = idx & 7;
        *(LAS u32x4*)(KL + row * 144 + ch * 16) = R.k[j]; *(LAS u32x4*)(VL + row * 128 + ch * 16) = R.v[j]; }
}
__device__ __forceinline__ void attn_compute(Ctx& X, int unit, const bf16x8 (&qf)[4]) {
    const int u16 = unit & 15, h = (unit >> 4) & 7, g = (unit >> 7) % 3, b = unit / 384;
    const int d = g == 0 ? 1 : g == 1 ? 4 : 16, nblk = 16 / d, r = u16 / nblk, blk = u16 % nblk;
    const int mk0 = blk * 256 - 128;
    LAS unsigned char* KL = X.lds; LAS unsigned char* VL = X.lds + 55296;
    const int l = X.lane, w = X.wave, q = l & 31, hi = l >> 5;
    const size_t tokq = (size_t)b * SEQ + (size_t)(blk * 256 + 32 * w + q) * d + r;
    f32x16 s[5];
#pragma unroll
    for (int kt = 0; kt < 5; ++kt) {
        f32x16 acc;
#pragma unroll
        for (int i = 0; i < 16; ++i) acc[i] = 0.f;
#pragma unroll
        for (int ds = 0; ds < 4; ++ds) { const bf16x8 kf = *(const LAS bf16x8*)(KL + (32 * w + 32 * kt + q) * 144 + ds * 32 + hi * 16); acc = MFMA32(kf, qf[ds], acc); }
        s[kt] = acc;
    }
    const int iq = 32 * w + q;
    const int jmin = iq > -mk0 ? iq : -mk0; const unsigned jspan = (unsigned)(iq + 128 - jmin);
    float mx = -INFINITY;
#pragma unroll
    for (int kt = 0; kt < 5; ++kt)
#pragma unroll
        for (int rg = 0; rg < 16; ++rg) { const int j = 32 * w + 32 * kt + (rg & 3) + 8 * (rg >> 2) + 4 * hi;
            const bool valid = (unsigned)(j - jmin) <= jspan;
            s[kt][rg] = valid ? s[kt][rg] : -INFINITY; mx = fmaxf(mx, s[kt][rg]); if ((rg & 3) == 3) __builtin_amdgcn_sched_barrier(0); }
    mx = fmaxf(mx, __shfl_xor(mx, 32));
    const float c2 = 0.125f * 1.4426950408889634f;
    float lsum = 0.f;
#pragma unroll
    for (int kt = 0; kt < 5; ++kt)
#pragma unroll
        for (int rg = 0; rg < 16; ++rg) { const float p = exp2f((s[kt][rg] - mx) * c2); s[kt][rg] = p; lsum += p; }
    lsum += __shfl_xor(lsum, 32);
    f32x16 o[2];
#pragma unroll
    for (int dt = 0; dt < 2; ++dt)
#pragma unroll
        for (int i = 0; i < 16; ++i) o[dt][i] = 0.f;
    const int vlane = ((l & 15) >> 2) * 128 + (((l >> 4) & 1) * 16 + (l & 3) * 4) * 2;
#pragma unroll
    for (int kt = 0; kt < 5; ++kt)
#pragma unroll
        for (int s2 = 0; s2 < 2; ++s2) {
            bf16x8 pb;
#pragma unroll
            for (int j = 0; j < 8; j += 2) { const unsigned pw = pg8::cvt_pk_bf16(s[kt][8 * s2 + j], s[kt][8 * s2 + j + 1]); pb[j] = (short)(pw & 0xffffu); pb[j + 1] = (short)(pw >> 16); }
            const int key0 = 32 * w + 32 * kt + 16 * s2 + 4 * hi;
#pragma unroll
            for (int dt = 0; dt < 2; ++dt) {
                LAS unsigned char* vp = VL + key0 * 128 + dt * 64 + vlane;
                const s16x4 t0 = __builtin_amdgcn_ds_read_tr16_b64_v4i16((LAS s16x4*)vp);
                const s16x4 t1 = __builtin_amdgcn_ds_read_tr16_b64_v4i16((LAS s16x4*)(vp + 8 * 128));
                bf16x8 va; va[0] = t0[0]; va[1] = t0[1]; va[2] = t0[2]; va[3] = t0[3]; va[4] = t1[0]; va[5] = t1[1]; va[6] = t1[2]; va[7] = t1[3];
                o[dt] = MFMA32(va, pb, o[dt]);
            }
        }
    const float inv = 1.0f / lsum;
    bf16_t* OG = WSP(bf16_t, WS_OG) + (size_t)g * T * 512;
#pragma unroll
    for (int dt = 0; dt < 2; ++dt)
#pragma unroll
        for (int rg = 0; rg < 4; ++rg) { const int d0 = 32 * dt + 8 * rg + 4 * hi;
            u32x2 wv; wv.x = pg8::cvt_pk_bf16(o[dt][4 * rg] * inv, o[dt][4 * rg + 1] * inv); wv.y = pg8::cvt_pk_bf16(o[dt][4 * rg + 2] * inv, o[dt][4 * rg + 3] * inv);
            *(u32x2*)(OG + tokq * 512 + h * 64 + d0) = wv; }
    if (hi == 0) WSP(float, WS_LSE)[((size_t)g * T + tokq) * 8 + h] = mx * 0.125f + __logf(lsum);
}
__device__ __forceinline__ void attn_combine(Ctx& X) {
    const bf16_t* OG = WSP(bf16_t, WS_OG); const float* LSE = WSP(float, WS_LSE); bf16_t* YCAT = WSP(bf16_t, WS_YCAT);
    const int gt = X.wg * NTHREADS + X.tid, NGT = X.G * NTHREADS;
    for (int item = gt; item < T * 64; item += NGT) {
        const int t = item >> 6, ch = item & 63, h = ch >> 3;
        const float l0 = LSE[(size_t)t * 8 + h], l1 = LSE[((size_t)T + t) * 8 + h], l2 = LSE[((size_t)2 * T + t) * 8 + h];
        const float m = fmaxf(l0, fmaxf(l1, l2)); float w0 = __expf(l0 - m), w1 = __expf(l1 - m), w2 = __expf(l2 - m); const float inv = 1.f / (w0 + w1 + w2); w0 *= inv; w1 *= inv; w2 *= inv;
        const u32x4 a = *(const u32x4*)(OG + (size_t)t * 512 + ch * 8), bq = *(const u32x4*)(OG + ((size_t)T + t) * 512 + ch * 8), cq = *(const u32x4*)(OG + ((size_t)2 * T + t) * 512 + ch * 8);
        u32x4 o;
#pragma unroll
        for (int j = 0; j < 4; ++j) o[j] = pk2(w0 * bflo(a[j]) + w1 * bflo(bq[j]) + w2 * bflo(cq[j]), w0 * bfhi(a[j]) + w1 * bfhi(bq[j]) + w2 * bfhi(cq[j]));
        *(u32x4*)(YCAT + (size_t)t * D + 512 + ch * 8) = o;
    }
}

__device__ __forceinline__ unsigned sortable_key(float f) { const unsigned u = __builtin_bit_cast(unsigned, f); return (u & 0x80000000u) ? ~u : (u | 0x80000000u); }
__device__ __forceinline__ void moe_route(Ctx& X, bool local) {
    const float* LG = WSP(float, WS_KVT); unsigned* CNT = WSP(unsigned, WS_CTL) + CW_CNT; int* LISTS = WSP(int, WS_LISTS); float* GATEW = WSP(float, WS_GATEW);
    const int gw = X.wg * NWAVES + X.wave, NGW = X.G * NWAVES, l = X.lane, grp = l >> 3;
    const f32x4 bias = *(const f32x4*)(X.rbias + 4 * l);
    const unsigned long long ltmask = (1ull << l) - 1ull;
    const int tbeg = local ? X.wg * 64 + X.wave : gw, tend = local ? X.wg * 64 + 64 : T, tstep = local ? NWAVES : NGW;
    for (int t = tbeg; t < tend; t += tstep) {
        f32x4 lg = *(const f32x4*)(LG + (size_t)t * 256 + 4 * l);
#pragma unroll
        for (int ks = 1; ks < 4; ++ks) lg += *(const f32x4*)(LG + ((size_t)ks * T + t) * 256 + 4 * l);
        float sc[4], mb[4];
#pragma unroll
        for (int i = 0; i < 4; ++i) { sc[i] = sigmoidf_(lg[i]); mb[i] = sc[i] + bias[i]; }
        float m1 = fmaxf(mb[0], mb[1]), m2 = fminf(mb[0], mb[1]);
        { const float a1 = fmaxf(mb[2], mb[3]), a2 = fminf(mb[2], mb[3]); const float n1 = fmaxf(m1, a1), n2 = fmaxf(fminf(m1, a1), fmaxf(m2, a2)); m1 = n1; m2 = n2; }
#pragma unroll
        for (int o = 1; o < 8; o <<= 1) { const float a1 = __shfl_xor(m1, o), a2 = __shfl_xor(m2, o); const float n1 = fmaxf(m1, a1), n2 = fmaxf(fminf(m1, a1), fmaxf(m2, a2)); m1 = n1; m2 = n2; }
        const float gs = m1 + m2;
        int rank = 0;
#pragma unroll
        for (int gg = 0; gg < 8; ++gg) { const float og = __builtin_bit_cast(float, __builtin_amdgcn_readlane(__builtin_bit_cast(int, gs), gg * 8)); rank += (og > gs || (og == gs && gg < grp)) ? 1 : 0; }
        const bool sel = rank < 4;
        unsigned key[4];
#pragma unroll
        for (int i = 0; i < 4; ++i) key[i] = sel ? sortable_key(mb[i]) : 0u;
        unsigned pre = 0u;
#pragma unroll 1
        for (int bit = 31; bit >= 0; --bit) { const unsigned cand = pre | (1u << bit);
            const int cnt = __popcll(__ballot(key[0] >= cand)) + __popcll(__ballot(key[1] >= cand)) + __popcll(__ballot(key[2] >= cand)) + __popcll(__ballot(key[3] >= cand));
            if (cnt >= TOPK) pre = cand; }
        int ngt = 0, eqb = 0, tkb = 0; bool take[4];
#pragma unroll
        for (int i = 0; i < 4; ++i) ngt += __popcll(__ballot(key[i] > pre));
        const int need = TOPK - ngt;
#pragma unroll
        for (int i = 0; i < 4; ++i) eqb += __popcll(__ballot(key[i] == pre) & ltmask);
        int eqrun = eqb;
#pragma unroll
        for (int i = 0; i < 4; ++i) { const bool eq = key[i] == pre; take[i] = (key[i] > pre) || (eq && eqrun < need); eqrun += eq ? 1 : 0; }
#pragma unroll
        for (int i = 0; i < 4; ++i) tkb += __popcll(__ballot(take[i]) & ltmask);
        float part = 0.f;
#pragma unroll
        for (int i = 0; i < 4; ++i) part += take[i] ? sc[i] : 0.f;
        const float scale = 2.5f / wave_sum(part);
        int slot = tkb;
#pragma unroll
        for (int i = 0; i < 4; ++i) if (take[i]) { const int e = 4 * l + i; const unsigned pos = atomicAdd(&CNT[e * 64], 1u); LISTS[(size_t)e * 16384 + pos] = t * NSLOT + slot; GATEW[t * NSLOT + slot] = sc[i] * scale; ++slot; }
        if (l == 0) { LISTS[(size_t)NE * 16384 + t] = t * NSLOT + TOPK; GATEW[t * NSLOT + TOPK] = 1.0f; }
    }
}
__device__ __forceinline__ int moe_table(Ctx& X) {
    LAS int* tbl = (LAS int*)(X.lds + TBL_OFF); LAS int* cnts = (LAS int*)(X.lds + TCNT_OFF); LAS int* pref = cnts + 320;
    const unsigned* CNT = WSP(unsigned, WS_CTL) + CW_CNT;
    const int x = X.wg & 7;
    if (X.tid < NEX) cnts[X.tid] = X.tid < NE ? (int)__hip_atomic_load(CNT + X.tid * 64, __ATOMIC_RELAXED, __HIP_MEMORY_SCOPE_AGENT) : T;
    __syncthreads();
    if (X.tid < NEX) { int pre = 0; for (int e = 0; e < X.tid; ++e) pre += (cnts[e] + 255) >> 8; pref[X.tid] = pre; }
    __syncthreads();
    if (X.tid < 33) {
        const int i = X.tid; int lp = 0; for (int k = 0; k < i && k < 32; ++k) lp += (cnts[x + 8 * k] + 255) >> 8;
        if (i < 32) { const int e = x + 8 * i, n = (cnts[e] + 255) >> 8, p0 = pref[e]; for (int r = 0; r < n; ++r) tbl[lp + r] = ((p0 + r) << 16) | (e << 7) | r; }
        else { const int p0 = pref[NE]; for (int r8 = 0; r8 < 8; ++r8) { const int r = 8 * x + r8; tbl[lp + r8] = ((p0 + r) << 16) | (NE << 7) | r; } cnts[600] = lp + 8; }
    }
    __syncthreads();
    return __builtin_amdgcn_readfirstlane(cnts[600]);
}
__device__ __forceinline__ void final_rows(Ctx& X) {
    const bf16_t* X1 = WSP(bf16_t, WS_X1); const float* MOD = WSP(float, WS_MOD); const unsigned char* YBUF = WSP(unsigned char, WS_YBUF);
    const int gw = X.wg * NWAVES + X.wave, NGW = X.G * NWAVES, l = X.lane;
    for (int t = gw; t < T; t += NGW) {
        const int b = t / SEQ; f32x4 v[2][2]; float s = 0.f;
#pragma unroll
        for (int j = 0; j < 2; ++j) { const int col = 8 * l + 512 * j; f32x4 m0 = {0.f, 0.f, 0.f, 0.f}, m1 = {0.f, 0.f, 0.f, 0.f};
#pragma unroll
            for (int k = 0; k < NSLOT; ++k) { const u32x2 y = *(const u32x2*)(YBUF + ((size_t)t * NSLOT + k) * D + col);
                const f32x2 a = __builtin_amdgcn_cvt_pk_f32_fp8((int)y.x, false), bq = __builtin_amdgcn_cvt_pk_f32_fp8((int)y.x, true), c = __builtin_amdgcn_cvt_pk_f32_fp8((int)y.y, false), d = __builtin_amdgcn_cvt_pk_f32_fp8((int)y.y, true);
                m0.x += a[0]; m0.y += a[1]; m0.z += bq[0]; m0.w += bq[1]; m1.x += c[0]; m1.y += c[1]; m1.z += d[0]; m1.w += d[1]; }
            const f32x4 g0 = *(const f32x4*)(MOD + b * 6144 + 5120 + col) * (1.0f / YSCALE), g1 = *(const f32x4*)(MOD + b * 6144 + 5120 + col + 4) * (1.0f / YSCALE);
            const u32x4 xw = *(const u32x4*)(X1 + (size_t)t * D + col); const f32x4 x0 = {bflo(xw.x), bfhi(xw.x), bflo(xw.y), bfhi(xw.y)}, x1 = {bflo(xw.z), bfhi(xw.z), bflo(xw.w), bfhi(xw.w)};
            v[j][0] = x0 + g0 * m0; v[j][1] = x1 + g1 * m1;
#pragma unroll
            for (int q = 0; q < 2; ++q) s += (v[j][q].x * v[j][q].x + v[j][q].y * v[j][q].y) + (v[j][q].z * v[j][q].z + v[j][q].w * v[j][q].w); }
        const float rstd = rsqrtf(wave_sum(s) * (1.f / D) + EPS);
#pragma unroll
        for (int j = 0; j < 2; ++j) { const int col = 8 * l + 512 * j;
            *(f32x4*)(X.out + (size_t)t * D + col) = v[j][0] * rstd * *(const f32x4*)(X.g_final + col); *(f32x4*)(X.out + (size_t)t * D + col + 4) = v[j][1] * rstd * *(const f32x4*)(X.g_final + col + 4); }
    }
}

__device__ __forceinline__ unsigned* panel_word(Ctx& X, int bank, int pm) { return WSP(unsigned, WS_CTL) + CW_PANEL + (bank * 64 + pm) * 64; }
__device__ __forceinline__ void panel_signal(Ctx& X, int bank, int pm) {
    asm volatile("s_waitcnt vmcnt(0)" ::: "memory"); __syncthreads();
    if (X.tid == 0) (void)xb_add(panel_word(X, bank, pm), 1u);
}
__device__ __forceinline__ void panel_wait(Ctx& X, int bank, int pm, unsigned target) {
    if (X.tid == 0) { unsigned* p = panel_word(X, bank, pm); unsigned sp = 0u;
        while (xb_ld(p) < target) { __builtin_amdgcn_s_sleep(2); if (++sp > (1u << 22)) break; }
        __builtin_amdgcn_fence(__ATOMIC_ACQUIRE, "agent"); asm volatile("s_waitcnt vmcnt(0)" ::: "memory"); }
    __syncthreads();
}

constexpr int NG_INPROJ = 176;
__device__ __forceinline__ void ph_inproj(Ctx& X) {
    const int ng = X.G > NG_INPROJ + 8 ? NG_INPROJ : X.G;
    if (X.wg < ng) {
        RegSched S{(const char*)WSP(bf16_t, WS_H), (const char*)WSP(bf16_t, WS_WIN), (size_t)256 * 2048, (size_t)256 * 2048, T / 256, INW / 256, ng, X.wg};
        EpiInproj E{WSP(bf16_t, WS_PROJ), WSP(float, WS_LOGF), WSP(float, WS_LB), WSP(float, WS_ROPE), WSP(unsigned char, WS_G8)};
        pg8::gemm_phase<EpiInproj, RegSched, true, false>(X.lds, 1024, 1024, 1024, S, E);
    }
    if (ng == X.G) expert_convert(X, X.wg, X.G);
    else if (X.wg >= ng) expert_convert(X, X.wg - ng, X.G - ng);
}
__device__ __forceinline__ void ph_mix_a(Ctx& X) {
    for (int it = X.wg; it < 256; it += X.G) hgrn_kv_unit(X, it);
    AttnRegs R; int unit = X.wg; bf16x8 qf[4];
    if (unit < 1536) attn_load(X, unit, R);
    while (unit < 1536) {
        attn_stage(X, R);
#pragma unroll
        for (int ds = 0; ds < 4; ++ds) qf[ds] = R.q[ds];
        __syncthreads();
        const int nu = unit + X.G;
        if (nu < 1536) attn_load(X, nu, R);
        attn_compute(X, unit, qf);
        __syncthreads();
        unit = nu;
    }
}
__device__ __forceinline__ void ph_mix_c(Ctx& X) { for (int it = X.wg; it < 512; it += X.G) hgrn_out_unit(X, it); attn_combine(X); }
__device__ __forceinline__ void ph_mixed(Ctx& X, bool chain) {
    TwoPartSched S{(const char*)WSP(bf16_t, WS_YCAT), (const char*)WSP(bf16_t, WS_WPA), (const char*)WSP(bf16_t, WS_WPB), T / 256, D / 256, X.G, X.wg};
    EpiMixed E{WSP(unsigned char, WS_G8), WSP(bf16_t, WS_MIXED)};
    pg8::gemm_phase<EpiMixed, TwoPartSched, false, false>(X.lds, 1024, 512, 512, S, E);
    if (chain) { int pm, pn; pg8::swz_tile(X.wg, T / 256, D / 256, pm, pn); panel_signal(X, 0, pm); }
}
__device__ __forceinline__ void ph_outproj(Ctx& X, bool chain) {
    int pm = 0, pn = 0; pg8::swz_tile(X.wg < 256 ? X.wg : 0, T / 256, D / 256, pm, pn);
    RegSched S{(const char*)WSP(bf16_t, WS_MIXED), (const char*)WSP(bf16_t, WS_WOUT), (size_t)256 * 2048, (size_t)256 * 2048, T / 256, D / 256, X.G, X.wg};
    if (chain) {
        panel_wait(X, 0, pm, 4u);
        EpiOutNorm E{X.x, WSP(float, WS_MOD), X.g2, WSP(bf16_t, WS_X1), WSP(bf16_t, WS_H), WSP(unsigned char, WS_H8), WSP(float, WS_XB), panel_word(X, 1, 0), X.lds + 139264};
        pg8::gemm_phase<EpiOutNorm, RegSched, true, false>(X.lds, 1024, 1024, 1024, S, E);
        panel_signal(X, 2, pm);
    } else {
        EpiOutproj E{X.x, WSP(float, WS_MOD), WSP(bf16_t, WS_X1)};
        pg8::gemm_phase<EpiOutproj, RegSched, false, false>(X.lds, 1024, 1024, 1024, S, E);
    }
}
__device__ __forceinline__ void ph_norm2(Ctx& X, bool chain) { if (!chain) norm_rows(X, 1); }
__device__ __forceinline__ void ph_router(Ctx& X, bool chain) {
    if (chain) panel_wait(X, 2, X.wg >> 2, 4u);
    RouterSched S{(const char*)WSP(bf16_t, WS_H), (const char*)WSP(bf16_t, WS_WR), X.G, X.wg};
    EpiRouter E{WSP(float, WS_KVT)};
    pg8::gemm_phase<EpiRouter, RouterSched, false, false>(X.lds, 1024, 1024, 256, S, E);
    if (chain) panel_signal(X, 3, X.wg >> 2);
}
__device__ __forceinline__ void ph_route(Ctx& X, bool chain) {
    if (chain) panel_wait(X, 3, X.wg >> 2, 4u);
    moe_route(X, chain);
}
__device__ __forceinline__ void ph_gu(Ctx& X) {
    const int nent = moe_table(X);
    MoeSched S{(const LAS int*)(X.lds + TBL_OFF), (const LAS int*)(X.lds + TCNT_OFF), nent, (const char*)WSP(unsigned char, WS_H8), (const char*)WSP(unsigned char, WS_WGU), WSP(int, WS_LISTS), 2, 256 * 1024, 512 * 1024, 0, X.G, X.wg};
    EpiGU E{WSP(unsigned char, WS_ACT)};
    pg8::gemm_phase<EpiGU, MoeSched, true, true, true>(X.lds, 512, 512, 512, S, E);
}
__device__ __forceinline__ void ph_down(Ctx& X) {
    const int nent = moe_table(X);
    MoeSched S{(const LAS int*)(X.lds + TBL_OFF), (const LAS int*)(X.lds + TCNT_OFF), nent, (const char*)WSP(unsigned char, WS_ACT), (const char*)WSP(unsigned char, WS_WD), WSP(int, WS_LISTS), 4, 256 * 256, 1024 * 256, 256 * 256, X.G, X.wg};
    EpiDown E{WSP(unsigned char, WS_YBUF), WSP(float, WS_GATEW)};
    pg8::gemm_phase<EpiDown, MoeSched, true, false, true>(X.lds, 128, 128, 128, S, E);
}

constexpr int NPHASE = 14;
struct Args { const void* in[20]; float* out; unsigned char* ws; int ph_lo, ph_hi; };
__global__ void __launch_bounds__(NTHREADS, 2) mega_fwd(Args args) {
    extern __shared__ __attribute__((aligned(16))) unsigned char lds_raw[];
    Ctx X;
    X.lds = (LAS unsigned char*)lds_raw;
    X.tid = threadIdx.x; X.lane = X.tid & 63; X.wave = __builtin_amdgcn_readfirstlane(X.tid >> 6); X.wg = blockIdx.x; X.G = gridDim.x;
    X.x = (const float*)args.in[0]; X.c = (const float*)args.in[1]; X.positions = (const int*)args.in[2]; X.w_ada = (const float*)args.in[3]; X.b_ada = (const float*)args.in[4];
    X.g1 = (const float*)args.in[5]; X.w_in = (const float*)args.in[6]; X.lb_logits = (const float*)args.in[7]; X.g_hgrn = (const float*)args.in[8]; X.w_pa = (const float*)args.in[9];
    X.w_pb = (const float*)args.in[10]; X.w_out = (const float*)args.in[11]; X.g2 = (const float*)args.in[12]; X.w_router = (const float*)args.in[13]; X.rbias = (const float*)args.in[14];
    X.w_egu = (const float*)args.in[15]; X.w_edown = (const float*)args.in[16]; X.w_sgu = (const float*)args.in[17]; X.w_sdown = (const float*)args.in[18]; X.g_final = (const float*)args.in[19];
    X.out = args.out; X.ws = args.ws;
    volatile LAS unsigned* MISC = (volatile LAS unsigned*)(X.lds + MISC_OFF);
    if (X.tid < 32) MISC[X.tid] = 0u;
    __syncthreads();
    const int lo = args.ph_lo, hi = args.ph_hi;
    XcdBarrier bar; bar.bar = WSP(unsigned, WS_CTL) + CW_BAR; bar.x = 0; bar.st = nullptr;
    if (hi - lo > 1) bar = xcd_barrier_post(WSP(unsigned, WS_CTL) + CW_BAR, MISC + 8);
#ifndef PH_MASK
#define PH_MASK 0xffffffffu
#endif
#define IN(k) ((((PH_MASK) >> (k)) & 1u) && lo <= (k) && (k) < hi)
#ifndef REPEAT_MASK
#define REPEAT_MASK 0u
#endif
#define SEAM(k) do { if (IN(k) && IN((k) + 1)) xcd_barrier(bar); } while (0)
#define RUN(k, call) do { if (IN(k)) { call; if (((REPEAT_MASK) >> (k)) & 1u) { xcd_barrier(bar); call; } } } while (0)

    RUN(0, p0_prologue(X)); SEAM(0);
    RUN(1, { small_transposes(X); norm_rows(X, 0); }); SEAM(1);
    RUN(2, ph_inproj(X)); SEAM(2);
    RUN(3, ph_mix_a(X)); SEAM(3);
    RUN(4, hgrn_passB(X)); SEAM(4);
    RUN(5, ph_mix_c(X)); SEAM(5);
    const bool chain = (X.G == 256);
    RUN(6, ph_mixed(X, chain)); if (!chain) SEAM(6);
    RUN(7, ph_outproj(X, chain)); if (!chain) SEAM(7);
    RUN(8, ph_norm2(X, chain)); if (!chain) SEAM(8);
    RUN(9, ph_router(X, chain)); if (!chain) SEAM(9);
    RUN(10, ph_route(X, chain)); SEAM(10);
    RUN(11, ph_gu(X)); SEAM(11);
    RUN(12, ph_down(X)); SEAM(12);
    RUN(13, final_rows(X));
#undef IN
#undef SEAM
}

extern "C" void kernel_launch(void* const* d_in, const int* in_sizes, int n_in, void* d_out, int out_size, void* d_ws, size_t ws_size, hipStream_t stream) {
    static int grid = 0;
    if (grid == 0) {
        if (n_in != 20 || out_size != T * D || ws_size < WS_END) { fprintf(stderr, "kernel_launch: unexpected shapes (n_in %d, out %d, ws %zu); nothing launched\n", n_in, out_size, ws_size); grid = -1; return; }
        int dev = 0, cus = 0, per_cu = 0;
        if (hipGetDevice(&dev) != hipSuccess || hipDeviceGetAttribute(&cus, hipDeviceAttributeMultiprocessorCount, dev) != hipSuccess) { grid = -1; return; }
        if (hipFuncSetAttribute((const void*)mega_fwd, hipFuncAttributeMaxDynamicSharedMemorySize, LDS_BYTES) != hipSuccess) { fprintf(stderr, "kernel_launch: hipFuncSetAttribute failed\n"); grid = -1; return; }
        if (hipOccupancyMaxActiveBlocksPerMultiprocessor(&per_cu, (const void*)mega_fwd, NTHREADS, LDS_BYTES) != hipSuccess || per_cu < 1) { fprintf(stderr, "kernel_launch: occupancy query says %d blocks/CU; nothing launched\n", per_cu); (void)hipGetLastError(); grid = -1; return; }
        grid = cus;
        if (T % grid != 0 || 24576 % grid != 0 || grid % 8 != 0) { fprintf(stderr, "kernel_launch: grid %d does not divide the row count; nothing launched\n", grid); grid = -1; return; }
    }
    if (grid < 0) return;
    (void)hipMemsetAsync((char*)d_ws + WS_CTL, 0, CTL_ZERO_BYTES, stream);
    Args a{};
    for (int i = 0; i < 20; ++i) a.in[i] = d_in[i];
    a.out = (float*)d_out; a.ws = (unsigned char*)d_ws;
#if MK_PER_PHASE
    for (int p = 0; p < NPHASE; ++p) { a.ph_lo = p; a.ph_hi = p + 1; hipLaunchKernelGGL(mega_fwd, dim3(grid), dim3(NTHREADS), LDS_BYTES, stream, a); }
#else
    a.ph_lo = 0; a.ph_hi = NPHASE;
    hipLaunchKernelGGL(mega_fwd, dim3(grid), dim3(NTHREADS), LDS_BYTES, stream, a);
#endif
}
```

```cpp
#include <hip/hip_runtime.h>
#include <cstdio>
#include <cstdint>

#ifndef MK_PER_PHASE
#define MK_PER_PHASE 0
#endif

#define GAS __attribute__((address_space(1)))
#define LAS __attribute__((address_space(3)))
typedef unsigned short bf16_t;
typedef short bf16x8 __attribute__((ext_vector_type(8)));
typedef short s16x4 __attribute__((ext_vector_type(4)));
typedef float f32x4 __attribute__((ext_vector_type(4)));
typedef float f32x2 __attribute__((ext_vector_type(2)));
typedef float f32x16 __attribute__((ext_vector_type(16)));
typedef unsigned u32x4 __attribute__((ext_vector_type(4)));
typedef unsigned u32x2 __attribute__((ext_vector_type(2)));
typedef long l64x2 __attribute__((ext_vector_type(2)));

constexpr int NB = 4, SEQ = 4096, T = NB * SEQ, D = 1024, INW = 8704;
constexpr int C_HQ = 0, C_HK = 512, C_HV = 1024, C_HG = 1536, C_AQ = 2048, C_AK = 3584, C_AV = 5120, C_GA = 6656, C_GB = 7680;
constexpr int NE = 256, NEX = 257, TOPK = 8, NSLOT = 9, EFF = 256;
constexpr float EPS = 1e-6f;
constexpr float WGU_SCALE = 64.0f, WD_SCALE = 32.0f;
constexpr float YSCALE = 16.0f;
constexpr int NWAVES = 8, NTHREADS = 512;

constexpr size_t MiB = 1u << 20;
constexpr size_t WS_CTL = 0, CTL_ZERO_BYTES = 1 * MiB;
constexpr size_t WS_MODP = 2 * MiB;
constexpr size_t WS_MOD = 4 * MiB;
constexpr size_t WS_LB = 4 * MiB + 128 * 1024;
constexpr size_t WS_XB = 4 * MiB + 256 * 1024;
constexpr size_t WS_ROPE = 5 * MiB;
constexpr size_t WS_DECAY = 6 * MiB;
constexpr size_t WS_GATEW = 7 * MiB;
constexpr size_t WS_LISTS = 16 * MiB;
constexpr size_t WS_WIN = 34 * MiB;
constexpr size_t WS_WPA = 51 * MiB, WS_WPB = 52 * MiB, WS_WOUT = 53 * MiB, WS_WR = 55 * MiB;
constexpr size_t WS_H = 56 * MiB;
constexpr size_t WS_LOGF = 88 * MiB;
constexpr size_t WS_H8 = 120 * MiB;
constexpr size_t WS_MIXED = 136 * MiB;
constexpr size_t WS_YCAT = 168 * MiB;
constexpr size_t WS_X1 = 200 * MiB;
constexpr size_t WS_G8 = 232 * MiB;
constexpr size_t WS_OG = 264 * MiB;
constexpr size_t WS_LSE = 312 * MiB;
constexpr size_t WS_KVT = 314 * MiB;
constexpr size_t WS_SPT = 378 * MiB;
constexpr size_t WS_PROJ = 410 * MiB;
constexpr size_t WS_WGU = 682 * MiB;
constexpr size_t WS_QK8 = 820 * MiB;
constexpr size_t WS_WD = 939 * MiB;
constexpr size_t WS_ACT = 1068 * MiB;
constexpr size_t WS_YBUF = 1172 * MiB;
constexpr size_t WS_END = 1460 * MiB;
constexpr int CW_BAR = 4096;
constexpr int CW_PANEL = 65536;
constexpr int CW_CNT = 16384;

constexpr int RING_BYTES = 131072;
constexpr int TBL_OFF = RING_BYTES;
constexpr int TCNT_OFF = TBL_OFF + 4096;
constexpr int MISC_OFF = TCNT_OFF + 2560;
constexpr int LDS_BYTES = 147456;

#define LDS_WAIT() asm volatile("s_waitcnt lgkmcnt(0)" ::: "memory")
#define VM_WAIT() asm volatile("s_waitcnt vmcnt(0)" ::: "memory")
__device__ __forceinline__ unsigned f2bf(float f) { unsigned u = __builtin_bit_cast(unsigned, f); return (u + 0x7fffu + ((u >> 16) & 1u)) >> 16; }
__device__ __forceinline__ float bf2f(unsigned b) { return __builtin_bit_cast(float, b << 16); }
__device__ __forceinline__ unsigned pk2(float lo, float hi) { return f2bf(lo) | (f2bf(hi) << 16); }
__device__ __forceinline__ float bflo(unsigned w) { return __builtin_bit_cast(float, w << 16); }
__device__ __forceinline__ float bfhi(unsigned w) { return __builtin_bit_cast(float, w & 0xffff0000u); }
__device__ __forceinline__ float sigmoidf_(float x) { return 1.0f / (1.0f + __expf(-x)); }
__device__ __forceinline__ float wave_sum(float v) {
#pragma unroll
    for (int o = 1; o < 64; o <<= 1) v += __shfl_xor(v, o);
    return v;
}

__device__ __forceinline__ float clamp_e4m3(float x) { return __builtin_amdgcn_fmed3f(x, -448.0f, 448.0f); }
__device__ __forceinline__ unsigned pk4_fp8(float a, float b, float c, float d) { int w = 0; w = __builtin_amdgcn_cvt_pk_fp8_f32(clamp_e4m3(a), clamp_e4m3(b), w, false); w = __builtin_amdgcn_cvt_pk_fp8_f32(clamp_e4m3(c), clamp_e4m3(d), w, true); return (unsigned)w; }
__device__ __forceinline__ void st_wt8(void* p, unsigned long long v) { __hip_atomic_store((unsigned long long*)p, v, __ATOMIC_RELAXED, __HIP_MEMORY_SCOPE_AGENT); }
__device__ __forceinline__ void st_wt16(void* p, u32x4 v) { asm volatile("global_store_dwordx4 %0, %1, off sc1\n\ts_nop 1" :: "v"(p), "v"(v) : "memory"); }
__device__ __forceinline__ void st_wt4(void* p, unsigned v) { __hip_atomic_store((unsigned*)p, v, __ATOMIC_RELAXED, __HIP_MEMORY_SCOPE_AGENT); }
namespace pg8 {
constexpr int BM = 256, BK = 64, HALF = 128, HTB = HALF * BK * 2, STAGE_BYTES = 8 * HTB, NXCD = 8, WGM = 8;
__host__ __device__ __forceinline__ int lds_byte(int r, int c) { const int st = (r >> 4) * 2 + (c >> 5), rr = r & 15, cc = c & 31, ob = rr * 64 + cc * 2; return st * 1024 + (ob ^ (((ob >> 9) & 1) << 5)); }
__host__ __device__ __forceinline__ void stage_rc(int b, int& R, int& C) { const int st = b / 1024, sb = b % 1024, swz = sb ^ (((sb >> 9) & 1) << 5); R = (st >> 1) * 16 + swz / 64; C = (st & 1) * 32 + (swz % 64) / 2; }
__host__ __device__ __forceinline__ int perm32(int rho) { const int n = rho >> 4, i = rho & 15; return 8 * (i >> 2) + 4 * n + (i & 3); }

struct Unit { const char* a; const char* b; const int* rows; int pm, pn, aux, nvalid; };

__device__ __forceinline__ void swz_tile(int L, int nM, int nN, int& pm, int& pn) {
    const int nwg = nM * nN; int wgid = L;
    { const int q = nwg / NXCD, r = nwg % NXCD, xcd = wgid % NXCD, off = wgid / NXCD; wgid = (xcd < r ? xcd * (q + 1) : r * (q + 1) + (xcd - r) * q) + off; }
    const int nig = WGM * nN, gid = wgid / nig, fm = gid * WGM, gsz = (nM - fm) < WGM ? (nM - fm) : WGM;
    pm = fm + ((wgid % nig) % gsz); pn = (wgid % nig) / gsz;
}

__device__ __forceinline__ unsigned cvt_pk_bf16(float lo, float hi) { unsigned r; asm volatile("v_cvt_pk_bf16_f32 %0, %1, %2" : "=v"(r) : "v"(lo), "v"(hi)); return r; }

template <bool GATHER>
__device__ __forceinline__ void gather_offs(const Unit& u, int tid, int lda, unsigned (&v)[2][2]) {
    if constexpr (GATHER) {
#pragma unroll
        for (int i = 0; i < 2; ++i) { int R, C; stage_rc(tid * 16 + i * 8192, R, C);
#pragma unroll
            for (int hh = 0; hh < 2; ++hh) { const int ri = hh * HALF + R; int slot = 0; if (ri < u.nvalid) slot = u.rows[ri];
                const unsigned tok = (unsigned)slot / 9u; v[hh][i] = (tok * (unsigned)lda + (unsigned)C) * 2u; } }
    }
}

template <class Epi, class Sched, bool ALIGN_EPI, bool GATHER, bool FP8 = false>
__device__ __forceinline__ void gemm_phase(LAS unsigned char* lds, const int lda, const int ldb, const int K, const Sched& S, const Epi& E) {
    const int tid = threadIdx.x, wid = __builtin_amdgcn_readfirstlane(tid >> 6), lane = tid & 63, wr = wid >> 2, wc = wid & 3, fr = lane & 15, fq = lane >> 4;
    const int nt = K / BK;
    unsigned voffA[2], voffB[2];
#pragma unroll
    for (int i = 0; i < 2; ++i) { int R, C; stage_rc(tid * 16 + i * 8192, R, C); const int Rb = Epi::PERM ? ((R & ~31) + perm32(R & 31)) : R;
        voffA[i] = (unsigned)(R * lda + C) * 2u; voffB[i] = (unsigned)(Rb * ldb + C) * 2u; }
    const size_t kstep = (size_t)(BK * 2);
    const size_t hstepA = GATHER ? 0 : (size_t)HALF * lda * 2, hstepB = (size_t)HALF * ldb * 2;
    const unsigned ldsw = (unsigned)wid * 1024u;
    const int aoff = lds_byte(wr * 64 + fr, fq * 8), boff = lds_byte(wc * 32 + fr, fq * 8);
#define PG8_SA(b, h) (((b) * 2 + (h)) * HTB)
#define PG8_SB(b, h) ((4 + (b) * 2 + (h)) * HTB)
#define PG8_STAGE(bufoff, gbase, voff) do { _Pragma("unroll") for (int _i = 0; _i < 2; ++_i) \
        __builtin_amdgcn_global_load_lds((const unsigned*)((const char*)(gbase) + (voff)[_i]), (LAS unsigned*)(lds + (bufoff) + ldsw + _i * 8192), 16, 0, 0); } while (0)
#define PG8_STAGE_A(bufoff, gb, hh, nx) do { if constexpr (GATHER) { unsigned _v[2]; _v[0] = (nx) ? vn[hh][0] : vc[hh][0]; _v[1] = (nx) ? vn[hh][1] : vc[hh][1]; PG8_STAGE(bufoff, gb, _v); } \
        else { PG8_STAGE(bufoff, (gb) + (hh) * hstepA, voffA); } } while (0)
#define PG8_LDA(dst, b, h) do { _Pragma("unroll") for (int m = 0; m < 4; ++m) _Pragma("unroll") for (int k = 0; k < 2; ++k) dst[m][k] = *(const LAS bf16x8*)(lds + PG8_SA(b, h) + aoff + m * 2048 + k * 1024); } while (0)
#define PG8_LDB(dst, b, h) do { _Pragma("unroll") for (int n = 0; n < 2; ++n) _Pragma("unroll") for (int k = 0; k < 2; ++k) dst[n][k] = *(const LAS bf16x8*)(lds + PG8_SB(b, h) + boff + n * 2048 + k * 1024); } while (0)
#define PG8_MMA(ai, bj, At, Bt) do { __builtin_amdgcn_s_setprio(1); _Pragma("unroll") for (int m = 0; m < 4; ++m) _Pragma("unroll") for (int n = 0; n < 2; ++n) _Pragma("unroll") for (int k = 0; k < 2; ++k) { \
        if constexpr (FP8) { const l64x2 _b = __builtin_bit_cast(l64x2, Bt[n][k]), _a = __builtin_bit_cast(l64x2, At[m][k]); \
            acc[ai][bj][m][n] = __builtin_amdgcn_mfma_f32_16x16x32_fp8_fp8(_b[0], _a[0], acc[ai][bj][m][n], 0, 0, 0); acc[ai][bj][m][n] = __builtin_amdgcn_mfma_f32_16x16x32_fp8_fp8(_b[1], _a[1], acc[ai][bj][m][n], 0, 0, 0); } \
        else acc[ai][bj][m][n] = __builtin_amdgcn_mfma_f32_16x16x32_bf16(Bt[n][k], At[m][k], acc[ai][bj][m][n], 0, 0, 0); } __builtin_amdgcn_s_setprio(0); } while (0)
#define PG8_WAIT_V(n) asm volatile("s_waitcnt vmcnt(" #n ")" ::: "memory")
#define PG8_WAIT_L(n) asm volatile("s_waitcnt lgkmcnt(" #n ")" ::: "memory")
#define PG8_BAR __builtin_amdgcn_s_barrier()
#define PG8_SCHED __builtin_amdgcn_sched_barrier(0)
    Unit cur, nxt; int ui = 0;
    if (!S.next(0, cur)) return;
    unsigned vc[2][2] = {{0u, 0u}, {0u, 0u}}, vn[2][2] = {{0u, 0u}, {0u, 0u}};
    gather_offs<GATHER>(cur, tid, lda, vc);
    f32x4 acc[2][2][4][2];
#pragma unroll
    for (int a = 0; a < 2; ++a)
#pragma unroll
        for (int b = 0; b < 2; ++b)
#pragma unroll
            for (int m = 0; m < 4; ++m)
#pragma unroll
                for (int n = 0; n < 2; ++n) acc[a][b][m][n] = (f32x4){0.f, 0.f, 0.f, 0.f};
    bf16x8 At[4][2], B0[2][2], B1[2][2];
    const char* cA = cur.a; const char* cB = cur.b;
    PG8_STAGE(PG8_SB(0, 0), cB, voffB); PG8_STAGE(PG8_SB(0, 1), cB + hstepB, voffB); PG8_STAGE_A(PG8_SA(0, 0), cA, 0, false); PG8_STAGE_A(PG8_SA(0, 1), cA, 1, false);
    if (wr == 1) PG8_BAR;
    PG8_WAIT_V(2); PG8_BAR;
    PG8_STAGE(PG8_SB(1, 0), cB + kstep, voffB); PG8_STAGE_A(PG8_SA(1, 0), cA + kstep, 0, false); PG8_STAGE(PG8_SB(1, 1), cB + hstepB + kstep, voffB);
    PG8_WAIT_V(6); PG8_BAR;
    for (;;) {
        const bool has_next = S.next(ui + 1, nxt);
        if (has_next) gather_offs<GATHER>(nxt, tid, lda, vn);
        const char* nA = has_next ? nxt.a : cA; const char* nB = has_next ? nxt.b : cB;
        const bool do0 = !Sched::HALFSKIP || cur.nvalid > 64 * wr, do1 = !Sched::HALFSKIP || cur.nvalid > 128 + 64 * wr;
        for (int t = 0; t < nt; t += 2) {
            const bool last = (t == nt - 2);
            const bool lnx = last && has_next;
            const char* a1 = cA + (size_t)(t + 1) * kstep;
            const char* a2 = last ? nA : cA + (size_t)(t + 2) * kstep; const char* b2 = last ? nB : cB + (size_t)(t + 2) * kstep;
            const char* a3 = a2 + kstep; const char* b3 = b2 + kstep;
            PG8_LDB(B0, 0, 0); PG8_LDB(B1, 0, 1); PG8_SCHED; PG8_LDA(At, 0, 0); PG8_STAGE_A(PG8_SA(1, 1), a1, 1, false);
            PG8_WAIT_V(8); PG8_WAIT_L(0); PG8_BAR; if (do0) { PG8_MMA(0, 0, At, B0); PG8_MMA(0, 1, At, B1); } PG8_BAR; PG8_SCHED;
            PG8_LDA(At, 0, 1); PG8_STAGE(PG8_SB(0, 0), b2, voffB); PG8_STAGE(PG8_SB(0, 1), b2 + hstepB, voffB); PG8_STAGE_A(PG8_SA(0, 0), a2, 0, lnx);
            PG8_WAIT_V(8); PG8_WAIT_L(0); PG8_BAR; if (do1) { PG8_MMA(1, 0, At, B0); PG8_MMA(1, 1, At, B1); } PG8_BAR; PG8_SCHED;
            PG8_LDB(B0, 1, 0); PG8_LDB(B1, 1, 1); PG8_SCHED; PG8_LDA(At, 1, 0); PG8_STAGE_A(PG8_SA(0, 1), a2, 1, lnx);
            PG8_WAIT_V(8); PG8_WAIT_L(0); PG8_BAR; if (do0) { PG8_MMA(0, 0, At, B0); PG8_MMA(0, 1, At, B1); } PG8_BAR; PG8_SCHED;
            PG8_LDA(At, 1, 1); PG8_STAGE(PG8_SB(1, 0), b3, voffB); PG8_STAGE(PG8_SB(1, 1), b3 + hstepB, voffB); PG8_STAGE_A(PG8_SA(1, 0), a3, 0, lnx);
            PG8_WAIT_V(8); PG8_WAIT_L(0); PG8_BAR; if (do1) { PG8_MMA(1, 0, At, B0); PG8_MMA(1, 1, At, B1); } PG8_BAR; PG8_SCHED;
        }
        if constexpr (ALIGN_EPI) { if (wr == 0) PG8_BAR; }
        E(acc, cur, wr, wc, fr, fq);
        __builtin_amdgcn_s_waitcnt(0x0F70);
        if (!has_next) break;
        if (!E.keep(cur)) {
#pragma unroll
            for (int a = 0; a < 2; ++a)
#pragma unroll
                for (int b = 0; b < 2; ++b)
#pragma unroll
                    for (int m = 0; m < 4; ++m)
#pragma unroll
                        for (int n = 0; n < 2; ++n) acc[a][b][m][n] = (f32x4){0.f, 0.f, 0.f, 0.f};
        }
        cur = nxt; cA = nA; cB = nB; ++ui;
        if constexpr (GATHER) {
#pragma unroll
            for (int hh = 0; hh < 2; ++hh) { vc[hh][0] = vn[hh][0]; vc[hh][1] = vn[hh][1]; }
        }
        if constexpr (ALIGN_EPI) { if (wr == 1) PG8_BAR; }
    }
    PG8_WAIT_V(0);
    if constexpr (!ALIGN_EPI) { if (wr == 0) PG8_BAR; }
    PG8_BAR;
#undef PG8_SA
#undef PG8_SB
#undef PG8_STAGE
#undef PG8_STAGE_A
#undef PG8_LDA
#undef PG8_LDB
#undef PG8_MMA
#undef PG8_WAIT_V
#undef PG8_WAIT_L
#undef PG8_BAR
#undef PG8_SCHED
}
}

#define XB_TMO      128
#define XB_XCNT(j)  (256  + 64 * (j))
#define XB_XSUB(j)  (1280 + 64 * (j))
#define XB_XGEN(j)  (2304 + 64 * (j))
#define XB_TOP      3328
#define XB_TOPGEN   3392
#define XCD_BAR_WORDS 3456
#define XB_SPIN_CAP (1u << 20)
__device__ __forceinline__ unsigned xb_ld(unsigned* p)              { return __hip_atomic_load(p, __ATOMIC_RELAXED, __HIP_MEMORY_SCOPE_AGENT); }
__device__ __forceinline__ unsigned xb_add(unsigned* p, unsigned v) { return __hip_atomic_fetch_add(p, v, __ATOMIC_RELAXED, __HIP_MEMORY_SCOPE_AGENT); }
__device__ __forceinline__ unsigned xb_xcc_id() { return (unsigned)__builtin_amdgcn_s_getreg((3 << 11) | 20) & 0xFu; }
#define XB_SPIN(cond, bar) do { unsigned _sp = 0; while (cond) { __builtin_amdgcn_s_sleep(1); \
    if ((++_sp & 255u) == 0u) { if (xb_ld(&(bar)[XB_TMO])) break; if (_sp > XB_SPIN_CAP) { atomicAdd(&(bar)[XB_TMO], 1u); break; } } } } while (0)
struct XcdBarrier { unsigned* bar; unsigned x; volatile LAS unsigned* st; };
__device__ __forceinline__ XcdBarrier xcd_barrier_post(unsigned* bar, volatile LAS unsigned* st) {
    XcdBarrier b; b.bar = bar; b.x = xb_xcc_id(); b.st = st;
    if (threadIdx.x == 0) (void)xb_add(&bar[XB_XCNT(b.x)], 1u);
    return b;
}
__device__ __forceinline__ void xcd_barrier_complete(unsigned* bar, unsigned x, unsigned& nloc, unsigned& nx) {
    const unsigned G = gridDim.x * gridDim.y * gridDim.z;
    unsigned sum, cnt, mine, sp = 0u;
    for (;;) {
        sum = 0u; cnt = 0u; mine = 0u;
#pragma unroll
        for (unsigned j = 0; j < 16; ++j) { const unsigned c = xb_ld(&bar[XB_XCNT(j)]); sum += c; cnt += (c > 0u) ? 1u : 0u; mine = (j == x) ? c : mine; }
        if (sum == G) break;
        __builtin_amdgcn_s_sleep(1);
        if ((++sp & 255u) == 0u) { if (xb_ld(&bar[XB_TMO])) break; if (sp > XB_SPIN_CAP) { atomicAdd(&bar[XB_TMO], 1u); break; } }
    }
    nloc = mine > 0u ? mine : 1u; nx = cnt > 0u ? cnt : 1u;
}
__device__ __forceinline__ void xcd_barrier(const XcdBarrier& b) {
    asm volatile("s_waitcnt vmcnt(0)" ::: "memory");
    __syncthreads();
    if (threadIdx.x == 0) {
        unsigned* bar = b.bar;
        __builtin_amdgcn_s_waitcnt(0);
        unsigned nloc = b.st[0], nx = b.st[1];
        if (nloc == 0u) { xcd_barrier_complete(bar, b.x, nloc, nx); b.st[0] = nloc; b.st[1] = nx; }
        const unsigned old = xb_add(&bar[XB_XSUB(b.x)], 1u);
        const unsigned gen = old / nloc;
        if (old + 1u == (gen + 1u) * nloc) {
            __builtin_amdgcn_fence(__ATOMIC_RELEASE, "agent");
            asm volatile("s_waitcnt vmcnt(0)" ::: "memory");
            const unsigned og = xb_add(&bar[XB_TOP], 1u);
            const unsigned tg = og / nx;
            if (og + 1u == (tg + 1u) * nx) xb_add(&bar[XB_TOPGEN], 1u);
            else XB_SPIN(xb_ld(&bar[XB_TOPGEN]) == tg, bar);
            __builtin_amdgcn_fence(__ATOMIC_ACQUIRE, "agent");
            asm volatile("s_waitcnt vmcnt(0)" ::: "memory");
        } else {
            XB_SPIN(xb_ld(&bar[XB_TOPGEN]) == gen, bar);
            __builtin_amdgcn_fence(__ATOMIC_ACQUIRE, "agent");
            asm volatile("s_waitcnt vmcnt(0)" ::: "memory");
        }
    }
    __syncthreads();
}

struct Ctx {
    LAS unsigned char* lds;
    int tid, lane, wave, wg, G;
    const float *x, *c, *w_ada, *b_ada, *g1, *w_in, *lb_logits, *g_hgrn, *w_pa, *w_pb, *w_out, *g2, *w_router, *rbias, *w_egu, *w_edown, *w_sgu, *w_sdown, *g_final;
    const int* positions;
    float* out;
    unsigned char* ws;
};
#define WSP(type, off) ((type*)(X.ws + (off)))

__device__ __forceinline__ void transpose_item(const float* W, int K, int N, bf16_t* WT, int dst_row0, int src_col0, int k0, LAS float* scr, int lane) {
#pragma unroll 16
    for (int i = 0; i < 32; ++i) { const int kk = 2 * i + (lane >> 5); scr[kk * 33 + (lane & 31)] = W[(size_t)(k0 + kk) * N + src_col0 + (lane & 31)]; }
    LDS_WAIT(); asm volatile("" ::: "memory");
    const int c = lane & 7;
#pragma unroll
    for (int j = 0; j < 4; ++j) { const int n = (lane >> 3) + 8 * j; const LAS float* s = scr + (8 * c) * 33 + n;
        u32x4 o; o.x = pk2(s[0 * 33], s[1 * 33]); o.y = pk2(s[2 * 33], s[3 * 33]); o.z = pk2(s[4 * 33], s[5 * 33]); o.w = pk2(s[6 * 33], s[7 * 33]);
        *(u32x4*)(WT + (size_t)(dst_row0 + n) * K + k0 + 8 * c) = o; }
    LDS_WAIT(); asm volatile("" ::: "memory");
}
__device__ __forceinline__ void transpose_plain(const float* W, int K, int N, bf16_t* WT, int item, LAS float* scr, int lane) {
    const int nblk = N / 32, kb = item / nblk, nb = item % nblk;
    transpose_item(W, K, N, WT, nb * 32, nb * 32, kb * 64, scr, lane);
}
__device__ __forceinline__ void p0_prologue(Ctx& X) {
    LAS float* scr = (LAS float*)(X.lds + X.wave * 16384);
    const int gw = X.wg * NWAVES + X.wave, NGW = X.G * NWAVES;
    {
        float* MODP = WSP(float, WS_MODP);
        for (int it = gw; it < 96 * 16; it += NGW) {
            const int jc = it % 96, kc = it / 96, j = jc * 64 + X.lane;
            float a0 = 0.f, a1 = 0.f, a2 = 0.f, a3 = 0.f;
#pragma unroll 16
            for (int kk = 0; kk < 64; ++kk) { const int k = kc * 64 + kk; const float w = X.w_ada[(size_t)k * 6144 + j];
                const float c0 = X.c[k], c1 = X.c[1024 + k], c2 = X.c[2048 + k], c3 = X.c[3072 + k];
                a0 += c0 * sigmoidf_(c0) * w; a1 += c1 * sigmoidf_(c1) * w; a2 += c2 * sigmoidf_(c2) * w; a3 += c3 * sigmoidf_(c3) * w; }
            float* o = MODP + (size_t)kc * 24576 + j;
            o[0] = a0; o[6144] = a1; o[12288] = a2; o[18432] = a3;
        }
    }
    {
        float* ROPE = WSP(float, WS_ROPE);
        const int gt = X.wg * NTHREADS + X.tid, NGT = X.G * NTHREADS;
        for (int idx = gt; idx < T * 8; idx += NGT) { const int t = idx >> 3, i = idx & 7;
            const float inv_freq = 1.0f / powf(500000.0f, (float)(2 * i) / 16.0f);
            const float ang = (float)X.positions[t] * inv_freq;
            ROPE[t * 16 + i] = cosf(ang); ROPE[t * 16 + 8 + i] = sinf(ang); }
        if (X.wg == 0) { float* LB = WSP(float, WS_LB);
            for (int j = X.tid; j < 512; j += NTHREADS) { const float l0 = X.lb_logits[j], l1 = X.lb_logits[512 + j], m = fmaxf(l0, l1), e0 = __expf(l0 - m), e1 = __expf(l1 - m); LB[j] = e0 / (e0 + e1); } }
    }
}
struct CvtItem { const float* src; bf16_t* dst; };
template <bool GU> __device__ __forceinline__ CvtItem cvt_item(const Ctx& X, int it) {
    CvtItem c;
    if constexpr (GU) { const int e = it >> 7, q = it & 127, w8 = q & 7, sq = q >> 3, kb = 4 * (sq >> 2) + (w8 & 3), nb = 2 * (sq & 3) + (w8 >> 2);
        const int n0 = nb * 64, pn = n0 >> 8, bj = (n0 >> 7) & 1, idx = n0 & 127, srcc = bj * 256 + pn * 128 + idx;
        const float* W = (e < NE) ? X.w_egu + (size_t)e * 1024 * 512 : X.w_sgu;
        c.src = W + (size_t)(kb * 64) * 512 + srcc; c.dst = (bf16_t*)(X.ws + WS_WGU + ((size_t)e * 512 + n0) * 1024 + kb * 64); }
    else { const int e = it >> 6, q = it & 63, w8 = q & 7, sq = q >> 3, kb = w8 & 3, nb = 2 * sq + (w8 >> 2);
        const float* W = (e < NE) ? X.w_edown + (size_t)e * 256 * 1024 : X.w_sdown;
        c.src = W + (size_t)(kb * 64) * 1024 + nb * 64; c.dst = (bf16_t*)(X.ws + WS_WD + ((size_t)e * 1024 + nb * 64) * 256 + kb * 64); }
    return c;
}
template <int KB> __device__ __forceinline__ void cvt_store8(const CvtItem& c, int lane, const f32x4 (&v)[16], LAS unsigned char* tl, float sc) {
    const int kq = lane >> 4, nq = lane & 15;
#pragma unroll
    for (int i = 0; i < 4; ++i) { u32x4 w;
        w.x = pk4_fp8(v[0][i] * sc, v[1][i] * sc, v[2][i] * sc, v[3][i] * sc); w.y = pk4_fp8(v[4][i] * sc, v[5][i] * sc, v[6][i] * sc, v[7][i] * sc);
        w.z = pk4_fp8(v[8][i] * sc, v[9][i] * sc, v[10][i] * sc, v[11][i] * sc); w.w = pk4_fp8(v[12][i] * sc, v[13][i] * sc, v[14][i] * sc, v[15][i] * sc);
        *(LAS u32x4*)(tl + (4 * nq + i) * 80 + kq * 16) = w; }
    LDS_WAIT(); asm volatile("" ::: "memory");
    const int ch = lane & 3, r = lane >> 2;
    unsigned char* d8 = (unsigned char*)c.dst;
#pragma unroll
    for (int j = 0; j < 4; ++j) { const int n = 16 * j + r; const u32x4 w = *(const LAS u32x4*)(tl + n * 80 + ch * 16); __builtin_nontemporal_store(w, (u32x4*)(d8 + (size_t)n * KB + 16 * ch)); }
    LDS_WAIT(); asm volatile("" ::: "memory");
}
template <int N> __device__ __forceinline__ void cvt_load(const CvtItem& c, int lane, f32x4 (&v)[16]) {
    const float* p = c.src + (size_t)(16 * (lane >> 4)) * N + 4 * (lane & 15);
#pragma unroll
    for (int j = 0; j < 16; ++j) v[j] = __builtin_nontemporal_load((const f32x4*)(p + (size_t)j * N));
}
template <int K> __device__ __forceinline__ void cvt_store(const CvtItem& c, int lane, const f32x4 (&v)[16], LAS unsigned char* tl) {
    const int kq = lane >> 4, nq = lane & 15;
#pragma unroll
    for (int i = 0; i < 4; ++i) { u32x4 w0, w1;
        w0.x = pk2(v[0][i], v[1][i]); w0.y = pk2(v[2][i], v[3][i]); w0.z = pk2(v[4][i], v[5][i]); w0.w = pk2(v[6][i], v[7][i]);
        w1.x = pk2(v[8][i], v[9][i]); w1.y = pk2(v[10][i], v[11][i]); w1.z = pk2(v[12][i], v[13][i]); w1.w = pk2(v[14][i], v[15][i]);
        LAS unsigned char* q = tl + (4 * nq + i) * 144 + kq * 32; *(LAS u32x4*)q = w0; *(LAS u32x4*)(q + 16) = w1; }
    LDS_WAIT(); asm volatile("" ::: "memory");
    const int ch = lane & 7, r = lane >> 3;
#pragma unroll
    for (int j = 0; j < 8; ++j) { const int n = 8 * j + r; const u32x4 w = *(const LAS u32x4*)(tl + n * 144 + ch * 16); __builtin_nontemporal_store(w, (u32x4*)(c.dst + (size_t)n * K + 8 * ch)); }
    LDS_WAIT(); asm volatile("" ::: "memory");
}
struct CvtPair { const float* src; unsigned char* dst; };
template <bool GU> __device__ __forceinline__ CvtPair cvt_pair(const Ctx& X, int di) {
    CvtPair c;
    if constexpr (GU) { const int e = di >> 6, q = di & 63, nb = q & 7, kb2 = q >> 3;
        const int n0 = nb * 64, pn = n0 >> 8, bj = (n0 >> 7) & 1, idx = n0 & 127, srcc = bj * 256 + pn * 128 + idx;
        const float* W = (e < NE) ? X.w_egu + (size_t)e * 1024 * 512 : X.w_sgu;
        c.src = W + (size_t)(kb2 * 128) * 512 + srcc; c.dst = X.ws + WS_WGU + ((size_t)e * 512 + n0) * 1024 + kb2 * 128; }
    else { const int e = di >> 5, q = di & 31, nb = q & 15, kb2 = q >> 4;
        const float* W = (e < NE) ? X.w_edown + (size_t)e * 256 * 1024 : X.w_sdown;
        c.src = W + (size_t)(kb2 * 128) * 1024 + nb * 64; c.dst = X.ws + WS_WD + ((size_t)e * 1024 + nb * 64) * 256 + kb2 * 128; }
    return c;
}
template <int N> __device__ __forceinline__ void cvt_load_half(const CvtPair& c, int half, int lane, f32x4 (&v)[16]) {
    const float* p = c.src + (size_t)(64 * half + 16 * (lane >> 4)) * N + 4 * (lane & 15);
#pragma unroll
    for (int j = 0; j < 16; ++j) v[j] = __builtin_nontemporal_load((const f32x4*)(p + (size_t)j * N));
}
__device__ __forceinline__ void cvt_half_to_lds(int half, int lane, const f32x4 (&v)[16], LAS unsigned char* tl, float sc) {
    const int kq = lane >> 4, nq = lane & 15;
#pragma unroll
    for (int i = 0; i < 4; ++i) { u32x4 w;
        w.x = pk4_fp8(v[0][i] * sc, v[1][i] * sc, v[2][i] * sc, v[3][i] * sc); w.y = pk4_fp8(v[4][i] * sc, v[5][i] * sc, v[6][i] * sc, v[7][i] * sc);
        w.z = pk4_fp8(v[8][i] * sc, v[9][i] * sc, v[10][i] * sc, v[11][i] * sc); w.w = pk4_fp8(v[12][i] * sc, v[13][i] * sc, v[14][i] * sc, v[15][i] * sc);
        *(LAS u32x4*)(tl + (4 * nq + i) * 144 + half * 64 + kq * 16) = w; }
}
template <int KB> __device__ __forceinline__ void cvt_flush(const CvtPair& c, int lane, LAS unsigned char* tl) {
    LDS_WAIT(); asm volatile("" ::: "memory");
    const int ch = lane & 7, r = lane >> 3;
#pragma unroll
    for (int j = 0; j < 8; ++j) { const int n = 8 * j + r; const u32x4 w = *(const LAS u32x4*)(tl + n * 144 + ch * 16); __builtin_nontemporal_store(w, (u32x4*)(c.dst + (size_t)n * KB + 16 * ch)); }
    LDS_WAIT(); asm volatile("" ::: "memory");
}
template <bool GU> __device__ __forceinline__ void expert_convert_set(Ctx& X, int gw, int NGW, LAS unsigned char* tl) {
    constexpr int NIT = GU ? NEX * 64 : NEX * 32, N = GU ? 512 : 1024, K = GU ? 1024 : 256; constexpr float SC = GU ? WGU_SCALE : WD_SCALE;
    if (gw >= NIT) return;
    const int nmine = (NIT - gw + NGW - 1) / NGW;
    f32x4 va[16], vb[16];
    CvtPair cur = cvt_pair<GU>(X, gw);
    cvt_load_half<N>(cur, 0, X.lane, va); cvt_load_half<N>(cur, 1, X.lane, vb);
    for (int j = 0; j < nmine; ++j) {
        const CvtPair nxt = cvt_pair<GU>(X, gw + (j + 1 < nmine ? j + 1 : j) * NGW);
        __builtin_amdgcn_sched_barrier(0);
        cvt_half_to_lds(0, X.lane, va, tl, SC);
        __builtin_amdgcn_sched_barrier(0);
        cvt_load_half<N>(nxt, 0, X.lane, va);
        __builtin_amdgcn_sched_barrier(0);
        cvt_half_to_lds(1, X.lane, vb, tl, SC);
        cvt_flush<K>(cur, X.lane, tl);
        __builtin_amdgcn_sched_barrier(0);
        cvt_load_half<N>(nxt, 1, X.lane, vb);
        __builtin_amdgcn_sched_barrier(0);
        cur = nxt;
    }
}
__device__ __forceinline__ void expert_convert(Ctx& X, int cw, int ncw) {
    LAS unsigned char* tl = X.lds + X.wave * 16384;
    const int gw = cw * NWAVES + X.wave, NGW = ncw * NWAVES;
    expert_convert_set<true>(X, gw, NGW, tl);
    expert_convert_set<false>(X, gw, NGW, tl);
}

__device__ __forceinline__ void small_transposes(Ctx& X) {
    LAS float* scr = (LAS float*)(X.lds + 16384 + X.wave * 12288);
    const int gw = X.wg * NWAVES + X.wave, NGW = X.G * NWAVES;
    {
        constexpr int I_IN = 16 * 272, I_PA = 8 * 32, I_PB = 8 * 32, I_OUT = 16 * 32, I_R = 16 * 8;
        constexpr int NITEMS = I_IN + I_PA + I_PB + I_OUT + I_R;
        for (int it = gw; it < NITEMS; it += NGW) {
            int r = it;
            if (r < I_IN) { transpose_plain(X.w_in, 1024, INW, WSP(bf16_t, WS_WIN), r, scr, X.lane); continue; } r -= I_IN;
            if (r < I_PA) { transpose_plain(X.w_pa, 512, 1024, WSP(bf16_t, WS_WPA), r, scr, X.lane); continue; } r -= I_PA;
            if (r < I_PB) { transpose_plain(X.w_pb, 512, 1024, WSP(bf16_t, WS_WPB), r, scr, X.lane); continue; } r -= I_PB;
            if (r < I_OUT) { transpose_plain(X.w_out, 1024, 1024, WSP(bf16_t, WS_WOUT), r, scr, X.lane); continue; } r -= I_OUT;
            transpose_plain(X.w_router, 1024, 256, WSP(bf16_t, WS_WR), r, scr, X.lane);
        }
    }
}

__device__ __forceinline__ void norm_rows(Ctx& X, int which) {
    LAS float* sm = (LAS float*)X.lds;
    const float* MODP = WSP(float, WS_MODP); float* MOD = WSP(float, WS_MOD);
    const int rows_per_wg = T / X.G, row0 = X.wg * rows_per_wg, b = row0 / SEQ;
    if (which == 0) {
        for (int i = X.tid; i < 2048; i += NTHREADS) { const int j = b * 6144 + i; float s = X.b_ada[i];
#pragma unroll
            for (int p = 0; p < 16; ++p) s += MODP[(size_t)p * 24576 + j];
            sm[i] = s; }
        const int per = 24576 / X.G;
        for (int i = X.tid; i < per; i += NTHREADS) { const int j = X.wg * per + i; float s = X.b_ada[j % 6144];
#pragma unroll
            for (int p = 0; p < 16; ++p) s += MODP[(size_t)p * 24576 + j];
            MOD[j] = s; }
    } else {
        for (int i = X.tid; i < 2048; i += NTHREADS) sm[i] = MOD[b * 6144 + 3072 + i];
    }
    __syncthreads();
    const float* src = X.x; const bf16_t* srcb = WSP(bf16_t, WS_X1); const float* g = which == 0 ? X.g1 : X.g2;
    bf16_t* H = WSP(bf16_t, WS_H);
    for (int r = X.wave; r < rows_per_wg; r += NWAVES) {
        const int row = row0 + r;
        f32x4 v[2][2]; float s = 0.f;
#pragma unroll
        for (int j = 0; j < 2; ++j) { const int col = 8 * X.lane + 512 * j;
            if (which == 0) { v[j][0] = *(const f32x4*)(src + (size_t)row * D + col); v[j][1] = *(const f32x4*)(src + (size_t)row * D + col + 4); }
            else { const u32x4 wv = *(const u32x4*)(srcb + (size_t)row * D + col); v[j][0] = (f32x4){bflo(wv.x), bfhi(wv.x), bflo(wv.y), bfhi(wv.y)}; v[j][1] = (f32x4){bflo(wv.z), bfhi(wv.z), bflo(wv.w), bfhi(wv.w)}; }
#pragma unroll
            for (int q = 0; q < 2; ++q) s += (v[j][q].x * v[j][q].x + v[j][q].y * v[j][q].y) + (v[j][q].z * v[j][q].z + v[j][q].w * v[j][q].w); }
        const float rstd = rsqrtf(wave_sum(s) * (1.f / D) + EPS);
#pragma unroll
        for (int j = 0; j < 2; ++j) { const int col = 8 * X.lane + 512 * j; float y[8];
#pragma unroll
            for (int q = 0; q < 2; ++q) { const f32x4 gg = *(const f32x4*)(g + col + 4 * q), sh = *(const LAS f32x4*)(sm + col + 4 * q), sc = *(const LAS f32x4*)(sm + 1024 + col + 4 * q);
#pragma unroll
                for (int e = 0; e < 4; ++e) y[4 * q + e] = v[j][q][e] * rstd * gg[e] * (1.f + sc[e]) + sh[e]; }
            u32x4 hw; hw.x = pk2(y[0], y[1]); hw.y = pk2(y[2], y[3]); hw.z = pk2(y[4], y[5]); hw.w = pk2(y[6], y[7]);
            if (which == 1) { st_wt16(H + (size_t)row * D + col, hw);
                st_wt8(WSP(unsigned char, WS_H8) + (size_t)row * D + col, (unsigned long long)pk4_fp8(y[0], y[1], y[2], y[3]) | ((unsigned long long)pk4_fp8(y[4], y[5], y[6], y[7]) << 32)); }
            else *(u32x4*)(H + (size_t)row * D + col) = hw; }
    }
    __syncthreads();
}

struct RegSched {
    static constexpr bool HALFSKIP = false;
    const char* A; const char* Bt; size_t a_tile, b_tile; int nM, nN, G, c;
    __device__ __forceinline__ bool next(int i, pg8::Unit& u) const {
        const int L = i * G + c; if (L >= nM * nN) return false;
        int pm, pn; pg8::swz_tile(L, nM, nN, pm, pn);
        u.a = A + (size_t)pm * a_tile; u.b = Bt + (size_t)pn * b_tile; u.rows = nullptr; u.pm = pm; u.pn = pn; u.aux = 0; u.nvalid = 256; return true;
    }
};
struct TwoPartSched {      static constexpr bool HALFSKIP = false;
    const char* Y; const char* Wa; const char* Wb; int nM, nN, G, c;
    __device__ __forceinline__ bool next(int i, pg8::Unit& u) const {
        const int L = (i >> 1) * G + c, part = i & 1; if (L >= nM * nN) return false;
        int pm, pn; pg8::swz_tile(L, nM, nN, pm, pn);
        u.a = Y + (size_t)pm * 256 * 2048 + part * 1024; u.b = (part ? Wb : Wa) + (size_t)pn * 256 * 1024; u.rows = nullptr; u.pm = pm; u.pn = pn; u.aux = part; u.nvalid = 256; return true;
    }
};
struct MoeSched {
    static constexpr bool HALFSKIP = true;
    const LAS int* tbl; const LAS int* cnts; int nent; const char* A; const char* W; const int* lists; int ncol  , wtile  , wexp  , atile  , G, c;
    __device__ __forceinline__ bool next(int i, pg8::Unit& u) const {
        const int un = i * (G >> 3) + (c >> 3); if (un >= nent * ncol) return false;
        const int pn = un % ncol; const int ent = __builtin_amdgcn_readfirstlane(tbl[un / ncol]), e = (ent >> 7) & 511, r = ent & 127, rt = ent >> 16;
        u.a = A + (size_t)rt * atile; u.b = W + (size_t)e * wexp + (size_t)pn * wtile; u.rows = lists + (size_t)e * 16384 + r * 256;
        u.pm = rt; u.pn = pn; u.aux = e; const int left = __builtin_amdgcn_readfirstlane(cnts[e]) - r * 256; u.nvalid = left < 256 ? left : 256; return true;
    }
};

struct EpiInproj {
    static constexpr bool PERM = true;
    bf16_t* PROJ; float* LOGF; const float* LB; const float* ROPE; unsigned char* G8; unsigned char* QK8;
    __device__ __forceinline__ bool keep(const pg8::Unit&) const { return false; }
    __device__ __forceinline__ void operator()(f32x4 (&acc)[2][2][4][2], const pg8::Unit& u, int wr, int wc, int fr, int fq) const {
        const int pn = u.pn;
        const int mode = pn < 2 ? 0 : pn < 4 ? 1 : pn < 6 ? 0 : pn < 8 ? 2 : pn < 20 ? 3 : pn < 26 ? 0 : 4;
        const int row0 = u.pm * 256 + wr * 64 + fr, colb = pn * 256 + wc * 32 + 8 * fq;
        const bool rot = (mode == 3) && ((wc & 1) == 0);
#pragma unroll
        for (int ai = 0; ai < 2; ++ai)
#pragma unroll
            for (int m = 0; m < 4; ++m) {
                const int row = row0 + ai * 128 + m * 16;
                f32x4 cs0, cs1, sn0, sn1;
                if (rot) { const f32x4* rp = (const f32x4*)(ROPE + (size_t)row * 16); cs0 = rp[0]; cs1 = rp[1]; sn0 = rp[2]; sn1 = rp[3]; }
#pragma unroll
                for (int bj = 0; bj < 2; ++bj) {
                    const int col = colb + bj * 128;
                    f32x4 v0 = acc[ai][bj][m][0], v1 = acc[ai][bj][m][1];
                    if (mode == 1) {
                        const int cf = col - 512; const f32x4 l0 = *(const f32x4*)(LB + cf), l1 = *(const f32x4*)(LB + cf + 4);
                        f32x4 lf0, lf1;
#pragma unroll
                        for (int j = 0; j < 4; ++j) { float sg = sigmoidf_(v0[j]); float f = l0[j] + (1.f - l0[j]) * sg; lf0[j] = __logf(f); v0[j] = (1.f - l0[j]) * (1.f - sg);
                            sg = sigmoidf_(v1[j]); f = l1[j] + (1.f - l1[j]) * sg; lf1[j] = __logf(f); v1[j] = (1.f - l1[j]) * (1.f - sg); }
                        acc[ai][bj][m][0] = lf0; acc[ai][bj][m][1] = lf1;
                    } else if (mode == 2) {
#pragma unroll
                        for (int j = 0; j < 4; ++j) { v0[j] = v0[j] * sigmoidf_(v0[j]); v1[j] = v1[j] * sigmoidf_(v1[j]); }
                    } else if (mode == 4) {
#pragma unroll
                        for (int j = 0; j < 4; ++j) { v0[j] = sigmoidf_(v0[j]); v1[j] = sigmoidf_(v1[j]); }
                    } else if (rot) {
                        f32x4 p0, p1;
#pragma unroll
                        for (int j = 0; j < 4; ++j) { p0[j] = __shfl_xor(v0[j], 16); p1[j] = __shfl_xor(v1[j], 16); }
                        if (fq == 0) { v0 = v0 * cs0 - p0 * sn0; v1 = v1 * cs1 - p1 * sn1; }
                        else if (fq == 1) { v0 = v0 * cs0 + p0 * sn0; v1 = v1 * cs1 + p1 * sn1; }
                    }
                    if (mode == 4) {
                        int g0 = 0, g1 = 0;
#pragma unroll
                        for (int j = 0; j < 4; ++j) { g0 = __builtin_amdgcn_cvt_pk_u8_f32(fmaxf(v0[j] * 255.0f, 1.0f), j, g0); g1 = __builtin_amdgcn_cvt_pk_u8_f32(fmaxf(v1[j] * 255.0f, 1.0f), j, g1); }
                        *(u32x2*)(G8 + (size_t)row * 2048 + (col - C_GA)) = (u32x2){(unsigned)g0, (unsigned)g1};
                        continue; }
                    if (mode == 3) {
                        *(u32x2*)(QK8 + (size_t)row * 3072 + (col - C_AQ)) = (u32x2){pk4_fp8(v0[0], v0[1], v0[2], v0[3]), pk4_fp8(v1[0], v1[1], v1[2], v1[3])};
                        continue; }
                    u32x4 w; w.x = pg8::cvt_pk_bf16(v0[0], v0[1]); w.y = pg8::cvt_pk_bf16(v0[2], v0[3]); w.z = pg8::cvt_pk_bf16(v1[0], v1[1]); w.w = pg8::cvt_pk_bf16(v1[2], v1[3]);
                    *(u32x4*)(PROJ + (size_t)row * INW + col) = w;
                }
            }
        if (mode == 1) {
            const int lane = fq * 16 + fr;
#pragma unroll
            for (int ai = 0; ai < 2; ++ai)
#pragma unroll
                for (int bj = 0; bj < 2; ++bj)
#pragma unroll
                    for (int n = 0; n < 2; ++n)
#pragma unroll
                        for (int j = 0; j < 4; ++j) { float carry = 0.f;
#pragma unroll
                            for (int m = 0; m < 4; ++m) { float v = acc[ai][bj][m][n][j];
                                v += __builtin_bit_cast(float, __builtin_amdgcn_update_dpp(0, __builtin_bit_cast(int, v), 0x111, 0xF, 0xF, true));
                                v += __builtin_bit_cast(float, __builtin_amdgcn_update_dpp(0, __builtin_bit_cast(int, v), 0x112, 0xF, 0xF, true));
                                v += __builtin_bit_cast(float, __builtin_amdgcn_update_dpp(0, __builtin_bit_cast(int, v), 0x114, 0xF, 0xF, true));
                                v += __builtin_bit_cast(float, __builtin_amdgcn_update_dpp(0, __builtin_bit_cast(int, v), 0x118, 0xF, 0xF, true));
                                v += carry; acc[ai][bj][m][n][j] = v; carry = __shfl(v, (lane & 48) | 15); } }
#pragma unroll
            for (int ai = 0; ai < 2; ++ai)
#pragma unroll
                for (int m = 0; m < 4; ++m)
#pragma unroll
                    for (int bj = 0; bj < 2; ++bj) { float* lp = LOGF + (size_t)(row0 + ai * 128 + m * 16) * 512 + (colb + bj * 128 - 512); *(f32x4*)lp = acc[ai][bj][m][0]; *(f32x4*)(lp + 4) = acc[ai][bj][m][1]; }
        }
    }
};
__device__ __forceinline__ void gate8(u32x2 w, f32x4& lo, f32x4& hi) {
    constexpr float s = 1.0f / 255.0f;
    lo = (f32x4){(float)(w.x & 255u), (float)((w.x >> 8) & 255u), (float)((w.x >> 16) & 255u), (float)(w.x >> 24)} * s;
    hi = (f32x4){(float)(w.y & 255u), (float)((w.y >> 8) & 255u), (float)((w.y >> 16) & 255u), (float)(w.y >> 24)} * s;
}
struct EpiMixed {
    static constexpr bool PERM = true;
    const unsigned char* G8; bf16_t* MIXED;
    __device__ __forceinline__ bool keep(const pg8::Unit& u) const { return u.aux == 0; }
    __device__ __forceinline__ void operator()(f32x4 (&acc)[2][2][4][2], const pg8::Unit& u, int wr, int wc, int fr, int fq) const {
        const int row0 = u.pm * 256 + wr * 64 + fr, colb = u.pn * 256 + wc * 32 + 8 * fq;
#pragma unroll
        for (int ai = 0; ai < 2; ++ai)
#pragma unroll
            for (int m = 0; m < 4; ++m) {
                const int row = row0 + ai * 128 + m * 16;
#pragma unroll
                for (int bj = 0; bj < 2; ++bj) {
                    const int col = colb + bj * 128;
                    f32x4 b0, b1; gate8(*(const u32x2*)(G8 + (size_t)row * 2048 + 1024 + col), b0, b1);
                    if (u.aux == 0) {
                        f32x4 a0, a1; gate8(*(const u32x2*)(G8 + (size_t)row * 2048 + col), a0, a1);
#pragma unroll
                        for (int j = 0; j < 4; ++j) { acc[ai][bj][m][0][j] *= a0[j] / b0[j]; acc[ai][bj][m][1][j] *= a1[j] / b1[j]; }
                    } else {
                        const f32x4 v0 = acc[ai][bj][m][0] * b0, v1 = acc[ai][bj][m][1] * b1;
                        u32x4 w; w.x = pg8::cvt_pk_bf16(v0[0], v0[1]); w.y = pg8::cvt_pk_bf16(v0[2], v0[3]); w.z = pg8::cvt_pk_bf16(v1[0], v1[1]); w.w = pg8::cvt_pk_bf16(v1[2], v1[3]);
                        st_wt16(MIXED + (size_t)row * D + col, w);
                    }
                }
            }
    }
};
struct EpiOutproj {
    static constexpr bool PERM = true;
    const float* x; const float* MOD; bf16_t* X1;
    __device__ __forceinline__ bool keep(const pg8::Unit&) const { return false; }
    __device__ __forceinline__ void operator()(f32x4 (&acc)[2][2][4][2], const pg8::Unit& u, int wr, int wc, int fr, int fq) const {
        const int row0 = u.pm * 256 + wr * 64 + fr, colb = u.pn * 256 + wc * 32 + 8 * fq;
        const int b = (u.pm * 256) / SEQ;
#pragma unroll
        for (int bj = 0; bj < 2; ++bj) {
            const int col = colb + bj * 128;
            const f32x4 g0 = *(const f32x4*)(MOD + b * 6144 + 2048 + col), g1 = *(const f32x4*)(MOD + b * 6144 + 2048 + col + 4);
#pragma unroll
            for (int ai = 0; ai < 2; ++ai)
#pragma unroll
                for (int m = 0; m < 4; ++m) { const size_t off = (size_t)(row0 + ai * 128 + m * 16) * D + col;
                    const f32x4 v0 = *(const f32x4*)(x + off) + g0 * acc[ai][bj][m][0], v1 = *(const f32x4*)(x + off + 4) + g1 * acc[ai][bj][m][1];
                    u32x4 w; w.x = pg8::cvt_pk_bf16(v0[0], v0[1]); w.y = pg8::cvt_pk_bf16(v0[2], v0[3]); w.z = pg8::cvt_pk_bf16(v1[0], v1[1]); w.w = pg8::cvt_pk_bf16(v1[2], v1[3]);
                    st_wt16(X1 + off, w); }
        }
    }
};
struct EpiOutNorm {
    static constexpr bool PERM = true;
    const float* x; const float* MOD; const float* g2; bf16_t* X1; bf16_t* H; unsigned char* H8; float* XB; unsigned* cnt; LAS unsigned char* sl;
    __device__ __forceinline__ bool keep(const pg8::Unit&) const { return false; }
    __device__ __forceinline__ void operator()(f32x4 (&acc)[2][2][4][2], const pg8::Unit& u, int wr, int wc, int fr, int fq) const {
        const int tid = threadIdx.x;
        const int rl0 = wr * 64 + fr, row0 = u.pm * 256 + rl0, colb = u.pn * 256 + wc * 32 + 8 * fq;
        const int b = (u.pm * 256) / SEQ;
        LAS float* Pt = (LAS float*)sl; LAS float* Rs = (LAS float*)(sl + 4096);
#pragma unroll
        for (int bj = 0; bj < 2; ++bj) {
            const int col = colb + bj * 128;
            const f32x4 g0 = *(const f32x4*)(MOD + b * 6144 + 2048 + col), g1 = *(const f32x4*)(MOD + b * 6144 + 2048 + col + 4);
#pragma unroll
            for (int ai = 0; ai < 2; ++ai)
#pragma unroll
                for (int m = 0; m < 4; ++m) { const size_t off = (size_t)(row0 + ai * 128 + m * 16) * D + col;
                    acc[ai][bj][m][0] = *(const f32x4*)(x + off) + g0 * acc[ai][bj][m][0]; acc[ai][bj][m][1] = *(const f32x4*)(x + off + 4) + g1 * acc[ai][bj][m][1];
                    asm volatile("" : "+v"(acc[ai][bj][m][0]), "+v"(acc[ai][bj][m][1]));
                    if (m & 1) asm volatile("" ::: "memory"); }
        }
#pragma unroll
        for (int ai = 0; ai < 2; ++ai)
#pragma unroll
            for (int m = 0; m < 4; ++m) { float q = 0.f;
#pragma unroll
                for (int bj = 0; bj < 2; ++bj)
#pragma unroll
                    for (int n = 0; n < 2; ++n) { const f32x4 v = acc[ai][bj][m][n]; q += (v[0] * v[0] + v[1] * v[1]) + (v[2] * v[2] + v[3] * v[3]); }
                q += __shfl_xor(q, 16); q += __shfl_xor(q, 32);
                if (fq == 0) Pt[(ai * 128 + rl0 + m * 16) * 4 + wc] = q; }
        asm volatile("s_waitcnt lgkmcnt(0)" ::: "memory"); __builtin_amdgcn_s_barrier(); asm volatile("" ::: "memory");
        if (tid < 256) { const f32x4 p = *(const LAS f32x4*)(Pt + tid * 4); st_wt4(XB + ((size_t)u.pm * 256 + tid) * 4 + u.pn, __builtin_bit_cast(unsigned, (p[0] + p[1]) + (p[2] + p[3]))); }
        asm volatile("s_waitcnt vmcnt(0)" ::: "memory"); __builtin_amdgcn_s_barrier(); asm volatile("" ::: "memory");
        if (tid == 0) { unsigned* p = cnt + (size_t)u.pm * 64; (void)xb_add(p, 1u); unsigned sp = 0u;
            while (xb_ld(p) < 4u) { __builtin_amdgcn_s_sleep(2); if (++sp > (1u << 22)) break; }
            __builtin_amdgcn_fence(__ATOMIC_ACQUIRE, "agent"); asm volatile("s_waitcnt vmcnt(0)" ::: "memory"); }
        __builtin_amdgcn_s_barrier(); asm volatile("" ::: "memory");
        if (tid < 256) { const f32x4 q = *(const f32x4*)(XB + ((size_t)u.pm * 256 + tid) * 4); Rs[tid] = rsqrtf(((q[0] + q[1]) + (q[2] + q[3])) * (1.f / D) + EPS); }
        asm volatile("s_waitcnt vmcnt(0) lgkmcnt(0)" ::: "memory"); __builtin_amdgcn_s_barrier(); asm volatile("" ::: "memory");
#pragma unroll
        for (int bj = 0; bj < 2; ++bj) {
            const int col = colb + bj * 128;
            f32x4 gg[2], sc[2], sh[2];
#pragma unroll
            for (int q = 0; q < 2; ++q) { gg[q] = *(const f32x4*)(g2 + col + 4 * q); sh[q] = *(const f32x4*)(MOD + b * 6144 + 3072 + col + 4 * q); sc[q] = *(const f32x4*)(MOD + b * 6144 + 4096 + col + 4 * q) + 1.0f; gg[q] = gg[q] * sc[q]; }
#pragma unroll
            for (int ai = 0; ai < 2; ++ai)
#pragma unroll
                for (int m = 0; m < 4; ++m) { const int rl = ai * 128 + rl0 + m * 16; const size_t off = (size_t)(u.pm * 256 + rl) * D + col; const float rs = Rs[rl];
                    const f32x4 v0 = acc[ai][bj][m][0], v1 = acc[ai][bj][m][1];
                    u32x4 w; w.x = pg8::cvt_pk_bf16(v0[0], v0[1]); w.y = pg8::cvt_pk_bf16(v0[2], v0[3]); w.z = pg8::cvt_pk_bf16(v1[0], v1[1]); w.w = pg8::cvt_pk_bf16(v1[2], v1[3]);
                    *(u32x4*)(X1 + off) = w;
                    const f32x4 h0 = v0 * rs * gg[0] + sh[0], h1 = v1 * rs * gg[1] + sh[1];
                    u32x4 hw; hw.x = pg8::cvt_pk_bf16(h0[0], h0[1]); hw.y = pg8::cvt_pk_bf16(h0[2], h0[3]); hw.z = pg8::cvt_pk_bf16(h1[0], h1[1]); hw.w = pg8::cvt_pk_bf16(h1[2], h1[3]);
                    st_wt16(H + off, hw);
                    st_wt8(H8 + off, (unsigned long long)pk4_fp8(h0[0], h0[1], h0[2], h0[3]) | ((unsigned long long)pk4_fp8(h1[0], h1[1], h1[2], h1[3]) << 32));
                    asm volatile("" ::: "memory"); }
        }
    }
};
struct EpiRouter {
    static constexpr bool PERM = false;
    float* LOGITS4;
    __device__ __forceinline__ bool keep(const pg8::Unit&) const { return false; }
    __device__ __forceinline__ void operator()(f32x4 (&acc)[2][2][4][2], const pg8::Unit& u, int wr, int wc, int fr, int fq) const {
        const int row0 = u.pm * 256 + wr * 64 + fr, colb = wc * 32 + 4 * fq;
        float* base = LOGITS4 + (size_t)u.aux * T * 256;
#pragma unroll
        for (int ai = 0; ai < 2; ++ai)
#pragma unroll
            for (int m = 0; m < 4; ++m)
#pragma unroll
                for (int bj = 0; bj < 2; ++bj)
#pragma unroll
                    for (int n = 0; n < 2; ++n) st_wt16(base + (size_t)(row0 + ai * 128 + m * 16) * 256 + colb + bj * 128 + n * 16, __builtin_bit_cast(u32x4, acc[ai][bj][m][n]));
    }
};
struct RouterSched {
    static constexpr bool HALFSKIP = false;
    const char* A; const char* Bt; int G, c;
    __device__ __forceinline__ bool next(int i, pg8::Unit& u) const {
        const int L = i * G + c; if (L >= 256) return false;
        const int pm = L >> 2, ks = L & 3;
        u.a = A + (size_t)pm * 256 * 2048 + ks * 512; u.b = Bt + ks * 512; u.rows = nullptr; u.pm = pm; u.pn = 0; u.aux = ks; u.nvalid = 256; return true;
    }
};
struct EpiGU {
    static constexpr bool PERM = true;
    unsigned char* ACT;
    __device__ __forceinline__ bool keep(const pg8::Unit&) const { return false; }
    __device__ __forceinline__ void operator()(f32x4 (&acc)[2][2][4][2], const pg8::Unit& u, int wr, int wc, int fr, int fq) const {
        const int rl0 = wr * 64 + fr, col = u.pn * 128 + wc * 32 + 8 * fq;
        constexpr float is = 1.0f / WGU_SCALE;
#pragma unroll
        for (int ai = 0; ai < 2; ++ai)
#pragma unroll
            for (int m = 0; m < 4; ++m) {
                const int rl = rl0 + ai * 128 + m * 16;
                f32x4 v0, v1;
#pragma unroll
                for (int j = 0; j < 4; ++j) { const float a0 = acc[ai][0][m][0][j] * is, a1 = acc[ai][0][m][1][j] * is;
                    v0[j] = a0 * sigmoidf_(a0) * (acc[ai][1][m][0][j] * is); v1[j] = a1 * sigmoidf_(a1) * (acc[ai][1][m][1][j] * is); }
                *(u32x2*)(ACT + ((size_t)u.pm * 256 + rl) * EFF + col) = (u32x2){pk4_fp8(v0[0], v0[1], v0[2], v0[3]), pk4_fp8(v1[0], v1[1], v1[2], v1[3])};
                asm volatile("" ::: "memory");
            }
    }
};
struct EpiDown {
    static constexpr bool PERM = true;
    unsigned char* YBUF; const float* GATEW;
    __device__ __forceinline__ bool keep(const pg8::Unit&) const { return false; }
    __device__ __forceinline__ void operator()(f32x4 (&acc)[2][2][4][2], const pg8::Unit& u, int wr, int wc, int fr, int fq) const {
        const int rl0 = wr * 64 + fr, colb = u.pn * 256 + wc * 32 + 8 * fq;
#pragma unroll
        for (int ai = 0; ai < 2; ++ai)
#pragma unroll
            for (int m = 0; m < 4; ++m) {
                const int rl = rl0 + ai * 128 + m * 16;
                if (rl < u.nvalid) {
                    const int slot = u.rows[rl]; const float gw = GATEW[slot] * (YSCALE / WD_SCALE);
#pragma unroll
                    for (int bj = 0; bj < 2; ++bj) { const f32x4 v0 = acc[ai][bj][m][0] * gw, v1 = acc[ai][bj][m][1] * gw;
                        *(u32x2*)(YBUF + (size_t)slot * D + colb + bj * 128) = (u32x2){pk4_fp8(v0[0], v0[1], v0[2], v0[3]), pk4_fp8(v1[0], v1[1], v1[2], v1[3])}; }
                }
                asm volatile("" ::: "memory");
            }
    }
};

#define MFMA16(a, b, c) __builtin_amdgcn_mfma_f32_16x16x32_bf16((a), (b), (c), 0, 0, 0)
#define MFMA32(a, b, c) __builtin_amdgcn_mfma_f32_32x32x16_bf16((a), (b), (c), 0, 0, 0)
__device__ __forceinline__ s16x4 tr16(const LAS unsigned char* p) { return __builtin_amdgcn_ds_read_tr16_b64_v4i16((LAS s16x4*)p); }
__device__ __forceinline__ bf16x8 cat8(s16x4 a, s16x4 b) { bf16x8 r; r[0] = a[0]; r[1] = a[1]; r[2] = a[2]; r[3] = a[3]; r[4] = b[0]; r[5] = b[1]; r[6] = b[2]; r[7] = b[3]; return r; }
__device__ __forceinline__ u32x4 pack8(const float (&v)[8]) { u32x4 w; w.x = pg8::cvt_pk_bf16(v[0], v[1]); w.y = pg8::cvt_pk_bf16(v[2], v[3]); w.z = pg8::cvt_pk_bf16(v[4], v[5]); w.w = pg8::cvt_pk_bf16(v[6], v[7]); return w; }
__device__ __forceinline__ void unpack8(u32x4 w, float (&v)[8]) { v[0] = bflo(w.x); v[1] = bfhi(w.x); v[2] = bflo(w.y); v[3] = bfhi(w.y); v[4] = bflo(w.z); v[5] = bfhi(w.z); v[6] = bflo(w.w); v[7] = bfhi(w.w); }
__device__ __forceinline__ int swzA(int row) { return (row & 3) | (((row >> 3) & 1) << 2); }
__device__ __forceinline__ void hgrn_kv_unit(Ctx& X, int bn) {
    const int t0 = bn * 64;
    const bf16_t* PROJ = WSP(bf16_t, WS_PROJ); const float* BC = WSP(float, WS_LOGF);
#pragma unroll 2
    for (int j = 0; j < 8; ++j) {
        const int p = X.tid + NTHREADS * j, row = p >> 6, c64 = p & 63, h = c64 >> 4, ch = c64 & 15;
        const size_t prow = (size_t)(t0 + row) * INW + h * 128 + 8 * ch;
        const u32x4 kraw = *(const u32x4*)(PROJ + prow + C_HK), vraw = *(const u32x4*)(PROJ + prow + C_HV);
        const float* bp = BC + (size_t)(t0 + row) * 512 + h * 128 + 8 * ch; const float* bl = BC + (size_t)(t0 + 63) * 512 + h * 128 + 8 * ch;
        const f32x4 b0 = *(const f32x4*)bp, b1 = *(const f32x4*)(bp + 4), l0 = *(const f32x4*)bl, l1 = *(const f32x4*)(bl + 4);
        float kv[8]; unpack8(kraw, kv);
#pragma unroll
        for (int e = 0; e < 4; ++e) { kv[e] *= __expf(l0[e] - b0[e]); kv[4 + e] *= __expf(l1[e] - b1[e]); }
        const int off = row * 256 + (((ch >> 1) ^ swzA(row)) * 32) + (ch & 1) * 16;
        *(LAS u32x4*)(X.lds + h * 32768 + off) = vraw; *(LAS u32x4*)(X.lds + h * 32768 + 16384 + off) = pack8(kv);
    }
    WSP(float, WS_DECAY)[bn * 512 + X.tid] = __expf(BC[(size_t)(t0 + 63) * 512 + X.tid]);
    __syncthreads();
    const int l = X.lane, w = X.wave, fr = l & 15, fq = l >> 4, r = fr >> 2, p4 = l & 3, h = w >> 1, vt0 = 4 * (w & 1);
    const LAS unsigned char* VI = X.lds + h * 32768; const LAS unsigned char* KI = VI + 16384;
    bf16x8 af[4][2];
#pragma unroll
    for (int vt = 0; vt < 4; ++vt)
#pragma unroll
        for (int kk = 0; kk < 2; ++kk) { const int r0 = 32 * kk + 8 * fq + r, r1 = r0 + 4;
            af[vt][kk] = cat8(tr16(VI + r0 * 256 + (((vt0 + vt) ^ swzA(r0)) * 32) + p4 * 8), tr16(VI + r1 * 256 + (((vt0 + vt) ^ swzA(r1)) * 32) + p4 * 8)); }
    bf16_t* KVT = WSP(bf16_t, WS_KVT) + (size_t)(bn * 4 + h) * 16384;
#pragma unroll 2
    for (int ct = 0; ct < 8; ++ct) {
        bf16x8 bfr[2];
#pragma unroll
        for (int kk = 0; kk < 2; ++kk) { const int r0 = 32 * kk + 8 * fq + r, r1 = r0 + 4;
            bfr[kk] = cat8(tr16(KI + r0 * 256 + ((ct ^ swzA(r0)) * 32) + p4 * 8), tr16(KI + r1 * 256 + ((ct ^ swzA(r1)) * 32) + p4 * 8)); }
#pragma unroll
        for (int vt = 0; vt < 4; ++vt) { f32x4 acc = {0.f, 0.f, 0.f, 0.f}; acc = MFMA16(bfr[0], af[vt][0], acc); acc = MFMA16(bfr[1], af[vt][1], acc);
            u32x2 wv; wv.x = pg8::cvt_pk_bf16(acc[0], acc[1]); wv.y = pg8::cvt_pk_bf16(acc[2], acc[3]);
            *(u32x2*)(KVT + (16 * (vt0 + vt) + fr) * 128 + 16 * ct + 4 * fq) = wv; }
    }
    __syncthreads();
}
__device__ __forceinline__ void hgrn_passB(Ctx& X) {
    const unsigned* KVT = WSP(unsigned, WS_KVT); const float* DECAY = WSP(float, WS_DECAY); unsigned* SPT = WSP(unsigned, WS_SPT);
    const int gt = X.wg * NTHREADS + X.tid, NGT = X.G * NTHREADS;
    for (int item = gt; item < 16 * 128 * 64; item += NGT) {
        const int bh = item >> 13, rem = item & 8191, vd = rem >> 6, c = (rem & 63) * 2, b = bh >> 2, h = bh & 3;
        float s0 = 0.f, s1 = 0.f;
#pragma unroll 8
        for (int n = 0; n < 64; ++n) {
            const int unit = (b * 64 + n) * 4 + h;
            const unsigned kw = KVT[((size_t)unit * 16384 + vd * 128 + c) >> 1]; const f32x2 kv = {bflo(kw), bfhi(kw)};
            const f32x2 dc = *(const f32x2*)(DECAY + unit * 128 + c);
            SPT[((size_t)unit * 16384 + vd * 128 + c) >> 1] = pk2(s0, s1);
            s0 = dc.x * s0 + kv.x; s1 = dc.y * s1 + kv.y;
        }
    }
}
__device__ __forceinline__ void hgrn_out_unit(Ctx& X, int u2) {
    const int bn = u2 >> 1, hp = u2 & 1, t0 = bn * 64;
    const bf16_t* PROJ = WSP(bf16_t, WS_PROJ); const float* BCg = WSP(float, WS_LOGF);
#pragma unroll 2
    for (int j = 0; j < 4; ++j) { const int p = X.tid + NTHREADS * j, row = p >> 5, c32 = p & 31, hh = c32 >> 4, ch = c32 & 15, h = 2 * hp + hh;
        const size_t prow = (size_t)(t0 + row) * INW + h * 128 + 8 * ch;
        const u32x4 qraw = *(const u32x4*)(PROJ + prow + C_HQ), kraw = *(const u32x4*)(PROJ + prow + C_HK), vraw = *(const u32x4*)(PROJ + prow + C_HV);
        const float* bp = BCg + (size_t)(t0 + row) * 512 + h * 128 + 8 * ch; const float* br = BCg + (size_t)(t0 + 32) * 512 + h * 128 + 8 * ch;
        const f32x4 b0 = *(const f32x4*)bp, b1 = *(const f32x4*)(bp + 4), r0 = *(const f32x4*)br, r1 = *(const f32x4*)(br + 4);
        float qv[8], kv[8], a[8], bq[8]; unpack8(qraw, qv); unpack8(kraw, kv);
#pragma unroll
        for (int e = 0; e < 4; ++e) { const float e0 = __expf(b0[e] - r0[e]), e1 = __expf(b1[e] - r1[e]);
            a[e] = qv[e] * e0; a[4 + e] = qv[4 + e] * e1; kv[e] *= __builtin_amdgcn_rcpf(e0); kv[4 + e] *= __builtin_amdgcn_rcpf(e1);
            bq[e] = qv[e] * __expf(b0[e]); bq[4 + e] = qv[4 + e] * __expf(b1[e]); }
        LAS unsigned char* hb = X.lds + hh * 65536; const int o16 = row * 256 + ((ch ^ (row & 15)) * 16);
        *(LAS u32x4*)(hb + o16) = pack8(a); *(LAS u32x4*)(hb + 16384 + o16) = pack8(kv); *(LAS u32x4*)(hb + 32768 + o16) = pack8(bq);
        *(LAS u32x4*)(hb + 49152 + row * 256 + (((ch >> 1) ^ (row & 7)) * 32) + (ch & 1) * 16) = vraw; }
    const int l = X.lane, w = X.wave, fr = l & 15, fq = l >> 4, r = fr >> 2, p4 = l & 3, hh = w >> 2, h = 2 * hp + hh, ti = w & 3;
    const int tq = 16 * ti + fr;
    const bf16_t* SPT = WSP(bf16_t, WS_SPT) + (size_t)(bn * 4 + h) * 16384;
    __syncthreads();
    const LAS unsigned char* QSI = X.lds + hh * 65536; const LAS unsigned char* KSI = QSI + 16384; const LAS unsigned char* QNI = QSI + 32768; const LAS unsigned char* VI = QSI + 49152;
    bf16x8 QS[4];
#pragma unroll
    for (int ks = 0; ks < 4; ++ks) QS[ks] = *(const LAS bf16x8*)(QSI + tq * 256 + (((4 * ks + fq) ^ (tq & 15)) * 16));
    f32x4 ST[4];
#pragma unroll
    for (int si = 0; si < 4; ++si) {
        f32x4 acc = {0.f, 0.f, 0.f, 0.f};
        if (si <= ti) {
            const int sr = 16 * si + fr;
#pragma unroll
            for (int ks = 0; ks < 4; ++ks) { const bf16x8 kf = *(const LAS bf16x8*)(KSI + sr * 256 + (((4 * ks + fq) ^ (sr & 15)) * 16)); acc = MFMA16(kf, QS[ks], acc); }
            if (si == ti) {
#pragma unroll
                for (int q = 0; q < 4; ++q) acc[q] = (4 * fq + q <= fr) ? acc[q] : 0.f; }
        }
        ST[si] = acc;
    }
    f32x4 o[8];
#pragma unroll
    for (int vt = 0; vt < 8; ++vt) o[vt] = (f32x4){0.f, 0.f, 0.f, 0.f};
#pragma unroll
    for (int kk = 0; kk < 2; ++kk) {
        if (2 * kk <= ti) {
            float pv[8];
#pragma unroll
            for (int q = 0; q < 4; ++q) { pv[q] = ST[2 * kk][q]; pv[4 + q] = ST[2 * kk + 1][q]; }
            const bf16x8 pf = __builtin_bit_cast(bf16x8, pack8(pv));
            const int r0 = 32 * kk + 4 * fq + r, r1 = r0 + 16;
#pragma unroll
            for (int vt = 0; vt < 8; ++vt) { const bf16x8 va = cat8(tr16(VI + r0 * 256 + ((vt ^ (r0 & 7)) * 32) + p4 * 8), tr16(VI + r1 * 256 + ((vt ^ (r1 & 7)) * 32) + p4 * 8));
                o[vt] = MFMA16(va, pf, o[vt]); }
        }
    }
#pragma unroll
    for (int ks = 0; ks < 4; ++ks) { const bf16x8 qn = *(const LAS bf16x8*)(QNI + tq * 256 + (((4 * ks + fq) ^ (tq & 15)) * 16));
#pragma unroll
        for (int vt = 0; vt < 8; ++vt) { const bf16x8 sa = *(const bf16x8*)(SPT + (16 * vt + fr) * 128 + 32 * ks + 8 * fq); o[vt] = MFMA16(sa, qn, o[vt]); } }
    float ss = 0.f;
#pragma unroll
    for (int vt = 0; vt < 8; ++vt) ss += (o[vt][0] * o[vt][0] + o[vt][1] * o[vt][1]) + (o[vt][2] * o[vt][2] + o[vt][3] * o[vt][3]);
    ss += __shfl_xor(ss, 16); ss += __shfl_xor(ss, 32);
    const float rstd = rsqrtf(ss * (1.f / 128.f) + EPS);
    bf16_t* YCAT = WSP(bf16_t, WS_YCAT);
#pragma unroll
    for (int vt = 0; vt < 8; ++vt) { const int vd = 16 * vt + 4 * fq;
        const u32x2 sg = *(const u32x2*)(PROJ + (size_t)(t0 + tq) * INW + C_HG + h * 128 + vd); const f32x4 gn = *(const f32x4*)(X.g_hgrn + h * 128 + vd);
        u32x2 wv; wv.x = pg8::cvt_pk_bf16(o[vt][0] * rstd * gn[0] * bflo(sg.x), o[vt][1] * rstd * gn[1] * bfhi(sg.x)); wv.y = pg8::cvt_pk_bf16(o[vt][2] * rstd * gn[2] * bflo(sg.y), o[vt][3] * rstd * gn[3] * bfhi(sg.y));
        *(u32x2*)(YCAT + (size_t)(t0 + tq) * D + h * 128 + vd) = wv; }
    __syncthreads();
}

struct AttnRegs { u32x4 k[3], v[6]; long q[4]; };
__device__ __forceinline__ void attn_load(Ctx& X, int unit, AttnRegs& R) {
    const int u16 = unit & 15, h = (unit >> 4) & 7, g = (unit >> 7) % 3, b = unit / 384;
    const int d = g == 0 ? 1 : g == 1 ? 4 : 16, nblk = 16 / d, r = u16 / nblk, blk = u16 % nblk;
    const int vcol = C_AV + g * 512 + h * 64;
    const int mk0 = blk * 256 - 128;
    const bf16_t* PROJ = WSP(bf16_t, WS_PROJ); const unsigned char* QK8 = WSP(unsigned char, WS_QK8);
    const int q8col = g * 512 + h * 64, k8col = 1536 + g * 512 + h * 64;
#pragma unroll
    for (int j = 0; j < 6; ++j) { const int idx = X.tid + NTHREADS * j, row = idx >> 3, ch = idx & 7, m = mk0 + row;
        R.v[j] = (u32x4){0u, 0u, 0u, 0u};
        if (m >= 0) { const size_t tok = (size_t)b * SEQ + (size_t)m * d + r; R.v[j] = *(const u32x4*)(PROJ + tok * INW + vcol + ch * 8); } }
#pragma unroll
    for (int j = 0; j < 3; ++j) { const int idx = X.tid + NTHREADS * j, row = idx >> 2, ch = idx & 3, m = mk0 + row;
        R.k[j] = (u32x4){0u, 0u, 0u, 0u};
        if (m >= 0) { const size_t tok = (size_t)b * SEQ + (size_t)m * d + r; R.k[j] = *(const u32x4*)(QK8 + tok * 3072 + k8col + ch * 16); } }
    const int l = X.lane, w = X.wave, q = l & 31, hi = l >> 5;
    const size_t tokq = (size_t)b * SEQ + (size_t)(blk * 256 + 32 * w + q) * d + r;
#pragma unroll
    for (int ds = 0; ds < 4; ++ds) R.q[ds] = *(const long*)(QK8 + tokq * 3072 + q8col + ds * 16 + hi * 8);
}
__device__ __forceinline__ void attn_stage(Ctx& X, const AttnRegs& R) {
    LAS unsigned char* KL = X.lds; LAS unsigned char* VL = X.lds + 55296;
#pragma unroll
    for (int j = 0; j < 6; ++j) { const int idx = X.tid + NTHREADS * j, row = idx >> 3, ch = idx & 7;
        *(LAS u32x4*)(VL + row * 128 + ch * 16) = R.v[j]; }
#pragma unroll
    for (int j = 0; j < 3; ++j) { const int idx = X.tid + NTHREADS * j, row = idx >> 2, ch = idx & 3;
        *(LAS u32x4*)(KL + row * 80 + ch * 16) = R.k[j]; }
}
__device__ __forceinline__ void attn_compute(Ctx& X, int unit, const long (&qf)[4]) {
    const int u16 = unit & 15, h = (unit >> 4) & 7, g = (unit >> 7) % 3, b = unit / 384;
    const int d = g == 0 ? 1 : g == 1 ? 4 : 16, nblk = 16 / d, r = u16 / nblk, blk = u16 % nblk;
    const int mk0 = blk * 256 - 128;
    LAS unsigned char* KL = X.lds; LAS unsigned char* VL = X.lds + 55296;
    const int l = X.lane, w = X.wave, q = l & 31, hi = l >> 5;
    const size_t tokq = (size_t)b * SEQ + (size_t)(blk * 256 + 32 * w + q) * d + r;
    f32x16 s[5];
#pragma unroll
    for (int kt = 0; kt < 5; ++kt) {
        f32x16 acc;
#pragma unroll
        for (int i = 0; i < 16; ++i) acc[i] = 0.f;
#pragma unroll
        for (int ds = 0; ds < 4; ++ds) { const long kf = *(const LAS long*)(KL + (32 * w + 32 * kt + q) * 80 + ds * 16 + hi * 8); acc = __builtin_amdgcn_mfma_f32_32x32x16_fp8_fp8(kf, qf[ds], acc, 0, 0, 0); }
        s[kt] = acc;
    }
    const int iq = 32 * w + q;
    const int jmin = iq > -mk0 ? iq : -mk0; const unsigned jspan = (unsigned)(iq + 128 - jmin);
    float mx = -INFINITY;
#pragma unroll
    for (int kt = 0; kt < 5; ++kt)
#pragma unroll
        for (int rg = 0; rg < 16; ++rg) { const int j = 32 * w + 32 * kt + (rg & 3) + 8 * (rg >> 2) + 4 * hi;
            const bool valid = (unsigned)(j - jmin) <= jspan;
            s[kt][rg] = valid ? s[kt][rg] : -INFINITY; mx = fmaxf(mx, s[kt][rg]); if ((rg & 3) == 3) __builtin_amdgcn_sched_barrier(0); }
    mx = fmaxf(mx, __shfl_xor(mx, 32));
    const float c2 = 0.125f * 1.4426950408889634f;
    float lsum = 0.f;
#pragma unroll
    for (int kt = 0; kt < 5; ++kt)
#pragma unroll
        for (int rg = 0; rg < 16; ++rg) { const float p = exp2f((s[kt][rg] - mx) * c2); s[kt][rg] = p; lsum += p; }
    lsum += __shfl_xor(lsum, 32);
    f32x16 o[2];
#pragma unroll
    for (int dt = 0; dt < 2; ++dt)
#pragma unroll
        for (int i = 0; i < 16; ++i) o[dt][i] = 0.f;
    const int vlane = ((l & 15) >> 2) * 128 + (((l >> 4) & 1) * 16 + (l & 3) * 4) * 2;
#pragma unroll
    for (int kt = 0; kt < 5; ++kt)
#pragma unroll
        for (int s2 = 0; s2 < 2; ++s2) {
            bf16x8 pb;
#pragma unroll
            for (int j = 0; j < 8; j += 2) { const unsigned pw = pg8::cvt_pk_bf16(s[kt][8 * s2 + j], s[kt][8 * s2 + j + 1]); pb[j] = (short)(pw & 0xffffu); pb[j + 1] = (short)(pw >> 16); }
            const int key0 = 32 * w + 32 * kt + 16 * s2 + 4 * hi;
#pragma unroll
            for (int dt = 0; dt < 2; ++dt) {
                LAS unsigned char* vp = VL + key0 * 128 + dt * 64 + vlane;
                const s16x4 t0 = __builtin_amdgcn_ds_read_tr16_b64_v4i16((LAS s16x4*)vp);
                const s16x4 t1 = __builtin_amdgcn_ds_read_tr16_b64_v4i16((LAS s16x4*)(vp + 8 * 128));
                bf16x8 va; va[0] = t0[0]; va[1] = t0[1]; va[2] = t0[2]; va[3] = t0[3]; va[4] = t1[0]; va[5] = t1[1]; va[6] = t1[2]; va[7] = t1[3];
                o[dt] = MFMA32(va, pb, o[dt]);
            }
        }
    const float inv = 1.0f / lsum;
    bf16_t* OG = WSP(bf16_t, WS_OG) + (size_t)g * T * 512;
#pragma unroll
    for (int dt = 0; dt < 2; ++dt)
#pragma unroll
        for (int rg = 0; rg < 4; ++rg) { const int d0 = 32 * dt + 8 * rg + 4 * hi;
            u32x2 wv; wv.x = pg8::cvt_pk_bf16(o[dt][4 * rg] * inv, o[dt][4 * rg + 1] * inv); wv.y = pg8::cvt_pk_bf16(o[dt][4 * rg + 2] * inv, o[dt][4 * rg + 3] * inv);
            *(u32x2*)(OG + tokq * 512 + h * 64 + d0) = wv; }
    if (hi == 0) WSP(float, WS_LSE)[((size_t)g * T + tokq) * 8 + h] = mx * 0.125f + __logf(lsum);
}
__device__ __forceinline__ void attn_combine(Ctx& X) {
    const bf16_t* OG = WSP(bf16_t, WS_OG); const float* LSE = WSP(float, WS_LSE); bf16_t* YCAT = WSP(bf16_t, WS_YCAT);
    const int gt = X.wg * NTHREADS + X.tid, NGT = X.G * NTHREADS;
    for (int item = gt; item < T * 64; item += NGT) {
        const int t = item >> 6, ch = item & 63, h = ch >> 3;
        const float l0 = LSE[(size_t)t * 8 + h], l1 = LSE[((size_t)T + t) * 8 + h], l2 = LSE[((size_t)2 * T + t) * 8 + h];
        const float m = fmaxf(l0, fmaxf(l1, l2)); float w0 = __expf(l0 - m), w1 = __expf(l1 - m), w2 = __expf(l2 - m); const float inv = 1.f / (w0 + w1 + w2); w0 *= inv; w1 *= inv; w2 *= inv;
        const u32x4 a = *(const u32x4*)(OG + (size_t)t * 512 + ch * 8), bq = *(const u32x4*)(OG + ((size_t)T + t) * 512 + ch * 8), cq = *(const u32x4*)(OG + ((size_t)2 * T + t) * 512 + ch * 8);
        u32x4 o;
#pragma unroll
        for (int j = 0; j < 4; ++j) o[j] = pk2(w0 * bflo(a[j]) + w1 * bflo(bq[j]) + w2 * bflo(cq[j]), w0 * bfhi(a[j]) + w1 * bfhi(bq[j]) + w2 * bfhi(cq[j]));
        *(u32x4*)(YCAT + (size_t)t * D + 512 + ch * 8) = o;
    }
}

__device__ __forceinline__ unsigned sortable_key(float f) { const unsigned u = __builtin_bit_cast(unsigned, f); return (u & 0x80000000u) ? ~u : (u | 0x80000000u); }
__device__ __forceinline__ void moe_route(Ctx& X, bool local) {
    const float* LG = WSP(float, WS_KVT); unsigned* CNT = WSP(unsigned, WS_CTL) + CW_CNT; int* LISTS = WSP(int, WS_LISTS); float* GATEW = WSP(float, WS_GATEW);
    const int gw = X.wg * NWAVES + X.wave, NGW = X.G * NWAVES, l = X.lane, grp = l >> 3;
    const f32x4 bias = *(const f32x4*)(X.rbias + 4 * l);
    const unsigned long long ltmask = (1ull << l) - 1ull;
    const int tbeg = local ? X.wg * 64 + X.wave : gw, tend = local ? X.wg * 64 + 64 : T, tstep = local ? NWAVES : NGW;
    for (int t = tbeg; t < tend; t += tstep) {
        f32x4 lg = *(const f32x4*)(LG + (size_t)t * 256 + 4 * l);
#pragma unroll
        for (int ks = 1; ks < 4; ++ks) lg += *(const f32x4*)(LG + ((size_t)ks * T + t) * 256 + 4 * l);
        float sc[4], mb[4];
#pragma unroll
        for (int i = 0; i < 4; ++i) { sc[i] = sigmoidf_(lg[i]); mb[i] = sc[i] + bias[i]; }
        float m1 = fmaxf(mb[0], mb[1]), m2 = fminf(mb[0], mb[1]);
        { const float a1 = fmaxf(mb[2], mb[3]), a2 = fminf(mb[2], mb[3]); const float n1 = fmaxf(m1, a1), n2 = fmaxf(fminf(m1, a1), fmaxf(m2, a2)); m1 = n1; m2 = n2; }
#pragma unroll
        for (int o = 1; o < 8; o <<= 1) { const float a1 = __shfl_xor(m1, o), a2 = __shfl_xor(m2, o); const float n1 = fmaxf(m1, a1), n2 = fmaxf(fminf(m1, a1), fmaxf(m2, a2)); m1 = n1; m2 = n2; }
        const float gs = m1 + m2;
        int rank = 0;
#pragma unroll
        for (int gg = 0; gg < 8; ++gg) { const float og = __builtin_bit_cast(float, __builtin_amdgcn_readlane(__builtin_bit_cast(int, gs), gg * 8)); rank += (og > gs || (og == gs && gg < grp)) ? 1 : 0; }
        const bool sel = rank < 4;
        unsigned key[4];
#pragma unroll
        for (int i = 0; i < 4; ++i) key[i] = sel ? sortable_key(mb[i]) : 0u;
        unsigned pre = 0u;
#pragma unroll 1
        for (int bit = 31; bit >= 0; --bit) { const unsigned cand = pre | (1u << bit);
            const int cnt = __popcll(__ballot(key[0] >= cand)) + __popcll(__ballot(key[1] >= cand)) + __popcll(__ballot(key[2] >= cand)) + __popcll(__ballot(key[3] >= cand));
            if (cnt >= TOPK) pre = cand; }
        int ngt = 0, eqb = 0, tkb = 0; bool take[4];
#pragma unroll
        for (int i = 0; i < 4; ++i) ngt += __popcll(__ballot(key[i] > pre));
        const int need = TOPK - ngt;
#pragma unroll
        for (int i = 0; i < 4; ++i) eqb += __popcll(__ballot(key[i] == pre) & ltmask);
        int eqrun = eqb;
#pragma unroll
        for (int i = 0; i < 4; ++i) { const bool eq = key[i] == pre; take[i] = (key[i] > pre) || (eq && eqrun < need); eqrun += eq ? 1 : 0; }
#pragma unroll
        for (int i = 0; i < 4; ++i) tkb += __popcll(__ballot(take[i]) & ltmask);
        float part = 0.f;
#pragma unroll
        for (int i = 0; i < 4; ++i) part += take[i] ? sc[i] : 0.f;
        const float scale = 2.5f / wave_sum(part);
        int slot = tkb;
#pragma unroll
        for (int i = 0; i < 4; ++i) if (take[i]) { const int e = 4 * l + i; const unsigned pos = atomicAdd(&CNT[e * 64], 1u); LISTS[(size_t)e * 16384 + pos] = t * NSLOT + slot; GATEW[t * NSLOT + slot] = sc[i] * scale; ++slot; }
        if (l == 0) { LISTS[(size_t)NE * 16384 + t] = t * NSLOT + TOPK; GATEW[t * NSLOT + TOPK] = 1.0f; }
    }
}
__device__ __forceinline__ int moe_table(Ctx& X) {
    LAS int* tbl = (LAS int*)(X.lds + TBL_OFF); LAS int* cnts = (LAS int*)(X.lds + TCNT_OFF); LAS int* pref = cnts + 320;
    const unsigned* CNT = WSP(unsigned, WS_CTL) + CW_CNT;
    const int x = X.wg & 7;
    if (X.tid < NEX) cnts[X.tid] = X.tid < NE ? (int)__hip_atomic_load(CNT + X.tid * 64, __ATOMIC_RELAXED, __HIP_MEMORY_SCOPE_AGENT) : T;
    __syncthreads();
    if (X.tid < NEX) { int pre = 0; for (int e = 0; e < X.tid; ++e) pre += (cnts[e] + 255) >> 8; pref[X.tid] = pre; }
    __syncthreads();
    if (X.tid < 33) {
        const int i = X.tid; int lp = 0; for (int k = 0; k < i && k < 32; ++k) lp += (cnts[x + 8 * k] + 255) >> 8;
        if (i < 32) { const int e = x + 8 * i, n = (cnts[e] + 255) >> 8, p0 = pref[e]; for (int r = 0; r < n; ++r) tbl[lp + r] = ((p0 + r) << 16) | (e << 7) | r; }
        else { const int p0 = pref[NE]; for (int r8 = 0; r8 < 8; ++r8) { const int r = 8 * x + r8; tbl[lp + r8] = ((p0 + r) << 16) | (NE << 7) | r; } cnts[600] = lp + 8; }
    }
    __syncthreads();
    return __builtin_amdgcn_readfirstlane(cnts[600]);
}
__device__ __forceinline__ void final_rows(Ctx& X) {
    const bf16_t* X1 = WSP(bf16_t, WS_X1); const float* MOD = WSP(float, WS_MOD); const unsigned char* YBUF = WSP(unsigned char, WS_YBUF);
    const int gw = X.wg * NWAVES + X.wave, NGW = X.G * NWAVES, l = X.lane;
    for (int t = gw; t < T; t += NGW) {
        const int b = t / SEQ; f32x4 v[2][2]; float s = 0.f;
#pragma unroll
        for (int j = 0; j < 2; ++j) { const int col = 8 * l + 512 * j; f32x4 m0 = {0.f, 0.f, 0.f, 0.f}, m1 = {0.f, 0.f, 0.f, 0.f};
#pragma unroll
            for (int k = 0; k < NSLOT; ++k) { const u32x2 y = *(const u32x2*)(YBUF + ((size_t)t * NSLOT + k) * D + col);
                const f32x2 a = __builtin_amdgcn_cvt_pk_f32_fp8((int)y.x, false), bq = __builtin_amdgcn_cvt_pk_f32_fp8((int)y.x, true), c = __builtin_amdgcn_cvt_pk_f32_fp8((int)y.y, false), d = __builtin_amdgcn_cvt_pk_f32_fp8((int)y.y, true);
                m0.x += a[0]; m0.y += a[1]; m0.z += bq[0]; m0.w += bq[1]; m1.x += c[0]; m1.y += c[1]; m1.z += d[0]; m1.w += d[1]; }
            const f32x4 g0 = *(const f32x4*)(MOD + b * 6144 + 5120 + col) * (1.0f / YSCALE), g1 = *(const f32x4*)(MOD + b * 6144 + 5120 + col + 4) * (1.0f / YSCALE);
            const u32x4 xw = *(const u32x4*)(X1 + (size_t)t * D + col); const f32x4 x0 = {bflo(xw.x), bfhi(xw.x), bflo(xw.y), bfhi(xw.y)}, x1 = {bflo(xw.z), bfhi(xw.z), bflo(xw.w), bfhi(xw.w)};
            v[j][0] = x0 + g0 * m0; v[j][1] = x1 + g1 * m1;
#pragma unroll
            for (int q = 0; q < 2; ++q) s += (v[j][q].x * v[j][q].x + v[j][q].y * v[j][q].y) + (v[j][q].z * v[j][q].z + v[j][q].w * v[j][q].w); }
        const float rstd = rsqrtf(wave_sum(s) * (1.f / D) + EPS);
#pragma unroll
        for (int j = 0; j < 2; ++j) { const int col = 8 * l + 512 * j;
            *(f32x4*)(X.out + (size_t)t * D + col) = v[j][0] * rstd * *(const f32x4*)(X.g_final + col); *(f32x4*)(X.out + (size_t)t * D + col + 4) = v[j][1] * rstd * *(const f32x4*)(X.g_final + col + 4); }
    }
}

__device__ __forceinline__ unsigned* panel_word(Ctx& X, int bank, int pm) { return WSP(unsigned, WS_CTL) + CW_PANEL + (bank * 64 + pm) * 64; }
__device__ __forceinline__ void panel_signal(Ctx& X, int bank, int pm) {
    asm volatile("s_waitcnt vmcnt(0)" ::: "memory"); __syncthreads();
    if (X.tid == 0) (void)xb_add(panel_word(X, bank, pm), 1u);
}
__device__ __forceinline__ void panel_wait(Ctx& X, int bank, int pm, unsigned target) {
    if (X.tid == 0) { unsigned* p = panel_word(X, bank, pm); unsigned sp = 0u;
        while (xb_ld(p) < target) { __builtin_amdgcn_s_sleep(2); if (++sp > (1u << 22)) break; }
        __builtin_amdgcn_fence(__ATOMIC_ACQUIRE, "agent"); asm volatile("s_waitcnt vmcnt(0)" ::: "memory"); }
    __syncthreads();
}

constexpr int NG_INPROJ = 176;
__device__ __forceinline__ void ph_inproj(Ctx& X) {
    const int ng = X.G > NG_INPROJ + 8 ? NG_INPROJ : X.G;
    if (X.wg < ng) {
        RegSched S{(const char*)WSP(bf16_t, WS_H), (const char*)WSP(bf16_t, WS_WIN), (size_t)256 * 2048, (size_t)256 * 2048, T / 256, INW / 256, ng, X.wg};
        EpiInproj E{WSP(bf16_t, WS_PROJ), WSP(float, WS_LOGF), WSP(float, WS_LB), WSP(float, WS_ROPE), WSP(unsigned char, WS_G8), WSP(unsigned char, WS_QK8)};
        pg8::gemm_phase<EpiInproj, RegSched, true, false>(X.lds, 1024, 1024, 1024, S, E);
    }
    if (ng == X.G) expert_convert(X, X.wg, X.G);
    else if (X.wg >= ng) expert_convert(X, X.wg - ng, X.G - ng);
}
__device__ __forceinline__ void ph_mix_a(Ctx& X) {
    for (int it = X.wg; it < 256; it += X.G) hgrn_kv_unit(X, it);
    AttnRegs R; int unit = X.wg; long qf[4];
    if (unit < 1536) attn_load(X, unit, R);
    while (unit < 1536) {
        attn_stage(X, R);
#pragma unroll
        for (int ds = 0; ds < 4; ++ds) qf[ds] = R.q[ds];
        __syncthreads();
        const int nu = unit + X.G;
        if (nu < 1536) attn_load(X, nu, R);
        attn_compute(X, unit, qf);
        __syncthreads();
        unit = nu;
    }
}
__device__ __forceinline__ void ph_mix_c(Ctx& X) { for (int it = X.wg; it < 512; it += X.G) hgrn_out_unit(X, it); attn_combine(X); }
__device__ __forceinline__ void ph_mixed(Ctx& X, bool chain) {
    TwoPartSched S{(const char*)WSP(bf16_t, WS_YCAT), (const char*)WSP(bf16_t, WS_WPA), (const char*)WSP(bf16_t, WS_WPB), T / 256, D / 256, X.G, X.wg};
    EpiMixed E{WSP(unsigned char, WS_G8), WSP(bf16_t, WS_MIXED)};
    pg8::gemm_phase<EpiMixed, TwoPartSched, false, false>(X.lds, 1024, 512, 512, S, E);
    if (chain) { int pm, pn; pg8::swz_tile(X.wg, T / 256, D / 256, pm, pn); panel_signal(X, 0, pm); }
}
__device__ __forceinline__ void ph_outproj(Ctx& X, bool chain) {
    int pm = 0, pn = 0; pg8::swz_tile(X.wg < 256 ? X.wg : 0, T / 256, D / 256, pm, pn);
    RegSched S{(const char*)WSP(bf16_t, WS_MIXED), (const char*)WSP(bf16_t, WS_WOUT), (size_t)256 * 2048, (size_t)256 * 2048, T / 256, D / 256, X.G, X.wg};
    if (chain) {
        panel_wait(X, 0, pm, 4u);
        EpiOutNorm E{X.x, WSP(float, WS_MOD), X.g2, WSP(bf16_t, WS_X1), WSP(bf16_t, WS_H), WSP(unsigned char, WS_H8), WSP(float, WS_XB), panel_word(X, 1, 0), X.lds + 139264};
        pg8::gemm_phase<EpiOutNorm, RegSched, true, false>(X.lds, 1024, 1024, 1024, S, E);
        panel_signal(X, 2, pm);
    } else {
        EpiOutproj E{X.x, WSP(float, WS_MOD), WSP(bf16_t, WS_X1)};
        pg8::gemm_phase<EpiOutproj, RegSched, false, false>(X.lds, 1024, 1024, 1024, S, E);
    }
}
__device__ __forceinline__ void ph_norm2(Ctx& X, bool chain) { if (!chain) norm_rows(X, 1); }
__device__ __forceinline__ void ph_router(Ctx& X, bool chain) {
    if (chain) panel_wait(X, 2, X.wg >> 2, 4u);
    RouterSched S{(const char*)WSP(bf16_t, WS_H), (const char*)WSP(bf16_t, WS_WR), X.G, X.wg};
    EpiRouter E{WSP(float, WS_KVT)};
    pg8::gemm_phase<EpiRouter, RouterSched, false, false>(X.lds, 1024, 1024, 256, S, E);
    if (chain) panel_signal(X, 3, X.wg >> 2);
}
__device__ __forceinline__ void ph_route(Ctx& X, bool chain) {
    if (chain) panel_wait(X, 3, X.wg >> 2, 4u);
    moe_route(X, chain);
}
__device__ __forceinline__ void ph_gu(Ctx& X) {
    const int nent = moe_table(X);
    MoeSched S{(const LAS int*)(X.lds + TBL_OFF), (const LAS int*)(X.lds + TCNT_OFF), nent, (const char*)WSP(unsigned char, WS_H8), (const char*)WSP(unsigned char, WS_WGU), WSP(int, WS_LISTS), 2, 256 * 1024, 512 * 1024, 0, X.G, X.wg};
    EpiGU E{WSP(unsigned char, WS_ACT)};
    pg8::gemm_phase<EpiGU, MoeSched, true, true, true>(X.lds, 512, 512, 512, S, E);
}
__device__ __forceinline__ void ph_down(Ctx& X) {
    const int nent = moe_table(X);
    MoeSched S{(const LAS int*)(X.lds + TBL_OFF), (const LAS int*)(X.lds + TCNT_OFF), nent, (const char*)WSP(unsigned char, WS_ACT), (const char*)WSP(unsigned char, WS_WD), WSP(int, WS_LISTS), 4, 256 * 256, 1024 * 256, 256 * 256, X.G, X.wg};
    EpiDown E{WSP(unsigned char, WS_YBUF), WSP(float, WS_GATEW)};
    pg8::gemm_phase<EpiDown, MoeSched, true, false, true>(X.lds, 128, 128, 128, S, E);
}

constexpr int NPHASE = 14;
struct Args { const void* in[20]; float* out; unsigned char* ws; int ph_lo, ph_hi; };
__global__ void __launch_bounds__(NTHREADS, 2) mega_fwd(Args args) {
    extern __shared__ __attribute__((aligned(16))) unsigned char lds_raw[];
    Ctx X;
    X.lds = (LAS unsigned char*)lds_raw;
    X.tid = threadIdx.x; X.lane = X.tid & 63; X.wave = __builtin_amdgcn_readfirstlane(X.tid >> 6); X.wg = blockIdx.x; X.G = gridDim.x;
    X.x = (const float*)args.in[0]; X.c = (const float*)args.in[1]; X.positions = (const int*)args.in[2]; X.w_ada = (const float*)args.in[3]; X.b_ada = (const float*)args.in[4];
    X.g1 = (const float*)args.in[5]; X.w_in = (const float*)args.in[6]; X.lb_logits = (const float*)args.in[7]; X.g_hgrn = (const float*)args.in[8]; X.w_pa = (const float*)args.in[9];
    X.w_pb = (const float*)args.in[10]; X.w_out = (const float*)args.in[11]; X.g2 = (const float*)args.in[12]; X.w_router = (const float*)args.in[13]; X.rbias = (const float*)args.in[14];
    X.w_egu = (const float*)args.in[15]; X.w_edown = (const float*)args.in[16]; X.w_sgu = (const float*)args.in[17]; X.w_sdown = (const float*)args.in[18]; X.g_final = (const float*)args.in[19];
    X.out = args.out; X.ws = args.ws;
    volatile LAS unsigned* MISC = (volatile LAS unsigned*)(X.lds + MISC_OFF);
    if (X.tid < 32) MISC[X.tid] = 0u;
    __syncthreads();
    const int lo = args.ph_lo, hi = args.ph_hi;
    XcdBarrier bar; bar.bar = WSP(unsigned, WS_CTL) + CW_BAR; bar.x = 0; bar.st = nullptr;
    if (hi - lo > 1) bar = xcd_barrier_post(WSP(unsigned, WS_CTL) + CW_BAR, MISC + 8);
#ifndef PH_MASK
#define PH_MASK 0xffffffffu
#endif
#define IN(k) ((((PH_MASK) >> (k)) & 1u) && lo <= (k) && (k) < hi)
#ifndef REPEAT_MASK
#define REPEAT_MASK 0u
#endif
#define SEAM(k) do { if (IN(k) && IN((k) + 1)) xcd_barrier(bar); } while (0)
#define RUN(k, call) do { if (IN(k)) { call; if (((REPEAT_MASK) >> (k)) & 1u) { xcd_barrier(bar); call; } } } while (0)

    RUN(0, p0_prologue(X)); SEAM(0);
    RUN(1, { small_transposes(X); norm_rows(X, 0); }); SEAM(1);
    RUN(2, ph_inproj(X)); SEAM(2);
    RUN(3, ph_mix_a(X)); SEAM(3);
    RUN(4, hgrn_passB(X)); SEAM(4);
    RUN(5, ph_mix_c(X)); SEAM(5);
    const bool chain = (X.G == 256);
    RUN(6, ph_mixed(X, chain)); if (!chain) SEAM(6);
    RUN(7, ph_outproj(X, chain)); if (!chain) SEAM(7);
    RUN(8, ph_norm2(X, chain)); if (!chain) SEAM(8);
    RUN(9, ph_router(X, chain)); if (!chain) SEAM(9);
    RUN(10, ph_route(X, chain)); SEAM(10);
    RUN(11, ph_gu(X)); SEAM(11);
    RUN(12, ph_down(X)); SEAM(12);
    RUN(13, final_rows(X));
#undef IN
#undef SEAM
}

extern "C" void kernel_launch(void* const* d_in, const int* in_sizes, int n_in, void* d_out, int out_size, void* d_ws, size_t ws_size, hipStream_t stream) {
    static int grid = 0;
    if (grid == 0) {
        if (n_in != 20 || out_size != T * D || ws_size < WS_END) { fprintf(stderr, "kernel_launch: unexpected shapes (n_in %d, out %d, ws %zu); nothing launched\n", n_in, out_size, ws_size); grid = -1; return; }
        int dev = 0, cus = 0, per_cu = 0;
        if (hipGetDevice(&dev) != hipSuccess || hipDeviceGetAttribute(&cus, hipDeviceAttributeMultiprocessorCount, dev) != hipSuccess) { grid = -1; return; }
        if (hipFuncSetAttribute((const void*)mega_fwd, hipFuncAttributeMaxDynamicSharedMemorySize, LDS_BYTES) != hipSuccess) { fprintf(stderr, "kernel_launch: hipFuncSetAttribute failed\n"); grid = -1; return; }
        if (hipOccupancyMaxActiveBlocksPerMultiprocessor(&per_cu, (const void*)mega_fwd, NTHREADS, LDS_BYTES) != hipSuccess || per_cu < 1) { fprintf(stderr, "kernel_launch: occupancy query says %d blocks/CU; nothing launched\n", per_cu); (void)hipGetLastError(); grid = -1; return; }
        grid = cus;
        if (T % grid != 0 || 24576 % grid != 0 || grid % 8 != 0) { fprintf(stderr, "kernel_launch: grid %d does not divide the row count; nothing launched\n", grid); grid = -1; return; }
    }
    if (grid < 0) return;
    (void)hipMemsetAsync((char*)d_ws + WS_CTL, 0, CTL_ZERO_BYTES, stream);
    Args a{};
    for (int i = 0; i < 20; ++i) a.in[i] = d_in[i];
    a.out = (float*)d_out; a.ws = (unsigned char*)d_ws;
#if MK_PER_PHASE
    for (int p = 0; p < NPHASE; ++p) { a.ph_lo = p; a.ph_hi = p + 1; hipLaunchKernelGGL(mega_fwd, dim3(grid), dim3(NTHREADS), LDS_BYTES, stream, a); }
#else
    a.ph_lo = 0; a.ph_hi = NPHASE;
    hipLaunchKernelGGL(mega_fwd, dim3(grid), dim3(NTHREADS), LDS_BYTES, stream, a);
#endif
}
```

```cpp
#include <hip/hip_runtime.h>
#include <cstdio>
#include <cstdint>

#ifndef MK_PER_PHASE
#define MK_PER_PHASE 0
#endif

#define GAS __attribute__((address_space(1)))
#define LAS __attribute__((address_space(3)))
typedef unsigned short bf16_t;
typedef short bf16x8 __attribute__((ext_vector_type(8)));
typedef short s16x4 __attribute__((ext_vector_type(4)));
typedef float f32x4 __attribute__((ext_vector_type(4)));
typedef float f32x2 __attribute__((ext_vector_type(2)));
typedef float f32x16 __attribute__((ext_vector_type(16)));
typedef unsigned u32x4 __attribute__((ext_vector_type(4)));
typedef unsigned u32x2 __attribute__((ext_vector_type(2)));
typedef long l64x2 __attribute__((ext_vector_type(2)));

constexpr int NB = 4, SEQ = 4096, T = NB * SEQ, D = 1024, INW = 8704;
constexpr int C_HQ = 0, C_HK = 512, C_HV = 1024, C_HG = 1536, C_AQ = 2048, C_AK = 3584, C_AV = 5120, C_GA = 6656, C_GB = 7680;
constexpr int NE = 256, NEX = 257, TOPK = 8, NSLOT = 9, EFF = 256;
constexpr float EPS = 1e-6f;
constexpr float WGU_SCALE = 64.0f, WD_SCALE = 32.0f;
constexpr float YSCALE = 16.0f;
constexpr int NWAVES = 8, NTHREADS = 512;

constexpr size_t MiB = 1u << 20;
constexpr size_t WS_CTL = 0, CTL_ZERO_BYTES = 1 * MiB;
constexpr size_t WS_MODP = 2 * MiB;
constexpr size_t WS_MOD = 4 * MiB;
constexpr size_t WS_LB = 4 * MiB + 128 * 1024;
constexpr size_t WS_XB = 4 * MiB + 256 * 1024;
constexpr size_t WS_ROPE = 5 * MiB;
constexpr size_t WS_DECAY = 6 * MiB;
constexpr size_t WS_GATEW = 7 * MiB;
constexpr size_t WS_LISTS = 16 * MiB;
constexpr size_t WS_WIN = 34 * MiB;
constexpr size_t WS_WPA = 51 * MiB, WS_WPB = 52 * MiB, WS_WOUT = 53 * MiB, WS_WR = 55 * MiB;
constexpr size_t WS_H = 56 * MiB;
constexpr size_t WS_LOGF = 88 * MiB;
constexpr size_t WS_H8 = 120 * MiB;
constexpr size_t WS_MIXED = 136 * MiB;
constexpr size_t WS_YCAT = 168 * MiB;
constexpr size_t WS_X1 = 200 * MiB;
constexpr size_t WS_G8 = 232 * MiB;
constexpr size_t WS_OG = 264 * MiB;
constexpr size_t WS_LSE = 312 * MiB;
constexpr size_t WS_KVT = 314 * MiB;
constexpr size_t WS_SPT = 378 * MiB;
constexpr size_t WS_PROJ = 410 * MiB;
constexpr size_t WS_WGU = 682 * MiB;
constexpr size_t WS_QK8 = 820 * MiB;
constexpr size_t WS_WD = 939 * MiB;
constexpr size_t WS_ACT = 1068 * MiB;
constexpr size_t WS_YBUF = 1172 * MiB;
constexpr size_t WS_END = 1460 * MiB;
constexpr int CW_BAR = 4096;
constexpr int CW_PANEL = 65536;
constexpr int CW_CNT = 16384;

constexpr int RING_BYTES = 131072;
constexpr int TBL_OFF = RING_BYTES;
constexpr int TCNT_OFF = TBL_OFF + 4096;
constexpr int MISC_OFF = TCNT_OFF + 2560;
constexpr int LDS_BYTES = 147456;

#define LDS_WAIT() asm volatile("s_waitcnt lgkmcnt(0)" ::: "memory")
#define VM_WAIT() asm volatile("s_waitcnt vmcnt(0)" ::: "memory")
__device__ __forceinline__ unsigned f2bf(float f) { unsigned u = __builtin_bit_cast(unsigned, f); return (u + 0x7fffu + ((u >> 16) & 1u)) >> 16; }
__device__ __forceinline__ float bf2f(unsigned b) { return __builtin_bit_cast(float, b << 16); }
__device__ __forceinline__ unsigned pk2(float lo, float hi) { return f2bf(lo) | (f2bf(hi) << 16); }
__device__ __forceinline__ float bflo(unsigned w) { return __builtin_bit_cast(float, w << 16); }
__device__ __forceinline__ float bfhi(unsigned w) { return __builtin_bit_cast(float, w & 0xffff0000u); }
__device__ __forceinline__ float sigmoidf_(float x) { return 1.0f / (1.0f + __expf(-x)); }
__device__ __forceinline__ float wave_sum(float v) {
#pragma unroll
    for (int o = 1; o < 64; o <<= 1) v += __shfl_xor(v, o);
    return v;
}

__device__ __forceinline__ float clamp_e4m3(float x) { return __builtin_amdgcn_fmed3f(x, -448.0f, 448.0f); }
__device__ __forceinline__ unsigned pk4_fp8(float a, float b, float c, float d) { int w = 0; w = __builtin_amdgcn_cvt_pk_fp8_f32(clamp_e4m3(a), clamp_e4m3(b), w, false); w = __builtin_amdgcn_cvt_pk_fp8_f32(clamp_e4m3(c), clamp_e4m3(d), w, true); return (unsigned)w; }
__device__ __forceinline__ void st_wt8(void* p, unsigned long long v) { __hip_atomic_store((unsigned long long*)p, v, __ATOMIC_RELAXED, __HIP_MEMORY_SCOPE_AGENT); }
__device__ __forceinline__ void st_wt16(void* p, u32x4 v) { asm volatile("global_store_dwordx4 %0, %1, off sc1\n\ts_nop 1" :: "v"(p), "v"(v) : "memory"); }
__device__ __forceinline__ void st_wt4(void* p, unsigned v) { __hip_atomic_store((unsigned*)p, v, __ATOMIC_RELAXED, __HIP_MEMORY_SCOPE_AGENT); }
namespace pg8 {
constexpr int BM = 256, BK = 64, HALF = 128, HTB = HALF * BK * 2, STAGE_BYTES = 8 * HTB, NXCD = 8, WGM = 8;
__host__ __device__ __forceinline__ int lds_byte(int r, int c) { const int st = (r >> 4) * 2 + (c >> 5), rr = r & 15, cc = c & 31, ob = rr * 64 + cc * 2; return st * 1024 + (ob ^ (((ob >> 9) & 1) << 5)); }
__host__ __device__ __forceinline__ void stage_rc(int b, int& R, int& C) { const int st = b / 1024, sb = b % 1024, swz = sb ^ (((sb >> 9) & 1) << 5); R = (st >> 1) * 16 + swz / 64; C = (st & 1) * 32 + (swz % 64) / 2; }
__host__ __device__ __forceinline__ int perm32(int rho) { const int n = rho >> 4, i = rho & 15; return 8 * (i >> 2) + 4 * n + (i & 3); }

struct Unit { const char* a; const char* b; const int* rows; int pm, pn, aux, nvalid; };

__device__ __forceinline__ void swz_tile(int L, int nM, int nN, int& pm, int& pn) {
    const int nwg = nM * nN; int wgid = L;
    { const int q = nwg / NXCD, r = nwg % NXCD, xcd = wgid % NXCD, off = wgid / NXCD; wgid = (xcd < r ? xcd * (q + 1) : r * (q + 1) + (xcd - r) * q) + off; }
    const int nig = WGM * nN, gid = wgid / nig, fm = gid * WGM, gsz = (nM - fm) < WGM ? (nM - fm) : WGM;
    pm = fm + ((wgid % nig) % gsz); pn = (wgid % nig) / gsz;
}

__device__ __forceinline__ unsigned cvt_pk_bf16(float lo, float hi) { unsigned r; asm volatile("v_cvt_pk_bf16_f32 %0, %1, %2" : "=v"(r) : "v"(lo), "v"(hi)); return r; }

template <bool GATHER>
__device__ __forceinline__ void gather_offs(const Unit& u, int tid, int lda, unsigned (&v)[2][2]) {
    if constexpr (GATHER) {
#pragma unroll
        for (int i = 0; i < 2; ++i) { int R, C; stage_rc(tid * 16 + i * 8192, R, C);
#pragma unroll
            for (int hh = 0; hh < 2; ++hh) { const int ri = hh * HALF + R; int slot = 0; if (ri < u.nvalid) slot = u.rows[ri];
                const unsigned tok = (unsigned)slot / 9u; v[hh][i] = (tok * (unsigned)lda + (unsigned)C) * 2u; } }
    }
}

template <class Epi, class Sched, bool ALIGN_EPI, bool GATHER, bool FP8 = false>
__device__ __forceinline__ void gemm_phase(LAS unsigned char* lds, const int lda, const int ldb, const int K, const Sched& S, const Epi& E) {
    const int tid = threadIdx.x, wid = __builtin_amdgcn_readfirstlane(tid >> 6), lane = tid & 63, wr = wid >> 2, wc = wid & 3, fr = lane & 15, fq = lane >> 4;
    const int nt = K / BK;
    unsigned voffA[2], voffB[2];
#pragma unroll
    for (int i = 0; i < 2; ++i) { int R, C; stage_rc(tid * 16 + i * 8192, R, C); const int Rb = Epi::PERM ? ((R & ~31) + perm32(R & 31)) : R;
        voffA[i] = (unsigned)(R * lda + C) * 2u; voffB[i] = (unsigned)(Rb * ldb + C) * 2u; }
    const size_t kstep = (size_t)(BK * 2);
    const size_t hstepA = GATHER ? 0 : (size_t)HALF * lda * 2, hstepB = (size_t)HALF * ldb * 2;
    const unsigned ldsw = (unsigned)wid * 1024u;
    const int aoff = lds_byte(wr * 64 + fr, fq * 8), boff = lds_byte(wc * 32 + fr, fq * 8);
#define PG8_SA(b, h) (((b) * 2 + (h)) * HTB)
#define PG8_SB(b, h) ((4 + (b) * 2 + (h)) * HTB)
#define PG8_STAGE(bufoff, gbase, voff) do { _Pragma("unroll") for (int _i = 0; _i < 2; ++_i) \
        __builtin_amdgcn_global_load_lds((const unsigned*)((const char*)(gbase) + (voff)[_i]), (LAS unsigned*)(lds + (bufoff) + ldsw + _i * 8192), 16, 0, 0); } while (0)
#define PG8_STAGE_A(bufoff, gb, hh, nx) do { if constexpr (GATHER) { unsigned _v[2]; _v[0] = (nx) ? vn[hh][0] : vc[hh][0]; _v[1] = (nx) ? vn[hh][1] : vc[hh][1]; PG8_STAGE(bufoff, gb, _v); } \
        else { PG8_STAGE(bufoff, (gb) + (hh) * hstepA, voffA); } } while (0)
#define PG8_LDA(dst, b, h) do { _Pragma("unroll") for (int m = 0; m < 4; ++m) _Pragma("unroll") for (int k = 0; k < 2; ++k) dst[m][k] = *(const LAS bf16x8*)(lds + PG8_SA(b, h) + aoff + m * 2048 + k * 1024); } while (0)
#define PG8_LDB(dst, b, h) do { _Pragma("unroll") for (int n = 0; n < 2; ++n) _Pragma("unroll") for (int k = 0; k < 2; ++k) dst[n][k] = *(const LAS bf16x8*)(lds + PG8_SB(b, h) + boff + n * 2048 + k * 1024); } while (0)
#define PG8_MMA(ai, bj, At, Bt) do { __builtin_amdgcn_s_setprio(1); _Pragma("unroll") for (int m = 0; m < 4; ++m) _Pragma("unroll") for (int n = 0; n < 2; ++n) _Pragma("unroll") for (int k = 0; k < 2; ++k) { \
        if constexpr (FP8) { const l64x2 _b = __builtin_bit_cast(l64x2, Bt[n][k]), _a = __builtin_bit_cast(l64x2, At[m][k]); \
            acc[ai][bj][m][n] = __builtin_amdgcn_mfma_f32_16x16x32_fp8_fp8(_b[0], _a[0], acc[ai][bj][m][n], 0, 0, 0); acc[ai][bj][m][n] = __builtin_amdgcn_mfma_f32_16x16x32_fp8_fp8(_b[1], _a[1], acc[ai][bj][m][n], 0, 0, 0); } \
        else acc[ai][bj][m][n] = __builtin_amdgcn_mfma_f32_16x16x32_bf16(Bt[n][k], At[m][k], acc[ai][bj][m][n], 0, 0, 0); } __builtin_amdgcn_s_setprio(0); } while (0)
#define PG8_WAIT_V(n) asm volatile("s_waitcnt vmcnt(" #n ")" ::: "memory")
#define PG8_WAIT_L(n) asm volatile("s_waitcnt lgkmcnt(" #n ")" ::: "memory")
#define PG8_BAR __builtin_amdgcn_s_barrier()
#define PG8_SCHED __builtin_amdgcn_sched_barrier(0)
    Unit cur, nxt; int ui = 0;
    if (!S.next(0, cur)) return;
    unsigned vc[2][2] = {{0u, 0u}, {0u, 0u}}, vn[2][2] = {{0u, 0u}, {0u, 0u}};
    gather_offs<GATHER>(cur, tid, lda, vc);
    f32x4 acc[2][2][4][2];
#pragma unroll
    for (int a = 0; a < 2; ++a)
#pragma unroll
        for (int b = 0; b < 2; ++b)
#pragma unroll
            for (int m = 0; m < 4; ++m)
#pragma unroll
                for (int n = 0; n < 2; ++n) acc[a][b][m][n] = (f32x4){0.f, 0.f, 0.f, 0.f};
    bf16x8 At[4][2], B0[2][2], B1[2][2];
    const char* cA = cur.a; const char* cB = cur.b;
    PG8_STAGE(PG8_SB(0, 0), cB, voffB); PG8_STAGE(PG8_SB(0, 1), cB + hstepB, voffB); PG8_STAGE_A(PG8_SA(0, 0), cA, 0, false); PG8_STAGE_A(PG8_SA(0, 1), cA, 1, false);
    if (wr == 1) PG8_BAR;
    PG8_WAIT_V(2); PG8_BAR;
    PG8_STAGE(PG8_SB(1, 0), cB + kstep, voffB); PG8_STAGE_A(PG8_SA(1, 0), cA + kstep, 0, false); PG8_STAGE(PG8_SB(1, 1), cB + hstepB + kstep, voffB);
    PG8_WAIT_V(6); PG8_BAR;
    for (;;) {
        const bool has_next = S.next(ui + 1, nxt);
        if (has_next) gather_offs<GATHER>(nxt, tid, lda, vn);
        const char* nA = has_next ? nxt.a : cA; const char* nB = has_next ? nxt.b : cB;
        const bool do0 = !Sched::HALFSKIP || cur.nvalid > 64 * wr, do1 = !Sched::HALFSKIP || cur.nvalid > 128 + 64 * wr;
        for (int t = 0; t < nt; t += 2) {
            const bool last = (t == nt - 2);
            const bool lnx = last && has_next;
            const char* a1 = cA + (size_t)(t + 1) * kstep;
            const char* a2 = last ? nA : cA + (size_t)(t + 2) * kstep; const char* b2 = last ? nB : cB + (size_t)(t + 2) * kstep;
            const char* a3 = a2 + kstep; const char* b3 = b2 + kstep;
            PG8_LDB(B0, 0, 0); PG8_LDB(B1, 0, 1); PG8_SCHED; PG8_LDA(At, 0, 0); PG8_STAGE_A(PG8_SA(1, 1), a1, 1, false);
            PG8_WAIT_V(8); PG8_WAIT_L(0); PG8_BAR; if (do0) { PG8_MMA(0, 0, At, B0); PG8_MMA(0, 1, At, B1); } PG8_BAR; PG8_SCHED;
            PG8_LDA(At, 0, 1); PG8_STAGE(PG8_SB(0, 0), b2, voffB); PG8_STAGE(PG8_SB(0, 1), b2 + hstepB, voffB); PG8_STAGE_A(PG8_SA(0, 0), a2, 0, lnx);
            PG8_WAIT_V(8); PG8_WAIT_L(0); PG8_BAR; if (do1) { PG8_MMA(1, 0, At, B0); PG8_MMA(1, 1, At, B1); } PG8_BAR; PG8_SCHED;
            PG8_LDB(B0, 1, 0); PG8_LDB(B1, 1, 1); PG8_SCHED; PG8_LDA(At, 1, 0); PG8_STAGE_A(PG8_SA(0, 1), a2, 1, lnx);
            PG8_WAIT_V(8); PG8_WAIT_L(0); PG8_BAR; if (do0) { PG8_MMA(0, 0, At, B0); PG8_MMA(0, 1, At, B1); } PG8_BAR; PG8_SCHED;
            PG8_LDA(At, 1, 1); PG8_STAGE(PG8_SB(1, 0), b3, voffB); PG8_STAGE(PG8_SB(1, 1), b3 + hstepB, voffB); PG8_STAGE_A(PG8_SA(1, 0), a3, 0, lnx);
            PG8_WAIT_V(8); PG8_WAIT_L(0); PG8_BAR; if (do1) { PG8_MMA(1, 0, At, B0); PG8_MMA(1, 1, At, B1); } PG8_BAR; PG8_SCHED;
        }
        if constexpr (ALIGN_EPI) { if (wr == 0) PG8_BAR; }
        E(acc, cur, wr, wc, fr, fq);
        __builtin_amdgcn_s_waitcnt(0x0F70);
        if (!has_next) break;
        if (!E.keep(cur)) {
#pragma unroll
            for (int a = 0; a < 2; ++a)
#pragma unroll
                for (int b = 0; b < 2; ++b)
#pragma unroll
                    for (int m = 0; m < 4; ++m)
#pragma unroll
                        for (int n = 0; n < 2; ++n) acc[a][b][m][n] = (f32x4){0.f, 0.f, 0.f, 0.f};
        }
        cur = nxt; cA = nA; cB = nB; ++ui;
        if constexpr (GATHER) {
#pragma unroll
            for (int hh = 0; hh < 2; ++hh) { vc[hh][0] = vn[hh][0]; vc[hh][1] = vn[hh][1]; }
        }
        if constexpr (ALIGN_EPI) { if (wr == 1) PG8_BAR; }
    }
    PG8_WAIT_V(0);
    if constexpr (!ALIGN_EPI) { if (wr == 0) PG8_BAR; }
    PG8_BAR;
#undef PG8_SA
#undef PG8_SB
#undef PG8_STAGE
#undef PG8_STAGE_A
#undef PG8_LDA
#undef PG8_LDB
#undef PG8_MMA
#undef PG8_WAIT_V
#undef PG8_WAIT_L
#undef PG8_BAR
#undef PG8_SCHED
}
}

#define XB_TMO      128
#define XB_XCNT(j)  (256  + 64 * (j))
#define XB_XSUB(j)  (1280 + 64 * (j))
#define XB_XGEN(j)  (2304 + 64 * (j))
#define XB_TOP      3328
#define XB_TOPGEN   3392
#define XCD_BAR_WORDS 3456
#define XB_SPIN_CAP (1u << 20)
__device__ __forceinline__ unsigned xb_ld(unsigned* p)              { return __hip_atomic_load(p, __ATOMIC_RELAXED, __HIP_MEMORY_SCOPE_AGENT); }
__device__ __forceinline__ unsigned xb_add(unsigned* p, unsigned v) { return __hip_atomic_fetch_add(p, v, __ATOMIC_RELAXED, __HIP_MEMORY_SCOPE_AGENT); }
__device__ __forceinline__ unsigned xb_xcc_id() { return (unsigned)__builtin_amdgcn_s_getreg((3 << 11) | 20) & 0xFu; }
#define XB_SPIN(cond, bar) do { unsigned _sp = 0; while (cond) { __builtin_amdgcn_s_sleep(1); \
    if ((++_sp & 255u) == 0u) { if (xb_ld(&(bar)[XB_TMO])) break; if (_sp > XB_SPIN_CAP) { atomicAdd(&(bar)[XB_TMO], 1u); break; } } } } while (0)
struct XcdBarrier { unsigned* bar; unsigned x; volatile LAS unsigned* st; };
__device__ __forceinline__ XcdBarrier xcd_barrier_post(unsigned* bar, volatile LAS unsigned* st) {
    XcdBarrier b; b.bar = bar; b.x = xb_xcc_id(); b.st = st;
    if (threadIdx.x == 0) (void)xb_add(&bar[XB_XCNT(b.x)], 1u);
    return b;
}
__device__ __forceinline__ void xcd_barrier_complete(unsigned* bar, unsigned x, unsigned& nloc, unsigned& nx) {
    const unsigned G = gridDim.x * gridDim.y * gridDim.z;
    unsigned sum, cnt, mine, sp = 0u;
    for (;;) {
        sum = 0u; cnt = 0u; mine = 0u;
#pragma unroll
        for (unsigned j = 0; j < 16; ++j) { const unsigned c = xb_ld(&bar[XB_XCNT(j)]); sum += c; cnt += (c > 0u) ? 1u : 0u; mine = (j == x) ? c : mine; }
        if (sum == G) break;
        __builtin_amdgcn_s_sleep(1);
        if ((++sp & 255u) == 0u) { if (xb_ld(&bar[XB_TMO])) break; if (sp > XB_SPIN_CAP) { atomicAdd(&bar[XB_TMO], 1u); break; } }
    }
    nloc = mine > 0u ? mine : 1u; nx = cnt > 0u ? cnt : 1u;
}
__device__ __forceinline__ void xcd_barrier(const XcdBarrier& b) {
    asm volatile("s_waitcnt vmcnt(0)" ::: "memory");
    __syncthreads();
    if (threadIdx.x == 0) {
        unsigned* bar = b.bar;
        __builtin_amdgcn_s_waitcnt(0);
        unsigned nloc = b.st[0], nx = b.st[1];
        if (nloc == 0u) { xcd_barrier_complete(bar, b.x, nloc, nx); b.st[0] = nloc; b.st[1] = nx; }
        const unsigned old = xb_add(&bar[XB_XSUB(b.x)], 1u);
        const unsigned gen = old / nloc;
        if (old + 1u == (gen + 1u) * nloc) {
            __builtin_amdgcn_fence(__ATOMIC_RELEASE, "agent");
            asm volatile("s_waitcnt vmcnt(0)" ::: "memory");
            const unsigned og = xb_add(&bar[XB_TOP], 1u);
            const unsigned tg = og / nx;
            if (og + 1u == (tg + 1u) * nx) xb_add(&bar[XB_TOPGEN], 1u);
            else XB_SPIN(xb_ld(&bar[XB_TOPGEN]) == tg, bar);
            __builtin_amdgcn_fence(__ATOMIC_ACQUIRE, "agent");
            asm volatile("s_waitcnt vmcnt(0)" ::: "memory");
        } else {
            XB_SPIN(xb_ld(&bar[XB_TOPGEN]) == gen, bar);
            __builtin_amdgcn_fence(__ATOMIC_ACQUIRE, "agent");
            asm volatile("s_waitcnt vmcnt(0)" ::: "memory");
        }
    }
    __syncthreads();
}

struct Ctx {
    LAS unsigned char* lds;
    int tid, lane, wave, wg, G;
    const float *x, *c, *w_ada, *b_ada, *g1, *w_in, *lb_logits, *g_hgrn, *w_pa, *w_pb, *w_out, *g2, *w_router, *rbias, *w_egu, *w_edown, *w_sgu, *w_sdown, *g_final;
    const int* positions;
    float* out;
    unsigned char* ws;
};
#define WSP(type, off) ((type*)(X.ws + (off)))

__device__ __forceinline__ void transpose_item(const float* W, int K, int N, bf16_t* WT, int dst_row0, int src_col0, int k0, LAS float* scr, int lane) {
#pragma unroll 16
    for (int i = 0; i < 32; ++i) { const int kk = 2 * i + (lane >> 5); scr[kk * 33 + (lane & 31)] = W[(size_t)(k0 + kk) * N + src_col0 + (lane & 31)]; }
    LDS_WAIT(); asm volatile("" ::: "memory");
    const int c = lane & 7;
#pragma unroll
    for (int j = 0; j < 4; ++j) { const int n = (lane >> 3) + 8 * j; const LAS float* s = scr + (8 * c) * 33 + n;
        u32x4 o; o.x = pk2(s[0 * 33], s[1 * 33]); o.y = pk2(s[2 * 33], s[3 * 33]); o.z = pk2(s[4 * 33], s[5 * 33]); o.w = pk2(s[6 * 33], s[7 * 33]);
        *(u32x4*)(WT + (size_t)(dst_row0 + n) * K + k0 + 8 * c) = o; }
    LDS_WAIT(); asm volatile("" ::: "memory");
}
__device__ __forceinline__ void transpose_plain(const float* W, int K, int N, bf16_t* WT, int item, LAS float* scr, int lane) {
    const int nblk = N / 32, kb = item / nblk, nb = item % nblk;
    transpose_item(W, K, N, WT, nb * 32, nb * 32, kb * 64, scr, lane);
}
__device__ __forceinline__ void p0_prologue(Ctx& X) {
    LAS float* scr = (LAS float*)(X.lds + X.wave * 16384);
    const int gw = X.wg * NWAVES + X.wave, NGW = X.G * NWAVES;
    {
        float* MODP = WSP(float, WS_MODP);
        for (int it = gw; it < 96 * 16; it += NGW) {
            const int jc = it % 96, kc = it / 96, j = jc * 64 + X.lane;
            float a0 = 0.f, a1 = 0.f, a2 = 0.f, a3 = 0.f;
#pragma unroll 16
            for (int kk = 0; kk < 64; ++kk) { const int k = kc * 64 + kk; const float w = X.w_ada[(size_t)k * 6144 + j];
                const float c0 = X.c[k], c1 = X.c[1024 + k], c2 = X.c[2048 + k], c3 = X.c[3072 + k];
                a0 += c0 * sigmoidf_(c0) * w; a1 += c1 * sigmoidf_(c1) * w; a2 += c2 * sigmoidf_(c2) * w; a3 += c3 * sigmoidf_(c3) * w; }
            float* o = MODP + (size_t)kc * 24576 + j;
            o[0] = a0; o[6144] = a1; o[12288] = a2; o[18432] = a3;
        }
    }
    {
        float* ROPE = WSP(float, WS_ROPE);
        const int gt = X.wg * NTHREADS + X.tid, NGT = X.G * NTHREADS;
        for (int idx = gt; idx < T * 8; idx += NGT) { const int t = idx >> 3, i = idx & 7;
            const float inv_freq = 1.0f / powf(500000.0f, (float)(2 * i) / 16.0f);
            const float ang = (float)X.positions[t] * inv_freq;
            ROPE[t * 16 + i] = cosf(ang); ROPE[t * 16 + 8 + i] = sinf(ang); }
        if (X.wg == 0) { float* LB = WSP(float, WS_LB);
            for (int j = X.tid; j < 512; j += NTHREADS) { const float l0 = X.lb_logits[j], l1 = X.lb_logits[512 + j], m = fmaxf(l0, l1), e0 = __expf(l0 - m), e1 = __expf(l1 - m); LB[j] = e0 / (e0 + e1); } }
    }
}
struct CvtItem { const float* src; bf16_t* dst; };
template <bool GU> __device__ __forceinline__ CvtItem cvt_item(const Ctx& X, int it) {
    CvtItem c;
    if constexpr (GU) { const int e = it >> 7, q = it & 127, w8 = q & 7, sq = q >> 3, kb = 4 * (sq >> 2) + (w8 & 3), nb = 2 * (sq & 3) + (w8 >> 2);
        const int n0 = nb * 64, pn = n0 >> 8, bj = (n0 >> 7) & 1, idx = n0 & 127, srcc = bj * 256 + pn * 128 + idx;
        const float* W = (e < NE) ? X.w_egu + (size_t)e * 1024 * 512 : X.w_sgu;
        c.src = W + (size_t)(kb * 64) * 512 + srcc; c.dst = (bf16_t*)(X.ws + WS_WGU + ((size_t)e * 512 + n0) * 1024 + kb * 64); }
    else { const int e = it >> 6, q = it & 63, w8 = q & 7, sq = q >> 3, kb = w8 & 3, nb = 2 * sq + (w8 >> 2);
        const float* W = (e < NE) ? X.w_edown + (size_t)e * 256 * 1024 : X.w_sdown;
        c.src = W + (size_t)(kb * 64) * 1024 + nb * 64; c.dst = (bf16_t*)(X.ws + WS_WD + ((size_t)e * 1024 + nb * 64) * 256 + kb * 64); }
    return c;
}
template <int KB> __device__ __forceinline__ void cvt_store8(const CvtItem& c, int lane, const f32x4 (&v)[16], LAS unsigned char* tl, float sc) {
    const int kq = lane >> 4, nq = lane & 15;
#pragma unroll
    for (int i = 0; i < 4; ++i) { u32x4 w;
        w.x = pk4_fp8(v[0][i] * sc, v[1][i] * sc, v[2][i] * sc, v[3][i] * sc); w.y = pk4_fp8(v[4][i] * sc, v[5][i] * sc, v[6][i] * sc, v[7][i] * sc);
        w.z = pk4_fp8(v[8][i] * sc, v[9][i] * sc, v[10][i] * sc, v[11][i] * sc); w.w = pk4_fp8(v[12][i] * sc, v[13][i] * sc, v[14][i] * sc, v[15][i] * sc);
        *(LAS u32x4*)(tl + (4 * nq + i) * 80 + kq * 16) = w; }
    LDS_WAIT(); asm volatile("" ::: "memory");
    const int ch = lane & 3, r = lane >> 2;
    unsigned char* d8 = (unsigned char*)c.dst;
#pragma unroll
    for (int j = 0; j < 4; ++j) { const int n = 16 * j + r; const u32x4 w = *(const LAS u32x4*)(tl + n * 80 + ch * 16); __builtin_nontemporal_store(w, (u32x4*)(d8 + (size_t)n * KB + 16 * ch)); }
    LDS_WAIT(); asm volatile("" ::: "memory");
}
template <int N> __device__ __forceinline__ void cvt_load(const CvtItem& c, int lane, f32x4 (&v)[16]) {
    const float* p = c.src + (size_t)(16 * (lane >> 4)) * N + 4 * (lane & 15);
#pragma unroll
    for (int j = 0; j < 16; ++j) v[j] = __builtin_nontemporal_load((const f32x4*)(p + (size_t)j * N));
}
template <int K> __device__ __forceinline__ void cvt_store(const CvtItem& c, int lane, const f32x4 (&v)[16], LAS unsigned char* tl) {
    const int kq = lane >> 4, nq = lane & 15;
#pragma unroll
    for (int i = 0; i < 4; ++i) { u32x4 w0, w1;
        w0.x = pk2(v[0][i], v[1][i]); w0.y = pk2(v[2][i], v[3][i]); w0.z = pk2(v[4][i], v[5][i]); w0.w = pk2(v[6][i], v[7][i]);
        w1.x = pk2(v[8][i], v[9][i]); w1.y = pk2(v[10][i], v[11][i]); w1.z = pk2(v[12][i], v[13][i]); w1.w = pk2(v[14][i], v[15][i]);
        LAS unsigned char* q = tl + (4 * nq + i) * 144 + kq * 32; *(LAS u32x4*)q = w0; *(LAS u32x4*)(q + 16) = w1; }
    LDS_WAIT(); asm volatile("" ::: "memory");
    const int ch = lane & 7, r = lane >> 3;
#pragma unroll
    for (int j = 0; j < 8; ++j) { const int n = 8 * j + r; const u32x4 w = *(const LAS u32x4*)(tl + n * 144 + ch * 16); __builtin_nontemporal_store(w, (u32x4*)(c.dst + (size_t)n * K + 8 * ch)); }
    LDS_WAIT(); asm volatile("" ::: "memory");
}
struct CvtPair { const float* src; unsigned char* dst; };
template <bool GU> __device__ __forceinline__ CvtPair cvt_pair(const Ctx& X, int di) {
    CvtPair c;
    if constexpr (GU) { const int e = di >> 6, q = di & 63, nb = q & 7, kb2 = q >> 3;
        const int n0 = nb * 64, pn = n0 >> 8, bj = (n0 >> 7) & 1, idx = n0 & 127, srcc = bj * 256 + pn * 128 + idx;
        const float* W = (e < NE) ? X.w_egu + (size_t)e * 1024 * 512 : X.w_sgu;
        c.src = W + (size_t)(kb2 * 128) * 512 + srcc; c.dst = X.ws + WS_WGU + ((size_t)e * 512 + n0) * 1024 + kb2 * 128; }
    else { const int e = di >> 5, q = di & 31, nb = q & 15, kb2 = q >> 4;
        const float* W = (e < NE) ? X.w_edown + (size_t)e * 256 * 1024 : X.w_sdown;
        c.src = W + (size_t)(kb2 * 128) * 1024 + nb * 64; c.dst = X.ws + WS_WD + ((size_t)e * 1024 + nb * 64) * 256 + kb2 * 128; }
    return c;
}
template <int N> __device__ __forceinline__ void cvt_load_half(const CvtPair& c, int half, int lane, f32x4 (&v)[16]) {
    const float* p = c.src + (size_t)(64 * half + 16 * (lane >> 4)) * N + 4 * (lane & 15);
#pragma unroll
    for (int j = 0; j < 16; ++j) v[j] = __builtin_nontemporal_load((const f32x4*)(p + (size_t)j * N));
}
__device__ __forceinline__ void cvt_half_to_lds(int half, int lane, const f32x4 (&v)[16], LAS unsigned char* tl, float sc) {
    const int kq = lane >> 4, nq = lane & 15;
#pragma unroll
    for (int i = 0; i < 4; ++i) { u32x4 w;
        w.x = pk4_fp8(v[0][i] * sc, v[1][i] * sc, v[2][i] * sc, v[3][i] * sc); w.y = pk4_fp8(v[4][i] * sc, v[5][i] * sc, v[6][i] * sc, v[7][i] * sc);
        w.z = pk4_fp8(v[8][i] * sc, v[9][i] * sc, v[10][i] * sc, v[11][i] * sc); w.w = pk4_fp8(v[12][i] * sc, v[13][i] * sc, v[14][i] * sc, v[15][i] * sc);
        *(LAS u32x4*)(tl + (4 * nq + i) * 144 + half * 64 + kq * 16) = w; }
}
template <int KB> __device__ __forceinline__ void cvt_flush(const CvtPair& c, int lane, LAS unsigned char* tl) {
    LDS_WAIT(); asm volatile("" ::: "memory");
    const int ch = lane & 7, r = lane >> 3;
#pragma unroll
    for (int j = 0; j < 8; ++j) { const int n = 8 * j + r; const u32x4 w = *(const LAS u32x4*)(tl + n * 144 + ch * 16); __builtin_nontemporal_store(w, (u32x4*)(c.dst + (size_t)n * KB + 16 * ch)); }
    LDS_WAIT(); asm volatile("" ::: "memory");
}
template <bool GU> __device__ __forceinline__ void expert_convert_set(Ctx& X, int gw, int NGW, LAS unsigned char* tl) {
    constexpr int NIT = GU ? NEX * 64 : NEX * 32, N = GU ? 512 : 1024, K = GU ? 1024 : 256; constexpr float SC = GU ? WGU_SCALE : WD_SCALE;
    if (gw >= NIT) return;
    const int nmine = (NIT - gw + NGW - 1) / NGW;
    f32x4 va[16], vb[16];
    CvtPair cur = cvt_pair<GU>(X, gw);
    cvt_load_half<N>(cur, 0, X.lane, va); cvt_load_half<N>(cur, 1, X.lane, vb);
    for (int j = 0; j < nmine; ++j) {
        const CvtPair nxt = cvt_pair<GU>(X, gw + (j + 1 < nmine ? j + 1 : j) * NGW);
        __builtin_amdgcn_sched_barrier(0);
        cvt_half_to_lds(0, X.lane, va, tl, SC);
        __builtin_amdgcn_sched_barrier(0);
        cvt_load_half<N>(nxt, 0, X.lane, va);
        __builtin_amdgcn_sched_barrier(0);
        cvt_half_to_lds(1, X.lane, vb, tl, SC);
        cvt_flush<K>(cur, X.lane, tl);
        __builtin_amdgcn_sched_barrier(0);
        cvt_load_half<N>(nxt, 1, X.lane, vb);
        __builtin_amdgcn_sched_barrier(0);
        cur = nxt;
    }
}
__device__ __forceinline__ void expert_convert(Ctx& X, int cw, int ncw) {
    LAS unsigned char* tl = X.lds + X.wave * 16384;
    const int gw = cw * NWAVES + X.wave, NGW = ncw * NWAVES;
    expert_convert_set<true>(X, gw, NGW, tl);
    expert_convert_set<false>(X, gw, NGW, tl);
}

__device__ __forceinline__ void small_transposes(Ctx& X) {
    LAS float* scr = (LAS float*)(X.lds + 16384 + X.wave * 12288);
    const int gw = X.wg * NWAVES + X.wave, NGW = X.G * NWAVES;
    {
        constexpr int I_IN = 16 * 272, I_PA = 8 * 32, I_PB = 8 * 32, I_OUT = 16 * 32, I_R = 16 * 8;
        constexpr int NITEMS = I_IN + I_PA + I_PB + I_OUT + I_R;
        for (int it = gw; it < NITEMS; it += NGW) {
            int r = it;
            if (r < I_IN) { transpose_plain(X.w_in, 1024, INW, WSP(bf16_t, WS_WIN), r, scr, X.lane); continue; } r -= I_IN;
            if (r < I_PA) { transpose_plain(X.w_pa, 512, 1024, WSP(bf16_t, WS_WPA), r, scr, X.lane); continue; } r -= I_PA;
            if (r < I_PB) { transpose_plain(X.w_pb, 512, 1024, WSP(bf16_t, WS_WPB), r, scr, X.lane); continue; } r -= I_PB;
            if (r < I_OUT) { transpose_plain(X.w_out, 1024, 1024, WSP(bf16_t, WS_WOUT), r, scr, X.lane); continue; } r -= I_OUT;
            transpose_plain(X.w_router, 1024, 256, WSP(bf16_t, WS_WR), r, scr, X.lane);
        }
    }
}

__device__ __forceinline__ void norm_rows(Ctx& X, int which) {
    LAS float* sm = (LAS float*)X.lds;
    const float* MODP = WSP(float, WS_MODP); float* MOD = WSP(float, WS_MOD);
    const int rows_per_wg = T / X.G, row0 = X.wg * rows_per_wg, b = row0 / SEQ;
    if (which == 0) {
        for (int i = X.tid; i < 2048; i += NTHREADS) { const int j = b * 6144 + i; float s = X.b_ada[i];
#pragma unroll
            for (int p = 0; p < 16; ++p) s += MODP[(size_t)p * 24576 + j];
            sm[i] = s; }
        const int per = 24576 / X.G;
        for (int i = X.tid; i < per; i += NTHREADS) { const int j = X.wg * per + i; float s = X.b_ada[j % 6144];
#pragma unroll
            for (int p = 0; p < 16; ++p) s += MODP[(size_t)p * 24576 + j];
            MOD[j] = s; }
    } else {
        for (int i = X.tid; i < 2048; i += NTHREADS) sm[i] = MOD[b * 6144 + 3072 + i];
    }
    __syncthreads();
    const float* src = X.x; const bf16_t* srcb = WSP(bf16_t, WS_X1); const float* g = which == 0 ? X.g1 : X.g2;
    bf16_t* H = WSP(bf16_t, WS_H);
    for (int r = X.wave; r < rows_per_wg; r += NWAVES) {
        const int row = row0 + r;
        f32x4 v[2][2]; float s = 0.f;
#pragma unroll
        for (int j = 0; j < 2; ++j) { const int col = 8 * X.lane + 512 * j;
            if (which == 0) { v[j][0] = *(const f32x4*)(src + (size_t)row * D + col); v[j][1] = *(const f32x4*)(src + (size_t)row * D + col + 4); }
            else { const u32x4 wv = *(const u32x4*)(srcb + (size_t)row * D + col); v[j][0] = (f32x4){bflo(wv.x), bfhi(wv.x), bflo(wv.y), bfhi(wv.y)}; v[j][1] = (f32x4){bflo(wv.z), bfhi(wv.z), bflo(wv.w), bfhi(wv.w)}; }
#pragma unroll
            for (int q = 0; q < 2; ++q) s += (v[j][q].x * v[j][q].x + v[j][q].y * v[j][q].y) + (v[j][q].z * v[j][q].z + v[j][q].w * v[j][q].w); }
        const float rstd = rsqrtf(wave_sum(s) * (1.f / D) + EPS);
#pragma unroll
        for (int j = 0; j < 2; ++j) { const int col = 8 * X.lane + 512 * j; float y[8];
#pragma unroll
            for (int q = 0; q < 2; ++q) { const f32x4 gg = *(const f32x4*)(g + col + 4 * q), sh = *(const LAS f32x4*)(sm + col + 4 * q), sc = *(const LAS f32x4*)(sm + 1024 + col + 4 * q);
#pragma unroll
                for (int e = 0; e < 4; ++e) y[4 * q + e] = v[j][q][e] * rstd * gg[e] * (1.f + sc[e]) + sh[e]; }
            u32x4 hw; hw.x = pk2(y[0], y[1]); hw.y = pk2(y[2], y[3]); hw.z = pk2(y[4], y[5]); hw.w = pk2(y[6], y[7]);
            if (which == 1) { st_wt16(H + (size_t)row * D + col, hw);
                st_wt8(WSP(unsigned char, WS_H8) + (size_t)row * D + col, (unsigned long long)pk4_fp8(y[0], y[1], y[2], y[3]) | ((unsigned long long)pk4_fp8(y[4], y[5], y[6], y[7]) << 32)); }
            else *(u32x4*)(H + (size_t)row * D + col) = hw; }
    }
    __syncthreads();
}

struct RegSched {
    static constexpr bool HALFSKIP = false;
    const char* A; const char* Bt; size_t a_tile, b_tile; int nM, nN, G, c;
    __device__ __forceinline__ bool next(int i, pg8::Unit& u) const {
        const int L = i * G + c; if (L >= nM * nN) return false;
        int pm, pn; pg8::swz_tile(L, nM, nN, pm, pn);
        u.a = A + (size_t)pm * a_tile; u.b = Bt + (size_t)pn * b_tile; u.rows = nullptr; u.pm = pm; u.pn = pn; u.aux = 0; u.nvalid = 256; return true;
    }
};
struct TwoPartSched {      static constexpr bool HALFSKIP = false;
    const char* Y; const char* Wa; const char* Wb; int nM, nN, G, c;
    __device__ __forceinline__ bool next(int i, pg8::Unit& u) const {
        const int L = (i >> 1) * G + c, part = i & 1; if (L >= nM * nN) return false;
        int pm, pn; pg8::swz_tile(L, nM, nN, pm, pn);
        u.a = Y + (size_t)pm * 256 * 2048 + part * 1024; u.b = (part ? Wb : Wa) + (size_t)pn * 256 * 1024; u.rows = nullptr; u.pm = pm; u.pn = pn; u.aux = part; u.nvalid = 256; return true;
    }
};
struct MoeSched {
    static constexpr bool HALFSKIP = true;
    const LAS int* tbl; const LAS int* cnts; int nent; const char* A; const char* W; const int* lists; int ncol  , wtile  , wexp  , atile  , G, c;
    __device__ __forceinline__ bool next(int i, pg8::Unit& u) const {
        const int un = i * (G >> 3) + (c >> 3); if (un >= nent * ncol) return false;
        const int pn = un % ncol; const int ent = __builtin_amdgcn_readfirstlane(tbl[un / ncol]), e = (ent >> 7) & 511, r = ent & 127, rt = ent >> 16;
        u.a = A + (size_t)rt * atile; u.b = W + (size_t)e * wexp + (size_t)pn * wtile; u.rows = lists + (size_t)e * 16384 + r * 256;
        u.pm = rt; u.pn = pn; u.aux = e; const int left = __builtin_amdgcn_readfirstlane(cnts[e]) - r * 256; u.nvalid = left < 256 ? left : 256; return true;
    }
};

struct EpiInproj {
    static constexpr bool PERM = true;
    bf16_t* PROJ; float* LOGF; const float* LB; const float* ROPE; unsigned char* G8; unsigned char* QK8;
    __device__ __forceinline__ bool keep(const pg8::Unit&) const { return false; }
    __device__ __forceinline__ void operator()(f32x4 (&acc)[2][2][4][2], const pg8::Unit& u, int wr, int wc, int fr, int fq) const {
        const int pn = u.pn;
        const int mode = pn < 2 ? 0 : pn < 4 ? 1 : pn < 6 ? 0 : pn < 8 ? 2 : pn < 20 ? 3 : pn < 26 ? 5 : 4;
        const int row0 = u.pm * 256 + wr * 64 + fr, colb = pn * 256 + wc * 32 + 8 * fq;
        const bool rot = (mode == 3) && ((wc & 1) == 0);
#pragma unroll
        for (int ai = 0; ai < 2; ++ai)
#pragma unroll
            for (int m = 0; m < 4; ++m) {
                const int row = row0 + ai * 128 + m * 16;
                f32x4 cs0, cs1, sn0, sn1;
                if (rot) { const f32x4* rp = (const f32x4*)(ROPE + (size_t)row * 16); cs0 = rp[0]; cs1 = rp[1]; sn0 = rp[2]; sn1 = rp[3]; }
#pragma unroll
                for (int bj = 0; bj < 2; ++bj) {
                    const int col = colb + bj * 128;
                    f32x4 v0 = acc[ai][bj][m][0], v1 = acc[ai][bj][m][1];
                    if (mode == 1) {
                        const int cf = col - 512; const f32x4 l0 = *(const f32x4*)(LB + cf), l1 = *(const f32x4*)(LB + cf + 4);
                        f32x4 lf0, lf1;
#pragma unroll
                        for (int j = 0; j < 4; ++j) { float sg = sigmoidf_(v0[j]); float f = l0[j] + (1.f - l0[j]) * sg; lf0[j] = __logf(f); v0[j] = (1.f - l0[j]) * (1.f - sg);
                            sg = sigmoidf_(v1[j]); f = l1[j] + (1.f - l1[j]) * sg; lf1[j] = __logf(f); v1[j] = (1.f - l1[j]) * (1.f - sg); }
                        acc[ai][bj][m][0] = lf0; acc[ai][bj][m][1] = lf1;
                    } else if (mode == 2) {
#pragma unroll
                        for (int j = 0; j < 4; ++j) { v0[j] = v0[j] * sigmoidf_(v0[j]); v1[j] = v1[j] * sigmoidf_(v1[j]); }
                    } else if (mode == 4) {
#pragma unroll
                        for (int j = 0; j < 4; ++j) { v0[j] = sigmoidf_(v0[j]); v1[j] = sigmoidf_(v1[j]); }
                    } else if (rot) {
                        f32x4 p0, p1;
#pragma unroll
                        for (int j = 0; j < 4; ++j) { p0[j] = __shfl_xor(v0[j], 16); p1[j] = __shfl_xor(v1[j], 16); }
                        if (fq == 0) { v0 = v0 * cs0 - p0 * sn0; v1 = v1 * cs1 - p1 * sn1; }
                        else if (fq == 1) { v0 = v0 * cs0 + p0 * sn0; v1 = v1 * cs1 + p1 * sn1; }
                    }
                    if (mode == 4) {
                        int g0 = 0, g1 = 0;
#pragma unroll
                        for (int j = 0; j < 4; ++j) { g0 = __builtin_amdgcn_cvt_pk_u8_f32(fmaxf(v0[j] * 255.0f, 1.0f), j, g0); g1 = __builtin_amdgcn_cvt_pk_u8_f32(fmaxf(v1[j] * 255.0f, 1.0f), j, g1); }
                        *(u32x2*)(G8 + (size_t)row * 2048 + (col - C_GA)) = (u32x2){(unsigned)g0, (unsigned)g1};
                        continue; }
                    if (mode == 3 || mode == 5) {
                        *(u32x2*)(QK8 + (size_t)row * 4608 + (col - C_AQ)) = (u32x2){pk4_fp8(v0[0], v0[1], v0[2], v0[3]), pk4_fp8(v1[0], v1[1], v1[2], v1[3])};
                        continue; }
                    u32x4 w; w.x = pg8::cvt_pk_bf16(v0[0], v0[1]); w.y = pg8::cvt_pk_bf16(v0[2], v0[3]); w.z = pg8::cvt_pk_bf16(v1[0], v1[1]); w.w = pg8::cvt_pk_bf16(v1[2], v1[3]);
                    *(u32x4*)(PROJ + (size_t)row * INW + col) = w;
                }
            }
        if (mode == 1) {
            const int lane = fq * 16 + fr;
#pragma unroll
            for (int ai = 0; ai < 2; ++ai)
#pragma unroll
                for (int bj = 0; bj < 2; ++bj)
#pragma unroll
                    for (int n = 0; n < 2; ++n)
#pragma unroll
                        for (int j = 0; j < 4; ++j) { float carry = 0.f;
#pragma unroll
                            for (int m = 0; m < 4; ++m) { float v = acc[ai][bj][m][n][j];
                                v += __builtin_bit_cast(float, __builtin_amdgcn_update_dpp(0, __builtin_bit_cast(int, v), 0x111, 0xF, 0xF, true));
                                v += __builtin_bit_cast(float, __builtin_amdgcn_update_dpp(0, __builtin_bit_cast(int, v), 0x112, 0xF, 0xF, true));
                                v += __builtin_bit_cast(float, __builtin_amdgcn_update_dpp(0, __builtin_bit_cast(int, v), 0x114, 0xF, 0xF, true));
                                v += __builtin_bit_cast(float, __builtin_amdgcn_update_dpp(0, __builtin_bit_cast(int, v), 0x118, 0xF, 0xF, true));
                                v += carry; acc[ai][bj][m][n][j] = v; carry = __shfl(v, (lane & 48) | 15); } }
#pragma unroll
            for (int ai = 0; ai < 2; ++ai)
#pragma unroll
                for (int m = 0; m < 4; ++m)
#pragma unroll
                    for (int bj = 0; bj < 2; ++bj) { float* lp = LOGF + (size_t)(row0 + ai * 128 + m * 16) * 512 + (colb + bj * 128 - 512); *(f32x4*)lp = acc[ai][bj][m][0]; *(f32x4*)(lp + 4) = acc[ai][bj][m][1]; }
        }
    }
};
__device__ __forceinline__ void gate8(u32x2 w, f32x4& lo, f32x4& hi) {
    constexpr float s = 1.0f / 255.0f;
    lo = (f32x4){(float)(w.x & 255u), (float)((w.x >> 8) & 255u), (float)((w.x >> 16) & 255u), (float)(w.x >> 24)} * s;
    hi = (f32x4){(float)(w.y & 255u), (float)((w.y >> 8) & 255u), (float)((w.y >> 16) & 255u), (float)(w.y >> 24)} * s;
}
struct EpiMixed {
    static constexpr bool PERM = true;
    const unsigned char* G8; bf16_t* MIXED;
    __device__ __forceinline__ bool keep(const pg8::Unit& u) const { return u.aux == 0; }
    __device__ __forceinline__ void operator()(f32x4 (&acc)[2][2][4][2], const pg8::Unit& u, int wr, int wc, int fr, int fq) const {
        const int row0 = u.pm * 256 + wr * 64 + fr, colb = u.pn * 256 + wc * 32 + 8 * fq;
#pragma unroll
        for (int ai = 0; ai < 2; ++ai)
#pragma unroll
            for (int m = 0; m < 4; ++m) {
                const int row = row0 + ai * 128 + m * 16;
#pragma unroll
                for (int bj = 0; bj < 2; ++bj) {
                    const int col = colb + bj * 128;
                    f32x4 b0, b1; gate8(*(const u32x2*)(G8 + (size_t)row * 2048 + 1024 + col), b0, b1);
                    if (u.aux == 0) {
                        f32x4 a0, a1; gate8(*(const u32x2*)(G8 + (size_t)row * 2048 + col), a0, a1);
#pragma unroll
                        for (int j = 0; j < 4; ++j) { acc[ai][bj][m][0][j] *= a0[j] / b0[j]; acc[ai][bj][m][1][j] *= a1[j] / b1[j]; }
                    } else {
                        const f32x4 v0 = acc[ai][bj][m][0] * b0, v1 = acc[ai][bj][m][1] * b1;
                        u32x4 w; w.x = pg8::cvt_pk_bf16(v0[0], v0[1]); w.y = pg8::cvt_pk_bf16(v0[2], v0[3]); w.z = pg8::cvt_pk_bf16(v1[0], v1[1]); w.w = pg8::cvt_pk_bf16(v1[2], v1[3]);
                        st_wt16(MIXED + (size_t)row * D + col, w);
                    }
                }
            }
    }
};
struct EpiOutproj {
    static constexpr bool PERM = true;
    const float* x; const float* MOD; bf16_t* X1;
    __device__ __forceinline__ bool keep(const pg8::Unit&) const { return false; }
    __device__ __forceinline__ void operator()(f32x4 (&acc)[2][2][4][2], const pg8::Unit& u, int wr, int wc, int fr, int fq) const {
        const int row0 = u.pm * 256 + wr * 64 + fr, colb = u.pn * 256 + wc * 32 + 8 * fq;
        const int b = (u.pm * 256) / SEQ;
#pragma unroll
        for (int bj = 0; bj < 2; ++bj) {
            const int col = colb + bj * 128;
            const f32x4 g0 = *(const f32x4*)(MOD + b * 6144 + 2048 + col), g1 = *(const f32x4*)(MOD + b * 6144 + 2048 + col + 4);
#pragma unroll
            for (int ai = 0; ai < 2; ++ai)
#pragma unroll
                for (int m = 0; m < 4; ++m) { const size_t off = (size_t)(row0 + ai * 128 + m * 16) * D + col;
                    const f32x4 v0 = *(const f32x4*)(x + off) + g0 * acc[ai][bj][m][0], v1 = *(const f32x4*)(x + off + 4) + g1 * acc[ai][bj][m][1];
                    u32x4 w; w.x = pg8::cvt_pk_bf16(v0[0], v0[1]); w.y = pg8::cvt_pk_bf16(v0[2], v0[3]); w.z = pg8::cvt_pk_bf16(v1[0], v1[1]); w.w = pg8::cvt_pk_bf16(v1[2], v1[3]);
                    st_wt16(X1 + off, w); }
        }
    }
};
struct EpiOutNorm {
    static constexpr bool PERM = true;
    const float* x; const float* MOD; const float* g2; bf16_t* X1; bf16_t* H; unsigned char* H8; float* XB; unsigned* cnt; LAS unsigned char* sl;
    __device__ __forceinline__ bool keep(const pg8::Unit&) const { return false; }
    __device__ __forceinline__ void operator()(f32x4 (&acc)[2][2][4][2], const pg8::Unit& u, int wr, int wc, int fr, int fq) const {
        const int tid = threadIdx.x;
        const int rl0 = wr * 64 + fr, row0 = u.pm * 256 + rl0, colb = u.pn * 256 + wc * 32 + 8 * fq;
        const int b = (u.pm * 256) / SEQ;
        LAS float* Pt = (LAS float*)sl; LAS float* Rs = (LAS float*)(sl + 4096);
#pragma unroll
        for (int bj = 0; bj < 2; ++bj) {
            const int col = colb + bj * 128;
            const f32x4 g0 = *(const f32x4*)(MOD + b * 6144 + 2048 + col), g1 = *(const f32x4*)(MOD + b * 6144 + 2048 + col + 4);
#pragma unroll
            for (int ai = 0; ai < 2; ++ai)
#pragma unroll
                for (int m = 0; m < 4; ++m) { const size_t off = (size_t)(row0 + ai * 128 + m * 16) * D + col;
                    acc[ai][bj][m][0] = *(const f32x4*)(x + off) + g0 * acc[ai][bj][m][0]; acc[ai][bj][m][1] = *(const f32x4*)(x + off + 4) + g1 * acc[ai][bj][m][1];
                    asm volatile("" : "+v"(acc[ai][bj][m][0]), "+v"(acc[ai][bj][m][1]));
                    if (m & 1) asm volatile("" ::: "memory"); }
        }
#pragma unroll
        for (int ai = 0; ai < 2; ++ai)
#pragma unroll
            for (int m = 0; m < 4; ++m) { float q = 0.f;
#pragma unroll
                for (int bj = 0; bj < 2; ++bj)
#pragma unroll
                    for (int n = 0; n < 2; ++n) { const f32x4 v = acc[ai][bj][m][n]; q += (v[0] * v[0] + v[1] * v[1]) + (v[2] * v[2] + v[3] * v[3]); }
                q += __shfl_xor(q, 16); q += __shfl_xor(q, 32);
                if (fq == 0) Pt[(ai * 128 + rl0 + m * 16) * 4 + wc] = q; }
        asm volatile("s_waitcnt lgkmcnt(0)" ::: "memory"); __builtin_amdgcn_s_barrier(); asm volatile("" ::: "memory");
        if (tid < 256) { const f32x4 p = *(const LAS f32x4*)(Pt + tid * 4); st_wt4(XB + ((size_t)u.pm * 256 + tid) * 4 + u.pn, __builtin_bit_cast(unsigned, (p[0] + p[1]) + (p[2] + p[3]))); }
        asm volatile("s_waitcnt vmcnt(0)" ::: "memory"); __builtin_amdgcn_s_barrier(); asm volatile("" ::: "memory");
        if (tid == 0) { unsigned* p = cnt + (size_t)u.pm * 64; (void)xb_add(p, 1u); unsigned sp = 0u;
            while (xb_ld(p) < 4u) { __builtin_amdgcn_s_sleep(2); if (++sp > (1u << 22)) break; }
            __builtin_amdgcn_fence(__ATOMIC_ACQUIRE, "agent"); asm volatile("s_waitcnt vmcnt(0)" ::: "memory"); }
        __builtin_amdgcn_s_barrier(); asm volatile("" ::: "memory");
        if (tid < 256) { const f32x4 q = *(const f32x4*)(XB + ((size_t)u.pm * 256 + tid) * 4); Rs[tid] = rsqrtf(((q[0] + q[1]) + (q[2] + q[3])) * (1.f / D) + EPS); }
        asm volatile("s_waitcnt vmcnt(0) lgkmcnt(0)" ::: "memory"); __builtin_amdgcn_s_barrier(); asm volatile("" ::: "memory");
#pragma unroll
        for (int bj = 0; bj < 2; ++bj) {
            const int col = colb + bj * 128;
            f32x4 gg[2], sc[2], sh[2];
#pragma unroll
            for (int q = 0; q < 2; ++q) { gg[q] = *(const f32x4*)(g2 + col + 4 * q); sh[q] = *(const f32x4*)(MOD + b * 6144 + 3072 + col + 4 * q); sc[q] = *(const f32x4*)(MOD + b * 6144 + 4096 + col + 4 * q) + 1.0f; gg[q] = gg[q] * sc[q]; }
#pragma unroll
            for (int ai = 0; ai < 2; ++ai)
#pragma unroll
                for (int m = 0; m < 4; ++m) { const int rl = ai * 128 + rl0 + m * 16; const size_t off = (size_t)(u.pm * 256 + rl) * D + col; const float rs = Rs[rl];
                    const f32x4 v0 = acc[ai][bj][m][0], v1 = acc[ai][bj][m][1];
                    u32x4 w; w.x = pg8::cvt_pk_bf16(v0[0], v0[1]); w.y = pg8::cvt_pk_bf16(v0[2], v0[3]); w.z = pg8::cvt_pk_bf16(v1[0], v1[1]); w.w = pg8::cvt_pk_bf16(v1[2], v1[3]);
                    *(u32x4*)(X1 + off) = w;
                    const f32x4 h0 = v0 * rs * gg[0] + sh[0], h1 = v1 * rs * gg[1] + sh[1];
                    u32x4 hw; hw.x = pg8::cvt_pk_bf16(h0[0], h0[1]); hw.y = pg8::cvt_pk_bf16(h0[2], h0[3]); hw.z = pg8::cvt_pk_bf16(h1[0], h1[1]); hw.w = pg8::cvt_pk_bf16(h1[2], h1[3]);
                    st_wt16(H + off, hw);
                    st_wt8(H8 + off, (unsigned long long)pk4_fp8(h0[0], h0[1], h0[2], h0[3]) | ((unsigned long long)pk4_fp8(h1[0], h1[1], h1[2], h1[3]) << 32));
                    asm volatile("" ::: "memory"); }
        }
    }
};
struct EpiRouter {
    static constexpr bool PERM = false;
    float* LOGITS4;
    __device__ __forceinline__ bool keep(const pg8::Unit&) const { return false; }
    __device__ __forceinline__ void operator()(f32x4 (&acc)[2][2][4][2], const pg8::Unit& u, int wr, int wc, int fr, int fq) const {
        const int row0 = u.pm * 256 + wr * 64 + fr, colb = wc * 32 + 4 * fq;
        float* base = LOGITS4 + (size_t)u.aux * T * 256;
#pragma unroll
        for (int ai = 0; ai < 2; ++ai)
#pragma unroll
            for (int m = 0; m < 4; ++m)
#pragma unroll
                for (int bj = 0; bj < 2; ++bj)
#pragma unroll
                    for (int n = 0; n < 2; ++n) st_wt16(base + (size_t)(row0 + ai * 128 + m * 16) * 256 + colb + bj * 128 + n * 16, __builtin_bit_cast(u32x4, acc[ai][bj][m][n]));
    }
};
struct RouterSched {
    static constexpr bool HALFSKIP = false;
    const char* A; const char* Bt; int G, c;
    __device__ __forceinline__ bool next(int i, pg8::Unit& u) const {
        const int L = i * G + c; if (L >= 256) return false;
        const int pm = L >> 2, ks = L & 3;
        u.a = A + (size_t)pm * 256 * 2048 + ks * 512; u.b = Bt + ks * 512; u.rows = nullptr; u.pm = pm; u.pn = 0; u.aux = ks; u.nvalid = 256; return true;
    }
};
struct EpiGU {
    static constexpr bool PERM = true;
    unsigned char* ACT;
    __device__ __forceinline__ bool keep(const pg8::Unit&) const { return false; }
    __device__ __forceinline__ void operator()(f32x4 (&acc)[2][2][4][2], const pg8::Unit& u, int wr, int wc, int fr, int fq) const {
        const int rl0 = wr * 64 + fr, col = u.pn * 128 + wc * 32 + 8 * fq;
        constexpr float is = 1.0f / WGU_SCALE;
#pragma unroll
        for (int ai = 0; ai < 2; ++ai)
#pragma unroll
            for (int m = 0; m < 4; ++m) {
                const int rl = rl0 + ai * 128 + m * 16;
                f32x4 v0, v1;
#pragma unroll
                for (int j = 0; j < 4; ++j) { const float a0 = acc[ai][0][m][0][j] * is, a1 = acc[ai][0][m][1][j] * is;
                    v0[j] = a0 * sigmoidf_(a0) * (acc[ai][1][m][0][j] * is); v1[j] = a1 * sigmoidf_(a1) * (acc[ai][1][m][1][j] * is); }
                *(u32x2*)(ACT + ((size_t)u.pm * 256 + rl) * EFF + col) = (u32x2){pk4_fp8(v0[0], v0[1], v0[2], v0[3]), pk4_fp8(v1[0], v1[1], v1[2], v1[3])};
                asm volatile("" ::: "memory");
            }
    }
};
struct EpiDown {
    static constexpr bool PERM = true;
    unsigned char* YBUF; const float* GATEW;
    __device__ __forceinline__ bool keep(const pg8::Unit&) const { return false; }
    __device__ __forceinline__ void operator()(f32x4 (&acc)[2][2][4][2], const pg8::Unit& u, int wr, int wc, int fr, int fq) const {
        const int rl0 = wr * 64 + fr, colb = u.pn * 256 + wc * 32 + 8 * fq;
#pragma unroll
        for (int ai = 0; ai < 2; ++ai)
#pragma unroll
            for (int m = 0; m < 4; ++m) {
                const int rl = rl0 + ai * 128 + m * 16;
                if (rl < u.nvalid) {
                    const int slot = u.rows[rl]; const float gw = GATEW[slot] * (YSCALE / WD_SCALE);
#pragma unroll
                    for (int bj = 0; bj < 2; ++bj) { const f32x4 v0 = acc[ai][bj][m][0] * gw, v1 = acc[ai][bj][m][1] * gw;
                        *(u32x2*)(YBUF + (size_t)slot * D + colb + bj * 128) = (u32x2){pk4_fp8(v0[0], v0[1], v0[2], v0[3]), pk4_fp8(v1[0], v1[1], v1[2], v1[3])}; }
                }
                asm volatile("" ::: "memory");
            }
    }
};

#define MFMA16(a, b, c) __builtin_amdgcn_mfma_f32_16x16x32_bf16((a), (b), (c), 0, 0, 0)
#define MFMA32(a, b, c) __builtin_amdgcn_mfma_f32_32x32x16_bf16((a), (b), (c), 0, 0, 0)
__device__ __forceinline__ s16x4 tr16(const LAS unsigned char* p) { return __builtin_amdgcn_ds_read_tr16_b64_v4i16((LAS s16x4*)p); }
__device__ __forceinline__ bf16x8 cat8(s16x4 a, s16x4 b) { bf16x8 r; r[0] = a[0]; r[1] = a[1]; r[2] = a[2]; r[3] = a[3]; r[4] = b[0]; r[5] = b[1]; r[6] = b[2]; r[7] = b[3]; return r; }
__device__ __forceinline__ u32x4 pack8(const float (&v)[8]) { u32x4 w; w.x = pg8::cvt_pk_bf16(v[0], v[1]); w.y = pg8::cvt_pk_bf16(v[2], v[3]); w.z = pg8::cvt_pk_bf16(v[4], v[5]); w.w = pg8::cvt_pk_bf16(v[6], v[7]); return w; }
__device__ __forceinline__ void unpack8(u32x4 w, float (&v)[8]) { v[0] = bflo(w.x); v[1] = bfhi(w.x); v[2] = bflo(w.y); v[3] = bfhi(w.y); v[4] = bflo(w.z); v[5] = bfhi(w.z); v[6] = bflo(w.w); v[7] = bfhi(w.w); }
__device__ __forceinline__ int swzA(int row) { return (row & 3) | (((row >> 3) & 1) << 2); }
__device__ __forceinline__ void hgrn_kv_unit(Ctx& X, int bn) {
    const int t0 = bn * 64;
    const bf16_t* PROJ = WSP(bf16_t, WS_PROJ); const float* BC = WSP(float, WS_LOGF);
#pragma unroll 2
    for (int j = 0; j < 8; ++j) {
        const int p = X.tid + NTHREADS * j, row = p >> 6, c64 = p & 63, h = c64 >> 4, ch = c64 & 15;
        const size_t prow = (size_t)(t0 + row) * INW + h * 128 + 8 * ch;
        const u32x4 kraw = *(const u32x4*)(PROJ + prow + C_HK), vraw = *(const u32x4*)(PROJ + prow + C_HV);
        const float* bp = BC + (size_t)(t0 + row) * 512 + h * 128 + 8 * ch; const float* bl = BC + (size_t)(t0 + 63) * 512 + h * 128 + 8 * ch;
        const f32x4 b0 = *(const f32x4*)bp, b1 = *(const f32x4*)(bp + 4), l0 = *(const f32x4*)bl, l1 = *(const f32x4*)(bl + 4);
        float kv[8]; unpack8(kraw, kv);
#pragma unroll
        for (int e = 0; e < 4; ++e) { kv[e] *= __expf(l0[e] - b0[e]); kv[4 + e] *= __expf(l1[e] - b1[e]); }
        const int off = row * 256 + (((ch >> 1) ^ swzA(row)) * 32) + (ch & 1) * 16;
        *(LAS u32x4*)(X.lds + h * 32768 + off) = vraw; *(LAS u32x4*)(X.lds + h * 32768 + 16384 + off) = pack8(kv);
    }
    WSP(float, WS_DECAY)[bn * 512 + X.tid] = __expf(BC[(size_t)(t0 + 63) * 512 + X.tid]);
    __syncthreads();
    const int l = X.lane, w = X.wave, fr = l & 15, fq = l >> 4, r = fr >> 2, p4 = l & 3, h = w >> 1, vt0 = 4 * (w & 1);
    const LAS unsigned char* VI = X.lds + h * 32768; const LAS unsigned char* KI = VI + 16384;
    bf16x8 af[4][2];
#pragma unroll
    for (int vt = 0; vt < 4; ++vt)
#pragma unroll
        for (int kk = 0; kk < 2; ++kk) { const int r0 = 32 * kk + 8 * fq + r, r1 = r0 + 4;
            af[vt][kk] = cat8(tr16(VI + r0 * 256 + (((vt0 + vt) ^ swzA(r0)) * 32) + p4 * 8), tr16(VI + r1 * 256 + (((vt0 + vt) ^ swzA(r1)) * 32) + p4 * 8)); }
    bf16_t* KVT = WSP(bf16_t, WS_KVT) + (size_t)(bn * 4 + h) * 16384;
#pragma unroll 2
    for (int ct = 0; ct < 8; ++ct) {
        bf16x8 bfr[2];
#pragma unroll
        for (int kk = 0; kk < 2; ++kk) { const int r0 = 32 * kk + 8 * fq + r, r1 = r0 + 4;
            bfr[kk] = cat8(tr16(KI + r0 * 256 + ((ct ^ swzA(r0)) * 32) + p4 * 8), tr16(KI + r1 * 256 + ((ct ^ swzA(r1)) * 32) + p4 * 8)); }
#pragma unroll
        for (int vt = 0; vt < 4; ++vt) { f32x4 acc = {0.f, 0.f, 0.f, 0.f}; acc = MFMA16(bfr[0], af[vt][0], acc); acc = MFMA16(bfr[1], af[vt][1], acc);
            u32x2 wv; wv.x = pg8::cvt_pk_bf16(acc[0], acc[1]); wv.y = pg8::cvt_pk_bf16(acc[2], acc[3]);
            *(u32x2*)(KVT + (16 * (vt0 + vt) + fr) * 128 + 16 * ct + 4 * fq) = wv; }
    }
    __syncthreads();
}
__device__ __forceinline__ void hgrn_passB(Ctx& X) {
    const unsigned* KVT = WSP(unsigned, WS_KVT); const float* DECAY = WSP(float, WS_DECAY); unsigned* SPT = WSP(unsigned, WS_SPT);
    const int gt = X.wg * NTHREADS + X.tid, NGT = X.G * NTHREADS;
    for (int item = gt; item < 16 * 128 * 64; item += NGT) {
        const int bh = item >> 13, rem = item & 8191, vd = rem >> 6, c = (rem & 63) * 2, b = bh >> 2, h = bh & 3;
        float s0 = 0.f, s1 = 0.f;
#pragma unroll 8
        for (int n = 0; n < 64; ++n) {
            const int unit = (b * 64 + n) * 4 + h;
            const unsigned kw = KVT[((size_t)unit * 16384 + vd * 128 + c) >> 1]; const f32x2 kv = {bflo(kw), bfhi(kw)};
            const f32x2 dc = *(const f32x2*)(DECAY + unit * 128 + c);
            SPT[((size_t)unit * 16384 + vd * 128 + c) >> 1] = pk2(s0, s1);
            s0 = dc.x * s0 + kv.x; s1 = dc.y * s1 + kv.y;
        }
    }
}
__device__ __forceinline__ void hgrn_out_unit(Ctx& X, int u2) {
    const int bn = u2 >> 1, hp = u2 & 1, t0 = bn * 64;
    const bf16_t* PROJ = WSP(bf16_t, WS_PROJ); const float* BCg = WSP(float, WS_LOGF);
#pragma unroll 2
    for (int j = 0; j < 4; ++j) { const int p = X.tid + NTHREADS * j, row = p >> 5, c32 = p & 31, hh = c32 >> 4, ch = c32 & 15, h = 2 * hp + hh;
        const size_t prow = (size_t)(t0 + row) * INW + h * 128 + 8 * ch;
        const u32x4 qraw = *(const u32x4*)(PROJ + prow + C_HQ), kraw = *(const u32x4*)(PROJ + prow + C_HK), vraw = *(const u32x4*)(PROJ + prow + C_HV);
        const float* bp = BCg + (size_t)(t0 + row) * 512 + h * 128 + 8 * ch; const float* br = BCg + (size_t)(t0 + 32) * 512 + h * 128 + 8 * ch;
        const f32x4 b0 = *(const f32x4*)bp, b1 = *(const f32x4*)(bp + 4), r0 = *(const f32x4*)br, r1 = *(const f32x4*)(br + 4);
        float qv[8], kv[8], a[8], bq[8]; unpack8(qraw, qv); unpack8(kraw, kv);
#pragma unroll
        for (int e = 0; e < 4; ++e) { const float e0 = __expf(b0[e] - r0[e]), e1 = __expf(b1[e] - r1[e]);
            a[e] = qv[e] * e0; a[4 + e] = qv[4 + e] * e1; kv[e] *= __builtin_amdgcn_rcpf(e0); kv[4 + e] *= __builtin_amdgcn_rcpf(e1);
            bq[e] = qv[e] * __expf(b0[e]); bq[4 + e] = qv[4 + e] * __expf(b1[e]); }
        LAS unsigned char* hb = X.lds + hh * 65536; const int o16 = row * 256 + ((ch ^ (row & 15)) * 16);
        *(LAS u32x4*)(hb + o16) = pack8(a); *(LAS u32x4*)(hb + 16384 + o16) = pack8(kv); *(LAS u32x4*)(hb + 32768 + o16) = pack8(bq);
        *(LAS u32x4*)(hb + 49152 + row * 256 + (((ch >> 1) ^ (row & 7)) * 32) + (ch & 1) * 16) = vraw; }
    const int l = X.lane, w = X.wave, fr = l & 15, fq = l >> 4, r = fr >> 2, p4 = l & 3, hh = w >> 2, h = 2 * hp + hh, ti = w & 3;
    const int tq = 16 * ti + fr;
    const bf16_t* SPT = WSP(bf16_t, WS_SPT) + (size_t)(bn * 4 + h) * 16384;
    __syncthreads();
    const LAS unsigned char* QSI = X.lds + hh * 65536; const LAS unsigned char* KSI = QSI + 16384; const LAS unsigned char* QNI = QSI + 32768; const LAS unsigned char* VI = QSI + 49152;
    bf16x8 QS[4];
#pragma unroll
    for (int ks = 0; ks < 4; ++ks) QS[ks] = *(const LAS bf16x8*)(QSI + tq * 256 + (((4 * ks + fq) ^ (tq & 15)) * 16));
    f32x4 ST[4];
#pragma unroll
    for (int si = 0; si < 4; ++si) {
        f32x4 acc = {0.f, 0.f, 0.f, 0.f};
        if (si <= ti) {
            const int sr = 16 * si + fr;
#pragma unroll
            for (int ks = 0; ks < 4; ++ks) { const bf16x8 kf = *(const LAS bf16x8*)(KSI + sr * 256 + (((4 * ks + fq) ^ (sr & 15)) * 16)); acc = MFMA16(kf, QS[ks], acc); }
            if (si == ti) {
#pragma unroll
                for (int q = 0; q < 4; ++q) acc[q] = (4 * fq + q <= fr) ? acc[q] : 0.f; }
        }
        ST[si] = acc;
    }
    f32x4 o[8];
#pragma unroll
    for (int vt = 0; vt < 8; ++vt) o[vt] = (f32x4){0.f, 0.f, 0.f, 0.f};
#pragma unroll
    for (int kk = 0; kk < 2; ++kk) {
        if (2 * kk <= ti) {
            float pv[8];
#pragma unroll
            for (int q = 0; q < 4; ++q) { pv[q] = ST[2 * kk][q]; pv[4 + q] = ST[2 * kk + 1][q]; }
            const bf16x8 pf = __builtin_bit_cast(bf16x8, pack8(pv));
            const int r0 = 32 * kk + 4 * fq + r, r1 = r0 + 16;
#pragma unroll
            for (int vt = 0; vt < 8; ++vt) { const bf16x8 va = cat8(tr16(VI + r0 * 256 + ((vt ^ (r0 & 7)) * 32) + p4 * 8), tr16(VI + r1 * 256 + ((vt ^ (r1 & 7)) * 32) + p4 * 8));
                o[vt] = MFMA16(va, pf, o[vt]); }
        }
    }
#pragma unroll
    for (int ks = 0; ks < 4; ++ks) { const bf16x8 qn = *(const LAS bf16x8*)(QNI + tq * 256 + (((4 * ks + fq) ^ (tq & 15)) * 16));
#pragma unroll
        for (int vt = 0; vt < 8; ++vt) { const bf16x8 sa = *(const bf16x8*)(SPT + (16 * vt + fr) * 128 + 32 * ks + 8 * fq); o[vt] = MFMA16(sa, qn, o[vt]); } }
    float ss = 0.f;
#pragma unroll
    for (int vt = 0; vt < 8; ++vt) ss += (o[vt][0] * o[vt][0] + o[vt][1] * o[vt][1]) + (o[vt][2] * o[vt][2] + o[vt][3] * o[vt][3]);
    ss += __shfl_xor(ss, 16); ss += __shfl_xor(ss, 32);
    const float rstd = rsqrtf(ss * (1.f / 128.f) + EPS);
    bf16_t* YCAT = WSP(bf16_t, WS_YCAT);
#pragma unroll
    for (int vt = 0; vt < 8; ++vt) { const int vd = 16 * vt + 4 * fq;
        const u32x2 sg = *(const u32x2*)(PROJ + (size_t)(t0 + tq) * INW + C_HG + h * 128 + vd); const f32x4 gn = *(const f32x4*)(X.g_hgrn + h * 128 + vd);
        u32x2 wv; wv.x = pg8::cvt_pk_bf16(o[vt][0] * rstd * gn[0] * bflo(sg.x), o[vt][1] * rstd * gn[1] * bfhi(sg.x)); wv.y = pg8::cvt_pk_bf16(o[vt][2] * rstd * gn[2] * bflo(sg.y), o[vt][3] * rstd * gn[3] * bfhi(sg.y));
        *(u32x2*)(YCAT + (size_t)(t0 + tq) * D + h * 128 + vd) = wv; }
    __syncthreads();
}

template <bool HI> __device__ __forceinline__ unsigned fp8x2_bf16_(unsigned w) { const auto f = __builtin_amdgcn_cvt_pk_f32_fp8((int)w, HI); return pg8::cvt_pk_bf16(f[0], f[1]); }
__device__ __forceinline__ unsigned fp8x2_bf16(unsigned w, bool hi) { return hi ? fp8x2_bf16_<true>(w) : fp8x2_bf16_<false>(w); }
struct AttnRegs { u32x4 k[3], v[3]; long q[4]; };
__device__ __forceinline__ void attn_load(Ctx& X, int unit, AttnRegs& R) {
    const int u16 = unit & 15, h = (unit >> 4) & 7, g = (unit >> 7) % 3, b = unit / 384;
    const int d = g == 0 ? 1 : g == 1 ? 4 : 16, nblk = 16 / d, r = u16 / nblk, blk = u16 % nblk;
    const int vcol = C_AV + g * 512 + h * 64;
    const int mk0 = blk * 256 - 128;
    const unsigned char* QK8 = WSP(unsigned char, WS_QK8);
    const int q8col = g * 512 + h * 64, k8col = 1536 + q8col, v8col = 3072 + q8col;
#pragma unroll
    for (int j = 0; j < 3; ++j) { const int idx = X.tid + NTHREADS * j, row = idx >> 2, ch = idx & 3, m = mk0 + row;
        R.k[j] = (u32x4){0u, 0u, 0u, 0u}; R.v[j] = (u32x4){0u, 0u, 0u, 0u};
        if (m >= 0) { const size_t tok = (size_t)b * SEQ + (size_t)m * d + r; R.k[j] = *(const u32x4*)(QK8 + tok * 4608 + k8col + ch * 16); R.v[j] = *(const u32x4*)(QK8 + tok * 4608 + v8col + ch * 16); } }
    const int l = X.lane, w = X.wave, q = l & 31, hi = l >> 5;
    const size_t tokq = (size_t)b * SEQ + (size_t)(blk * 256 + 32 * w + q) * d + r;
#pragma unroll
    for (int ds = 0; ds < 4; ++ds) R.q[ds] = *(const long*)(QK8 + tokq * 4608 + q8col + ds * 16 + hi * 8);
}
__device__ __forceinline__ void attn_stage(Ctx& X, const AttnRegs& R) {
    LAS unsigned char* KL = X.lds; LAS unsigned char* VL = X.lds + 55296;
#pragma unroll
    for (int j = 0; j < 3; ++j) { const int idx = X.tid + NTHREADS * j, row = idx >> 2, ch = idx & 3;
        *(LAS u32x4*)(KL + row * 80 + ch * 16) = R.k[j];
        u32x4 lo, hi2;
        lo.x = fp8x2_bf16(R.v[j].x, false); lo.y = fp8x2_bf16(R.v[j].x, true); lo.z = fp8x2_bf16(R.v[j].y, false); lo.w = fp8x2_bf16(R.v[j].y, true);
        hi2.x = fp8x2_bf16(R.v[j].z, false); hi2.y = fp8x2_bf16(R.v[j].z, true); hi2.z = fp8x2_bf16(R.v[j].w, false); hi2.w = fp8x2_bf16(R.v[j].w, true);
        *(LAS u32x4*)(VL + row * 128 + ch * 32) = lo; *(LAS u32x4*)(VL + row * 128 + ch * 32 + 16) = hi2; }
}
__device__ __forceinline__ void attn_compute(Ctx& X, int unit, const long (&qf)[4]) {
    const int u16 = unit & 15, h = (unit >> 4) & 7, g = (unit >> 7) % 3, b = unit / 384;
    const int d = g == 0 ? 1 : g == 1 ? 4 : 16, nblk = 16 / d, r = u16 / nblk, blk = u16 % nblk;
    const int mk0 = blk * 256 - 128;
    LAS unsigned char* KL = X.lds; LAS unsigned char* VL = X.lds + 55296;
    const int l = X.lane, w = X.wave, q = l & 31, hi = l >> 5;
    const size_t tokq = (size_t)b * SEQ + (size_t)(blk * 256 + 32 * w + q) * d + r;
    f32x16 s[5];
#pragma unroll
    for (int kt = 0; kt < 5; ++kt) {
        f32x16 acc;
#pragma unroll
        for (int i = 0; i < 16; ++i) acc[i] = 0.f;
#pragma unroll
        for (int ds = 0; ds < 4; ++ds) { const long kf = *(const LAS long*)(KL + (32 * w + 32 * kt + q) * 80 + ds * 16 + hi * 8); acc = __builtin_amdgcn_mfma_f32_32x32x16_fp8_fp8(kf, qf[ds], acc, 0, 0, 0); }
        s[kt] = acc;
    }
    const int iq = 32 * w + q;
    const int jmin = iq > -mk0 ? iq : -mk0; const unsigned jspan = (unsigned)(iq + 128 - jmin);
    float mx = -INFINITY;
#pragma unroll
    for (int kt = 0; kt < 5; ++kt)
#pragma unroll
        for (int rg = 0; rg < 16; ++rg) { const int j = 32 * w + 32 * kt + (rg & 3) + 8 * (rg >> 2) + 4 * hi;
            const bool valid = (unsigned)(j - jmin) <= jspan;
            s[kt][rg] = valid ? s[kt][rg] : -INFINITY; mx = fmaxf(mx, s[kt][rg]); if ((rg & 3) == 3) __builtin_amdgcn_sched_barrier(0); }
    mx = fmaxf(mx, __shfl_xor(mx, 32));
    const float c2 = 0.125f * 1.4426950408889634f;
    float lsum = 0.f;
#pragma unroll
    for (int kt = 0; kt < 5; ++kt)
#pragma unroll
        for (int rg = 0; rg < 16; ++rg) { const float p = exp2f((s[kt][rg] - mx) * c2); s[kt][rg] = p; lsum += p; }
    lsum += __shfl_xor(lsum, 32);
    f32x16 o[2];
#pragma unroll
    for (int dt = 0; dt < 2; ++dt)
#pragma unroll
        for (int i = 0; i < 16; ++i) o[dt][i] = 0.f;
    const int vlane = ((l & 15) >> 2) * 128 + (((l >> 4) & 1) * 16 + (l & 3) * 4) * 2;
#pragma unroll
    for (int kt = 0; kt < 5; ++kt)
#pragma unroll
        for (int s2 = 0; s2 < 2; ++s2) {
            bf16x8 pb;
#pragma unroll
            for (int j = 0; j < 8; j += 2) { const unsigned pw = pg8::cvt_pk_bf16(s[kt][8 * s2 + j], s[kt][8 * s2 + j + 1]); pb[j] = (short)(pw & 0xffffu); pb[j + 1] = (short)(pw >> 16); }
            const int key0 = 32 * w + 32 * kt + 16 * s2 + 4 * hi;
#pragma unroll
            for (int dt = 0; dt < 2; ++dt) {
                LAS unsigned char* vp = VL + key0 * 128 + dt * 64 + vlane;
                const s16x4 t0 = __builtin_amdgcn_ds_read_tr16_b64_v4i16((LAS s16x4*)vp);
                const s16x4 t1 = __builtin_amdgcn_ds_read_tr16_b64_v4i16((LAS s16x4*)(vp + 8 * 128));
                bf16x8 va; va[0] = t0[0]; va[1] = t0[1]; va[2] = t0[2]; va[3] = t0[3]; va[4] = t1[0]; va[5] = t1[1]; va[6] = t1[2]; va[7] = t1[3];
                o[dt] = MFMA32(va, pb, o[dt]);
            }
        }
    const float inv = 1.0f / lsum;
    bf16_t* OG = WSP(bf16_t, WS_OG) + (size_t)g * T * 512;
#pragma unroll
    for (int dt = 0; dt < 2; ++dt)
#pragma unroll
        for (int rg = 0; rg < 4; ++rg) { const int d0 = 32 * dt + 8 * rg + 4 * hi;
            u32x2 wv; wv.x = pg8::cvt_pk_bf16(o[dt][4 * rg] * inv, o[dt][4 * rg + 1] * inv); wv.y = pg8::cvt_pk_bf16(o[dt][4 * rg + 2] * inv, o[dt][4 * rg + 3] * inv);
            *(u32x2*)(OG + tokq * 512 + h * 64 + d0) = wv; }
    if (hi == 0) WSP(float, WS_LSE)[((size_t)g * T + tokq) * 8 + h] = mx * 0.125f + __logf(lsum);
}
__device__ __forceinline__ void attn_combine(Ctx& X) {
    const bf16_t* OG = WSP(bf16_t, WS_OG); const float* LSE = WSP(float, WS_LSE); bf16_t* YCAT = WSP(bf16_t, WS_YCAT);
    const int gt = X.wg * NTHREADS + X.tid, NGT = X.G * NTHREADS;
    for (int item = gt; item < T * 64; item += NGT) {
        const int t = item >> 6, ch = item & 63, h = ch >> 3;
        const float l0 = LSE[(size_t)t * 8 + h], l1 = LSE[((size_t)T + t) * 8 + h], l2 = LSE[((size_t)2 * T + t) * 8 + h];
        const float m = fmaxf(l0, fmaxf(l1, l2)); float w0 = __expf(l0 - m), w1 = __expf(l1 - m), w2 = __expf(l2 - m); const float inv = 1.f / (w0 + w1 + w2); w0 *= inv; w1 *= inv; w2 *= inv;
        const u32x4 a = *(const u32x4*)(OG + (size_t)t * 512 + ch * 8), bq = *(const u32x4*)(OG + ((size_t)T + t) * 512 + ch * 8), cq = *(const u32x4*)(OG + ((size_t)2 * T + t) * 512 + ch * 8);
        u32x4 o;
#pragma unroll
        for (int j = 0; j < 4; ++j) o[j] = pk2(w0 * bflo(a[j]) + w1 * bflo(bq[j]) + w2 * bflo(cq[j]), w0 * bfhi(a[j]) + w1 * bfhi(bq[j]) + w2 * bfhi(cq[j]));
        *(u32x4*)(YCAT + (size_t)t * D + 512 + ch * 8) = o;
    }
}

__device__ __forceinline__ unsigned sortable_key(float f) { const unsigned u = __builtin_bit_cast(unsigned, f); return (u & 0x80000000u) ? ~u : (u | 0x80000000u); }
__device__ __forceinline__ void moe_route(Ctx& X, bool local) {
    const float* LG = WSP(float, WS_KVT); unsigned* CNT = WSP(unsigned, WS_CTL) + CW_CNT; int* LISTS = WSP(int, WS_LISTS); float* GATEW = WSP(float, WS_GATEW);
    const int gw = X.wg * NWAVES + X.wave, NGW = X.G * NWAVES, l = X.lane, grp = l >> 3;
    const f32x4 bias = *(const f32x4*)(X.rbias + 4 * l);
    const unsigned long long ltmask = (1ull << l) - 1ull;
    const int tbeg = local ? X.wg * 64 + X.wave : gw, tend = local ? X.wg * 64 + 64 : T, tstep = local ? NWAVES : NGW;
    for (int t = tbeg; t < tend; t += tstep) {
        f32x4 lg = *(const f32x4*)(LG + (size_t)t * 256 + 4 * l);
#pragma unroll
        for (int ks = 1; ks < 4; ++ks) lg += *(const f32x4*)(LG + ((size_t)ks * T + t) * 256 + 4 * l);
        float sc[4], mb[4];
#pragma unroll
        for (int i = 0; i < 4; ++i) { sc[i] = sigmoidf_(lg[i]); mb[i] = sc[i] + bias[i]; }
        float m1 = fmaxf(mb[0], mb[1]), m2 = fminf(mb[0], mb[1]);
        { const float a1 = fmaxf(mb[2], mb[3]), a2 = fminf(mb[2], mb[3]); const float n1 = fmaxf(m1, a1), n2 = fmaxf(fminf(m1, a1), fmaxf(m2, a2)); m1 = n1; m2 = n2; }
#pragma unroll
        for (int o = 1; o < 8; o <<= 1) { const float a1 = __shfl_xor(m1, o), a2 = __shfl_xor(m2, o); const float n1 = fmaxf(m1, a1), n2 = fmaxf(fminf(m1, a1), fmaxf(m2, a2)); m1 = n1; m2 = n2; }
        const float gs = m1 + m2;
        int rank = 0;
#pragma unroll
        for (int gg = 0; gg < 8; ++gg) { const float og = __builtin_bit_cast(float, __builtin_amdgcn_readlane(__builtin_bit_cast(int, gs), gg * 8)); rank += (og > gs || (og == gs && gg < grp)) ? 1 : 0; }
        const bool sel = rank < 4;
        unsigned key[4];
#pragma unroll
        for (int i = 0; i < 4; ++i) key[i] = sel ? sortable_key(mb[i]) : 0u;
        unsigned pre = 0u;
#pragma unroll 1
        for (int bit = 31; bit >= 0; --bit) { const unsigned cand = pre | (1u << bit);
            const int cnt = __popcll(__ballot(key[0] >= cand)) + __popcll(__ballot(key[1] >= cand)) + __popcll(__ballot(key[2] >= cand)) + __popcll(__ballot(key[3] >= cand));
            if (cnt >= TOPK) pre = cand; }
        int ngt = 0, eqb = 0, tkb = 0; bool take[4];
#pragma unroll
        for (int i = 0; i < 4; ++i) ngt += __popcll(__ballot(key[i] > pre));
        const int need = TOPK - ngt;
#pragma unroll
        for (int i = 0; i < 4; ++i) eqb += __popcll(__ballot(key[i] == pre) & ltmask);
        int eqrun = eqb;
#pragma unroll
        for (int i = 0; i < 4; ++i) { const bool eq = key[i] == pre; take[i] = (key[i] > pre) || (eq && eqrun < need); eqrun += eq ? 1 : 0; }
#pragma unroll
        for (int i = 0; i < 4; ++i) tkb += __popcll(__ballot(take[i]) & ltmask);
        float part = 0.f;
#pragma unroll
        for (int i = 0; i < 4; ++i) part += take[i] ? sc[i] : 0.f;
        const float scale = 2.5f / wave_sum(part);
        int slot = tkb;
#pragma unroll
        for (int i = 0; i < 4; ++i) if (take[i]) { const int e = 4 * l + i; const unsigned pos = atomicAdd(&CNT[e * 64], 1u); LISTS[(size_t)e * 16384 + pos] = t * NSLOT + slot; GATEW[t * NSLOT + slot] = sc[i] * scale; ++slot; }
        if (l == 0) { LISTS[(size_t)NE * 16384 + t] = t * NSLOT + TOPK; GATEW[t * NSLOT + TOPK] = 1.0f; }
    }
}
__device__ __forceinline__ int moe_table(Ctx& X) {
    LAS int* tbl = (LAS int*)(X.lds + TBL_OFF); LAS int* cnts = (LAS int*)(X.lds + TCNT_OFF); LAS int* pref = cnts + 320;
    const unsigned* CNT = WSP(unsigned, WS_CTL) + CW_CNT;
    const int x = X.wg & 7;
    if (X.tid < NEX) cnts[X.tid] = X.tid < NE ? (int)__hip_atomic_load(CNT + X.tid * 64, __ATOMIC_RELAXED, __HIP_MEMORY_SCOPE_AGENT) : T;
    __syncthreads();
    if (X.tid < NEX) { int pre = 0; for (int e = 0; e < X.tid; ++e) pre += (cnts[e] + 255) >> 8; pref[X.tid] = pre; }
    __syncthreads();
    if (X.tid < 33) {
        const int i = X.tid; int lp = 0; for (int k = 0; k < i && k < 32; ++k) lp += (cnts[x + 8 * k] + 255) >> 8;
        if (i < 32) { const int e = x + 8 * i, n = (cnts[e] + 255) >> 8, p0 = pref[e]; for (int r = 0; r < n; ++r) tbl[lp + r] = ((p0 + r) << 16) | (e << 7) | r; }
        else { const int p0 = pref[NE]; for (int r8 = 0; r8 < 8; ++r8) { const int r = 8 * x + r8; tbl[lp + r8] = ((p0 + r) << 16) | (NE << 7) | r; } cnts[600] = lp + 8; }
    }
    __syncthreads();
    return __builtin_amdgcn_readfirstlane(cnts[600]);
}
__device__ __forceinline__ void final_rows(Ctx& X) {
    const bf16_t* X1 = WSP(bf16_t, WS_X1); const float* MOD = WSP(float, WS_MOD); const unsigned char* YBUF = WSP(unsigned char, WS_YBUF);
    const int gw = X.wg * NWAVES + X.wave, NGW = X.G * NWAVES, l = X.lane;
    for (int t = gw; t < T; t += NGW) {
        const int b = t / SEQ; f32x4 v[2][2]; float s = 0.f;
#pragma unroll
        for (int j = 0; j < 2; ++j) { const int col = 8 * l + 512 * j; f32x4 m0 = {0.f, 0.f, 0.f, 0.f}, m1 = {0.f, 0.f, 0.f, 0.f};
#pragma unroll
            for (int k = 0; k < NSLOT; ++k) { const u32x2 y = *(const u32x2*)(YBUF + ((size_t)t * NSLOT + k) * D + col);
                const f32x2 a = __builtin_amdgcn_cvt_pk_f32_fp8((int)y.x, false), bq = __builtin_amdgcn_cvt_pk_f32_fp8((int)y.x, true), c = __builtin_amdgcn_cvt_pk_f32_fp8((int)y.y, false), d = __builtin_amdgcn_cvt_pk_f32_fp8((int)y.y, true);
                m0.x += a[0]; m0.y += a[1]; m0.z += bq[0]; m0.w += bq[1]; m1.x += c[0]; m1.y += c[1]; m1.z += d[0]; m1.w += d[1]; }
            const f32x4 g0 = *(const f32x4*)(MOD + b * 6144 + 5120 + col) * (1.0f / YSCALE), g1 = *(const f32x4*)(MOD + b * 6144 + 5120 + col + 4) * (1.0f / YSCALE);
            const u32x4 xw = *(const u32x4*)(X1 + (size_t)t * D + col); const f32x4 x0 = {bflo(xw.x), bfhi(xw.x), bflo(xw.y), bfhi(xw.y)}, x1 = {bflo(xw.z), bfhi(xw.z), bflo(xw.w), bfhi(xw.w)};
            v[j][0] = x0 + g0 * m0; v[j][1] = x1 + g1 * m1;
#pragma unroll
            for (int q = 0; q < 2; ++q) s += (v[j][q].x * v[j][q].x + v[j][q].y * v[j][q].y) + (v[j][q].z * v[j][q].z + v[j][q].w * v[j][q].w); }
        const float rstd = rsqrtf(wave_sum(s) * (1.f / D) + EPS);
#pragma unroll
        for (int j = 0; j < 2; ++j) { const int col = 8 * l + 512 * j;
            *(f32x4*)(X.out + (size_t)t * D + col) = v[j][0] * rstd * *(const f32x4*)(X.g_final + col); *(f32x4*)(X.out + (size_t)t * D + col + 4) = v[j][1] * rstd * *(const f32x4*)(X.g_final + col + 4); }
    }
}

__device__ __forceinline__ unsigned* panel_word(Ctx& X, int bank, int pm) { return WSP(unsigned, WS_CTL) + CW_PANEL + (bank * 64 + pm) * 64; }
__device__ __forceinline__ void panel_signal(Ctx& X, int bank, int pm) {
    asm volatile("s_waitcnt vmcnt(0)" ::: "memory"); __syncthreads();
    if (X.tid == 0) (void)xb_add(panel_word(X, bank, pm), 1u);
}
__device__ __forceinline__ void panel_wait(Ctx& X, int bank, int pm, unsigned target) {
    if (X.tid == 0) { unsigned* p = panel_word(X, bank, pm); unsigned sp = 0u;
        while (xb_ld(p) < target) { __builtin_amdgcn_s_sleep(2); if (++sp > (1u << 22)) break; }
        __builtin_amdgcn_fence(__ATOMIC_ACQUIRE, "agent"); asm volatile("s_waitcnt vmcnt(0)" ::: "memory"); }
    __syncthreads();
}

constexpr int NG_INPROJ = 176;
__device__ __forceinline__ void ph_inproj(Ctx& X) {
    const int ng = X.G > NG_INPROJ + 8 ? NG_INPROJ : X.G;
    if (X.wg < ng) {
        RegSched S{(const char*)WSP(bf16_t, WS_H), (const char*)WSP(bf16_t, WS_WIN), (size_t)256 * 2048, (size_t)256 * 2048, T / 256, INW / 256, ng, X.wg};
        EpiInproj E{WSP(bf16_t, WS_PROJ), WSP(float, WS_LOGF), WSP(float, WS_LB), WSP(float, WS_ROPE), WSP(unsigned char, WS_G8), WSP(unsigned char, WS_QK8)};
        pg8::gemm_phase<EpiInproj, RegSched, true, false>(X.lds, 1024, 1024, 1024, S, E);
    }
    if (ng == X.G) expert_convert(X, X.wg, X.G);
    else if (X.wg >= ng) expert_convert(X, X.wg - ng, X.G - ng);
}
__device__ __forceinline__ void ph_mix_a(Ctx& X) {
    for (int it = X.wg; it < 256; it += X.G) hgrn_kv_unit(X, it);
    AttnRegs R; int unit = X.wg; long qf[4];
    if (unit < 1536) attn_load(X, unit, R);
    while (unit < 1536) {
        attn_stage(X, R);
#pragma unroll
        for (int ds = 0; ds < 4; ++ds) qf[ds] = R.q[ds];
        __syncthreads();
        const int nu = unit + X.G;
        if (nu < 1536) attn_load(X, nu, R);
        attn_compute(X, unit, qf);
        __syncthreads();
        unit = nu;
    }
}
__device__ __forceinline__ void ph_mix_c(Ctx& X) { for (int it = X.wg; it < 512; it += X.G) hgrn_out_unit(X, it); attn_combine(X); }
__device__ __forceinline__ void ph_mixed(Ctx& X, bool chain) {
    TwoPartSched S{(const char*)WSP(bf16_t, WS_YCAT), (const char*)WSP(bf16_t, WS_WPA), (const char*)WSP(bf16_t, WS_WPB), T / 256, D / 256, X.G, X.wg};
    EpiMixed E{WSP(unsigned char, WS_G8), WSP(bf16_t, WS_MIXED)};
    pg8::gemm_phase<EpiMixed, TwoPartSched, false, false>(X.lds, 1024, 512, 512, S, E);
    if (chain) { int pm, pn; pg8::swz_tile(X.wg, T / 256, D / 256, pm, pn); panel_signal(X, 0, pm); }
}
__device__ __forceinline__ void ph_outproj(Ctx& X, bool chain) {
    int pm = 0, pn = 0; pg8::swz_tile(X.wg < 256 ? X.wg : 0, T / 256, D / 256, pm, pn);
    RegSched S{(const char*)WSP(bf16_t, WS_MIXED), (const char*)WSP(bf16_t, WS_WOUT), (size_t)256 * 2048, (size_t)256 * 2048, T / 256, D / 256, X.G, X.wg};
    if (chain) {
        panel_wait(X, 0, pm, 4u);
        EpiOutNorm E{X.x, WSP(float, WS_MOD), X.g2, WSP(bf16_t, WS_X1), WSP(bf16_t, WS_H), WSP(unsigned char, WS_H8), WSP(float, WS_XB), panel_word(X, 1, 0), X.lds + 139264};
        pg8::gemm_phase<EpiOutNorm, RegSched, true, false>(X.lds, 1024, 1024, 1024, S, E);
        panel_signal(X, 2, pm);
    } else {
        EpiOutproj E{X.x, WSP(float, WS_MOD), WSP(bf16_t, WS_X1)};
        pg8::gemm_phase<EpiOutproj, RegSched, false, false>(X.lds, 1024, 1024, 1024, S, E);
    }
}
__device__ __forceinline__ void ph_norm2(Ctx& X, bool chain) { if (!chain) norm_rows(X, 1); }
__device__ __forceinline__ void ph_router(Ctx& X, bool chain) {
    if (chain) panel_wait(X, 2, X.wg >> 2, 4u);
    RouterSched S{(const char*)WSP(bf16_t, WS_H), (const char*)WSP(bf16_t, WS_WR), X.G, X.wg};
    EpiRouter E{WSP(float, WS_KVT)};
    pg8::gemm_phase<EpiRouter, RouterSched, false, false>(X.lds, 1024, 1024, 256, S, E);
    if (chain) panel_signal(X, 3, X.wg >> 2);
}
__device__ __forceinline__ void ph_route(Ctx& X, bool chain) {
    if (chain) panel_wait(X, 3, X.wg >> 2, 4u);
    moe_route(X, chain);
}
__device__ __forceinline__ void ph_gu(Ctx& X) {
    const int nent = moe_table(X);
    MoeSched S{(const LAS int*)(X.lds + TBL_OFF), (const LAS int*)(X.lds + TCNT_OFF), nent, (const char*)WSP(unsigned char, WS_H8), (const char*)WSP(unsigned char, WS_WGU), WSP(int, WS_LISTS), 2, 256 * 1024, 512 * 1024, 0, X.G, X.wg};
    EpiGU E{WSP(unsigned char, WS_ACT)};
    pg8::gemm_phase<EpiGU, MoeSched, true, true, true>(X.lds, 512, 512, 512, S, E);
}
__device__ __forceinline__ void ph_down(Ctx& X) {
    const int nent = moe_table(X);
    MoeSched S{(const LAS int*)(X.lds + TBL_OFF), (const LAS int*)(X.lds + TCNT_OFF), nent, (const char*)WSP(unsigned char, WS_ACT), (const char*)WSP(unsigned char, WS_WD), WSP(int, WS_LISTS), 4, 256 * 256, 1024 * 256, 256 * 256, X.G, X.wg};
    EpiDown E{WSP(unsigned char, WS_YBUF), WSP(float, WS_GATEW)};
    pg8::gemm_phase<EpiDown, MoeSched, true, false, true>(X.lds, 128, 128, 128, S, E);
}

constexpr int NPHASE = 14;
struct Args { const void* in[20]; float* out; unsigned char* ws; int ph_lo, ph_hi; };
__global__ void __launch_bounds__(NTHREADS, 2) mega_fwd(Args args) {
    extern __shared__ __attribute__((aligned(16))) unsigned char lds_raw[];
    Ctx X;
    X.lds = (LAS unsigned char*)lds_raw;
    X.tid = threadIdx.x; X.lane = X.tid & 63; X.wave = __builtin_amdgcn_readfirstlane(X.tid >> 6); X.wg = blockIdx.x; X.G = gridDim.x;
    X.x = (const float*)args.in[0]; X.c = (const float*)args.in[1]; X.positions = (const int*)args.in[2]; X.w_ada = (const float*)args.in[3]; X.b_ada = (const float*)args.in[4];
    X.g1 = (const float*)args.in[5]; X.w_in = (const float*)args.in[6]; X.lb_logits = (const float*)args.in[7]; X.g_hgrn = (const float*)args.in[8]; X.w_pa = (const float*)args.in[9];
    X.w_pb = (const float*)args.in[10]; X.w_out = (const float*)args.in[11]; X.g2 = (const float*)args.in[12]; X.w_router = (const float*)args.in[13]; X.rbias = (const float*)args.in[14];
    X.w_egu = (const float*)args.in[15]; X.w_edown = (const float*)args.in[16]; X.w_sgu = (const float*)args.in[17]; X.w_sdown = (const float*)args.in[18]; X.g_final = (const float*)args.in[19];
    X.out = args.out; X.ws = args.ws;
    volatile LAS unsigned* MISC = (volatile LAS unsigned*)(X.lds + MISC_OFF);
    if (X.tid < 32) MISC[X.tid] = 0u;
    __syncthreads();
    const int lo = args.ph_lo, hi = args.ph_hi;
    XcdBarrier bar; bar.bar = WSP(unsigned, WS_CTL) + CW_BAR; bar.x = 0; bar.st = nullptr;
    if (hi - lo > 1) bar = xcd_barrier_post(WSP(unsigned, WS_CTL) + CW_BAR, MISC + 8);
#ifndef PH_MASK
#define PH_MASK 0xffffffffu
#endif
#define IN(k) ((((PH_MASK) >> (k)) & 1u) && lo <= (k) && (k) < hi)
#ifndef REPEAT_MASK
#define REPEAT_MASK 0u
#endif
#define SEAM(k) do { if (IN(k) && IN((k) + 1)) xcd_barrier(bar); } while (0)
#define RUN(k, call) do { if (IN(k)) { call; if (((REPEAT_MASK) >> (k)) & 1u) { xcd_barrier(bar); call; } } } while (0)

    RUN(0, p0_prologue(X)); SEAM(0);
    RUN(1, { small_transposes(X); norm_rows(X, 0); }); SEAM(1);
    RUN(2, ph_inproj(X)); SEAM(2);
    RUN(3, ph_mix_a(X)); SEAM(3);
    RUN(4, hgrn_passB(X)); SEAM(4);
    RUN(5, ph_mix_c(X)); SEAM(5);
    const bool chain = (X.G == 256);
    RUN(6, ph_mixed(X, chain)); if (!chain) SEAM(6);
    RUN(7, ph_outproj(X, chain)); if (!chain) SEAM(7);
    RUN(8, ph_norm2(X, chain)); if (!chain) SEAM(8);
    RUN(9, ph_router(X, chain)); if (!chain) SEAM(9);
    RUN(10, ph_route(X, chain)); SEAM(10);
    RUN(11, ph_gu(X)); SEAM(11);
    RUN(12, ph_down(X)); SEAM(12);
    RUN(13, final_rows(X));
#undef IN
#undef SEAM
}

extern "C" void kernel_launch(void* const* d_in, const int* in_sizes, int n_in, void* d_out, int out_size, void* d_ws, size_t ws_size, hipStream_t stream) {
    static int grid = 0;
    if (grid == 0) {
        if (n_in != 20 || out_size != T * D || ws_size < WS_END) { fprintf(stderr, "kernel_launch: unexpected shapes (n_in %d, out %d, ws %zu); nothing launched\n", n_in, out_size, ws_size); grid = -1; return; }
        int dev = 0, cus = 0, per_cu = 0;
        if (hipGetDevice(&dev) != hipSuccess || hipDeviceGetAttribute(&cus, hipDeviceAttributeMultiprocessorCount, dev) != hipSuccess) { grid = -1; return; }
        if (hipFuncSetAttribute((const void*)mega_fwd, hipFuncAttributeMaxDynamicSharedMemorySize, LDS_BYTES) != hipSuccess) { fprintf(stderr, "kernel_launch: hipFuncSetAttribute failed\n"); grid = -1; return; }
        if (hipOccupancyMaxActiveBlocksPerMultiprocessor(&per_cu, (const void*)mega_fwd, NTHREADS, LDS_BYTES) != hipSuccess || per_cu < 1) { fprintf(stderr, "kernel_launch: occupancy query says %d blocks/CU; nothing launched\n", per_cu); (void)hipGetLastError(); grid = -1; return; }
        grid = cus;
        if (T % grid != 0 || 24576 % grid != 0 || grid % 8 != 0) { fprintf(stderr, "kernel_launch: grid %d does not divide the row count; nothing launched\n", grid); grid = -1; return; }
    }
    if (grid < 0) return;
    (void)hipMemsetAsync((char*)d_ws + WS_CTL, 0, CTL_ZERO_BYTES, stream);
    Args a{};
    for (int i = 0; i < 20; ++i) a.in[i] = d_in[i];
    a.out = (float*)d_out; a.ws = (unsigned char*)d_ws;
#if MK_PER_PHASE
    for (int p = 0; p < NPHASE; ++p) { a.ph_lo = p; a.ph_hi = p + 1; hipLaunchKernelGGL(mega_fwd, dim3(grid), dim3(NTHREADS), LDS_BYTES, stream, a); }
#else
    a.ph_lo = 0; a.ph_hi = NPHASE;
    hipLaunchKernelGGL(mega_fwd, dim3(grid), dim3(NTHREADS), LDS_BYTES, stream, a);
#endif
}
```

```cpp
#include <hip/hip_runtime.h>
#include <cstdio>
#include <cstdint>

#ifndef MK_PER_PHASE
#define MK_PER_PHASE 0
#endif

#define GAS __attribute__((address_space(1)))
#define LAS __attribute__((address_space(3)))
typedef unsigned short bf16_t;
typedef short bf16x8 __attribute__((ext_vector_type(8)));
typedef short s16x4 __attribute__((ext_vector_type(4)));
typedef float f32x4 __attribute__((ext_vector_type(4)));
typedef float f32x2 __attribute__((ext_vector_type(2)));
typedef float f32x16 __attribute__((ext_vector_type(16)));
typedef unsigned u32x4 __attribute__((ext_vector_type(4)));
typedef unsigned u32x2 __attribute__((ext_vector_type(2)));
typedef long l64x2 __attribute__((ext_vector_type(2)));

constexpr int NB = 4, SEQ = 4096, T = NB * SEQ, D = 1024, INW = 8704;
constexpr int C_HQ = 0, C_HK = 512, C_HV = 1024, C_HG = 1536, C_AQ = 2048, C_AK = 3584, C_AV = 5120, C_GA = 6656, C_GB = 7680;
constexpr int NE = 256, NEX = 257, TOPK = 8, NSLOT = 9, EFF = 256;
constexpr float EPS = 1e-6f;
constexpr float WGU_SCALE = 64.0f, WD_SCALE = 32.0f;
constexpr float YSCALE = 16.0f;
constexpr int NWAVES = 8, NTHREADS = 512;

constexpr size_t MiB = 1u << 20;
constexpr size_t WS_CTL = 0, CTL_ZERO_BYTES = 1 * MiB;
constexpr size_t WS_MODP = 2 * MiB;
constexpr size_t WS_MOD = 4 * MiB;
constexpr size_t WS_LB = 4 * MiB + 128 * 1024;
constexpr size_t WS_XB = 4 * MiB + 256 * 1024;
constexpr size_t WS_ROPE = 5 * MiB;
constexpr size_t WS_DECAY = 6 * MiB;
constexpr size_t WS_GATEW = 7 * MiB;
constexpr size_t WS_LISTS = 16 * MiB;
constexpr size_t WS_WIN = 34 * MiB;
constexpr size_t WS_WPA = 51 * MiB, WS_WPB = 52 * MiB, WS_WOUT = 53 * MiB, WS_WR = 55 * MiB;
constexpr size_t WS_H = 56 * MiB;
constexpr size_t WS_LOGF = 88 * MiB;
constexpr size_t WS_H8 = 120 * MiB;
constexpr size_t WS_MIXED = 136 * MiB;
constexpr size_t WS_YCAT = 168 * MiB;
constexpr size_t WS_X1 = 200 * MiB;
constexpr size_t WS_G8 = 232 * MiB;
constexpr size_t WS_OG = 264 * MiB;
constexpr size_t WS_LSE = 312 * MiB;
constexpr size_t WS_KVT = 314 * MiB;
constexpr size_t WS_SPT = 378 * MiB;
constexpr size_t WS_PROJ = 410 * MiB;
constexpr size_t WS_WGU = 682 * MiB;
constexpr size_t WS_QK8 = 820 * MiB;
constexpr size_t WS_WD = 939 * MiB;
constexpr size_t WS_ACT = 1068 * MiB;
constexpr size_t WS_YBUF = 1172 * MiB;
constexpr size_t WS_END = 1460 * MiB;
constexpr int CW_BAR = 4096;
constexpr int CW_PANEL = 65536;
constexpr int CW_CNT = 16384;

constexpr int RING_BYTES = 131072;
constexpr int TBL_OFF = RING_BYTES;
constexpr int TCNT_OFF = TBL_OFF + 4096;
constexpr int MISC_OFF = TCNT_OFF + 2560;
constexpr int LDS_BYTES = 147456;

#define LDS_WAIT() asm volatile("s_waitcnt lgkmcnt(0)" ::: "memory")
#define VM_WAIT() asm volatile("s_waitcnt vmcnt(0)" ::: "memory")
__device__ __forceinline__ unsigned f2bf(float f) { unsigned u = __builtin_bit_cast(unsigned, f); return (u + 0x7fffu + ((u >> 16) & 1u)) >> 16; }
__device__ __forceinline__ float bf2f(unsigned b) { return __builtin_bit_cast(float, b << 16); }
__device__ __forceinline__ unsigned pk2(float lo, float hi) { return f2bf(lo) | (f2bf(hi) << 16); }
__device__ __forceinline__ float bflo(unsigned w) { return __builtin_bit_cast(float, w << 16); }
__device__ __forceinline__ float bfhi(unsigned w) { return __builtin_bit_cast(float, w & 0xffff0000u); }
__device__ __forceinline__ float sigmoidf_(float x) { return __builtin_amdgcn_rcpf(1.0f + __expf(-x)); }
__device__ __forceinline__ float wave_sum(float v) {
#pragma unroll
    for (int o = 1; o < 64; o <<= 1) v += __shfl_xor(v, o);
    return v;
}

__device__ __forceinline__ float clamp_e4m3(float x) { return __builtin_amdgcn_fmed3f(x, -448.0f, 448.0f); }
__device__ __forceinline__ unsigned pk4_fp8(float a, float b, float c, float d) { int w = 0; w = __builtin_amdgcn_cvt_pk_fp8_f32(clamp_e4m3(a), clamp_e4m3(b), w, false); w = __builtin_amdgcn_cvt_pk_fp8_f32(clamp_e4m3(c), clamp_e4m3(d), w, true); return (unsigned)w; }
__device__ __forceinline__ void st_wt8(void* p, unsigned long long v) { __hip_atomic_store((unsigned long long*)p, v, __ATOMIC_RELAXED, __HIP_MEMORY_SCOPE_AGENT); }
__device__ __forceinline__ void st_wt16(void* p, u32x4 v) { asm volatile("global_store_dwordx4 %0, %1, off sc1\n\ts_nop 1" :: "v"(p), "v"(v) : "memory"); }
__device__ __forceinline__ void st_wt4(void* p, unsigned v) { __hip_atomic_store((unsigned*)p, v, __ATOMIC_RELAXED, __HIP_MEMORY_SCOPE_AGENT); }
namespace pg8 {
constexpr int BM = 256, BK = 64, HALF = 128, HTB = HALF * BK * 2, STAGE_BYTES = 8 * HTB, NXCD = 8, WGM = 8;
__host__ __device__ __forceinline__ int lds_byte(int r, int c) { const int st = (r >> 4) * 2 + (c >> 5), rr = r & 15, cc = c & 31, ob = rr * 64 + cc * 2; return st * 1024 + (ob ^ (((ob >> 9) & 1) << 5)); }
__host__ __device__ __forceinline__ void stage_rc(int b, int& R, int& C) { const int st = b / 1024, sb = b % 1024, swz = sb ^ (((sb >> 9) & 1) << 5); R = (st >> 1) * 16 + swz / 64; C = (st & 1) * 32 + (swz % 64) / 2; }
__host__ __device__ __forceinline__ int perm32(int rho) { const int n = rho >> 4, i = rho & 15; return 8 * (i >> 2) + 4 * n + (i & 3); }

struct Unit { const char* a; const char* b; const int* rows; int pm, pn, aux, nvalid; };

__device__ __forceinline__ void swz_tile(int L, int nM, int nN, int& pm, int& pn) {
    const int nwg = nM * nN; int wgid = L;
    { const int q = nwg / NXCD, r = nwg % NXCD, xcd = wgid % NXCD, off = wgid / NXCD; wgid = (xcd < r ? xcd * (q + 1) : r * (q + 1) + (xcd - r) * q) + off; }
    const int nig = WGM * nN, gid = wgid / nig, fm = gid * WGM, gsz = (nM - fm) < WGM ? (nM - fm) : WGM;
    pm = fm + ((wgid % nig) % gsz); pn = (wgid % nig) / gsz;
}

__device__ __forceinline__ unsigned cvt_pk_bf16(float lo, float hi) { unsigned r; asm volatile("v_cvt_pk_bf16_f32 %0, %1, %2" : "=v"(r) : "v"(lo), "v"(hi)); return r; }

template <bool GATHER>
__device__ __forceinline__ void gather_offs(const Unit& u, int tid, int lda, unsigned (&v)[2][2]) {
    if constexpr (GATHER) {
#pragma unroll
        for (int i = 0; i < 2; ++i) { int R, C; stage_rc(tid * 16 + i * 8192, R, C);
#pragma unroll
            for (int hh = 0; hh < 2; ++hh) { const int ri = hh * HALF + R; int slot = 0; if (ri < u.nvalid) slot = u.rows[ri];
                const unsigned tok = (unsigned)slot / 9u; v[hh][i] = (tok * (unsigned)lda + (unsigned)C) * 2u; } }
    }
}

template <class Epi, class Sched, bool ALIGN_EPI, bool GATHER, bool FP8 = false>
__device__ __forceinline__ void gemm_phase(LAS unsigned char* lds, const int lda, const int ldb, const int K, const Sched& S, const Epi& E) {
    const int tid = threadIdx.x, wid = __builtin_amdgcn_readfirstlane(tid >> 6), lane = tid & 63, wr = wid >> 2, wc = wid & 3, fr = lane & 15, fq = lane >> 4;
    const int nt = K / BK;
    unsigned voffA[2], voffB[2];
#pragma unroll
    for (int i = 0; i < 2; ++i) { int R, C; stage_rc(tid * 16 + i * 8192, R, C); const int Rb = Epi::PERM ? ((R & ~31) + perm32(R & 31)) : R;
        voffA[i] = (unsigned)(R * lda + C) * 2u; voffB[i] = (unsigned)(Rb * ldb + C) * 2u; }
    const size_t kstep = (size_t)(BK * 2);
    const size_t hstepA = GATHER ? 0 : (size_t)HALF * lda * 2, hstepB = (size_t)HALF * ldb * 2;
    const unsigned ldsw = (unsigned)wid * 1024u;
    const int aoff = lds_byte(wr * 64 + fr, fq * 8), boff = lds_byte(wc * 32 + fr, fq * 8);
#define PG8_SA(b, h) (((b) * 2 + (h)) * HTB)
#define PG8_SB(b, h) ((4 + (b) * 2 + (h)) * HTB)
#define PG8_STAGE(bufoff, gbase, voff) do { _Pragma("unroll") for (int _i = 0; _i < 2; ++_i) \
        __builtin_amdgcn_global_load_lds((const unsigned*)((const char*)(gbase) + (voff)[_i]), (LAS unsigned*)(lds + (bufoff) + ldsw + _i * 8192), 16, 0, 0); } while (0)
#define PG8_STAGE_A(bufoff, gb, hh, nx) do { if constexpr (GATHER) { unsigned _v[2]; _v[0] = (nx) ? vn[hh][0] : vc[hh][0]; _v[1] = (nx) ? vn[hh][1] : vc[hh][1]; PG8_STAGE(bufoff, gb, _v); } \
        else { PG8_STAGE(bufoff, (gb) + (hh) * hstepA, voffA); } } while (0)
#define PG8_LDA(dst, b, h) do { _Pragma("unroll") for (int m = 0; m < 4; ++m) _Pragma("unroll") for (int k = 0; k < 2; ++k) dst[m][k] = *(const LAS bf16x8*)(lds + PG8_SA(b, h) + aoff + m * 2048 + k * 1024); } while (0)
#define PG8_LDB(dst, b, h) do { _Pragma("unroll") for (int n = 0; n < 2; ++n) _Pragma("unroll") for (int k = 0; k < 2; ++k) dst[n][k] = *(const LAS bf16x8*)(lds + PG8_SB(b, h) + boff + n * 2048 + k * 1024); } while (0)
#define PG8_MMA(ai, bj, At, Bt) do { __builtin_amdgcn_s_setprio(1); _Pragma("unroll") for (int m = 0; m < 4; ++m) _Pragma("unroll") for (int n = 0; n < 2; ++n) _Pragma("unroll") for (int k = 0; k < 2; ++k) { \
        if constexpr (FP8) { const l64x2 _b = __builtin_bit_cast(l64x2, Bt[n][k]), _a = __builtin_bit_cast(l64x2, At[m][k]); \
            acc[ai][bj][m][n] = __builtin_amdgcn_mfma_f32_16x16x32_fp8_fp8(_b[0], _a[0], acc[ai][bj][m][n], 0, 0, 0); acc[ai][bj][m][n] = __builtin_amdgcn_mfma_f32_16x16x32_fp8_fp8(_b[1], _a[1], acc[ai][bj][m][n], 0, 0, 0); } \
        else acc[ai][bj][m][n] = __builtin_amdgcn_mfma_f32_16x16x32_bf16(Bt[n][k], At[m][k], acc[ai][bj][m][n], 0, 0, 0); } __builtin_amdgcn_s_setprio(0); } while (0)
#define PG8_WAIT_V(n) asm volatile("s_waitcnt vmcnt(" #n ")" ::: "memory")
#define PG8_WAIT_L(n) asm volatile("s_waitcnt lgkmcnt(" #n ")" ::: "memory")
#define PG8_BAR __builtin_amdgcn_s_barrier()
#define PG8_SCHED __builtin_amdgcn_sched_barrier(0)
    Unit cur, nxt; int ui = 0;
    if (!S.next(0, cur)) return;
    unsigned vc[2][2] = {{0u, 0u}, {0u, 0u}}, vn[2][2] = {{0u, 0u}, {0u, 0u}};
    gather_offs<GATHER>(cur, tid, lda, vc);
    f32x4 acc[2][2][4][2];
#pragma unroll
    for (int a = 0; a < 2; ++a)
#pragma unroll
        for (int b = 0; b < 2; ++b)
#pragma unroll
            for (int m = 0; m < 4; ++m)
#pragma unroll
                for (int n = 0; n < 2; ++n) acc[a][b][m][n] = (f32x4){0.f, 0.f, 0.f, 0.f};
    bf16x8 At[4][2], B0[2][2], B1[2][2];
    const char* cA = cur.a; const char* cB = cur.b;
    PG8_STAGE(PG8_SB(0, 0), cB, voffB); PG8_STAGE(PG8_SB(0, 1), cB + hstepB, voffB); PG8_STAGE_A(PG8_SA(0, 0), cA, 0, false); PG8_STAGE_A(PG8_SA(0, 1), cA, 1, false);
    if (wr == 1) PG8_BAR;
    PG8_WAIT_V(2); PG8_BAR;
    PG8_STAGE(PG8_SB(1, 0), cB + kstep, voffB); PG8_STAGE_A(PG8_SA(1, 0), cA + kstep, 0, false); PG8_STAGE(PG8_SB(1, 1), cB + hstepB + kstep, voffB);
    PG8_WAIT_V(6); PG8_BAR;
    for (;;) {
        const bool has_next = S.next(ui + 1, nxt);
        if (has_next) gather_offs<GATHER>(nxt, tid, lda, vn);
        const char* nA = has_next ? nxt.a : cA; const char* nB = has_next ? nxt.b : cB;
        const bool do0 = !Sched::HALFSKIP || cur.nvalid > 64 * wr, do1 = !Sched::HALFSKIP || cur.nvalid > 128 + 64 * wr;
        for (int t = 0; t < nt; t += 2) {
            const bool last = (t == nt - 2);
            const bool lnx = last && has_next;
            const char* a1 = cA + (size_t)(t + 1) * kstep;
            const char* a2 = last ? nA : cA + (size_t)(t + 2) * kstep; const char* b2 = last ? nB : cB + (size_t)(t + 2) * kstep;
            const char* a3 = a2 + kstep; const char* b3 = b2 + kstep;
            PG8_LDB(B0, 0, 0); PG8_LDB(B1, 0, 1); PG8_SCHED; PG8_LDA(At, 0, 0); PG8_STAGE_A(PG8_SA(1, 1), a1, 1, false);
            PG8_WAIT_V(8); PG8_WAIT_L(0); PG8_BAR; if (do0) { PG8_MMA(0, 0, At, B0); PG8_MMA(0, 1, At, B1); } PG8_BAR; PG8_SCHED;
            PG8_LDA(At, 0, 1); PG8_STAGE(PG8_SB(0, 0), b2, voffB); PG8_STAGE(PG8_SB(0, 1), b2 + hstepB, voffB); PG8_STAGE_A(PG8_SA(0, 0), a2, 0, lnx);
            PG8_WAIT_V(8); PG8_WAIT_L(0); PG8_BAR; if (do1) { PG8_MMA(1, 0, At, B0); PG8_MMA(1, 1, At, B1); } PG8_BAR; PG8_SCHED;
            PG8_LDB(B0, 1, 0); PG8_LDB(B1, 1, 1); PG8_SCHED; PG8_LDA(At, 1, 0); PG8_STAGE_A(PG8_SA(0, 1), a2, 1, lnx);
            PG8_WAIT_V(8); PG8_WAIT_L(0); PG8_BAR; if (do0) { PG8_MMA(0, 0, At, B0); PG8_MMA(0, 1, At, B1); } PG8_BAR; PG8_SCHED;
            PG8_LDA(At, 1, 1); PG8_STAGE(PG8_SB(1, 0), b3, voffB); PG8_STAGE(PG8_SB(1, 1), b3 + hstepB, voffB); PG8_STAGE_A(PG8_SA(1, 0), a3, 0, lnx);
            PG8_WAIT_V(8); PG8_WAIT_L(0); PG8_BAR; if (do1) { PG8_MMA(1, 0, At, B0); PG8_MMA(1, 1, At, B1); } PG8_BAR; PG8_SCHED;
        }
        if constexpr (ALIGN_EPI) { if (wr == 0) PG8_BAR; }
        E(acc, cur, wr, wc, fr, fq);
        __builtin_amdgcn_s_waitcnt(0x0F70);
        if (!has_next) break;
        if (!E.keep(cur)) {
#pragma unroll
            for (int a = 0; a < 2; ++a)
#pragma unroll
                for (int b = 0; b < 2; ++b)
#pragma unroll
                    for (int m = 0; m < 4; ++m)
#pragma unroll
                        for (int n = 0; n < 2; ++n) acc[a][b][m][n] = (f32x4){0.f, 0.f, 0.f, 0.f};
        }
        cur = nxt; cA = nA; cB = nB; ++ui;
        if constexpr (GATHER) {
#pragma unroll
            for (int hh = 0; hh < 2; ++hh) { vc[hh][0] = vn[hh][0]; vc[hh][1] = vn[hh][1]; }
        }
        if constexpr (ALIGN_EPI) { if (wr == 1) PG8_BAR; }
    }
    PG8_WAIT_V(0);
    if constexpr (!ALIGN_EPI) { if (wr == 0) PG8_BAR; }
    PG8_BAR;
#undef PG8_SA
#undef PG8_SB
#undef PG8_STAGE
#undef PG8_STAGE_A
#undef PG8_LDA
#undef PG8_LDB
#undef PG8_MMA
#undef PG8_WAIT_V
#undef PG8_WAIT_L
#undef PG8_BAR
#undef PG8_SCHED
}
}

#define XB_TMO      128
#define XB_XCNT(j)  (256  + 64 * (j))
#define XB_XSUB(j)  (1280 + 64 * (j))
#define XB_XGEN(j)  (2304 + 64 * (j))
#define XB_TOP      3328
#define XB_TOPGEN   3392
#define XCD_BAR_WORDS 3456
#define XB_SPIN_CAP (1u << 20)
__device__ __forceinline__ unsigned xb_ld(unsigned* p)              { return __hip_atomic_load(p, __ATOMIC_RELAXED, __HIP_MEMORY_SCOPE_AGENT); }
__device__ __forceinline__ unsigned xb_add(unsigned* p, unsigned v) { return __hip_atomic_fetch_add(p, v, __ATOMIC_RELAXED, __HIP_MEMORY_SCOPE_AGENT); }
__device__ __forceinline__ unsigned xb_xcc_id() { return (unsigned)__builtin_amdgcn_s_getreg((3 << 11) | 20) & 0xFu; }
#define XB_SPIN(cond, bar) do { unsigned _sp = 0; while (cond) { __builtin_amdgcn_s_sleep(1); \
    if ((++_sp & 255u) == 0u) { if (xb_ld(&(bar)[XB_TMO])) break; if (_sp > XB_SPIN_CAP) { atomicAdd(&(bar)[XB_TMO], 1u); break; } } } } while (0)
struct XcdBarrier { unsigned* bar; unsigned x; volatile LAS unsigned* st; };
__device__ __forceinline__ XcdBarrier xcd_barrier_post(unsigned* bar, volatile LAS unsigned* st) {
    XcdBarrier b; b.bar = bar; b.x = xb_xcc_id(); b.st = st;
    if (threadIdx.x == 0) (void)xb_add(&bar[XB_XCNT(b.x)], 1u);
    return b;
}
__device__ __forceinline__ void xcd_barrier_complete(unsigned* bar, unsigned x, unsigned& nloc, unsigned& nx) {
    const unsigned G = gridDim.x * gridDim.y * gridDim.z;
    unsigned sum, cnt, mine, sp = 0u;
    for (;;) {
        sum = 0u; cnt = 0u; mine = 0u;
#pragma unroll
        for (unsigned j = 0; j < 16; ++j) { const unsigned c = xb_ld(&bar[XB_XCNT(j)]); sum += c; cnt += (c > 0u) ? 1u : 0u; mine = (j == x) ? c : mine; }
        if (sum == G) break;
        __builtin_amdgcn_s_sleep(1);
        if ((++sp & 255u) == 0u) { if (xb_ld(&bar[XB_TMO])) break; if (sp > XB_SPIN_CAP) { atomicAdd(&bar[XB_TMO], 1u); break; } }
    }
    nloc = mine > 0u ? mine : 1u; nx = cnt > 0u ? cnt : 1u;
}
__device__ __forceinline__ void xcd_barrier(const XcdBarrier& b) {
    asm volatile("s_waitcnt vmcnt(0)" ::: "memory");
    __syncthreads();
    if (threadIdx.x == 0) {
        unsigned* bar = b.bar;
        __builtin_amdgcn_s_waitcnt(0);
        unsigned nloc = b.st[0], nx = b.st[1];
        if (nloc == 0u) { xcd_barrier_complete(bar, b.x, nloc, nx); b.st[0] = nloc; b.st[1] = nx; }
        const unsigned old = xb_add(&bar[XB_XSUB(b.x)], 1u);
        const unsigned gen = old / nloc;
        if (old + 1u == (gen + 1u) * nloc) {
            __builtin_amdgcn_fence(__ATOMIC_RELEASE, "agent");
            asm volatile("s_waitcnt vmcnt(0)" ::: "memory");
            const unsigned og = xb_add(&bar[XB_TOP], 1u);
            const unsigned tg = og / nx;
            if (og + 1u == (tg + 1u) * nx) xb_add(&bar[XB_TOPGEN], 1u);
            else XB_SPIN(xb_ld(&bar[XB_TOPGEN]) == tg, bar);
            __builtin_amdgcn_fence(__ATOMIC_ACQUIRE, "agent");
            asm volatile("s_waitcnt vmcnt(0)" ::: "memory");
        } else {
            XB_SPIN(xb_ld(&bar[XB_TOPGEN]) == gen, bar);
            __builtin_amdgcn_fence(__ATOMIC_ACQUIRE, "agent");
            asm volatile("s_waitcnt vmcnt(0)" ::: "memory");
        }
    }
    __syncthreads();
}

struct Ctx {
    LAS unsigned char* lds;
    int tid, lane, wave, wg, G;
    const float *x, *c, *w_ada, *b_ada, *g1, *w_in, *lb_logits, *g_hgrn, *w_pa, *w_pb, *w_out, *g2, *w_router, *rbias, *w_egu, *w_edown, *w_sgu, *w_sdown, *g_final;
    const int* positions;
    float* out;
    unsigned char* ws;
};
#define WSP(type, off) ((type*)(X.ws + (off)))

__device__ __forceinline__ void transpose_item(const float* W, int K, int N, bf16_t* WT, int dst_row0, int src_col0, int k0, LAS float* scr, int lane) {
#pragma unroll 16
    for (int i = 0; i < 32; ++i) { const int kk = 2 * i + (lane >> 5); scr[kk * 33 + (lane & 31)] = W[(size_t)(k0 + kk) * N + src_col0 + (lane & 31)]; }
    LDS_WAIT(); asm volatile("" ::: "memory");
    const int c = lane & 7;
#pragma unroll
    for (int j = 0; j < 4; ++j) { const int n = (lane >> 3) + 8 * j; const LAS float* s = scr + (8 * c) * 33 + n;
        u32x4 o; o.x = pk2(s[0 * 33], s[1 * 33]); o.y = pk2(s[2 * 33], s[3 * 33]); o.z = pk2(s[4 * 33], s[5 * 33]); o.w = pk2(s[6 * 33], s[7 * 33]);
        *(u32x4*)(WT + (size_t)(dst_row0 + n) * K + k0 + 8 * c) = o; }
    LDS_WAIT(); asm volatile("" ::: "memory");
}
__device__ __forceinline__ void transpose_plain(const float* W, int K, int N, bf16_t* WT, int item, LAS float* scr, int lane) {
    const int nblk = N / 32, kb = item / nblk, nb = item % nblk;
    transpose_item(W, K, N, WT, nb * 32, nb * 32, kb * 64, scr, lane);
}
__device__ __forceinline__ void p0_prologue(Ctx& X) {
    LAS float* scr = (LAS float*)(X.lds + X.wave * 16384);
    const int gw = X.wg * NWAVES + X.wave, NGW = X.G * NWAVES;
    {
        float* MODP = WSP(float, WS_MODP);
        for (int it = gw; it < 96 * 16; it += NGW) {
            const int jc = it % 96, kc = it / 96, j = jc * 64 + X.lane;
            float a0 = 0.f, a1 = 0.f, a2 = 0.f, a3 = 0.f;
#pragma unroll 16
            for (int kk = 0; kk < 64; ++kk) { const int k = kc * 64 + kk; const float w = X.w_ada[(size_t)k * 6144 + j];
                const float c0 = X.c[k], c1 = X.c[1024 + k], c2 = X.c[2048 + k], c3 = X.c[3072 + k];
                a0 += c0 * sigmoidf_(c0) * w; a1 += c1 * sigmoidf_(c1) * w; a2 += c2 * sigmoidf_(c2) * w; a3 += c3 * sigmoidf_(c3) * w; }
            float* o = MODP + (size_t)kc * 24576 + j;
            o[0] = a0; o[6144] = a1; o[12288] = a2; o[18432] = a3;
        }
    }
    {
        float* ROPE = WSP(float, WS_ROPE);
        const int gt = X.wg * NTHREADS + X.tid, NGT = X.G * NTHREADS;
        for (int idx = gt; idx < T * 8; idx += NGT) { const int t = idx >> 3, i = idx & 7;
            const float inv_freq = 1.0f / powf(500000.0f, (float)(2 * i) / 16.0f);
            const float ang = (float)X.positions[t] * inv_freq;
            ROPE[t * 16 + i] = cosf(ang); ROPE[t * 16 + 8 + i] = sinf(ang); }
        if (X.wg == 0) { float* LB = WSP(float, WS_LB);
            for (int j = X.tid; j < 512; j += NTHREADS) { const float l0 = X.lb_logits[j], l1 = X.lb_logits[512 + j], m = fmaxf(l0, l1), e0 = __expf(l0 - m), e1 = __expf(l1 - m); LB[j] = e0 / (e0 + e1); } }
    }
}
struct CvtItem { const float* src; bf16_t* dst; };
template <bool GU> __device__ __forceinline__ CvtItem cvt_item(const Ctx& X, int it) {
    CvtItem c;
    if constexpr (GU) { const int e = it >> 7, q = it & 127, w8 = q & 7, sq = q >> 3, kb = 4 * (sq >> 2) + (w8 & 3), nb = 2 * (sq & 3) + (w8 >> 2);
        const int n0 = nb * 64, pn = n0 >> 8, bj = (n0 >> 7) & 1, idx = n0 & 127, srcc = bj * 256 + pn * 128 + idx;
        const float* W = (e < NE) ? X.w_egu + (size_t)e * 1024 * 512 : X.w_sgu;
        c.src = W + (size_t)(kb * 64) * 512 + srcc; c.dst = (bf16_t*)(X.ws + WS_WGU + ((size_t)e * 512 + n0) * 1024 + kb * 64); }
    else { const int e = it >> 6, q = it & 63, w8 = q & 7, sq = q >> 3, kb = w8 & 3, nb = 2 * sq + (w8 >> 2);
        const float* W = (e < NE) ? X.w_edown + (size_t)e * 256 * 1024 : X.w_sdown;
        c.src = W + (size_t)(kb * 64) * 1024 + nb * 64; c.dst = (bf16_t*)(X.ws + WS_WD + ((size_t)e * 1024 + nb * 64) * 256 + kb * 64); }
    return c;
}
template <int KB> __device__ __forceinline__ void cvt_store8(const CvtItem& c, int lane, const f32x4 (&v)[16], LAS unsigned char* tl, float sc) {
    const int kq = lane >> 4, nq = lane & 15;
#pragma unroll
    for (int i = 0; i < 4; ++i) { u32x4 w;
        w.x = pk4_fp8(v[0][i] * sc, v[1][i] * sc, v[2][i] * sc, v[3][i] * sc); w.y = pk4_fp8(v[4][i] * sc, v[5][i] * sc, v[6][i] * sc, v[7][i] * sc);
        w.z = pk4_fp8(v[8][i] * sc, v[9][i] * sc, v[10][i] * sc, v[11][i] * sc); w.w = pk4_fp8(v[12][i] * sc, v[13][i] * sc, v[14][i] * sc, v[15][i] * sc);
        *(LAS u32x4*)(tl + (4 * nq + i) * 80 + kq * 16) = w; }
    LDS_WAIT(); asm volatile("" ::: "memory");
    const int ch = lane & 3, r = lane >> 2;
    unsigned char* d8 = (unsigned char*)c.dst;
#pragma unroll
    for (int j = 0; j < 4; ++j) { const int n = 16 * j + r; const u32x4 w = *(const LAS u32x4*)(tl + n * 80 + ch * 16); __builtin_nontemporal_store(w, (u32x4*)(d8 + (size_t)n * KB + 16 * ch)); }
    LDS_WAIT(); asm volatile("" ::: "memory");
}
template <int N> __device__ __forceinline__ void cvt_load(const CvtItem& c, int lane, f32x4 (&v)[16]) {
    const float* p = c.src + (size_t)(16 * (lane >> 4)) * N + 4 * (lane & 15);
#pragma unroll
    for (int j = 0; j < 16; ++j) v[j] = __builtin_nontemporal_load((const f32x4*)(p + (size_t)j * N));
}
template <int K> __device__ __forceinline__ void cvt_store(const CvtItem& c, int lane, const f32x4 (&v)[16], LAS unsigned char* tl) {
    const int kq = lane >> 4, nq = lane & 15;
#pragma unroll
    for (int i = 0; i < 4; ++i) { u32x4 w0, w1;
        w0.x = pk2(v[0][i], v[1][i]); w0.y = pk2(v[2][i], v[3][i]); w0.z = pk2(v[4][i], v[5][i]); w0.w = pk2(v[6][i], v[7][i]);
        w1.x = pk2(v[8][i], v[9][i]); w1.y = pk2(v[10][i], v[11][i]); w1.z = pk2(v[12][i], v[13][i]); w1.w = pk2(v[14][i], v[15][i]);
        LAS unsigned char* q = tl + (4 * nq + i) * 144 + kq * 32; *(LAS u32x4*)q = w0; *(LAS u32x4*)(q + 16) = w1; }
    LDS_WAIT(); asm volatile("" ::: "memory");
    const int ch = lane & 7, r = lane >> 3;
#pragma unroll
    for (int j = 0; j < 8; ++j) { const int n = 8 * j + r; const u32x4 w = *(const LAS u32x4*)(tl + n * 144 + ch * 16); __builtin_nontemporal_store(w, (u32x4*)(c.dst + (size_t)n * K + 8 * ch)); }
    LDS_WAIT(); asm volatile("" ::: "memory");
}
struct CvtPair { const float* src; unsigned char* dst; };
template <bool GU> __device__ __forceinline__ CvtPair cvt_pair(const Ctx& X, int di) {
    CvtPair c;
    if constexpr (GU) { const int e = di >> 6, q = di & 63, nb = q & 7, kb2 = q >> 3;
        const int n0 = nb * 64, pn = n0 >> 8, bj = (n0 >> 7) & 1, idx = n0 & 127, srcc = bj * 256 + pn * 128 + idx;
        const float* W = (e < NE) ? X.w_egu + (size_t)e * 1024 * 512 : X.w_sgu;
        c.src = W + (size_t)(kb2 * 128) * 512 + srcc; c.dst = X.ws + WS_WGU + ((size_t)e * 512 + n0) * 1024 + kb2 * 128; }
    else { const int e = di >> 5, q = di & 31, nb = q & 15, kb2 = q >> 4;
        const float* W = (e < NE) ? X.w_edown + (size_t)e * 256 * 1024 : X.w_sdown;
        c.src = W + (size_t)(kb2 * 128) * 1024 + nb * 64; c.dst = X.ws + WS_WD + ((size_t)e * 1024 + nb * 64) * 256 + kb2 * 128; }
    return c;
}
template <int N> __device__ __forceinline__ void cvt_load_half(const CvtPair& c, int half, int lane, f32x4 (&v)[16]) {
    const float* p = c.src + (size_t)(64 * half + 16 * (lane >> 4)) * N + 4 * (lane & 15);
#pragma unroll
    for (int j = 0; j < 16; ++j) v[j] = __builtin_nontemporal_load((const f32x4*)(p + (size_t)j * N));
}
__device__ __forceinline__ void cvt_half_to_lds(int half, int lane, const f32x4 (&v)[16], LAS unsigned char* tl, float sc) {
    const int kq = lane >> 4, nq = lane & 15;
#pragma unroll
    for (int i = 0; i < 4; ++i) { u32x4 w;
        w.x = pk4_fp8(v[0][i] * sc, v[1][i] * sc, v[2][i] * sc, v[3][i] * sc); w.y = pk4_fp8(v[4][i] * sc, v[5][i] * sc, v[6][i] * sc, v[7][i] * sc);
        w.z = pk4_fp8(v[8][i] * sc, v[9][i] * sc, v[10][i] * sc, v[11][i] * sc); w.w = pk4_fp8(v[12][i] * sc, v[13][i] * sc, v[14][i] * sc, v[15][i] * sc);
        *(LAS u32x4*)(tl + (4 * nq + i) * 144 + half * 64 + kq * 16) = w; }
}
template <int KB> __device__ __forceinline__ void cvt_flush(const CvtPair& c, int lane, LAS unsigned char* tl) {
    LDS_WAIT(); asm volatile("" ::: "memory");
    const int ch = lane & 7, r = lane >> 3;
#pragma unroll
    for (int j = 0; j < 8; ++j) { const int n = 8 * j + r; const u32x4 w = *(const LAS u32x4*)(tl + n * 144 + ch * 16); __builtin_nontemporal_store(w, (u32x4*)(c.dst + (size_t)n * KB + 16 * ch)); }
    LDS_WAIT(); asm volatile("" ::: "memory");
}
template <bool GU> __device__ __forceinline__ void expert_convert_set(Ctx& X, int gw, int NGW, LAS unsigned char* tl) {
    constexpr int NIT = GU ? NEX * 64 : NEX * 32, N = GU ? 512 : 1024, K = GU ? 1024 : 256; constexpr float SC = GU ? WGU_SCALE : WD_SCALE;
    if (gw >= NIT) return;
    const int nmine = (NIT - gw + NGW - 1) / NGW;
    f32x4 va[16], vb[16];
    CvtPair cur = cvt_pair<GU>(X, gw);
    cvt_load_half<N>(cur, 0, X.lane, va); cvt_load_half<N>(cur, 1, X.lane, vb);
    for (int j = 0; j < nmine; ++j) {
        const CvtPair nxt = cvt_pair<GU>(X, gw + (j + 1 < nmine ? j + 1 : j) * NGW);
        __builtin_amdgcn_sched_barrier(0);
        cvt_half_to_lds(0, X.lane, va, tl, SC);
        __builtin_amdgcn_sched_barrier(0);
        cvt_load_half<N>(nxt, 0, X.lane, va);
        __builtin_amdgcn_sched_barrier(0);
        cvt_half_to_lds(1, X.lane, vb, tl, SC);
        cvt_flush<K>(cur, X.lane, tl);
        __builtin_amdgcn_sched_barrier(0);
        cvt_load_half<N>(nxt, 1, X.lane, vb);
        __builtin_amdgcn_sched_barrier(0);
        cur = nxt;
    }
}
__device__ __forceinline__ void expert_convert(Ctx& X, int cw, int ncw) {
    LAS unsigned char* tl = X.lds + X.wave * 16384;
    const int gw = cw * NWAVES + X.wave, NGW = ncw * NWAVES;
    expert_convert_set<true>(X, gw, NGW, tl);
    expert_convert_set<false>(X, gw, NGW, tl);
}

__device__ __forceinline__ void small_transposes(Ctx& X) {
    LAS float* scr = (LAS float*)(X.lds + 16384 + X.wave * 12288);
    const int gw = X.wg * NWAVES + X.wave, NGW = X.G * NWAVES;
    {
        constexpr int I_IN = 16 * 272, I_PA = 8 * 32, I_PB = 8 * 32, I_OUT = 16 * 32, I_R = 16 * 8;
        constexpr int NITEMS = I_IN + I_PA + I_PB + I_OUT + I_R;
        for (int it = gw; it < NITEMS; it += NGW) {
            int r = it;
            if (r < I_IN) { transpose_plain(X.w_in, 1024, INW, WSP(bf16_t, WS_WIN), r, scr, X.lane); continue; } r -= I_IN;
            if (r < I_PA) { transpose_plain(X.w_pa, 512, 1024, WSP(bf16_t, WS_WPA), r, scr, X.lane); continue; } r -= I_PA;
            if (r < I_PB) { transpose_plain(X.w_pb, 512, 1024, WSP(bf16_t, WS_WPB), r, scr, X.lane); continue; } r -= I_PB;
            if (r < I_OUT) { transpose_plain(X.w_out, 1024, 1024, WSP(bf16_t, WS_WOUT), r, scr, X.lane); continue; } r -= I_OUT;
            transpose_plain(X.w_router, 1024, 256, WSP(bf16_t, WS_WR), r, scr, X.lane);
        }
    }
}

__device__ __forceinline__ void norm_rows(Ctx& X, int which) {
    LAS float* sm = (LAS float*)X.lds;
    const float* MODP = WSP(float, WS_MODP); float* MOD = WSP(float, WS_MOD);
    const int rows_per_wg = T / X.G, row0 = X.wg * rows_per_wg, b = row0 / SEQ;
    if (which == 0) {
        for (int i = X.tid; i < 2048; i += NTHREADS) { const int j = b * 6144 + i; float s = X.b_ada[i];
#pragma unroll
            for (int p = 0; p < 16; ++p) s += MODP[(size_t)p * 24576 + j];
            sm[i] = s; }
        const int per = 24576 / X.G;
        for (int i = X.tid; i < per; i += NTHREADS) { const int j = X.wg * per + i; float s = X.b_ada[j % 6144];
#pragma unroll
            for (int p = 0; p < 16; ++p) s += MODP[(size_t)p * 24576 + j];
            MOD[j] = s; }
    } else {
        for (int i = X.tid; i < 2048; i += NTHREADS) sm[i] = MOD[b * 6144 + 3072 + i];
    }
    __syncthreads();
    const float* src = X.x; const bf16_t* srcb = WSP(bf16_t, WS_X1); const float* g = which == 0 ? X.g1 : X.g2;
    bf16_t* H = WSP(bf16_t, WS_H);
    for (int r = X.wave; r < rows_per_wg; r += NWAVES) {
        const int row = row0 + r;
        f32x4 v[2][2]; float s = 0.f;
#pragma unroll
        for (int j = 0; j < 2; ++j) { const int col = 8 * X.lane + 512 * j;
            if (which == 0) { v[j][0] = *(const f32x4*)(src + (size_t)row * D + col); v[j][1] = *(const f32x4*)(src + (size_t)row * D + col + 4); }
            else { const u32x4 wv = *(const u32x4*)(srcb + (size_t)row * D + col); v[j][0] = (f32x4){bflo(wv.x), bfhi(wv.x), bflo(wv.y), bfhi(wv.y)}; v[j][1] = (f32x4){bflo(wv.z), bfhi(wv.z), bflo(wv.w), bfhi(wv.w)}; }
#pragma unroll
            for (int q = 0; q < 2; ++q) s += (v[j][q].x * v[j][q].x + v[j][q].y * v[j][q].y) + (v[j][q].z * v[j][q].z + v[j][q].w * v[j][q].w); }
        const float rstd = rsqrtf(wave_sum(s) * (1.f / D) + EPS);
#pragma unroll
        for (int j = 0; j < 2; ++j) { const int col = 8 * X.lane + 512 * j; float y[8];
#pragma unroll
            for (int q = 0; q < 2; ++q) { const f32x4 gg = *(const f32x4*)(g + col + 4 * q), sh = *(const LAS f32x4*)(sm + col + 4 * q), sc = *(const LAS f32x4*)(sm + 1024 + col + 4 * q);
#pragma unroll
                for (int e = 0; e < 4; ++e) y[4 * q + e] = v[j][q][e] * rstd * gg[e] * (1.f + sc[e]) + sh[e]; }
            u32x4 hw; hw.x = pk2(y[0], y[1]); hw.y = pk2(y[2], y[3]); hw.z = pk2(y[4], y[5]); hw.w = pk2(y[6], y[7]);
            if (which == 1) { st_wt16(H + (size_t)row * D + col, hw);
                st_wt8(WSP(unsigned char, WS_H8) + (size_t)row * D + col, (unsigned long long)pk4_fp8(y[0], y[1], y[2], y[3]) | ((unsigned long long)pk4_fp8(y[4], y[5], y[6], y[7]) << 32)); }
            else *(u32x4*)(H + (size_t)row * D + col) = hw; }
    }
    __syncthreads();
}

struct RegSched {
    static constexpr bool HALFSKIP = false;
    const char* A; const char* Bt; size_t a_tile, b_tile; int nM, nN, G, c;
    __device__ __forceinline__ bool next(int i, pg8::Unit& u) const {
        const int L = i * G + c; if (L >= nM * nN) return false;
        int pm, pn; pg8::swz_tile(L, nM, nN, pm, pn);
        u.a = A + (size_t)pm * a_tile; u.b = Bt + (size_t)pn * b_tile; u.rows = nullptr; u.pm = pm; u.pn = pn; u.aux = 0; u.nvalid = 256; return true;
    }
};
struct TwoPartSched {      static constexpr bool HALFSKIP = false;
    const char* Y; const char* Wa; const char* Wb; int nM, nN, G, c;
    __device__ __forceinline__ bool next(int i, pg8::Unit& u) const {
        const int L = (i >> 1) * G + c, part = i & 1; if (L >= nM * nN) return false;
        int pm, pn; pg8::swz_tile(L, nM, nN, pm, pn);
        u.a = Y + (size_t)pm * 256 * 2048 + part * 1024; u.b = (part ? Wb : Wa) + (size_t)pn * 256 * 1024; u.rows = nullptr; u.pm = pm; u.pn = pn; u.aux = part; u.nvalid = 256; return true;
    }
};
struct MoeSched {
    static constexpr bool HALFSKIP = true;
    const LAS int* tbl; const LAS int* cnts; int nent; const char* A; const char* W; const int* lists; int ncol  , wtile  , wexp  , atile  , G, c;
    __device__ __forceinline__ bool next(int i, pg8::Unit& u) const {
        const int un = i * (G >> 3) + (c >> 3); if (un >= nent * ncol) return false;
        const int pn = un % ncol; const int ent = __builtin_amdgcn_readfirstlane(tbl[un / ncol]), e = (ent >> 7) & 511, r = ent & 127, rt = ent >> 16;
        u.a = A + (size_t)rt * atile; u.b = W + (size_t)e * wexp + (size_t)pn * wtile; u.rows = lists + (size_t)e * 16384 + r * 256;
        u.pm = rt; u.pn = pn; u.aux = e; const int left = __builtin_amdgcn_readfirstlane(cnts[e]) - r * 256; u.nvalid = left < 256 ? left : 256; return true;
    }
};

struct EpiInproj {
    static constexpr bool PERM = true;
    bf16_t* PROJ; float* LOGF; const float* LB; const float* ROPE; unsigned char* G8; unsigned char* QK8;
    __device__ __forceinline__ bool keep(const pg8::Unit&) const { return false; }
    __device__ __forceinline__ void operator()(f32x4 (&acc)[2][2][4][2], const pg8::Unit& u, int wr, int wc, int fr, int fq) const {
        const int pn = u.pn;
        const int mode = pn < 2 ? 0 : pn < 4 ? 1 : pn < 6 ? 0 : pn < 8 ? 2 : pn < 20 ? 3 : pn < 26 ? 5 : 4;
        const int row0 = u.pm * 256 + wr * 64 + fr, colb = pn * 256 + wc * 32 + 8 * fq;
        const bool rot = (mode == 3) && ((wc & 1) == 0);
#pragma unroll
        for (int ai = 0; ai < 2; ++ai)
#pragma unroll
            for (int m = 0; m < 4; ++m) {
                const int row = row0 + ai * 128 + m * 16;
                f32x4 cs0, cs1, sn0, sn1;
                if (rot) { const f32x4* rp = (const f32x4*)(ROPE + (size_t)row * 16); cs0 = rp[0]; cs1 = rp[1]; sn0 = rp[2]; sn1 = rp[3]; }
#pragma unroll
                for (int bj = 0; bj < 2; ++bj) {
                    const int col = colb + bj * 128;
                    f32x4 v0 = acc[ai][bj][m][0], v1 = acc[ai][bj][m][1];
                    if (mode == 1) {
                        const int cf = col - 512; const f32x4 l0 = *(const f32x4*)(LB + cf), l1 = *(const f32x4*)(LB + cf + 4);
                        f32x4 lf0, lf1;
#pragma unroll
                        for (int j = 0; j < 4; ++j) { float sg = sigmoidf_(v0[j]); float f = l0[j] + (1.f - l0[j]) * sg; lf0[j] = __logf(f); v0[j] = (1.f - l0[j]) * (1.f - sg);
                            sg = sigmoidf_(v1[j]); f = l1[j] + (1.f - l1[j]) * sg; lf1[j] = __logf(f); v1[j] = (1.f - l1[j]) * (1.f - sg); }
                        acc[ai][bj][m][0] = lf0; acc[ai][bj][m][1] = lf1;
                    } else if (mode == 2) {
#pragma unroll
                        for (int j = 0; j < 4; ++j) { v0[j] = v0[j] * sigmoidf_(v0[j]); v1[j] = v1[j] * sigmoidf_(v1[j]); }
                    } else if (mode == 4) {
#pragma unroll
                        for (int j = 0; j < 4; ++j) { v0[j] = sigmoidf_(v0[j]); v1[j] = sigmoidf_(v1[j]); }
                    } else if (rot) {
                        f32x4 p0, p1;
#pragma unroll
                        for (int j = 0; j < 4; ++j) { p0[j] = __shfl_xor(v0[j], 16); p1[j] = __shfl_xor(v1[j], 16); }
                        if (fq == 0) { v0 = v0 * cs0 - p0 * sn0; v1 = v1 * cs1 - p1 * sn1; }
                        else if (fq == 1) { v0 = v0 * cs0 + p0 * sn0; v1 = v1 * cs1 + p1 * sn1; }
                    }
                    if (mode == 4) {
                        int g0 = 0, g1 = 0;
#pragma unroll
                        for (int j = 0; j < 4; ++j) { g0 = __builtin_amdgcn_cvt_pk_u8_f32(fmaxf(v0[j] * 255.0f, 1.0f), j, g0); g1 = __builtin_amdgcn_cvt_pk_u8_f32(fmaxf(v1[j] * 255.0f, 1.0f), j, g1); }
                        *(u32x2*)(G8 + (size_t)row * 2048 + (col - C_GA)) = (u32x2){(unsigned)g0, (unsigned)g1};
                        continue; }
                    if (mode == 3 || mode == 5) {
                        *(u32x2*)(QK8 + (size_t)row * 4608 + (col - C_AQ)) = (u32x2){pk4_fp8(v0[0], v0[1], v0[2], v0[3]), pk4_fp8(v1[0], v1[1], v1[2], v1[3])};
                        continue; }
                    u32x4 w; w.x = pg8::cvt_pk_bf16(v0[0], v0[1]); w.y = pg8::cvt_pk_bf16(v0[2], v0[3]); w.z = pg8::cvt_pk_bf16(v1[0], v1[1]); w.w = pg8::cvt_pk_bf16(v1[2], v1[3]);
                    *(u32x4*)(PROJ + (size_t)row * INW + col) = w;
                }
            }
        if (mode == 1) {
            const int lane = fq * 16 + fr;
#pragma unroll
            for (int ai = 0; ai < 2; ++ai)
#pragma unroll
                for (int bj = 0; bj < 2; ++bj)
#pragma unroll
                    for (int n = 0; n < 2; ++n)
#pragma unroll
                        for (int j = 0; j < 4; ++j) { float carry = 0.f;
#pragma unroll
                            for (int m = 0; m < 4; ++m) { float v = acc[ai][bj][m][n][j];
                                v += __builtin_bit_cast(float, __builtin_amdgcn_update_dpp(0, __builtin_bit_cast(int, v), 0x111, 0xF, 0xF, true));
                                v += __builtin_bit_cast(float, __builtin_amdgcn_update_dpp(0, __builtin_bit_cast(int, v), 0x112, 0xF, 0xF, true));
                                v += __builtin_bit_cast(float, __builtin_amdgcn_update_dpp(0, __builtin_bit_cast(int, v), 0x114, 0xF, 0xF, true));
                                v += __builtin_bit_cast(float, __builtin_amdgcn_update_dpp(0, __builtin_bit_cast(int, v), 0x118, 0xF, 0xF, true));
                                v += carry; acc[ai][bj][m][n][j] = v; carry = __shfl(v, (lane & 48) | 15); } }
#pragma unroll
            for (int ai = 0; ai < 2; ++ai)
#pragma unroll
                for (int m = 0; m < 4; ++m)
#pragma unroll
                    for (int bj = 0; bj < 2; ++bj) { float* lp = LOGF + (size_t)(row0 + ai * 128 + m * 16) * 512 + (colb + bj * 128 - 512); *(f32x4*)lp = acc[ai][bj][m][0]; *(f32x4*)(lp + 4) = acc[ai][bj][m][1]; }
        }
    }
};
__device__ __forceinline__ void gate8(u32x2 w, f32x4& lo, f32x4& hi) {
    constexpr float s = 1.0f / 255.0f;
    lo = (f32x4){(float)(w.x & 255u), (float)((w.x >> 8) & 255u), (float)((w.x >> 16) & 255u), (float)(w.x >> 24)} * s;
    hi = (f32x4){(float)(w.y & 255u), (float)((w.y >> 8) & 255u), (float)((w.y >> 16) & 255u), (float)(w.y >> 24)} * s;
}
struct EpiMixed {
    static constexpr bool PERM = true;
    const unsigned char* G8; bf16_t* MIXED;
    __device__ __forceinline__ bool keep(const pg8::Unit& u) const { return u.aux == 0; }
    __device__ __forceinline__ void operator()(f32x4 (&acc)[2][2][4][2], const pg8::Unit& u, int wr, int wc, int fr, int fq) const {
        const int row0 = u.pm * 256 + wr * 64 + fr, colb = u.pn * 256 + wc * 32 + 8 * fq;
#pragma unroll
        for (int ai = 0; ai < 2; ++ai)
#pragma unroll
            for (int m = 0; m < 4; ++m) {
                const int row = row0 + ai * 128 + m * 16;
#pragma unroll
                for (int bj = 0; bj < 2; ++bj) {
                    const int col = colb + bj * 128;
                    f32x4 b0, b1; gate8(*(const u32x2*)(G8 + (size_t)row * 2048 + 1024 + col), b0, b1);
                    if (u.aux == 0) {
                        f32x4 a0, a1; gate8(*(const u32x2*)(G8 + (size_t)row * 2048 + col), a0, a1);
#pragma unroll
                        for (int j = 0; j < 4; ++j) { acc[ai][bj][m][0][j] *= a0[j] / b0[j]; acc[ai][bj][m][1][j] *= a1[j] / b1[j]; }
                    } else {
                        const f32x4 v0 = acc[ai][bj][m][0] * b0, v1 = acc[ai][bj][m][1] * b1;
                        u32x4 w; w.x = pg8::cvt_pk_bf16(v0[0], v0[1]); w.y = pg8::cvt_pk_bf16(v0[2], v0[3]); w.z = pg8::cvt_pk_bf16(v1[0], v1[1]); w.w = pg8::cvt_pk_bf16(v1[2], v1[3]);
                        st_wt16(MIXED + (size_t)row * D + col, w);
                    }
                }
            }
    }
};
struct EpiOutproj {
    static constexpr bool PERM = true;
    const float* x; const float* MOD; bf16_t* X1;
    __device__ __forceinline__ bool keep(const pg8::Unit&) const { return false; }
    __device__ __forceinline__ void operator()(f32x4 (&acc)[2][2][4][2], const pg8::Unit& u, int wr, int wc, int fr, int fq) const {
        const int row0 = u.pm * 256 + wr * 64 + fr, colb = u.pn * 256 + wc * 32 + 8 * fq;
        const int b = (u.pm * 256) / SEQ;
#pragma unroll
        for (int bj = 0; bj < 2; ++bj) {
            const int col = colb + bj * 128;
            const f32x4 g0 = *(const f32x4*)(MOD + b * 6144 + 2048 + col), g1 = *(const f32x4*)(MOD + b * 6144 + 2048 + col + 4);
#pragma unroll
            for (int ai = 0; ai < 2; ++ai)
#pragma unroll
                for (int m = 0; m < 4; ++m) { const size_t off = (size_t)(row0 + ai * 128 + m * 16) * D + col;
                    const f32x4 v0 = *(const f32x4*)(x + off) + g0 * acc[ai][bj][m][0], v1 = *(const f32x4*)(x + off + 4) + g1 * acc[ai][bj][m][1];
                    u32x4 w; w.x = pg8::cvt_pk_bf16(v0[0], v0[1]); w.y = pg8::cvt_pk_bf16(v0[2], v0[3]); w.z = pg8::cvt_pk_bf16(v1[0], v1[1]); w.w = pg8::cvt_pk_bf16(v1[2], v1[3]);
                    st_wt16(X1 + off, w); }
        }
    }
};
struct EpiOutNorm {
    static constexpr bool PERM = true;
    const float* x; const float* MOD; const float* g2; bf16_t* X1; bf16_t* H; unsigned char* H8; float* XB; unsigned* cnt; LAS unsigned char* sl;
    __device__ __forceinline__ bool keep(const pg8::Unit&) const { return false; }
    __device__ __forceinline__ void operator()(f32x4 (&acc)[2][2][4][2], const pg8::Unit& u, int wr, int wc, int fr, int fq) const {
        const int tid = threadIdx.x;
        const int rl0 = wr * 64 + fr, row0 = u.pm * 256 + rl0, colb = u.pn * 256 + wc * 32 + 8 * fq;
        const int b = (u.pm * 256) / SEQ;
        LAS float* Pt = (LAS float*)sl; LAS float* Rs = (LAS float*)(sl + 4096);
#pragma unroll
        for (int bj = 0; bj < 2; ++bj) {
            const int col = colb + bj * 128;
            const f32x4 g0 = *(const f32x4*)(MOD + b * 6144 + 2048 + col), g1 = *(const f32x4*)(MOD + b * 6144 + 2048 + col + 4);
#pragma unroll
            for (int ai = 0; ai < 2; ++ai)
#pragma unroll
                for (int m = 0; m < 4; ++m) { const size_t off = (size_t)(row0 + ai * 128 + m * 16) * D + col;
                    acc[ai][bj][m][0] = *(const f32x4*)(x + off) + g0 * acc[ai][bj][m][0]; acc[ai][bj][m][1] = *(const f32x4*)(x + off + 4) + g1 * acc[ai][bj][m][1];
                    asm volatile("" : "+v"(acc[ai][bj][m][0]), "+v"(acc[ai][bj][m][1]));
                    if (m & 1) asm volatile("" ::: "memory"); }
        }
#pragma unroll
        for (int ai = 0; ai < 2; ++ai)
#pragma unroll
            for (int m = 0; m < 4; ++m) { float q = 0.f;
#pragma unroll
                for (int bj = 0; bj < 2; ++bj)
#pragma unroll
                    for (int n = 0; n < 2; ++n) { const f32x4 v = acc[ai][bj][m][n]; q += (v[0] * v[0] + v[1] * v[1]) + (v[2] * v[2] + v[3] * v[3]); }
                q += __shfl_xor(q, 16); q += __shfl_xor(q, 32);
                if (fq == 0) Pt[(ai * 128 + rl0 + m * 16) * 4 + wc] = q; }
        asm volatile("s_waitcnt lgkmcnt(0)" ::: "memory"); __builtin_amdgcn_s_barrier(); asm volatile("" ::: "memory");
        if (tid < 256) { const f32x4 p = *(const LAS f32x4*)(Pt + tid * 4); st_wt4(XB + ((size_t)u.pm * 256 + tid) * 4 + u.pn, __builtin_bit_cast(unsigned, (p[0] + p[1]) + (p[2] + p[3]))); }
        asm volatile("s_waitcnt vmcnt(0)" ::: "memory"); __builtin_amdgcn_s_barrier(); asm volatile("" ::: "memory");
        if (tid == 0) { unsigned* p = cnt + (size_t)u.pm * 64; (void)xb_add(p, 1u); unsigned sp = 0u;
            while (xb_ld(p) < 4u) { __builtin_amdgcn_s_sleep(2); if (++sp > (1u << 22)) break; }
            __builtin_amdgcn_fence(__ATOMIC_ACQUIRE, "agent"); asm volatile("s_waitcnt vmcnt(0)" ::: "memory"); }
        __builtin_amdgcn_s_barrier(); asm volatile("" ::: "memory");
        if (tid < 256) { const f32x4 q = *(const f32x4*)(XB + ((size_t)u.pm * 256 + tid) * 4); Rs[tid] = rsqrtf(((q[0] + q[1]) + (q[2] + q[3])) * (1.f / D) + EPS); }
        asm volatile("s_waitcnt vmcnt(0) lgkmcnt(0)" ::: "memory"); __builtin_amdgcn_s_barrier(); asm volatile("" ::: "memory");
#pragma unroll
        for (int bj = 0; bj < 2; ++bj) {
            const int col = colb + bj * 128;
            f32x4 gg[2], sc[2], sh[2];
#pragma unroll
            for (int q = 0; q < 2; ++q) { gg[q] = *(const f32x4*)(g2 + col + 4 * q); sh[q] = *(const f32x4*)(MOD + b * 6144 + 3072 + col + 4 * q); sc[q] = *(const f32x4*)(MOD + b * 6144 + 4096 + col + 4 * q) + 1.0f; gg[q] = gg[q] * sc[q]; }
#pragma unroll
            for (int ai = 0; ai < 2; ++ai)
#pragma unroll
                for (int m = 0; m < 4; ++m) { const int rl = ai * 128 + rl0 + m * 16; const size_t off = (size_t)(u.pm * 256 + rl) * D + col; const float rs = Rs[rl];
                    const f32x4 v0 = acc[ai][bj][m][0], v1 = acc[ai][bj][m][1];
                    u32x4 w; w.x = pg8::cvt_pk_bf16(v0[0], v0[1]); w.y = pg8::cvt_pk_bf16(v0[2], v0[3]); w.z = pg8::cvt_pk_bf16(v1[0], v1[1]); w.w = pg8::cvt_pk_bf16(v1[2], v1[3]);
                    *(u32x4*)(X1 + off) = w;
                    const f32x4 h0 = v0 * rs * gg[0] + sh[0], h1 = v1 * rs * gg[1] + sh[1];
                    u32x4 hw; hw.x = pg8::cvt_pk_bf16(h0[0], h0[1]); hw.y = pg8::cvt_pk_bf16(h0[2], h0[3]); hw.z = pg8::cvt_pk_bf16(h1[0], h1[1]); hw.w = pg8::cvt_pk_bf16(h1[2], h1[3]);
                    st_wt16(H + off, hw);
                    st_wt8(H8 + off, (unsigned long long)pk4_fp8(h0[0], h0[1], h0[2], h0[3]) | ((unsigned long long)pk4_fp8(h1[0], h1[1], h1[2], h1[3]) << 32));
                    asm volatile("" ::: "memory"); }
        }
    }
};
struct EpiRouter {
    static constexpr bool PERM = false;
    float* LOGITS4;
    __device__ __forceinline__ bool keep(const pg8::Unit&) const { return false; }
    __device__ __forceinline__ void operator()(f32x4 (&acc)[2][2][4][2], const pg8::Unit& u, int wr, int wc, int fr, int fq) const {
        const int row0 = u.pm * 256 + wr * 64 + fr, colb = wc * 32 + 4 * fq;
        float* base = LOGITS4 + (size_t)u.aux * T * 256;
#pragma unroll
        for (int ai = 0; ai < 2; ++ai)
#pragma unroll
            for (int m = 0; m < 4; ++m)
#pragma unroll
                for (int bj = 0; bj < 2; ++bj)
#pragma unroll
                    for (int n = 0; n < 2; ++n) st_wt16(base + (size_t)(row0 + ai * 128 + m * 16) * 256 + colb + bj * 128 + n * 16, __builtin_bit_cast(u32x4, acc[ai][bj][m][n]));
    }
};
struct RouterSched {
    static constexpr bool HALFSKIP = false;
    const char* A; const char* Bt; int G, c;
    __device__ __forceinline__ bool next(int i, pg8::Unit& u) const {
        const int L = i * G + c; if (L >= 256) return false;
        const int pm = L >> 2, ks = L & 3;
        u.a = A + (size_t)pm * 256 * 2048 + ks * 512; u.b = Bt + ks * 512; u.rows = nullptr; u.pm = pm; u.pn = 0; u.aux = ks; u.nvalid = 256; return true;
    }
};
struct EpiGU {
    static constexpr bool PERM = true;
    unsigned char* ACT;
    __device__ __forceinline__ bool keep(const pg8::Unit&) const { return false; }
    __device__ __forceinline__ void operator()(f32x4 (&acc)[2][2][4][2], const pg8::Unit& u, int wr, int wc, int fr, int fq) const {
        const int rl0 = wr * 64 + fr, col = u.pn * 128 + wc * 32 + 8 * fq;
        constexpr float is = 1.0f / WGU_SCALE;
#pragma unroll
        for (int ai = 0; ai < 2; ++ai)
#pragma unroll
            for (int m = 0; m < 4; ++m) {
                const int rl = rl0 + ai * 128 + m * 16;
                f32x4 v0, v1;
#pragma unroll
                for (int j = 0; j < 4; ++j) { const float a0 = acc[ai][0][m][0][j] * is, a1 = acc[ai][0][m][1][j] * is;
                    v0[j] = a0 * sigmoidf_(a0) * (acc[ai][1][m][0][j] * is); v1[j] = a1 * sigmoidf_(a1) * (acc[ai][1][m][1][j] * is); }
                *(u32x2*)(ACT + ((size_t)u.pm * 256 + rl) * EFF + col) = (u32x2){pk4_fp8(v0[0], v0[1], v0[2], v0[3]), pk4_fp8(v1[0], v1[1], v1[2], v1[3])};
                asm volatile("" ::: "memory");
            }
    }
};
struct EpiDown {
    static constexpr bool PERM = true;
    unsigned char* YBUF; const float* GATEW;
    __device__ __forceinline__ bool keep(const pg8::Unit&) const { return false; }
    __device__ __forceinline__ void operator()(f32x4 (&acc)[2][2][4][2], const pg8::Unit& u, int wr, int wc, int fr, int fq) const {
        const int rl0 = wr * 64 + fr, colb = u.pn * 256 + wc * 32 + 8 * fq;
#pragma unroll
        for (int ai = 0; ai < 2; ++ai)
#pragma unroll
            for (int m = 0; m < 4; ++m) {
                const int rl = rl0 + ai * 128 + m * 16;
                if (rl < u.nvalid) {
                    const int slot = u.rows[rl]; const float gw = GATEW[slot] * (YSCALE / WD_SCALE);
#pragma unroll
                    for (int bj = 0; bj < 2; ++bj) { const f32x4 v0 = acc[ai][bj][m][0] * gw, v1 = acc[ai][bj][m][1] * gw;
                        *(u32x2*)(YBUF + (size_t)slot * D + colb + bj * 128) = (u32x2){pk4_fp8(v0[0], v0[1], v0[2], v0[3]), pk4_fp8(v1[0], v1[1], v1[2], v1[3])}; }
                }
                asm volatile("" ::: "memory");
            }
    }
};

#define MFMA16(a, b, c) __builtin_amdgcn_mfma_f32_16x16x32_bf16((a), (b), (c), 0, 0, 0)
#define MFMA32(a, b, c) __builtin_amdgcn_mfma_f32_32x32x16_bf16((a), (b), (c), 0, 0, 0)
__device__ __forceinline__ s16x4 tr16(const LAS unsigned char* p) { return __builtin_amdgcn_ds_read_tr16_b64_v4i16((LAS s16x4*)p); }
__device__ __forceinline__ bf16x8 cat8(s16x4 a, s16x4 b) { bf16x8 r; r[0] = a[0]; r[1] = a[1]; r[2] = a[2]; r[3] = a[3]; r[4] = b[0]; r[5] = b[1]; r[6] = b[2]; r[7] = b[3]; return r; }
__device__ __forceinline__ u32x4 pack8(const float (&v)[8]) { u32x4 w; w.x = pg8::cvt_pk_bf16(v[0], v[1]); w.y = pg8::cvt_pk_bf16(v[2], v[3]); w.z = pg8::cvt_pk_bf16(v[4], v[5]); w.w = pg8::cvt_pk_bf16(v[6], v[7]); return w; }
__device__ __forceinline__ void unpack8(u32x4 w, float (&v)[8]) { v[0] = bflo(w.x); v[1] = bfhi(w.x); v[2] = bflo(w.y); v[3] = bfhi(w.y); v[4] = bflo(w.z); v[5] = bfhi(w.z); v[6] = bflo(w.w); v[7] = bfhi(w.w); }
__device__ __forceinline__ int swzA(int row) { return (row & 3) | (((row >> 3) & 1) << 2); }
__device__ __forceinline__ void hgrn_kv_unit(Ctx& X, int bn) {
    const int t0 = bn * 64;
    const bf16_t* PROJ = WSP(bf16_t, WS_PROJ); const float* BC = WSP(float, WS_LOGF);
#pragma unroll 2
    for (int j = 0; j < 8; ++j) {
        const int p = X.tid + NTHREADS * j, row = p >> 6, c64 = p & 63, h = c64 >> 4, ch = c64 & 15;
        const size_t prow = (size_t)(t0 + row) * INW + h * 128 + 8 * ch;
        const u32x4 kraw = *(const u32x4*)(PROJ + prow + C_HK), vraw = *(const u32x4*)(PROJ + prow + C_HV);
        const float* bp = BC + (size_t)(t0 + row) * 512 + h * 128 + 8 * ch; const float* bl = BC + (size_t)(t0 + 63) * 512 + h * 128 + 8 * ch;
        const f32x4 b0 = *(const f32x4*)bp, b1 = *(const f32x4*)(bp + 4), l0 = *(const f32x4*)bl, l1 = *(const f32x4*)(bl + 4);
        float kv[8]; unpack8(kraw, kv);
#pragma unroll
        for (int e = 0; e < 4; ++e) { kv[e] *= __expf(l0[e] - b0[e]); kv[4 + e] *= __expf(l1[e] - b1[e]); }
        const int off = row * 256 + (((ch >> 1) ^ swzA(row)) * 32) + (ch & 1) * 16;
        *(LAS u32x4*)(X.lds + h * 32768 + off) = vraw; *(LAS u32x4*)(X.lds + h * 32768 + 16384 + off) = pack8(kv);
    }
    WSP(float, WS_DECAY)[bn * 512 + X.tid] = __expf(BC[(size_t)(t0 + 63) * 512 + X.tid]);
    __syncthreads();
    const int l = X.lane, w = X.wave, fr = l & 15, fq = l >> 4, r = fr >> 2, p4 = l & 3, h = w >> 1, vt0 = 4 * (w & 1);
    const LAS unsigned char* VI = X.lds + h * 32768; const LAS unsigned char* KI = VI + 16384;
    bf16x8 af[4][2];
#pragma unroll
    for (int vt = 0; vt < 4; ++vt)
#pragma unroll
        for (int kk = 0; kk < 2; ++kk) { const int r0 = 32 * kk + 8 * fq + r, r1 = r0 + 4;
            af[vt][kk] = cat8(tr16(VI + r0 * 256 + (((vt0 + vt) ^ swzA(r0)) * 32) + p4 * 8), tr16(VI + r1 * 256 + (((vt0 + vt) ^ swzA(r1)) * 32) + p4 * 8)); }
    bf16_t* KVT = WSP(bf16_t, WS_KVT) + (size_t)(bn * 4 + h) * 16384;
#pragma unroll 2
    for (int ct = 0; ct < 8; ++ct) {
        bf16x8 bfr[2];
#pragma unroll
        for (int kk = 0; kk < 2; ++kk) { const int r0 = 32 * kk + 8 * fq + r, r1 = r0 + 4;
            bfr[kk] = cat8(tr16(KI + r0 * 256 + ((ct ^ swzA(r0)) * 32) + p4 * 8), tr16(KI + r1 * 256 + ((ct ^ swzA(r1)) * 32) + p4 * 8)); }
#pragma unroll
        for (int vt = 0; vt < 4; ++vt) { f32x4 acc = {0.f, 0.f, 0.f, 0.f}; acc = MFMA16(bfr[0], af[vt][0], acc); acc = MFMA16(bfr[1], af[vt][1], acc);
            u32x2 wv; wv.x = pg8::cvt_pk_bf16(acc[0], acc[1]); wv.y = pg8::cvt_pk_bf16(acc[2], acc[3]);
            *(u32x2*)(KVT + (16 * (vt0 + vt) + fr) * 128 + 16 * ct + 4 * fq) = wv; }
    }
    __syncthreads();
}
__device__ __forceinline__ void hgrn_passB(Ctx& X) {
    const unsigned* KVT = WSP(unsigned, WS_KVT); const float* DECAY = WSP(float, WS_DECAY); unsigned* SPT = WSP(unsigned, WS_SPT);
    const int gt = X.wg * NTHREADS + X.tid, NGT = X.G * NTHREADS;
    for (int item = gt; item < 16 * 128 * 64; item += NGT) {
        const int bh = item >> 13, rem = item & 8191, vd = rem >> 6, c = (rem & 63) * 2, b = bh >> 2, h = bh & 3;
        float s0 = 0.f, s1 = 0.f;
#pragma unroll 8
        for (int n = 0; n < 64; ++n) {
            const int unit = (b * 64 + n) * 4 + h;
            const unsigned kw = KVT[((size_t)unit * 16384 + vd * 128 + c) >> 1]; const f32x2 kv = {bflo(kw), bfhi(kw)};
            const f32x2 dc = *(const f32x2*)(DECAY + unit * 128 + c);
            SPT[((size_t)unit * 16384 + vd * 128 + c) >> 1] = pk2(s0, s1);
            s0 = dc.x * s0 + kv.x; s1 = dc.y * s1 + kv.y;
        }
    }
}
__device__ __forceinline__ void hgrn_out_unit(Ctx& X, int u2) {
    const int bn = u2 >> 1, hp = u2 & 1, t0 = bn * 64;
    const bf16_t* PROJ = WSP(bf16_t, WS_PROJ); const float* BCg = WSP(float, WS_LOGF);
#pragma unroll 2
    for (int j = 0; j < 4; ++j) { const int p = X.tid + NTHREADS * j, row = p >> 5, c32 = p & 31, hh = c32 >> 4, ch = c32 & 15, h = 2 * hp + hh;
        const size_t prow = (size_t)(t0 + row) * INW + h * 128 + 8 * ch;
        const u32x4 qraw = *(const u32x4*)(PROJ + prow + C_HQ), kraw = *(const u32x4*)(PROJ + prow + C_HK), vraw = *(const u32x4*)(PROJ + prow + C_HV);
        const float* bp = BCg + (size_t)(t0 + row) * 512 + h * 128 + 8 * ch; const float* br = BCg + (size_t)(t0 + 32) * 512 + h * 128 + 8 * ch;
        const f32x4 b0 = *(const f32x4*)bp, b1 = *(const f32x4*)(bp + 4), r0 = *(const f32x4*)br, r1 = *(const f32x4*)(br + 4);
        float qv[8], kv[8], a[8], bq[8]; unpack8(qraw, qv); unpack8(kraw, kv);
#pragma unroll
        for (int e = 0; e < 4; ++e) { const float e0 = __expf(b0[e] - r0[e]), e1 = __expf(b1[e] - r1[e]);
            a[e] = qv[e] * e0; a[4 + e] = qv[4 + e] * e1; kv[e] *= __builtin_amdgcn_rcpf(e0); kv[4 + e] *= __builtin_amdgcn_rcpf(e1);
            bq[e] = qv[e] * __expf(b0[e]); bq[4 + e] = qv[4 + e] * __expf(b1[e]); }
        LAS unsigned char* hb = X.lds + hh * 65536; const int o16 = row * 256 + ((ch ^ (row & 15)) * 16);
        *(LAS u32x4*)(hb + o16) = pack8(a); *(LAS u32x4*)(hb + 16384 + o16) = pack8(kv); *(LAS u32x4*)(hb + 32768 + o16) = pack8(bq);
        *(LAS u32x4*)(hb + 49152 + row * 256 + (((ch >> 1) ^ (row & 7)) * 32) + (ch & 1) * 16) = vraw; }
    const int l = X.lane, w = X.wave, fr = l & 15, fq = l >> 4, r = fr >> 2, p4 = l & 3, hh = w >> 2, h = 2 * hp + hh, ti = w & 3;
    const int tq = 16 * ti + fr;
    const bf16_t* SPT = WSP(bf16_t, WS_SPT) + (size_t)(bn * 4 + h) * 16384;
    __syncthreads();
    const LAS unsigned char* QSI = X.lds + hh * 65536; const LAS unsigned char* KSI = QSI + 16384; const LAS unsigned char* QNI = QSI + 32768; const LAS unsigned char* VI = QSI + 49152;
    bf16x8 QS[4];
#pragma unroll
    for (int ks = 0; ks < 4; ++ks) QS[ks] = *(const LAS bf16x8*)(QSI + tq * 256 + (((4 * ks + fq) ^ (tq & 15)) * 16));
    f32x4 ST[4];
#pragma unroll
    for (int si = 0; si < 4; ++si) {
        f32x4 acc = {0.f, 0.f, 0.f, 0.f};
        if (si <= ti) {
            const int sr = 16 * si + fr;
#pragma unroll
            for (int ks = 0; ks < 4; ++ks) { const bf16x8 kf = *(const LAS bf16x8*)(KSI + sr * 256 + (((4 * ks + fq) ^ (sr & 15)) * 16)); acc = MFMA16(kf, QS[ks], acc); }
            if (si == ti) {
#pragma unroll
                for (int q = 0; q < 4; ++q) acc[q] = (4 * fq + q <= fr) ? acc[q] : 0.f; }
        }
        ST[si] = acc;
    }
    f32x4 o[8];
#pragma unroll
    for (int vt = 0; vt < 8; ++vt) o[vt] = (f32x4){0.f, 0.f, 0.f, 0.f};
#pragma unroll
    for (int kk = 0; kk < 2; ++kk) {
        if (2 * kk <= ti) {
            float pv[8];
#pragma unroll
            for (int q = 0; q < 4; ++q) { pv[q] = ST[2 * kk][q]; pv[4 + q] = ST[2 * kk + 1][q]; }
            const bf16x8 pf = __builtin_bit_cast(bf16x8, pack8(pv));
            const int r0 = 32 * kk + 4 * fq + r, r1 = r0 + 16;
#pragma unroll
            for (int vt = 0; vt < 8; ++vt) { const bf16x8 va = cat8(tr16(VI + r0 * 256 + ((vt ^ (r0 & 7)) * 32) + p4 * 8), tr16(VI + r1 * 256 + ((vt ^ (r1 & 7)) * 32) + p4 * 8));
                o[vt] = MFMA16(va, pf, o[vt]); }
        }
    }
#pragma unroll
    for (int ks = 0; ks < 4; ++ks) { const bf16x8 qn = *(const LAS bf16x8*)(QNI + tq * 256 + (((4 * ks + fq) ^ (tq & 15)) * 16));
#pragma unroll
        for (int vt = 0; vt < 8; ++vt) { const bf16x8 sa = *(const bf16x8*)(SPT + (16 * vt + fr) * 128 + 32 * ks + 8 * fq); o[vt] = MFMA16(sa, qn, o[vt]); } }
    float ss = 0.f;
#pragma unroll
    for (int vt = 0; vt < 8; ++vt) ss += (o[vt][0] * o[vt][0] + o[vt][1] * o[vt][1]) + (o[vt][2] * o[vt][2] + o[vt][3] * o[vt][3]);
    ss += __shfl_xor(ss, 16); ss += __shfl_xor(ss, 32);
    const float rstd = rsqrtf(ss * (1.f / 128.f) + EPS);
    bf16_t* YCAT = WSP(bf16_t, WS_YCAT);
#pragma unroll
    for (int vt = 0; vt < 8; ++vt) { const int vd = 16 * vt + 4 * fq;
        const u32x2 sg = *(const u32x2*)(PROJ + (size_t)(t0 + tq) * INW + C_HG + h * 128 + vd); const f32x4 gn = *(const f32x4*)(X.g_hgrn + h * 128 + vd);
        u32x2 wv; wv.x = pg8::cvt_pk_bf16(o[vt][0] * rstd * gn[0] * bflo(sg.x), o[vt][1] * rstd * gn[1] * bfhi(sg.x)); wv.y = pg8::cvt_pk_bf16(o[vt][2] * rstd * gn[2] * bflo(sg.y), o[vt][3] * rstd * gn[3] * bfhi(sg.y));
        *(u32x2*)(YCAT + (size_t)(t0 + tq) * D + h * 128 + vd) = wv; }
    __syncthreads();
}

template <bool HI> __device__ __forceinline__ unsigned fp8x2_bf16_(unsigned w) { const auto f = __builtin_amdgcn_cvt_pk_f32_fp8((int)w, HI); return pg8::cvt_pk_bf16(f[0], f[1]); }
__device__ __forceinline__ unsigned fp8x2_bf16(unsigned w, bool hi) { return hi ? fp8x2_bf16_<true>(w) : fp8x2_bf16_<false>(w); }
struct AttnRegs { u32x4 k[3], v[3]; long q[4]; };
__device__ __forceinline__ void attn_load(Ctx& X, int unit, AttnRegs& R) {
    const int u16 = unit & 15, h = (unit >> 4) & 7, g = (unit >> 7) % 3, b = unit / 384;
    const int d = g == 0 ? 1 : g == 1 ? 4 : 16, nblk = 16 / d, r = u16 / nblk, blk = u16 % nblk;
    const int vcol = C_AV + g * 512 + h * 64;
    const int mk0 = blk * 256 - 128;
    const unsigned char* QK8 = WSP(unsigned char, WS_QK8);
    const int q8col = g * 512 + h * 64, k8col = 1536 + q8col, v8col = 3072 + q8col;
#pragma unroll
    for (int j = 0; j < 3; ++j) { const int idx = X.tid + NTHREADS * j, row = idx >> 2, ch = idx & 3, m = mk0 + row > 0 ? mk0 + row : 0;
        const size_t tok = (size_t)b * SEQ + (size_t)m * d + r; R.k[j] = *(const u32x4*)(QK8 + tok * 4608 + k8col + ch * 16); R.v[j] = *(const u32x4*)(QK8 + tok * 4608 + v8col + ch * 16); }
    const int l = X.lane, w = X.wave, q = l & 31, hi = l >> 5;
    const size_t tokq = (size_t)b * SEQ + (size_t)(blk * 256 + 32 * w + q) * d + r;
#pragma unroll
    for (int ds = 0; ds < 4; ++ds) R.q[ds] = *(const long*)(QK8 + tokq * 4608 + q8col + ds * 16 + hi * 8);
}
__device__ __forceinline__ void attn_stage(Ctx& X, const AttnRegs& R) {
    LAS unsigned char* KL = X.lds; LAS unsigned char* VL = X.lds + 55296;
#pragma unroll
    for (int j = 0; j < 3; ++j) { const int idx = X.tid + NTHREADS * j, row = idx >> 2, ch = idx & 3;
        *(LAS u32x4*)(KL + row * 80 + ch * 16) = R.k[j];
        u32x4 lo, hi2;
        lo.x = fp8x2_bf16(R.v[j].x, false); lo.y = fp8x2_bf16(R.v[j].x, true); lo.z = fp8x2_bf16(R.v[j].y, false); lo.w = fp8x2_bf16(R.v[j].y, true);
        hi2.x = fp8x2_bf16(R.v[j].z, false); hi2.y = fp8x2_bf16(R.v[j].z, true); hi2.z = fp8x2_bf16(R.v[j].w, false); hi2.w = fp8x2_bf16(R.v[j].w, true);
        *(LAS u32x4*)(VL + row * 128 + ch * 32) = lo; *(LAS u32x4*)(VL + row * 128 + ch * 32 + 16) = hi2; }
    LAS long* QL = (LAS long*)(X.lds + 104448 + X.tid * 32);
    QL[0] = R.q[0]; QL[1] = R.q[1]; QL[2] = R.q[2]; QL[3] = R.q[3];
}
__device__ __forceinline__ void attn_compute(Ctx& X, int unit) {
    const int u16 = unit & 15, h = (unit >> 4) & 7, g = (unit >> 7) % 3, b = unit / 384;
    const int d = g == 0 ? 1 : g == 1 ? 4 : 16, nblk = 16 / d, r = u16 / nblk, blk = u16 % nblk;
    const int mk0 = blk * 256 - 128;
    LAS unsigned char* KL = X.lds; LAS unsigned char* VL = X.lds + 55296;
    const int l = X.lane, w = X.wave, q = l & 31, hi = l >> 5;
    const size_t tokq = (size_t)b * SEQ + (size_t)(blk * 256 + 32 * w + q) * d + r;
    long qf[4];
    { const LAS long* QL = (const LAS long*)(X.lds + 104448 + X.tid * 32); qf[0] = QL[0]; qf[1] = QL[1]; qf[2] = QL[2]; qf[3] = QL[3]; }
    f32x16 s[5];
#pragma unroll
    for (int kt = 0; kt < 5; ++kt) {
        f32x16 acc;
#pragma unroll
        for (int i = 0; i < 16; ++i) acc[i] = 0.f;
#pragma unroll
        for (int ds = 0; ds < 4; ++ds) { const long kf = *(const LAS long*)(KL + (32 * w + 32 * kt + q) * 80 + ds * 16 + hi * 8); acc = __builtin_amdgcn_mfma_f32_32x32x16_fp8_fp8(kf, qf[ds], acc, 0, 0, 0); }
        s[kt] = acc;
    }
    const int iq = 32 * w + q;
    const int jmin = iq > -mk0 ? iq : -mk0;
    const int tlo = jmin - (32 * w + 4 * hi), thi = iq + 128 - (32 * w + 128 + 4 * hi), tst = -mk0 - (32 * w + 4 * hi);
    float mx = -INFINITY;
#pragma unroll
    for (int kt = 0; kt < 5; ++kt) {
        const bool chk = kt == 0 || kt == 4 || (32 * w + 32 * kt < -mk0);
        if (chk) {
#pragma unroll
            for (int rg = 0; rg < 16; ++rg) { const int c = (rg & 3) + 8 * (rg >> 2);
                const bool valid = kt == 0 ? (c >= tlo) : kt == 4 ? (c <= thi) : (c + 32 * kt >= tst);
                s[kt][rg] = valid ? s[kt][rg] : -INFINITY; if ((rg & 3) == 3) __builtin_amdgcn_sched_barrier(0); }
        }
#pragma unroll
        for (int rg = 0; rg < 16; ++rg) mx = fmaxf(mx, s[kt][rg]);
    }
    mx = fmaxf(mx, __shfl_xor(mx, 32));
    const float c2 = 0.125f * 1.4426950408889634f, mxs = mx * c2;
    float lsum = 0.f;
#pragma unroll
    for (int kt = 0; kt < 5; ++kt)
#pragma unroll
        for (int rg = 0; rg < 16; ++rg) { const float p = __builtin_amdgcn_exp2f(__builtin_fmaf(s[kt][rg], c2, -mxs)); s[kt][rg] = p; lsum += p; }
    lsum += __shfl_xor(lsum, 32);
    f32x16 o[2];
#pragma unroll
    for (int dt = 0; dt < 2; ++dt)
#pragma unroll
        for (int i = 0; i < 16; ++i) o[dt][i] = 0.f;
    const int vlane = ((l & 15) >> 2) * 128 + (((l >> 4) & 1) * 16 + (l & 3) * 4) * 2;
#pragma unroll
    for (int kt = 0; kt < 5; ++kt)
#pragma unroll
        for (int s2 = 0; s2 < 2; ++s2) {
            bf16x8 pb;
#pragma unroll
            for (int j = 0; j < 8; j += 2) { const unsigned pw = pg8::cvt_pk_bf16(s[kt][8 * s2 + j], s[kt][8 * s2 + j + 1]); pb[j] = (short)(pw & 0xffffu); pb[j + 1] = (short)(pw >> 16); }
            const int key0 = 32 * w + 32 * kt + 16 * s2 + 4 * hi;
#pragma unroll
            for (int dt = 0; dt < 2; ++dt) {
                LAS unsigned char* vp = VL + key0 * 128 + dt * 64 + vlane;
                const s16x4 t0 = __builtin_amdgcn_ds_read_tr16_b64_v4i16((LAS s16x4*)vp);
                const s16x4 t1 = __builtin_amdgcn_ds_read_tr16_b64_v4i16((LAS s16x4*)(vp + 8 * 128));
                bf16x8 va; va[0] = t0[0]; va[1] = t0[1]; va[2] = t0[2]; va[3] = t0[3]; va[4] = t1[0]; va[5] = t1[1]; va[6] = t1[2]; va[7] = t1[3];
                o[dt] = MFMA32(va, pb, o[dt]);
            }
        }
    const float inv = 1.0f / lsum;
    bf16_t* OG = WSP(bf16_t, WS_OG) + (size_t)g * T * 512;
#pragma unroll
    for (int dt = 0; dt < 2; ++dt)
#pragma unroll
        for (int rg = 0; rg < 4; ++rg) { const int d0 = 32 * dt + 8 * rg + 4 * hi;
            u32x2 wv; wv.x = pg8::cvt_pk_bf16(o[dt][4 * rg] * inv, o[dt][4 * rg + 1] * inv); wv.y = pg8::cvt_pk_bf16(o[dt][4 * rg + 2] * inv, o[dt][4 * rg + 3] * inv);
            *(u32x2*)(OG + tokq * 512 + h * 64 + d0) = wv; }
    WSP(float, WS_LSE)[((size_t)g * T + tokq) * 8 + h] = mx * 0.125f + __logf(lsum);
}
__device__ __forceinline__ void attn_combine(Ctx& X) {
    const bf16_t* OG = WSP(bf16_t, WS_OG); const float* LSE = WSP(float, WS_LSE); bf16_t* YCAT = WSP(bf16_t, WS_YCAT);
    const int gt = X.wg * NTHREADS + X.tid, NGT = X.G * NTHREADS;
    for (int item = gt; item < T * 64; item += NGT) {
        const int t = item >> 6, ch = item & 63, h = ch >> 3;
        const float l0 = LSE[(size_t)t * 8 + h], l1 = LSE[((size_t)T + t) * 8 + h], l2 = LSE[((size_t)2 * T + t) * 8 + h];
        const float m = fmaxf(l0, fmaxf(l1, l2)); float w0 = __expf(l0 - m), w1 = __expf(l1 - m), w2 = __expf(l2 - m); const float inv = 1.f / (w0 + w1 + w2); w0 *= inv; w1 *= inv; w2 *= inv;
        const u32x4 a = *(const u32x4*)(OG + (size_t)t * 512 + ch * 8), bq = *(const u32x4*)(OG + ((size_t)T + t) * 512 + ch * 8), cq = *(const u32x4*)(OG + ((size_t)2 * T + t) * 512 + ch * 8);
        u32x4 o;
#pragma unroll
        for (int j = 0; j < 4; ++j) o[j] = pk2(w0 * bflo(a[j]) + w1 * bflo(bq[j]) + w2 * bflo(cq[j]), w0 * bfhi(a[j]) + w1 * bfhi(bq[j]) + w2 * bfhi(cq[j]));
        *(u32x4*)(YCAT + (size_t)t * D + 512 + ch * 8) = o;
    }
}

__device__ __forceinline__ unsigned sortable_key(float f) { const unsigned u = __builtin_bit_cast(unsigned, f); return (u & 0x80000000u) ? ~u : (u | 0x80000000u); }
__device__ __forceinline__ void moe_route(Ctx& X, bool local) {
    const float* LG = WSP(float, WS_KVT); unsigned* CNT = WSP(unsigned, WS_CTL) + CW_CNT; int* LISTS = WSP(int, WS_LISTS); float* GATEW = WSP(float, WS_GATEW);
    const int gw = X.wg * NWAVES + X.wave, NGW = X.G * NWAVES, l = X.lane, grp = l >> 3;
    const f32x4 bias = *(const f32x4*)(X.rbias + 4 * l);
    const unsigned long long ltmask = (1ull << l) - 1ull;
    const int tbeg = local ? X.wg * 64 + X.wave : gw, tend = local ? X.wg * 64 + 64 : T, tstep = local ? NWAVES : NGW;
    for (int t = tbeg; t < tend; t += tstep) {
        f32x4 lg = *(const f32x4*)(LG + (size_t)t * 256 + 4 * l);
#pragma unroll
        for (int ks = 1; ks < 4; ++ks) lg += *(const f32x4*)(LG + ((size_t)ks * T + t) * 256 + 4 * l);
        float sc[4], mb[4];
#pragma unroll
        for (int i = 0; i < 4; ++i) { sc[i] = sigmoidf_(lg[i]); mb[i] = sc[i] + bias[i]; }
        float m1 = fmaxf(mb[0], mb[1]), m2 = fminf(mb[0], mb[1]);
        { const float a1 = fmaxf(mb[2], mb[3]), a2 = fminf(mb[2], mb[3]); const float n1 = fmaxf(m1, a1), n2 = fmaxf(fminf(m1, a1), fmaxf(m2, a2)); m1 = n1; m2 = n2; }
#pragma unroll
        for (int o = 1; o < 8; o <<= 1) { const float a1 = __shfl_xor(m1, o), a2 = __shfl_xor(m2, o); const float n1 = fmaxf(m1, a1), n2 = fmaxf(fminf(m1, a1), fmaxf(m2, a2)); m1 = n1; m2 = n2; }
        const float gs = m1 + m2;
        int rank = 0;
#pragma unroll
        for (int gg = 0; gg < 8; ++gg) { const float og = __builtin_bit_cast(float, __builtin_amdgcn_readlane(__builtin_bit_cast(int, gs), gg * 8)); rank += (og > gs || (og == gs && gg < grp)) ? 1 : 0; }
        const bool sel = rank < 4;
        unsigned key[4];
#pragma unroll
        for (int i = 0; i < 4; ++i) key[i] = sel ? sortable_key(mb[i]) : 0u;
        unsigned pre = 0u;
#pragma unroll 1
        for (int bit = 31; bit >= 0; --bit) { const unsigned cand = pre | (1u << bit);
            const int cnt = __popcll(__ballot(key[0] >= cand)) + __popcll(__ballot(key[1] >= cand)) + __popcll(__ballot(key[2] >= cand)) + __popcll(__ballot(key[3] >= cand));
            if (cnt >= TOPK) pre = cand; }
        int ngt = 0, eqb = 0, tkb = 0; bool take[4];
#pragma unroll
        for (int i = 0; i < 4; ++i) ngt += __popcll(__ballot(key[i] > pre));
        const int need = TOPK - ngt;
#pragma unroll
        for (int i = 0; i < 4; ++i) eqb += __popcll(__ballot(key[i] == pre) & ltmask);
        int eqrun = eqb;
#pragma unroll
        for (int i = 0; i < 4; ++i) { const bool eq = key[i] == pre; take[i] = (key[i] > pre) || (eq && eqrun < need); eqrun += eq ? 1 : 0; }
#pragma unroll
        for (int i = 0; i < 4; ++i) tkb += __popcll(__ballot(take[i]) & ltmask);
        float part = 0.f;
#pragma unroll
        for (int i = 0; i < 4; ++i) part += take[i] ? sc[i] : 0.f;
        const float scale = 2.5f / wave_sum(part);
        int slot = tkb;
#pragma unroll
        for (int i = 0; i < 4; ++i) if (take[i]) { const int e = 4 * l + i; const unsigned pos = atomicAdd(&CNT[e * 64], 1u); LISTS[(size_t)e * 16384 + pos] = t * NSLOT + slot; GATEW[t * NSLOT + slot] = sc[i] * scale; ++slot; }
        if (l == 0) { LISTS[(size_t)NE * 16384 + t] = t * NSLOT + TOPK; GATEW[t * NSLOT + TOPK] = 1.0f; }
    }
}
__device__ __forceinline__ int moe_table(Ctx& X) {
    LAS int* tbl = (LAS int*)(X.lds + TBL_OFF); LAS int* cnts = (LAS int*)(X.lds + TCNT_OFF); LAS int* pref = cnts + 320;
    const unsigned* CNT = WSP(unsigned, WS_CTL) + CW_CNT;
    const int x = X.wg & 7;
    if (X.tid < NEX) cnts[X.tid] = X.tid < NE ? (int)__hip_atomic_load(CNT + X.tid * 64, __ATOMIC_RELAXED, __HIP_MEMORY_SCOPE_AGENT) : T;
    __syncthreads();
    if (X.tid < NEX) { int pre = 0; for (int e = 0; e < X.tid; ++e) pre += (cnts[e] + 255) >> 8; pref[X.tid] = pre; }
    __syncthreads();
    if (X.tid < 33) {
        const int i = X.tid; int lp = 0; for (int k = 0; k < i && k < 32; ++k) lp += (cnts[x + 8 * k] + 255) >> 8;
        if (i < 32) { const int e = x + 8 * i, n = (cnts[e] + 255) >> 8, p0 = pref[e]; for (int r = 0; r < n; ++r) tbl[lp + r] = ((p0 + r) << 16) | (e << 7) | r; }
        else { const int p0 = pref[NE]; for (int r8 = 0; r8 < 8; ++r8) { const int r = 8 * x + r8; tbl[lp + r8] = ((p0 + r) << 16) | (NE << 7) | r; } cnts[600] = lp + 8; }
    }
    __syncthreads();
    return __builtin_amdgcn_readfirstlane(cnts[600]);
}
__device__ __forceinline__ void final_rows(Ctx& X) {
    const bf16_t* X1 = WSP(bf16_t, WS_X1); const float* MOD = WSP(float, WS_MOD); const unsigned char* YBUF = WSP(unsigned char, WS_YBUF);
    const int gw = X.wg * NWAVES + X.wave, NGW = X.G * NWAVES, l = X.lane;
    for (int t = gw; t < T; t += NGW) {
        const int b = t / SEQ; f32x4 v[2][2]; float s = 0.f;
#pragma unroll
        for (int j = 0; j < 2; ++j) { const int col = 8 * l + 512 * j; f32x4 m0 = {0.f, 0.f, 0.f, 0.f}, m1 = {0.f, 0.f, 0.f, 0.f};
#pragma unroll
            for (int k = 0; k < NSLOT; ++k) { const u32x2 y = *(const u32x2*)(YBUF + ((size_t)t * NSLOT + k) * D + col);
                const f32x2 a = __builtin_amdgcn_cvt_pk_f32_fp8((int)y.x, false), bq = __builtin_amdgcn_cvt_pk_f32_fp8((int)y.x, true), c = __builtin_amdgcn_cvt_pk_f32_fp8((int)y.y, false), d = __builtin_amdgcn_cvt_pk_f32_fp8((int)y.y, true);
                m0.x += a[0]; m0.y += a[1]; m0.z += bq[0]; m0.w += bq[1]; m1.x += c[0]; m1.y += c[1]; m1.z += d[0]; m1.w += d[1]; }
            const f32x4 g0 = *(const f32x4*)(MOD + b * 6144 + 5120 + col) * (1.0f / YSCALE), g1 = *(const f32x4*)(MOD + b * 6144 + 5120 + col + 4) * (1.0f / YSCALE);
            const u32x4 xw = *(const u32x4*)(X1 + (size_t)t * D + col); const f32x4 x0 = {bflo(xw.x), bfhi(xw.x), bflo(xw.y), bfhi(xw.y)}, x1 = {bflo(xw.z), bfhi(xw.z), bflo(xw.w), bfhi(xw.w)};
            v[j][0] = x0 + g0 * m0; v[j][1] = x1 + g1 * m1;
#pragma unroll
            for (int q = 0; q < 2; ++q) s += (v[j][q].x * v[j][q].x + v[j][q].y * v[j][q].y) + (v[j][q].z * v[j][q].z + v[j][q].w * v[j][q].w); }
        const float rstd = rsqrtf(wave_sum(s) * (1.f / D) + EPS);
#pragma unroll
        for (int j = 0; j < 2; ++j) { const int col = 8 * l + 512 * j;
            *(f32x4*)(X.out + (size_t)t * D + col) = v[j][0] * rstd * *(const f32x4*)(X.g_final + col); *(f32x4*)(X.out + (size_t)t * D + col + 4) = v[j][1] * rstd * *(const f32x4*)(X.g_final + col + 4); }
    }
}

__device__ __forceinline__ unsigned* panel_word(Ctx& X, int bank, int pm) { return WSP(unsigned, WS_CTL) + CW_PANEL + (bank * 64 + pm) * 64; }
__device__ __forceinline__ void panel_signal(Ctx& X, int bank, int pm) {
    asm volatile("s_waitcnt vmcnt(0)" ::: "memory"); __syncthreads();
    if (X.tid == 0) (void)xb_add(panel_word(X, bank, pm), 1u);
}
__device__ __forceinline__ void panel_wait(Ctx& X, int bank, int pm, unsigned target) {
    if (X.tid == 0) { unsigned* p = panel_word(X, bank, pm); unsigned sp = 0u;
        while (xb_ld(p) < target) { __builtin_amdgcn_s_sleep(2); if (++sp > (1u << 22)) break; }
        __builtin_amdgcn_fence(__ATOMIC_ACQUIRE, "agent"); asm volatile("s_waitcnt vmcnt(0)" ::: "memory"); }
    __syncthreads();
}

constexpr int NG_INPROJ = 176;
__device__ __forceinline__ void ph_inproj(Ctx& X) {
    const int ng = X.G > NG_INPROJ + 8 ? NG_INPROJ : X.G;
    if (X.wg < ng) {
        RegSched S{(const char*)WSP(bf16_t, WS_H), (const char*)WSP(bf16_t, WS_WIN), (size_t)256 * 2048, (size_t)256 * 2048, T / 256, INW / 256, ng, X.wg};
        EpiInproj E{WSP(bf16_t, WS_PROJ), WSP(float, WS_LOGF), WSP(float, WS_LB), WSP(float, WS_ROPE), WSP(unsigned char, WS_G8), WSP(unsigned char, WS_QK8)};
        pg8::gemm_phase<EpiInproj, RegSched, true, false>(X.lds, 1024, 1024, 1024, S, E);
    }
    if (ng == X.G) expert_convert(X, X.wg, X.G);
    else if (X.wg >= ng) expert_convert(X, X.wg - ng, X.G - ng);
}
__device__ __forceinline__ void ph_mix_a(Ctx& X) {
    for (int it = X.wg; it < 256; it += X.G) hgrn_kv_unit(X, it);
    AttnRegs Ra, Rb; int unit = X.wg;
    auto clampu = [](int u) { return u < 1536 ? u : 1535; };
    attn_load(X, clampu(unit), Ra);
    __builtin_amdgcn_sched_barrier(0);
    attn_load(X, clampu(unit + X.G), Rb);
    __builtin_amdgcn_sched_barrier(0);
#define ATTN_STEP(R_) do { attn_stage(X, R_); __syncthreads(); __builtin_amdgcn_sched_barrier(0); attn_load(X, clampu(unit + 2 * X.G), R_); __builtin_amdgcn_sched_barrier(0); \
        attn_compute(X, unit); __syncthreads(); unit += X.G; } while (0)
    if (unit < 1536) {
        ATTN_STEP(Ra);
        while (unit < 1536) {
            ATTN_STEP(Rb);
            if (unit >= 1536) break;
            ATTN_STEP(Ra);
        }
    }
#undef ATTN_STEP
}
__device__ __forceinline__ void ph_mix_c(Ctx& X) { for (int it = X.wg; it < 512; it += X.G) hgrn_out_unit(X, it); attn_combine(X); }
__device__ __forceinline__ void ph_mixed(Ctx& X, bool chain) {
    TwoPartSched S{(const char*)WSP(bf16_t, WS_YCAT), (const char*)WSP(bf16_t, WS_WPA), (const char*)WSP(bf16_t, WS_WPB), T / 256, D / 256, X.G, X.wg};
    EpiMixed E{WSP(unsigned char, WS_G8), WSP(bf16_t, WS_MIXED)};
    pg8::gemm_phase<EpiMixed, TwoPartSched, false, false>(X.lds, 1024, 512, 512, S, E);
    if (chain) { int pm, pn; pg8::swz_tile(X.wg, T / 256, D / 256, pm, pn); panel_signal(X, 0, pm); }
}
__device__ __forceinline__ void ph_outproj(Ctx& X, bool chain) {
    int pm = 0, pn = 0; pg8::swz_tile(X.wg < 256 ? X.wg : 0, T / 256, D / 256, pm, pn);
    RegSched S{(const char*)WSP(bf16_t, WS_MIXED), (const char*)WSP(bf16_t, WS_WOUT), (size_t)256 * 2048, (size_t)256 * 2048, T / 256, D / 256, X.G, X.wg};
    if (chain) {
        panel_wait(X, 0, pm, 4u);
        EpiOutNorm E{X.x, WSP(float, WS_MOD), X.g2, WSP(bf16_t, WS_X1), WSP(bf16_t, WS_H), WSP(unsigned char, WS_H8), WSP(float, WS_XB), panel_word(X, 1, 0), X.lds + 139264};
        pg8::gemm_phase<EpiOutNorm, RegSched, true, false>(X.lds, 1024, 1024, 1024, S, E);
        panel_signal(X, 2, pm);
    } else {
        EpiOutproj E{X.x, WSP(float, WS_MOD), WSP(bf16_t, WS_X1)};
        pg8::gemm_phase<EpiOutproj, RegSched, false, false>(X.lds, 1024, 1024, 1024, S, E);
    }
}
__device__ __forceinline__ void ph_norm2(Ctx& X, bool chain) { if (!chain) norm_rows(X, 1); }
__device__ __forceinline__ void ph_router(Ctx& X, bool chain) {
    if (chain) panel_wait(X, 2, X.wg >> 2, 4u);
    RouterSched S{(const char*)WSP(bf16_t, WS_H), (const char*)WSP(bf16_t, WS_WR), X.G, X.wg};
    EpiRouter E{WSP(float, WS_KVT)};
    pg8::gemm_phase<EpiRouter, RouterSched, false, false>(X.lds, 1024, 1024, 256, S, E);
    if (chain) panel_signal(X, 3, X.wg >> 2);
}
__device__ __forceinline__ void ph_route(Ctx& X, bool chain) {
    if (chain) panel_wait(X, 3, X.wg >> 2, 4u);
    moe_route(X, chain);
}
__device__ __forceinline__ void ph_gu(Ctx& X) {
    const int nent = moe_table(X);
    MoeSched S{(const LAS int*)(X.lds + TBL_OFF), (const LAS int*)(X.lds + TCNT_OFF), nent, (const char*)WSP(unsigned char, WS_H8), (const char*)WSP(unsigned char, WS_WGU), WSP(int, WS_LISTS), 2, 256 * 1024, 512 * 1024, 0, X.G, X.wg};
    EpiGU E{WSP(unsigned char, WS_ACT)};
    pg8::gemm_phase<EpiGU, MoeSched, true, true, true>(X.lds, 512, 512, 512, S, E);
}
__device__ __forceinline__ void ph_down(Ctx& X) {
    const int nent = moe_table(X);
    MoeSched S{(const LAS int*)(X.lds + TBL_OFF), (const LAS int*)(X.lds + TCNT_OFF), nent, (const char*)WSP(unsigned char, WS_ACT), (const char*)WSP(unsigned char, WS_WD), WSP(int, WS_LISTS), 4, 256 * 256, 1024 * 256, 256 * 256, X.G, X.wg};
    EpiDown E{WSP(unsigned char, WS_YBUF), WSP(float, WS_GATEW)};
    pg8::gemm_phase<EpiDown, MoeSched, true, false, true>(X.lds, 128, 128, 128, S, E);
}

constexpr int NPHASE = 14;
struct Args { const void* in[20]; float* out; unsigned char* ws; int ph_lo, ph_hi; };
__global__ void __launch_bounds__(NTHREADS, 2) mega_fwd(Args args) {
    extern __shared__ __attribute__((aligned(16))) unsigned char lds_raw[];
    Ctx X;
    X.lds = (LAS unsigned char*)lds_raw;
    X.tid = threadIdx.x; X.lane = X.tid & 63; X.wave = __builtin_amdgcn_readfirstlane(X.tid >> 6); X.wg = blockIdx.x; X.G = gridDim.x;
    X.x = (const float*)args.in[0]; X.c = (const float*)args.in[1]; X.positions = (const int*)args.in[2]; X.w_ada = (const float*)args.in[3]; X.b_ada = (const float*)args.in[4];
    X.g1 = (const float*)args.in[5]; X.w_in = (const float*)args.in[6]; X.lb_logits = (const float*)args.in[7]; X.g_hgrn = (const float*)args.in[8]; X.w_pa = (const float*)args.in[9];
    X.w_pb = (const float*)args.in[10]; X.w_out = (const float*)args.in[11]; X.g2 = (const float*)args.in[12]; X.w_router = (const float*)args.in[13]; X.rbias = (const float*)args.in[14];
    X.w_egu = (const float*)args.in[15]; X.w_edown = (const float*)args.in[16]; X.w_sgu = (const float*)args.in[17]; X.w_sdown = (const float*)args.in[18]; X.g_final = (const float*)args.in[19];
    X.out = args.out; X.ws = args.ws;
    volatile LAS unsigned* MISC = (volatile LAS unsigned*)(X.lds + MISC_OFF);
    if (X.tid < 32) MISC[X.tid] = 0u;
    __syncthreads();
    const int lo = args.ph_lo, hi = args.ph_hi;
    XcdBarrier bar; bar.bar = WSP(unsigned, WS_CTL) + CW_BAR; bar.x = 0; bar.st = nullptr;
    if (hi - lo > 1) bar = xcd_barrier_post(WSP(unsigned, WS_CTL) + CW_BAR, MISC + 8);
#ifndef PH_MASK
#define PH_MASK 0xffffffffu
#endif
#define IN(k) ((((PH_MASK) >> (k)) & 1u) && lo <= (k) && (k) < hi)
#ifndef REPEAT_MASK
#define REPEAT_MASK 0u
#endif
#define SEAM(k) do { if (IN(k) && IN((k) + 1)) xcd_barrier(bar); } while (0)
#define RUN(k, call) do { if (IN(k)) { call; if (((REPEAT_MASK) >> (k)) & 1u) { xcd_barrier(bar); call; } } } while (0)

    RUN(0, p0_prologue(X)); SEAM(0);
    RUN(1, { small_transposes(X); norm_rows(X, 0); }); SEAM(1);
    RUN(2, ph_inproj(X)); SEAM(2);
    RUN(3, ph_mix_a(X)); SEAM(3);
    RUN(4, hgrn_passB(X)); SEAM(4);
    RUN(5, ph_mix_c(X)); SEAM(5);
    const bool chain = (X.G == 256);
    RUN(6, ph_mixed(X, chain)); if (!chain) SEAM(6);
    RUN(7, ph_outproj(X, chain)); if (!chain) SEAM(7);
    RUN(8, ph_norm2(X, chain)); if (!chain) SEAM(8);
    RUN(9, ph_router(X, chain)); if (!chain) SEAM(9);
    RUN(10, ph_route(X, chain)); SEAM(10);
    RUN(11, ph_gu(X)); SEAM(11);
    RUN(12, ph_down(X)); SEAM(12);
    RUN(13, final_rows(X));
#undef IN
#undef SEAM
}

extern "C" void kernel_launch(void* const* d_in, const int* in_sizes, int n_in, void* d_out, int out_size, void* d_ws, size_t ws_size, hipStream_t stream) {
    static int grid = 0;
    if (grid == 0) {
        if (n_in != 20 || out_size != T * D || ws_size < WS_END) { fprintf(stderr, "kernel_launch: unexpected shapes (n_in %d, out %d, ws %zu); nothing launched\n", n_in, out_size, ws_size); grid = -1; return; }
        int dev = 0, cus = 0, per_cu = 0;
        if (hipGetDevice(&dev) != hipSuccess || hipDeviceGetAttribute(&cus, hipDeviceAttributeMultiprocessorCount, dev) != hipSuccess) { grid = -1; return; }
        if (hipFuncSetAttribute((const void*)mega_fwd, hipFuncAttributeMaxDynamicSharedMemorySize, LDS_BYTES) != hipSuccess) { fprintf(stderr, "kernel_launch: hipFuncSetAttribute failed\n"); grid = -1; return; }
        if (hipOccupancyMaxActiveBlocksPerMultiprocessor(&per_cu, (const void*)mega_fwd, NTHREADS, LDS_BYTES) != hipSuccess || per_cu < 1) { fprintf(stderr, "kernel_launch: occupancy query says %d blocks/CU; nothing launched\n", per_cu); (void)hipGetLastError(); grid = -1; return; }
        grid = cus;
        if (T % grid != 0 || 24576 % grid != 0 || grid % 8 != 0) { fprintf(stderr, "kernel_launch: grid %d does not divide the row count; nothing launched\n", grid); grid = -1; return; }
    }
    if (grid < 0) return;
    (void)hipMemsetAsync((char*)d_ws + WS_CTL, 0, CTL_ZERO_BYTES, stream);
    Args a{};
    for (int i = 0; i < 20; ++i) a.in[i] = d_in[i];
    a.out = (float*)d_out; a.ws = (unsigned char*)d_ws;
#if MK_PER_PHASE
    for (int p = 0; p < NPHASE; ++p) { a.ph_lo = p; a.ph_hi = p + 1; hipLaunchKernelGGL(mega_fwd, dim3(grid), dim3(NTHREADS), LDS_BYTES, stream, a); }
#else
    a.ph_lo = 0; a.ph_hi = NPHASE;
    hipLaunchKernelGGL(mega_fwd, dim3(grid), dim3(NTHREADS), LDS_BYTES, stream, a);
#endif
}
```

```cpp
#include <hip/hip_runtime.h>
#include <cstdio>
#include <cstdint>

#ifndef MK_PER_PHASE
#define MK_PER_PHASE 0
#endif

#define GAS __attribute__((address_space(1)))
#define LAS __attribute__((address_space(3)))
typedef unsigned short bf16_t;
typedef short bf16x8 __attribute__((ext_vector_type(8)));
typedef short s16x4 __attribute__((ext_vector_type(4)));
typedef float f32x4 __attribute__((ext_vector_type(4)));
typedef float f32x2 __attribute__((ext_vector_type(2)));
typedef float f32x16 __attribute__((ext_vector_type(16)));
typedef unsigned u32x4 __attribute__((ext_vector_type(4)));
typedef unsigned u32x2 __attribute__((ext_vector_type(2)));
typedef long l64x2 __attribute__((ext_vector_type(2)));

constexpr int NB = 4, SEQ = 4096, T = NB * SEQ, D = 1024, INW = 8704;
constexpr int C_HQ = 0, C_HK = 512, C_HV = 1024, C_HG = 1536, C_AQ = 2048, C_AK = 3584, C_AV = 5120, C_GA = 6656, C_GB = 7680;
constexpr int NE = 256, NEX = 257, TOPK = 8, NSLOT = 9, EFF = 256;
constexpr float EPS = 1e-6f;
constexpr float WGU_SCALE = 64.0f, WD_SCALE = 32.0f;
constexpr float YSCALE = 16.0f;
constexpr int NWAVES = 8, NTHREADS = 512;

constexpr size_t MiB = 1u << 20;
constexpr size_t WS_CTL = 0, CTL_ZERO_BYTES = 1 * MiB;
constexpr size_t WS_MODP = 2 * MiB;
constexpr size_t WS_MOD = 4 * MiB;
constexpr size_t WS_LB = 4 * MiB + 128 * 1024;
constexpr size_t WS_XB = 4 * MiB + 256 * 1024;
constexpr size_t WS_ROPE = 5 * MiB;
constexpr size_t WS_DECAY = 6 * MiB;
constexpr size_t WS_GATEW = 7 * MiB;
constexpr size_t WS_LISTS = 16 * MiB;
constexpr size_t WS_WIN = 34 * MiB;
constexpr size_t WS_WPA = 51 * MiB, WS_WPB = 52 * MiB, WS_WOUT = 53 * MiB, WS_WR = 55 * MiB;
constexpr size_t WS_H = 56 * MiB;
constexpr size_t WS_LOGF = 88 * MiB;
constexpr size_t WS_H8 = 120 * MiB;
constexpr size_t WS_MIXED = 136 * MiB;
constexpr size_t WS_YCAT = 168 * MiB;
constexpr size_t WS_X1 = 200 * MiB;
constexpr size_t WS_G8 = 232 * MiB;
constexpr size_t WS_OG = 264 * MiB;
constexpr size_t WS_LSE = 312 * MiB;
constexpr size_t WS_KVT = 314 * MiB;
constexpr size_t WS_SPT = 378 * MiB;
constexpr size_t WS_PROJ = 410 * MiB;
constexpr size_t WS_WGU = 682 * MiB;
constexpr size_t WS_QK8 = 820 * MiB;
constexpr size_t WS_WD = 939 * MiB;
constexpr size_t WS_ACT = 1068 * MiB;
constexpr size_t WS_YBUF = 1172 * MiB;
constexpr size_t WS_END = 1460 * MiB;
constexpr int CW_BAR = 4096;
constexpr int CW_PANEL = 65536;
constexpr int CW_CNT = 16384;

constexpr int RING_BYTES = 131072;
constexpr int TBL_OFF = RING_BYTES;
constexpr int TCNT_OFF = TBL_OFF + 4096;
constexpr int MISC_OFF = TCNT_OFF + 2560;
constexpr int LDS_BYTES = 147456;

#define LDS_WAIT() asm volatile("s_waitcnt lgkmcnt(0)" ::: "memory")
#define VM_WAIT() asm volatile("s_waitcnt vmcnt(0)" ::: "memory")
__device__ __forceinline__ unsigned f2bf(float f) { unsigned u = __builtin_bit_cast(unsigned, f); return (u + 0x7fffu + ((u >> 16) & 1u)) >> 16; }
__device__ __forceinline__ float bf2f(unsigned b) { return __builtin_bit_cast(float, b << 16); }
__device__ __forceinline__ unsigned pk2(float lo, float hi) { return f2bf(lo) | (f2bf(hi) << 16); }
__device__ __forceinline__ float bflo(unsigned w) { return __builtin_bit_cast(float, w << 16); }
__device__ __forceinline__ float bfhi(unsigned w) { return __builtin_bit_cast(float, w & 0xffff0000u); }
__device__ __forceinline__ float fast_logf(float x) { return __builtin_amdgcn_logf(x) * 0.6931471805599453f; }
__device__ __forceinline__ float sigmoidf_(float x) { return __builtin_amdgcn_rcpf(1.0f + __expf(-x)); }
__device__ __forceinline__ float wave_sum(float v) {
#pragma unroll
    for (int o = 1; o < 64; o <<= 1) v += __shfl_xor(v, o);
    return v;
}

__device__ __forceinline__ float clamp_e4m3(float x) { return __builtin_amdgcn_fmed3f(x, -448.0f, 448.0f); }
__device__ __forceinline__ unsigned pk4_fp8(float a, float b, float c, float d) { int w = 0; w = __builtin_amdgcn_cvt_pk_fp8_f32(clamp_e4m3(a), clamp_e4m3(b), w, false); w = __builtin_amdgcn_cvt_pk_fp8_f32(clamp_e4m3(c), clamp_e4m3(d), w, true); return (unsigned)w; }
__device__ __forceinline__ void st_wt8(void* p, unsigned long long v) { __hip_atomic_store((unsigned long long*)p, v, __ATOMIC_RELAXED, __HIP_MEMORY_SCOPE_AGENT); }
__device__ __forceinline__ void st_wt16(void* p, u32x4 v) { asm volatile("global_store_dwordx4 %0, %1, off sc1\n\ts_nop 1" :: "v"(p), "v"(v) : "memory"); }
__device__ __forceinline__ void st_wt4(void* p, unsigned v) { __hip_atomic_store((unsigned*)p, v, __ATOMIC_RELAXED, __HIP_MEMORY_SCOPE_AGENT); }
namespace pg8 {
constexpr int BM = 256, BK = 64, HALF = 128, HTB = HALF * BK * 2, STAGE_BYTES = 8 * HTB, NXCD = 8, WGM = 8;
__host__ __device__ __forceinline__ int lds_byte(int r, int c) { const int st = (r >> 4) * 2 + (c >> 5), rr = r & 15, cc = c & 31, ob = rr * 64 + cc * 2; return st * 1024 + (ob ^ (((ob >> 9) & 1) << 5)); }
__host__ __device__ __forceinline__ void stage_rc(int b, int& R, int& C) { const int st = b / 1024, sb = b % 1024, swz = sb ^ (((sb >> 9) & 1) << 5); R = (st >> 1) * 16 + swz / 64; C = (st & 1) * 32 + (swz % 64) / 2; }
__host__ __device__ __forceinline__ int perm32(int rho) { const int n = rho >> 4, i = rho & 15; return 8 * (i >> 2) + 4 * n + (i & 3); }

struct Unit { const char* a; const char* b; const int* rows; int pm, pn, aux, nvalid; };

__device__ __forceinline__ void swz_tile(int L, int nM, int nN, int& pm, int& pn) {
    const int nwg = nM * nN; int wgid = L;
    { const int q = nwg / NXCD, r = nwg % NXCD, xcd = wgid % NXCD, off = wgid / NXCD; wgid = (xcd < r ? xcd * (q + 1) : r * (q + 1) + (xcd - r) * q) + off; }
    const int nig = WGM * nN, gid = wgid / nig, fm = gid * WGM, gsz = (nM - fm) < WGM ? (nM - fm) : WGM;
    pm = fm + ((wgid % nig) % gsz); pn = (wgid % nig) / gsz;
}

__device__ __forceinline__ unsigned cvt_pk_bf16(float lo, float hi) { unsigned r; asm volatile("v_cvt_pk_bf16_f32 %0, %1, %2" : "=v"(r) : "v"(lo), "v"(hi)); return r; }

template <bool GATHER>
__device__ __forceinline__ void gather_offs(const Unit& u, int tid, int lda, unsigned (&v)[2][2]) {
    if constexpr (GATHER) {
#pragma unroll
        for (int i = 0; i < 2; ++i) { int R, C; stage_rc(tid * 16 + i * 8192, R, C);
#pragma unroll
            for (int hh = 0; hh < 2; ++hh) { const int ri = hh * HALF + R; int slot = 0; if (ri < u.nvalid) slot = u.rows[ri];
                const unsigned tok = (unsigned)slot / 9u; v[hh][i] = (tok * (unsigned)lda + (unsigned)C) * 2u; } }
    }
}

template <class Epi, class Sched, bool ALIGN_EPI, bool GATHER, bool FP8 = false>
__device__ __forceinline__ void gemm_phase(LAS unsigned char* lds, const int lda, const int ldb, const int K, const Sched& S, const Epi& E) {
    const int tid = threadIdx.x, wid = __builtin_amdgcn_readfirstlane(tid >> 6), lane = tid & 63, wr = wid >> 2, wc = wid & 3, fr = lane & 15, fq = lane >> 4;
    const int nt = K / BK;
    unsigned voffA[2], voffB[2];
#pragma unroll
    for (int i = 0; i < 2; ++i) { int R, C; stage_rc(tid * 16 + i * 8192, R, C); const int Rb = Epi::PERM ? ((R & ~31) + perm32(R & 31)) : R;
        voffA[i] = (unsigned)(R * lda + C) * 2u; voffB[i] = (unsigned)(Rb * ldb + C) * 2u; }
    const size_t kstep = (size_t)(BK * 2);
    const size_t hstepA = GATHER ? 0 : (size_t)HALF * lda * 2, hstepB = (size_t)HALF * ldb * 2;
    const unsigned ldsw = (unsigned)wid * 1024u;
    const int aoff = lds_byte(wr * 64 + fr, fq * 8), boff = lds_byte(wc * 32 + fr, fq * 8);
#define PG8_SA(b, h) (((b) * 2 + (h)) * HTB)
#define PG8_SB(b, h) ((4 + (b) * 2 + (h)) * HTB)
#define PG8_STAGE(bufoff, gbase, voff) do { _Pragma("unroll") for (int _i = 0; _i < 2; ++_i) \
        __builtin_amdgcn_global_load_lds((const unsigned*)((const char*)(gbase) + (voff)[_i]), (LAS unsigned*)(lds + (bufoff) + ldsw + _i * 8192), 16, 0, 0); } while (0)
#define PG8_STAGE_A(bufoff, gb, hh, nx) do { if constexpr (GATHER) { unsigned _v[2]; _v[0] = (nx) ? vn[hh][0] : vc[hh][0]; _v[1] = (nx) ? vn[hh][1] : vc[hh][1]; PG8_STAGE(bufoff, gb, _v); } \
        else { PG8_STAGE(bufoff, (gb) + (hh) * hstepA, voffA); } } while (0)
#define PG8_LDA(dst, b, h) do { _Pragma("unroll") for (int m = 0; m < 4; ++m) _Pragma("unroll") for (int k = 0; k < 2; ++k) dst[m][k] = *(const LAS bf16x8*)(lds + PG8_SA(b, h) + aoff + m * 2048 + k * 1024); } while (0)
#define PG8_LDB(dst, b, h) do { _Pragma("unroll") for (int n = 0; n < 2; ++n) _Pragma("unroll") for (int k = 0; k < 2; ++k) dst[n][k] = *(const LAS bf16x8*)(lds + PG8_SB(b, h) + boff + n * 2048 + k * 1024); } while (0)
#define PG8_MMA(ai, bj, At, Bt) do { __builtin_amdgcn_s_setprio(1); _Pragma("unroll") for (int m = 0; m < 4; ++m) _Pragma("unroll") for (int n = 0; n < 2; ++n) _Pragma("unroll") for (int k = 0; k < 2; ++k) { \
        if constexpr (FP8) { const l64x2 _b = __builtin_bit_cast(l64x2, Bt[n][k]), _a = __builtin_bit_cast(l64x2, At[m][k]); \
            acc[ai][bj][m][n] = __builtin_amdgcn_mfma_f32_16x16x32_fp8_fp8(_b[0], _a[0], acc[ai][bj][m][n], 0, 0, 0); acc[ai][bj][m][n] = __builtin_amdgcn_mfma_f32_16x16x32_fp8_fp8(_b[1], _a[1], acc[ai][bj][m][n], 0, 0, 0); } \
        else acc[ai][bj][m][n] = __builtin_amdgcn_mfma_f32_16x16x32_bf16(Bt[n][k], At[m][k], acc[ai][bj][m][n], 0, 0, 0); } __builtin_amdgcn_s_setprio(0); } while (0)
#define PG8_WAIT_V(n) asm volatile("s_waitcnt vmcnt(" #n ")" ::: "memory")
#define PG8_WAIT_L(n) asm volatile("s_waitcnt lgkmcnt(" #n ")" ::: "memory")
#define PG8_BAR __builtin_amdgcn_s_barrier()
#define PG8_SCHED __builtin_amdgcn_sched_barrier(0)
    Unit cur, nxt; int ui = 0;
    if (!S.next(0, cur)) return;
    unsigned vc[2][2] = {{0u, 0u}, {0u, 0u}}, vn[2][2] = {{0u, 0u}, {0u, 0u}};
    gather_offs<GATHER>(cur, tid, lda, vc);
    f32x4 acc[2][2][4][2];
#pragma unroll
    for (int a = 0; a < 2; ++a)
#pragma unroll
        for (int b = 0; b < 2; ++b)
#pragma unroll
            for (int m = 0; m < 4; ++m)
#pragma unroll
                for (int n = 0; n < 2; ++n) acc[a][b][m][n] = (f32x4){0.f, 0.f, 0.f, 0.f};
    bf16x8 At[4][2], B0[2][2], B1[2][2];
    const char* cA = cur.a; const char* cB = cur.b;
    PG8_STAGE(PG8_SB(0, 0), cB, voffB); PG8_STAGE(PG8_SB(0, 1), cB + hstepB, voffB); PG8_STAGE_A(PG8_SA(0, 0), cA, 0, false); PG8_STAGE_A(PG8_SA(0, 1), cA, 1, false);
    if (wr == 1) PG8_BAR;
    PG8_WAIT_V(2); PG8_BAR;
    PG8_STAGE(PG8_SB(1, 0), cB + kstep, voffB); PG8_STAGE_A(PG8_SA(1, 0), cA + kstep, 0, false); PG8_STAGE(PG8_SB(1, 1), cB + hstepB + kstep, voffB);
    PG8_WAIT_V(6); PG8_BAR;
    for (;;) {
        const bool has_next = S.next(ui + 1, nxt);
        if (has_next) gather_offs<GATHER>(nxt, tid, lda, vn);
        const char* nA = has_next ? nxt.a : cA; const char* nB = has_next ? nxt.b : cB;
        const bool do0 = !Sched::HALFSKIP || cur.nvalid > 64 * wr, do1 = !Sched::HALFSKIP || cur.nvalid > 128 + 64 * wr;
        for (int t = 0; t < nt; t += 2) {
            const bool last = (t == nt - 2);
            const bool lnx = last && has_next;
            const char* a1 = cA + (size_t)(t + 1) * kstep;
            const char* a2 = last ? nA : cA + (size_t)(t + 2) * kstep; const char* b2 = last ? nB : cB + (size_t)(t + 2) * kstep;
            const char* a3 = a2 + kstep; const char* b3 = b2 + kstep;
            PG8_LDB(B0, 0, 0); PG8_LDB(B1, 0, 1); PG8_SCHED; PG8_LDA(At, 0, 0); PG8_STAGE_A(PG8_SA(1, 1), a1, 1, false);
            PG8_WAIT_V(8); PG8_WAIT_L(0); PG8_BAR; if (do0) { PG8_MMA(0, 0, At, B0); PG8_MMA(0, 1, At, B1); } PG8_BAR; PG8_SCHED;
            PG8_LDA(At, 0, 1); PG8_STAGE(PG8_SB(0, 0), b2, voffB); PG8_STAGE(PG8_SB(0, 1), b2 + hstepB, voffB); PG8_STAGE_A(PG8_SA(0, 0), a2, 0, lnx);
            PG8_WAIT_V(8); PG8_WAIT_L(0); PG8_BAR; if (do1) { PG8_MMA(1, 0, At, B0); PG8_MMA(1, 1, At, B1); } PG8_BAR; PG8_SCHED;
            PG8_LDB(B0, 1, 0); PG8_LDB(B1, 1, 1); PG8_SCHED; PG8_LDA(At, 1, 0); PG8_STAGE_A(PG8_SA(0, 1), a2, 1, lnx);
            PG8_WAIT_V(8); PG8_WAIT_L(0); PG8_BAR; if (do0) { PG8_MMA(0, 0, At, B0); PG8_MMA(0, 1, At, B1); } PG8_BAR; PG8_SCHED;
            PG8_LDA(At, 1, 1); PG8_STAGE(PG8_SB(1, 0), b3, voffB); PG8_STAGE(PG8_SB(1, 1), b3 + hstepB, voffB); PG8_STAGE_A(PG8_SA(1, 0), a3, 0, lnx);
            PG8_WAIT_V(8); PG8_WAIT_L(0); PG8_BAR; if (do1) { PG8_MMA(1, 0, At, B0); PG8_MMA(1, 1, At, B1); } PG8_BAR; PG8_SCHED;
        }
        if constexpr (ALIGN_EPI) { if (wr == 0) PG8_BAR; }
        E(acc, cur, wr, wc, fr, fq);
        __builtin_amdgcn_s_waitcnt(0x0F70);
        if (!has_next) break;
        if (!E.keep(cur)) {
#pragma unroll
            for (int a = 0; a < 2; ++a)
#pragma unroll
                for (int b = 0; b < 2; ++b)
#pragma unroll
                    for (int m = 0; m < 4; ++m)
#pragma unroll
                        for (int n = 0; n < 2; ++n) acc[a][b][m][n] = (f32x4){0.f, 0.f, 0.f, 0.f};
        }
        cur = nxt; cA = nA; cB = nB; ++ui;
        if constexpr (GATHER) {
#pragma unroll
            for (int hh = 0; hh < 2; ++hh) { vc[hh][0] = vn[hh][0]; vc[hh][1] = vn[hh][1]; }
        }
        if constexpr (ALIGN_EPI) { if (wr == 1) PG8_BAR; }
    }
    PG8_WAIT_V(0);
    if constexpr (!ALIGN_EPI) { if (wr == 0) PG8_BAR; }
    PG8_BAR;
#undef PG8_SA
#undef PG8_SB
#undef PG8_STAGE
#undef PG8_STAGE_A
#undef PG8_LDA
#undef PG8_LDB
#undef PG8_MMA
#undef PG8_WAIT_V
#undef PG8_WAIT_L
#undef PG8_BAR
#undef PG8_SCHED
}
}

#define XB_TMO      128
#define XB_XCNT(j)  (256  + 64 * (j))
#define XB_XSUB(j)  (1280 + 64 * (j))
#define XB_XGEN(j)  (2304 + 64 * (j))
#define XB_TOP      3328
#define XB_TOPGEN   3392
#define XCD_BAR_WORDS 3456
#define XB_SPIN_CAP (1u << 20)
__device__ __forceinline__ unsigned xb_ld(unsigned* p)              { return __hip_atomic_load(p, __ATOMIC_RELAXED, __HIP_MEMORY_SCOPE_AGENT); }
__device__ __forceinline__ unsigned xb_add(unsigned* p, unsigned v) { return __hip_atomic_fetch_add(p, v, __ATOMIC_RELAXED, __HIP_MEMORY_SCOPE_AGENT); }
__device__ __forceinline__ unsigned xb_xcc_id() { return (unsigned)__builtin_amdgcn_s_getreg((3 << 11) | 20) & 0xFu; }
#define XB_SPIN(cond, bar) do { unsigned _sp = 0; while (cond) { __builtin_amdgcn_s_sleep(1); \
    if ((++_sp & 255u) == 0u) { if (xb_ld(&(bar)[XB_TMO])) break; if (_sp > XB_SPIN_CAP) { atomicAdd(&(bar)[XB_TMO], 1u); break; } } } } while (0)
struct XcdBarrier { unsigned* bar; unsigned x; volatile LAS unsigned* st; };
__device__ __forceinline__ XcdBarrier xcd_barrier_post(unsigned* bar, volatile LAS unsigned* st) {
    XcdBarrier b; b.bar = bar; b.x = xb_xcc_id(); b.st = st;
    if (threadIdx.x == 0) (void)xb_add(&bar[XB_XCNT(b.x)], 1u);
    return b;
}
__device__ __forceinline__ void xcd_barrier_complete(unsigned* bar, unsigned x, unsigned& nloc, unsigned& nx) {
    const unsigned G = gridDim.x * gridDim.y * gridDim.z;
    unsigned sum, cnt, mine, sp = 0u;
    for (;;) {
        sum = 0u; cnt = 0u; mine = 0u;
#pragma unroll
        for (unsigned j = 0; j < 16; ++j) { const unsigned c = xb_ld(&bar[XB_XCNT(j)]); sum += c; cnt += (c > 0u) ? 1u : 0u; mine = (j == x) ? c : mine; }
        if (sum == G) break;
        __builtin_amdgcn_s_sleep(1);
        if ((++sp & 255u) == 0u) { if (xb_ld(&bar[XB_TMO])) break; if (sp > XB_SPIN_CAP) { atomicAdd(&bar[XB_TMO], 1u); break; } }
    }
    nloc = mine > 0u ? mine : 1u; nx = cnt > 0u ? cnt : 1u;
}
__device__ __forceinline__ void xcd_barrier(const XcdBarrier& b) {
    asm volatile("s_waitcnt vmcnt(0)" ::: "memory");
    __syncthreads();
    if (threadIdx.x == 0) {
        unsigned* bar = b.bar;
        __builtin_amdgcn_s_waitcnt(0);
        unsigned nloc = b.st[0], nx = b.st[1];
        if (nloc == 0u) { xcd_barrier_complete(bar, b.x, nloc, nx); b.st[0] = nloc; b.st[1] = nx; }
        const unsigned old = xb_add(&bar[XB_XSUB(b.x)], 1u);
        const unsigned gen = old / nloc;
        if (old + 1u == (gen + 1u) * nloc) {
            __builtin_amdgcn_fence(__ATOMIC_RELEASE, "agent");
            asm volatile("s_waitcnt vmcnt(0)" ::: "memory");
            const unsigned og = xb_add(&bar[XB_TOP], 1u);
            const unsigned tg = og / nx;
            if (og + 1u == (tg + 1u) * nx) xb_add(&bar[XB_TOPGEN], 1u);
            else XB_SPIN(xb_ld(&bar[XB_TOPGEN]) == tg, bar);
            __builtin_amdgcn_fence(__ATOMIC_ACQUIRE, "agent");
            asm volatile("s_waitcnt vmcnt(0)" ::: "memory");
        } else {
            XB_SPIN(xb_ld(&bar[XB_TOPGEN]) == gen, bar);
            __builtin_amdgcn_fence(__ATOMIC_ACQUIRE, "agent");
            asm volatile("s_waitcnt vmcnt(0)" ::: "memory");
        }
    }
    __syncthreads();
}

struct Ctx {
    LAS unsigned char* lds;
    int tid, lane, wave, wg, G;
    const float *x, *c, *w_ada, *b_ada, *g1, *w_in, *lb_logits, *g_hgrn, *w_pa, *w_pb, *w_out, *g2, *w_router, *rbias, *w_egu, *w_edown, *w_sgu, *w_sdown, *g_final;
    const int* positions;
    float* out;
    unsigned char* ws;
};
#define WSP(type, off) ((type*)(X.ws + (off)))

__device__ __forceinline__ void transpose_item(const float* W, int K, int N, bf16_t* WT, int dst_row0, int src_col0, int k0, LAS float* scr, int lane) {
#pragma unroll 16
    for (int i = 0; i < 32; ++i) { const int kk = 2 * i + (lane >> 5); scr[kk * 33 + (lane & 31)] = W[(size_t)(k0 + kk) * N + src_col0 + (lane & 31)]; }
    LDS_WAIT(); asm volatile("" ::: "memory");
    const int c = lane & 7;
#pragma unroll
    for (int j = 0; j < 4; ++j) { const int n = (lane >> 3) + 8 * j; const LAS float* s = scr + (8 * c) * 33 + n;
        u32x4 o; o.x = pk2(s[0 * 33], s[1 * 33]); o.y = pk2(s[2 * 33], s[3 * 33]); o.z = pk2(s[4 * 33], s[5 * 33]); o.w = pk2(s[6 * 33], s[7 * 33]);
        *(u32x4*)(WT + (size_t)(dst_row0 + n) * K + k0 + 8 * c) = o; }
    LDS_WAIT(); asm volatile("" ::: "memory");
}
__device__ __forceinline__ void transpose_plain(const float* W, int K, int N, bf16_t* WT, int item, LAS float* scr, int lane) {
    const int nblk = N / 32, kb = item / nblk, nb = item % nblk;
    transpose_item(W, K, N, WT, nb * 32, nb * 32, kb * 64, scr, lane);
}
__device__ __forceinline__ void p0_prologue(Ctx& X) {
    LAS float* scr = (LAS float*)(X.lds + X.wave * 16384);
    const int gw = X.wg * NWAVES + X.wave, NGW = X.G * NWAVES;
    {
        float* MODP = WSP(float, WS_MODP);
        for (int it = gw; it < 96 * 16; it += NGW) {
            const int jc = it % 96, kc = it / 96, j = jc * 64 + X.lane;
            float a0 = 0.f, a1 = 0.f, a2 = 0.f, a3 = 0.f;
#pragma unroll 16
            for (int kk = 0; kk < 64; ++kk) { const int k = kc * 64 + kk; const float w = X.w_ada[(size_t)k * 6144 + j];
                const float c0 = X.c[k], c1 = X.c[1024 + k], c2 = X.c[2048 + k], c3 = X.c[3072 + k];
                a0 += c0 * sigmoidf_(c0) * w; a1 += c1 * sigmoidf_(c1) * w; a2 += c2 * sigmoidf_(c2) * w; a3 += c3 * sigmoidf_(c3) * w; }
            float* o = MODP + (size_t)kc * 24576 + j;
            o[0] = a0; o[6144] = a1; o[12288] = a2; o[18432] = a3;
        }
    }
    {
        float* ROPE = WSP(float, WS_ROPE);
        const int gt = X.wg * NTHREADS + X.tid, NGT = X.G * NTHREADS;
        for (int idx = gt; idx < T * 8; idx += NGT) { const int t = idx >> 3, i = idx & 7;
            const float inv_freq = 1.0f / powf(500000.0f, (float)(2 * i) / 16.0f);
            const float ang = (float)X.positions[t] * inv_freq;
            ROPE[t * 16 + i] = cosf(ang); ROPE[t * 16 + 8 + i] = sinf(ang); }
        if (X.wg == 0) { float* LB = WSP(float, WS_LB);
            for (int j = X.tid; j < 512; j += NTHREADS) { const float l0 = X.lb_logits[j], l1 = X.lb_logits[512 + j], m = fmaxf(l0, l1), e0 = __expf(l0 - m), e1 = __expf(l1 - m); LB[j] = e0 / (e0 + e1); } }
    }
}
struct CvtItem { const float* src; bf16_t* dst; };
template <bool GU> __device__ __forceinline__ CvtItem cvt_item(const Ctx& X, int it) {
    CvtItem c;
    if constexpr (GU) { const int e = it >> 7, q = it & 127, w8 = q & 7, sq = q >> 3, kb = 4 * (sq >> 2) + (w8 & 3), nb = 2 * (sq & 3) + (w8 >> 2);
        const int n0 = nb * 64, pn = n0 >> 8, bj = (n0 >> 7) & 1, idx = n0 & 127, srcc = bj * 256 + pn * 128 + idx;
        const float* W = (e < NE) ? X.w_egu + (size_t)e * 1024 * 512 : X.w_sgu;
        c.src = W + (size_t)(kb * 64) * 512 + srcc; c.dst = (bf16_t*)(X.ws + WS_WGU + ((size_t)e * 512 + n0) * 1024 + kb * 64); }
    else { const int e = it >> 6, q = it & 63, w8 = q & 7, sq = q >> 3, kb = w8 & 3, nb = 2 * sq + (w8 >> 2);
        const float* W = (e < NE) ? X.w_edown + (size_t)e * 256 * 1024 : X.w_sdown;
        c.src = W + (size_t)(kb * 64) * 1024 + nb * 64; c.dst = (bf16_t*)(X.ws + WS_WD + ((size_t)e * 1024 + nb * 64) * 256 + kb * 64); }
    return c;
}
template <int KB> __device__ __forceinline__ void cvt_store8(const CvtItem& c, int lane, const f32x4 (&v)[16], LAS unsigned char* tl, float sc) {
    const int kq = lane >> 4, nq = lane & 15;
#pragma unroll
    for (int i = 0; i < 4; ++i) { u32x4 w;
        w.x = pk4_fp8(v[0][i] * sc, v[1][i] * sc, v[2][i] * sc, v[3][i] * sc); w.y = pk4_fp8(v[4][i] * sc, v[5][i] * sc, v[6][i] * sc, v[7][i] * sc);
        w.z = pk4_fp8(v[8][i] * sc, v[9][i] * sc, v[10][i] * sc, v[11][i] * sc); w.w = pk4_fp8(v[12][i] * sc, v[13][i] * sc, v[14][i] * sc, v[15][i] * sc);
        *(LAS u32x4*)(tl + (4 * nq + i) * 80 + kq * 16) = w; }
    LDS_WAIT(); asm volatile("" ::: "memory");
    const int ch = lane & 3, r = lane >> 2;
    unsigned char* d8 = (unsigned char*)c.dst;
#pragma unroll
    for (int j = 0; j < 4; ++j) { const int n = 16 * j + r; const u32x4 w = *(const LAS u32x4*)(tl + n * 80 + ch * 16); __builtin_nontemporal_store(w, (u32x4*)(d8 + (size_t)n * KB + 16 * ch)); }
    LDS_WAIT(); asm volatile("" ::: "memory");
}
template <int N> __device__ __forceinline__ void cvt_load(const CvtItem& c, int lane, f32x4 (&v)[16]) {
    const float* p = c.src + (size_t)(16 * (lane >> 4)) * N + 4 * (lane & 15);
#pragma unroll
    for (int j = 0; j < 16; ++j) v[j] = __builtin_nontemporal_load((const f32x4*)(p + (size_t)j * N));
}
template <int K> __device__ __forceinline__ void cvt_store(const CvtItem& c, int lane, const f32x4 (&v)[16], LAS unsigned char* tl) {
    const int kq = lane >> 4, nq = lane & 15;
#pragma unroll
    for (int i = 0; i < 4; ++i) { u32x4 w0, w1;
        w0.x = pk2(v[0][i], v[1][i]); w0.y = pk2(v[2][i], v[3][i]); w0.z = pk2(v[4][i], v[5][i]); w0.w = pk2(v[6][i], v[7][i]);
        w1.x = pk2(v[8][i], v[9][i]); w1.y = pk2(v[10][i], v[11][i]); w1.z = pk2(v[12][i], v[13][i]); w1.w = pk2(v[14][i], v[15][i]);
        LAS unsigned char* q = tl + (4 * nq + i) * 144 + kq * 32; *(LAS u32x4*)q = w0; *(LAS u32x4*)(q + 16) = w1; }
    LDS_WAIT(); asm volatile("" ::: "memory");
    const int ch = lane & 7, r = lane >> 3;
#pragma unroll
    for (int j = 0; j < 8; ++j) { const int n = 8 * j + r; const u32x4 w = *(const LAS u32x4*)(tl + n * 144 + ch * 16); __builtin_nontemporal_store(w, (u32x4*)(c.dst + (size_t)n * K + 8 * ch)); }
    LDS_WAIT(); asm volatile("" ::: "memory");
}
struct CvtPair { const float* src; unsigned char* dst; };
template <bool GU> __device__ __forceinline__ CvtPair cvt_pair(const Ctx& X, int di) {
    CvtPair c;
    if constexpr (GU) { const int e = di >> 6, q = di & 63, nb = q & 7, kb2 = q >> 3;
        const int n0 = nb * 64, pn = n0 >> 8, bj = (n0 >> 7) & 1, idx = n0 & 127, srcc = bj * 256 + pn * 128 + idx;
        const float* W = (e < NE) ? X.w_egu + (size_t)e * 1024 * 512 : X.w_sgu;
        c.src = W + (size_t)(kb2 * 128) * 512 + srcc; c.dst = X.ws + WS_WGU + ((size_t)e * 512 + n0) * 1024 + kb2 * 128; }
    else { const int e = di >> 5, q = di & 31, nb = q & 15, kb2 = q >> 4;
        const float* W = (e < NE) ? X.w_edown + (size_t)e * 256 * 1024 : X.w_sdown;
        c.src = W + (size_t)(kb2 * 128) * 1024 + nb * 64; c.dst = X.ws + WS_WD + ((size_t)e * 1024 + nb * 64) * 256 + kb2 * 128; }
    return c;
}
template <int N> __device__ __forceinline__ void cvt_load_half(const CvtPair& c, int half, int lane, f32x4 (&v)[16]) {
    const float* p = c.src + (size_t)(64 * half + 16 * (lane >> 4)) * N + 4 * (lane & 15);
#pragma unroll
    for (int j = 0; j < 16; ++j) v[j] = __builtin_nontemporal_load((const f32x4*)(p + (size_t)j * N));
}
__device__ __forceinline__ void cvt_half_to_lds(int half, int lane, const f32x4 (&v)[16], LAS unsigned char* tl, float sc) {
    const int kq = lane >> 4, nq = lane & 15;
#pragma unroll
    for (int i = 0; i < 4; ++i) { u32x4 w;
        w.x = pk4_fp8(v[0][i] * sc, v[1][i] * sc, v[2][i] * sc, v[3][i] * sc); w.y = pk4_fp8(v[4][i] * sc, v[5][i] * sc, v[6][i] * sc, v[7][i] * sc);
        w.z = pk4_fp8(v[8][i] * sc, v[9][i] * sc, v[10][i] * sc, v[11][i] * sc); w.w = pk4_fp8(v[12][i] * sc, v[13][i] * sc, v[14][i] * sc, v[15][i] * sc);
        *(LAS u32x4*)(tl + (4 * nq + i) * 144 + half * 64 + kq * 16) = w; }
}
template <int KB> __device__ __forceinline__ void cvt_flush(const CvtPair& c, int lane, LAS unsigned char* tl) {
    LDS_WAIT(); asm volatile("" ::: "memory");
    const int ch = lane & 7, r = lane >> 3;
#pragma unroll
    for (int j = 0; j < 8; ++j) { const int n = 8 * j + r; const u32x4 w = *(const LAS u32x4*)(tl + n * 144 + ch * 16); __builtin_nontemporal_store(w, (u32x4*)(c.dst + (size_t)n * KB + 16 * ch)); }
    LDS_WAIT(); asm volatile("" ::: "memory");
}
template <bool GU> __device__ __forceinline__ void expert_convert_set(Ctx& X, int gw, int NGW, LAS unsigned char* tl) {
    constexpr int NIT = GU ? NEX * 64 : NEX * 32, N = GU ? 512 : 1024, K = GU ? 1024 : 256; constexpr float SC = GU ? WGU_SCALE : WD_SCALE;
    if (gw >= NIT) return;
    const int nmine = (NIT - gw + NGW - 1) / NGW;
    f32x4 va[16], vb[16];
    CvtPair cur = cvt_pair<GU>(X, gw);
    cvt_load_half<N>(cur, 0, X.lane, va); cvt_load_half<N>(cur, 1, X.lane, vb);
    for (int j = 0; j < nmine; ++j) {
        const CvtPair nxt = cvt_pair<GU>(X, gw + (j + 1 < nmine ? j + 1 : j) * NGW);
        __builtin_amdgcn_sched_barrier(0);
        cvt_half_to_lds(0, X.lane, va, tl, SC);
        __builtin_amdgcn_sched_barrier(0);
        cvt_load_half<N>(nxt, 0, X.lane, va);
        __builtin_amdgcn_sched_barrier(0);
        cvt_half_to_lds(1, X.lane, vb, tl, SC);
        cvt_flush<K>(cur, X.lane, tl);
        __builtin_amdgcn_sched_barrier(0);
        cvt_load_half<N>(nxt, 1, X.lane, vb);
        __builtin_amdgcn_sched_barrier(0);
        cur = nxt;
    }
}
__device__ __forceinline__ void expert_convert(Ctx& X, int cw, int ncw) {
    LAS unsigned char* tl = X.lds + X.wave * 16384;
    const int gw = cw * NWAVES + X.wave, NGW = ncw * NWAVES;
    expert_convert_set<true>(X, gw, NGW, tl);
    expert_convert_set<false>(X, gw, NGW, tl);
}

__device__ __forceinline__ void small_transposes(Ctx& X) {
    LAS float* scr = (LAS float*)(X.lds + 16384 + X.wave * 12288);
    const int gw = X.wg * NWAVES + X.wave, NGW = X.G * NWAVES;
    {
        constexpr int I_IN = 16 * 272, I_PA = 8 * 32, I_PB = 8 * 32, I_OUT = 16 * 32, I_R = 16 * 8;
        constexpr int NITEMS = I_IN + I_PA + I_PB + I_OUT + I_R;
        for (int it = gw; it < NITEMS; it += NGW) {
            int r = it;
            if (r < I_IN) { transpose_plain(X.w_in, 1024, INW, WSP(bf16_t, WS_WIN), r, scr, X.lane); continue; } r -= I_IN;
            if (r < I_PA) { transpose_plain(X.w_pa, 512, 1024, WSP(bf16_t, WS_WPA), r, scr, X.lane); continue; } r -= I_PA;
            if (r < I_PB) { transpose_plain(X.w_pb, 512, 1024, WSP(bf16_t, WS_WPB), r, scr, X.lane); continue; } r -= I_PB;
            if (r < I_OUT) { transpose_plain(X.w_out, 1024, 1024, WSP(bf16_t, WS_WOUT), r, scr, X.lane); continue; } r -= I_OUT;
            transpose_plain(X.w_router, 1024, 256, WSP(bf16_t, WS_WR), r, scr, X.lane);
        }
    }
}

__device__ __forceinline__ void norm_rows(Ctx& X, int which) {
    LAS float* sm = (LAS float*)X.lds;
    const float* MODP = WSP(float, WS_MODP); float* MOD = WSP(float, WS_MOD);
    const int rows_per_wg = T / X.G, row0 = X.wg * rows_per_wg, b = row0 / SEQ;
    if (which == 0) {
        for (int i = X.tid; i < 2048; i += NTHREADS) { const int j = b * 6144 + i; float s = X.b_ada[i];
#pragma unroll
            for (int p = 0; p < 16; ++p) s += MODP[(size_t)p * 24576 + j];
            sm[i] = s; }
        const int per = 24576 / X.G;
        for (int i = X.tid; i < per; i += NTHREADS) { const int j = X.wg * per + i; float s = X.b_ada[j % 6144];
#pragma unroll
            for (int p = 0; p < 16; ++p) s += MODP[(size_t)p * 24576 + j];
            MOD[j] = s; }
    } else {
        for (int i = X.tid; i < 2048; i += NTHREADS) sm[i] = MOD[b * 6144 + 3072 + i];
    }
    __syncthreads();
    const float* src = X.x; const bf16_t* srcb = WSP(bf16_t, WS_X1); const float* g = which == 0 ? X.g1 : X.g2;
    bf16_t* H = WSP(bf16_t, WS_H);
    for (int r = X.wave; r < rows_per_wg; r += NWAVES) {
        const int row = row0 + r;
        f32x4 v[2][2]; float s = 0.f;
#pragma unroll
        for (int j = 0; j < 2; ++j) { const int col = 8 * X.lane + 512 * j;
            if (which == 0) { v[j][0] = *(const f32x4*)(src + (size_t)row * D + col); v[j][1] = *(const f32x4*)(src + (size_t)row * D + col + 4); }
            else { const u32x4 wv = *(const u32x4*)(srcb + (size_t)row * D + col); v[j][0] = (f32x4){bflo(wv.x), bfhi(wv.x), bflo(wv.y), bfhi(wv.y)}; v[j][1] = (f32x4){bflo(wv.z), bfhi(wv.z), bflo(wv.w), bfhi(wv.w)}; }
#pragma unroll
            for (int q = 0; q < 2; ++q) s += (v[j][q].x * v[j][q].x + v[j][q].y * v[j][q].y) + (v[j][q].z * v[j][q].z + v[j][q].w * v[j][q].w); }
        const float rstd = rsqrtf(wave_sum(s) * (1.f / D) + EPS);
#pragma unroll
        for (int j = 0; j < 2; ++j) { const int col = 8 * X.lane + 512 * j; float y[8];
#pragma unroll
            for (int q = 0; q < 2; ++q) { const f32x4 gg = *(const f32x4*)(g + col + 4 * q), sh = *(const LAS f32x4*)(sm + col + 4 * q), sc = *(const LAS f32x4*)(sm + 1024 + col + 4 * q);
#pragma unroll
                for (int e = 0; e < 4; ++e) y[4 * q + e] = v[j][q][e] * rstd * gg[e] * (1.f + sc[e]) + sh[e]; }
            u32x4 hw; hw.x = pk2(y[0], y[1]); hw.y = pk2(y[2], y[3]); hw.z = pk2(y[4], y[5]); hw.w = pk2(y[6], y[7]);
            if (which == 1) { st_wt16(H + (size_t)row * D + col, hw);
                st_wt8(WSP(unsigned char, WS_H8) + (size_t)row * D + col, (unsigned long long)pk4_fp8(y[0], y[1], y[2], y[3]) | ((unsigned long long)pk4_fp8(y[4], y[5], y[6], y[7]) << 32)); }
            else *(u32x4*)(H + (size_t)row * D + col) = hw; }
    }
    __syncthreads();
}

struct RegSched {
    static constexpr bool HALFSKIP = false;
    const char* A; const char* Bt; size_t a_tile, b_tile; int nM, nN, G, c;
    __device__ __forceinline__ bool next(int i, pg8::Unit& u) const {
        const int L = i * G + c; if (L >= nM * nN) return false;
        int pm, pn; pg8::swz_tile(L, nM, nN, pm, pn);
        u.a = A + (size_t)pm * a_tile; u.b = Bt + (size_t)pn * b_tile; u.rows = nullptr; u.pm = pm; u.pn = pn; u.aux = 0; u.nvalid = 256; return true;
    }
};
struct TwoPartSched {      static constexpr bool HALFSKIP = false;
    const char* Y; const char* Wa; const char* Wb; int nM, nN, G, c;
    __device__ __forceinline__ bool next(int i, pg8::Unit& u) const {
        const int L = (i >> 1) * G + c, part = i & 1; if (L >= nM * nN) return false;
        int pm, pn; pg8::swz_tile(L, nM, nN, pm, pn);
        u.a = Y + (size_t)pm * 256 * 2048 + part * 1024; u.b = (part ? Wb : Wa) + (size_t)pn * 256 * 1024; u.rows = nullptr; u.pm = pm; u.pn = pn; u.aux = part; u.nvalid = 256; return true;
    }
};
struct MoeSched {
    static constexpr bool HALFSKIP = true;
    const LAS int* tbl; const LAS int* cnts; int nent; const char* A; const char* W; const int* lists; int ncol  , wtile  , wexp  , atile  , G, c;
    __device__ __forceinline__ bool next(int i, pg8::Unit& u) const {
        const int un = i * (G >> 3) + (c >> 3); if (un >= nent * ncol) return false;
        const int pn = un % ncol; const int ent = __builtin_amdgcn_readfirstlane(tbl[un / ncol]), e = (ent >> 7) & 511, r = ent & 127, rt = ent >> 16;
        u.a = A + (size_t)rt * atile; u.b = W + (size_t)e * wexp + (size_t)pn * wtile; u.rows = lists + (size_t)e * 16384 + r * 256;
        u.pm = rt; u.pn = pn; u.aux = e; const int left = __builtin_amdgcn_readfirstlane(cnts[e]) - r * 256; u.nvalid = left < 256 ? left : 256; return true;
    }
};

struct EpiInproj {
    static constexpr bool PERM = true;
    bf16_t* PROJ; float* LOGF; const float* LB; const float* ROPE; unsigned char* G8; unsigned char* QK8;
    __device__ __forceinline__ bool keep(const pg8::Unit&) const { return false; }
    __device__ __forceinline__ void operator()(f32x4 (&acc)[2][2][4][2], const pg8::Unit& u, int wr, int wc, int fr, int fq) const {
        const int pn = u.pn;
        const int mode = pn < 2 ? 0 : pn < 4 ? 1 : pn < 6 ? 0 : pn < 8 ? 2 : pn < 20 ? 3 : pn < 26 ? 5 : 4;
        const int row0 = u.pm * 256 + wr * 64 + fr, colb = pn * 256 + wc * 32 + 8 * fq;
        const bool rot = (mode == 3) && ((wc & 1) == 0);
#pragma unroll
        for (int ai = 0; ai < 2; ++ai)
#pragma unroll
            for (int m = 0; m < 4; ++m) {
                const int row = row0 + ai * 128 + m * 16;
                f32x4 cs0, cs1, sn0, sn1;
                if (rot) { const f32x4* rp = (const f32x4*)(ROPE + (size_t)row * 16); cs0 = rp[0]; cs1 = rp[1]; sn0 = rp[2]; sn1 = rp[3]; }
#pragma unroll
                for (int bj = 0; bj < 2; ++bj) {
                    const int col = colb + bj * 128;
                    f32x4 v0 = acc[ai][bj][m][0], v1 = acc[ai][bj][m][1];
                    if (mode == 1) {
                        const int cf = col - 512; const f32x4 l0 = *(const f32x4*)(LB + cf), l1 = *(const f32x4*)(LB + cf + 4);
                        f32x4 lf0, lf1;
#pragma unroll
                        for (int j = 0; j < 4; ++j) { float sg = sigmoidf_(v0[j]); float f = l0[j] + (1.f - l0[j]) * sg; lf0[j] = fast_logf(f); v0[j] = (1.f - l0[j]) * (1.f - sg);
                            sg = sigmoidf_(v1[j]); f = l1[j] + (1.f - l1[j]) * sg; lf1[j] = fast_logf(f); v1[j] = (1.f - l1[j]) * (1.f - sg); }
                        acc[ai][bj][m][0] = lf0; acc[ai][bj][m][1] = lf1;
                    } else if (mode == 2) {
#pragma unroll
                        for (int j = 0; j < 4; ++j) { v0[j] = v0[j] * sigmoidf_(v0[j]); v1[j] = v1[j] * sigmoidf_(v1[j]); }
                    } else if (mode == 4) {
#pragma unroll
                        for (int j = 0; j < 4; ++j) { v0[j] = sigmoidf_(v0[j]); v1[j] = sigmoidf_(v1[j]); }
                    } else if (rot) {
                        f32x4 p0, p1;
#pragma unroll
                        for (int j = 0; j < 4; ++j) { p0[j] = __shfl_xor(v0[j], 16); p1[j] = __shfl_xor(v1[j], 16); }
                        if (fq == 0) { v0 = v0 * cs0 - p0 * sn0; v1 = v1 * cs1 - p1 * sn1; }
                        else if (fq == 1) { v0 = v0 * cs0 + p0 * sn0; v1 = v1 * cs1 + p1 * sn1; }
                    }
                    if (mode == 4) {
                        int g0 = 0, g1 = 0;
#pragma unroll
                        for (int j = 0; j < 4; ++j) { g0 = __builtin_amdgcn_cvt_pk_u8_f32(fmaxf(v0[j] * 255.0f, 1.0f), j, g0); g1 = __builtin_amdgcn_cvt_pk_u8_f32(fmaxf(v1[j] * 255.0f, 1.0f), j, g1); }
                        *(u32x2*)(G8 + (size_t)row * 2048 + (col - C_GA)) = (u32x2){(unsigned)g0, (unsigned)g1};
                        continue; }
                    if (mode == 3 || mode == 5) {
                        *(u32x2*)(QK8 + (size_t)row * 4608 + (col - C_AQ)) = (u32x2){pk4_fp8(v0[0], v0[1], v0[2], v0[3]), pk4_fp8(v1[0], v1[1], v1[2], v1[3])};
                        continue; }
                    u32x4 w; w.x = pg8::cvt_pk_bf16(v0[0], v0[1]); w.y = pg8::cvt_pk_bf16(v0[2], v0[3]); w.z = pg8::cvt_pk_bf16(v1[0], v1[1]); w.w = pg8::cvt_pk_bf16(v1[2], v1[3]);
                    *(u32x4*)(PROJ + (size_t)row * INW + col) = w;
                }
            }
        if (mode == 1) {
            const int lane = fq * 16 + fr;
#pragma unroll
            for (int ai = 0; ai < 2; ++ai)
#pragma unroll
                for (int bj = 0; bj < 2; ++bj)
#pragma unroll
                    for (int n = 0; n < 2; ++n)
#pragma unroll
                        for (int j = 0; j < 4; ++j) { float carry = 0.f;
#pragma unroll
                            for (int m = 0; m < 4; ++m) { float v = acc[ai][bj][m][n][j];
                                v += __builtin_bit_cast(float, __builtin_amdgcn_update_dpp(0, __builtin_bit_cast(int, v), 0x111, 0xF, 0xF, true));
                                v += __builtin_bit_cast(float, __builtin_amdgcn_update_dpp(0, __builtin_bit_cast(int, v), 0x112, 0xF, 0xF, true));
                                v += __builtin_bit_cast(float, __builtin_amdgcn_update_dpp(0, __builtin_bit_cast(int, v), 0x114, 0xF, 0xF, true));
                                v += __builtin_bit_cast(float, __builtin_amdgcn_update_dpp(0, __builtin_bit_cast(int, v), 0x118, 0xF, 0xF, true));
                                v += carry; acc[ai][bj][m][n][j] = v; carry = __shfl(v, (lane & 48) | 15); } }
#pragma unroll
            for (int ai = 0; ai < 2; ++ai)
#pragma unroll
                for (int m = 0; m < 4; ++m)
#pragma unroll
                    for (int bj = 0; bj < 2; ++bj) { float* lp = LOGF + (size_t)(row0 + ai * 128 + m * 16) * 512 + (colb + bj * 128 - 512); *(f32x4*)lp = acc[ai][bj][m][0]; *(f32x4*)(lp + 4) = acc[ai][bj][m][1]; }
        }
    }
};
__device__ __forceinline__ void gate8(u32x2 w, f32x4& lo, f32x4& hi) {
    constexpr float s = 1.0f / 255.0f;
    lo = (f32x4){(float)(w.x & 255u), (float)((w.x >> 8) & 255u), (float)((w.x >> 16) & 255u), (float)(w.x >> 24)} * s;
    hi = (f32x4){(float)(w.y & 255u), (float)((w.y >> 8) & 255u), (float)((w.y >> 16) & 255u), (float)(w.y >> 24)} * s;
}
struct EpiMixed {
    static constexpr bool PERM = true;
    const unsigned char* G8; bf16_t* MIXED;
    __device__ __forceinline__ bool keep(const pg8::Unit& u) const { return u.aux == 0; }
    __device__ __forceinline__ void operator()(f32x4 (&acc)[2][2][4][2], const pg8::Unit& u, int wr, int wc, int fr, int fq) const {
        const int row0 = u.pm * 256 + wr * 64 + fr, colb = u.pn * 256 + wc * 32 + 8 * fq;
#pragma unroll
        for (int ai = 0; ai < 2; ++ai)
#pragma unroll
            for (int m = 0; m < 4; ++m) {
                const int row = row0 + ai * 128 + m * 16;
#pragma unroll
                for (int bj = 0; bj < 2; ++bj) {
                    const int col = colb + bj * 128;
                    f32x4 b0, b1; gate8(*(const u32x2*)(G8 + (size_t)row * 2048 + 1024 + col), b0, b1);
                    if (u.aux == 0) {
                        f32x4 a0, a1; gate8(*(const u32x2*)(G8 + (size_t)row * 2048 + col), a0, a1);
#pragma unroll
                        for (int j = 0; j < 4; ++j) { acc[ai][bj][m][0][j] *= a0[j] * __builtin_amdgcn_rcpf(b0[j]); acc[ai][bj][m][1][j] *= a1[j] * __builtin_amdgcn_rcpf(b1[j]); }
                    } else {
                        const f32x4 v0 = acc[ai][bj][m][0] * b0, v1 = acc[ai][bj][m][1] * b1;
                        u32x4 w; w.x = pg8::cvt_pk_bf16(v0[0], v0[1]); w.y = pg8::cvt_pk_bf16(v0[2], v0[3]); w.z = pg8::cvt_pk_bf16(v1[0], v1[1]); w.w = pg8::cvt_pk_bf16(v1[2], v1[3]);
                        st_wt16(MIXED + (size_t)row * D + col, w);
                    }
                }
            }
    }
};
struct EpiOutproj {
    static constexpr bool PERM = true;
    const float* x; const float* MOD; bf16_t* X1;
    __device__ __forceinline__ bool keep(const pg8::Unit&) const { return false; }
    __device__ __forceinline__ void operator()(f32x4 (&acc)[2][2][4][2], const pg8::Unit& u, int wr, int wc, int fr, int fq) const {
        const int row0 = u.pm * 256 + wr * 64 + fr, colb = u.pn * 256 + wc * 32 + 8 * fq;
        const int b = (u.pm * 256) / SEQ;
#pragma unroll
        for (int bj = 0; bj < 2; ++bj) {
            const int col = colb + bj * 128;
            const f32x4 g0 = *(const f32x4*)(MOD + b * 6144 + 2048 + col), g1 = *(const f32x4*)(MOD + b * 6144 + 2048 + col + 4);
#pragma unroll
            for (int ai = 0; ai < 2; ++ai)
#pragma unroll
                for (int m = 0; m < 4; ++m) { const size_t off = (size_t)(row0 + ai * 128 + m * 16) * D + col;
                    const f32x4 v0 = *(const f32x4*)(x + off) + g0 * acc[ai][bj][m][0], v1 = *(const f32x4*)(x + off + 4) + g1 * acc[ai][bj][m][1];
                    u32x4 w; w.x = pg8::cvt_pk_bf16(v0[0], v0[1]); w.y = pg8::cvt_pk_bf16(v0[2], v0[3]); w.z = pg8::cvt_pk_bf16(v1[0], v1[1]); w.w = pg8::cvt_pk_bf16(v1[2], v1[3]);
                    st_wt16(X1 + off, w); }
        }
    }
};
struct EpiOutNorm {
    static constexpr bool PERM = true;
    const float* x; const float* MOD; const float* g2; bf16_t* X1; bf16_t* H; unsigned char* H8; float* XB; unsigned* cnt; LAS unsigned char* sl;
    __device__ __forceinline__ bool keep(const pg8::Unit&) const { return false; }
    __device__ __forceinline__ void operator()(f32x4 (&acc)[2][2][4][2], const pg8::Unit& u, int wr, int wc, int fr, int fq) const {
        const int tid = threadIdx.x;
        const int rl0 = wr * 64 + fr, row0 = u.pm * 256 + rl0, colb = u.pn * 256 + wc * 32 + 8 * fq;
        const int b = (u.pm * 256) / SEQ;
        LAS float* Pt = (LAS float*)sl; LAS float* Rs = (LAS float*)(sl + 4096);
#pragma unroll
        for (int bj = 0; bj < 2; ++bj) {
            const int col = colb + bj * 128;
            const f32x4 g0 = *(const f32x4*)(MOD + b * 6144 + 2048 + col), g1 = *(const f32x4*)(MOD + b * 6144 + 2048 + col + 4);
#pragma unroll
            for (int ai = 0; ai < 2; ++ai)
#pragma unroll
                for (int m = 0; m < 4; ++m) { const size_t off = (size_t)(row0 + ai * 128 + m * 16) * D + col;
                    acc[ai][bj][m][0] = *(const f32x4*)(x + off) + g0 * acc[ai][bj][m][0]; acc[ai][bj][m][1] = *(const f32x4*)(x + off + 4) + g1 * acc[ai][bj][m][1];
                    asm volatile("" : "+v"(acc[ai][bj][m][0]), "+v"(acc[ai][bj][m][1]));
                    if (m & 1) asm volatile("" ::: "memory"); }
        }
#pragma unroll
        for (int ai = 0; ai < 2; ++ai)
#pragma unroll
            for (int m = 0; m < 4; ++m) { float q = 0.f;
#pragma unroll
                for (int bj = 0; bj < 2; ++bj)
#pragma unroll
                    for (int n = 0; n < 2; ++n) { const f32x4 v = acc[ai][bj][m][n]; q += (v[0] * v[0] + v[1] * v[1]) + (v[2] * v[2] + v[3] * v[3]); }
                q += __shfl_xor(q, 16); q += __shfl_xor(q, 32);
                if (fq == 0) Pt[(ai * 128 + rl0 + m * 16) * 4 + wc] = q; }
        asm volatile("s_waitcnt lgkmcnt(0)" ::: "memory"); __builtin_amdgcn_s_barrier(); asm volatile("" ::: "memory");
        if (tid < 256) { const f32x4 p = *(const LAS f32x4*)(Pt + tid * 4); st_wt4(XB + ((size_t)u.pm * 256 + tid) * 4 + u.pn, __builtin_bit_cast(unsigned, (p[0] + p[1]) + (p[2] + p[3]))); }
        asm volatile("s_waitcnt vmcnt(0)" ::: "memory"); __builtin_amdgcn_s_barrier(); asm volatile("" ::: "memory");
        if (tid == 0) { unsigned* p = cnt + (size_t)u.pm * 64; (void)xb_add(p, 1u); unsigned sp = 0u;
            while (xb_ld(p) < 4u) { __builtin_amdgcn_s_sleep(2); if (++sp > (1u << 22)) break; }
            __builtin_amdgcn_fence(__ATOMIC_ACQUIRE, "agent"); asm volatile("s_waitcnt vmcnt(0)" ::: "memory"); }
        __builtin_amdgcn_s_barrier(); asm volatile("" ::: "memory");
        if (tid < 256) { const f32x4 q = *(const f32x4*)(XB + ((size_t)u.pm * 256 + tid) * 4); Rs[tid] = rsqrtf(((q[0] + q[1]) + (q[2] + q[3])) * (1.f / D) + EPS); }
        asm volatile("s_waitcnt vmcnt(0) lgkmcnt(0)" ::: "memory"); __builtin_amdgcn_s_barrier(); asm volatile("" ::: "memory");
#pragma unroll
        for (int bj = 0; bj < 2; ++bj) {
            const int col = colb + bj * 128;
            f32x4 gg[2], sc[2], sh[2];
#pragma unroll
            for (int q = 0; q < 2; ++q) { gg[q] = *(const f32x4*)(g2 + col + 4 * q); sh[q] = *(const f32x4*)(MOD + b * 6144 + 3072 + col + 4 * q); sc[q] = *(const f32x4*)(MOD + b * 6144 + 4096 + col + 4 * q) + 1.0f; gg[q] = gg[q] * sc[q]; }
#pragma unroll
            for (int ai = 0; ai < 2; ++ai)
#pragma unroll
                for (int m = 0; m < 4; ++m) { const int rl = ai * 128 + rl0 + m * 16; const size_t off = (size_t)(u.pm * 256 + rl) * D + col; const float rs = Rs[rl];
                    const f32x4 v0 = acc[ai][bj][m][0], v1 = acc[ai][bj][m][1];
                    u32x4 w; w.x = pg8::cvt_pk_bf16(v0[0], v0[1]); w.y = pg8::cvt_pk_bf16(v0[2], v0[3]); w.z = pg8::cvt_pk_bf16(v1[0], v1[1]); w.w = pg8::cvt_pk_bf16(v1[2], v1[3]);
                    *(u32x4*)(X1 + off) = w;
                    const f32x4 h0 = v0 * rs * gg[0] + sh[0], h1 = v1 * rs * gg[1] + sh[1];
                    u32x4 hw; hw.x = pg8::cvt_pk_bf16(h0[0], h0[1]); hw.y = pg8::cvt_pk_bf16(h0[2], h0[3]); hw.z = pg8::cvt_pk_bf16(h1[0], h1[1]); hw.w = pg8::cvt_pk_bf16(h1[2], h1[3]);
                    st_wt16(H + off, hw);
                    st_wt8(H8 + off, (unsigned long long)pk4_fp8(h0[0], h0[1], h0[2], h0[3]) | ((unsigned long long)pk4_fp8(h1[0], h1[1], h1[2], h1[3]) << 32));
                    asm volatile("" ::: "memory"); }
        }
    }
};
struct EpiRouter {
    static constexpr bool PERM = false;
    float* LOGITS4;
    __device__ __forceinline__ bool keep(const pg8::Unit&) const { return false; }
    __device__ __forceinline__ void operator()(f32x4 (&acc)[2][2][4][2], const pg8::Unit& u, int wr, int wc, int fr, int fq) const {
        const int row0 = u.pm * 256 + wr * 64 + fr, colb = wc * 32 + 4 * fq;
        float* base = LOGITS4 + (size_t)u.aux * T * 256;
#pragma unroll
        for (int ai = 0; ai < 2; ++ai)
#pragma unroll
            for (int m = 0; m < 4; ++m)
#pragma unroll
                for (int bj = 0; bj < 2; ++bj)
#pragma unroll
                    for (int n = 0; n < 2; ++n) st_wt16(base + (size_t)(row0 + ai * 128 + m * 16) * 256 + colb + bj * 128 + n * 16, __builtin_bit_cast(u32x4, acc[ai][bj][m][n]));
    }
};
struct RouterSched {
    static constexpr bool HALFSKIP = false;
    const char* A; const char* Bt; int G, c;
    __device__ __forceinline__ bool next(int i, pg8::Unit& u) const {
        const int L = i * G + c; if (L >= 256) return false;
        const int pm = L >> 2, ks = L & 3;
        u.a = A + (size_t)pm * 256 * 2048 + ks * 512; u.b = Bt + ks * 512; u.rows = nullptr; u.pm = pm; u.pn = 0; u.aux = ks; u.nvalid = 256; return true;
    }
};
struct EpiGU {
    static constexpr bool PERM = true;
    unsigned char* ACT;
    __device__ __forceinline__ bool keep(const pg8::Unit&) const { return false; }
    __device__ __forceinline__ void operator()(f32x4 (&acc)[2][2][4][2], const pg8::Unit& u, int wr, int wc, int fr, int fq) const {
        const int rl0 = wr * 64 + fr, col = u.pn * 128 + wc * 32 + 8 * fq;
        constexpr float is = 1.0f / WGU_SCALE;
#pragma unroll
        for (int ai = 0; ai < 2; ++ai)
#pragma unroll
            for (int m = 0; m < 4; ++m) {
                const int rl = rl0 + ai * 128 + m * 16;
                f32x4 v0, v1;
#pragma unroll
                for (int j = 0; j < 4; ++j) { const float a0 = acc[ai][0][m][0][j] * is, a1 = acc[ai][0][m][1][j] * is;
                    v0[j] = a0 * sigmoidf_(a0) * (acc[ai][1][m][0][j] * is); v1[j] = a1 * sigmoidf_(a1) * (acc[ai][1][m][1][j] * is); }
                *(u32x2*)(ACT + ((size_t)u.pm * 256 + rl) * EFF + col) = (u32x2){pk4_fp8(v0[0], v0[1], v0[2], v0[3]), pk4_fp8(v1[0], v1[1], v1[2], v1[3])};
                asm volatile("" ::: "memory");
            }
    }
};
struct EpiDown {
    static constexpr bool PERM = true;
    unsigned char* YBUF; const float* GATEW;
    __device__ __forceinline__ bool keep(const pg8::Unit&) const { return false; }
    __device__ __forceinline__ void operator()(f32x4 (&acc)[2][2][4][2], const pg8::Unit& u, int wr, int wc, int fr, int fq) const {
        const int rl0 = wr * 64 + fr, colb = u.pn * 256 + wc * 32 + 8 * fq;
#pragma unroll
        for (int ai = 0; ai < 2; ++ai)
#pragma unroll
            for (int m = 0; m < 4; ++m) {
                const int rl = rl0 + ai * 128 + m * 16;
                if (rl < u.nvalid) {
                    const int slot = u.rows[rl]; const float gw = GATEW[slot] * (YSCALE / WD_SCALE);
#pragma unroll
                    for (int bj = 0; bj < 2; ++bj) { const f32x4 v0 = acc[ai][bj][m][0] * gw, v1 = acc[ai][bj][m][1] * gw;
                        *(u32x2*)(YBUF + (size_t)slot * D + colb + bj * 128) = (u32x2){pk4_fp8(v0[0], v0[1], v0[2], v0[3]), pk4_fp8(v1[0], v1[1], v1[2], v1[3])}; }
                }
                asm volatile("" ::: "memory");
            }
    }
};

#define MFMA16(a, b, c) __builtin_amdgcn_mfma_f32_16x16x32_bf16((a), (b), (c), 0, 0, 0)
#define MFMA32(a, b, c) __builtin_amdgcn_mfma_f32_32x32x16_bf16((a), (b), (c), 0, 0, 0)
__device__ __forceinline__ s16x4 tr16(const LAS unsigned char* p) { return __builtin_amdgcn_ds_read_tr16_b64_v4i16((LAS s16x4*)p); }
__device__ __forceinline__ bf16x8 cat8(s16x4 a, s16x4 b) { bf16x8 r; r[0] = a[0]; r[1] = a[1]; r[2] = a[2]; r[3] = a[3]; r[4] = b[0]; r[5] = b[1]; r[6] = b[2]; r[7] = b[3]; return r; }
__device__ __forceinline__ u32x4 pack8(const float (&v)[8]) { u32x4 w; w.x = pg8::cvt_pk_bf16(v[0], v[1]); w.y = pg8::cvt_pk_bf16(v[2], v[3]); w.z = pg8::cvt_pk_bf16(v[4], v[5]); w.w = pg8::cvt_pk_bf16(v[6], v[7]); return w; }
__device__ __forceinline__ void unpack8(u32x4 w, float (&v)[8]) { v[0] = bflo(w.x); v[1] = bfhi(w.x); v[2] = bflo(w.y); v[3] = bfhi(w.y); v[4] = bflo(w.z); v[5] = bfhi(w.z); v[6] = bflo(w.w); v[7] = bfhi(w.w); }
__device__ __forceinline__ int swzA(int row) { return (row & 3) | (((row >> 3) & 1) << 2); }
__device__ __forceinline__ void hgrn_kv_unit(Ctx& X, int bn) {
    const int t0 = bn * 64;
    const bf16_t* PROJ = WSP(bf16_t, WS_PROJ); const float* BC = WSP(float, WS_LOGF);
#pragma unroll 2
    for (int j = 0; j < 8; ++j) {
        const int p = X.tid + NTHREADS * j, row = p >> 6, c64 = p & 63, h = c64 >> 4, ch = c64 & 15;
        const size_t prow = (size_t)(t0 + row) * INW + h * 128 + 8 * ch;
        const u32x4 kraw = *(const u32x4*)(PROJ + prow + C_HK), vraw = *(const u32x4*)(PROJ + prow + C_HV);
        const float* bp = BC + (size_t)(t0 + row) * 512 + h * 128 + 8 * ch; const float* bl = BC + (size_t)(t0 + 63) * 512 + h * 128 + 8 * ch;
        const f32x4 b0 = *(const f32x4*)bp, b1 = *(const f32x4*)(bp + 4), l0 = *(const f32x4*)bl, l1 = *(const f32x4*)(bl + 4);
        float kv[8]; unpack8(kraw, kv);
#pragma unroll
        for (int e = 0; e < 4; ++e) { kv[e] *= __expf(l0[e] - b0[e]); kv[4 + e] *= __expf(l1[e] - b1[e]); }
        const int off = row * 256 + (((ch >> 1) ^ swzA(row)) * 32) + (ch & 1) * 16;
        *(LAS u32x4*)(X.lds + h * 32768 + off) = vraw; *(LAS u32x4*)(X.lds + h * 32768 + 16384 + off) = pack8(kv);
    }
    WSP(float, WS_DECAY)[bn * 512 + X.tid] = __expf(BC[(size_t)(t0 + 63) * 512 + X.tid]);
    __syncthreads();
    const int l = X.lane, w = X.wave, fr = l & 15, fq = l >> 4, r = fr >> 2, p4 = l & 3, h = w >> 1, vt0 = 4 * (w & 1);
    const LAS unsigned char* VI = X.lds + h * 32768; const LAS unsigned char* KI = VI + 16384;
    bf16x8 af[4][2];
#pragma unroll
    for (int vt = 0; vt < 4; ++vt)
#pragma unroll
        for (int kk = 0; kk < 2; ++kk) { const int r0 = 32 * kk + 8 * fq + r, r1 = r0 + 4;
            af[vt][kk] = cat8(tr16(VI + r0 * 256 + (((vt0 + vt) ^ swzA(r0)) * 32) + p4 * 8), tr16(VI + r1 * 256 + (((vt0 + vt) ^ swzA(r1)) * 32) + p4 * 8)); }
    bf16_t* KVT = WSP(bf16_t, WS_KVT) + (size_t)(bn * 4 + h) * 16384;
#pragma unroll 2
    for (int ct = 0; ct < 8; ++ct) {
        bf16x8 bfr[2];
#pragma unroll
        for (int kk = 0; kk < 2; ++kk) { const int r0 = 32 * kk + 8 * fq + r, r1 = r0 + 4;
            bfr[kk] = cat8(tr16(KI + r0 * 256 + ((ct ^ swzA(r0)) * 32) + p4 * 8), tr16(KI + r1 * 256 + ((ct ^ swzA(r1)) * 32) + p4 * 8)); }
#pragma unroll
        for (int vt = 0; vt < 4; ++vt) { f32x4 acc = {0.f, 0.f, 0.f, 0.f}; acc = MFMA16(bfr[0], af[vt][0], acc); acc = MFMA16(bfr[1], af[vt][1], acc);
            u32x2 wv; wv.x = pg8::cvt_pk_bf16(acc[0], acc[1]); wv.y = pg8::cvt_pk_bf16(acc[2], acc[3]);
            *(u32x2*)(KVT + (16 * (vt0 + vt) + fr) * 128 + 16 * ct + 4 * fq) = wv; }
    }
    __syncthreads();
}
__device__ __forceinline__ void hgrn_passB(Ctx& X) {
    const unsigned* KVT = WSP(unsigned, WS_KVT); const float* DECAY = WSP(float, WS_DECAY); unsigned* SPT = WSP(unsigned, WS_SPT);
    const int gt = X.wg * NTHREADS + X.tid, NGT = X.G * NTHREADS;
    for (int item = gt; item < 16 * 128 * 64; item += NGT) {
        const int bh = item >> 13, rem = item & 8191, vd = rem >> 6, c = (rem & 63) * 2, b = bh >> 2, h = bh & 3;
        float s0 = 0.f, s1 = 0.f;
#pragma unroll 8
        for (int n = 0; n < 64; ++n) {
            const int unit = (b * 64 + n) * 4 + h;
            const unsigned kw = KVT[((size_t)unit * 16384 + vd * 128 + c) >> 1]; const f32x2 kv = {bflo(kw), bfhi(kw)};
            const f32x2 dc = *(const f32x2*)(DECAY + unit * 128 + c);
            SPT[((size_t)unit * 16384 + vd * 128 + c) >> 1] = pk2(s0, s1);
            s0 = dc.x * s0 + kv.x; s1 = dc.y * s1 + kv.y;
        }
    }
}
__device__ __forceinline__ void hgrn_out_unit(Ctx& X, int u2) {
    const int bn = u2 >> 1, hp = u2 & 1, t0 = bn * 64;
    const bf16_t* PROJ = WSP(bf16_t, WS_PROJ); const float* BCg = WSP(float, WS_LOGF);
#pragma unroll 2
    for (int j = 0; j < 4; ++j) { const int p = X.tid + NTHREADS * j, row = p >> 5, c32 = p & 31, hh = c32 >> 4, ch = c32 & 15, h = 2 * hp + hh;
        const size_t prow = (size_t)(t0 + row) * INW + h * 128 + 8 * ch;
        const u32x4 qraw = *(const u32x4*)(PROJ + prow + C_HQ), kraw = *(const u32x4*)(PROJ + prow + C_HK), vraw = *(const u32x4*)(PROJ + prow + C_HV);
        const float* bp = BCg + (size_t)(t0 + row) * 512 + h * 128 + 8 * ch; const float* br = BCg + (size_t)(t0 + 32) * 512 + h * 128 + 8 * ch;
        const f32x4 b0 = *(const f32x4*)bp, b1 = *(const f32x4*)(bp + 4), r0 = *(const f32x4*)br, r1 = *(const f32x4*)(br + 4);
        float qv[8], kv[8], a[8], bq[8]; unpack8(qraw, qv); unpack8(kraw, kv);
#pragma unroll
        for (int e = 0; e < 4; ++e) { const float e0 = __expf(b0[e] - r0[e]), e1 = __expf(b1[e] - r1[e]);
            a[e] = qv[e] * e0; a[4 + e] = qv[4 + e] * e1; kv[e] *= __builtin_amdgcn_rcpf(e0); kv[4 + e] *= __builtin_amdgcn_rcpf(e1);
            bq[e] = qv[e] * __expf(b0[e]); bq[4 + e] = qv[4 + e] * __expf(b1[e]); }
        LAS unsigned char* hb = X.lds + hh * 65536; const int o16 = row * 256 + ((ch ^ (row & 15)) * 16);
        *(LAS u32x4*)(hb + o16) = pack8(a); *(LAS u32x4*)(hb + 16384 + o16) = pack8(kv); *(LAS u32x4*)(hb + 32768 + o16) = pack8(bq);
        *(LAS u32x4*)(hb + 49152 + row * 256 + (((ch >> 1) ^ (row & 7)) * 32) + (ch & 1) * 16) = vraw; }
    const int l = X.lane, w = X.wave, fr = l & 15, fq = l >> 4, r = fr >> 2, p4 = l & 3, hh = w >> 2, h = 2 * hp + hh, ti = w & 3;
    const int tq = 16 * ti + fr;
    const bf16_t* SPT = WSP(bf16_t, WS_SPT) + (size_t)(bn * 4 + h) * 16384;
    __syncthreads();
    const LAS unsigned char* QSI = X.lds + hh * 65536; const LAS unsigned char* KSI = QSI + 16384; const LAS unsigned char* QNI = QSI + 32768; const LAS unsigned char* VI = QSI + 49152;
    bf16x8 QS[4];
#pragma unroll
    for (int ks = 0; ks < 4; ++ks) QS[ks] = *(const LAS bf16x8*)(QSI + tq * 256 + (((4 * ks + fq) ^ (tq & 15)) * 16));
    f32x4 ST[4];
#pragma unroll
    for (int si = 0; si < 4; ++si) {
        f32x4 acc = {0.f, 0.f, 0.f, 0.f};
        if (si <= ti) {
            const int sr = 16 * si + fr;
#pragma unroll
            for (int ks = 0; ks < 4; ++ks) { const bf16x8 kf = *(const LAS bf16x8*)(KSI + sr * 256 + (((4 * ks + fq) ^ (sr & 15)) * 16)); acc = MFMA16(kf, QS[ks], acc); }
            if (si == ti) {
#pragma unroll
                for (int q = 0; q < 4; ++q) acc[q] = (4 * fq + q <= fr) ? acc[q] : 0.f; }
        }
        ST[si] = acc;
    }
    f32x4 o[8];
#pragma unroll
    for (int vt = 0; vt < 8; ++vt) o[vt] = (f32x4){0.f, 0.f, 0.f, 0.f};
#pragma unroll
    for (int kk = 0; kk < 2; ++kk) {
        if (2 * kk <= ti) {
            float pv[8];
#pragma unroll
            for (int q = 0; q < 4; ++q) { pv[q] = ST[2 * kk][q]; pv[4 + q] = ST[2 * kk + 1][q]; }
            const bf16x8 pf = __builtin_bit_cast(bf16x8, pack8(pv));
            const int r0 = 32 * kk + 4 * fq + r, r1 = r0 + 16;
#pragma unroll
            for (int vt = 0; vt < 8; ++vt) { const bf16x8 va = cat8(tr16(VI + r0 * 256 + ((vt ^ (r0 & 7)) * 32) + p4 * 8), tr16(VI + r1 * 256 + ((vt ^ (r1 & 7)) * 32) + p4 * 8));
                o[vt] = MFMA16(va, pf, o[vt]); }
        }
    }
#pragma unroll
    for (int ks = 0; ks < 4; ++ks) { const bf16x8 qn = *(const LAS bf16x8*)(QNI + tq * 256 + (((4 * ks + fq) ^ (tq & 15)) * 16));
#pragma unroll
        for (int vt = 0; vt < 8; ++vt) { const bf16x8 sa = *(const bf16x8*)(SPT + (16 * vt + fr) * 128 + 32 * ks + 8 * fq); o[vt] = MFMA16(sa, qn, o[vt]); } }
    float ss = 0.f;
#pragma unroll
    for (int vt = 0; vt < 8; ++vt) ss += (o[vt][0] * o[vt][0] + o[vt][1] * o[vt][1]) + (o[vt][2] * o[vt][2] + o[vt][3] * o[vt][3]);
    ss += __shfl_xor(ss, 16); ss += __shfl_xor(ss, 32);
    const float rstd = rsqrtf(ss * (1.f / 128.f) + EPS);
    bf16_t* YCAT = WSP(bf16_t, WS_YCAT);
#pragma unroll
    for (int vt = 0; vt < 8; ++vt) { const int vd = 16 * vt + 4 * fq;
        const u32x2 sg = *(const u32x2*)(PROJ + (size_t)(t0 + tq) * INW + C_HG + h * 128 + vd); const f32x4 gn = *(const f32x4*)(X.g_hgrn + h * 128 + vd);
        u32x2 wv; wv.x = pg8::cvt_pk_bf16(o[vt][0] * rstd * gn[0] * bflo(sg.x), o[vt][1] * rstd * gn[1] * bfhi(sg.x)); wv.y = pg8::cvt_pk_bf16(o[vt][2] * rstd * gn[2] * bflo(sg.y), o[vt][3] * rstd * gn[3] * bfhi(sg.y));
        *(u32x2*)(YCAT + (size_t)(t0 + tq) * D + h * 128 + vd) = wv; }
    __syncthreads();
}

template <bool HI> __device__ __forceinline__ unsigned fp8x2_bf16_(unsigned w) { const auto f = __builtin_amdgcn_cvt_pk_f32_fp8((int)w, HI); return pg8::cvt_pk_bf16(f[0], f[1]); }
__device__ __forceinline__ unsigned fp8x2_bf16(unsigned w, bool hi) { return hi ? fp8x2_bf16_<true>(w) : fp8x2_bf16_<false>(w); }
struct AttnRegs { u32x4 k[3], v[3]; long q[4]; };
__device__ __forceinline__ void attn_load(Ctx& X, int unit, AttnRegs& R) {
    const int u16 = unit & 15, h = (unit >> 4) & 7, g = (unit >> 7) % 3, b = unit / 384;
    const int d = g == 0 ? 1 : g == 1 ? 4 : 16, nblk = 16 / d, r = u16 / nblk, blk = u16 % nblk;
    const int vcol = C_AV + g * 512 + h * 64;
    const int mk0 = blk * 256 - 128;
    const unsigned char* QK8 = WSP(unsigned char, WS_QK8);
    const int q8col = g * 512 + h * 64, k8col = 1536 + q8col, v8col = 3072 + q8col;
#pragma unroll
    for (int j = 0; j < 3; ++j) { const int idx = X.tid + NTHREADS * j, row = idx >> 2, ch = idx & 3, m = mk0 + row > 0 ? mk0 + row : 0;
        const size_t tok = (size_t)b * SEQ + (size_t)m * d + r; R.k[j] = *(const u32x4*)(QK8 + tok * 4608 + k8col + ch * 16); R.v[j] = *(const u32x4*)(QK8 + tok * 4608 + v8col + ch * 16); }
    const int l = X.lane, w = X.wave, q = l & 31, hi = l >> 5;
    const size_t tokq = (size_t)b * SEQ + (size_t)(blk * 256 + 32 * w + q) * d + r;
#pragma unroll
    for (int ds = 0; ds < 4; ++ds) R.q[ds] = *(const long*)(QK8 + tokq * 4608 + q8col + ds * 16 + hi * 8);
}
__device__ __forceinline__ void attn_stage(Ctx& X, const AttnRegs& R) {
    LAS unsigned char* KL = X.lds; LAS unsigned char* VL = X.lds + 55296;
#pragma unroll
    for (int j = 0; j < 3; ++j) { const int idx = X.tid + NTHREADS * j, row = idx >> 2, ch = idx & 3;
        *(LAS u32x4*)(KL + row * 80 + ch * 16) = R.k[j];
        u32x4 lo, hi2;
        lo.x = fp8x2_bf16(R.v[j].x, false); lo.y = fp8x2_bf16(R.v[j].x, true); lo.z = fp8x2_bf16(R.v[j].y, false); lo.w = fp8x2_bf16(R.v[j].y, true);
        hi2.x = fp8x2_bf16(R.v[j].z, false); hi2.y = fp8x2_bf16(R.v[j].z, true); hi2.z = fp8x2_bf16(R.v[j].w, false); hi2.w = fp8x2_bf16(R.v[j].w, true);
        *(LAS u32x4*)(VL + row * 128 + ch * 32) = lo; *(LAS u32x4*)(VL + row * 128 + ch * 32 + 16) = hi2; }
    LAS long* QL = (LAS long*)(X.lds + 104448 + X.tid * 32);
    QL[0] = R.q[0]; QL[1] = R.q[1]; QL[2] = R.q[2]; QL[3] = R.q[3];
}
__device__ __forceinline__ void attn_compute(Ctx& X, int unit) {
    const int u16 = unit & 15, h = (unit >> 4) & 7, g = (unit >> 7) % 3, b = unit / 384;
    const int d = g == 0 ? 1 : g == 1 ? 4 : 16, nblk = 16 / d, r = u16 / nblk, blk = u16 % nblk;
    const int mk0 = blk * 256 - 128;
    LAS unsigned char* KL = X.lds; LAS unsigned char* VL = X.lds + 55296;
    const int l = X.lane, w = X.wave, q = l & 31, hi = l >> 5;
    const size_t tokq = (size_t)b * SEQ + (size_t)(blk * 256 + 32 * w + q) * d + r;
    long qf[4];
    { const LAS long* QL = (const LAS long*)(X.lds + 104448 + X.tid * 32); qf[0] = QL[0]; qf[1] = QL[1]; qf[2] = QL[2]; qf[3] = QL[3]; }
    f32x16 s[5];
#pragma unroll
    for (int kt = 0; kt < 5; ++kt) {
        f32x16 acc;
#pragma unroll
        for (int i = 0; i < 16; ++i) acc[i] = 0.f;
#pragma unroll
        for (int ds = 0; ds < 4; ++ds) { const long kf = *(const LAS long*)(KL + (32 * w + 32 * kt + q) * 80 + ds * 16 + hi * 8); acc = __builtin_amdgcn_mfma_f32_32x32x16_fp8_fp8(kf, qf[ds], acc, 0, 0, 0); }
        s[kt] = acc;
    }
    const int iq = 32 * w + q;
    const int jmin = iq > -mk0 ? iq : -mk0;
    const int tlo = jmin - (32 * w + 4 * hi), thi = iq + 128 - (32 * w + 128 + 4 * hi), tst = -mk0 - (32 * w + 4 * hi);
    float mx = -INFINITY;
#pragma unroll
    for (int kt = 0; kt < 5; ++kt) {
        const bool chk = kt == 0 || kt == 4 || (32 * w + 32 * kt < -mk0);
        if (chk) {
#pragma unroll
            for (int rg = 0; rg < 16; ++rg) { const int c = (rg & 3) + 8 * (rg >> 2);
                const bool valid = kt == 0 ? (c >= tlo) : kt == 4 ? (c <= thi) : (c + 32 * kt >= tst);
                s[kt][rg] = valid ? s[kt][rg] : -INFINITY; if ((rg & 3) == 3) __builtin_amdgcn_sched_barrier(0); }
        }
#pragma unroll
        for (int rg = 0; rg < 16; ++rg) mx = fmaxf(mx, s[kt][rg]);
    }
    mx = fmaxf(mx, __shfl_xor(mx, 32));
    const float c2 = 0.125f * 1.4426950408889634f, mxs = mx * c2;
    float lsum = 0.f;
#pragma unroll
    for (int kt = 0; kt < 5; ++kt)
#pragma unroll
        for (int rg = 0; rg < 16; ++rg) { const float p = __builtin_amdgcn_exp2f(__builtin_fmaf(s[kt][rg], c2, -mxs)); s[kt][rg] = p; lsum += p; }
    lsum += __shfl_xor(lsum, 32);
    f32x16 o[2];
#pragma unroll
    for (int dt = 0; dt < 2; ++dt)
#pragma unroll
        for (int i = 0; i < 16; ++i) o[dt][i] = 0.f;
    const int vlane = ((l & 15) >> 2) * 128 + (((l >> 4) & 1) * 16 + (l & 3) * 4) * 2;
#pragma unroll
    for (int kt = 0; kt < 5; ++kt)
#pragma unroll
        for (int s2 = 0; s2 < 2; ++s2) {
            bf16x8 pb;
#pragma unroll
            for (int j = 0; j < 8; j += 2) { const unsigned pw = pg8::cvt_pk_bf16(s[kt][8 * s2 + j], s[kt][8 * s2 + j + 1]); pb[j] = (short)(pw & 0xffffu); pb[j + 1] = (short)(pw >> 16); }
            const int key0 = 32 * w + 32 * kt + 16 * s2 + 4 * hi;
#pragma unroll
            for (int dt = 0; dt < 2; ++dt) {
                LAS unsigned char* vp = VL + key0 * 128 + dt * 64 + vlane;
                const s16x4 t0 = __builtin_amdgcn_ds_read_tr16_b64_v4i16((LAS s16x4*)vp);
                const s16x4 t1 = __builtin_amdgcn_ds_read_tr16_b64_v4i16((LAS s16x4*)(vp + 8 * 128));
                bf16x8 va; va[0] = t0[0]; va[1] = t0[1]; va[2] = t0[2]; va[3] = t0[3]; va[4] = t1[0]; va[5] = t1[1]; va[6] = t1[2]; va[7] = t1[3];
                o[dt] = MFMA32(va, pb, o[dt]);
            }
        }
    const float inv = 1.0f / lsum;
    bf16_t* OG = WSP(bf16_t, WS_OG) + (size_t)g * T * 512;
#pragma unroll
    for (int dt = 0; dt < 2; ++dt)
#pragma unroll
        for (int rg = 0; rg < 4; ++rg) { const int d0 = 32 * dt + 8 * rg + 4 * hi;
            u32x2 wv; wv.x = pg8::cvt_pk_bf16(o[dt][4 * rg] * inv, o[dt][4 * rg + 1] * inv); wv.y = pg8::cvt_pk_bf16(o[dt][4 * rg + 2] * inv, o[dt][4 * rg + 3] * inv);
            *(u32x2*)(OG + tokq * 512 + h * 64 + d0) = wv; }
    WSP(float, WS_LSE)[((size_t)g * T + tokq) * 8 + h] = mx * 0.125f + __logf(lsum);
}
__device__ __forceinline__ void attn_combine(Ctx& X) {
    const bf16_t* OG = WSP(bf16_t, WS_OG); const float* LSE = WSP(float, WS_LSE); bf16_t* YCAT = WSP(bf16_t, WS_YCAT);
    const int gt = X.wg * NTHREADS + X.tid, NGT = X.G * NTHREADS;
    for (int item = gt; item < T * 64; item += NGT) {
        const int t = item >> 6, ch = item & 63, h = ch >> 3;
        const float l0 = LSE[(size_t)t * 8 + h], l1 = LSE[((size_t)T + t) * 8 + h], l2 = LSE[((size_t)2 * T + t) * 8 + h];
        const float m = fmaxf(l0, fmaxf(l1, l2)); float w0 = __expf(l0 - m), w1 = __expf(l1 - m), w2 = __expf(l2 - m); const float inv = 1.f / (w0 + w1 + w2); w0 *= inv; w1 *= inv; w2 *= inv;
        const u32x4 a = *(const u32x4*)(OG + (size_t)t * 512 + ch * 8), bq = *(const u32x4*)(OG + ((size_t)T + t) * 512 + ch * 8), cq = *(const u32x4*)(OG + ((size_t)2 * T + t) * 512 + ch * 8);
        u32x4 o;
#pragma unroll
        for (int j = 0; j < 4; ++j) o[j] = pk2(w0 * bflo(a[j]) + w1 * bflo(bq[j]) + w2 * bflo(cq[j]), w0 * bfhi(a[j]) + w1 * bfhi(bq[j]) + w2 * bfhi(cq[j]));
        *(u32x4*)(YCAT + (size_t)t * D + 512 + ch * 8) = o;
    }
}

__device__ __forceinline__ unsigned sortable_key(float f) { const unsigned u = __builtin_bit_cast(unsigned, f); return (u & 0x80000000u) ? ~u : (u | 0x80000000u); }
__device__ __forceinline__ void moe_route(Ctx& X, bool local) {
    const float* LG = WSP(float, WS_KVT); unsigned* CNT = WSP(unsigned, WS_CTL) + CW_CNT; int* LISTS = WSP(int, WS_LISTS); float* GATEW = WSP(float, WS_GATEW);
    const int gw = X.wg * NWAVES + X.wave, NGW = X.G * NWAVES, l = X.lane, grp = l >> 3;
    const f32x4 bias = *(const f32x4*)(X.rbias + 4 * l);
    const unsigned long long ltmask = (1ull << l) - 1ull;
    const int tbeg = local ? X.wg * 64 + X.wave : gw, tend = local ? X.wg * 64 + 64 : T, tstep = local ? NWAVES : NGW;
    for (int t = tbeg; t < tend; t += tstep) {
        f32x4 lg = *(const f32x4*)(LG + (size_t)t * 256 + 4 * l);
#pragma unroll
        for (int ks = 1; ks < 4; ++ks) lg += *(const f32x4*)(LG + ((size_t)ks * T + t) * 256 + 4 * l);
        float sc[4], mb[4];
#pragma unroll
        for (int i = 0; i < 4; ++i) { sc[i] = sigmoidf_(lg[i]); mb[i] = sc[i] + bias[i]; }
        float m1 = fmaxf(mb[0], mb[1]), m2 = fminf(mb[0], mb[1]);
        { const float a1 = fmaxf(mb[2], mb[3]), a2 = fminf(mb[2], mb[3]); const float n1 = fmaxf(m1, a1), n2 = fmaxf(fminf(m1, a1), fmaxf(m2, a2)); m1 = n1; m2 = n2; }
#pragma unroll
        for (int o = 1; o < 8; o <<= 1) { const float a1 = __shfl_xor(m1, o), a2 = __shfl_xor(m2, o); const float n1 = fmaxf(m1, a1), n2 = fmaxf(fminf(m1, a1), fmaxf(m2, a2)); m1 = n1; m2 = n2; }
        const float gs = m1 + m2;
        int rank = 0;
#pragma unroll
        for (int gg = 0; gg < 8; ++gg) { const float og = __builtin_bit_cast(float, __builtin_amdgcn_readlane(__builtin_bit_cast(int, gs), gg * 8)); rank += (og > gs || (og == gs && gg < grp)) ? 1 : 0; }
        const bool sel = rank < 4;
        unsigned key[4];
#pragma unroll
        for (int i = 0; i < 4; ++i) key[i] = sel ? sortable_key(mb[i]) : 0u;
        unsigned pre = 0u;
#pragma unroll 1
        for (int bit = 31; bit >= 0; --bit) { const unsigned cand = pre | (1u << bit);
            const int cnt = __popcll(__ballot(key[0] >= cand)) + __popcll(__ballot(key[1] >= cand)) + __popcll(__ballot(key[2] >= cand)) + __popcll(__ballot(key[3] >= cand));
            if (cnt >= TOPK) pre = cand; }
        int ngt = 0, eqb = 0, tkb = 0; bool take[4];
#pragma unroll
        for (int i = 0; i < 4; ++i) ngt += __popcll(__ballot(key[i] > pre));
        const int need = TOPK - ngt;
#pragma unroll
        for (int i = 0; i < 4; ++i) eqb += __popcll(__ballot(key[i] == pre) & ltmask);
        int eqrun = eqb;
#pragma unroll
        for (int i = 0; i < 4; ++i) { const bool eq = key[i] == pre; take[i] = (key[i] > pre) || (eq && eqrun < need); eqrun += eq ? 1 : 0; }
#pragma unroll
        for (int i = 0; i < 4; ++i) tkb += __popcll(__ballot(take[i]) & ltmask);
        float part = 0.f;
#pragma unroll
        for (int i = 0; i < 4; ++i) part += take[i] ? sc[i] : 0.f;
        const float scale = 2.5f / wave_sum(part);
        int slot = tkb;
#pragma unroll
        for (int i = 0; i < 4; ++i) if (take[i]) { const int e = 4 * l + i; const unsigned pos = atomicAdd(&CNT[e * 64], 1u); LISTS[(size_t)e * 16384 + pos] = t * NSLOT + slot; GATEW[t * NSLOT + slot] = sc[i] * scale; ++slot; }
        if (l == 0) { LISTS[(size_t)NE * 16384 + t] = t * NSLOT + TOPK; GATEW[t * NSLOT + TOPK] = 1.0f; }
    }
}
__device__ __forceinline__ int moe_table(Ctx& X) {
    LAS int* tbl = (LAS int*)(X.lds + TBL_OFF); LAS int* cnts = (LAS int*)(X.lds + TCNT_OFF); LAS int* pref = cnts + 320;
    const unsigned* CNT = WSP(unsigned, WS_CTL) + CW_CNT;
    const int x = X.wg & 7;
    if (X.tid < NEX) cnts[X.tid] = X.tid < NE ? (int)__hip_atomic_load(CNT + X.tid * 64, __ATOMIC_RELAXED, __HIP_MEMORY_SCOPE_AGENT) : T;
    __syncthreads();
    if (X.tid < NEX) { int pre = 0; for (int e = 0; e < X.tid; ++e) pre += (cnts[e] + 255) >> 8; pref[X.tid] = pre; }
    __syncthreads();
    if (X.tid < 33) {
        const int i = X.tid; int lp = 0; for (int k = 0; k < i && k < 32; ++k) lp += (cnts[x + 8 * k] + 255) >> 8;
        if (i < 32) { const int e = x + 8 * i, n = (cnts[e] + 255) >> 8, p0 = pref[e]; for (int r = 0; r < n; ++r) tbl[lp + r] = ((p0 + r) << 16) | (e << 7) | r; }
        else { const int p0 = pref[NE]; for (int r8 = 0; r8 < 8; ++r8) { const int r = 8 * x + r8; tbl[lp + r8] = ((p0 + r) << 16) | (NE << 7) | r; } cnts[600] = lp + 8; }
    }
    __syncthreads();
    return __builtin_amdgcn_readfirstlane(cnts[600]);
}
__device__ __forceinline__ void final_rows(Ctx& X) {
    const bf16_t* X1 = WSP(bf16_t, WS_X1); const float* MOD = WSP(float, WS_MOD); const unsigned char* YBUF = WSP(unsigned char, WS_YBUF);
    const int gw = X.wg * NWAVES + X.wave, NGW = X.G * NWAVES, l = X.lane;
    for (int t = gw; t < T; t += NGW) {
        const int b = t / SEQ; f32x4 v[2][2]; float s = 0.f;
#pragma unroll
        for (int j = 0; j < 2; ++j) { const int col = 8 * l + 512 * j; f32x4 m0 = {0.f, 0.f, 0.f, 0.f}, m1 = {0.f, 0.f, 0.f, 0.f};
#pragma unroll
            for (int k = 0; k < NSLOT; ++k) { const u32x2 y = *(const u32x2*)(YBUF + ((size_t)t * NSLOT + k) * D + col);
                const f32x2 a = __builtin_amdgcn_cvt_pk_f32_fp8((int)y.x, false), bq = __builtin_amdgcn_cvt_pk_f32_fp8((int)y.x, true), c = __builtin_amdgcn_cvt_pk_f32_fp8((int)y.y, false), d = __builtin_amdgcn_cvt_pk_f32_fp8((int)y.y, true);
                m0.x += a[0]; m0.y += a[1]; m0.z += bq[0]; m0.w += bq[1]; m1.x += c[0]; m1.y += c[1]; m1.z += d[0]; m1.w += d[1]; }
            const f32x4 g0 = *(const f32x4*)(MOD + b * 6144 + 5120 + col) * (1.0f / YSCALE), g1 = *(const f32x4*)(MOD + b * 6144 + 5120 + col + 4) * (1.0f / YSCALE);
            const u32x4 xw = *(const u32x4*)(X1 + (size_t)t * D + col); const f32x4 x0 = {bflo(xw.x), bfhi(xw.x), bflo(xw.y), bfhi(xw.y)}, x1 = {bflo(xw.z), bfhi(xw.z), bflo(xw.w), bfhi(xw.w)};
            v[j][0] = x0 + g0 * m0; v[j][1] = x1 + g1 * m1;
#pragma unroll
            for (int q = 0; q < 2; ++q) s += (v[j][q].x * v[j][q].x + v[j][q].y * v[j][q].y) + (v[j][q].z * v[j][q].z + v[j][q].w * v[j][q].w); }
        const float rstd = rsqrtf(wave_sum(s) * (1.f / D) + EPS);
#pragma unroll
        for (int j = 0; j < 2; ++j) { const int col = 8 * l + 512 * j;
            *(f32x4*)(X.out + (size_t)t * D + col) = v[j][0] * rstd * *(const f32x4*)(X.g_final + col); *(f32x4*)(X.out + (size_t)t * D + col + 4) = v[j][1] * rstd * *(const f32x4*)(X.g_final + col + 4); }
    }
}

__device__ __forceinline__ unsigned* panel_word(Ctx& X, int bank, int pm) { return WSP(unsigned, WS_CTL) + CW_PANEL + (bank * 64 + pm) * 64; }
__device__ __forceinline__ void panel_signal(Ctx& X, int bank, int pm) {
    asm volatile("s_waitcnt vmcnt(0)" ::: "memory"); __syncthreads();
    if (X.tid == 0) (void)xb_add(panel_word(X, bank, pm), 1u);
}
__device__ __forceinline__ void panel_wait(Ctx& X, int bank, int pm, unsigned target) {
    if (X.tid == 0) { unsigned* p = panel_word(X, bank, pm); unsigned sp = 0u;
        while (xb_ld(p) < target) { __builtin_amdgcn_s_sleep(2); if (++sp > (1u << 22)) break; }
        __builtin_amdgcn_fence(__ATOMIC_ACQUIRE, "agent"); asm volatile("s_waitcnt vmcnt(0)" ::: "memory"); }
    __syncthreads();
}

constexpr int NG_INPROJ = 176;
__device__ __forceinline__ void ph_inproj(Ctx& X) {
    const int ng = X.G > NG_INPROJ + 8 ? NG_INPROJ : X.G;
    if (X.wg < ng) {
        RegSched S{(const char*)WSP(bf16_t, WS_H), (const char*)WSP(bf16_t, WS_WIN), (size_t)256 * 2048, (size_t)256 * 2048, T / 256, INW / 256, ng, X.wg};
        EpiInproj E{WSP(bf16_t, WS_PROJ), WSP(float, WS_LOGF), WSP(float, WS_LB), WSP(float, WS_ROPE), WSP(unsigned char, WS_G8), WSP(unsigned char, WS_QK8)};
        pg8::gemm_phase<EpiInproj, RegSched, true, false>(X.lds, 1024, 1024, 1024, S, E);
    }
    if (ng == X.G) expert_convert(X, X.wg, X.G);
    else if (X.wg >= ng) expert_convert(X, X.wg - ng, X.G - ng);
}
__device__ __forceinline__ void ph_mix_a(Ctx& X) {
    for (int it = X.wg; it < 256; it += X.G) hgrn_kv_unit(X, it);
    AttnRegs Ra, Rb; int unit = X.wg;
    auto clampu = [](int u) { return u < 1536 ? u : 1535; };
    attn_load(X, clampu(unit), Ra);
    __builtin_amdgcn_sched_barrier(0);
    attn_load(X, clampu(unit + X.G), Rb);
    __builtin_amdgcn_sched_barrier(0);
#define ATTN_STEP(R_) do { attn_stage(X, R_); __syncthreads(); __builtin_amdgcn_sched_barrier(0); attn_load(X, clampu(unit + 2 * X.G), R_); __builtin_amdgcn_sched_barrier(0); \
        attn_compute(X, unit); __syncthreads(); unit += X.G; } while (0)
    if (unit < 1536) {
        ATTN_STEP(Ra);
        while (unit < 1536) {
            ATTN_STEP(Rb);
            if (unit >= 1536) break;
            ATTN_STEP(Ra);
        }
    }
#undef ATTN_STEP
}
__device__ __forceinline__ void ph_mix_c(Ctx& X) { for (int it = X.wg; it < 512; it += X.G) hgrn_out_unit(X, it); attn_combine(X); }
__device__ __forceinline__ void ph_mixed(Ctx& X, bool chain) {
    TwoPartSched S{(const char*)WSP(bf16_t, WS_YCAT), (const char*)WSP(bf16_t, WS_WPA), (const char*)WSP(bf16_t, WS_WPB), T / 256, D / 256, X.G, X.wg};
    EpiMixed E{WSP(unsigned char, WS_G8), WSP(bf16_t, WS_MIXED)};
    pg8::gemm_phase<EpiMixed, TwoPartSched, false, false>(X.lds, 1024, 512, 512, S, E);
    if (chain) { int pm, pn; pg8::swz_tile(X.wg, T / 256, D / 256, pm, pn); panel_signal(X, 0, pm); }
}
__device__ __forceinline__ void ph_outproj(Ctx& X, bool chain) {
    int pm = 0, pn = 0; pg8::swz_tile(X.wg < 256 ? X.wg : 0, T / 256, D / 256, pm, pn);
    RegSched S{(const char*)WSP(bf16_t, WS_MIXED), (const char*)WSP(bf16_t, WS_WOUT), (size_t)256 * 2048, (size_t)256 * 2048, T / 256, D / 256, X.G, X.wg};
    if (chain) {
        panel_wait(X, 0, pm, 4u);
        EpiOutNorm E{X.x, WSP(float, WS_MOD), X.g2, WSP(bf16_t, WS_X1), WSP(bf16_t, WS_H), WSP(unsigned char, WS_H8), WSP(float, WS_XB), panel_word(X, 1, 0), X.lds + 139264};
        pg8::gemm_phase<EpiOutNorm, RegSched, true, false>(X.lds, 1024, 1024, 1024, S, E);
        panel_signal(X, 2, pm);
    } else {
        EpiOutproj E{X.x, WSP(float, WS_MOD), WSP(bf16_t, WS_X1)};
        pg8::gemm_phase<EpiOutproj, RegSched, false, false>(X.lds, 1024, 1024, 1024, S, E);
    }
}
__device__ __forceinline__ void ph_norm2(Ctx& X, bool chain) { if (!chain) norm_rows(X, 1); }
__device__ __forceinline__ void ph_router(Ctx& X, bool chain) {
    if (chain) panel_wait(X, 2, X.wg >> 2, 4u);
    RouterSched S{(const char*)WSP(bf16_t, WS_H), (const char*)WSP(bf16_t, WS_WR), X.G, X.wg};
    EpiRouter E{WSP(float, WS_KVT)};
    pg8::gemm_phase<EpiRouter, RouterSched, false, false>(X.lds, 1024, 1024, 256, S, E);
    if (chain) panel_signal(X, 3, X.wg >> 2);
}
__device__ __forceinline__ void ph_route(Ctx& X, bool chain) {
    if (chain) panel_wait(X, 3, X.wg >> 2, 4u);
    moe_route(X, chain);
}
__device__ __forceinline__ void ph_gu(Ctx& X) {
    const int nent = moe_table(X);
    MoeSched S{(const LAS int*)(X.lds + TBL_OFF), (const LAS int*)(X.lds + TCNT_OFF), nent, (const char*)WSP(unsigned char, WS_H8), (const char*)WSP(unsigned char, WS_WGU), WSP(int, WS_LISTS), 2, 256 * 1024, 512 * 1024, 0, X.G, X.wg};
    EpiGU E{WSP(unsigned char, WS_ACT)};
    pg8::gemm_phase<EpiGU, MoeSched, true, true, true>(X.lds, 512, 512, 512, S, E);
}
__device__ __forceinline__ void ph_down(Ctx& X) {
    const int nent = moe_table(X);
    MoeSched S{(const LAS int*)(X.lds + TBL_OFF), (const LAS int*)(X.lds + TCNT_OFF), nent, (const char*)WSP(unsigned char, WS_ACT), (const char*)WSP(unsigned char, WS_WD), WSP(int, WS_LISTS), 4, 256 * 256, 1024 * 256, 256 * 256, X.G, X.wg};
    EpiDown E{WSP(unsigned char, WS_YBUF), WSP(float, WS_GATEW)};
    pg8::gemm_phase<EpiDown, MoeSched, true, false, true>(X.lds, 128, 128, 128, S, E);
}

constexpr int NPHASE = 14;
struct Args { const void* in[20]; float* out; unsigned char* ws; int ph_lo, ph_hi; };
__global__ void __launch_bounds__(NTHREADS, 2) mega_fwd(Args args) {
    extern __shared__ __attribute__((aligned(16))) unsigned char lds_raw[];
    Ctx X;
    X.lds = (LAS unsigned char*)lds_raw;
    X.tid = threadIdx.x; X.lane = X.tid & 63; X.wave = __builtin_amdgcn_readfirstlane(X.tid >> 6); X.wg = blockIdx.x; X.G = gridDim.x;
    X.x = (const float*)args.in[0]; X.c = (const float*)args.in[1]; X.positions = (const int*)args.in[2]; X.w_ada = (const float*)args.in[3]; X.b_ada = (const float*)args.in[4];
    X.g1 = (const float*)args.in[5]; X.w_in = (const float*)args.in[6]; X.lb_logits = (const float*)args.in[7]; X.g_hgrn = (const float*)args.in[8]; X.w_pa = (const float*)args.in[9];
    X.w_pb = (const float*)args.in[10]; X.w_out = (const float*)args.in[11]; X.g2 = (const float*)args.in[12]; X.w_router = (const float*)args.in[13]; X.rbias = (const float*)args.in[14];
    X.w_egu = (const float*)args.in[15]; X.w_edown = (const float*)args.in[16]; X.w_sgu = (const float*)args.in[17]; X.w_sdown = (const float*)args.in[18]; X.g_final = (const float*)args.in[19];
    X.out = args.out; X.ws = args.ws;
    volatile LAS unsigned* MISC = (volatile LAS unsigned*)(X.lds + MISC_OFF);
    if (X.tid < 32) MISC[X.tid] = 0u;
    __syncthreads();
    const int lo = args.ph_lo, hi = args.ph_hi;
    XcdBarrier bar; bar.bar = WSP(unsigned, WS_CTL) + CW_BAR; bar.x = 0; bar.st = nullptr;
    if (hi - lo > 1) bar = xcd_barrier_post(WSP(unsigned, WS_CTL) + CW_BAR, MISC + 8);
#ifndef PH_MASK
#define PH_MASK 0xffffffffu
#endif
#define IN(k) ((((PH_MASK) >> (k)) & 1u) && lo <= (k) && (k) < hi)
#ifndef REPEAT_MASK
#define REPEAT_MASK 0u
#endif
#define SEAM(k) do { if (IN(k) && IN((k) + 1)) xcd_barrier(bar); } while (0)
#define RUN(k, call) do { if (IN(k)) { call; if (((REPEAT_MASK) >> (k)) & 1u) { xcd_barrier(bar); call; } } } while (0)

    RUN(0, p0_prologue(X)); SEAM(0);
    RUN(1, { small_transposes(X); norm_rows(X, 0); }); SEAM(1);
    RUN(2, ph_inproj(X)); SEAM(2);
    RUN(3, ph_mix_a(X)); SEAM(3);
    RUN(4, hgrn_passB(X)); SEAM(4);
    RUN(5, ph_mix_c(X)); SEAM(5);
    const bool chain = (X.G == 256);
    RUN(6, ph_mixed(X, chain)); if (!chain) SEAM(6);
    RUN(7, ph_outproj(X, chain)); if (!chain) SEAM(7);
    RUN(8, ph_norm2(X, chain)); if (!chain) SEAM(8);
    RUN(9, ph_router(X, chain)); if (!chain) SEAM(9);
    RUN(10, ph_route(X, chain)); SEAM(10);
    RUN(11, ph_gu(X)); SEAM(11);
    RUN(12, ph_down(X)); SEAM(12);
    RUN(13, final_rows(X));
#undef IN
#undef SEAM
}

extern "C" void kernel_launch(void* const* d_in, const int* in_sizes, int n_in, void* d_out, int out_size, void* d_ws, size_t ws_size, hipStream_t stream) {
    static int grid = 0;
    if (grid == 0) {
        if (n_in != 20 || out_size != T * D || ws_size < WS_END) { fprintf(stderr, "kernel_launch: unexpected shapes (n_in %d, out %d, ws %zu); nothing launched\n", n_in, out_size, ws_size); grid = -1; return; }
        int dev = 0, cus = 0, per_cu = 0;
        if (hipGetDevice(&dev) != hipSuccess || hipDeviceGetAttribute(&cus, hipDeviceAttributeMultiprocessorCount, dev) != hipSuccess) { grid = -1; return; }
        if (hipFuncSetAttribute((const void*)mega_fwd, hipFuncAttributeMaxDynamicSharedMemorySize, LDS_BYTES) != hipSuccess) { fprintf(stderr, "kernel_launch: hipFuncSetAttribute failed\n"); grid = -1; return; }
        if (hipOccupancyMaxActiveBlocksPerMultiprocessor(&per_cu, (const void*)mega_fwd, NTHREADS, LDS_BYTES) != hipSuccess || per_cu < 1) { fprintf(stderr, "kernel_launch: occupancy query says %d blocks/CU; nothing launched\n", per_cu); (void)hipGetLastError(); grid = -1; return; }
        grid = cus;
        if (T % grid != 0 || 24576 % grid != 0 || grid % 8 != 0) { fprintf(stderr, "kernel_launch: grid %d does not divide the row count; nothing launched\n", grid); grid = -1; return; }
    }
    if (grid < 0) return;
    (void)hipMemsetAsync((char*)d_ws + WS_CTL, 0, CTL_ZERO_BYTES, stream);
    Args a{};
    for (int i = 0; i < 20; ++i) a.in[i] = d_in[i];
    a.out = (float*)d_out; a.ws = (unsigned char*)d_ws;
#if MK_PER_PHASE
    for (int p = 0; p < NPHASE; ++p) { a.ph_lo = p; a.ph_hi = p + 1; hipLaunchKernelGGL(mega_fwd, dim3(grid), dim3(NTHREADS), LDS_BYTES, stream, a); }
#else
    a.ph_lo = 0; a.ph_hi = NPHASE;
    hipLaunchKernelGGL(mega_fwd, dim3(grid), dim3(NTHREADS), LDS_BYTES, stream, a);
#endif
}
```

```cpp
#include <hip/hip_runtime.h>
#include <cstdio>
#include <cstdint>

#ifndef MK_PER_PHASE
#define MK_PER_PHASE 0
#endif

#define GAS __attribute__((address_space(1)))
#define LAS __attribute__((address_space(3)))
typedef unsigned short bf16_t;
typedef short bf16x8 __attribute__((ext_vector_type(8)));
typedef short s16x4 __attribute__((ext_vector_type(4)));
typedef float f32x4 __attribute__((ext_vector_type(4)));
typedef float f32x2 __attribute__((ext_vector_type(2)));
typedef float f32x16 __attribute__((ext_vector_type(16)));
typedef unsigned u32x4 __attribute__((ext_vector_type(4)));
typedef unsigned u32x2 __attribute__((ext_vector_type(2)));
typedef long l64x2 __attribute__((ext_vector_type(2)));

constexpr int NB = 4, SEQ = 4096, T = NB * SEQ, D = 1024, INW = 8704;
constexpr int C_HQ = 0, C_HK = 512, C_HV = 1024, C_HG = 1536, C_AQ = 2048, C_AK = 3584, C_AV = 5120, C_GA = 6656, C_GB = 7680;
constexpr int NE = 256, NEX = 257, TOPK = 8, NSLOT = 9, EFF = 256;
constexpr float EPS = 1e-6f;
constexpr float WGU_SCALE = 64.0f, WD_SCALE = 32.0f;
constexpr float YSCALE = 16.0f;
constexpr int NWAVES = 8, NTHREADS = 512;

constexpr size_t MiB = 1u << 20;
constexpr size_t WS_CTL = 0, CTL_ZERO_BYTES = 1 * MiB;
constexpr size_t WS_MODP = 2 * MiB;
constexpr size_t WS_MOD = 4 * MiB;
constexpr size_t WS_LB = 4 * MiB + 128 * 1024;
constexpr size_t WS_XB = 4 * MiB + 256 * 1024;
constexpr size_t WS_ROPE = 5 * MiB;
constexpr size_t WS_DECAY = 6 * MiB;
constexpr size_t WS_GATEW = 7 * MiB;
constexpr size_t WS_LISTS = 16 * MiB;
constexpr size_t WS_WIN = 34 * MiB;
constexpr size_t WS_WPA = 51 * MiB, WS_WPB = 52 * MiB, WS_WOUT = 53 * MiB, WS_WR = 55 * MiB;
constexpr size_t WS_H = 56 * MiB;
constexpr size_t WS_LOGF = 88 * MiB;
constexpr size_t WS_H8 = 120 * MiB;
constexpr size_t WS_MIXED = 136 * MiB;
constexpr size_t WS_YCAT = 168 * MiB;
constexpr size_t WS_X1 = 200 * MiB;
constexpr size_t WS_G8 = 232 * MiB;
constexpr size_t WS_OG = 264 * MiB;
constexpr size_t WS_LSE = 312 * MiB;
constexpr size_t WS_KVT = 314 * MiB;
constexpr size_t WS_SPT = 378 * MiB;
constexpr size_t WS_PROJ = 410 * MiB;
constexpr size_t WS_WGU = 682 * MiB;
constexpr size_t WS_QK8 = 820 * MiB;
constexpr size_t WS_WD = 939 * MiB;
constexpr size_t WS_ACT = 1068 * MiB;
constexpr size_t WS_YBUF = 1172 * MiB;
constexpr size_t WS_END = 1460 * MiB;
constexpr int CW_P0 = 2048;
constexpr int CW_BAR = 4096;
constexpr int CW_PANEL = 65536;
constexpr int CW_CNT = 16384;

constexpr int RING_BYTES = 131072;
constexpr int TBL_OFF = RING_BYTES;
constexpr int TCNT_OFF = TBL_OFF + 4096;
constexpr int MISC_OFF = TCNT_OFF + 2560;
constexpr int LDS_BYTES = 147456;

#define LDS_WAIT() asm volatile("s_waitcnt lgkmcnt(0)" ::: "memory")
#define VM_WAIT() asm volatile("s_waitcnt vmcnt(0)" ::: "memory")
__device__ __forceinline__ unsigned f2bf(float f) { unsigned u = __builtin_bit_cast(unsigned, f); return (u + 0x7fffu + ((u >> 16) & 1u)) >> 16; }
__device__ __forceinline__ float bf2f(unsigned b) { return __builtin_bit_cast(float, b << 16); }
__device__ __forceinline__ unsigned pk2(float lo, float hi) { return f2bf(lo) | (f2bf(hi) << 16); }
__device__ __forceinline__ float bflo(unsigned w) { return __builtin_bit_cast(float, w << 16); }
__device__ __forceinline__ float bfhi(unsigned w) { return __builtin_bit_cast(float, w & 0xffff0000u); }
__device__ __forceinline__ float fast_logf(float x) { return __builtin_amdgcn_logf(x) * 0.6931471805599453f; }
__device__ __forceinline__ float sigmoidf_(float x) { return __builtin_amdgcn_rcpf(1.0f + __expf(-x)); }
__device__ __forceinline__ float wave_sum(float v) {
#pragma unroll
    for (int o = 1; o < 64; o <<= 1) v += __shfl_xor(v, o);
    return v;
}

__device__ __forceinline__ float clamp_e4m3(float x) { return __builtin_amdgcn_fmed3f(x, -448.0f, 448.0f); }
__device__ __forceinline__ unsigned pk4_fp8(float a, float b, float c, float d) { int w = 0; w = __builtin_amdgcn_cvt_pk_fp8_f32(clamp_e4m3(a), clamp_e4m3(b), w, false); w = __builtin_amdgcn_cvt_pk_fp8_f32(clamp_e4m3(c), clamp_e4m3(d), w, true); return (unsigned)w; }
__device__ __forceinline__ void st_wt8(void* p, unsigned long long v) { __hip_atomic_store((unsigned long long*)p, v, __ATOMIC_RELAXED, __HIP_MEMORY_SCOPE_AGENT); }
__device__ __forceinline__ void st_wt16(void* p, u32x4 v) { asm volatile("global_store_dwordx4 %0, %1, off sc1\n\ts_nop 1" :: "v"(p), "v"(v) : "memory"); }
__device__ __forceinline__ void st_wt4(void* p, unsigned v) { __hip_atomic_store((unsigned*)p, v, __ATOMIC_RELAXED, __HIP_MEMORY_SCOPE_AGENT); }
namespace pg8 {
constexpr int BM = 256, BK = 64, HALF = 128, HTB = HALF * BK * 2, STAGE_BYTES = 8 * HTB, NXCD = 8, WGM = 8;
__host__ __device__ __forceinline__ int lds_byte(int r, int c) { const int st = (r >> 4) * 2 + (c >> 5), rr = r & 15, cc = c & 31, ob = rr * 64 + cc * 2; return st * 1024 + (ob ^ (((ob >> 9) & 1) << 5)); }
__host__ __device__ __forceinline__ void stage_rc(int b, int& R, int& C) { const int st = b / 1024, sb = b % 1024, swz = sb ^ (((sb >> 9) & 1) << 5); R = (st >> 1) * 16 + swz / 64; C = (st & 1) * 32 + (swz % 64) / 2; }
__host__ __device__ __forceinline__ int perm32(int rho) { const int n = rho >> 4, i = rho & 15; return 8 * (i >> 2) + 4 * n + (i & 3); }

struct Unit { const char* a; const char* b; const int* rows; int pm, pn, aux, nvalid; };

__device__ __forceinline__ void swz_tile(int L, int nM, int nN, int& pm, int& pn) {
    const int nwg = nM * nN; int wgid = L;
    { const int q = nwg / NXCD, r = nwg % NXCD, xcd = wgid % NXCD, off = wgid / NXCD; wgid = (xcd < r ? xcd * (q + 1) : r * (q + 1) + (xcd - r) * q) + off; }
    const int nig = WGM * nN, gid = wgid / nig, fm = gid * WGM, gsz = (nM - fm) < WGM ? (nM - fm) : WGM;
    pm = fm + ((wgid % nig) % gsz); pn = (wgid % nig) / gsz;
}

__device__ __forceinline__ unsigned cvt_pk_bf16(float lo, float hi) { unsigned r; asm volatile("v_cvt_pk_bf16_f32 %0, %1, %2" : "=v"(r) : "v"(lo), "v"(hi)); return r; }

template <bool GATHER>
__device__ __forceinline__ void gather_offs(const Unit& u, int tid, int lda, unsigned (&v)[2][2]) {
    if constexpr (GATHER) {
#pragma unroll
        for (int i = 0; i < 2; ++i) { int R, C; stage_rc(tid * 16 + i * 8192, R, C);
#pragma unroll
            for (int hh = 0; hh < 2; ++hh) { const int ri = hh * HALF + R; int slot = 0; if (ri < u.nvalid) slot = u.rows[ri];
                const unsigned tok = (unsigned)slot / 9u; v[hh][i] = (tok * (unsigned)lda + (unsigned)C) * 2u; } }
    }
}

template <class Epi, class Sched, bool ALIGN_EPI, bool GATHER, bool FP8 = false>
__device__ __forceinline__ void gemm_phase(LAS unsigned char* lds, const int lda, const int ldb, const int K, const Sched& S, const Epi& E) {
    const int tid = threadIdx.x, wid = __builtin_amdgcn_readfirstlane(tid >> 6), lane = tid & 63, wr = wid >> 2, wc = wid & 3, fr = lane & 15, fq = lane >> 4;
    const int nt = K / BK;
    unsigned voffA[2], voffB[2];
#pragma unroll
    for (int i = 0; i < 2; ++i) { int R, C; stage_rc(tid * 16 + i * 8192, R, C); const int Rb = Epi::PERM ? ((R & ~31) + perm32(R & 31)) : R;
        voffA[i] = (unsigned)(R * lda + C) * 2u; voffB[i] = (unsigned)(Rb * ldb + C) * 2u; }
    const size_t kstep = (size_t)(BK * 2);
    const size_t hstepA = GATHER ? 0 : (size_t)HALF * lda * 2, hstepB = (size_t)HALF * ldb * 2;
    const unsigned ldsw = (unsigned)wid * 1024u;
    const int aoff = lds_byte(wr * 64 + fr, fq * 8), boff = lds_byte(wc * 32 + fr, fq * 8);
#define PG8_SA(b, h) (((b) * 2 + (h)) * HTB)
#define PG8_SB(b, h) ((4 + (b) * 2 + (h)) * HTB)
#define PG8_STAGE(bufoff, gbase, voff) do { _Pragma("unroll") for (int _i = 0; _i < 2; ++_i) \
        __builtin_amdgcn_global_load_lds((const unsigned*)((const char*)(gbase) + (voff)[_i]), (LAS unsigned*)(lds + (bufoff) + ldsw + _i * 8192), 16, 0, 0); } while (0)
#define PG8_STAGE_A(bufoff, gb, hh, nx) do { if constexpr (GATHER) { unsigned _v[2]; _v[0] = (nx) ? vn[hh][0] : vc[hh][0]; _v[1] = (nx) ? vn[hh][1] : vc[hh][1]; PG8_STAGE(bufoff, gb, _v); } \
        else { PG8_STAGE(bufoff, (gb) + (hh) * hstepA, voffA); } } while (0)
#define PG8_LDA(dst, b, h) do { _Pragma("unroll") for (int m = 0; m < 4; ++m) _Pragma("unroll") for (int k = 0; k < 2; ++k) dst[m][k] = *(const LAS bf16x8*)(lds + PG8_SA(b, h) + aoff + m * 2048 + k * 1024); } while (0)
#define PG8_LDB(dst, b, h) do { _Pragma("unroll") for (int n = 0; n < 2; ++n) _Pragma("unroll") for (int k = 0; k < 2; ++k) dst[n][k] = *(const LAS bf16x8*)(lds + PG8_SB(b, h) + boff + n * 2048 + k * 1024); } while (0)
#define PG8_MMA(ai, bj, At, Bt) do { __builtin_amdgcn_s_setprio(1); _Pragma("unroll") for (int m = 0; m < 4; ++m) _Pragma("unroll") for (int n = 0; n < 2; ++n) _Pragma("unroll") for (int k = 0; k < 2; ++k) { \
        if constexpr (FP8) { const l64x2 _b = __builtin_bit_cast(l64x2, Bt[n][k]), _a = __builtin_bit_cast(l64x2, At[m][k]); \
            acc[ai][bj][m][n] = __builtin_amdgcn_mfma_f32_16x16x32_fp8_fp8(_b[0], _a[0], acc[ai][bj][m][n], 0, 0, 0); acc[ai][bj][m][n] = __builtin_amdgcn_mfma_f32_16x16x32_fp8_fp8(_b[1], _a[1], acc[ai][bj][m][n], 0, 0, 0); } \
        else acc[ai][bj][m][n] = __builtin_amdgcn_mfma_f32_16x16x32_bf16(Bt[n][k], At[m][k], acc[ai][bj][m][n], 0, 0, 0); } __builtin_amdgcn_s_setprio(0); } while (0)
#define PG8_WAIT_V(n) asm volatile("s_waitcnt vmcnt(" #n ")" ::: "memory")
#define PG8_WAIT_L(n) asm volatile("s_waitcnt lgkmcnt(" #n ")" ::: "memory")
#define PG8_BAR __builtin_amdgcn_s_barrier()
#define PG8_SCHED __builtin_amdgcn_sched_barrier(0)
    Unit cur, nxt; int ui = 0;
    if (!S.next(0, cur)) return;
    unsigned vc[2][2] = {{0u, 0u}, {0u, 0u}}, vn[2][2] = {{0u, 0u}, {0u, 0u}};
    gather_offs<GATHER>(cur, tid, lda, vc);
    f32x4 acc[2][2][4][2];
#pragma unroll
    for (int a = 0; a < 2; ++a)
#pragma unroll
        for (int b = 0; b < 2; ++b)
#pragma unroll
            for (int m = 0; m < 4; ++m)
#pragma unroll
                for (int n = 0; n < 2; ++n) acc[a][b][m][n] = (f32x4){0.f, 0.f, 0.f, 0.f};
    bf16x8 At[4][2], B0[2][2], B1[2][2];
    const char* cA = cur.a; const char* cB = cur.b;
    PG8_STAGE(PG8_SB(0, 0), cB, voffB); PG8_STAGE(PG8_SB(0, 1), cB + hstepB, voffB); PG8_STAGE_A(PG8_SA(0, 0), cA, 0, false); PG8_STAGE_A(PG8_SA(0, 1), cA, 1, false);
    if (wr == 1) PG8_BAR;
    PG8_WAIT_V(2); PG8_BAR;
    PG8_STAGE(PG8_SB(1, 0), cB + kstep, voffB); PG8_STAGE_A(PG8_SA(1, 0), cA + kstep, 0, false); PG8_STAGE(PG8_SB(1, 1), cB + hstepB + kstep, voffB);
    PG8_WAIT_V(6); PG8_BAR;
    for (;;) {
        const bool has_next = S.next(ui + 1, nxt);
        if (has_next) gather_offs<GATHER>(nxt, tid, lda, vn);
        const char* nA = has_next ? nxt.a : cA; const char* nB = has_next ? nxt.b : cB;
        const bool do0 = !Sched::HALFSKIP || cur.nvalid > 64 * wr, do1 = !Sched::HALFSKIP || cur.nvalid > 128 + 64 * wr;
        for (int t = 0; t < nt; t += 2) {
            const bool last = (t == nt - 2);
            const bool lnx = last && has_next;
            const char* a1 = cA + (size_t)(t + 1) * kstep;
            const char* a2 = last ? nA : cA + (size_t)(t + 2) * kstep; const char* b2 = last ? nB : cB + (size_t)(t + 2) * kstep;
            const char* a3 = a2 + kstep; const char* b3 = b2 + kstep;
            PG8_LDB(B0, 0, 0); PG8_LDB(B1, 0, 1); PG8_SCHED; PG8_LDA(At, 0, 0); PG8_STAGE_A(PG8_SA(1, 1), a1, 1, false);
            PG8_WAIT_V(8); PG8_WAIT_L(0); PG8_BAR; if (do0) { PG8_MMA(0, 0, At, B0); PG8_MMA(0, 1, At, B1); } PG8_BAR; PG8_SCHED;
            PG8_LDA(At, 0, 1); PG8_STAGE(PG8_SB(0, 0), b2, voffB); PG8_STAGE(PG8_SB(0, 1), b2 + hstepB, voffB); PG8_STAGE_A(PG8_SA(0, 0), a2, 0, lnx);
            PG8_WAIT_V(8); PG8_WAIT_L(0); PG8_BAR; if (do1) { PG8_MMA(1, 0, At, B0); PG8_MMA(1, 1, At, B1); } PG8_BAR; PG8_SCHED;
            PG8_LDB(B0, 1, 0); PG8_LDB(B1, 1, 1); PG8_SCHED; PG8_LDA(At, 1, 0); PG8_STAGE_A(PG8_SA(0, 1), a2, 1, lnx);
            PG8_WAIT_V(8); PG8_WAIT_L(0); PG8_BAR; if (do0) { PG8_MMA(0, 0, At, B0); PG8_MMA(0, 1, At, B1); } PG8_BAR; PG8_SCHED;
            PG8_LDA(At, 1, 1); PG8_STAGE(PG8_SB(1, 0), b3, voffB); PG8_STAGE(PG8_SB(1, 1), b3 + hstepB, voffB); PG8_STAGE_A(PG8_SA(1, 0), a3, 0, lnx);
            PG8_WAIT_V(8); PG8_WAIT_L(0); PG8_BAR; if (do1) { PG8_MMA(1, 0, At, B0); PG8_MMA(1, 1, At, B1); } PG8_BAR; PG8_SCHED;
        }
        if constexpr (ALIGN_EPI) { if (wr == 0) PG8_BAR; }
        E(acc, cur, wr, wc, fr, fq);
        __builtin_amdgcn_s_waitcnt(0x0F70);
        if (!has_next) break;
        if (!E.keep(cur)) {
#pragma unroll
            for (int a = 0; a < 2; ++a)
#pragma unroll
                for (int b = 0; b < 2; ++b)
#pragma unroll
                    for (int m = 0; m < 4; ++m)
#pragma unroll
                        for (int n = 0; n < 2; ++n) acc[a][b][m][n] = (f32x4){0.f, 0.f, 0.f, 0.f};
        }
        cur = nxt; cA = nA; cB = nB; ++ui;
        if constexpr (GATHER) {
#pragma unroll
            for (int hh = 0; hh < 2; ++hh) { vc[hh][0] = vn[hh][0]; vc[hh][1] = vn[hh][1]; }
        }
        if constexpr (ALIGN_EPI) { if (wr == 1) PG8_BAR; }
    }
    PG8_WAIT_V(0);
    if constexpr (!ALIGN_EPI) { if (wr == 0) PG8_BAR; }
    PG8_BAR;
#undef PG8_SA
#undef PG8_SB
#undef PG8_STAGE
#undef PG8_STAGE_A
#undef PG8_LDA
#undef PG8_LDB
#undef PG8_MMA
#undef PG8_WAIT_V
#undef PG8_WAIT_L
#undef PG8_BAR
#undef PG8_SCHED
}
}

#define XB_TMO      128
#define XB_XCNT(j)  (256  + 64 * (j))
#define XB_XSUB(j)  (1280 + 64 * (j))
#define XB_XGEN(j)  (2304 + 64 * (j))
#define XB_TOP      3328
#define XB_TOPGEN   3392
#define XCD_BAR_WORDS 3456
#define XB_SPIN_CAP (1u << 20)
__device__ __forceinline__ unsigned xb_ld(unsigned* p)              { return __hip_atomic_load(p, __ATOMIC_RELAXED, __HIP_MEMORY_SCOPE_AGENT); }
__device__ __forceinline__ unsigned xb_add(unsigned* p, unsigned v) { return __hip_atomic_fetch_add(p, v, __ATOMIC_RELAXED, __HIP_MEMORY_SCOPE_AGENT); }
__device__ __forceinline__ unsigned xb_xcc_id() { return (unsigned)__builtin_amdgcn_s_getreg((3 << 11) | 20) & 0xFu; }
#define XB_SPIN(cond, bar) do { unsigned _sp = 0; while (cond) { __builtin_amdgcn_s_sleep(1); \
    if ((++_sp & 255u) == 0u) { if (xb_ld(&(bar)[XB_TMO])) break; if (_sp > XB_SPIN_CAP) { atomicAdd(&(bar)[XB_TMO], 1u); break; } } } } while (0)
struct XcdBarrier { unsigned* bar; unsigned x; volatile LAS unsigned* st; };
__device__ __forceinline__ XcdBarrier xcd_barrier_post(unsigned* bar, volatile LAS unsigned* st) {
    XcdBarrier b; b.bar = bar; b.x = xb_xcc_id(); b.st = st;
    if (threadIdx.x == 0) (void)xb_add(&bar[XB_XCNT(b.x)], 1u);
    return b;
}
__device__ __forceinline__ void xcd_barrier_complete(unsigned* bar, unsigned x, unsigned& nloc, unsigned& nx) {
    const unsigned G = gridDim.x * gridDim.y * gridDim.z;
    unsigned sum, cnt, mine, sp = 0u;
    for (;;) {
        sum = 0u; cnt = 0u; mine = 0u;
#pragma unroll
        for (unsigned j = 0; j < 16; ++j) { const unsigned c = xb_ld(&bar[XB_XCNT(j)]); sum += c; cnt += (c > 0u) ? 1u : 0u; mine = (j == x) ? c : mine; }
        if (sum == G) break;
        __builtin_amdgcn_s_sleep(1);
        if ((++sp & 255u) == 0u) { if (xb_ld(&bar[XB_TMO])) break; if (sp > XB_SPIN_CAP) { atomicAdd(&bar[XB_TMO], 1u); break; } }
    }
    nloc = mine > 0u ? mine : 1u; nx = cnt > 0u ? cnt : 1u;
}
__device__ __forceinline__ void xcd_barrier(const XcdBarrier& b) {
    asm volatile("s_waitcnt vmcnt(0)" ::: "memory");
    __syncthreads();
    if (threadIdx.x == 0) {
        unsigned* bar = b.bar;
        __builtin_amdgcn_s_waitcnt(0);
        unsigned nloc = b.st[0], nx = b.st[1];
        if (nloc == 0u) { xcd_barrier_complete(bar, b.x, nloc, nx); b.st[0] = nloc; b.st[1] = nx; }
        const unsigned old = xb_add(&bar[XB_XSUB(b.x)], 1u);
        const unsigned gen = old / nloc;
        if (old + 1u == (gen + 1u) * nloc) {
            __builtin_amdgcn_fence(__ATOMIC_RELEASE, "agent");
            asm volatile("s_waitcnt vmcnt(0)" ::: "memory");
            const unsigned og = xb_add(&bar[XB_TOP], 1u);
            const unsigned tg = og / nx;
            if (og + 1u == (tg + 1u) * nx) xb_add(&bar[XB_TOPGEN], 1u);
            else XB_SPIN(xb_ld(&bar[XB_TOPGEN]) == tg, bar);
            __builtin_amdgcn_fence(__ATOMIC_ACQUIRE, "agent");
            asm volatile("s_waitcnt vmcnt(0)" ::: "memory");
        } else {
            XB_SPIN(xb_ld(&bar[XB_TOPGEN]) == gen, bar);
            __builtin_amdgcn_fence(__ATOMIC_ACQUIRE, "agent");
            asm volatile("s_waitcnt vmcnt(0)" ::: "memory");
        }
    }
    __syncthreads();
}

struct Ctx {
    LAS unsigned char* lds;
    int tid, lane, wave, wg, G;
    const float *x, *c, *w_ada, *b_ada, *g1, *w_in, *lb_logits, *g_hgrn, *w_pa, *w_pb, *w_out, *g2, *w_router, *rbias, *w_egu, *w_edown, *w_sgu, *w_sdown, *g_final;
    const int* positions;
    float* out;
    unsigned char* ws;
};
#define WSP(type, off) ((type*)(X.ws + (off)))

__device__ __forceinline__ void transpose_item(const float* W, int K, int N, bf16_t* WT, int dst_row0, int src_col0, int k0, LAS float* scr, int lane) {
#pragma unroll 16
    for (int i = 0; i < 32; ++i) { const int kk = 2 * i + (lane >> 5); scr[kk * 33 + (lane & 31)] = W[(size_t)(k0 + kk) * N + src_col0 + (lane & 31)]; }
    LDS_WAIT(); asm volatile("" ::: "memory");
    const int c = lane & 7;
#pragma unroll
    for (int j = 0; j < 4; ++j) { const int n = (lane >> 3) + 8 * j; const LAS float* s = scr + (8 * c) * 33 + n;
        u32x4 o; o.x = pk2(s[0 * 33], s[1 * 33]); o.y = pk2(s[2 * 33], s[3 * 33]); o.z = pk2(s[4 * 33], s[5 * 33]); o.w = pk2(s[6 * 33], s[7 * 33]);
        *(u32x4*)(WT + (size_t)(dst_row0 + n) * K + k0 + 8 * c) = o; }
    LDS_WAIT(); asm volatile("" ::: "memory");
}
__device__ __forceinline__ void transpose_plain(const float* W, int K, int N, bf16_t* WT, int item, LAS float* scr, int lane) {
    const int nblk = N / 32, kb = item / nblk, nb = item % nblk;
    transpose_item(W, K, N, WT, nb * 32, nb * 32, kb * 64, scr, lane);
}
__device__ __forceinline__ void p0_prologue(Ctx& X) {
    LAS float* scr = (LAS float*)(X.lds + X.wave * 16384);
    const int gw = X.wg * NWAVES + X.wave, NGW = X.G * NWAVES;
    {
        float* MODP = WSP(float, WS_MODP);
        for (int it = gw; it < 96 * 16; it += NGW) {
            const int jc = it % 96, kc = it / 96, j = jc * 64 + X.lane;
            float a0 = 0.f, a1 = 0.f, a2 = 0.f, a3 = 0.f;
#pragma unroll 16
            for (int kk = 0; kk < 64; ++kk) { const int k = kc * 64 + kk; const float w = X.w_ada[(size_t)k * 6144 + j];
                const float c0 = X.c[k], c1 = X.c[1024 + k], c2 = X.c[2048 + k], c3 = X.c[3072 + k];
                a0 += c0 * sigmoidf_(c0) * w; a1 += c1 * sigmoidf_(c1) * w; a2 += c2 * sigmoidf_(c2) * w; a3 += c3 * sigmoidf_(c3) * w; }
            float* o = MODP + (size_t)kc * 24576 + j;
            st_wt4(o, __builtin_bit_cast(unsigned, a0)); st_wt4(o + 6144, __builtin_bit_cast(unsigned, a1)); st_wt4(o + 12288, __builtin_bit_cast(unsigned, a2)); st_wt4(o + 18432, __builtin_bit_cast(unsigned, a3));
        }
    }
    {
        float* ROPE = WSP(float, WS_ROPE);
        const int gt = X.wg * NTHREADS + X.tid, NGT = X.G * NTHREADS;
        for (int idx = gt; idx < T * 8; idx += NGT) { const int t = idx >> 3, i = idx & 7;
            const float inv_freq = 1.0f / powf(500000.0f, (float)(2 * i) / 16.0f);
            const float ang = (float)X.positions[t] * inv_freq;
            ROPE[t * 16 + i] = cosf(ang); ROPE[t * 16 + 8 + i] = sinf(ang); }
        if (X.wg == 0) { float* LB = WSP(float, WS_LB);
            for (int j = X.tid; j < 512; j += NTHREADS) { const float l0 = X.lb_logits[j], l1 = X.lb_logits[512 + j], m = fmaxf(l0, l1), e0 = __expf(l0 - m), e1 = __expf(l1 - m); LB[j] = e0 / (e0 + e1); } }
    }
}
struct CvtItem { const float* src; bf16_t* dst; };
template <bool GU> __device__ __forceinline__ CvtItem cvt_item(const Ctx& X, int it) {
    CvtItem c;
    if constexpr (GU) { const int e = it >> 7, q = it & 127, w8 = q & 7, sq = q >> 3, kb = 4 * (sq >> 2) + (w8 & 3), nb = 2 * (sq & 3) + (w8 >> 2);
        const int n0 = nb * 64, pn = n0 >> 8, bj = (n0 >> 7) & 1, idx = n0 & 127, srcc = bj * 256 + pn * 128 + idx;
        const float* W = (e < NE) ? X.w_egu + (size_t)e * 1024 * 512 : X.w_sgu;
        c.src = W + (size_t)(kb * 64) * 512 + srcc; c.dst = (bf16_t*)(X.ws + WS_WGU + ((size_t)e * 512 + n0) * 1024 + kb * 64); }
    else { const int e = it >> 6, q = it & 63, w8 = q & 7, sq = q >> 3, kb = w8 & 3, nb = 2 * sq + (w8 >> 2);
        const float* W = (e < NE) ? X.w_edown + (size_t)e * 256 * 1024 : X.w_sdown;
        c.src = W + (size_t)(kb * 64) * 1024 + nb * 64; c.dst = (bf16_t*)(X.ws + WS_WD + ((size_t)e * 1024 + nb * 64) * 256 + kb * 64); }
    return c;
}
template <int KB> __device__ __forceinline__ void cvt_store8(const CvtItem& c, int lane, const f32x4 (&v)[16], LAS unsigned char* tl, float sc) {
    const int kq = lane >> 4, nq = lane & 15;
#pragma unroll
    for (int i = 0; i < 4; ++i) { u32x4 w;
        w.x = pk4_fp8(v[0][i] * sc, v[1][i] * sc, v[2][i] * sc, v[3][i] * sc); w.y = pk4_fp8(v[4][i] * sc, v[5][i] * sc, v[6][i] * sc, v[7][i] * sc);
        w.z = pk4_fp8(v[8][i] * sc, v[9][i] * sc, v[10][i] * sc, v[11][i] * sc); w.w = pk4_fp8(v[12][i] * sc, v[13][i] * sc, v[14][i] * sc, v[15][i] * sc);
        *(LAS u32x4*)(tl + (4 * nq + i) * 80 + kq * 16) = w; }
    LDS_WAIT(); asm volatile("" ::: "memory");
    const int ch = lane & 3, r = lane >> 2;
    unsigned char* d8 = (unsigned char*)c.dst;
#pragma unroll
    for (int j = 0; j < 4; ++j) { const int n = 16 * j + r; const u32x4 w = *(const LAS u32x4*)(tl + n * 80 + ch * 16); __builtin_nontemporal_store(w, (u32x4*)(d8 + (size_t)n * KB + 16 * ch)); }
    LDS_WAIT(); asm volatile("" ::: "memory");
}
template <int N> __device__ __forceinline__ void cvt_load(const CvtItem& c, int lane, f32x4 (&v)[16]) {
    const float* p = c.src + (size_t)(16 * (lane >> 4)) * N + 4 * (lane & 15);
#pragma unroll
    for (int j = 0; j < 16; ++j) v[j] = __builtin_nontemporal_load((const f32x4*)(p + (size_t)j * N));
}
template <int K> __device__ __forceinline__ void cvt_store(const CvtItem& c, int lane, const f32x4 (&v)[16], LAS unsigned char* tl) {
    const int kq = lane >> 4, nq = lane & 15;
#pragma unroll
    for (int i = 0; i < 4; ++i) { u32x4 w0, w1;
        w0.x = pk2(v[0][i], v[1][i]); w0.y = pk2(v[2][i], v[3][i]); w0.z = pk2(v[4][i], v[5][i]); w0.w = pk2(v[6][i], v[7][i]);
        w1.x = pk2(v[8][i], v[9][i]); w1.y = pk2(v[10][i], v[11][i]); w1.z = pk2(v[12][i], v[13][i]); w1.w = pk2(v[14][i], v[15][i]);
        LAS unsigned char* q = tl + (4 * nq + i) * 144 + kq * 32; *(LAS u32x4*)q = w0; *(LAS u32x4*)(q + 16) = w1; }
    LDS_WAIT(); asm volatile("" ::: "memory");
    const int ch = lane & 7, r = lane >> 3;
#pragma unroll
    for (int j = 0; j < 8; ++j) { const int n = 8 * j + r; const u32x4 w = *(const LAS u32x4*)(tl + n * 144 + ch * 16); __builtin_nontemporal_store(w, (u32x4*)(c.dst + (size_t)n * K + 8 * ch)); }
    LDS_WAIT(); asm volatile("" ::: "memory");
}
struct CvtPair { const float* src; unsigned char* dst; };
template <bool GU> __device__ __forceinline__ CvtPair cvt_pair(const Ctx& X, int di) {
    CvtPair c;
    if constexpr (GU) { const int e = di >> 6, q = di & 63, nb = q & 7, kb2 = q >> 3;
        const int n0 = nb * 64, pn = n0 >> 8, bj = (n0 >> 7) & 1, idx = n0 & 127, srcc = bj * 256 + pn * 128 + idx;
        const float* W = (e < NE) ? X.w_egu + (size_t)e * 1024 * 512 : X.w_sgu;
        c.src = W + (size_t)(kb2 * 128) * 512 + srcc; c.dst = X.ws + WS_WGU + ((size_t)e * 512 + n0) * 1024 + kb2 * 128; }
    else { const int e = di >> 5, q = di & 31, nb = q & 15, kb2 = q >> 4;
        const float* W = (e < NE) ? X.w_edown + (size_t)e * 256 * 1024 : X.w_sdown;
        c.src = W + (size_t)(kb2 * 128) * 1024 + nb * 64; c.dst = X.ws + WS_WD + ((size_t)e * 1024 + nb * 64) * 256 + kb2 * 128; }
    return c;
}
template <int N> __device__ __forceinline__ void cvt_load_half(const CvtPair& c, int half, int lane, f32x4 (&v)[16]) {
    const float* p = c.src + (size_t)(64 * half + 16 * (lane >> 4)) * N + 4 * (lane & 15);
#pragma unroll
    for (int j = 0; j < 16; ++j) v[j] = __builtin_nontemporal_load((const f32x4*)(p + (size_t)j * N));
}
__device__ __forceinline__ void cvt_half_to_lds(int half, int lane, const f32x4 (&v)[16], LAS unsigned char* tl, float sc) {
    const int kq = lane >> 4, nq = lane & 15;
#pragma unroll
    for (int i = 0; i < 4; ++i) { u32x4 w;
        w.x = pk4_fp8(v[0][i] * sc, v[1][i] * sc, v[2][i] * sc, v[3][i] * sc); w.y = pk4_fp8(v[4][i] * sc, v[5][i] * sc, v[6][i] * sc, v[7][i] * sc);
        w.z = pk4_fp8(v[8][i] * sc, v[9][i] * sc, v[10][i] * sc, v[11][i] * sc); w.w = pk4_fp8(v[12][i] * sc, v[13][i] * sc, v[14][i] * sc, v[15][i] * sc);
        *(LAS u32x4*)(tl + (4 * nq + i) * 144 + half * 64 + kq * 16) = w; }
}
template <int KB> __device__ __forceinline__ void cvt_flush(const CvtPair& c, int lane, LAS unsigned char* tl) {
    LDS_WAIT(); asm volatile("" ::: "memory");
    const int ch = lane & 7, r = lane >> 3;
#pragma unroll
    for (int j = 0; j < 8; ++j) { const int n = 8 * j + r; const u32x4 w = *(const LAS u32x4*)(tl + n * 144 + ch * 16); __builtin_nontemporal_store(w, (u32x4*)(c.dst + (size_t)n * KB + 16 * ch)); }
    LDS_WAIT(); asm volatile("" ::: "memory");
}
template <bool GU> __device__ __forceinline__ void expert_convert_set(Ctx& X, int gw, int NGW, LAS unsigned char* tl) {
    constexpr int NIT = GU ? NEX * 64 : NEX * 32, N = GU ? 512 : 1024, K = GU ? 1024 : 256; constexpr float SC = GU ? WGU_SCALE : WD_SCALE;
    if (gw >= NIT) return;
    const int nmine = (NIT - gw + NGW - 1) / NGW;
    f32x4 va[16], vb[16];
    CvtPair cur = cvt_pair<GU>(X, gw);
    cvt_load_half<N>(cur, 0, X.lane, va); cvt_load_half<N>(cur, 1, X.lane, vb);
    for (int j = 0; j < nmine; ++j) {
        const CvtPair nxt = cvt_pair<GU>(X, gw + (j + 1 < nmine ? j + 1 : j) * NGW);
        __builtin_amdgcn_sched_barrier(0);
        cvt_half_to_lds(0, X.lane, va, tl, SC);
        __builtin_amdgcn_sched_barrier(0);
        cvt_load_half<N>(nxt, 0, X.lane, va);
        __builtin_amdgcn_sched_barrier(0);
        cvt_half_to_lds(1, X.lane, vb, tl, SC);
        cvt_flush<K>(cur, X.lane, tl);
        __builtin_amdgcn_sched_barrier(0);
        cvt_load_half<N>(nxt, 1, X.lane, vb);
        __builtin_amdgcn_sched_barrier(0);
        cur = nxt;
    }
}
__device__ __forceinline__ void expert_convert(Ctx& X, int cw, int ncw) {
    LAS unsigned char* tl = X.lds + X.wave * 16384;
    const int gw = cw * NWAVES + X.wave, NGW = ncw * NWAVES;
    expert_convert_set<true>(X, gw, NGW, tl);
    expert_convert_set<false>(X, gw, NGW, tl);
}

__device__ __forceinline__ void small_transposes(Ctx& X) {
    LAS float* scr = (LAS float*)(X.lds + 16384 + X.wave * 12288);
    const int gw = X.wg * NWAVES + X.wave, NGW = X.G * NWAVES;
    {
        constexpr int I_IN = 16 * 272, I_PA = 8 * 32, I_PB = 8 * 32, I_OUT = 16 * 32, I_R = 16 * 8;
        constexpr int NITEMS = I_IN + I_PA + I_PB + I_OUT + I_R;
        for (int it = gw; it < NITEMS; it += NGW) {
            int r = it;
            if (r < I_IN) { transpose_plain(X.w_in, 1024, INW, WSP(bf16_t, WS_WIN), r, scr, X.lane); continue; } r -= I_IN;
            if (r < I_PA) { transpose_plain(X.w_pa, 512, 1024, WSP(bf16_t, WS_WPA), r, scr, X.lane); continue; } r -= I_PA;
            if (r < I_PB) { transpose_plain(X.w_pb, 512, 1024, WSP(bf16_t, WS_WPB), r, scr, X.lane); continue; } r -= I_PB;
            if (r < I_OUT) { transpose_plain(X.w_out, 1024, 1024, WSP(bf16_t, WS_WOUT), r, scr, X.lane); continue; } r -= I_OUT;
            transpose_plain(X.w_router, 1024, 256, WSP(bf16_t, WS_WR), r, scr, X.lane);
        }
    }
}

__device__ __forceinline__ void norm_rows(Ctx& X, int which) {
    LAS float* sm = (LAS float*)X.lds;
    const float* MODP = WSP(float, WS_MODP); float* MOD = WSP(float, WS_MOD);
    const int rows_per_wg = T / X.G, row0 = X.wg * rows_per_wg, b = row0 / SEQ;
    if (which == 0) {
        for (int i = X.tid; i < 2048; i += NTHREADS) { const int j = b * 6144 + i; float s = X.b_ada[i];
#pragma unroll
            for (int p = 0; p < 16; ++p) s += MODP[(size_t)p * 24576 + j];
            sm[i] = s; }
        const int per = 24576 / X.G;
        for (int i = X.tid; i < per; i += NTHREADS) { const int j = X.wg * per + i; float s = X.b_ada[j % 6144];
#pragma unroll
            for (int p = 0; p < 16; ++p) s += MODP[(size_t)p * 24576 + j];
            MOD[j] = s; }
    } else {
        for (int i = X.tid; i < 2048; i += NTHREADS) sm[i] = MOD[b * 6144 + 3072 + i];
    }
    __syncthreads();
    const float* src = X.x; const bf16_t* srcb = WSP(bf16_t, WS_X1); const float* g = which == 0 ? X.g1 : X.g2;
    bf16_t* H = WSP(bf16_t, WS_H);
    for (int r = X.wave; r < rows_per_wg; r += NWAVES) {
        const int row = row0 + r;
        f32x4 v[2][2]; float s = 0.f;
#pragma unroll
        for (int j = 0; j < 2; ++j) { const int col = 8 * X.lane + 512 * j;
            if (which == 0) { v[j][0] = *(const f32x4*)(src + (size_t)row * D + col); v[j][1] = *(const f32x4*)(src + (size_t)row * D + col + 4); }
            else { const u32x4 wv = *(const u32x4*)(srcb + (size_t)row * D + col); v[j][0] = (f32x4){bflo(wv.x), bfhi(wv.x), bflo(wv.y), bfhi(wv.y)}; v[j][1] = (f32x4){bflo(wv.z), bfhi(wv.z), bflo(wv.w), bfhi(wv.w)}; }
#pragma unroll
            for (int q = 0; q < 2; ++q) s += (v[j][q].x * v[j][q].x + v[j][q].y * v[j][q].y) + (v[j][q].z * v[j][q].z + v[j][q].w * v[j][q].w); }
        const float rstd = rsqrtf(wave_sum(s) * (1.f / D) + EPS);
#pragma unroll
        for (int j = 0; j < 2; ++j) { const int col = 8 * X.lane + 512 * j; float y[8];
#pragma unroll
            for (int q = 0; q < 2; ++q) { const f32x4 gg = *(const f32x4*)(g + col + 4 * q), sh = *(const LAS f32x4*)(sm + col + 4 * q), sc = *(const LAS f32x4*)(sm + 1024 + col + 4 * q);
#pragma unroll
                for (int e = 0; e < 4; ++e) y[4 * q + e] = v[j][q][e] * rstd * gg[e] * (1.f + sc[e]) + sh[e]; }
            u32x4 hw; hw.x = pk2(y[0], y[1]); hw.y = pk2(y[2], y[3]); hw.z = pk2(y[4], y[5]); hw.w = pk2(y[6], y[7]);
            if (which == 1) { st_wt16(H + (size_t)row * D + col, hw);
                st_wt8(WSP(unsigned char, WS_H8) + (size_t)row * D + col, (unsigned long long)pk4_fp8(y[0], y[1], y[2], y[3]) | ((unsigned long long)pk4_fp8(y[4], y[5], y[6], y[7]) << 32)); }
            else *(u32x4*)(H + (size_t)row * D + col) = hw; }
    }
    __syncthreads();
}

struct RegSched {
    static constexpr bool HALFSKIP = false;
    const char* A; const char* Bt; size_t a_tile, b_tile; int nM, nN, G, c;
    __device__ __forceinline__ bool next(int i, pg8::Unit& u) const {
        const int L = i * G + c; if (L >= nM * nN) return false;
        int pm, pn; pg8::swz_tile(L, nM, nN, pm, pn);
        u.a = A + (size_t)pm * a_tile; u.b = Bt + (size_t)pn * b_tile; u.rows = nullptr; u.pm = pm; u.pn = pn; u.aux = 0; u.nvalid = 256; return true;
    }
};
struct TwoPartSched {      static constexpr bool HALFSKIP = false;
    const char* Y; const char* Wa; const char* Wb; int nM, nN, G, c;
    __device__ __forceinline__ bool next(int i, pg8::Unit& u) const {
        const int L = (i >> 1) * G + c, part = i & 1; if (L >= nM * nN) return false;
        int pm, pn; pg8::swz_tile(L, nM, nN, pm, pn);
        u.a = Y + (size_t)pm * 256 * 2048 + part * 1024; u.b = (part ? Wb : Wa) + (size_t)pn * 256 * 1024; u.rows = nullptr; u.pm = pm; u.pn = pn; u.aux = part; u.nvalid = 256; return true;
    }
};
struct MoeSched {
    static constexpr bool HALFSKIP = true;
    const LAS int* tbl; const LAS int* cnts; int nent; const char* A; const char* W; const int* lists; int ncol  , wtile  , wexp  , atile  , G, c;
    __device__ __forceinline__ bool next(int i, pg8::Unit& u) const {
        const int un = i * (G >> 3) + (c >> 3); if (un >= nent * ncol) return false;
        const int pn = un % ncol; const int ent = __builtin_amdgcn_readfirstlane(tbl[un / ncol]), e = (ent >> 7) & 511, r = ent & 127, rt = ent >> 16;
        u.a = A + (size_t)rt * atile; u.b = W + (size_t)e * wexp + (size_t)pn * wtile; u.rows = lists + (size_t)e * 16384 + r * 256;
        u.pm = rt; u.pn = pn; u.aux = e; const int left = __builtin_amdgcn_readfirstlane(cnts[e]) - r * 256; u.nvalid = left < 256 ? left : 256; return true;
    }
};

struct EpiInproj {
    static constexpr bool PERM = true;
    bf16_t* PROJ; float* LOGF; const float* LB; const float* ROPE; unsigned char* G8; unsigned char* QK8;
    __device__ __forceinline__ bool keep(const pg8::Unit&) const { return false; }
    __device__ __forceinline__ void operator()(f32x4 (&acc)[2][2][4][2], const pg8::Unit& u, int wr, int wc, int fr, int fq) const {
        const int pn = u.pn;
        const int mode = pn < 2 ? 0 : pn < 4 ? 1 : pn < 6 ? 0 : pn < 8 ? 2 : pn < 20 ? 3 : pn < 26 ? 5 : 4;
        const int row0 = u.pm * 256 + wr * 64 + fr, colb = pn * 256 + wc * 32 + 8 * fq;
        const bool rot = (mode == 3) && ((wc & 1) == 0);
#pragma unroll
        for (int ai = 0; ai < 2; ++ai)
#pragma unroll
            for (int m = 0; m < 4; ++m) {
                const int row = row0 + ai * 128 + m * 16;
                f32x4 cs0, cs1, sn0, sn1;
                if (rot) { const f32x4* rp = (const f32x4*)(ROPE + (size_t)row * 16); cs0 = rp[0]; cs1 = rp[1]; sn0 = rp[2]; sn1 = rp[3]; }
#pragma unroll
                for (int bj = 0; bj < 2; ++bj) {
                    const int col = colb + bj * 128;
                    f32x4 v0 = acc[ai][bj][m][0], v1 = acc[ai][bj][m][1];
                    if (mode == 1) {
                        const int cf = col - 512; const f32x4 l0 = *(const f32x4*)(LB + cf), l1 = *(const f32x4*)(LB + cf + 4);
                        f32x4 lf0, lf1;
#pragma unroll
                        for (int j = 0; j < 4; ++j) { float sg = sigmoidf_(v0[j]); float f = l0[j] + (1.f - l0[j]) * sg; lf0[j] = fast_logf(f); v0[j] = (1.f - l0[j]) * (1.f - sg);
                            sg = sigmoidf_(v1[j]); f = l1[j] + (1.f - l1[j]) * sg; lf1[j] = fast_logf(f); v1[j] = (1.f - l1[j]) * (1.f - sg); }
                        acc[ai][bj][m][0] = lf0; acc[ai][bj][m][1] = lf1;
                    } else if (mode == 2) {
#pragma unroll
                        for (int j = 0; j < 4; ++j) { v0[j] = v0[j] * sigmoidf_(v0[j]); v1[j] = v1[j] * sigmoidf_(v1[j]); }
                    } else if (mode == 4) {
#pragma unroll
                        for (int j = 0; j < 4; ++j) { v0[j] = sigmoidf_(v0[j]); v1[j] = sigmoidf_(v1[j]); }
                    } else if (rot) {
                        f32x4 p0, p1;
#pragma unroll
                        for (int j = 0; j < 4; ++j) { p0[j] = __shfl_xor(v0[j], 16); p1[j] = __shfl_xor(v1[j], 16); }
                        if (fq == 0) { v0 = v0 * cs0 - p0 * sn0; v1 = v1 * cs1 - p1 * sn1; }
                        else if (fq == 1) { v0 = v0 * cs0 + p0 * sn0; v1 = v1 * cs1 + p1 * sn1; }
                    }
                    if (mode == 4) {
                        int g0 = 0, g1 = 0;
#pragma unroll
                        for (int j = 0; j < 4; ++j) { g0 = __builtin_amdgcn_cvt_pk_u8_f32(fmaxf(v0[j] * 255.0f, 1.0f), j, g0); g1 = __builtin_amdgcn_cvt_pk_u8_f32(fmaxf(v1[j] * 255.0f, 1.0f), j, g1); }
                        *(u32x2*)(G8 + (size_t)row * 2048 + (col - C_GA)) = (u32x2){(unsigned)g0, (unsigned)g1};
                        continue; }
                    if (mode == 3 || mode == 5) {
                        *(u32x2*)(QK8 + (size_t)row * 4608 + (col - C_AQ)) = (u32x2){pk4_fp8(v0[0], v0[1], v0[2], v0[3]), pk4_fp8(v1[0], v1[1], v1[2], v1[3])};
                        continue; }
                    u32x4 w; w.x = pg8::cvt_pk_bf16(v0[0], v0[1]); w.y = pg8::cvt_pk_bf16(v0[2], v0[3]); w.z = pg8::cvt_pk_bf16(v1[0], v1[1]); w.w = pg8::cvt_pk_bf16(v1[2], v1[3]);
                    *(u32x4*)(PROJ + (size_t)row * INW + col) = w;
                }
            }
        if (mode == 1) {
            const int lane = fq * 16 + fr;
#pragma unroll
            for (int ai = 0; ai < 2; ++ai)
#pragma unroll
                for (int bj = 0; bj < 2; ++bj)
#pragma unroll
                    for (int n = 0; n < 2; ++n)
#pragma unroll
                        for (int j = 0; j < 4; ++j) { float carry = 0.f;
#pragma unroll
                            for (int m = 0; m < 4; ++m) { float v = acc[ai][bj][m][n][j];
                                v += __builtin_bit_cast(float, __builtin_amdgcn_update_dpp(0, __builtin_bit_cast(int, v), 0x111, 0xF, 0xF, true));
                                v += __builtin_bit_cast(float, __builtin_amdgcn_update_dpp(0, __builtin_bit_cast(int, v), 0x112, 0xF, 0xF, true));
                                v += __builtin_bit_cast(float, __builtin_amdgcn_update_dpp(0, __builtin_bit_cast(int, v), 0x114, 0xF, 0xF, true));
                                v += __builtin_bit_cast(float, __builtin_amdgcn_update_dpp(0, __builtin_bit_cast(int, v), 0x118, 0xF, 0xF, true));
                                v += carry; acc[ai][bj][m][n][j] = v; carry = __shfl(v, (lane & 48) | 15); } }
#pragma unroll
            for (int ai = 0; ai < 2; ++ai)
#pragma unroll
                for (int m = 0; m < 4; ++m)
#pragma unroll
                    for (int bj = 0; bj < 2; ++bj) { float* lp = LOGF + (size_t)(row0 + ai * 128 + m * 16) * 512 + (colb + bj * 128 - 512); *(f32x4*)lp = acc[ai][bj][m][0]; *(f32x4*)(lp + 4) = acc[ai][bj][m][1]; }
        }
    }
};
__device__ __forceinline__ void gate8(u32x2 w, f32x4& lo, f32x4& hi) {
    constexpr float s = 1.0f / 255.0f;
    lo = (f32x4){(float)(w.x & 255u), (float)((w.x >> 8) & 255u), (float)((w.x >> 16) & 255u), (float)(w.x >> 24)} * s;
    hi = (f32x4){(float)(w.y & 255u), (float)((w.y >> 8) & 255u), (float)((w.y >> 16) & 255u), (float)(w.y >> 24)} * s;
}
struct EpiMixed {
    static constexpr bool PERM = true;
    const unsigned char* G8; bf16_t* MIXED;
    __device__ __forceinline__ bool keep(const pg8::Unit& u) const { return u.aux == 0; }
    __device__ __forceinline__ void operator()(f32x4 (&acc)[2][2][4][2], const pg8::Unit& u, int wr, int wc, int fr, int fq) const {
        const int row0 = u.pm * 256 + wr * 64 + fr, colb = u.pn * 256 + wc * 32 + 8 * fq;
#pragma unroll
        for (int ai = 0; ai < 2; ++ai)
#pragma unroll
            for (int m = 0; m < 4; ++m) {
                const int row = row0 + ai * 128 + m * 16;
#pragma unroll
                for (int bj = 0; bj < 2; ++bj) {
                    const int col = colb + bj * 128;
                    f32x4 b0, b1; gate8(*(const u32x2*)(G8 + (size_t)row * 2048 + 1024 + col), b0, b1);
                    if (u.aux == 0) {
                        f32x4 a0, a1; gate8(*(const u32x2*)(G8 + (size_t)row * 2048 + col), a0, a1);
#pragma unroll
                        for (int j = 0; j < 4; ++j) { acc[ai][bj][m][0][j] *= a0[j] * __builtin_amdgcn_rcpf(b0[j]); acc[ai][bj][m][1][j] *= a1[j] * __builtin_amdgcn_rcpf(b1[j]); }
                    } else {
                        const f32x4 v0 = acc[ai][bj][m][0] * b0, v1 = acc[ai][bj][m][1] * b1;
                        u32x4 w; w.x = pg8::cvt_pk_bf16(v0[0], v0[1]); w.y = pg8::cvt_pk_bf16(v0[2], v0[3]); w.z = pg8::cvt_pk_bf16(v1[0], v1[1]); w.w = pg8::cvt_pk_bf16(v1[2], v1[3]);
                        st_wt16(MIXED + (size_t)row * D + col, w);
                    }
                }
            }
    }
};
struct EpiOutproj {
    static constexpr bool PERM = true;
    const float* x; const float* MOD; bf16_t* X1;
    __device__ __forceinline__ bool keep(const pg8::Unit&) const { return false; }
    __device__ __forceinline__ void operator()(f32x4 (&acc)[2][2][4][2], const pg8::Unit& u, int wr, int wc, int fr, int fq) const {
        const int row0 = u.pm * 256 + wr * 64 + fr, colb = u.pn * 256 + wc * 32 + 8 * fq;
        const int b = (u.pm * 256) / SEQ;
#pragma unroll
        for (int bj = 0; bj < 2; ++bj) {
            const int col = colb + bj * 128;
            const f32x4 g0 = *(const f32x4*)(MOD + b * 6144 + 2048 + col), g1 = *(const f32x4*)(MOD + b * 6144 + 2048 + col + 4);
#pragma unroll
            for (int ai = 0; ai < 2; ++ai)
#pragma unroll
                for (int m = 0; m < 4; ++m) { const size_t off = (size_t)(row0 + ai * 128 + m * 16) * D + col;
                    const f32x4 v0 = *(const f32x4*)(x + off) + g0 * acc[ai][bj][m][0], v1 = *(const f32x4*)(x + off + 4) + g1 * acc[ai][bj][m][1];
                    u32x4 w; w.x = pg8::cvt_pk_bf16(v0[0], v0[1]); w.y = pg8::cvt_pk_bf16(v0[2], v0[3]); w.z = pg8::cvt_pk_bf16(v1[0], v1[1]); w.w = pg8::cvt_pk_bf16(v1[2], v1[3]);
                    st_wt16(X1 + off, w); }
        }
    }
};
struct EpiOutNorm {
    static constexpr bool PERM = true;
    const float* x; const float* MOD; const float* g2; bf16_t* X1; bf16_t* H; unsigned char* H8; float* XB; unsigned* cnt; LAS unsigned char* sl;
    __device__ __forceinline__ bool keep(const pg8::Unit&) const { return false; }
    __device__ __forceinline__ void operator()(f32x4 (&acc)[2][2][4][2], const pg8::Unit& u, int wr, int wc, int fr, int fq) const {
        const int tid = threadIdx.x;
        const int rl0 = wr * 64 + fr, row0 = u.pm * 256 + rl0, colb = u.pn * 256 + wc * 32 + 8 * fq;
        const int b = (u.pm * 256) / SEQ;
        LAS float* Pt = (LAS float*)sl; LAS float* Rs = (LAS float*)(sl + 4096);
#pragma unroll
        for (int bj = 0; bj < 2; ++bj) {
            const int col = colb + bj * 128;
            const f32x4 g0 = *(const f32x4*)(MOD + b * 6144 + 2048 + col), g1 = *(const f32x4*)(MOD + b * 6144 + 2048 + col + 4);
#pragma unroll
            for (int ai = 0; ai < 2; ++ai)
#pragma unroll
                for (int m = 0; m < 4; ++m) { const size_t off = (size_t)(row0 + ai * 128 + m * 16) * D + col;
                    acc[ai][bj][m][0] = *(const f32x4*)(x + off) + g0 * acc[ai][bj][m][0]; acc[ai][bj][m][1] = *(const f32x4*)(x + off + 4) + g1 * acc[ai][bj][m][1];
                    asm volatile("" : "+v"(acc[ai][bj][m][0]), "+v"(acc[ai][bj][m][1]));
                    if (m & 1) asm volatile("" ::: "memory"); }
        }
#pragma unroll
        for (int ai = 0; ai < 2; ++ai)
#pragma unroll
            for (int m = 0; m < 4; ++m) { float q = 0.f;
#pragma unroll
                for (int bj = 0; bj < 2; ++bj)
#pragma unroll
                    for (int n = 0; n < 2; ++n) { const f32x4 v = acc[ai][bj][m][n]; q += (v[0] * v[0] + v[1] * v[1]) + (v[2] * v[2] + v[3] * v[3]); }
                q += __shfl_xor(q, 16); q += __shfl_xor(q, 32);
                if (fq == 0) Pt[(ai * 128 + rl0 + m * 16) * 4 + wc] = q; }
        asm volatile("s_waitcnt lgkmcnt(0)" ::: "memory"); __builtin_amdgcn_s_barrier(); asm volatile("" ::: "memory");
        if (tid < 256) { const f32x4 p = *(const LAS f32x4*)(Pt + tid * 4); st_wt4(XB + ((size_t)u.pm * 256 + tid) * 4 + u.pn, __builtin_bit_cast(unsigned, (p[0] + p[1]) + (p[2] + p[3]))); }
        asm volatile("s_waitcnt vmcnt(0)" ::: "memory"); __builtin_amdgcn_s_barrier(); asm volatile("" ::: "memory");
        if (tid == 0) { unsigned* p = cnt + (size_t)u.pm * 64; (void)xb_add(p, 1u); unsigned sp = 0u;
            while (xb_ld(p) < 4u) { __builtin_amdgcn_s_sleep(2); if (++sp > (1u << 22)) break; }
            __builtin_amdgcn_fence(__ATOMIC_ACQUIRE, "agent"); asm volatile("s_waitcnt vmcnt(0)" ::: "memory"); }
        __builtin_amdgcn_s_barrier(); asm volatile("" ::: "memory");
        if (tid < 256) { const f32x4 q = *(const f32x4*)(XB + ((size_t)u.pm * 256 + tid) * 4); Rs[tid] = rsqrtf(((q[0] + q[1]) + (q[2] + q[3])) * (1.f / D) + EPS); }
        asm volatile("s_waitcnt vmcnt(0) lgkmcnt(0)" ::: "memory"); __builtin_amdgcn_s_barrier(); asm volatile("" ::: "memory");
#pragma unroll
        for (int bj = 0; bj < 2; ++bj) {
            const int col = colb + bj * 128;
            f32x4 gg[2], sc[2], sh[2];
#pragma unroll
            for (int q = 0; q < 2; ++q) { gg[q] = *(const f32x4*)(g2 + col + 4 * q); sh[q] = *(const f32x4*)(MOD + b * 6144 + 3072 + col + 4 * q); sc[q] = *(const f32x4*)(MOD + b * 6144 + 4096 + col + 4 * q) + 1.0f; gg[q] = gg[q] * sc[q]; }
#pragma unroll
            for (int ai = 0; ai < 2; ++ai)
#pragma unroll
                for (int m = 0; m < 4; ++m) { const int rl = ai * 128 + rl0 + m * 16; const size_t off = (size_t)(u.pm * 256 + rl) * D + col; const float rs = Rs[rl];
                    const f32x4 v0 = acc[ai][bj][m][0], v1 = acc[ai][bj][m][1];
                    u32x4 w; w.x = pg8::cvt_pk_bf16(v0[0], v0[1]); w.y = pg8::cvt_pk_bf16(v0[2], v0[3]); w.z = pg8::cvt_pk_bf16(v1[0], v1[1]); w.w = pg8::cvt_pk_bf16(v1[2], v1[3]);
                    *(u32x4*)(X1 + off) = w;
                    const f32x4 h0 = v0 * rs * gg[0] + sh[0], h1 = v1 * rs * gg[1] + sh[1];
                    u32x4 hw; hw.x = pg8::cvt_pk_bf16(h0[0], h0[1]); hw.y = pg8::cvt_pk_bf16(h0[2], h0[3]); hw.z = pg8::cvt_pk_bf16(h1[0], h1[1]); hw.w = pg8::cvt_pk_bf16(h1[2], h1[3]);
                    st_wt16(H + off, hw);
                    st_wt8(H8 + off, (unsigned long long)pk4_fp8(h0[0], h0[1], h0[2], h0[3]) | ((unsigned long long)pk4_fp8(h1[0], h1[1], h1[2], h1[3]) << 32));
                    asm volatile("" ::: "memory"); }
        }
    }
};
struct EpiRouter {
    static constexpr bool PERM = false;
    float* LOGITS4;
    __device__ __forceinline__ bool keep(const pg8::Unit&) const { return false; }
    __device__ __forceinline__ void operator()(f32x4 (&acc)[2][2][4][2], const pg8::Unit& u, int wr, int wc, int fr, int fq) const {
        const int row0 = u.pm * 256 + wr * 64 + fr, colb = wc * 32 + 4 * fq;
        float* base = LOGITS4 + (size_t)u.aux * T * 256;
#pragma unroll
        for (int ai = 0; ai < 2; ++ai)
#pragma unroll
            for (int m = 0; m < 4; ++m)
#pragma unroll
                for (int bj = 0; bj < 2; ++bj)
#pragma unroll
                    for (int n = 0; n < 2; ++n) st_wt16(base + (size_t)(row0 + ai * 128 + m * 16) * 256 + colb + bj * 128 + n * 16, __builtin_bit_cast(u32x4, acc[ai][bj][m][n]));
    }
};
struct RouterSched {
    static constexpr bool HALFSKIP = false;
    const char* A; const char* Bt; int G, c;
    __device__ __forceinline__ bool next(int i, pg8::Unit& u) const {
        const int L = i * G + c; if (L >= 256) return false;
        const int pm = L >> 2, ks = L & 3;
        u.a = A + (size_t)pm * 256 * 2048 + ks * 512; u.b = Bt + ks * 512; u.rows = nullptr; u.pm = pm; u.pn = 0; u.aux = ks; u.nvalid = 256; return true;
    }
};
struct EpiGU {
    static constexpr bool PERM = true;
    unsigned char* ACT;
    __device__ __forceinline__ bool keep(const pg8::Unit&) const { return false; }
    __device__ __forceinline__ void operator()(f32x4 (&acc)[2][2][4][2], const pg8::Unit& u, int wr, int wc, int fr, int fq) const {
        const int rl0 = wr * 64 + fr, col = u.pn * 128 + wc * 32 + 8 * fq;
        constexpr float is = 1.0f / WGU_SCALE;
#pragma unroll
        for (int ai = 0; ai < 2; ++ai)
#pragma unroll
            for (int m = 0; m < 4; ++m) {
                const int rl = rl0 + ai * 128 + m * 16;
                f32x4 v0, v1;
#pragma unroll
                for (int j = 0; j < 4; ++j) { const float a0 = acc[ai][0][m][0][j] * is, a1 = acc[ai][0][m][1][j] * is;
                    v0[j] = a0 * sigmoidf_(a0) * (acc[ai][1][m][0][j] * is); v1[j] = a1 * sigmoidf_(a1) * (acc[ai][1][m][1][j] * is); }
                *(u32x2*)(ACT + ((size_t)u.pm * 256 + rl) * EFF + col) = (u32x2){pk4_fp8(v0[0], v0[1], v0[2], v0[3]), pk4_fp8(v1[0], v1[1], v1[2], v1[3])};
                asm volatile("" ::: "memory");
            }
    }
};
struct EpiDown {
    static constexpr bool PERM = true;
    unsigned char* YBUF; const float* GATEW;
    __device__ __forceinline__ bool keep(const pg8::Unit&) const { return false; }
    __device__ __forceinline__ void operator()(f32x4 (&acc)[2][2][4][2], const pg8::Unit& u, int wr, int wc, int fr, int fq) const {
        const int rl0 = wr * 64 + fr, colb = u.pn * 256 + wc * 32 + 8 * fq;
#pragma unroll
        for (int ai = 0; ai < 2; ++ai)
#pragma unroll
            for (int m = 0; m < 4; ++m) {
                const int rl = rl0 + ai * 128 + m * 16;
                if (rl < u.nvalid) {
                    const int slot = u.rows[rl]; const float gw = GATEW[slot] * (YSCALE / WD_SCALE);
#pragma unroll
                    for (int bj = 0; bj < 2; ++bj) { const f32x4 v0 = acc[ai][bj][m][0] * gw, v1 = acc[ai][bj][m][1] * gw;
                        *(u32x2*)(YBUF + (size_t)slot * D + colb + bj * 128) = (u32x2){pk4_fp8(v0[0], v0[1], v0[2], v0[3]), pk4_fp8(v1[0], v1[1], v1[2], v1[3])}; }
                }
                asm volatile("" ::: "memory");
            }
    }
};

#define MFMA16(a, b, c) __builtin_amdgcn_mfma_f32_16x16x32_bf16((a), (b), (c), 0, 0, 0)
#define MFMA32(a, b, c) __builtin_amdgcn_mfma_f32_32x32x16_bf16((a), (b), (c), 0, 0, 0)
__device__ __forceinline__ s16x4 tr16(const LAS unsigned char* p) { return __builtin_amdgcn_ds_read_tr16_b64_v4i16((LAS s16x4*)p); }
__device__ __forceinline__ bf16x8 cat8(s16x4 a, s16x4 b) { bf16x8 r; r[0] = a[0]; r[1] = a[1]; r[2] = a[2]; r[3] = a[3]; r[4] = b[0]; r[5] = b[1]; r[6] = b[2]; r[7] = b[3]; return r; }
__device__ __forceinline__ u32x4 pack8(const float (&v)[8]) { u32x4 w; w.x = pg8::cvt_pk_bf16(v[0], v[1]); w.y = pg8::cvt_pk_bf16(v[2], v[3]); w.z = pg8::cvt_pk_bf16(v[4], v[5]); w.w = pg8::cvt_pk_bf16(v[6], v[7]); return w; }
__device__ __forceinline__ void unpack8(u32x4 w, float (&v)[8]) { v[0] = bflo(w.x); v[1] = bfhi(w.x); v[2] = bflo(w.y); v[3] = bfhi(w.y); v[4] = bflo(w.z); v[5] = bfhi(w.z); v[6] = bflo(w.w); v[7] = bfhi(w.w); }
__device__ __forceinline__ int swzA(int row) { return (row & 3) | (((row >> 3) & 1) << 2); }
__device__ __forceinline__ void hgrn_kv_unit(Ctx& X, int bn) {
    const int t0 = bn * 64;
    const bf16_t* PROJ = WSP(bf16_t, WS_PROJ); const float* BC = WSP(float, WS_LOGF);
#pragma unroll 2
    for (int j = 0; j < 8; ++j) {
        const int p = X.tid + NTHREADS * j, row = p >> 6, c64 = p & 63, h = c64 >> 4, ch = c64 & 15;
        const size_t prow = (size_t)(t0 + row) * INW + h * 128 + 8 * ch;
        const u32x4 kraw = *(const u32x4*)(PROJ + prow + C_HK), vraw = *(const u32x4*)(PROJ + prow + C_HV);
        const float* bp = BC + (size_t)(t0 + row) * 512 + h * 128 + 8 * ch; const float* bl = BC + (size_t)(t0 + 63) * 512 + h * 128 + 8 * ch;
        const f32x4 b0 = *(const f32x4*)bp, b1 = *(const f32x4*)(bp + 4), l0 = *(const f32x4*)bl, l1 = *(const f32x4*)(bl + 4);
        float kv[8]; unpack8(kraw, kv);
#pragma unroll
        for (int e = 0; e < 4; ++e) { kv[e] *= __expf(l0[e] - b0[e]); kv[4 + e] *= __expf(l1[e] - b1[e]); }
        const int off = row * 256 + (((ch >> 1) ^ swzA(row)) * 32) + (ch & 1) * 16;
        *(LAS u32x4*)(X.lds + h * 32768 + off) = vraw; *(LAS u32x4*)(X.lds + h * 32768 + 16384 + off) = pack8(kv);
    }
    WSP(float, WS_DECAY)[bn * 512 + X.tid] = __expf(BC[(size_t)(t0 + 63) * 512 + X.tid]);
    __syncthreads();
    const int l = X.lane, w = X.wave, fr = l & 15, fq = l >> 4, r = fr >> 2, p4 = l & 3, h = w >> 1, vt0 = 4 * (w & 1);
    const LAS unsigned char* VI = X.lds + h * 32768; const LAS unsigned char* KI = VI + 16384;
    bf16x8 af[4][2];
#pragma unroll
    for (int vt = 0; vt < 4; ++vt)
#pragma unroll
        for (int kk = 0; kk < 2; ++kk) { const int r0 = 32 * kk + 8 * fq + r, r1 = r0 + 4;
            af[vt][kk] = cat8(tr16(VI + r0 * 256 + (((vt0 + vt) ^ swzA(r0)) * 32) + p4 * 8), tr16(VI + r1 * 256 + (((vt0 + vt) ^ swzA(r1)) * 32) + p4 * 8)); }
    bf16_t* KVT = WSP(bf16_t, WS_KVT) + (size_t)(bn * 4 + h) * 16384;
#pragma unroll 2
    for (int ct = 0; ct < 8; ++ct) {
        bf16x8 bfr[2];
#pragma unroll
        for (int kk = 0; kk < 2; ++kk) { const int r0 = 32 * kk + 8 * fq + r, r1 = r0 + 4;
            bfr[kk] = cat8(tr16(KI + r0 * 256 + ((ct ^ swzA(r0)) * 32) + p4 * 8), tr16(KI + r1 * 256 + ((ct ^ swzA(r1)) * 32) + p4 * 8)); }
#pragma unroll
        for (int vt = 0; vt < 4; ++vt) { f32x4 acc = {0.f, 0.f, 0.f, 0.f}; acc = MFMA16(bfr[0], af[vt][0], acc); acc = MFMA16(bfr[1], af[vt][1], acc);
            u32x2 wv; wv.x = pg8::cvt_pk_bf16(acc[0], acc[1]); wv.y = pg8::cvt_pk_bf16(acc[2], acc[3]);
            *(u32x2*)(KVT + (16 * (vt0 + vt) + fr) * 128 + 16 * ct + 4 * fq) = wv; }
    }
    __syncthreads();
}
__device__ __forceinline__ void hgrn_passB(Ctx& X) {
    const unsigned* KVT = WSP(unsigned, WS_KVT); const float* DECAY = WSP(float, WS_DECAY); unsigned* SPT = WSP(unsigned, WS_SPT);
    const int gt = X.wg * NTHREADS + X.tid, NGT = X.G * NTHREADS;
    for (int item = gt; item < 16 * 128 * 64; item += NGT) {
        const int bh = item >> 13, rem = item & 8191, vd = rem >> 6, c = (rem & 63) * 2, b = bh >> 2, h = bh & 3;
        float s0 = 0.f, s1 = 0.f;
#pragma unroll 8
        for (int n = 0; n < 64; ++n) {
            const int unit = (b * 64 + n) * 4 + h;
            const unsigned kw = KVT[((size_t)unit * 16384 + vd * 128 + c) >> 1]; const f32x2 kv = {bflo(kw), bfhi(kw)};
            const f32x2 dc = *(const f32x2*)(DECAY + unit * 128 + c);
            SPT[((size_t)unit * 16384 + vd * 128 + c) >> 1] = pk2(s0, s1);
            s0 = dc.x * s0 + kv.x; s1 = dc.y * s1 + kv.y;
        }
    }
}
__device__ __forceinline__ void hgrn_out_unit(Ctx& X, int u2) {
    const int bn = u2 >> 1, hp = u2 & 1, t0 = bn * 64;
    const bf16_t* PROJ = WSP(bf16_t, WS_PROJ); const float* BCg = WSP(float, WS_LOGF);
#pragma unroll 2
    for (int j = 0; j < 4; ++j) { const int p = X.tid + NTHREADS * j, row = p >> 5, c32 = p & 31, hh = c32 >> 4, ch = c32 & 15, h = 2 * hp + hh;
        const size_t prow = (size_t)(t0 + row) * INW + h * 128 + 8 * ch;
        const u32x4 qraw = *(const u32x4*)(PROJ + prow + C_HQ), kraw = *(const u32x4*)(PROJ + prow + C_HK), vraw = *(const u32x4*)(PROJ + prow + C_HV);
        const float* bp = BCg + (size_t)(t0 + row) * 512 + h * 128 + 8 * ch; const float* br = BCg + (size_t)(t0 + 32) * 512 + h * 128 + 8 * ch;
        const f32x4 b0 = *(const f32x4*)bp, b1 = *(const f32x4*)(bp + 4), r0 = *(const f32x4*)br, r1 = *(const f32x4*)(br + 4);
        float qv[8], kv[8], a[8], bq[8]; unpack8(qraw, qv); unpack8(kraw, kv);
#pragma unroll
        for (int e = 0; e < 4; ++e) { const float e0 = __expf(b0[e] - r0[e]), e1 = __expf(b1[e] - r1[e]);
            a[e] = qv[e] * e0; a[4 + e] = qv[4 + e] * e1; kv[e] *= __builtin_amdgcn_rcpf(e0); kv[4 + e] *= __builtin_amdgcn_rcpf(e1);
            bq[e] = qv[e] * __expf(b0[e]); bq[4 + e] = qv[4 + e] * __expf(b1[e]); }
        LAS unsigned char* hb = X.lds + hh * 65536; const int o16 = row * 256 + ((ch ^ (row & 15)) * 16);
        *(LAS u32x4*)(hb + o16) = pack8(a); *(LAS u32x4*)(hb + 16384 + o16) = pack8(kv); *(LAS u32x4*)(hb + 32768 + o16) = pack8(bq);
        *(LAS u32x4*)(hb + 49152 + row * 256 + (((ch >> 1) ^ (row & 7)) * 32) + (ch & 1) * 16) = vraw; }
    const int l = X.lane, w = X.wave, fr = l & 15, fq = l >> 4, r = fr >> 2, p4 = l & 3, hh = w >> 2, h = 2 * hp + hh, ti = w & 3;
    const int tq = 16 * ti + fr;
    const bf16_t* SPT = WSP(bf16_t, WS_SPT) + (size_t)(bn * 4 + h) * 16384;
    __syncthreads();
    const LAS unsigned char* QSI = X.lds + hh * 65536; const LAS unsigned char* KSI = QSI + 16384; const LAS unsigned char* QNI = QSI + 32768; const LAS unsigned char* VI = QSI + 49152;
    bf16x8 QS[4];
#pragma unroll
    for (int ks = 0; ks < 4; ++ks) QS[ks] = *(const LAS bf16x8*)(QSI + tq * 256 + (((4 * ks + fq) ^ (tq & 15)) * 16));
    f32x4 ST[4];
#pragma unroll
    for (int si = 0; si < 4; ++si) {
        f32x4 acc = {0.f, 0.f, 0.f, 0.f};
        if (si <= ti) {
            const int sr = 16 * si + fr;
#pragma unroll
            for (int ks = 0; ks < 4; ++ks) { const bf16x8 kf = *(const LAS bf16x8*)(KSI + sr * 256 + (((4 * ks + fq) ^ (sr & 15)) * 16)); acc = MFMA16(kf, QS[ks], acc); }
            if (si == ti) {
#pragma unroll
                for (int q = 0; q < 4; ++q) acc[q] = (4 * fq + q <= fr) ? acc[q] : 0.f; }
        }
        ST[si] = acc;
    }
    f32x4 o[8];
#pragma unroll
    for (int vt = 0; vt < 8; ++vt) o[vt] = (f32x4){0.f, 0.f, 0.f, 0.f};
#pragma unroll
    for (int kk = 0; kk < 2; ++kk) {
        if (2 * kk <= ti) {
            float pv[8];
#pragma unroll
            for (int q = 0; q < 4; ++q) { pv[q] = ST[2 * kk][q]; pv[4 + q] = ST[2 * kk + 1][q]; }
            const bf16x8 pf = __builtin_bit_cast(bf16x8, pack8(pv));
            const int r0 = 32 * kk + 4 * fq + r, r1 = r0 + 16;
#pragma unroll
            for (int vt = 0; vt < 8; ++vt) { const bf16x8 va = cat8(tr16(VI + r0 * 256 + ((vt ^ (r0 & 7)) * 32) + p4 * 8), tr16(VI + r1 * 256 + ((vt ^ (r1 & 7)) * 32) + p4 * 8));
                o[vt] = MFMA16(va, pf, o[vt]); }
        }
    }
#pragma unroll
    for (int ks = 0; ks < 4; ++ks) { const bf16x8 qn = *(const LAS bf16x8*)(QNI + tq * 256 + (((4 * ks + fq) ^ (tq & 15)) * 16));
#pragma unroll
        for (int vt = 0; vt < 8; ++vt) { const bf16x8 sa = *(const bf16x8*)(SPT + (16 * vt + fr) * 128 + 32 * ks + 8 * fq); o[vt] = MFMA16(sa, qn, o[vt]); } }
    float ss = 0.f;
#pragma unroll
    for (int vt = 0; vt < 8; ++vt) ss += (o[vt][0] * o[vt][0] + o[vt][1] * o[vt][1]) + (o[vt][2] * o[vt][2] + o[vt][3] * o[vt][3]);
    ss += __shfl_xor(ss, 16); ss += __shfl_xor(ss, 32);
    const float rstd = rsqrtf(ss * (1.f / 128.f) + EPS);
    bf16_t* YCAT = WSP(bf16_t, WS_YCAT);
#pragma unroll
    for (int vt = 0; vt < 8; ++vt) { const int vd = 16 * vt + 4 * fq;
        const u32x2 sg = *(const u32x2*)(PROJ + (size_t)(t0 + tq) * INW + C_HG + h * 128 + vd); const f32x4 gn = *(const f32x4*)(X.g_hgrn + h * 128 + vd);
        u32x2 wv; wv.x = pg8::cvt_pk_bf16(o[vt][0] * rstd * gn[0] * bflo(sg.x), o[vt][1] * rstd * gn[1] * bfhi(sg.x)); wv.y = pg8::cvt_pk_bf16(o[vt][2] * rstd * gn[2] * bflo(sg.y), o[vt][3] * rstd * gn[3] * bfhi(sg.y));
        *(u32x2*)(YCAT + (size_t)(t0 + tq) * D + h * 128 + vd) = wv; }
    __syncthreads();
}

template <bool HI> __device__ __forceinline__ unsigned fp8x2_bf16_(unsigned w) { const auto f = __builtin_amdgcn_cvt_pk_f32_fp8((int)w, HI); return pg8::cvt_pk_bf16(f[0], f[1]); }
__device__ __forceinline__ unsigned fp8x2_bf16(unsigned w, bool hi) { return hi ? fp8x2_bf16_<true>(w) : fp8x2_bf16_<false>(w); }
struct AttnRegs { u32x4 k[3], v[3]; long q[4]; };
__device__ __forceinline__ void attn_load(Ctx& X, int unit, AttnRegs& R) {
    const int u16 = unit & 15, h = (unit >> 4) & 7, g = (unit >> 7) % 3, b = unit / 384;
    const int d = g == 0 ? 1 : g == 1 ? 4 : 16, nblk = 16 / d, r = u16 / nblk, blk = u16 % nblk;
    const int vcol = C_AV + g * 512 + h * 64;
    const int mk0 = blk * 256 - 128;
    const unsigned char* QK8 = WSP(unsigned char, WS_QK8);
    const int q8col = g * 512 + h * 64, k8col = 1536 + q8col, v8col = 3072 + q8col;
#pragma unroll
    for (int j = 0; j < 3; ++j) { const int idx = X.tid + NTHREADS * j, row = idx >> 2, ch = idx & 3, m = mk0 + row > 0 ? mk0 + row : 0;
        const size_t tok = (size_t)b * SEQ + (size_t)m * d + r; R.k[j] = *(const u32x4*)(QK8 + tok * 4608 + k8col + ch * 16); R.v[j] = *(const u32x4*)(QK8 + tok * 4608 + v8col + ch * 16); }
    const int l = X.lane, w = X.wave, q = l & 31, hi = l >> 5;
    const size_t tokq = (size_t)b * SEQ + (size_t)(blk * 256 + 32 * w + q) * d + r;
#pragma unroll
    for (int ds = 0; ds < 4; ++ds) R.q[ds] = *(const long*)(QK8 + tokq * 4608 + q8col + ds * 16 + hi * 8);
}
__device__ __forceinline__ void attn_stage(Ctx& X, const AttnRegs& R) {
    LAS unsigned char* KL = X.lds; LAS unsigned char* VL = X.lds + 55296;
#pragma unroll
    for (int j = 0; j < 3; ++j) { const int idx = X.tid + NTHREADS * j, row = idx >> 2, ch = idx & 3;
        *(LAS u32x4*)(KL + row * 80 + ch * 16) = R.k[j];
        u32x4 lo, hi2;
        lo.x = fp8x2_bf16(R.v[j].x, false); lo.y = fp8x2_bf16(R.v[j].x, true); lo.z = fp8x2_bf16(R.v[j].y, false); lo.w = fp8x2_bf16(R.v[j].y, true);
        hi2.x = fp8x2_bf16(R.v[j].z, false); hi2.y = fp8x2_bf16(R.v[j].z, true); hi2.z = fp8x2_bf16(R.v[j].w, false); hi2.w = fp8x2_bf16(R.v[j].w, true);
        *(LAS u32x4*)(VL + row * 128 + ch * 32) = lo; *(LAS u32x4*)(VL + row * 128 + ch * 32 + 16) = hi2; }
    LAS long* QL = (LAS long*)(X.lds + 104448 + X.tid * 32);
    QL[0] = R.q[0]; QL[1] = R.q[1]; QL[2] = R.q[2]; QL[3] = R.q[3];
}
__device__ __forceinline__ void attn_compute(Ctx& X, int unit) {
    const int u16 = unit & 15, h = (unit >> 4) & 7, g = (unit >> 7) % 3, b = unit / 384;
    const int d = g == 0 ? 1 : g == 1 ? 4 : 16, nblk = 16 / d, r = u16 / nblk, blk = u16 % nblk;
    const int mk0 = blk * 256 - 128;
    LAS unsigned char* KL = X.lds; LAS unsigned char* VL = X.lds + 55296;
    const int l = X.lane, w = X.wave, q = l & 31, hi = l >> 5;
    const size_t tokq = (size_t)b * SEQ + (size_t)(blk * 256 + 32 * w + q) * d + r;
    long qf[4];
    { const LAS long* QL = (const LAS long*)(X.lds + 104448 + X.tid * 32); qf[0] = QL[0]; qf[1] = QL[1]; qf[2] = QL[2]; qf[3] = QL[3]; }
    f32x16 s[5];
#pragma unroll
    for (int kt = 0; kt < 5; ++kt) {
        f32x16 acc;
#pragma unroll
        for (int i = 0; i < 16; ++i) acc[i] = 0.f;
#pragma unroll
        for (int ds = 0; ds < 4; ++ds) { const long kf = *(const LAS long*)(KL + (32 * w + 32 * kt + q) * 80 + ds * 16 + hi * 8); acc = __builtin_amdgcn_mfma_f32_32x32x16_fp8_fp8(kf, qf[ds], acc, 0, 0, 0); }
        s[kt] = acc;
    }
    const int iq = 32 * w + q;
    const int jmin = iq > -mk0 ? iq : -mk0;
    const int tlo = jmin - (32 * w + 4 * hi), thi = iq + 128 - (32 * w + 128 + 4 * hi), tst = -mk0 - (32 * w + 4 * hi);
    float mx = -INFINITY;
#pragma unroll
    for (int kt = 0; kt < 5; ++kt) {
        const bool chk = kt == 0 || kt == 4 || (32 * w + 32 * kt < -mk0);
        if (chk) {
#pragma unroll
            for (int rg = 0; rg < 16; ++rg) { const int c = (rg & 3) + 8 * (rg >> 2);
                const bool valid = kt == 0 ? (c >= tlo) : kt == 4 ? (c <= thi) : (c + 32 * kt >= tst);
                s[kt][rg] = valid ? s[kt][rg] : -INFINITY; if ((rg & 3) == 3) __builtin_amdgcn_sched_barrier(0); }
        }
#pragma unroll
        for (int rg = 0; rg < 16; ++rg) mx = fmaxf(mx, s[kt][rg]);
    }
    mx = fmaxf(mx, __shfl_xor(mx, 32));
    const float c2 = 0.125f * 1.4426950408889634f, mxs = mx * c2;
    float lsum = 0.f;
#pragma unroll
    for (int kt = 0; kt < 5; ++kt)
#pragma unroll
        for (int rg = 0; rg < 16; ++rg) { const float p = __builtin_amdgcn_exp2f(__builtin_fmaf(s[kt][rg], c2, -mxs)); s[kt][rg] = p; lsum += p; }
    lsum += __shfl_xor(lsum, 32);
    f32x16 o[2];
#pragma unroll
    for (int dt = 0; dt < 2; ++dt)
#pragma unroll
        for (int i = 0; i < 16; ++i) o[dt][i] = 0.f;
    const int vlane = ((l & 15) >> 2) * 128 + (((l >> 4) & 1) * 16 + (l & 3) * 4) * 2;
#pragma unroll
    for (int kt = 0; kt < 5; ++kt)
#pragma unroll
        for (int s2 = 0; s2 < 2; ++s2) {
            bf16x8 pb;
#pragma unroll
            for (int j = 0; j < 8; j += 2) { const unsigned pw = pg8::cvt_pk_bf16(s[kt][8 * s2 + j], s[kt][8 * s2 + j + 1]); pb[j] = (short)(pw & 0xffffu); pb[j + 1] = (short)(pw >> 16); }
            const int key0 = 32 * w + 32 * kt + 16 * s2 + 4 * hi;
#pragma unroll
            for (int dt = 0; dt < 2; ++dt) {
                LAS unsigned char* vp = VL + key0 * 128 + dt * 64 + vlane;
                const s16x4 t0 = __builtin_amdgcn_ds_read_tr16_b64_v4i16((LAS s16x4*)vp);
                const s16x4 t1 = __builtin_amdgcn_ds_read_tr16_b64_v4i16((LAS s16x4*)(vp + 8 * 128));
                bf16x8 va; va[0] = t0[0]; va[1] = t0[1]; va[2] = t0[2]; va[3] = t0[3]; va[4] = t1[0]; va[5] = t1[1]; va[6] = t1[2]; va[7] = t1[3];
                o[dt] = MFMA32(va, pb, o[dt]);
            }
        }
    const float inv = 1.0f / lsum;
    bf16_t* OG = WSP(bf16_t, WS_OG) + (size_t)g * T * 512;
#pragma unroll
    for (int dt = 0; dt < 2; ++dt)
#pragma unroll
        for (int rg = 0; rg < 4; ++rg) { const int d0 = 32 * dt + 8 * rg + 4 * hi;
            u32x2 wv; wv.x = pg8::cvt_pk_bf16(o[dt][4 * rg] * inv, o[dt][4 * rg + 1] * inv); wv.y = pg8::cvt_pk_bf16(o[dt][4 * rg + 2] * inv, o[dt][4 * rg + 3] * inv);
            *(u32x2*)(OG + tokq * 512 + h * 64 + d0) = wv; }
    WSP(float, WS_LSE)[((size_t)g * T + tokq) * 8 + h] = mx * 0.125f + __logf(lsum);
}
__device__ __forceinline__ void attn_combine(Ctx& X) {
    const bf16_t* OG = WSP(bf16_t, WS_OG); const float* LSE = WSP(float, WS_LSE); bf16_t* YCAT = WSP(bf16_t, WS_YCAT);
    const int gt = X.wg * NTHREADS + X.tid, NGT = X.G * NTHREADS;
    for (int item = gt; item < T * 64; item += NGT) {
        const int t = item >> 6, ch = item & 63, h = ch >> 3;
        const float l0 = LSE[(size_t)t * 8 + h], l1 = LSE[((size_t)T + t) * 8 + h], l2 = LSE[((size_t)2 * T + t) * 8 + h];
        const float m = fmaxf(l0, fmaxf(l1, l2)); float w0 = __expf(l0 - m), w1 = __expf(l1 - m), w2 = __expf(l2 - m); const float inv = 1.f / (w0 + w1 + w2); w0 *= inv; w1 *= inv; w2 *= inv;
        const u32x4 a = *(const u32x4*)(OG + (size_t)t * 512 + ch * 8), bq = *(const u32x4*)(OG + ((size_t)T + t) * 512 + ch * 8), cq = *(const u32x4*)(OG + ((size_t)2 * T + t) * 512 + ch * 8);
        u32x4 o;
#pragma unroll
        for (int j = 0; j < 4; ++j) o[j] = pk2(w0 * bflo(a[j]) + w1 * bflo(bq[j]) + w2 * bflo(cq[j]), w0 * bfhi(a[j]) + w1 * bfhi(bq[j]) + w2 * bfhi(cq[j]));
        *(u32x4*)(YCAT + (size_t)t * D + 512 + ch * 8) = o;
    }
}

__device__ __forceinline__ unsigned sortable_key(float f) { const unsigned u = __builtin_bit_cast(unsigned, f); return (u & 0x80000000u) ? ~u : (u | 0x80000000u); }
__device__ __forceinline__ void moe_route(Ctx& X, bool local) {
    const float* LG = WSP(float, WS_KVT); unsigned* CNT = WSP(unsigned, WS_CTL) + CW_CNT; int* LISTS = WSP(int, WS_LISTS); float* GATEW = WSP(float, WS_GATEW);
    const int gw = X.wg * NWAVES + X.wave, NGW = X.G * NWAVES, l = X.lane, grp = l >> 3;
    const f32x4 bias = *(const f32x4*)(X.rbias + 4 * l);
    const unsigned long long ltmask = (1ull << l) - 1ull;
    const int tbeg = local ? X.wg * 64 + X.wave : gw, tend = local ? X.wg * 64 + 64 : T, tstep = local ? NWAVES : NGW;
    for (int t = tbeg; t < tend; t += tstep) {
        f32x4 lg = *(const f32x4*)(LG + (size_t)t * 256 + 4 * l);
#pragma unroll
        for (int ks = 1; ks < 4; ++ks) lg += *(const f32x4*)(LG + ((size_t)ks * T + t) * 256 + 4 * l);
        float sc[4], mb[4];
#pragma unroll
        for (int i = 0; i < 4; ++i) { sc[i] = sigmoidf_(lg[i]); mb[i] = sc[i] + bias[i]; }
        float m1 = fmaxf(mb[0], mb[1]), m2 = fminf(mb[0], mb[1]);
        { const float a1 = fmaxf(mb[2], mb[3]), a2 = fminf(mb[2], mb[3]); const float n1 = fmaxf(m1, a1), n2 = fmaxf(fminf(m1, a1), fmaxf(m2, a2)); m1 = n1; m2 = n2; }
#pragma unroll
        for (int o = 1; o < 8; o <<= 1) { const float a1 = __shfl_xor(m1, o), a2 = __shfl_xor(m2, o); const float n1 = fmaxf(m1, a1), n2 = fmaxf(fminf(m1, a1), fmaxf(m2, a2)); m1 = n1; m2 = n2; }
        const float gs = m1 + m2;
        int rank = 0;
#pragma unroll
        for (int gg = 0; gg < 8; ++gg) { const float og = __builtin_bit_cast(float, __builtin_amdgcn_readlane(__builtin_bit_cast(int, gs), gg * 8)); rank += (og > gs || (og == gs && gg < grp)) ? 1 : 0; }
        const bool sel = rank < 4;
        unsigned key[4];
#pragma unroll
        for (int i = 0; i < 4; ++i) key[i] = sel ? sortable_key(mb[i]) : 0u;
        unsigned pre = 0u;
#pragma unroll 1
        for (int bit = 31; bit >= 0; --bit) { const unsigned cand = pre | (1u << bit);
            const int cnt = __popcll(__ballot(key[0] >= cand)) + __popcll(__ballot(key[1] >= cand)) + __popcll(__ballot(key[2] >= cand)) + __popcll(__ballot(key[3] >= cand));
            if (cnt >= TOPK) pre = cand; }
        int ngt = 0, eqb = 0, tkb = 0; bool take[4];
#pragma unroll
        for (int i = 0; i < 4; ++i) ngt += __popcll(__ballot(key[i] > pre));
        const int need = TOPK - ngt;
#pragma unroll
        for (int i = 0; i < 4; ++i) eqb += __popcll(__ballot(key[i] == pre) & ltmask);
        int eqrun = eqb;
#pragma unroll
        for (int i = 0; i < 4; ++i) { const bool eq = key[i] == pre; take[i] = (key[i] > pre) || (eq && eqrun < need); eqrun += eq ? 1 : 0; }
#pragma unroll
        for (int i = 0; i < 4; ++i) tkb += __popcll(__ballot(take[i]) & ltmask);
        float part = 0.f;
#pragma unroll
        for (int i = 0; i < 4; ++i) part += take[i] ? sc[i] : 0.f;
        const float scale = 2.5f / wave_sum(part);
        int slot = tkb;
#pragma unroll
        for (int i = 0; i < 4; ++i) if (take[i]) { const int e = 4 * l + i; const unsigned pos = atomicAdd(&CNT[e * 64], 1u); LISTS[(size_t)e * 16384 + pos] = t * NSLOT + slot; GATEW[t * NSLOT + slot] = sc[i] * scale; ++slot; }
        if (l == 0) { LISTS[(size_t)NE * 16384 + t] = t * NSLOT + TOPK; GATEW[t * NSLOT + TOPK] = 1.0f; }
    }
}
__device__ __forceinline__ int moe_table(Ctx& X) {
    LAS int* tbl = (LAS int*)(X.lds + TBL_OFF); LAS int* cnts = (LAS int*)(X.lds + TCNT_OFF); LAS int* pref = cnts + 320;
    const unsigned* CNT = WSP(unsigned, WS_CTL) + CW_CNT;
    const int x = X.wg & 7;
    if (X.tid < NEX) cnts[X.tid] = X.tid < NE ? (int)__hip_atomic_load(CNT + X.tid * 64, __ATOMIC_RELAXED, __HIP_MEMORY_SCOPE_AGENT) : T;
    __syncthreads();
    if (X.tid < NEX) { int pre = 0; for (int e = 0; e < X.tid; ++e) pre += (cnts[e] + 255) >> 8; pref[X.tid] = pre; }
    __syncthreads();
    if (X.tid < 33) {
        const int i = X.tid; int lp = 0; for (int k = 0; k < i && k < 32; ++k) lp += (cnts[x + 8 * k] + 255) >> 8;
        if (i < 32) { const int e = x + 8 * i, n = (cnts[e] + 255) >> 8, p0 = pref[e]; for (int r = 0; r < n; ++r) tbl[lp + r] = ((p0 + r) << 16) | (e << 7) | r; }
        else { const int p0 = pref[NE]; for (int r8 = 0; r8 < 8; ++r8) { const int r = 8 * x + r8; tbl[lp + r8] = ((p0 + r) << 16) | (NE << 7) | r; } cnts[600] = lp + 8; }
    }
    __syncthreads();
    return __builtin_amdgcn_readfirstlane(cnts[600]);
}
__device__ __forceinline__ void final_rows(Ctx& X) {
    const bf16_t* X1 = WSP(bf16_t, WS_X1); const float* MOD = WSP(float, WS_MOD); const unsigned char* YBUF = WSP(unsigned char, WS_YBUF);
    const int gw = X.wg * NWAVES + X.wave, NGW = X.G * NWAVES, l = X.lane;
    for (int t = gw; t < T; t += NGW) {
        const int b = t / SEQ; f32x4 v[2][2]; float s = 0.f;
#pragma unroll
        for (int j = 0; j < 2; ++j) { const int col = 8 * l + 512 * j; f32x4 m0 = {0.f, 0.f, 0.f, 0.f}, m1 = {0.f, 0.f, 0.f, 0.f};
#pragma unroll
            for (int k = 0; k < NSLOT; ++k) { const u32x2 y = *(const u32x2*)(YBUF + ((size_t)t * NSLOT + k) * D + col);
                const f32x2 a = __builtin_amdgcn_cvt_pk_f32_fp8((int)y.x, false), bq = __builtin_amdgcn_cvt_pk_f32_fp8((int)y.x, true), c = __builtin_amdgcn_cvt_pk_f32_fp8((int)y.y, false), d = __builtin_amdgcn_cvt_pk_f32_fp8((int)y.y, true);
                m0.x += a[0]; m0.y += a[1]; m0.z += bq[0]; m0.w += bq[1]; m1.x += c[0]; m1.y += c[1]; m1.z += d[0]; m1.w += d[1]; }
            const f32x4 g0 = *(const f32x4*)(MOD + b * 6144 + 5120 + col) * (1.0f / YSCALE), g1 = *(const f32x4*)(MOD + b * 6144 + 5120 + col + 4) * (1.0f / YSCALE);
            const u32x4 xw = *(const u32x4*)(X1 + (size_t)t * D + col); const f32x4 x0 = {bflo(xw.x), bfhi(xw.x), bflo(xw.y), bfhi(xw.y)}, x1 = {bflo(xw.z), bfhi(xw.z), bflo(xw.w), bfhi(xw.w)};
            v[j][0] = x0 + g0 * m0; v[j][1] = x1 + g1 * m1;
#pragma unroll
            for (int q = 0; q < 2; ++q) s += (v[j][q].x * v[j][q].x + v[j][q].y * v[j][q].y) + (v[j][q].z * v[j][q].z + v[j][q].w * v[j][q].w); }
        const float rstd = rsqrtf(wave_sum(s) * (1.f / D) + EPS);
#pragma unroll
        for (int j = 0; j < 2; ++j) { const int col = 8 * l + 512 * j;
            *(f32x4*)(X.out + (size_t)t * D + col) = v[j][0] * rstd * *(const f32x4*)(X.g_final + col); *(f32x4*)(X.out + (size_t)t * D + col + 4) = v[j][1] * rstd * *(const f32x4*)(X.g_final + col + 4); }
    }
}

__device__ __forceinline__ unsigned* panel_word(Ctx& X, int bank, int pm) { return WSP(unsigned, WS_CTL) + CW_PANEL + (bank * 64 + pm) * 64; }
__device__ __forceinline__ void panel_signal(Ctx& X, int bank, int pm) {
    asm volatile("s_waitcnt vmcnt(0)" ::: "memory"); __syncthreads();
    if (X.tid == 0) (void)xb_add(panel_word(X, bank, pm), 1u);
}
__device__ __forceinline__ void panel_wait(Ctx& X, int bank, int pm, unsigned target) {
    if (X.tid == 0) { unsigned* p = panel_word(X, bank, pm); unsigned sp = 0u;
        while (xb_ld(p) < target) { __builtin_amdgcn_s_sleep(2); if (++sp > (1u << 22)) break; }
        __builtin_amdgcn_fence(__ATOMIC_ACQUIRE, "agent"); asm volatile("s_waitcnt vmcnt(0)" ::: "memory"); }
    __syncthreads();
}

constexpr int NG_INPROJ = 176;
__device__ __forceinline__ void ph_inproj(Ctx& X) {
    const int ng = X.G > NG_INPROJ + 8 ? NG_INPROJ : X.G;
    if (X.wg < ng) {
        RegSched S{(const char*)WSP(bf16_t, WS_H), (const char*)WSP(bf16_t, WS_WIN), (size_t)256 * 2048, (size_t)256 * 2048, T / 256, INW / 256, ng, X.wg};
        EpiInproj E{WSP(bf16_t, WS_PROJ), WSP(float, WS_LOGF), WSP(float, WS_LB), WSP(float, WS_ROPE), WSP(unsigned char, WS_G8), WSP(unsigned char, WS_QK8)};
        pg8::gemm_phase<EpiInproj, RegSched, true, false>(X.lds, 1024, 1024, 1024, S, E);
    }
    if (ng == X.G) expert_convert(X, X.wg, X.G);
    else if (X.wg >= ng) expert_convert(X, X.wg - ng, X.G - ng);
}
__device__ __forceinline__ void ph_mix_a(Ctx& X) {
    for (int it = X.wg; it < 256; it += X.G) hgrn_kv_unit(X, it);
    AttnRegs Ra, Rb; int unit = X.wg;
    auto clampu = [](int u) { return u < 1536 ? u : 1535; };
    attn_load(X, clampu(unit), Ra);
    __builtin_amdgcn_sched_barrier(0);
    attn_load(X, clampu(unit + X.G), Rb);
    __builtin_amdgcn_sched_barrier(0);
#define ATTN_STEP(R_) do { attn_stage(X, R_); __syncthreads(); __builtin_amdgcn_sched_barrier(0); attn_load(X, clampu(unit + 2 * X.G), R_); __builtin_amdgcn_sched_barrier(0); \
        attn_compute(X, unit); __syncthreads(); unit += X.G; } while (0)
    if (unit < 1536) {
        ATTN_STEP(Ra);
        while (unit < 1536) {
            ATTN_STEP(Rb);
            if (unit >= 1536) break;
            ATTN_STEP(Ra);
        }
    }
#undef ATTN_STEP
}
__device__ __forceinline__ void ph_mix_c(Ctx& X) { for (int it = X.wg; it < 512; it += X.G) hgrn_out_unit(X, it); attn_combine(X); }
__device__ __forceinline__ void ph_mixed(Ctx& X, bool chain) {
    TwoPartSched S{(const char*)WSP(bf16_t, WS_YCAT), (const char*)WSP(bf16_t, WS_WPA), (const char*)WSP(bf16_t, WS_WPB), T / 256, D / 256, X.G, X.wg};
    EpiMixed E{WSP(unsigned char, WS_G8), WSP(bf16_t, WS_MIXED)};
    pg8::gemm_phase<EpiMixed, TwoPartSched, false, false>(X.lds, 1024, 512, 512, S, E);
    if (chain) { int pm, pn; pg8::swz_tile(X.wg, T / 256, D / 256, pm, pn); panel_signal(X, 0, pm); }
}
__device__ __forceinline__ void ph_outproj(Ctx& X, bool chain) {
    int pm = 0, pn = 0; pg8::swz_tile(X.wg < 256 ? X.wg : 0, T / 256, D / 256, pm, pn);
    RegSched S{(const char*)WSP(bf16_t, WS_MIXED), (const char*)WSP(bf16_t, WS_WOUT), (size_t)256 * 2048, (size_t)256 * 2048, T / 256, D / 256, X.G, X.wg};
    if (chain) {
        panel_wait(X, 0, pm, 4u);
        EpiOutNorm E{X.x, WSP(float, WS_MOD), X.g2, WSP(bf16_t, WS_X1), WSP(bf16_t, WS_H), WSP(unsigned char, WS_H8), WSP(float, WS_XB), panel_word(X, 1, 0), X.lds + 139264};
        pg8::gemm_phase<EpiOutNorm, RegSched, true, false>(X.lds, 1024, 1024, 1024, S, E);
        panel_signal(X, 2, pm);
    } else {
        EpiOutproj E{X.x, WSP(float, WS_MOD), WSP(bf16_t, WS_X1)};
        pg8::gemm_phase<EpiOutproj, RegSched, false, false>(X.lds, 1024, 1024, 1024, S, E);
    }
}
__device__ __forceinline__ void ph_norm2(Ctx& X, bool chain) { if (!chain) norm_rows(X, 1); }
__device__ __forceinline__ void ph_router(Ctx& X, bool chain) {
    if (chain) panel_wait(X, 2, X.wg >> 2, 4u);
    RouterSched S{(const char*)WSP(bf16_t, WS_H), (const char*)WSP(bf16_t, WS_WR), X.G, X.wg};
    EpiRouter E{WSP(float, WS_KVT)};
    pg8::gemm_phase<EpiRouter, RouterSched, false, false>(X.lds, 1024, 1024, 256, S, E);
    if (chain) panel_signal(X, 3, X.wg >> 2);
}
__device__ __forceinline__ void ph_route(Ctx& X, bool chain) {
    if (chain) panel_wait(X, 3, X.wg >> 2, 4u);
    moe_route(X, chain);
}
__device__ __forceinline__ void ph_gu(Ctx& X) {
    const int nent = moe_table(X);
    MoeSched S{(const LAS int*)(X.lds + TBL_OFF), (const LAS int*)(X.lds + TCNT_OFF), nent, (const char*)WSP(unsigned char, WS_H8), (const char*)WSP(unsigned char, WS_WGU), WSP(int, WS_LISTS), 2, 256 * 1024, 512 * 1024, 0, X.G, X.wg};
    EpiGU E{WSP(unsigned char, WS_ACT)};
    pg8::gemm_phase<EpiGU, MoeSched, true, true, true>(X.lds, 512, 512, 512, S, E);
}
__device__ __forceinline__ void ph_down(Ctx& X) {
    const int nent = moe_table(X);
    MoeSched S{(const LAS int*)(X.lds + TBL_OFF), (const LAS int*)(X.lds + TCNT_OFF), nent, (const char*)WSP(unsigned char, WS_ACT), (const char*)WSP(unsigned char, WS_WD), WSP(int, WS_LISTS), 4, 256 * 256, 1024 * 256, 256 * 256, X.G, X.wg};
    EpiDown E{WSP(unsigned char, WS_YBUF), WSP(float, WS_GATEW)};
    pg8::gemm_phase<EpiDown, MoeSched, true, false, true>(X.lds, 128, 128, 128, S, E);
}

constexpr int NPHASE = 14;
struct Args { const void* in[20]; float* out; unsigned char* ws; int ph_lo, ph_hi; };
__global__ void __launch_bounds__(NTHREADS, 2) mega_fwd(Args args) {
    extern __shared__ __attribute__((aligned(16))) unsigned char lds_raw[];
    Ctx X;
    X.lds = (LAS unsigned char*)lds_raw;
    X.tid = threadIdx.x; X.lane = X.tid & 63; X.wave = __builtin_amdgcn_readfirstlane(X.tid >> 6); X.wg = blockIdx.x; X.G = gridDim.x;
    X.x = (const float*)args.in[0]; X.c = (const float*)args.in[1]; X.positions = (const int*)args.in[2]; X.w_ada = (const float*)args.in[3]; X.b_ada = (const float*)args.in[4];
    X.g1 = (const float*)args.in[5]; X.w_in = (const float*)args.in[6]; X.lb_logits = (const float*)args.in[7]; X.g_hgrn = (const float*)args.in[8]; X.w_pa = (const float*)args.in[9];
    X.w_pb = (const float*)args.in[10]; X.w_out = (const float*)args.in[11]; X.g2 = (const float*)args.in[12]; X.w_router = (const float*)args.in[13]; X.rbias = (const float*)args.in[14];
    X.w_egu = (const float*)args.in[15]; X.w_edown = (const float*)args.in[16]; X.w_sgu = (const float*)args.in[17]; X.w_sdown = (const float*)args.in[18]; X.g_final = (const float*)args.in[19];
    X.out = args.out; X.ws = args.ws;
    volatile LAS unsigned* MISC = (volatile LAS unsigned*)(X.lds + MISC_OFF);
    if (X.tid < 32) MISC[X.tid] = 0u;
    __syncthreads();
    const int lo = args.ph_lo, hi = args.ph_hi;
    XcdBarrier bar; bar.bar = WSP(unsigned, WS_CTL) + CW_BAR; bar.x = 0; bar.st = nullptr;
    if (hi - lo > 1) bar = xcd_barrier_post(WSP(unsigned, WS_CTL) + CW_BAR, MISC + 8);
#ifndef PH_MASK
#define PH_MASK 0xffffffffu
#endif
#define IN(k) ((((PH_MASK) >> (k)) & 1u) && lo <= (k) && (k) < hi)
#ifndef REPEAT_MASK
#define REPEAT_MASK 0u
#endif
#define SEAM(k) do { if (IN(k) && IN((k) + 1)) xcd_barrier(bar); } while (0)
#define RUN(k, call) do { if (IN(k)) { call; if (((REPEAT_MASK) >> (k)) & 1u) { xcd_barrier(bar); call; } } } while (0)

    const bool p01 = IN(0) && IN(1);
    RUN(0, p0_prologue(X));
    if (p01) { asm volatile("s_waitcnt vmcnt(0)" ::: "memory"); __syncthreads(); if (X.tid == 0) (void)xb_add(WSP(unsigned, WS_CTL) + CW_P0 + 64 * (X.wg & 7), 1u); }
    if (IN(1)) {
        small_transposes(X);
        if (p01) {
            if (X.tid == 0) { unsigned* p = WSP(unsigned, WS_CTL) + CW_P0; unsigned sp = 0u;
                for (;;) { unsigned sum = 0u;
#pragma unroll
                    for (int j = 0; j < 8; ++j) sum += xb_ld(p + 64 * j);
                    if (sum >= (unsigned)X.G) break;
                    __builtin_amdgcn_s_sleep(2); if (++sp > (1u << 22)) break; }
                __builtin_amdgcn_fence(__ATOMIC_ACQUIRE, "agent"); asm volatile("s_waitcnt vmcnt(0)" ::: "memory"); }
            __syncthreads();
        }
        norm_rows(X, 0);
    }
    SEAM(1);
    RUN(2, ph_inproj(X)); SEAM(2);
    RUN(3, ph_mix_a(X)); SEAM(3);
    RUN(4, hgrn_passB(X)); SEAM(4);
    RUN(5, ph_mix_c(X)); SEAM(5);
    const bool chain = (X.G == 256);
    RUN(6, ph_mixed(X, chain)); if (!chain) SEAM(6);
    RUN(7, ph_outproj(X, chain)); if (!chain) SEAM(7);
    RUN(8, ph_norm2(X, chain)); if (!chain) SEAM(8);
    RUN(9, ph_router(X, chain)); if (!chain) SEAM(9);
    RUN(10, ph_route(X, chain)); SEAM(10);
    RUN(11, ph_gu(X)); SEAM(11);
    RUN(12, ph_down(X)); SEAM(12);
    RUN(13, final_rows(X));
#undef IN
#undef SEAM
}

extern "C" void kernel_launch(void* const* d_in, const int* in_sizes, int n_in, void* d_out, int out_size, void* d_ws, size_t ws_size, hipStream_t stream) {
    static int grid = 0;
    if (grid == 0) {
        if (n_in != 20 || out_size != T * D || ws_size < WS_END) { fprintf(stderr, "kernel_launch: unexpected shapes (n_in %d, out %d, ws %zu); nothing launched\n", n_in, out_size, ws_size); grid = -1; return; }
        int dev = 0, cus = 0, per_cu = 0;
        if (hipGetDevice(&dev) != hipSuccess || hipDeviceGetAttribute(&cus, hipDeviceAttributeMultiprocessorCount, dev) != hipSuccess) { grid = -1; return; }
        if (hipFuncSetAttribute((const void*)mega_fwd, hipFuncAttributeMaxDynamicSharedMemorySize, LDS_BYTES) != hipSuccess) { fprintf(stderr, "kernel_launch: hipFuncSetAttribute failed\n"); grid = -1; return; }
        if (hipOccupancyMaxActiveBlocksPerMultiprocessor(&per_cu, (const void*)mega_fwd, NTHREADS, LDS_BYTES) != hipSuccess || per_cu < 1) { fprintf(stderr, "kernel_launch: occupancy query says %d blocks/CU; nothing launched\n", per_cu); (void)hipGetLastError(); grid = -1; return; }
        grid = cus;
        if (T % grid != 0 || 24576 % grid != 0 || grid % 8 != 0) { fprintf(stderr, "kernel_launch: grid %d does not divide the row count; nothing launched\n", grid); grid = -1; return; }
    }
    if (grid < 0) return;
    (void)hipMemsetAsync((char*)d_ws + WS_CTL, 0, CTL_ZERO_BYTES, stream);
    Args a{};
    for (int i = 0; i < 20; ++i) a.in[i] = d_in[i];
    a.out = (float*)d_out; a.ws = (unsigned char*)d_ws;
#if MK_PER_PHASE
    for (int p = 0; p < NPHASE; ++p) { a.ph_lo = p; a.ph_hi = p + 1; hipLaunchKernelGGL(mega_fwd, dim3(grid), dim3(NTHREADS), LDS_BYTES, stream, a); }
#else
    a.ph_lo = 0; a.ph_hi = NPHASE;
    hipLaunchKernelGGL(mega_fwd, dim3(grid), dim3(NTHREADS), LDS_BYTES, stream, a);
#endif
}
```

```cpp
#include <hip/hip_runtime.h>
#include <cstdio>
#include <cstdint>

#ifndef MK_PER_PHASE
#define MK_PER_PHASE 0
#endif

#define GAS __attribute__((address_space(1)))
#define LAS __attribute__((address_space(3)))
typedef unsigned short bf16_t;
typedef short bf16x8 __attribute__((ext_vector_type(8)));
typedef short s16x4 __attribute__((ext_vector_type(4)));
typedef float f32x4 __attribute__((ext_vector_type(4)));
typedef float f32x2 __attribute__((ext_vector_type(2)));
typedef float f32x16 __attribute__((ext_vector_type(16)));
typedef unsigned u32x4 __attribute__((ext_vector_type(4)));
typedef unsigned u32x2 __attribute__((ext_vector_type(2)));
typedef long l64x2 __attribute__((ext_vector_type(2)));

constexpr int NB = 4, SEQ = 4096, T = NB * SEQ, D = 1024, INW = 8704;
constexpr int C_HQ = 0, C_HK = 512, C_HV = 1024, C_HG = 1536, C_AQ = 2048, C_AK = 3584, C_AV = 5120, C_GA = 6656, C_GB = 7680;
constexpr int NE = 256, NEX = 257, TOPK = 8, NSLOT = 9, EFF = 256;
constexpr float EPS = 1e-6f;
constexpr float WGU_SCALE = 64.0f, WD_SCALE = 32.0f;
constexpr float YSCALE = 16.0f;
constexpr int NWAVES = 8, NTHREADS = 512;

constexpr size_t MiB = 1u << 20;
constexpr size_t WS_CTL = 0, CTL_ZERO_BYTES = 1 * MiB;
constexpr size_t WS_MODP = 2 * MiB;
constexpr size_t WS_MOD = 4 * MiB;
constexpr size_t WS_LB = 4 * MiB + 128 * 1024;
constexpr size_t WS_XB = 4 * MiB + 256 * 1024;
constexpr size_t WS_ROPE = 5 * MiB;
constexpr size_t WS_DECAY = 6 * MiB;
constexpr size_t WS_GATEW = 7 * MiB;
constexpr size_t WS_LISTS = 16 * MiB;
constexpr size_t WS_WIN = 34 * MiB;
constexpr size_t WS_WPA = 51 * MiB, WS_WPB = 52 * MiB, WS_WOUT = 53 * MiB, WS_WR = 55 * MiB;
constexpr size_t WS_H = 56 * MiB;
constexpr size_t WS_LOGF = 88 * MiB;
constexpr size_t WS_H8 = 120 * MiB;
constexpr size_t WS_MIXED = 136 * MiB;
constexpr size_t WS_YCAT = 168 * MiB;
constexpr size_t WS_X1 = 200 * MiB;
constexpr size_t WS_G8 = 232 * MiB;
constexpr size_t WS_OG = 264 * MiB;
constexpr size_t WS_LSE = 312 * MiB;
constexpr size_t WS_KVT = 314 * MiB;
constexpr size_t WS_SPT = 378 * MiB;
constexpr size_t WS_PROJ = 410 * MiB;
constexpr size_t WS_WGU = 682 * MiB;
constexpr size_t WS_QK8 = 820 * MiB;
constexpr size_t WS_WD = 939 * MiB;
constexpr size_t WS_ACT = 1068 * MiB;
constexpr size_t WS_YBUF = 1172 * MiB;
constexpr size_t WS_END = 1460 * MiB;
constexpr int CW_P0 = 2048;
constexpr int CW_BAR = 4096;
constexpr int CW_PANEL = 65536;
constexpr int CW_CNT = 16384;

constexpr int RING_BYTES = 131072;
constexpr int TBL_OFF = RING_BYTES;
constexpr int TCNT_OFF = TBL_OFF + 4096;
constexpr int MISC_OFF = TCNT_OFF + 2560;
constexpr int LDS_BYTES = 147456;

#define LDS_WAIT() asm volatile("s_waitcnt lgkmcnt(0)" ::: "memory")
#define VM_WAIT() asm volatile("s_waitcnt vmcnt(0)" ::: "memory")
__device__ __forceinline__ unsigned f2bf(float f) { unsigned u = __builtin_bit_cast(unsigned, f); return (u + 0x7fffu + ((u >> 16) & 1u)) >> 16; }
__device__ __forceinline__ float bf2f(unsigned b) { return __builtin_bit_cast(float, b << 16); }
__device__ __forceinline__ unsigned pk2(float lo, float hi) { return f2bf(lo) | (f2bf(hi) << 16); }
__device__ __forceinline__ float bflo(unsigned w) { return __builtin_bit_cast(float, w << 16); }
__device__ __forceinline__ float bfhi(unsigned w) { return __builtin_bit_cast(float, w & 0xffff0000u); }
__device__ __forceinline__ float fast_logf(float x) { return __builtin_amdgcn_logf(x) * 0.6931471805599453f; }
__device__ __forceinline__ float sigmoidf_(float x) { return __builtin_amdgcn_rcpf(1.0f + __expf(-x)); }
__device__ __forceinline__ float wave_sum(float v) {
#pragma unroll
    for (int o = 1; o < 64; o <<= 1) v += __shfl_xor(v, o);
    return v;
}

__device__ __forceinline__ float clamp_e4m3(float x) { return __builtin_amdgcn_fmed3f(x, -448.0f, 448.0f); }
__device__ __forceinline__ unsigned pk4_fp8(float a, float b, float c, float d) { int w = 0; w = __builtin_amdgcn_cvt_pk_fp8_f32(clamp_e4m3(a), clamp_e4m3(b), w, false); w = __builtin_amdgcn_cvt_pk_fp8_f32(clamp_e4m3(c), clamp_e4m3(d), w, true); return (unsigned)w; }
__device__ __forceinline__ void st_wt8(void* p, unsigned long long v) { __hip_atomic_store((unsigned long long*)p, v, __ATOMIC_RELAXED, __HIP_MEMORY_SCOPE_AGENT); }
__device__ __forceinline__ void st_wt16(void* p, u32x4 v) { asm volatile("global_store_dwordx4 %0, %1, off sc1\n\ts_nop 1" :: "v"(p), "v"(v) : "memory"); }
__device__ __forceinline__ void st_wt4(void* p, unsigned v) { __hip_atomic_store((unsigned*)p, v, __ATOMIC_RELAXED, __HIP_MEMORY_SCOPE_AGENT); }
namespace pg8 {
constexpr int BM = 256, BK = 64, HALF = 128, HTB = HALF * BK * 2, STAGE_BYTES = 8 * HTB, NXCD = 8, WGM = 8;
__host__ __device__ __forceinline__ int lds_byte(int r, int c) { const int st = (r >> 4) * 2 + (c >> 5), rr = r & 15, cc = c & 31, ob = rr * 64 + cc * 2; return st * 1024 + (ob ^ (((ob >> 9) & 1) << 5)); }
__host__ __device__ __forceinline__ void stage_rc(int b, int& R, int& C) { const int st = b / 1024, sb = b % 1024, swz = sb ^ (((sb >> 9) & 1) << 5); R = (st >> 1) * 16 + swz / 64; C = (st & 1) * 32 + (swz % 64) / 2; }
__host__ __device__ __forceinline__ int perm32(int rho) { const int n = rho >> 4, i = rho & 15; return 8 * (i >> 2) + 4 * n + (i & 3); }

struct Unit { const char* a; const char* b; const int* rows; int pm, pn, aux, nvalid; };

__device__ __forceinline__ void swz_tile(int L, int nM, int nN, int& pm, int& pn) {
    const int nwg = nM * nN; int wgid = L;
    { const int q = nwg / NXCD, r = nwg % NXCD, xcd = wgid % NXCD, off = wgid / NXCD; wgid = (xcd < r ? xcd * (q + 1) : r * (q + 1) + (xcd - r) * q) + off; }
    const int nig = WGM * nN, gid = wgid / nig, fm = gid * WGM, gsz = (nM - fm) < WGM ? (nM - fm) : WGM;
    pm = fm + ((wgid % nig) % gsz); pn = (wgid % nig) / gsz;
}

__device__ __forceinline__ unsigned cvt_pk_bf16(float lo, float hi) { unsigned r; asm volatile("v_cvt_pk_bf16_f32 %0, %1, %2" : "=v"(r) : "v"(lo), "v"(hi)); return r; }

template <bool GATHER>
__device__ __forceinline__ void gather_offs(const Unit& u, int tid, int lda, unsigned (&v)[2][2]) {
    if constexpr (GATHER) {
#pragma unroll
        for (int i = 0; i < 2; ++i) { int R, C; stage_rc(tid * 16 + i * 8192, R, C);
#pragma unroll
            for (int hh = 0; hh < 2; ++hh) { const int ri = hh * HALF + R; int slot = 0; if (ri < u.nvalid) slot = u.rows[ri];
                const unsigned tok = (unsigned)slot / 9u; v[hh][i] = (tok * (unsigned)lda + (unsigned)C) * 2u; } }
    }
}

template <class E, class = void> struct epi_bjadj { static constexpr bool v = false; };
template <class E> struct epi_bjadj<E, decltype((void)E::BJADJ)> { static constexpr bool v = E::BJADJ; };
template <class Epi, class Sched, bool ALIGN_EPI, bool GATHER, bool FP8 = false>
__device__ __forceinline__ void gemm_phase(LAS unsigned char* lds, const int lda, const int ldb, const int K, const Sched& S, const Epi& E) {
    const int tid = threadIdx.x, wid = __builtin_amdgcn_readfirstlane(tid >> 6), lane = tid & 63, wr = wid >> 2, wc = wid & 3, fr = lane & 15, fq = lane >> 4;
    const int nt = K / BK;
    unsigned voffA[2], voffB[2];
#pragma unroll
    for (int i = 0; i < 2; ++i) { int R, C; stage_rc(tid * 16 + i * 8192, R, C); const int Rb = Epi::PERM ? ((R & ~31) + perm32(R & 31)) : R;
        const int Rg = epi_bjadj<Epi>::v ? ((Rb >> 5) * 64 + (Rb & 31)) : Rb;
        voffA[i] = (unsigned)(R * lda + C) * 2u; voffB[i] = (unsigned)(Rg * ldb + C) * 2u; }
    const size_t kstep = (size_t)(BK * 2);
    const size_t hstepA = GATHER ? 0 : (size_t)HALF * lda * 2, hstepB = (size_t)(epi_bjadj<Epi>::v ? 32 : HALF) * ldb * 2;
    const unsigned ldsw = (unsigned)wid * 1024u;
    const int aoff = lds_byte(wr * 64 + fr, fq * 8), boff = lds_byte(wc * 32 + fr, fq * 8);
#define PG8_SA(b, h) (((b) * 2 + (h)) * HTB)
#define PG8_SB(b, h) ((4 + (b) * 2 + (h)) * HTB)
#define PG8_STAGE(bufoff, gbase, voff) do { _Pragma("unroll") for (int _i = 0; _i < 2; ++_i) \
        __builtin_amdgcn_global_load_lds((const unsigned*)((const char*)(gbase) + (voff)[_i]), (LAS unsigned*)(lds + (bufoff) + ldsw + _i * 8192), 16, 0, 0); } while (0)
#define PG8_STAGE_A(bufoff, gb, hh, nx) do { if constexpr (GATHER) { unsigned _v[2]; _v[0] = (nx) ? vn[hh][0] : vc[hh][0]; _v[1] = (nx) ? vn[hh][1] : vc[hh][1]; PG8_STAGE(bufoff, gb, _v); } \
        else { PG8_STAGE(bufoff, (gb) + (hh) * hstepA, voffA); } } while (0)
#define PG8_LDA(dst, b, h) do { _Pragma("unroll") for (int m = 0; m < 4; ++m) _Pragma("unroll") for (int k = 0; k < 2; ++k) dst[m][k] = *(const LAS bf16x8*)(lds + PG8_SA(b, h) + aoff + m * 2048 + k * 1024); } while (0)
#define PG8_LDB(dst, b, h) do { _Pragma("unroll") for (int n = 0; n < 2; ++n) _Pragma("unroll") for (int k = 0; k < 2; ++k) dst[n][k] = *(const LAS bf16x8*)(lds + PG8_SB(b, h) + boff + n * 2048 + k * 1024); } while (0)
#define PG8_MMA(ai, bj, At, Bt) do { __builtin_amdgcn_s_setprio(1); _Pragma("unroll") for (int m = 0; m < 4; ++m) _Pragma("unroll") for (int n = 0; n < 2; ++n) _Pragma("unroll") for (int k = 0; k < 2; ++k) { \
        if constexpr (FP8) { const l64x2 _b = __builtin_bit_cast(l64x2, Bt[n][k]), _a = __builtin_bit_cast(l64x2, At[m][k]); \
            acc[ai][bj][m][n] = __builtin_amdgcn_mfma_f32_16x16x32_fp8_fp8(_b[0], _a[0], acc[ai][bj][m][n], 0, 0, 0); acc[ai][bj][m][n] = __builtin_amdgcn_mfma_f32_16x16x32_fp8_fp8(_b[1], _a[1], acc[ai][bj][m][n], 0, 0, 0); } \
        else acc[ai][bj][m][n] = __builtin_amdgcn_mfma_f32_16x16x32_bf16(Bt[n][k], At[m][k], acc[ai][bj][m][n], 0, 0, 0); } __builtin_amdgcn_s_setprio(0); } while (0)
#define PG8_WAIT_V(n) asm volatile("s_waitcnt vmcnt(" #n ")" ::: "memory")
#define PG8_WAIT_L(n) asm volatile("s_waitcnt lgkmcnt(" #n ")" ::: "memory")
#define PG8_BAR __builtin_amdgcn_s_barrier()
#define PG8_SCHED __builtin_amdgcn_sched_barrier(0)
    Unit cur, nxt; int ui = 0;
    if (!S.next(0, cur)) return;
    unsigned vc[2][2] = {{0u, 0u}, {0u, 0u}}, vn[2][2] = {{0u, 0u}, {0u, 0u}};
    gather_offs<GATHER>(cur, tid, lda, vc);
    f32x4 acc[2][2][4][2];
#pragma unroll
    for (int a = 0; a < 2; ++a)
#pragma unroll
        for (int b = 0; b < 2; ++b)
#pragma unroll
            for (int m = 0; m < 4; ++m)
#pragma unroll
                for (int n = 0; n < 2; ++n) acc[a][b][m][n] = (f32x4){0.f, 0.f, 0.f, 0.f};
    bf16x8 At[4][2], B0[2][2], B1[2][2];
    const char* cA = cur.a; const char* cB = cur.b;
    PG8_STAGE(PG8_SB(0, 0), cB, voffB); PG8_STAGE(PG8_SB(0, 1), cB + hstepB, voffB); PG8_STAGE_A(PG8_SA(0, 0), cA, 0, false); PG8_STAGE_A(PG8_SA(0, 1), cA, 1, false);
    if (wr == 1) PG8_BAR;
    PG8_WAIT_V(2); PG8_BAR;
    PG8_STAGE(PG8_SB(1, 0), cB + kstep, voffB); PG8_STAGE_A(PG8_SA(1, 0), cA + kstep, 0, false); PG8_STAGE(PG8_SB(1, 1), cB + hstepB + kstep, voffB);
    PG8_WAIT_V(6); PG8_BAR;
    for (;;) {
        const bool has_next = S.next(ui + 1, nxt);
        if (has_next) gather_offs<GATHER>(nxt, tid, lda, vn);
        const char* nA = has_next ? nxt.a : cA; const char* nB = has_next ? nxt.b : cB;
        const bool do0 = !Sched::HALFSKIP || cur.nvalid > 64 * wr, do1 = !Sched::HALFSKIP || cur.nvalid > 128 + 64 * wr;
        for (int t = 0; t < nt; t += 2) {
            const bool last = (t == nt - 2);
            const bool lnx = last && has_next;
            const char* a1 = cA + (size_t)(t + 1) * kstep;
            const char* a2 = last ? nA : cA + (size_t)(t + 2) * kstep; const char* b2 = last ? nB : cB + (size_t)(t + 2) * kstep;
            const char* a3 = a2 + kstep; const char* b3 = b2 + kstep;
            PG8_LDB(B0, 0, 0); PG8_LDB(B1, 0, 1); PG8_SCHED; PG8_LDA(At, 0, 0); PG8_STAGE_A(PG8_SA(1, 1), a1, 1, false);
            PG8_WAIT_V(8); PG8_WAIT_L(0); PG8_BAR; if (do0) { PG8_MMA(0, 0, At, B0); PG8_MMA(0, 1, At, B1); } PG8_BAR; PG8_SCHED;
            PG8_LDA(At, 0, 1); PG8_STAGE(PG8_SB(0, 0), b2, voffB); PG8_STAGE(PG8_SB(0, 1), b2 + hstepB, voffB); PG8_STAGE_A(PG8_SA(0, 0), a2, 0, lnx);
            PG8_WAIT_V(8); PG8_WAIT_L(0); PG8_BAR; if (do1) { PG8_MMA(1, 0, At, B0); PG8_MMA(1, 1, At, B1); } PG8_BAR; PG8_SCHED;
            PG8_LDB(B0, 1, 0); PG8_LDB(B1, 1, 1); PG8_SCHED; PG8_LDA(At, 1, 0); PG8_STAGE_A(PG8_SA(0, 1), a2, 1, lnx);
            PG8_WAIT_V(8); PG8_WAIT_L(0); PG8_BAR; if (do0) { PG8_MMA(0, 0, At, B0); PG8_MMA(0, 1, At, B1); } PG8_BAR; PG8_SCHED;
            PG8_LDA(At, 1, 1); PG8_STAGE(PG8_SB(1, 0), b3, voffB); PG8_STAGE(PG8_SB(1, 1), b3 + hstepB, voffB); PG8_STAGE_A(PG8_SA(1, 0), a3, 0, lnx);
            PG8_WAIT_V(8); PG8_WAIT_L(0); PG8_BAR; if (do1) { PG8_MMA(1, 0, At, B0); PG8_MMA(1, 1, At, B1); } PG8_BAR; PG8_SCHED;
        }
        if constexpr (ALIGN_EPI) { if (wr == 0) PG8_BAR; }
        E(acc, cur, wr, wc, fr, fq);
        __builtin_amdgcn_s_waitcnt(0x0F70);
        if (!has_next) break;
        if (!E.keep(cur)) {
#pragma unroll
            for (int a = 0; a < 2; ++a)
#pragma unroll
                for (int b = 0; b < 2; ++b)
#pragma unroll
                    for (int m = 0; m < 4; ++m)
#pragma unroll
                        for (int n = 0; n < 2; ++n) acc[a][b][m][n] = (f32x4){0.f, 0.f, 0.f, 0.f};
        }
        cur = nxt; cA = nA; cB = nB; ++ui;
        if constexpr (GATHER) {
#pragma unroll
            for (int hh = 0; hh < 2; ++hh) { vc[hh][0] = vn[hh][0]; vc[hh][1] = vn[hh][1]; }
        }
        if constexpr (ALIGN_EPI) { if (wr == 1) PG8_BAR; }
    }
    PG8_WAIT_V(0);
    if constexpr (!ALIGN_EPI) { if (wr == 0) PG8_BAR; }
    PG8_BAR;
#undef PG8_SA
#undef PG8_SB
#undef PG8_STAGE
#undef PG8_STAGE_A
#undef PG8_LDA
#undef PG8_LDB
#undef PG8_MMA
#undef PG8_WAIT_V
#undef PG8_WAIT_L
#undef PG8_BAR
#undef PG8_SCHED
}
}

#define XB_TMO      128
#define XB_XCNT(j)  (256  + 64 * (j))
#define XB_XSUB(j)  (1280 + 64 * (j))
#define XB_XGEN(j)  (2304 + 64 * (j))
#define XB_TOP      3328
#define XB_TOPGEN   3392
#define XCD_BAR_WORDS 3456
#define XB_SPIN_CAP (1u << 20)
__device__ __forceinline__ unsigned xb_ld(unsigned* p)              { return __hip_atomic_load(p, __ATOMIC_RELAXED, __HIP_MEMORY_SCOPE_AGENT); }
__device__ __forceinline__ unsigned xb_add(unsigned* p, unsigned v) { return __hip_atomic_fetch_add(p, v, __ATOMIC_RELAXED, __HIP_MEMORY_SCOPE_AGENT); }
__device__ __forceinline__ unsigned xb_xcc_id() { return (unsigned)__builtin_amdgcn_s_getreg((3 << 11) | 20) & 0xFu; }
#define XB_SPIN(cond, bar) do { unsigned _sp = 0; while (cond) { __builtin_amdgcn_s_sleep(1); \
    if ((++_sp & 255u) == 0u) { if (xb_ld(&(bar)[XB_TMO])) break; if (_sp > XB_SPIN_CAP) { atomicAdd(&(bar)[XB_TMO], 1u); break; } } } } while (0)
struct XcdBarrier { unsigned* bar; unsigned x; volatile LAS unsigned* st; };
__device__ __forceinline__ XcdBarrier xcd_barrier_post(unsigned* bar, volatile LAS unsigned* st) {
    XcdBarrier b; b.bar = bar; b.x = xb_xcc_id(); b.st = st;
    if (threadIdx.x == 0) (void)xb_add(&bar[XB_XCNT(b.x)], 1u);
    return b;
}
__device__ __forceinline__ void xcd_barrier_complete(unsigned* bar, unsigned x, unsigned& nloc, unsigned& nx) {
    const unsigned G = gridDim.x * gridDim.y * gridDim.z;
    unsigned sum, cnt, mine, sp = 0u;
    for (;;) {
        sum = 0u; cnt = 0u; mine = 0u;
#pragma unroll
        for (unsigned j = 0; j < 16; ++j) { const unsigned c = xb_ld(&bar[XB_XCNT(j)]); sum += c; cnt += (c > 0u) ? 1u : 0u; mine = (j == x) ? c : mine; }
        if (sum == G) break;
        __builtin_amdgcn_s_sleep(1);
        if ((++sp & 255u) == 0u) { if (xb_ld(&bar[XB_TMO])) break; if (sp > XB_SPIN_CAP) { atomicAdd(&bar[XB_TMO], 1u); break; } }
    }
    nloc = mine > 0u ? mine : 1u; nx = cnt > 0u ? cnt : 1u;
}
__device__ __forceinline__ void xcd_barrier(const XcdBarrier& b) {
    asm volatile("s_waitcnt vmcnt(0)" ::: "memory");
    __syncthreads();
    if (threadIdx.x == 0) {
        unsigned* bar = b.bar;
        __builtin_amdgcn_s_waitcnt(0);
        unsigned nloc = b.st[0], nx = b.st[1];
        if (nloc == 0u) { xcd_barrier_complete(bar, b.x, nloc, nx); b.st[0] = nloc; b.st[1] = nx; }
        const unsigned old = xb_add(&bar[XB_XSUB(b.x)], 1u);
        const unsigned gen = old / nloc;
        if (old + 1u == (gen + 1u) * nloc) {
            __builtin_amdgcn_fence(__ATOMIC_RELEASE, "agent");
            asm volatile("s_waitcnt vmcnt(0)" ::: "memory");
            const unsigned og = xb_add(&bar[XB_TOP], 1u);
            const unsigned tg = og / nx;
            if (og + 1u == (tg + 1u) * nx) xb_add(&bar[XB_TOPGEN], 1u);
            else XB_SPIN(xb_ld(&bar[XB_TOPGEN]) == tg, bar);
            __builtin_amdgcn_fence(__ATOMIC_ACQUIRE, "agent");
            asm volatile("s_waitcnt vmcnt(0)" ::: "memory");
        } else {
            XB_SPIN(xb_ld(&bar[XB_TOPGEN]) == gen, bar);
            __builtin_amdgcn_fence(__ATOMIC_ACQUIRE, "agent");
            asm volatile("s_waitcnt vmcnt(0)" ::: "memory");
        }
    }
    __syncthreads();
}

struct Ctx {
    LAS unsigned char* lds;
    int tid, lane, wave, wg, G;
    const float *x, *c, *w_ada, *b_ada, *g1, *w_in, *lb_logits, *g_hgrn, *w_pa, *w_pb, *w_out, *g2, *w_router, *rbias, *w_egu, *w_edown, *w_sgu, *w_sdown, *g_final;
    const int* positions;
    float* out;
    unsigned char* ws;
};
#define WSP(type, off) ((type*)(X.ws + (off)))

__device__ __forceinline__ void transpose_item(const float* W, int K, int N, bf16_t* WT, int dst_row0, int src_col0, int k0, LAS float* scr, int lane) {
#pragma unroll 16
    for (int i = 0; i < 32; ++i) { const int kk = 2 * i + (lane >> 5); scr[kk * 33 + (lane & 31)] = W[(size_t)(k0 + kk) * N + src_col0 + (lane & 31)]; }
    LDS_WAIT(); asm volatile("" ::: "memory");
    const int c = lane & 7;
#pragma unroll
    for (int j = 0; j < 4; ++j) { const int n = (lane >> 3) + 8 * j; const LAS float* s = scr + (8 * c) * 33 + n;
        u32x4 o; o.x = pk2(s[0 * 33], s[1 * 33]); o.y = pk2(s[2 * 33], s[3 * 33]); o.z = pk2(s[4 * 33], s[5 * 33]); o.w = pk2(s[6 * 33], s[7 * 33]);
        *(u32x4*)(WT + (size_t)(dst_row0 + n) * K + k0 + 8 * c) = o; }
    LDS_WAIT(); asm volatile("" ::: "memory");
}
__device__ __forceinline__ void transpose_plain(const float* W, int K, int N, bf16_t* WT, int item, LAS float* scr, int lane) {
    const int nblk = N / 32, kb = item / nblk, nb = item % nblk;
    transpose_item(W, K, N, WT, nb * 32, nb * 32, kb * 64, scr, lane);
}
__device__ __forceinline__ void p0_prologue(Ctx& X) {
    LAS float* scr = (LAS float*)(X.lds + X.wave * 16384);
    const int gw = X.wg * NWAVES + X.wave, NGW = X.G * NWAVES;
    {
        float* MODP = WSP(float, WS_MODP);
        for (int it = gw; it < 96 * 16; it += NGW) {
            const int jc = it % 96, kc = it / 96, j = jc * 64 + X.lane;
            float a0 = 0.f, a1 = 0.f, a2 = 0.f, a3 = 0.f;
#pragma unroll 16
            for (int kk = 0; kk < 64; ++kk) { const int k = kc * 64 + kk; const float w = X.w_ada[(size_t)k * 6144 + j];
                const float c0 = X.c[k], c1 = X.c[1024 + k], c2 = X.c[2048 + k], c3 = X.c[3072 + k];
                a0 += c0 * sigmoidf_(c0) * w; a1 += c1 * sigmoidf_(c1) * w; a2 += c2 * sigmoidf_(c2) * w; a3 += c3 * sigmoidf_(c3) * w; }
            float* o = MODP + (size_t)kc * 24576 + j;
            st_wt4(o, __builtin_bit_cast(unsigned, a0)); st_wt4(o + 6144, __builtin_bit_cast(unsigned, a1)); st_wt4(o + 12288, __builtin_bit_cast(unsigned, a2)); st_wt4(o + 18432, __builtin_bit_cast(unsigned, a3));
        }
    }
    {
        float* ROPE = WSP(float, WS_ROPE);
        const int gt = X.wg * NTHREADS + X.tid, NGT = X.G * NTHREADS;
        for (int idx = gt; idx < T * 8; idx += NGT) { const int t = idx >> 3, i = idx & 7;
            const float inv_freq = 1.0f / powf(500000.0f, (float)(2 * i) / 16.0f);
            const float ang = (float)X.positions[t] * inv_freq;
            ROPE[t * 16 + i] = cosf(ang); ROPE[t * 16 + 8 + i] = sinf(ang); }
        if (X.wg == 0) { float* LB = WSP(float, WS_LB);
            for (int j = X.tid; j < 512; j += NTHREADS) { const float l0 = X.lb_logits[j], l1 = X.lb_logits[512 + j], m = fmaxf(l0, l1), e0 = __expf(l0 - m), e1 = __expf(l1 - m); LB[j] = e0 / (e0 + e1); } }
    }
}
struct CvtItem { const float* src; bf16_t* dst; };
template <bool GU> __device__ __forceinline__ CvtItem cvt_item(const Ctx& X, int it) {
    CvtItem c;
    if constexpr (GU) { const int e = it >> 7, q = it & 127, w8 = q & 7, sq = q >> 3, kb = 4 * (sq >> 2) + (w8 & 3), nb = 2 * (sq & 3) + (w8 >> 2);
        const int n0 = nb * 64, pn = n0 >> 8, bj = (n0 >> 7) & 1, idx = n0 & 127, srcc = bj * 256 + pn * 128 + idx;
        const float* W = (e < NE) ? X.w_egu + (size_t)e * 1024 * 512 : X.w_sgu;
        c.src = W + (size_t)(kb * 64) * 512 + srcc; c.dst = (bf16_t*)(X.ws + WS_WGU + ((size_t)e * 512 + n0) * 1024 + kb * 64); }
    else { const int e = it >> 6, q = it & 63, w8 = q & 7, sq = q >> 3, kb = w8 & 3, nb = 2 * sq + (w8 >> 2);
        const float* W = (e < NE) ? X.w_edown + (size_t)e * 256 * 1024 : X.w_sdown;
        c.src = W + (size_t)(kb * 64) * 1024 + nb * 64; c.dst = (bf16_t*)(X.ws + WS_WD + ((size_t)e * 1024 + nb * 64) * 256 + kb * 64); }
    return c;
}
template <int KB> __device__ __forceinline__ void cvt_store8(const CvtItem& c, int lane, const f32x4 (&v)[16], LAS unsigned char* tl, float sc) {
    const int kq = lane >> 4, nq = lane & 15;
#pragma unroll
    for (int i = 0; i < 4; ++i) { u32x4 w;
        w.x = pk4_fp8(v[0][i] * sc, v[1][i] * sc, v[2][i] * sc, v[3][i] * sc); w.y = pk4_fp8(v[4][i] * sc, v[5][i] * sc, v[6][i] * sc, v[7][i] * sc);
        w.z = pk4_fp8(v[8][i] * sc, v[9][i] * sc, v[10][i] * sc, v[11][i] * sc); w.w = pk4_fp8(v[12][i] * sc, v[13][i] * sc, v[14][i] * sc, v[15][i] * sc);
        *(LAS u32x4*)(tl + (4 * nq + i) * 80 + kq * 16) = w; }
    LDS_WAIT(); asm volatile("" ::: "memory");
    const int ch = lane & 3, r = lane >> 2;
    unsigned char* d8 = (unsigned char*)c.dst;
#pragma unroll
    for (int j = 0; j < 4; ++j) { const int n = 16 * j + r; const u32x4 w = *(const LAS u32x4*)(tl + n * 80 + ch * 16); __builtin_nontemporal_store(w, (u32x4*)(d8 + (size_t)n * KB + 16 * ch)); }
    LDS_WAIT(); asm volatile("" ::: "memory");
}
template <int N> __device__ __forceinline__ void cvt_load(const CvtItem& c, int lane, f32x4 (&v)[16]) {
    const float* p = c.src + (size_t)(16 * (lane >> 4)) * N + 4 * (lane & 15);
#pragma unroll
    for (int j = 0; j < 16; ++j) v[j] = __builtin_nontemporal_load((const f32x4*)(p + (size_t)j * N));
}
template <int K> __device__ __forceinline__ void cvt_store(const CvtItem& c, int lane, const f32x4 (&v)[16], LAS unsigned char* tl) {
    const int kq = lane >> 4, nq = lane & 15;
#pragma unroll
    for (int i = 0; i < 4; ++i) { u32x4 w0, w1;
        w0.x = pk2(v[0][i], v[1][i]); w0.y = pk2(v[2][i], v[3][i]); w0.z = pk2(v[4][i], v[5][i]); w0.w = pk2(v[6][i], v[7][i]);
        w1.x = pk2(v[8][i], v[9][i]); w1.y = pk2(v[10][i], v[11][i]); w1.z = pk2(v[12][i], v[13][i]); w1.w = pk2(v[14][i], v[15][i]);
        LAS unsigned char* q = tl + (4 * nq + i) * 144 + kq * 32; *(LAS u32x4*)q = w0; *(LAS u32x4*)(q + 16) = w1; }
    LDS_WAIT(); asm volatile("" ::: "memory");
    const int ch = lane & 7, r = lane >> 3;
#pragma unroll
    for (int j = 0; j < 8; ++j) { const int n = 8 * j + r; const u32x4 w = *(const LAS u32x4*)(tl + n * 144 + ch * 16); __builtin_nontemporal_store(w, (u32x4*)(c.dst + (size_t)n * K + 8 * ch)); }
    LDS_WAIT(); asm volatile("" ::: "memory");
}
struct CvtPair { const float* src; unsigned char* dst; };
template <bool GU> __device__ __forceinline__ CvtPair cvt_pair(const Ctx& X, int di) {
    CvtPair c;
    if constexpr (GU) { const int e = di >> 6, q = di & 63, nb = q & 7, kb2 = q >> 3;
        const int n0 = nb * 64, pn = n0 >> 8, bj = (n0 >> 7) & 1, idx = n0 & 127, srcc = bj * 256 + pn * 128 + idx;
        const float* W = (e < NE) ? X.w_egu + (size_t)e * 1024 * 512 : X.w_sgu;
        c.src = W + (size_t)(kb2 * 128) * 512 + srcc; c.dst = X.ws + WS_WGU + ((size_t)e * 512 + n0) * 1024 + kb2 * 128; }
    else { const int e = di >> 5, q = di & 31, nb = q & 15, kb2 = q >> 4;
        const float* W = (e < NE) ? X.w_edown + (size_t)e * 256 * 1024 : X.w_sdown;
        c.src = W + (size_t)(kb2 * 128) * 1024 + nb * 64; c.dst = X.ws + WS_WD + ((size_t)e * 1024 + nb * 64) * 256 + kb2 * 128; }
    return c;
}
template <int N> __device__ __forceinline__ void cvt_load_half(const CvtPair& c, int half, int lane, f32x4 (&v)[16]) {
    const float* p = c.src + (size_t)(64 * half + 16 * (lane >> 4)) * N + 4 * (lane & 15);
#pragma unroll
    for (int j = 0; j < 16; ++j) v[j] = __builtin_nontemporal_load((const f32x4*)(p + (size_t)j * N));
}
__device__ __forceinline__ void cvt_half_to_lds(int half, int lane, const f32x4 (&v)[16], LAS unsigned char* tl, float sc) {
    const int kq = lane >> 4, nq = lane & 15;
#pragma unroll
    for (int i = 0; i < 4; ++i) { u32x4 w;
        w.x = pk4_fp8(v[0][i] * sc, v[1][i] * sc, v[2][i] * sc, v[3][i] * sc); w.y = pk4_fp8(v[4][i] * sc, v[5][i] * sc, v[6][i] * sc, v[7][i] * sc);
        w.z = pk4_fp8(v[8][i] * sc, v[9][i] * sc, v[10][i] * sc, v[11][i] * sc); w.w = pk4_fp8(v[12][i] * sc, v[13][i] * sc, v[14][i] * sc, v[15][i] * sc);
        *(LAS u32x4*)(tl + (4 * nq + i) * 144 + half * 64 + kq * 16) = w; }
}
template <int KB> __device__ __forceinline__ void cvt_flush(const CvtPair& c, int lane, LAS unsigned char* tl) {
    LDS_WAIT(); asm volatile("" ::: "memory");
    const int ch = lane & 7, r = lane >> 3;
#pragma unroll
    for (int j = 0; j < 8; ++j) { const int n = 8 * j + r; const u32x4 w = *(const LAS u32x4*)(tl + n * 144 + ch * 16); __builtin_nontemporal_store(w, (u32x4*)(c.dst + (size_t)n * KB + 16 * ch)); }
    LDS_WAIT(); asm volatile("" ::: "memory");
}
template <bool GU> __device__ __forceinline__ void expert_convert_set(Ctx& X, int gw, int NGW, LAS unsigned char* tl) {
    constexpr int NIT = GU ? NEX * 64 : NEX * 32, N = GU ? 512 : 1024, K = GU ? 1024 : 256; constexpr float SC = GU ? WGU_SCALE : WD_SCALE;
    if (gw >= NIT) return;
    const int nmine = (NIT - gw + NGW - 1) / NGW;
    f32x4 va[16], vb[16];
    CvtPair cur = cvt_pair<GU>(X, gw);
    cvt_load_half<N>(cur, 0, X.lane, va); cvt_load_half<N>(cur, 1, X.lane, vb);
    for (int j = 0; j < nmine; ++j) {
        const CvtPair nxt = cvt_pair<GU>(X, gw + (j + 1 < nmine ? j + 1 : j) * NGW);
        __builtin_amdgcn_sched_barrier(0);
        cvt_half_to_lds(0, X.lane, va, tl, SC);
        __builtin_amdgcn_sched_barrier(0);
        cvt_load_half<N>(nxt, 0, X.lane, va);
        __builtin_amdgcn_sched_barrier(0);
        cvt_half_to_lds(1, X.lane, vb, tl, SC);
        cvt_flush<K>(cur, X.lane, tl);
        __builtin_amdgcn_sched_barrier(0);
        cvt_load_half<N>(nxt, 1, X.lane, vb);
        __builtin_amdgcn_sched_barrier(0);
        cur = nxt;
    }
}
__device__ __forceinline__ void expert_convert(Ctx& X, int cw, int ncw) {
    LAS unsigned char* tl = X.lds + X.wave * 16384;
    const int gw = cw * NWAVES + X.wave, NGW = ncw * NWAVES;
    expert_convert_set<true>(X, gw, NGW, tl);
    expert_convert_set<false>(X, gw, NGW, tl);
}

__device__ __forceinline__ void small_transposes(Ctx& X) {
    LAS float* scr = (LAS float*)(X.lds + 16384 + X.wave * 12288);
    const int gw = X.wg * NWAVES + X.wave, NGW = X.G * NWAVES;
    {
        constexpr int I_IN = 16 * 272, I_PA = 8 * 32, I_PB = 8 * 32, I_OUT = 16 * 32, I_R = 16 * 8;
        constexpr int NITEMS = I_IN + I_PA + I_PB + I_OUT + I_R;
        for (int it = gw; it < NITEMS; it += NGW) {
            int r = it;
            if (r < I_IN) { transpose_plain(X.w_in, 1024, INW, WSP(bf16_t, WS_WIN), r, scr, X.lane); continue; } r -= I_IN;
            if (r < I_PA) { transpose_plain(X.w_pa, 512, 1024, WSP(bf16_t, WS_WPA), r, scr, X.lane); continue; } r -= I_PA;
            if (r < I_PB) { transpose_plain(X.w_pb, 512, 1024, WSP(bf16_t, WS_WPB), r, scr, X.lane); continue; } r -= I_PB;
            if (r < I_OUT) { transpose_plain(X.w_out, 1024, 1024, WSP(bf16_t, WS_WOUT), r, scr, X.lane); continue; } r -= I_OUT;
            transpose_plain(X.w_router, 1024, 256, WSP(bf16_t, WS_WR), r, scr, X.lane);
        }
    }
}

__device__ __forceinline__ void norm_rows(Ctx& X, int which) {
    LAS float* sm = (LAS float*)X.lds;
    const float* MODP = WSP(float, WS_MODP); float* MOD = WSP(float, WS_MOD);
    const int rows_per_wg = T / X.G, row0 = X.wg * rows_per_wg, b = row0 / SEQ;
    if (which == 0) {
        for (int i = X.tid; i < 2048; i += NTHREADS) { const int j = b * 6144 + i; float s = X.b_ada[i];
#pragma unroll
            for (int p = 0; p < 16; ++p) s += MODP[(size_t)p * 24576 + j];
            sm[i] = s; }
        const int per = 24576 / X.G;
        for (int i = X.tid; i < per; i += NTHREADS) { const int j = X.wg * per + i; float s = X.b_ada[j % 6144];
#pragma unroll
            for (int p = 0; p < 16; ++p) s += MODP[(size_t)p * 24576 + j];
            MOD[j] = s; }
    } else {
        for (int i = X.tid; i < 2048; i += NTHREADS) sm[i] = MOD[b * 6144 + 3072 + i];
    }
    __syncthreads();
    const float* src = X.x; const bf16_t* srcb = WSP(bf16_t, WS_X1); const float* g = which == 0 ? X.g1 : X.g2;
    bf16_t* H = WSP(bf16_t, WS_H);
    for (int r = X.wave; r < rows_per_wg; r += NWAVES) {
        const int row = row0 + r;
        f32x4 v[2][2]; float s = 0.f;
#pragma unroll
        for (int j = 0; j < 2; ++j) { const int col = 8 * X.lane + 512 * j;
            if (which == 0) { v[j][0] = *(const f32x4*)(src + (size_t)row * D + col); v[j][1] = *(const f32x4*)(src + (size_t)row * D + col + 4); }
            else { const u32x4 wv = *(const u32x4*)(srcb + (size_t)row * D + col); v[j][0] = (f32x4){bflo(wv.x), bfhi(wv.x), bflo(wv.y), bfhi(wv.y)}; v[j][1] = (f32x4){bflo(wv.z), bfhi(wv.z), bflo(wv.w), bfhi(wv.w)}; }
#pragma unroll
            for (int q = 0; q < 2; ++q) s += (v[j][q].x * v[j][q].x + v[j][q].y * v[j][q].y) + (v[j][q].z * v[j][q].z + v[j][q].w * v[j][q].w); }
        const float rstd = rsqrtf(wave_sum(s) * (1.f / D) + EPS);
#pragma unroll
        for (int j = 0; j < 2; ++j) { const int col = 8 * X.lane + 512 * j; float y[8];
#pragma unroll
            for (int q = 0; q < 2; ++q) { const f32x4 gg = *(const f32x4*)(g + col + 4 * q), sh = *(const LAS f32x4*)(sm + col + 4 * q), sc = *(const LAS f32x4*)(sm + 1024 + col + 4 * q);
#pragma unroll
                for (int e = 0; e < 4; ++e) y[4 * q + e] = v[j][q][e] * rstd * gg[e] * (1.f + sc[e]) + sh[e]; }
            u32x4 hw; hw.x = pk2(y[0], y[1]); hw.y = pk2(y[2], y[3]); hw.z = pk2(y[4], y[5]); hw.w = pk2(y[6], y[7]);
            if (which == 1) { st_wt16(H + (size_t)row * D + col, hw);
                st_wt8(WSP(unsigned char, WS_H8) + (size_t)row * D + col, (unsigned long long)pk4_fp8(y[0], y[1], y[2], y[3]) | ((unsigned long long)pk4_fp8(y[4], y[5], y[6], y[7]) << 32)); }
            else *(u32x4*)(H + (size_t)row * D + col) = hw; }
    }
    __syncthreads();
}

struct RegSched {
    static constexpr bool HALFSKIP = false;
    const char* A; const char* Bt; size_t a_tile, b_tile; int nM, nN, G, c;
    __device__ __forceinline__ bool next(int i, pg8::Unit& u) const {
        const int L = i * G + c; if (L >= nM * nN) return false;
        int pm, pn; pg8::swz_tile(L, nM, nN, pm, pn);
        u.a = A + (size_t)pm * a_tile; u.b = Bt + (size_t)pn * b_tile; u.rows = nullptr; u.pm = pm; u.pn = pn; u.aux = 0; u.nvalid = 256; return true;
    }
};
struct TwoPartSched {      static constexpr bool HALFSKIP = false;
    const char* Y; const char* Wa; const char* Wb; int nM, nN, G, c;
    __device__ __forceinline__ bool next(int i, pg8::Unit& u) const {
        const int L = (i >> 1) * G + c, part = i & 1; if (L >= nM * nN) return false;
        int pm, pn; pg8::swz_tile(L, nM, nN, pm, pn);
        u.a = Y + (size_t)pm * 256 * 2048 + part * 1024; u.b = (part ? Wb : Wa) + (size_t)pn * 256 * 1024; u.rows = nullptr; u.pm = pm; u.pn = pn; u.aux = part; u.nvalid = 256; return true;
    }
};
struct MoeSched {
    static constexpr bool HALFSKIP = true;
    const LAS int* tbl; const LAS int* cnts; int nent; const char* A; const char* W; const int* lists; int ncol  , wtile  , wexp  , atile  , G, c;
    __device__ __forceinline__ bool next(int i, pg8::Unit& u) const {
        const int un = i * (G >> 3) + (c >> 3); if (un >= nent * ncol) return false;
        const int pn = un % ncol; const int ent = __builtin_amdgcn_readfirstlane(tbl[un / ncol]), e = (ent >> 7) & 511, r = ent & 127, rt = ent >> 16;
        u.a = A + (size_t)rt * atile; u.b = W + (size_t)e * wexp + (size_t)pn * wtile; u.rows = lists + (size_t)e * 16384 + r * 256;
        u.pm = rt; u.pn = pn; u.aux = e; const int left = __builtin_amdgcn_readfirstlane(cnts[e]) - r * 256; u.nvalid = left < 256 ? left : 256; return true;
    }
};

struct EpiInproj {
    static constexpr bool PERM = true;
    bf16_t* PROJ; float* LOGF; const float* LB; const float* ROPE; unsigned char* G8; unsigned char* QK8;
    __device__ __forceinline__ bool keep(const pg8::Unit&) const { return false; }
    __device__ __forceinline__ void operator()(f32x4 (&acc)[2][2][4][2], const pg8::Unit& u, int wr, int wc, int fr, int fq) const {
        const int pn = u.pn;
        const int mode = pn < 2 ? 0 : pn < 4 ? 1 : pn < 6 ? 0 : pn < 8 ? 2 : pn < 20 ? 3 : pn < 26 ? 5 : 4;
        const int row0 = u.pm * 256 + wr * 64 + fr, colb = pn * 256 + wc * 32 + 8 * fq;
        const bool rot = (mode == 3) && ((wc & 1) == 0);
#pragma unroll
        for (int ai = 0; ai < 2; ++ai)
#pragma unroll
            for (int m = 0; m < 4; ++m) {
                const int row = row0 + ai * 128 + m * 16;
                f32x4 cs0, cs1, sn0, sn1;
                if (rot) { const f32x4* rp = (const f32x4*)(ROPE + (size_t)row * 16); cs0 = rp[0]; cs1 = rp[1]; sn0 = rp[2]; sn1 = rp[3]; }
#pragma unroll
                for (int bj = 0; bj < 2; ++bj) {
                    const int col = colb + bj * 128;
                    f32x4 v0 = acc[ai][bj][m][0], v1 = acc[ai][bj][m][1];
                    if (mode == 1) {
                        const int cf = col - 512; const f32x4 l0 = *(const f32x4*)(LB + cf), l1 = *(const f32x4*)(LB + cf + 4);
                        f32x4 lf0, lf1;
#pragma unroll
                        for (int j = 0; j < 4; ++j) { float sg = sigmoidf_(v0[j]); float f = l0[j] + (1.f - l0[j]) * sg; lf0[j] = fast_logf(f); v0[j] = (1.f - l0[j]) * (1.f - sg);
                            sg = sigmoidf_(v1[j]); f = l1[j] + (1.f - l1[j]) * sg; lf1[j] = fast_logf(f); v1[j] = (1.f - l1[j]) * (1.f - sg); }
                        acc[ai][bj][m][0] = lf0; acc[ai][bj][m][1] = lf1;
                    } else if (mode == 2) {
#pragma unroll
                        for (int j = 0; j < 4; ++j) { v0[j] = v0[j] * sigmoidf_(v0[j]); v1[j] = v1[j] * sigmoidf_(v1[j]); }
                    } else if (mode == 4) {
#pragma unroll
                        for (int j = 0; j < 4; ++j) { v0[j] = sigmoidf_(v0[j]); v1[j] = sigmoidf_(v1[j]); }
                    } else if (rot) {
                        f32x4 p0, p1;
#pragma unroll
                        for (int j = 0; j < 4; ++j) { p0[j] = __shfl_xor(v0[j], 16); p1[j] = __shfl_xor(v1[j], 16); }
                        if (fq == 0) { v0 = v0 * cs0 - p0 * sn0; v1 = v1 * cs1 - p1 * sn1; }
                        else if (fq == 1) { v0 = v0 * cs0 + p0 * sn0; v1 = v1 * cs1 + p1 * sn1; }
                    }
                    if (mode == 4) {
                        int g0 = 0, g1 = 0;
#pragma unroll
                        for (int j = 0; j < 4; ++j) { g0 = __builtin_amdgcn_cvt_pk_u8_f32(fmaxf(v0[j] * 255.0f, 1.0f), j, g0); g1 = __builtin_amdgcn_cvt_pk_u8_f32(fmaxf(v1[j] * 255.0f, 1.0f), j, g1); }
                        *(u32x2*)(G8 + (size_t)row * 2048 + (col - C_GA)) = (u32x2){(unsigned)g0, (unsigned)g1};
                        continue; }
                    if (mode == 3 || mode == 5) {
                        *(u32x2*)(QK8 + (size_t)row * 4608 + (col - C_AQ)) = (u32x2){pk4_fp8(v0[0], v0[1], v0[2], v0[3]), pk4_fp8(v1[0], v1[1], v1[2], v1[3])};
                        continue; }
                    u32x4 w; w.x = pg8::cvt_pk_bf16(v0[0], v0[1]); w.y = pg8::cvt_pk_bf16(v0[2], v0[3]); w.z = pg8::cvt_pk_bf16(v1[0], v1[1]); w.w = pg8::cvt_pk_bf16(v1[2], v1[3]);
                    *(u32x4*)(PROJ + (size_t)row * INW + col) = w;
                }
            }
        if (mode == 1) {
            const int lane = fq * 16 + fr;
#pragma unroll
            for (int ai = 0; ai < 2; ++ai)
#pragma unroll
                for (int bj = 0; bj < 2; ++bj)
#pragma unroll
                    for (int n = 0; n < 2; ++n)
#pragma unroll
                        for (int j = 0; j < 4; ++j) { float carry = 0.f;
#pragma unroll
                            for (int m = 0; m < 4; ++m) { float v = acc[ai][bj][m][n][j];
                                v += __builtin_bit_cast(float, __builtin_amdgcn_update_dpp(0, __builtin_bit_cast(int, v), 0x111, 0xF, 0xF, true));
                                v += __builtin_bit_cast(float, __builtin_amdgcn_update_dpp(0, __builtin_bit_cast(int, v), 0x112, 0xF, 0xF, true));
                                v += __builtin_bit_cast(float, __builtin_amdgcn_update_dpp(0, __builtin_bit_cast(int, v), 0x114, 0xF, 0xF, true));
                                v += __builtin_bit_cast(float, __builtin_amdgcn_update_dpp(0, __builtin_bit_cast(int, v), 0x118, 0xF, 0xF, true));
                                v += carry; acc[ai][bj][m][n][j] = v; carry = __shfl(v, (lane & 48) | 15); } }
#pragma unroll
            for (int ai = 0; ai < 2; ++ai)
#pragma unroll
                for (int m = 0; m < 4; ++m)
#pragma unroll
                    for (int bj = 0; bj < 2; ++bj) { float* lp = LOGF + (size_t)(row0 + ai * 128 + m * 16) * 512 + (colb + bj * 128 - 512); *(f32x4*)lp = acc[ai][bj][m][0]; *(f32x4*)(lp + 4) = acc[ai][bj][m][1]; }
        }
    }
};
__device__ __forceinline__ void gate8(u32x2 w, f32x4& lo, f32x4& hi) {
    constexpr float s = 1.0f / 255.0f;
    lo = (f32x4){(float)(w.x & 255u), (float)((w.x >> 8) & 255u), (float)((w.x >> 16) & 255u), (float)(w.x >> 24)} * s;
    hi = (f32x4){(float)(w.y & 255u), (float)((w.y >> 8) & 255u), (float)((w.y >> 16) & 255u), (float)(w.y >> 24)} * s;
}
struct EpiMixed {
    static constexpr bool PERM = true;
    const unsigned char* G8; bf16_t* MIXED;
    __device__ __forceinline__ bool keep(const pg8::Unit& u) const { return u.aux == 0; }
    __device__ __forceinline__ void operator()(f32x4 (&acc)[2][2][4][2], const pg8::Unit& u, int wr, int wc, int fr, int fq) const {
        const int row0 = u.pm * 256 + wr * 64 + fr, colb = u.pn * 256 + wc * 32 + 8 * fq;
#pragma unroll
        for (int ai = 0; ai < 2; ++ai)
#pragma unroll
            for (int m = 0; m < 4; ++m) {
                const int row = row0 + ai * 128 + m * 16;
#pragma unroll
                for (int bj = 0; bj < 2; ++bj) {
                    const int col = colb + bj * 128;
                    f32x4 b0, b1; gate8(*(const u32x2*)(G8 + (size_t)row * 2048 + 1024 + col), b0, b1);
                    if (u.aux == 0) {
                        f32x4 a0, a1; gate8(*(const u32x2*)(G8 + (size_t)row * 2048 + col), a0, a1);
#pragma unroll
                        for (int j = 0; j < 4; ++j) { acc[ai][bj][m][0][j] *= a0[j] * __builtin_amdgcn_rcpf(b0[j]); acc[ai][bj][m][1][j] *= a1[j] * __builtin_amdgcn_rcpf(b1[j]); }
                    } else {
                        const f32x4 v0 = acc[ai][bj][m][0] * b0, v1 = acc[ai][bj][m][1] * b1;
                        u32x4 w; w.x = pg8::cvt_pk_bf16(v0[0], v0[1]); w.y = pg8::cvt_pk_bf16(v0[2], v0[3]); w.z = pg8::cvt_pk_bf16(v1[0], v1[1]); w.w = pg8::cvt_pk_bf16(v1[2], v1[3]);
                        st_wt16(MIXED + (size_t)row * D + col, w);
                    }
                }
            }
    }
};
struct EpiOutproj {
    static constexpr bool PERM = true;
    const float* x; const float* MOD; bf16_t* X1;
    __device__ __forceinline__ bool keep(const pg8::Unit&) const { return false; }
    __device__ __forceinline__ void operator()(f32x4 (&acc)[2][2][4][2], const pg8::Unit& u, int wr, int wc, int fr, int fq) const {
        const int row0 = u.pm * 256 + wr * 64 + fr, colb = u.pn * 256 + wc * 32 + 8 * fq;
        const int b = (u.pm * 256) / SEQ;
#pragma unroll
        for (int bj = 0; bj < 2; ++bj) {
            const int col = colb + bj * 128;
            const f32x4 g0 = *(const f32x4*)(MOD + b * 6144 + 2048 + col), g1 = *(const f32x4*)(MOD + b * 6144 + 2048 + col + 4);
#pragma unroll
            for (int ai = 0; ai < 2; ++ai)
#pragma unroll
                for (int m = 0; m < 4; ++m) { const size_t off = (size_t)(row0 + ai * 128 + m * 16) * D + col;
                    const f32x4 v0 = *(const f32x4*)(x + off) + g0 * acc[ai][bj][m][0], v1 = *(const f32x4*)(x + off + 4) + g1 * acc[ai][bj][m][1];
                    u32x4 w; w.x = pg8::cvt_pk_bf16(v0[0], v0[1]); w.y = pg8::cvt_pk_bf16(v0[2], v0[3]); w.z = pg8::cvt_pk_bf16(v1[0], v1[1]); w.w = pg8::cvt_pk_bf16(v1[2], v1[3]);
                    st_wt16(X1 + off, w); }
        }
    }
};
struct EpiOutNorm {
    static constexpr bool PERM = true;
    const float* x; const float* MOD; const float* g2; bf16_t* X1; bf16_t* H; unsigned char* H8; float* XB; unsigned* cnt; LAS unsigned char* sl;
    __device__ __forceinline__ bool keep(const pg8::Unit&) const { return false; }
    __device__ __forceinline__ void operator()(f32x4 (&acc)[2][2][4][2], const pg8::Unit& u, int wr, int wc, int fr, int fq) const {
        const int tid = threadIdx.x;
        const int rl0 = wr * 64 + fr, row0 = u.pm * 256 + rl0, colb = u.pn * 256 + wc * 32 + 8 * fq;
        const int b = (u.pm * 256) / SEQ;
        LAS float* Pt = (LAS float*)sl; LAS float* Rs = (LAS float*)(sl + 4096);
#pragma unroll
        for (int bj = 0; bj < 2; ++bj) {
            const int col = colb + bj * 128;
            const f32x4 g0 = *(const f32x4*)(MOD + b * 6144 + 2048 + col), g1 = *(const f32x4*)(MOD + b * 6144 + 2048 + col + 4);
#pragma unroll
            for (int ai = 0; ai < 2; ++ai)
#pragma unroll
                for (int m = 0; m < 4; ++m) { const size_t off = (size_t)(row0 + ai * 128 + m * 16) * D + col;
                    acc[ai][bj][m][0] = *(const f32x4*)(x + off) + g0 * acc[ai][bj][m][0]; acc[ai][bj][m][1] = *(const f32x4*)(x + off + 4) + g1 * acc[ai][bj][m][1];
                    asm volatile("" : "+v"(acc[ai][bj][m][0]), "+v"(acc[ai][bj][m][1]));
                    if (m & 1) asm volatile("" ::: "memory"); }
        }
#pragma unroll
        for (int ai = 0; ai < 2; ++ai)
#pragma unroll
            for (int m = 0; m < 4; ++m) { float q = 0.f;
#pragma unroll
                for (int bj = 0; bj < 2; ++bj)
#pragma unroll
                    for (int n = 0; n < 2; ++n) { const f32x4 v = acc[ai][bj][m][n]; q += (v[0] * v[0] + v[1] * v[1]) + (v[2] * v[2] + v[3] * v[3]); }
                q += __shfl_xor(q, 16); q += __shfl_xor(q, 32);
                if (fq == 0) Pt[(ai * 128 + rl0 + m * 16) * 4 + wc] = q; }
        asm volatile("s_waitcnt lgkmcnt(0)" ::: "memory"); __builtin_amdgcn_s_barrier(); asm volatile("" ::: "memory");
        if (tid < 256) { const f32x4 p = *(const LAS f32x4*)(Pt + tid * 4); st_wt4(XB + ((size_t)u.pm * 256 + tid) * 4 + u.pn, __builtin_bit_cast(unsigned, (p[0] + p[1]) + (p[2] + p[3]))); }
        asm volatile("s_waitcnt vmcnt(0)" ::: "memory"); __builtin_amdgcn_s_barrier(); asm volatile("" ::: "memory");
        if (tid == 0) { unsigned* p = cnt + (size_t)u.pm * 64; (void)xb_add(p, 1u); unsigned sp = 0u;
            while (xb_ld(p) < 4u) { __builtin_amdgcn_s_sleep(2); if (++sp > (1u << 22)) break; }
            __builtin_amdgcn_fence(__ATOMIC_ACQUIRE, "agent"); asm volatile("s_waitcnt vmcnt(0)" ::: "memory"); }
        __builtin_amdgcn_s_barrier(); asm volatile("" ::: "memory");
        if (tid < 256) { const f32x4 q = *(const f32x4*)(XB + ((size_t)u.pm * 256 + tid) * 4); Rs[tid] = rsqrtf(((q[0] + q[1]) + (q[2] + q[3])) * (1.f / D) + EPS); }
        asm volatile("s_waitcnt vmcnt(0) lgkmcnt(0)" ::: "memory"); __builtin_amdgcn_s_barrier(); asm volatile("" ::: "memory");
#pragma unroll
        for (int bj = 0; bj < 2; ++bj) {
            const int col = colb + bj * 128;
            f32x4 gg[2], sc[2], sh[2];
#pragma unroll
            for (int q = 0; q < 2; ++q) { gg[q] = *(const f32x4*)(g2 + col + 4 * q); sh[q] = *(const f32x4*)(MOD + b * 6144 + 3072 + col + 4 * q); sc[q] = *(const f32x4*)(MOD + b * 6144 + 4096 + col + 4 * q) + 1.0f; gg[q] = gg[q] * sc[q]; }
#pragma unroll
            for (int ai = 0; ai < 2; ++ai)
#pragma unroll
                for (int m = 0; m < 4; ++m) { const int rl = ai * 128 + rl0 + m * 16; const size_t off = (size_t)(u.pm * 256 + rl) * D + col; const float rs = Rs[rl];
                    const f32x4 v0 = acc[ai][bj][m][0], v1 = acc[ai][bj][m][1];
                    u32x4 w; w.x = pg8::cvt_pk_bf16(v0[0], v0[1]); w.y = pg8::cvt_pk_bf16(v0[2], v0[3]); w.z = pg8::cvt_pk_bf16(v1[0], v1[1]); w.w = pg8::cvt_pk_bf16(v1[2], v1[3]);
                    *(u32x4*)(X1 + off) = w;
                    const f32x4 h0 = v0 * rs * gg[0] + sh[0], h1 = v1 * rs * gg[1] + sh[1];
                    u32x4 hw; hw.x = pg8::cvt_pk_bf16(h0[0], h0[1]); hw.y = pg8::cvt_pk_bf16(h0[2], h0[3]); hw.z = pg8::cvt_pk_bf16(h1[0], h1[1]); hw.w = pg8::cvt_pk_bf16(h1[2], h1[3]);
                    st_wt16(H + off, hw);
                    st_wt8(H8 + off, (unsigned long long)pk4_fp8(h0[0], h0[1], h0[2], h0[3]) | ((unsigned long long)pk4_fp8(h1[0], h1[1], h1[2], h1[3]) << 32));
                    asm volatile("" ::: "memory"); }
        }
    }
};
struct EpiRouter {
    static constexpr bool PERM = false;
    float* LOGITS4;
    __device__ __forceinline__ bool keep(const pg8::Unit&) const { return false; }
    __device__ __forceinline__ void operator()(f32x4 (&acc)[2][2][4][2], const pg8::Unit& u, int wr, int wc, int fr, int fq) const {
        const int row0 = u.pm * 256 + wr * 64 + fr, colb = wc * 32 + 4 * fq;
        float* base = LOGITS4 + (size_t)u.aux * T * 256;
#pragma unroll
        for (int ai = 0; ai < 2; ++ai)
#pragma unroll
            for (int m = 0; m < 4; ++m)
#pragma unroll
                for (int bj = 0; bj < 2; ++bj)
#pragma unroll
                    for (int n = 0; n < 2; ++n) st_wt16(base + (size_t)(row0 + ai * 128 + m * 16) * 256 + colb + bj * 128 + n * 16, __builtin_bit_cast(u32x4, acc[ai][bj][m][n]));
    }
};
struct RouterSched {
    static constexpr bool HALFSKIP = false;
    const char* A; const char* Bt; int G, c;
    __device__ __forceinline__ bool next(int i, pg8::Unit& u) const {
        const int L = i * G + c; if (L >= 256) return false;
        const int pm = L >> 2, ks = L & 3;
        u.a = A + (size_t)pm * 256 * 2048 + ks * 512; u.b = Bt + ks * 512; u.rows = nullptr; u.pm = pm; u.pn = 0; u.aux = ks; u.nvalid = 256; return true;
    }
};
struct EpiGU {
    static constexpr bool PERM = true;
    unsigned char* ACT;
    __device__ __forceinline__ bool keep(const pg8::Unit&) const { return false; }
    __device__ __forceinline__ void operator()(f32x4 (&acc)[2][2][4][2], const pg8::Unit& u, int wr, int wc, int fr, int fq) const {
        const int rl0 = wr * 64 + fr, col = u.pn * 128 + wc * 32 + 8 * fq;
        constexpr float is = 1.0f / WGU_SCALE;
#pragma unroll
        for (int ai = 0; ai < 2; ++ai)
#pragma unroll
            for (int m = 0; m < 4; ++m) {
                const int rl = rl0 + ai * 128 + m * 16;
                f32x4 v0, v1;
#pragma unroll
                for (int j = 0; j < 4; ++j) { const float a0 = acc[ai][0][m][0][j] * is, a1 = acc[ai][0][m][1][j] * is;
                    v0[j] = a0 * sigmoidf_(a0) * (acc[ai][1][m][0][j] * is); v1[j] = a1 * sigmoidf_(a1) * (acc[ai][1][m][1][j] * is); }
                *(u32x2*)(ACT + ((size_t)u.pm * 256 + rl) * EFF + col) = (u32x2){pk4_fp8(v0[0], v0[1], v0[2], v0[3]), pk4_fp8(v1[0], v1[1], v1[2], v1[3])};
                asm volatile("" ::: "memory");
            }
    }
};
struct EpiDown {
    static constexpr bool PERM = true;
    static constexpr bool BJADJ = true;
    unsigned char* YBUF; const float* GATEW;
    __device__ __forceinline__ bool keep(const pg8::Unit&) const { return false; }
    __device__ __forceinline__ void operator()(f32x4 (&acc)[2][2][4][2], const pg8::Unit& u, int wr, int wc, int fr, int fq) const {
        const int rl0 = wr * 64 + fr, colw = u.pn * 256 + wc * 64 + (fq & 1) * 32 + (fq >> 1) * 16;
        const bool odd = fq & 1;
#pragma unroll
        for (int ai = 0; ai < 2; ++ai)
#pragma unroll
            for (int m = 0; m < 4; ++m) {
                const int rl = rl0 + ai * 128 + m * 16;
                const bool ok = rl < u.nvalid;
                int slot = 0; float gw = 0.f;
                if (ok) { slot = u.rows[rl]; gw = GATEW[slot] * (YSCALE / WD_SCALE); }
                u32x2 p[2];
#pragma unroll
                for (int bj = 0; bj < 2; ++bj) { const f32x4 v0 = acc[ai][bj][m][0] * gw, v1 = acc[ai][bj][m][1] * gw;
                    p[bj] = (u32x2){pk4_fp8(v0[0], v0[1], v0[2], v0[3]), pk4_fp8(v1[0], v1[1], v1[2], v1[3])}; }
                const u32x2 snd = odd ? p[0] : p[1];
                u32x2 rcv; rcv.x = (unsigned)__shfl_xor((int)snd.x, 16); rcv.y = (unsigned)__shfl_xor((int)snd.y, 16);
                const u32x4 w = odd ? (u32x4){rcv.x, rcv.y, p[1].x, p[1].y} : (u32x4){p[0].x, p[0].y, rcv.x, rcv.y};
                if (ok) *(u32x4*)(YBUF + (size_t)slot * D + colw) = w;
                asm volatile("" ::: "memory");
            }
    }
};

#define MFMA16(a, b, c) __builtin_amdgcn_mfma_f32_16x16x32_bf16((a), (b), (c), 0, 0, 0)
#define MFMA32(a, b, c) __builtin_amdgcn_mfma_f32_32x32x16_bf16((a), (b), (c), 0, 0, 0)
__device__ __forceinline__ s16x4 tr16(const LAS unsigned char* p) { return __builtin_amdgcn_ds_read_tr16_b64_v4i16((LAS s16x4*)p); }
__device__ __forceinline__ bf16x8 cat8(s16x4 a, s16x4 b) { bf16x8 r; r[0] = a[0]; r[1] = a[1]; r[2] = a[2]; r[3] = a[3]; r[4] = b[0]; r[5] = b[1]; r[6] = b[2]; r[7] = b[3]; return r; }
__device__ __forceinline__ u32x4 pack8(const float (&v)[8]) { u32x4 w; w.x = pg8::cvt_pk_bf16(v[0], v[1]); w.y = pg8::cvt_pk_bf16(v[2], v[3]); w.z = pg8::cvt_pk_bf16(v[4], v[5]); w.w = pg8::cvt_pk_bf16(v[6], v[7]); return w; }
__device__ __forceinline__ void unpack8(u32x4 w, float (&v)[8]) { v[0] = bflo(w.x); v[1] = bfhi(w.x); v[2] = bflo(w.y); v[3] = bfhi(w.y); v[4] = bflo(w.z); v[5] = bfhi(w.z); v[6] = bflo(w.w); v[7] = bfhi(w.w); }
__device__ __forceinline__ int swzA(int row) { return (row & 3) | (((row >> 3) & 1) << 2); }
__device__ __forceinline__ void hgrn_kv_unit(Ctx& X, int bn) {
    const int t0 = bn * 64;
    const bf16_t* PROJ = WSP(bf16_t, WS_PROJ); const float* BC = WSP(float, WS_LOGF);
#pragma unroll 2
    for (int j = 0; j < 8; ++j) {
        const int p = X.tid + NTHREADS * j, row = p >> 6, c64 = p & 63, h = c64 >> 4, ch = c64 & 15;
        const size_t prow = (size_t)(t0 + row) * INW + h * 128 + 8 * ch;
        const u32x4 kraw = *(const u32x4*)(PROJ + prow + C_HK), vraw = *(const u32x4*)(PROJ + prow + C_HV);
        const float* bp = BC + (size_t)(t0 + row) * 512 + h * 128 + 8 * ch; const float* bl = BC + (size_t)(t0 + 63) * 512 + h * 128 + 8 * ch;
        const f32x4 b0 = *(const f32x4*)bp, b1 = *(const f32x4*)(bp + 4), l0 = *(const f32x4*)bl, l1 = *(const f32x4*)(bl + 4);
        float kv[8]; unpack8(kraw, kv);
#pragma unroll
        for (int e = 0; e < 4; ++e) { kv[e] *= __expf(l0[e] - b0[e]); kv[4 + e] *= __expf(l1[e] - b1[e]); }
        const int off = row * 256 + (((ch >> 1) ^ swzA(row)) * 32) + (ch & 1) * 16;
        *(LAS u32x4*)(X.lds + h * 32768 + off) = vraw; *(LAS u32x4*)(X.lds + h * 32768 + 16384 + off) = pack8(kv);
    }
    WSP(float, WS_DECAY)[bn * 512 + X.tid] = __expf(BC[(size_t)(t0 + 63) * 512 + X.tid]);
    __syncthreads();
    const int l = X.lane, w = X.wave, fr = l & 15, fq = l >> 4, r = fr >> 2, p4 = l & 3, h = w >> 1, vt0 = 4 * (w & 1);
    const LAS unsigned char* VI = X.lds + h * 32768; const LAS unsigned char* KI = VI + 16384;
    bf16x8 af[4][2];
#pragma unroll
    for (int vt = 0; vt < 4; ++vt)
#pragma unroll
        for (int kk = 0; kk < 2; ++kk) { const int r0 = 32 * kk + 8 * fq + r, r1 = r0 + 4;
            af[vt][kk] = cat8(tr16(VI + r0 * 256 + (((vt0 + vt) ^ swzA(r0)) * 32) + p4 * 8), tr16(VI + r1 * 256 + (((vt0 + vt) ^ swzA(r1)) * 32) + p4 * 8)); }
    bf16_t* KVT = WSP(bf16_t, WS_KVT) + (size_t)(bn * 4 + h) * 16384;
#pragma unroll 2
    for (int ct = 0; ct < 8; ++ct) {
        bf16x8 bfr[2];
#pragma unroll
        for (int kk = 0; kk < 2; ++kk) { const int r0 = 32 * kk + 8 * fq + r, r1 = r0 + 4;
            bfr[kk] = cat8(tr16(KI + r0 * 256 + ((ct ^ swzA(r0)) * 32) + p4 * 8), tr16(KI + r1 * 256 + ((ct ^ swzA(r1)) * 32) + p4 * 8)); }
#pragma unroll
        for (int vt = 0; vt < 4; ++vt) { f32x4 acc = {0.f, 0.f, 0.f, 0.f}; acc = MFMA16(bfr[0], af[vt][0], acc); acc = MFMA16(bfr[1], af[vt][1], acc);
            u32x2 wv; wv.x = pg8::cvt_pk_bf16(acc[0], acc[1]); wv.y = pg8::cvt_pk_bf16(acc[2], acc[3]);
            *(u32x2*)(KVT + (16 * (vt0 + vt) + fr) * 128 + 16 * ct + 4 * fq) = wv; }
    }
    __syncthreads();
}
__device__ __forceinline__ void hgrn_passB(Ctx& X) {
    const unsigned* KVT = WSP(unsigned, WS_KVT); const float* DECAY = WSP(float, WS_DECAY); unsigned* SPT = WSP(unsigned, WS_SPT);
    const int gt = X.wg * NTHREADS + X.tid, NGT = X.G * NTHREADS;
    for (int item = gt; item < 16 * 128 * 64; item += NGT) {
        const int bh = item >> 13, rem = item & 8191, vd = rem >> 6, c = (rem & 63) * 2, b = bh >> 2, h = bh & 3;
        float s0 = 0.f, s1 = 0.f;
#pragma unroll 8
        for (int n = 0; n < 64; ++n) {
            const int unit = (b * 64 + n) * 4 + h;
            const unsigned kw = KVT[((size_t)unit * 16384 + vd * 128 + c) >> 1]; const f32x2 kv = {bflo(kw), bfhi(kw)};
            const f32x2 dc = *(const f32x2*)(DECAY + unit * 128 + c);
            SPT[((size_t)unit * 16384 + vd * 128 + c) >> 1] = pk2(s0, s1);
            s0 = dc.x * s0 + kv.x; s1 = dc.y * s1 + kv.y;
        }
    }
}
__device__ __forceinline__ void hgrn_out_unit(Ctx& X, int u2) {
    const int bn = u2 >> 1, hp = u2 & 1, t0 = bn * 64;
    const bf16_t* PROJ = WSP(bf16_t, WS_PROJ); const float* BCg = WSP(float, WS_LOGF);
#pragma unroll 2
    for (int j = 0; j < 4; ++j) { const int p = X.tid + NTHREADS * j, row = p >> 5, c32 = p & 31, hh = c32 >> 4, ch = c32 & 15, h = 2 * hp + hh;
        const size_t prow = (size_t)(t0 + row) * INW + h * 128 + 8 * ch;
        const u32x4 qraw = *(const u32x4*)(PROJ + prow + C_HQ), kraw = *(const u32x4*)(PROJ + prow + C_HK), vraw = *(const u32x4*)(PROJ + prow + C_HV);
        const float* bp = BCg + (size_t)(t0 + row) * 512 + h * 128 + 8 * ch; const float* br = BCg + (size_t)(t0 + 32) * 512 + h * 128 + 8 * ch;
        const f32x4 b0 = *(const f32x4*)bp, b1 = *(const f32x4*)(bp + 4), r0 = *(const f32x4*)br, r1 = *(const f32x4*)(br + 4);
        float qv[8], kv[8], a[8], bq[8]; unpack8(qraw, qv); unpack8(kraw, kv);
#pragma unroll
        for (int e = 0; e < 4; ++e) { const float e0 = __expf(b0[e] - r0[e]), e1 = __expf(b1[e] - r1[e]);
            a[e] = qv[e] * e0; a[4 + e] = qv[4 + e] * e1; kv[e] *= __builtin_amdgcn_rcpf(e0); kv[4 + e] *= __builtin_amdgcn_rcpf(e1);
            bq[e] = qv[e] * __expf(b0[e]); bq[4 + e] = qv[4 + e] * __expf(b1[e]); }
        LAS unsigned char* hb = X.lds + hh * 65536; const int o16 = row * 256 + ((ch ^ (row & 15)) * 16);
        *(LAS u32x4*)(hb + o16) = pack8(a); *(LAS u32x4*)(hb + 16384 + o16) = pack8(kv); *(LAS u32x4*)(hb + 32768 + o16) = pack8(bq);
        *(LAS u32x4*)(hb + 49152 + row * 256 + (((ch >> 1) ^ (row & 7)) * 32) + (ch & 1) * 16) = vraw; }
    const int l = X.lane, w = X.wave, fr = l & 15, fq = l >> 4, r = fr >> 2, p4 = l & 3, hh = w >> 2, h = 2 * hp + hh, ti = w & 3;
    const int tq = 16 * ti + fr;
    const bf16_t* SPT = WSP(bf16_t, WS_SPT) + (size_t)(bn * 4 + h) * 16384;
    __syncthreads();
    const LAS unsigned char* QSI = X.lds + hh * 65536; const LAS unsigned char* KSI = QSI + 16384; const LAS unsigned char* QNI = QSI + 32768; const LAS unsigned char* VI = QSI + 49152;
    bf16x8 QS[4];
#pragma unroll
    for (int ks = 0; ks < 4; ++ks) QS[ks] = *(const LAS bf16x8*)(QSI + tq * 256 + (((4 * ks + fq) ^ (tq & 15)) * 16));
    f32x4 ST[4];
#pragma unroll
    for (int si = 0; si < 4; ++si) {
        f32x4 acc = {0.f, 0.f, 0.f, 0.f};
        if (si <= ti) {
            const int sr = 16 * si + fr;
#pragma unroll
            for (int ks = 0; ks < 4; ++ks) { const bf16x8 kf = *(const LAS bf16x8*)(KSI + sr * 256 + (((4 * ks + fq) ^ (sr & 15)) * 16)); acc = MFMA16(kf, QS[ks], acc); }
            if (si == ti) {
#pragma unroll
                for (int q = 0; q < 4; ++q) acc[q] = (4 * fq + q <= fr) ? acc[q] : 0.f; }
        }
        ST[si] = acc;
    }
    f32x4 o[8];
#pragma unroll
    for (int vt = 0; vt < 8; ++vt) o[vt] = (f32x4){0.f, 0.f, 0.f, 0.f};
#pragma unroll
    for (int kk = 0; kk < 2; ++kk) {
        if (2 * kk <= ti) {
            float pv[8];
#pragma unroll
            for (int q = 0; q < 4; ++q) { pv[q] = ST[2 * kk][q]; pv[4 + q] = ST[2 * kk + 1][q]; }
            const bf16x8 pf = __builtin_bit_cast(bf16x8, pack8(pv));
            const int r0 = 32 * kk + 4 * fq + r, r1 = r0 + 16;
#pragma unroll
            for (int vt = 0; vt < 8; ++vt) { const bf16x8 va = cat8(tr16(VI + r0 * 256 + ((vt ^ (r0 & 7)) * 32) + p4 * 8), tr16(VI + r1 * 256 + ((vt ^ (r1 & 7)) * 32) + p4 * 8));
                o[vt] = MFMA16(va, pf, o[vt]); }
        }
    }
#pragma unroll
    for (int ks = 0; ks < 4; ++ks) { const bf16x8 qn = *(const LAS bf16x8*)(QNI + tq * 256 + (((4 * ks + fq) ^ (tq & 15)) * 16));
#pragma unroll
        for (int vt = 0; vt < 8; ++vt) { const bf16x8 sa = *(const bf16x8*)(SPT + (16 * vt + fr) * 128 + 32 * ks + 8 * fq); o[vt] = MFMA16(sa, qn, o[vt]); } }
    float ss = 0.f;
#pragma unroll
    for (int vt = 0; vt < 8; ++vt) ss += (o[vt][0] * o[vt][0] + o[vt][1] * o[vt][1]) + (o[vt][2] * o[vt][2] + o[vt][3] * o[vt][3]);
    ss += __shfl_xor(ss, 16); ss += __shfl_xor(ss, 32);
    const float rstd = rsqrtf(ss * (1.f / 128.f) + EPS);
    bf16_t* YCAT = WSP(bf16_t, WS_YCAT);
#pragma unroll
    for (int vt = 0; vt < 8; ++vt) { const int vd = 16 * vt + 4 * fq;
        const u32x2 sg = *(const u32x2*)(PROJ + (size_t)(t0 + tq) * INW + C_HG + h * 128 + vd); const f32x4 gn = *(const f32x4*)(X.g_hgrn + h * 128 + vd);
        u32x2 wv; wv.x = pg8::cvt_pk_bf16(o[vt][0] * rstd * gn[0] * bflo(sg.x), o[vt][1] * rstd * gn[1] * bfhi(sg.x)); wv.y = pg8::cvt_pk_bf16(o[vt][2] * rstd * gn[2] * bflo(sg.y), o[vt][3] * rstd * gn[3] * bfhi(sg.y));
        *(u32x2*)(YCAT + (size_t)(t0 + tq) * D + h * 128 + vd) = wv; }
    __syncthreads();
}

template <bool HI> __device__ __forceinline__ unsigned fp8x2_bf16_(unsigned w) { const auto f = __builtin_amdgcn_cvt_pk_f32_fp8((int)w, HI); return pg8::cvt_pk_bf16(f[0], f[1]); }
__device__ __forceinline__ unsigned fp8x2_bf16(unsigned w, bool hi) { return hi ? fp8x2_bf16_<true>(w) : fp8x2_bf16_<false>(w); }
struct AttnRegs { u32x4 k[3], v[3]; long q[4]; };
__device__ __forceinline__ void attn_load(Ctx& X, int unit, AttnRegs& R) {
    const int u16 = unit & 15, h = (unit >> 4) & 7, g = (unit >> 7) % 3, b = unit / 384;
    const int d = g == 0 ? 1 : g == 1 ? 4 : 16, nblk = 16 / d, r = u16 / nblk, blk = u16 % nblk;
    const int vcol = C_AV + g * 512 + h * 64;
    const int mk0 = blk * 256 - 128;
    const unsigned char* QK8 = WSP(unsigned char, WS_QK8);
    const int q8col = g * 512 + h * 64, k8col = 1536 + q8col, v8col = 3072 + q8col;
#pragma unroll
    for (int j = 0; j < 3; ++j) { const int idx = X.tid + NTHREADS * j, row = idx >> 2, ch = idx & 3, m = mk0 + row > 0 ? mk0 + row : 0;
        const size_t tok = (size_t)b * SEQ + (size_t)m * d + r; R.k[j] = *(const u32x4*)(QK8 + tok * 4608 + k8col + ch * 16); R.v[j] = *(const u32x4*)(QK8 + tok * 4608 + v8col + ch * 16); }
    const int l = X.lane, w = X.wave, q = l & 31, hi = l >> 5;
    const size_t tokq = (size_t)b * SEQ + (size_t)(blk * 256 + 32 * w + q) * d + r;
#pragma unroll
    for (int ds = 0; ds < 4; ++ds) R.q[ds] = *(const long*)(QK8 + tokq * 4608 + q8col + ds * 16 + hi * 8);
}
__device__ __forceinline__ void attn_stage(Ctx& X, const AttnRegs& R) {
    LAS unsigned char* KL = X.lds; LAS unsigned char* VL = X.lds + 55296;
#pragma unroll
    for (int j = 0; j < 3; ++j) { const int idx = X.tid + NTHREADS * j, row = idx >> 2, ch = idx & 3;
        *(LAS u32x4*)(KL + row * 80 + ch * 16) = R.k[j];
        u32x4 lo, hi2;
        lo.x = fp8x2_bf16(R.v[j].x, false); lo.y = fp8x2_bf16(R.v[j].x, true); lo.z = fp8x2_bf16(R.v[j].y, false); lo.w = fp8x2_bf16(R.v[j].y, true);
        hi2.x = fp8x2_bf16(R.v[j].z, false); hi2.y = fp8x2_bf16(R.v[j].z, true); hi2.z = fp8x2_bf16(R.v[j].w, false); hi2.w = fp8x2_bf16(R.v[j].w, true);
        *(LAS u32x4*)(VL + row * 128 + ch * 32) = lo; *(LAS u32x4*)(VL + row * 128 + ch * 32 + 16) = hi2; }
    LAS long* QL = (LAS long*)(X.lds + 104448 + X.tid * 32);
    QL[0] = R.q[0]; QL[1] = R.q[1]; QL[2] = R.q[2]; QL[3] = R.q[3];
}
__device__ __forceinline__ void attn_compute(Ctx& X, int unit) {
    const int u16 = unit & 15, h = (unit >> 4) & 7, g = (unit >> 7) % 3, b = unit / 384;
    const int d = g == 0 ? 1 : g == 1 ? 4 : 16, nblk = 16 / d, r = u16 / nblk, blk = u16 % nblk;
    const int mk0 = blk * 256 - 128;
    LAS unsigned char* KL = X.lds; LAS unsigned char* VL = X.lds + 55296;
    const int l = X.lane, w = X.wave, q = l & 31, hi = l >> 5;
    const size_t tokq = (size_t)b * SEQ + (size_t)(blk * 256 + 32 * w + q) * d + r;
    long qf[4];
    { const LAS long* QL = (const LAS long*)(X.lds + 104448 + X.tid * 32); qf[0] = QL[0]; qf[1] = QL[1]; qf[2] = QL[2]; qf[3] = QL[3]; }
    f32x16 s[5];
#pragma unroll
    for (int kt = 0; kt < 5; ++kt) {
        f32x16 acc;
#pragma unroll
        for (int i = 0; i < 16; ++i) acc[i] = 0.f;
#pragma unroll
        for (int ds = 0; ds < 4; ++ds) { const long kf = *(const LAS long*)(KL + (32 * w + 32 * kt + q) * 80 + ds * 16 + hi * 8); acc = __builtin_amdgcn_mfma_f32_32x32x16_fp8_fp8(kf, qf[ds], acc, 0, 0, 0); }
        s[kt] = acc;
    }
    const int iq = 32 * w + q;
    const int jmin = iq > -mk0 ? iq : -mk0;
    const int tlo = jmin - (32 * w + 4 * hi), thi = iq + 128 - (32 * w + 128 + 4 * hi), tst = -mk0 - (32 * w + 4 * hi);
    float mx = -INFINITY;
#pragma unroll
    for (int kt = 0; kt < 5; ++kt) {
        const bool chk = kt == 0 || kt == 4 || (32 * w + 32 * kt < -mk0);
        if (chk) {
#pragma unroll
            for (int rg = 0; rg < 16; ++rg) { const int c = (rg & 3) + 8 * (rg >> 2);
                const bool valid = kt == 0 ? (c >= tlo) : kt == 4 ? (c <= thi) : (c + 32 * kt >= tst);
                s[kt][rg] = valid ? s[kt][rg] : -INFINITY; if ((rg & 3) == 3) __builtin_amdgcn_sched_barrier(0); }
        }
#pragma unroll
        for (int rg = 0; rg < 16; ++rg) mx = fmaxf(mx, s[kt][rg]);
    }
    mx = fmaxf(mx, __shfl_xor(mx, 32));
    const float c2 = 0.125f * 1.4426950408889634f, mxs = mx * c2;
    float lsum = 0.f;
#pragma unroll
    for (int kt = 0; kt < 5; ++kt)
#pragma unroll
        for (int rg = 0; rg < 16; ++rg) { const float p = __builtin_amdgcn_exp2f(__builtin_fmaf(s[kt][rg], c2, -mxs)); s[kt][rg] = p; lsum += p; }
    lsum += __shfl_xor(lsum, 32);
    f32x16 o[2];
#pragma unroll
    for (int dt = 0; dt < 2; ++dt)
#pragma unroll
        for (int i = 0; i < 16; ++i) o[dt][i] = 0.f;
    const int vlane = ((l & 15) >> 2) * 128 + (((l >> 4) & 1) * 16 + (l & 3) * 4) * 2;
#pragma unroll
    for (int kt = 0; kt < 5; ++kt)
#pragma unroll
        for (int s2 = 0; s2 < 2; ++s2) {
            bf16x8 pb;
#pragma unroll
            for (int j = 0; j < 8; j += 2) { const unsigned pw = pg8::cvt_pk_bf16(s[kt][8 * s2 + j], s[kt][8 * s2 + j + 1]); pb[j] = (short)(pw & 0xffffu); pb[j + 1] = (short)(pw >> 16); }
            const int key0 = 32 * w + 32 * kt + 16 * s2 + 4 * hi;
#pragma unroll
            for (int dt = 0; dt < 2; ++dt) {
                LAS unsigned char* vp = VL + key0 * 128 + dt * 64 + vlane;
                const s16x4 t0 = __builtin_amdgcn_ds_read_tr16_b64_v4i16((LAS s16x4*)vp);
                const s16x4 t1 = __builtin_amdgcn_ds_read_tr16_b64_v4i16((LAS s16x4*)(vp + 8 * 128));
                bf16x8 va; va[0] = t0[0]; va[1] = t0[1]; va[2] = t0[2]; va[3] = t0[3]; va[4] = t1[0]; va[5] = t1[1]; va[6] = t1[2]; va[7] = t1[3];
                o[dt] = MFMA32(va, pb, o[dt]);
            }
        }
    const float inv = 1.0f / lsum;
    bf16_t* OG = WSP(bf16_t, WS_OG) + (size_t)g * T * 512;
#pragma unroll
    for (int dt = 0; dt < 2; ++dt)
#pragma unroll
        for (int rg = 0; rg < 4; ++rg) { const int d0 = 32 * dt + 8 * rg + 4 * hi;
            u32x2 wv; wv.x = pg8::cvt_pk_bf16(o[dt][4 * rg] * inv, o[dt][4 * rg + 1] * inv); wv.y = pg8::cvt_pk_bf16(o[dt][4 * rg + 2] * inv, o[dt][4 * rg + 3] * inv);
            *(u32x2*)(OG + tokq * 512 + h * 64 + d0) = wv; }
    WSP(float, WS_LSE)[((size_t)g * T + tokq) * 8 + h] = mx * 0.125f + __logf(lsum);
}
__device__ __forceinline__ void attn_combine(Ctx& X) {
    const bf16_t* OG = WSP(bf16_t, WS_OG); const float* LSE = WSP(float, WS_LSE); bf16_t* YCAT = WSP(bf16_t, WS_YCAT);
    const int gt = X.wg * NTHREADS + X.tid, NGT = X.G * NTHREADS;
    for (int item = gt; item < T * 64; item += NGT) {
        const int t = item >> 6, ch = item & 63, h = ch >> 3;
        const float l0 = LSE[(size_t)t * 8 + h], l1 = LSE[((size_t)T + t) * 8 + h], l2 = LSE[((size_t)2 * T + t) * 8 + h];
        const float m = fmaxf(l0, fmaxf(l1, l2)); float w0 = __expf(l0 - m), w1 = __expf(l1 - m), w2 = __expf(l2 - m); const float inv = 1.f / (w0 + w1 + w2); w0 *= inv; w1 *= inv; w2 *= inv;
        const u32x4 a = *(const u32x4*)(OG + (size_t)t * 512 + ch * 8), bq = *(const u32x4*)(OG + ((size_t)T + t) * 512 + ch * 8), cq = *(const u32x4*)(OG + ((size_t)2 * T + t) * 512 + ch * 8);
        u32x4 o;
#pragma unroll
        for (int j = 0; j < 4; ++j) o[j] = pk2(w0 * bflo(a[j]) + w1 * bflo(bq[j]) + w2 * bflo(cq[j]), w0 * bfhi(a[j]) + w1 * bfhi(bq[j]) + w2 * bfhi(cq[j]));
        *(u32x4*)(YCAT + (size_t)t * D + 512 + ch * 8) = o;
    }
}

__device__ __forceinline__ unsigned sortable_key(float f) { const unsigned u = __builtin_bit_cast(unsigned, f); return (u & 0x80000000u) ? ~u : (u | 0x80000000u); }
__device__ __forceinline__ void moe_route(Ctx& X, bool local) {
    const float* LG = WSP(float, WS_KVT); unsigned* CNT = WSP(unsigned, WS_CTL) + CW_CNT; int* LISTS = WSP(int, WS_LISTS); float* GATEW = WSP(float, WS_GATEW);
    const int gw = X.wg * NWAVES + X.wave, NGW = X.G * NWAVES, l = X.lane, grp = l >> 3;
    const f32x4 bias = *(const f32x4*)(X.rbias + 4 * l);
    const unsigned long long ltmask = (1ull << l) - 1ull;
    const int tbeg = local ? X.wg * 64 + X.wave : gw, tend = local ? X.wg * 64 + 64 : T, tstep = local ? NWAVES : NGW;
    for (int t = tbeg; t < tend; t += tstep) {
        f32x4 lg = *(const f32x4*)(LG + (size_t)t * 256 + 4 * l);
#pragma unroll
        for (int ks = 1; ks < 4; ++ks) lg += *(const f32x4*)(LG + ((size_t)ks * T + t) * 256 + 4 * l);
        float sc[4], mb[4];
#pragma unroll
        for (int i = 0; i < 4; ++i) { sc[i] = sigmoidf_(lg[i]); mb[i] = sc[i] + bias[i]; }
        float m1 = fmaxf(mb[0], mb[1]), m2 = fminf(mb[0], mb[1]);
        { const float a1 = fmaxf(mb[2], mb[3]), a2 = fminf(mb[2], mb[3]); const float n1 = fmaxf(m1, a1), n2 = fmaxf(fminf(m1, a1), fmaxf(m2, a2)); m1 = n1; m2 = n2; }
#pragma unroll
        for (int o = 1; o < 8; o <<= 1) { const float a1 = __shfl_xor(m1, o), a2 = __shfl_xor(m2, o); const float n1 = fmaxf(m1, a1), n2 = fmaxf(fminf(m1, a1), fmaxf(m2, a2)); m1 = n1; m2 = n2; }
        const float gs = m1 + m2;
        int rank = 0;
#pragma unroll
        for (int gg = 0; gg < 8; ++gg) { const float og = __builtin_bit_cast(float, __builtin_amdgcn_readlane(__builtin_bit_cast(int, gs), gg * 8)); rank += (og > gs || (og == gs && gg < grp)) ? 1 : 0; }
        const bool sel = rank < 4;
        unsigned key[4];
#pragma unroll
        for (int i = 0; i < 4; ++i) key[i] = sel ? sortable_key(mb[i]) : 0u;
        unsigned pre = 0u;
#pragma unroll 1
        for (int bit = 31; bit >= 0; --bit) { const unsigned cand = pre | (1u << bit);
            const int cnt = __popcll(__ballot(key[0] >= cand)) + __popcll(__ballot(key[1] >= cand)) + __popcll(__ballot(key[2] >= cand)) + __popcll(__ballot(key[3] >= cand));
            if (cnt >= TOPK) pre = cand; }
        int ngt = 0, eqb = 0, tkb = 0; bool take[4];
#pragma unroll
        for (int i = 0; i < 4; ++i) ngt += __popcll(__ballot(key[i] > pre));
        const int need = TOPK - ngt;
#pragma unroll
        for (int i = 0; i < 4; ++i) eqb += __popcll(__ballot(key[i] == pre) & ltmask);
        int eqrun = eqb;
#pragma unroll
        for (int i = 0; i < 4; ++i) { const bool eq = key[i] == pre; take[i] = (key[i] > pre) || (eq && eqrun < need); eqrun += eq ? 1 : 0; }
#pragma unroll
        for (int i = 0; i < 4; ++i) tkb += __popcll(__ballot(take[i]) & ltmask);
        float part = 0.f;
#pragma unroll
        for (int i = 0; i < 4; ++i) part += take[i] ? sc[i] : 0.f;
        const float scale = 2.5f / wave_sum(part);
        int slot = tkb;
#pragma unroll
        for (int i = 0; i < 4; ++i) if (take[i]) { const int e = 4 * l + i; const unsigned pos = atomicAdd(&CNT[e * 64], 1u); LISTS[(size_t)e * 16384 + pos] = t * NSLOT + slot; GATEW[t * NSLOT + slot] = sc[i] * scale; ++slot; }
        if (l == 0) { LISTS[(size_t)NE * 16384 + t] = t * NSLOT + TOPK; GATEW[t * NSLOT + TOPK] = 1.0f; }
    }
}
__device__ __forceinline__ int moe_table(Ctx& X) {
    LAS int* tbl = (LAS int*)(X.lds + TBL_OFF); LAS int* cnts = (LAS int*)(X.lds + TCNT_OFF); LAS int* pref = cnts + 320;
    const unsigned* CNT = WSP(unsigned, WS_CTL) + CW_CNT;
    const int x = X.wg & 7;
    if (X.tid < NEX) cnts[X.tid] = X.tid < NE ? (int)__hip_atomic_load(CNT + X.tid * 64, __ATOMIC_RELAXED, __HIP_MEMORY_SCOPE_AGENT) : T;
    __syncthreads();
    if (X.tid < NEX) { int pre = 0; for (int e = 0; e < X.tid; ++e) pre += (cnts[e] + 255) >> 8; pref[X.tid] = pre; }
    __syncthreads();
    if (X.tid < 33) {
        const int i = X.tid; int lp = 0; for (int k = 0; k < i && k < 32; ++k) lp += (cnts[x + 8 * k] + 255) >> 8;
        if (i < 32) { const int e = x + 8 * i, n = (cnts[e] + 255) >> 8, p0 = pref[e]; for (int r = 0; r < n; ++r) tbl[lp + r] = ((p0 + r) << 16) | (e << 7) | r; }
        else { const int p0 = pref[NE]; for (int r8 = 0; r8 < 8; ++r8) { const int r = 8 * x + r8; tbl[lp + r8] = ((p0 + r) << 16) | (NE << 7) | r; } cnts[600] = lp + 8; }
    }
    __syncthreads();
    return __builtin_amdgcn_readfirstlane(cnts[600]);
}
__device__ __forceinline__ void final_rows(Ctx& X) {
    const bf16_t* X1 = WSP(bf16_t, WS_X1); const float* MOD = WSP(float, WS_MOD); const unsigned char* YBUF = WSP(unsigned char, WS_YBUF);
    const int gw = X.wg * NWAVES + X.wave, NGW = X.G * NWAVES, l = X.lane;
    for (int t = gw; t < T; t += NGW) {
        const int b = t / SEQ; f32x4 v[2][2]; float s = 0.f;
#pragma unroll
        for (int j = 0; j < 2; ++j) { const int col = 8 * l + 512 * j; f32x4 m0 = {0.f, 0.f, 0.f, 0.f}, m1 = {0.f, 0.f, 0.f, 0.f};
#pragma unroll
            for (int k = 0; k < NSLOT; ++k) { const u32x2 y = *(const u32x2*)(YBUF + ((size_t)t * NSLOT + k) * D + col);
                const f32x2 a = __builtin_amdgcn_cvt_pk_f32_fp8((int)y.x, false), bq = __builtin_amdgcn_cvt_pk_f32_fp8((int)y.x, true), c = __builtin_amdgcn_cvt_pk_f32_fp8((int)y.y, false), d = __builtin_amdgcn_cvt_pk_f32_fp8((int)y.y, true);
                m0.x += a[0]; m0.y += a[1]; m0.z += bq[0]; m0.w += bq[1]; m1.x += c[0]; m1.y += c[1]; m1.z += d[0]; m1.w += d[1]; }
            const f32x4 g0 = *(const f32x4*)(MOD + b * 6144 + 5120 + col) * (1.0f / YSCALE), g1 = *(const f32x4*)(MOD + b * 6144 + 5120 + col + 4) * (1.0f / YSCALE);
            const u32x4 xw = *(const u32x4*)(X1 + (size_t)t * D + col); const f32x4 x0 = {bflo(xw.x), bfhi(xw.x), bflo(xw.y), bfhi(xw.y)}, x1 = {bflo(xw.z), bfhi(xw.z), bflo(xw.w), bfhi(xw.w)};
            v[j][0] = x0 + g0 * m0; v[j][1] = x1 + g1 * m1;
#pragma unroll
            for (int q = 0; q < 2; ++q) s += (v[j][q].x * v[j][q].x + v[j][q].y * v[j][q].y) + (v[j][q].z * v[j][q].z + v[j][q].w * v[j][q].w); }
        const float rstd = rsqrtf(wave_sum(s) * (1.f / D) + EPS);
#pragma unroll
        for (int j = 0; j < 2; ++j) { const int col = 8 * l + 512 * j;
            *(f32x4*)(X.out + (size_t)t * D + col) = v[j][0] * rstd * *(const f32x4*)(X.g_final + col); *(f32x4*)(X.out + (size_t)t * D + col + 4) = v[j][1] * rstd * *(const f32x4*)(X.g_final + col + 4); }
    }
}

__device__ __forceinline__ unsigned* panel_word(Ctx& X, int bank, int pm) { return WSP(unsigned, WS_CTL) + CW_PANEL + (bank * 64 + pm) * 64; }
__device__ __forceinline__ void panel_signal(Ctx& X, int bank, int pm) {
    asm volatile("s_waitcnt vmcnt(0)" ::: "memory"); __syncthreads();
    if (X.tid == 0) (void)xb_add(panel_word(X, bank, pm), 1u);
}
__device__ __forceinline__ void panel_wait(Ctx& X, int bank, int pm, unsigned target) {
    if (X.tid == 0) { unsigned* p = panel_word(X, bank, pm); unsigned sp = 0u;
        while (xb_ld(p) < target) { __builtin_amdgcn_s_sleep(2); if (++sp > (1u << 22)) break; }
        __builtin_amdgcn_fence(__ATOMIC_ACQUIRE, "agent"); asm volatile("s_waitcnt vmcnt(0)" ::: "memory"); }
    __syncthreads();
}

constexpr int NG_INPROJ = 176;
__device__ __forceinline__ void ph_inproj(Ctx& X) {
    const int ng = X.G > NG_INPROJ + 8 ? NG_INPROJ : X.G;
    if (X.wg < ng) {
        RegSched S{(const char*)WSP(bf16_t, WS_H), (const char*)WSP(bf16_t, WS_WIN), (size_t)256 * 2048, (size_t)256 * 2048, T / 256, INW / 256, ng, X.wg};
        EpiInproj E{WSP(bf16_t, WS_PROJ), WSP(float, WS_LOGF), WSP(float, WS_LB), WSP(float, WS_ROPE), WSP(unsigned char, WS_G8), WSP(unsigned char, WS_QK8)};
        pg8::gemm_phase<EpiInproj, RegSched, true, false>(X.lds, 1024, 1024, 1024, S, E);
    }
    if (ng == X.G) expert_convert(X, X.wg, X.G);
    else if (X.wg >= ng) expert_convert(X, X.wg - ng, X.G - ng);
}
__device__ __forceinline__ void ph_mix_a(Ctx& X) {
    for (int it = X.wg; it < 256; it += X.G) hgrn_kv_unit(X, it);
    AttnRegs Ra, Rb; int unit = X.wg;
    auto clampu = [](int u) { return u < 1536 ? u : 1535; };
    attn_load(X, clampu(unit), Ra);
    __builtin_amdgcn_sched_barrier(0);
    attn_load(X, clampu(unit + X.G), Rb);
    __builtin_amdgcn_sched_barrier(0);
#define ATTN_STEP(R_) do { attn_stage(X, R_); __syncthreads(); __builtin_amdgcn_sched_barrier(0); attn_load(X, clampu(unit + 2 * X.G), R_); __builtin_amdgcn_sched_barrier(0); \
        attn_compute(X, unit); __syncthreads(); unit += X.G; } while (0)
    if (unit < 1536) {
        ATTN_STEP(Ra);
        while (unit < 1536) {
            ATTN_STEP(Rb);
            if (unit >= 1536) break;
            ATTN_STEP(Ra);
        }
    }
#undef ATTN_STEP
}
__device__ __forceinline__ void ph_mix_c(Ctx& X) { for (int it = X.wg; it < 512; it += X.G) hgrn_out_unit(X, it); attn_combine(X); }
__device__ __forceinline__ void ph_mixed(Ctx& X, bool chain) {
    TwoPartSched S{(const char*)WSP(bf16_t, WS_YCAT), (const char*)WSP(bf16_t, WS_WPA), (const char*)WSP(bf16_t, WS_WPB), T / 256, D / 256, X.G, X.wg};
    EpiMixed E{WSP(unsigned char, WS_G8), WSP(bf16_t, WS_MIXED)};
    pg8::gemm_phase<EpiMixed, TwoPartSched, false, false>(X.lds, 1024, 512, 512, S, E);
    if (chain) { int pm, pn; pg8::swz_tile(X.wg, T / 256, D / 256, pm, pn); panel_signal(X, 0, pm); }
}
__device__ __forceinline__ void ph_outproj(Ctx& X, bool chain) {
    int pm = 0, pn = 0; pg8::swz_tile(X.wg < 256 ? X.wg : 0, T / 256, D / 256, pm, pn);
    RegSched S{(const char*)WSP(bf16_t, WS_MIXED), (const char*)WSP(bf16_t, WS_WOUT), (size_t)256 * 2048, (size_t)256 * 2048, T / 256, D / 256, X.G, X.wg};
    if (chain) {
        panel_wait(X, 0, pm, 4u);
        EpiOutNorm E{X.x, WSP(float, WS_MOD), X.g2, WSP(bf16_t, WS_X1), WSP(bf16_t, WS_H), WSP(unsigned char, WS_H8), WSP(float, WS_XB), panel_word(X, 1, 0), X.lds + 139264};
        pg8::gemm_phase<EpiOutNorm, RegSched, true, false>(X.lds, 1024, 1024, 1024, S, E);
        panel_signal(X, 2, pm);
    } else {
        EpiOutproj E{X.x, WSP(float, WS_MOD), WSP(bf16_t, WS_X1)};
        pg8::gemm_phase<EpiOutproj, RegSched, false, false>(X.lds, 1024, 1024, 1024, S, E);
    }
}
__device__ __forceinline__ void ph_norm2(Ctx& X, bool chain) { if (!chain) norm_rows(X, 1); }
__device__ __forceinline__ void ph_router(Ctx& X, bool chain) {
    if (chain) panel_wait(X, 2, X.wg >> 2, 4u);
    RouterSched S{(const char*)WSP(bf16_t, WS_H), (const char*)WSP(bf16_t, WS_WR), X.G, X.wg};
    EpiRouter E{WSP(float, WS_KVT)};
    pg8::gemm_phase<EpiRouter, RouterSched, false, false>(X.lds, 1024, 1024, 256, S, E);
    if (chain) panel_signal(X, 3, X.wg >> 2);
}
__device__ __forceinline__ void ph_route(Ctx& X, bool chain) {
    if (chain) panel_wait(X, 3, X.wg >> 2, 4u);
    moe_route(X, chain);
}
__device__ __forceinline__ void ph_gu(Ctx& X) {
    const int nent = moe_table(X);
    MoeSched S{(const LAS int*)(X.lds + TBL_OFF), (const LAS int*)(X.lds + TCNT_OFF), nent, (const char*)WSP(unsigned char, WS_H8), (const char*)WSP(unsigned char, WS_WGU), WSP(int, WS_LISTS), 2, 256 * 1024, 512 * 1024, 0, X.G, X.wg};
    EpiGU E{WSP(unsigned char, WS_ACT)};
    pg8::gemm_phase<EpiGU, MoeSched, true, true, true>(X.lds, 512, 512, 512, S, E);
}
__device__ __forceinline__ void ph_down(Ctx& X) {
    const int nent = moe_table(X);
    MoeSched S{(const LAS int*)(X.lds + TBL_OFF), (const LAS int*)(X.lds + TCNT_OFF), nent, (const char*)WSP(unsigned char, WS_ACT), (const char*)WSP(unsigned char, WS_WD), WSP(int, WS_LISTS), 4, 256 * 256, 1024 * 256, 256 * 256, X.G, X.wg};
    EpiDown E{WSP(unsigned char, WS_YBUF), WSP(float, WS_GATEW)};
    pg8::gemm_phase<EpiDown, MoeSched, true, false, true>(X.lds, 128, 128, 128, S, E);
}

constexpr int NPHASE = 14;
struct Args { const void* in[20]; float* out; unsigned char* ws; int ph_lo, ph_hi; };
__global__ void __launch_bounds__(NTHREADS, 2) mega_fwd(Args args) {
    extern __shared__ __attribute__((aligned(16))) unsigned char lds_raw[];
    Ctx X;
    X.lds = (LAS unsigned char*)lds_raw;
    X.tid = threadIdx.x; X.lane = X.tid & 63; X.wave = __builtin_amdgcn_readfirstlane(X.tid >> 6); X.wg = blockIdx.x; X.G = gridDim.x;
    X.x = (const float*)args.in[0]; X.c = (const float*)args.in[1]; X.positions = (const int*)args.in[2]; X.w_ada = (const float*)args.in[3]; X.b_ada = (const float*)args.in[4];
    X.g1 = (const float*)args.in[5]; X.w_in = (const float*)args.in[6]; X.lb_logits = (const float*)args.in[7]; X.g_hgrn = (const float*)args.in[8]; X.w_pa = (const float*)args.in[9];
    X.w_pb = (const float*)args.in[10]; X.w_out = (const float*)args.in[11]; X.g2 = (const float*)args.in[12]; X.w_router = (const float*)args.in[13]; X.rbias = (const float*)args.in[14];
    X.w_egu = (const float*)args.in[15]; X.w_edown = (const float*)args.in[16]; X.w_sgu = (const float*)args.in[17]; X.w_sdown = (const float*)args.in[18]; X.g_final = (const float*)args.in[19];
    X.out = args.out; X.ws = args.ws;
    volatile LAS unsigned* MISC = (volatile LAS unsigned*)(X.lds + MISC_OFF);
    if (X.tid < 32) MISC[X.tid] = 0u;
    __syncthreads();
    const int lo = args.ph_lo, hi = args.ph_hi;
    XcdBarrier bar; bar.bar = WSP(unsigned, WS_CTL) + CW_BAR; bar.x = 0; bar.st = nullptr;
    if (hi - lo > 1) bar = xcd_barrier_post(WSP(unsigned, WS_CTL) + CW_BAR, MISC + 8);
#ifndef PH_MASK
#define PH_MASK 0xffffffffu
#endif
#define IN(k) ((((PH_MASK) >> (k)) & 1u) && lo <= (k) && (k) < hi)
#ifndef REPEAT_MASK
#define REPEAT_MASK 0u
#endif
#define SEAM(k) do { if (IN(k) && IN((k) + 1)) xcd_barrier(bar); } while (0)
#define RUN(k, call) do { if (IN(k)) { call; if (((REPEAT_MASK) >> (k)) & 1u) { xcd_barrier(bar); call; } } } while (0)

    const bool p01 = IN(0) && IN(1);
    RUN(0, p0_prologue(X));
    if (p01) { asm volatile("s_waitcnt vmcnt(0)" ::: "memory"); __syncthreads(); if (X.tid == 0) (void)xb_add(WSP(unsigned, WS_CTL) + CW_P0 + 64 * (X.wg & 7), 1u); }
    if (IN(1)) {
        small_transposes(X);
        if (p01) {
            if (X.tid == 0) { unsigned* p = WSP(unsigned, WS_CTL) + CW_P0; unsigned sp = 0u;
                for (;;) { unsigned sum = 0u;
#pragma unroll
                    for (int j = 0; j < 8; ++j) sum += xb_ld(p + 64 * j);
                    if (sum >= (unsigned)X.G) break;
                    __builtin_amdgcn_s_sleep(2); if (++sp > (1u << 22)) break; }
                __builtin_amdgcn_fence(__ATOMIC_ACQUIRE, "agent"); asm volatile("s_waitcnt vmcnt(0)" ::: "memory"); }
            __syncthreads();
        }
        norm_rows(X, 0);
    }
    SEAM(1);
    RUN(2, ph_inproj(X)); SEAM(2);
    RUN(3, ph_mix_a(X)); SEAM(3);
    RUN(4, hgrn_passB(X)); SEAM(4);
    RUN(5, ph_mix_c(X)); SEAM(5);
    const bool chain = (X.G == 256);
    RUN(6, ph_mixed(X, chain)); if (!chain) SEAM(6);
    RUN(7, ph_outproj(X, chain)); if (!chain) SEAM(7);
    RUN(8, ph_norm2(X, chain)); if (!chain) SEAM(8);
    RUN(9, ph_router(X, chain)); if (!chain) SEAM(9);
    RUN(10, ph_route(X, chain)); SEAM(10);
    RUN(11, ph_gu(X)); SEAM(11);
    RUN(12, ph_down(X)); SEAM(12);
    RUN(13, final_rows(X));
#undef IN
#undef SEAM
}

extern "C" void kernel_launch(void* const* d_in, const int* in_sizes, int n_in, void* d_out, int out_size, void* d_ws, size_t ws_size, hipStream_t stream) {
    static int grid = 0;
    if (grid == 0) {
        if (n_in != 20 || out_size != T * D || ws_size < WS_END) { fprintf(stderr, "kernel_launch: unexpected shapes (n_in %d, out %d, ws %zu); nothing launched\n", n_in, out_size, ws_size); grid = -1; return; }
        int dev = 0, cus = 0, per_cu = 0;
        if (hipGetDevice(&dev) != hipSuccess || hipDeviceGetAttribute(&cus, hipDeviceAttributeMultiprocessorCount, dev) != hipSuccess) { grid = -1; return; }
        if (hipFuncSetAttribute((const void*)mega_fwd, hipFuncAttributeMaxDynamicSharedMemorySize, LDS_BYTES) != hipSuccess) { fprintf(stderr, "kernel_launch: hipFuncSetAttribute failed\n"); grid = -1; return; }
        if (hipOccupancyMaxActiveBlocksPerMultiprocessor(&per_cu, (const void*)mega_fwd, NTHREADS, LDS_BYTES) != hipSuccess || per_cu < 1) { fprintf(stderr, "kernel_launch: occupancy query says %d blocks/CU; nothing launched\n", per_cu); (void)hipGetLastError(); grid = -1; return; }
        grid = cus;
        if (T % grid != 0 || 24576 % grid != 0 || grid % 8 != 0) { fprintf(stderr, "kernel_launch: grid %d does not divide the row count; nothing launched\n", grid); grid = -1; return; }
    }
    if (grid < 0) return;
    (void)hipMemsetAsync((char*)d_ws + WS_CTL, 0, CTL_ZERO_BYTES, stream);
    Args a{};
    for (int i = 0; i < 20; ++i) a.in[i] = d_in[i];
    a.out = (float*)d_out; a.ws = (unsigned char*)d_ws;
#if MK_PER_PHASE
    for (int p = 0; p < NPHASE; ++p) { a.ph_lo = p; a.ph_hi = p + 1; hipLaunchKernelGGL(mega_fwd, dim3(grid), dim3(NTHREADS), LDS_BYTES, stream, a); }
#else
    a.ph_lo = 0; a.ph_hi = NPHASE;
    hipLaunchKernelGGL(mega_fwd, dim3(grid), dim3(NTHREADS), LDS_BYTES, stream, a);
#endif
}
```

```cpp
#include <hip/hip_runtime.h>
#include <cstdio>
#include <cstdint>

#ifndef MK_PER_PHASE
#define MK_PER_PHASE 0
#endif

#define GAS __attribute__((address_space(1)))
#define LAS __attribute__((address_space(3)))
typedef unsigned short bf16_t;
typedef short bf16x8 __attribute__((ext_vector_type(8)));
typedef short s16x4 __attribute__((ext_vector_type(4)));
typedef float f32x4 __attribute__((ext_vector_type(4)));
typedef float f32x2 __attribute__((ext_vector_type(2)));
typedef float f32x16 __attribute__((ext_vector_type(16)));
typedef unsigned u32x4 __attribute__((ext_vector_type(4)));
typedef unsigned u32x2 __attribute__((ext_vector_type(2)));
typedef long l64x2 __attribute__((ext_vector_type(2)));

constexpr int NB = 4, SEQ = 4096, T = NB * SEQ, D = 1024, INW = 8704;
constexpr int C_HQ = 0, C_HK = 512, C_HV = 1024, C_HG = 1536, C_AQ = 2048, C_AK = 3584, C_AV = 5120, C_GA = 6656, C_GB = 7680;
constexpr int NE = 256, NEX = 257, TOPK = 8, NSLOT = 9, EFF = 256;
constexpr float EPS = 1e-6f;
constexpr float WGU_SCALE = 64.0f, WD_SCALE = 32.0f;
constexpr float YSCALE = 16.0f;
constexpr int NWAVES = 8, NTHREADS = 512;

constexpr size_t MiB = 1u << 20;
constexpr size_t WS_CTL = 0, CTL_ZERO_BYTES = 1 * MiB;
constexpr size_t WS_MODP = 2 * MiB;
constexpr size_t WS_MOD = 4 * MiB;
constexpr size_t WS_LB = 4 * MiB + 128 * 1024;
constexpr size_t WS_XB = 4 * MiB + 256 * 1024;
constexpr size_t WS_ROPE = 5 * MiB;
constexpr size_t WS_DECAY = 6 * MiB;
constexpr size_t WS_GATEW = 7 * MiB;
constexpr size_t WS_LISTS = 16 * MiB;
constexpr size_t WS_WIN = 34 * MiB;
constexpr size_t WS_WPA = 51 * MiB, WS_WPB = 52 * MiB, WS_WOUT = 53 * MiB, WS_WR = 55 * MiB;
constexpr size_t WS_H = 56 * MiB;
constexpr size_t WS_LOGF = 88 * MiB;
constexpr size_t WS_H8 = 120 * MiB;
constexpr size_t WS_MIXED = 136 * MiB;
constexpr size_t WS_YCAT = 168 * MiB;
constexpr size_t WS_X1 = 200 * MiB;
constexpr size_t WS_G8 = 232 * MiB;
constexpr size_t WS_OG = 264 * MiB;
constexpr size_t WS_LSE = 312 * MiB;
constexpr size_t WS_KVT = 314 * MiB;
constexpr size_t WS_SPT = 378 * MiB;
constexpr size_t WS_PROJ = 410 * MiB;
constexpr size_t WS_WGU = 682 * MiB;
constexpr size_t WS_QK8 = 820 * MiB;
constexpr size_t WS_WD = 939 * MiB;
constexpr size_t WS_ACT = 1068 * MiB;
constexpr size_t WS_YBUF = 1172 * MiB;
constexpr size_t WS_END = 1460 * MiB;
constexpr int CW_P0 = 2048;
constexpr int CW_BAR = 4096;
constexpr int CW_PANEL = 65536;
constexpr int CW_CNT = 16384;

constexpr int RING_BYTES = 131072;
constexpr int TBL_OFF = RING_BYTES;
constexpr int TCNT_OFF = TBL_OFF + 4096;
constexpr int MISC_OFF = TCNT_OFF + 2560;
constexpr int LDS_BYTES = 147456;

#define LDS_WAIT() asm volatile("s_waitcnt lgkmcnt(0)" ::: "memory")
#define VM_WAIT() asm volatile("s_waitcnt vmcnt(0)" ::: "memory")
__device__ __forceinline__ unsigned f2bf(float f) { unsigned u = __builtin_bit_cast(unsigned, f); return (u + 0x7fffu + ((u >> 16) & 1u)) >> 16; }
__device__ __forceinline__ float bf2f(unsigned b) { return __builtin_bit_cast(float, b << 16); }
__device__ __forceinline__ unsigned pk2(float lo, float hi) { return f2bf(lo) | (f2bf(hi) << 16); }
__device__ __forceinline__ float bflo(unsigned w) { return __builtin_bit_cast(float, w << 16); }
__device__ __forceinline__ float bfhi(unsigned w) { return __builtin_bit_cast(float, w & 0xffff0000u); }
__device__ __forceinline__ float fast_logf(float x) { return __builtin_amdgcn_logf(x) * 0.6931471805599453f; }
__device__ __forceinline__ float sigmoidf_(float x) { return __builtin_amdgcn_rcpf(1.0f + __expf(-x)); }
__device__ __forceinline__ float wave_sum(float v) {
#pragma unroll
    for (int o = 1; o < 64; o <<= 1) v += __shfl_xor(v, o);
    return v;
}

__device__ __forceinline__ float clamp_e4m3(float x) { return __builtin_amdgcn_fmed3f(x, -448.0f, 448.0f); }
__device__ __forceinline__ unsigned pk4_fp8(float a, float b, float c, float d) { int w = 0; w = __builtin_amdgcn_cvt_pk_fp8_f32(clamp_e4m3(a), clamp_e4m3(b), w, false); w = __builtin_amdgcn_cvt_pk_fp8_f32(clamp_e4m3(c), clamp_e4m3(d), w, true); return (unsigned)w; }
__device__ __forceinline__ void st_wt8(void* p, unsigned long long v) { __hip_atomic_store((unsigned long long*)p, v, __ATOMIC_RELAXED, __HIP_MEMORY_SCOPE_AGENT); }
__device__ __forceinline__ void st_wt16(void* p, u32x4 v) { asm volatile("global_store_dwordx4 %0, %1, off sc1\n\ts_nop 1" :: "v"(p), "v"(v) : "memory"); }
__device__ __forceinline__ void st_wt4(void* p, unsigned v) { __hip_atomic_store((unsigned*)p, v, __ATOMIC_RELAXED, __HIP_MEMORY_SCOPE_AGENT); }
namespace pg8 {
constexpr int BM = 256, BK = 64, HALF = 128, HTB = HALF * BK * 2, STAGE_BYTES = 8 * HTB, NXCD = 8, WGM = 8;
__host__ __device__ __forceinline__ int lds_byte(int r, int c) { const int st = (r >> 4) * 2 + (c >> 5), rr = r & 15, cc = c & 31, ob = rr * 64 + cc * 2; return st * 1024 + (ob ^ (((ob >> 9) & 1) << 5)); }
__host__ __device__ __forceinline__ void stage_rc(int b, int& R, int& C) { const int st = b / 1024, sb = b % 1024, swz = sb ^ (((sb >> 9) & 1) << 5); R = (st >> 1) * 16 + swz / 64; C = (st & 1) * 32 + (swz % 64) / 2; }
__host__ __device__ __forceinline__ int perm32(int rho) { const int n = rho >> 4, i = rho & 15; return 8 * (i >> 2) + 4 * n + (i & 3); }

struct Unit { const char* a; const char* b; const int* rows; int pm, pn, aux, nvalid; };

__device__ __forceinline__ void swz_tile(int L, int nM, int nN, int& pm, int& pn) {
    const int nwg = nM * nN; int wgid = L;
    { const int q = nwg / NXCD, r = nwg % NXCD, xcd = wgid % NXCD, off = wgid / NXCD; wgid = (xcd < r ? xcd * (q + 1) : r * (q + 1) + (xcd - r) * q) + off; }
    const int nig = WGM * nN, gid = wgid / nig, fm = gid * WGM, gsz = (nM - fm) < WGM ? (nM - fm) : WGM;
    pm = fm + ((wgid % nig) % gsz); pn = (wgid % nig) / gsz;
}

__device__ __forceinline__ unsigned cvt_pk_bf16(float lo, float hi) { unsigned r; asm volatile("v_cvt_pk_bf16_f32 %0, %1, %2" : "=v"(r) : "v"(lo), "v"(hi)); return r; }

template <bool GATHER>
__device__ __forceinline__ void gather_offs(const Unit& u, int tid, int lda, unsigned (&v)[2][2]) {
    if constexpr (GATHER) {
#pragma unroll
        for (int i = 0; i < 2; ++i) { int R, C; stage_rc(tid * 16 + i * 8192, R, C);
#pragma unroll
            for (int hh = 0; hh < 2; ++hh) { const int ri = hh * HALF + R; int slot = 0; if (ri < u.nvalid) slot = u.rows[ri];
                const unsigned tok = (unsigned)slot / 9u; v[hh][i] = (tok * (unsigned)lda + (unsigned)C) * 2u; } }
    }
}

template <class E, class = void> struct epi_bjadj { static constexpr bool v = false; };
template <class E> struct epi_bjadj<E, decltype((void)E::BJADJ)> { static constexpr bool v = E::BJADJ; };
template <class Epi, class Sched, bool ALIGN_EPI, bool GATHER, bool FP8 = false>
__device__ __forceinline__ void gemm_phase(LAS unsigned char* lds, const int lda, const int ldb, const int K, const Sched& S, const Epi& E) {
    const int tid = threadIdx.x, wid = __builtin_amdgcn_readfirstlane(tid >> 6), lane = tid & 63, wr = wid >> 2, wc = wid & 3, fr = lane & 15, fq = lane >> 4;
    const int nt = K / BK;
    unsigned voffA[2], voffB[2];
#pragma unroll
    for (int i = 0; i < 2; ++i) { int R, C; stage_rc(tid * 16 + i * 8192, R, C); const int Rb = Epi::PERM ? ((R & ~31) + perm32(R & 31)) : R;
        const int Rg = epi_bjadj<Epi>::v ? ((Rb >> 5) * 64 + (Rb & 31)) : Rb;
        voffA[i] = (unsigned)(R * lda + C) * 2u; voffB[i] = (unsigned)(Rg * ldb + C) * 2u; }
    const size_t kstep = (size_t)(BK * 2);
    const size_t hstepA = GATHER ? 0 : (size_t)HALF * lda * 2, hstepB = (size_t)(epi_bjadj<Epi>::v ? 32 : HALF) * ldb * 2;
    const unsigned ldsw = (unsigned)wid * 1024u;
    const int aoff = lds_byte(wr * 64 + fr, fq * 8), boff = lds_byte(wc * 32 + fr, fq * 8);
#define PG8_SA(b, h) (((b) * 2 + (h)) * HTB)
#define PG8_SB(b, h) ((4 + (b) * 2 + (h)) * HTB)
#define PG8_STAGE(bufoff, gbase, voff) do { _Pragma("unroll") for (int _i = 0; _i < 2; ++_i) \
        __builtin_amdgcn_global_load_lds((const unsigned*)((const char*)(gbase) + (voff)[_i]), (LAS unsigned*)(lds + (bufoff) + ldsw + _i * 8192), 16, 0, 0); } while (0)
#define PG8_STAGE_A(bufoff, gb, hh, nx) do { if constexpr (GATHER) { unsigned _v[2]; _v[0] = (nx) ? vn[hh][0] : vc[hh][0]; _v[1] = (nx) ? vn[hh][1] : vc[hh][1]; PG8_STAGE(bufoff, gb, _v); } \
        else { PG8_STAGE(bufoff, (gb) + (hh) * hstepA, voffA); } } while (0)
#define PG8_LDA(dst, b, h) do { _Pragma("unroll") for (int m = 0; m < 4; ++m) _Pragma("unroll") for (int k = 0; k < 2; ++k) dst[m][k] = *(const LAS bf16x8*)(lds + PG8_SA(b, h) + aoff + m * 2048 + k * 1024); } while (0)
#define PG8_LDB(dst, b, h) do { _Pragma("unroll") for (int n = 0; n < 2; ++n) _Pragma("unroll") for (int k = 0; k < 2; ++k) dst[n][k] = *(const LAS bf16x8*)(lds + PG8_SB(b, h) + boff + n * 2048 + k * 1024); } while (0)
#define PG8_MMA(ai, bj, At, Bt) do { __builtin_amdgcn_s_setprio(1); _Pragma("unroll") for (int m = 0; m < 4; ++m) _Pragma("unroll") for (int n = 0; n < 2; ++n) _Pragma("unroll") for (int k = 0; k < 2; ++k) { \
        if constexpr (FP8) { const l64x2 _b = __builtin_bit_cast(l64x2, Bt[n][k]), _a = __builtin_bit_cast(l64x2, At[m][k]); \
            acc[ai][bj][m][n] = __builtin_amdgcn_mfma_f32_16x16x32_fp8_fp8(_b[0], _a[0], acc[ai][bj][m][n], 0, 0, 0); acc[ai][bj][m][n] = __builtin_amdgcn_mfma_f32_16x16x32_fp8_fp8(_b[1], _a[1], acc[ai][bj][m][n], 0, 0, 0); } \
        else acc[ai][bj][m][n] = __builtin_amdgcn_mfma_f32_16x16x32_bf16(Bt[n][k], At[m][k], acc[ai][bj][m][n], 0, 0, 0); } __builtin_amdgcn_s_setprio(0); } while (0)
#define PG8_WAIT_V(n) asm volatile("s_waitcnt vmcnt(" #n ")" ::: "memory")
#define PG8_WAIT_L(n) asm volatile("s_waitcnt lgkmcnt(" #n ")" ::: "memory")
#define PG8_BAR __builtin_amdgcn_s_barrier()
#define PG8_SCHED __builtin_amdgcn_sched_barrier(0)
    Unit cur, nxt; int ui = 0;
    if (!S.next(0, cur)) return;
    unsigned vc[2][2] = {{0u, 0u}, {0u, 0u}}, vn[2][2] = {{0u, 0u}, {0u, 0u}};
    gather_offs<GATHER>(cur, tid, lda, vc);
    f32x4 acc[2][2][4][2];
#pragma unroll
    for (int a = 0; a < 2; ++a)
#pragma unroll
        for (int b = 0; b < 2; ++b)
#pragma unroll
            for (int m = 0; m < 4; ++m)
#pragma unroll
                for (int n = 0; n < 2; ++n) acc[a][b][m][n] = (f32x4){0.f, 0.f, 0.f, 0.f};
    bf16x8 At[4][2], B0[2][2], B1[2][2];
    const char* cA = cur.a; const char* cB = cur.b;
    PG8_STAGE(PG8_SB(0, 0), cB, voffB); PG8_STAGE(PG8_SB(0, 1), cB + hstepB, voffB); PG8_STAGE_A(PG8_SA(0, 0), cA, 0, false); PG8_STAGE_A(PG8_SA(0, 1), cA, 1, false);
    if (wr == 1) PG8_BAR;
    PG8_WAIT_V(2); PG8_BAR;
    PG8_STAGE(PG8_SB(1, 0), cB + kstep, voffB); PG8_STAGE_A(PG8_SA(1, 0), cA + kstep, 0, false); PG8_STAGE(PG8_SB(1, 1), cB + hstepB + kstep, voffB);
    PG8_WAIT_V(6); PG8_BAR;
    for (;;) {
        const bool has_next = S.next(ui + 1, nxt);
        if (has_next) gather_offs<GATHER>(nxt, tid, lda, vn);
        const char* nA = has_next ? nxt.a : cA; const char* nB = has_next ? nxt.b : cB;
        const bool do0 = !Sched::HALFSKIP || cur.nvalid > 64 * wr, do1 = !Sched::HALFSKIP || cur.nvalid > 128 + 64 * wr;
        for (int t = 0; t < nt; t += 2) {
            const bool last = (t == nt - 2);
            const bool lnx = last && has_next;
            const char* a1 = cA + (size_t)(t + 1) * kstep;
            const char* a2 = last ? nA : cA + (size_t)(t + 2) * kstep; const char* b2 = last ? nB : cB + (size_t)(t + 2) * kstep;
            const char* a3 = a2 + kstep; const char* b3 = b2 + kstep;
            PG8_LDB(B0, 0, 0); PG8_LDB(B1, 0, 1); PG8_SCHED; PG8_LDA(At, 0, 0); PG8_STAGE_A(PG8_SA(1, 1), a1, 1, false);
            PG8_WAIT_V(8); PG8_WAIT_L(0); PG8_BAR; if (do0) { PG8_MMA(0, 0, At, B0); PG8_MMA(0, 1, At, B1); } PG8_BAR; PG8_SCHED;
            PG8_LDA(At, 0, 1); PG8_STAGE(PG8_SB(0, 0), b2, voffB); PG8_STAGE(PG8_SB(0, 1), b2 + hstepB, voffB); PG8_STAGE_A(PG8_SA(0, 0), a2, 0, lnx);
            PG8_WAIT_V(8); PG8_WAIT_L(0); PG8_BAR; if (do1) { PG8_MMA(1, 0, At, B0); PG8_MMA(1, 1, At, B1); } PG8_BAR; PG8_SCHED;
            PG8_LDB(B0, 1, 0); PG8_LDB(B1, 1, 1); PG8_SCHED; PG8_LDA(At, 1, 0); PG8_STAGE_A(PG8_SA(0, 1), a2, 1, lnx);
            PG8_WAIT_V(8); PG8_WAIT_L(0); PG8_BAR; if (do0) { PG8_MMA(0, 0, At, B0); PG8_MMA(0, 1, At, B1); } PG8_BAR; PG8_SCHED;
            PG8_LDA(At, 1, 1); PG8_STAGE(PG8_SB(1, 0), b3, voffB); PG8_STAGE(PG8_SB(1, 1), b3 + hstepB, voffB); PG8_STAGE_A(PG8_SA(1, 0), a3, 0, lnx);
            PG8_WAIT_V(8); PG8_WAIT_L(0); PG8_BAR; if (do1) { PG8_MMA(1, 0, At, B0); PG8_MMA(1, 1, At, B1); } PG8_BAR; PG8_SCHED;
        }
        if constexpr (ALIGN_EPI) { if (wr == 0) PG8_BAR; }
        E(acc, cur, wr, wc, fr, fq);
        __builtin_amdgcn_s_waitcnt(0x0F70);
        if (!has_next) break;
        if (!E.keep(cur)) {
#pragma unroll
            for (int a = 0; a < 2; ++a)
#pragma unroll
                for (int b = 0; b < 2; ++b)
#pragma unroll
                    for (int m = 0; m < 4; ++m)
#pragma unroll
                        for (int n = 0; n < 2; ++n) acc[a][b][m][n] = (f32x4){0.f, 0.f, 0.f, 0.f};
        }
        cur = nxt; cA = nA; cB = nB; ++ui;
        if constexpr (GATHER) {
#pragma unroll
            for (int hh = 0; hh < 2; ++hh) { vc[hh][0] = vn[hh][0]; vc[hh][1] = vn[hh][1]; }
        }
        if constexpr (ALIGN_EPI) { if (wr == 1) PG8_BAR; }
    }
    PG8_WAIT_V(0);
    if constexpr (!ALIGN_EPI) { if (wr == 0) PG8_BAR; }
    PG8_BAR;
#undef PG8_SA
#undef PG8_SB
#undef PG8_STAGE
#undef PG8_STAGE_A
#undef PG8_LDA
#undef PG8_LDB
#undef PG8_MMA
#undef PG8_WAIT_V
#undef PG8_WAIT_L
#undef PG8_BAR
#undef PG8_SCHED
}
}

#define XB_TMO      128
#define XB_XCNT(j)  (256  + 64 * (j))
#define XB_XSUB(j)  (1280 + 64 * (j))
#define XB_XGEN(j)  (2304 + 64 * (j))
#define XB_TOP      3328
#define XB_TOPGEN   3392
#define XCD_BAR_WORDS 3456
#define XB_SPIN_CAP (1u << 20)
__device__ __forceinline__ unsigned xb_ld(unsigned* p)              { return __hip_atomic_load(p, __ATOMIC_RELAXED, __HIP_MEMORY_SCOPE_AGENT); }
__device__ __forceinline__ unsigned xb_add(unsigned* p, unsigned v) { return __hip_atomic_fetch_add(p, v, __ATOMIC_RELAXED, __HIP_MEMORY_SCOPE_AGENT); }
__device__ __forceinline__ unsigned xb_xcc_id() { return (unsigned)__builtin_amdgcn_s_getreg((3 << 11) | 20) & 0xFu; }
#define XB_SPIN(cond, bar) do { unsigned _sp = 0; while (cond) { __builtin_amdgcn_s_sleep(1); \
    if ((++_sp & 255u) == 0u) { if (xb_ld(&(bar)[XB_TMO])) break; if (_sp > XB_SPIN_CAP) { atomicAdd(&(bar)[XB_TMO], 1u); break; } } } } while (0)
struct XcdBarrier { unsigned* bar; unsigned x; volatile LAS unsigned* st; };
__device__ __forceinline__ XcdBarrier xcd_barrier_post(unsigned* bar, volatile LAS unsigned* st) {
    XcdBarrier b; b.bar = bar; b.x = xb_xcc_id(); b.st = st;
    if (threadIdx.x == 0) (void)xb_add(&bar[XB_XCNT(b.x)], 1u);
    return b;
}
__device__ __forceinline__ void xcd_barrier_complete(unsigned* bar, unsigned x, unsigned& nloc, unsigned& nx) {
    const unsigned G = gridDim.x * gridDim.y * gridDim.z;
    unsigned sum, cnt, mine, sp = 0u;
    for (;;) {
        sum = 0u; cnt = 0u; mine = 0u;
#pragma unroll
        for (unsigned j = 0; j < 16; ++j) { const unsigned c = xb_ld(&bar[XB_XCNT(j)]); sum += c; cnt += (c > 0u) ? 1u : 0u; mine = (j == x) ? c : mine; }
        if (sum == G) break;
        __builtin_amdgcn_s_sleep(1);
        if ((++sp & 255u) == 0u) { if (xb_ld(&bar[XB_TMO])) break; if (sp > XB_SPIN_CAP) { atomicAdd(&bar[XB_TMO], 1u); break; } }
    }
    nloc = mine > 0u ? mine : 1u; nx = cnt > 0u ? cnt : 1u;
}
__device__ __forceinline__ void xcd_barrier(const XcdBarrier& b) {
    asm volatile("s_waitcnt vmcnt(0)" ::: "memory");
    __syncthreads();
    if (threadIdx.x == 0) {
        unsigned* bar = b.bar;
        __builtin_amdgcn_s_waitcnt(0);
        unsigned nloc = b.st[0], nx = b.st[1];
        if (nloc == 0u) { xcd_barrier_complete(bar, b.x, nloc, nx); b.st[0] = nloc; b.st[1] = nx; }
        const unsigned old = xb_add(&bar[XB_XSUB(b.x)], 1u);
        const unsigned gen = old / nloc;
        if (old + 1u == (gen + 1u) * nloc) {
            __builtin_amdgcn_fence(__ATOMIC_RELEASE, "agent");
            asm volatile("s_waitcnt vmcnt(0)" ::: "memory");
            const unsigned og = xb_add(&bar[XB_TOP], 1u);
            const unsigned tg = og / nx;
            if (og + 1u == (tg + 1u) * nx) xb_add(&bar[XB_TOPGEN], 1u);
            else XB_SPIN(xb_ld(&bar[XB_TOPGEN]) == tg, bar);
            __builtin_amdgcn_fence(__ATOMIC_ACQUIRE, "agent");
            asm volatile("s_waitcnt vmcnt(0)" ::: "memory");
        } else {
            XB_SPIN(xb_ld(&bar[XB_TOPGEN]) == gen, bar);
            __builtin_amdgcn_fence(__ATOMIC_ACQUIRE, "agent");
            asm volatile("s_waitcnt vmcnt(0)" ::: "memory");
        }
    }
    __syncthreads();
}

struct Ctx {
    LAS unsigned char* lds;
    int tid, lane, wave, wg, G;
    const float *x, *c, *w_ada, *b_ada, *g1, *w_in, *lb_logits, *g_hgrn, *w_pa, *w_pb, *w_out, *g2, *w_router, *rbias, *w_egu, *w_edown, *w_sgu, *w_sdown, *g_final;
    const int* positions;
    float* out;
    unsigned char* ws;
};
#define WSP(type, off) ((type*)(X.ws + (off)))

__device__ __forceinline__ void transpose_item(const float* W, int K, int N, bf16_t* WT, int dst_row0, int src_col0, int k0, LAS float* scr, int lane) {
#pragma unroll 16
    for (int i = 0; i < 32; ++i) { const int kk = 2 * i + (lane >> 5); scr[kk * 33 + (lane & 31)] = W[(size_t)(k0 + kk) * N + src_col0 + (lane & 31)]; }
    LDS_WAIT(); asm volatile("" ::: "memory");
    const int c = lane & 7;
#pragma unroll
    for (int j = 0; j < 4; ++j) { const int n = (lane >> 3) + 8 * j; const LAS float* s = scr + (8 * c) * 33 + n;
        u32x4 o; o.x = pk2(s[0 * 33], s[1 * 33]); o.y = pk2(s[2 * 33], s[3 * 33]); o.z = pk2(s[4 * 33], s[5 * 33]); o.w = pk2(s[6 * 33], s[7 * 33]);
        *(u32x4*)(WT + (size_t)(dst_row0 + n) * K + k0 + 8 * c) = o; }
    LDS_WAIT(); asm volatile("" ::: "memory");
}
__device__ __forceinline__ void transpose_plain(const float* W, int K, int N, bf16_t* WT, int item, LAS float* scr, int lane) {
    const int nblk = N / 32, kb = item / nblk, nb = item % nblk;
    transpose_item(W, K, N, WT, nb * 32, nb * 32, kb * 64, scr, lane);
}
__device__ __forceinline__ void p0_prologue(Ctx& X) {
    LAS float* scr = (LAS float*)(X.lds + X.wave * 16384);
    const int gw = X.wg * NWAVES + X.wave, NGW = X.G * NWAVES;
    {
        float* MODP = WSP(float, WS_MODP);
        for (int it = gw; it < 96 * 16; it += NGW) {
            const int jc = it % 96, kc = it / 96, j = jc * 64 + X.lane;
            float a0 = 0.f, a1 = 0.f, a2 = 0.f, a3 = 0.f;
#pragma unroll 16
            for (int kk = 0; kk < 64; ++kk) { const int k = kc * 64 + kk; const float w = X.w_ada[(size_t)k * 6144 + j];
                const float c0 = X.c[k], c1 = X.c[1024 + k], c2 = X.c[2048 + k], c3 = X.c[3072 + k];
                a0 += c0 * sigmoidf_(c0) * w; a1 += c1 * sigmoidf_(c1) * w; a2 += c2 * sigmoidf_(c2) * w; a3 += c3 * sigmoidf_(c3) * w; }
            float* o = MODP + (size_t)kc * 24576 + j;
            st_wt4(o, __builtin_bit_cast(unsigned, a0)); st_wt4(o + 6144, __builtin_bit_cast(unsigned, a1)); st_wt4(o + 12288, __builtin_bit_cast(unsigned, a2)); st_wt4(o + 18432, __builtin_bit_cast(unsigned, a3));
        }
    }
    {
        float* ROPE = WSP(float, WS_ROPE);
        const int gt = X.wg * NTHREADS + X.tid, NGT = X.G * NTHREADS;
        for (int idx = gt; idx < T * 8; idx += NGT) { const int t = idx >> 3, i = idx & 7;
            const float inv_freq = 1.0f / powf(500000.0f, (float)(2 * i) / 16.0f);
            const float ang = (float)X.positions[t] * inv_freq;
            ROPE[t * 16 + i] = cosf(ang); ROPE[t * 16 + 8 + i] = sinf(ang); }
        if (X.wg == 0) { float* LB = WSP(float, WS_LB);
            for (int j = X.tid; j < 512; j += NTHREADS) { const float l0 = X.lb_logits[j], l1 = X.lb_logits[512 + j], m = fmaxf(l0, l1), e0 = __expf(l0 - m), e1 = __expf(l1 - m); LB[j] = e0 / (e0 + e1); } }
    }
}
struct CvtItem { const float* src; bf16_t* dst; };
template <bool GU> __device__ __forceinline__ CvtItem cvt_item(const Ctx& X, int it) {
    CvtItem c;
    if constexpr (GU) { const int e = it >> 7, q = it & 127, w8 = q & 7, sq = q >> 3, kb = 4 * (sq >> 2) + (w8 & 3), nb = 2 * (sq & 3) + (w8 >> 2);
        const int n0 = nb * 64, pn = n0 >> 8, bj = (n0 >> 7) & 1, idx = n0 & 127, srcc = bj * 256 + pn * 128 + idx;
        const float* W = (e < NE) ? X.w_egu + (size_t)e * 1024 * 512 : X.w_sgu;
        c.src = W + (size_t)(kb * 64) * 512 + srcc; c.dst = (bf16_t*)(X.ws + WS_WGU + ((size_t)e * 512 + n0) * 1024 + kb * 64); }
    else { const int e = it >> 6, q = it & 63, w8 = q & 7, sq = q >> 3, kb = w8 & 3, nb = 2 * sq + (w8 >> 2);
        const float* W = (e < NE) ? X.w_edown + (size_t)e * 256 * 1024 : X.w_sdown;
        c.src = W + (size_t)(kb * 64) * 1024 + nb * 64; c.dst = (bf16_t*)(X.ws + WS_WD + ((size_t)e * 1024 + nb * 64) * 256 + kb * 64); }
    return c;
}
template <int KB> __device__ __forceinline__ void cvt_store8(const CvtItem& c, int lane, const f32x4 (&v)[16], LAS unsigned char* tl, float sc) {
    const int kq = lane >> 4, nq = lane & 15;
#pragma unroll
    for (int i = 0; i < 4; ++i) { u32x4 w;
        w.x = pk4_fp8(v[0][i] * sc, v[1][i] * sc, v[2][i] * sc, v[3][i] * sc); w.y = pk4_fp8(v[4][i] * sc, v[5][i] * sc, v[6][i] * sc, v[7][i] * sc);
        w.z = pk4_fp8(v[8][i] * sc, v[9][i] * sc, v[10][i] * sc, v[11][i] * sc); w.w = pk4_fp8(v[12][i] * sc, v[13][i] * sc, v[14][i] * sc, v[15][i] * sc);
        *(LAS u32x4*)(tl + (4 * nq + i) * 80 + kq * 16) = w; }
    LDS_WAIT(); asm volatile("" ::: "memory");
    const int ch = lane & 3, r = lane >> 2;
    unsigned char* d8 = (unsigned char*)c.dst;
#pragma unroll
    for (int j = 0; j < 4; ++j) { const int n = 16 * j + r; const u32x4 w = *(const LAS u32x4*)(tl + n * 80 + ch * 16); __builtin_nontemporal_store(w, (u32x4*)(d8 + (size_t)n * KB + 16 * ch)); }
    LDS_WAIT(); asm volatile("" ::: "memory");
}
template <int N> __device__ __forceinline__ void cvt_load(const CvtItem& c, int lane, f32x4 (&v)[16]) {
    const float* p = c.src + (size_t)(16 * (lane >> 4)) * N + 4 * (lane & 15);
#pragma unroll
    for (int j = 0; j < 16; ++j) v[j] = __builtin_nontemporal_load((const f32x4*)(p + (size_t)j * N));
}
template <int K> __device__ __forceinline__ void cvt_store(const CvtItem& c, int lane, const f32x4 (&v)[16], LAS unsigned char* tl) {
    const int kq = lane >> 4, nq = lane & 15;
#pragma unroll
    for (int i = 0; i < 4; ++i) { u32x4 w0, w1;
        w0.x = pk2(v[0][i], v[1][i]); w0.y = pk2(v[2][i], v[3][i]); w0.z = pk2(v[4][i], v[5][i]); w0.w = pk2(v[6][i], v[7][i]);
        w1.x = pk2(v[8][i], v[9][i]); w1.y = pk2(v[10][i], v[11][i]); w1.z = pk2(v[12][i], v[13][i]); w1.w = pk2(v[14][i], v[15][i]);
        LAS unsigned char* q = tl + (4 * nq + i) * 144 + kq * 32; *(LAS u32x4*)q = w0; *(LAS u32x4*)(q + 16) = w1; }
    LDS_WAIT(); asm volatile("" ::: "memory");
    const int ch = lane & 7, r = lane >> 3;
#pragma unroll
    for (int j = 0; j < 8; ++j) { const int n = 8 * j + r; const u32x4 w = *(const LAS u32x4*)(tl + n * 144 + ch * 16); __builtin_nontemporal_store(w, (u32x4*)(c.dst + (size_t)n * K + 8 * ch)); }
    LDS_WAIT(); asm volatile("" ::: "memory");
}
struct CvtPair { const float* src; unsigned char* dst; };
template <bool GU> __device__ __forceinline__ CvtPair cvt_pair(const Ctx& X, int di) {
    CvtPair c;
    if constexpr (GU) { const int e = di >> 6, q = di & 63, nb = q & 7, kb2 = q >> 3;
        const int n0 = nb * 64, pn = n0 >> 8, bj = (n0 >> 7) & 1, idx = n0 & 127, srcc = bj * 256 + pn * 128 + idx;
        const float* W = (e < NE) ? X.w_egu + (size_t)e * 1024 * 512 : X.w_sgu;
        c.src = W + (size_t)(kb2 * 128) * 512 + srcc; c.dst = X.ws + WS_WGU + ((size_t)e * 512 + n0) * 1024 + kb2 * 128; }
    else { const int e = di >> 5, q = di & 31, nb = q & 15, kb2 = q >> 4;
        const float* W = (e < NE) ? X.w_edown + (size_t)e * 256 * 1024 : X.w_sdown;
        c.src = W + (size_t)(kb2 * 128) * 1024 + nb * 64; c.dst = X.ws + WS_WD + ((size_t)e * 1024 + nb * 64) * 256 + kb2 * 128; }
    return c;
}
template <int N> __device__ __forceinline__ void cvt_load_half(const CvtPair& c, int half, int lane, f32x4 (&v)[16]) {
    const float* p = c.src + (size_t)(64 * half + 16 * (lane >> 4)) * N + 4 * (lane & 15);
#pragma unroll
    for (int j = 0; j < 16; ++j) v[j] = __builtin_nontemporal_load((const f32x4*)(p + (size_t)j * N));
}
__device__ __forceinline__ void cvt_half_to_lds(int half, int lane, const f32x4 (&v)[16], LAS unsigned char* tl, float sc) {
    const int kq = lane >> 4, nq = lane & 15;
#pragma unroll
    for (int i = 0; i < 4; ++i) { u32x4 w;
        w.x = pk4_fp8(v[0][i] * sc, v[1][i] * sc, v[2][i] * sc, v[3][i] * sc); w.y = pk4_fp8(v[4][i] * sc, v[5][i] * sc, v[6][i] * sc, v[7][i] * sc);
        w.z = pk4_fp8(v[8][i] * sc, v[9][i] * sc, v[10][i] * sc, v[11][i] * sc); w.w = pk4_fp8(v[12][i] * sc, v[13][i] * sc, v[14][i] * sc, v[15][i] * sc);
        *(LAS u32x4*)(tl + (4 * nq + i) * 144 + half * 64 + kq * 16) = w; }
}
template <int KB> __device__ __forceinline__ void cvt_flush(const CvtPair& c, int lane, LAS unsigned char* tl) {
    LDS_WAIT(); asm volatile("" ::: "memory");
    const int ch = lane & 7, r = lane >> 3;
#pragma unroll
    for (int j = 0; j < 8; ++j) { const int n = 8 * j + r; const u32x4 w = *(const LAS u32x4*)(tl + n * 144 + ch * 16); __builtin_nontemporal_store(w, (u32x4*)(c.dst + (size_t)n * KB + 16 * ch)); }
    LDS_WAIT(); asm volatile("" ::: "memory");
}
template <bool GU> __device__ __forceinline__ void expert_convert_set(Ctx& X, int gw, int NGW, LAS unsigned char* tl) {
    constexpr int NIT = GU ? NEX * 64 : NEX * 32, N = GU ? 512 : 1024, K = GU ? 1024 : 256; constexpr float SC = GU ? WGU_SCALE : WD_SCALE;
    if (gw >= NIT) return;
    const int nmine = (NIT - gw + NGW - 1) / NGW;
    f32x4 va[16], vb[16];
    CvtPair cur = cvt_pair<GU>(X, gw);
    cvt_load_half<N>(cur, 0, X.lane, va); cvt_load_half<N>(cur, 1, X.lane, vb);
    for (int j = 0; j < nmine; ++j) {
        const CvtPair nxt = cvt_pair<GU>(X, gw + (j + 1 < nmine ? j + 1 : j) * NGW);
        __builtin_amdgcn_sched_barrier(0);
        cvt_half_to_lds(0, X.lane, va, tl, SC);
        __builtin_amdgcn_sched_barrier(0);
        cvt_load_half<N>(nxt, 0, X.lane, va);
        __builtin_amdgcn_sched_barrier(0);
        cvt_half_to_lds(1, X.lane, vb, tl, SC);
        cvt_flush<K>(cur, X.lane, tl);
        __builtin_amdgcn_sched_barrier(0);
        cvt_load_half<N>(nxt, 1, X.lane, vb);
        __builtin_amdgcn_sched_barrier(0);
        cur = nxt;
    }
}
__device__ __forceinline__ void expert_convert(Ctx& X, int cw, int ncw) {
    LAS unsigned char* tl = X.lds + X.wave * 16384;
    const int gw = cw * NWAVES + X.wave, NGW = ncw * NWAVES;
    expert_convert_set<true>(X, gw, NGW, tl);
    expert_convert_set<false>(X, gw, NGW, tl);
}

__device__ __forceinline__ void small_transposes(Ctx& X) {
    LAS float* scr = (LAS float*)(X.lds + 16384 + X.wave * 12288);
    const int gw = X.wg * NWAVES + X.wave, NGW = X.G * NWAVES;
    {
        constexpr int I_IN = 16 * 272, I_PA = 8 * 32, I_PB = 8 * 32, I_OUT = 16 * 32, I_R = 16 * 8;
        constexpr int NITEMS = I_IN + I_PA + I_PB + I_OUT + I_R;
        for (int it = gw; it < NITEMS; it += NGW) {
            int r = it;
            if (r < I_IN) { transpose_plain(X.w_in, 1024, INW, WSP(bf16_t, WS_WIN), r, scr, X.lane); continue; } r -= I_IN;
            if (r < I_PA) { transpose_plain(X.w_pa, 512, 1024, WSP(bf16_t, WS_WPA), r, scr, X.lane); continue; } r -= I_PA;
            if (r < I_PB) { transpose_plain(X.w_pb, 512, 1024, WSP(bf16_t, WS_WPB), r, scr, X.lane); continue; } r -= I_PB;
            if (r < I_OUT) { transpose_plain(X.w_out, 1024, 1024, WSP(bf16_t, WS_WOUT), r, scr, X.lane); continue; } r -= I_OUT;
            transpose_plain(X.w_router, 1024, 256, WSP(bf16_t, WS_WR), r, scr, X.lane);
        }
    }
}

__device__ __forceinline__ void norm_rows(Ctx& X, int which) {
    LAS float* sm = (LAS float*)X.lds;
    const float* MODP = WSP(float, WS_MODP); float* MOD = WSP(float, WS_MOD);
    const int rows_per_wg = T / X.G, row0 = X.wg * rows_per_wg, b = row0 / SEQ;
    if (which == 0) {
        for (int i = X.tid; i < 2048; i += NTHREADS) { const int j = b * 6144 + i; float s = X.b_ada[i];
#pragma unroll
            for (int p = 0; p < 16; ++p) s += MODP[(size_t)p * 24576 + j];
            sm[i] = s; }
        const int per = 24576 / X.G;
        for (int i = X.tid; i < per; i += NTHREADS) { const int j = X.wg * per + i; float s = X.b_ada[j % 6144];
#pragma unroll
            for (int p = 0; p < 16; ++p) s += MODP[(size_t)p * 24576 + j];
            MOD[j] = s; }
    } else {
        for (int i = X.tid; i < 2048; i += NTHREADS) sm[i] = MOD[b * 6144 + 3072 + i];
    }
    __syncthreads();
    const float* src = X.x; const bf16_t* srcb = WSP(bf16_t, WS_X1); const float* g = which == 0 ? X.g1 : X.g2;
    bf16_t* H = WSP(bf16_t, WS_H);
    for (int r = X.wave; r < rows_per_wg; r += NWAVES) {
        const int row = row0 + r;
        f32x4 v[2][2]; float s = 0.f;
#pragma unroll
        for (int j = 0; j < 2; ++j) { const int col = 8 * X.lane + 512 * j;
            if (which == 0) { v[j][0] = *(const f32x4*)(src + (size_t)row * D + col); v[j][1] = *(const f32x4*)(src + (size_t)row * D + col + 4); }
            else { const u32x4 wv = *(const u32x4*)(srcb + (size_t)row * D + col); v[j][0] = (f32x4){bflo(wv.x), bfhi(wv.x), bflo(wv.y), bfhi(wv.y)}; v[j][1] = (f32x4){bflo(wv.z), bfhi(wv.z), bflo(wv.w), bfhi(wv.w)}; }
#pragma unroll
            for (int q = 0; q < 2; ++q) s += (v[j][q].x * v[j][q].x + v[j][q].y * v[j][q].y) + (v[j][q].z * v[j][q].z + v[j][q].w * v[j][q].w); }
        const float rstd = rsqrtf(wave_sum(s) * (1.f / D) + EPS);
#pragma unroll
        for (int j = 0; j < 2; ++j) { const int col = 8 * X.lane + 512 * j; float y[8];
#pragma unroll
            for (int q = 0; q < 2; ++q) { const f32x4 gg = *(const f32x4*)(g + col + 4 * q), sh = *(const LAS f32x4*)(sm + col + 4 * q), sc = *(const LAS f32x4*)(sm + 1024 + col + 4 * q);
#pragma unroll
                for (int e = 0; e < 4; ++e) y[4 * q + e] = v[j][q][e] * rstd * gg[e] * (1.f + sc[e]) + sh[e]; }
            u32x4 hw; hw.x = pk2(y[0], y[1]); hw.y = pk2(y[2], y[3]); hw.z = pk2(y[4], y[5]); hw.w = pk2(y[6], y[7]);
            if (which == 1) { st_wt16(H + (size_t)row * D + col, hw);
                st_wt8(WSP(unsigned char, WS_H8) + (size_t)row * D + col, (unsigned long long)pk4_fp8(y[0], y[1], y[2], y[3]) | ((unsigned long long)pk4_fp8(y[4], y[5], y[6], y[7]) << 32)); }
            else *(u32x4*)(H + (size_t)row * D + col) = hw; }
    }
    __syncthreads();
}

struct RegSched {
    static constexpr bool HALFSKIP = false;
    const char* A; const char* Bt; size_t a_tile, b_tile; int nM, nN, G, c;
    __device__ __forceinline__ bool next(int i, pg8::Unit& u) const {
        const int L = i * G + c; if (L >= nM * nN) return false;
        int pm, pn; pg8::swz_tile(L, nM, nN, pm, pn);
        u.a = A + (size_t)pm * a_tile; u.b = Bt + (size_t)pn * b_tile; u.rows = nullptr; u.pm = pm; u.pn = pn; u.aux = 0; u.nvalid = 256; return true;
    }
};
struct TwoPartSched {      static constexpr bool HALFSKIP = false;
    const char* Y; const char* Wa; const char* Wb; int nM, nN, G, c;
    __device__ __forceinline__ bool next(int i, pg8::Unit& u) const {
        const int L = (i >> 1) * G + c, part = i & 1; if (L >= nM * nN) return false;
        int pm, pn; pg8::swz_tile(L, nM, nN, pm, pn);
        u.a = Y + (size_t)pm * 256 * 2048 + part * 1024; u.b = (part ? Wb : Wa) + (size_t)pn * 256 * 1024; u.rows = nullptr; u.pm = pm; u.pn = pn; u.aux = part; u.nvalid = 256; return true;
    }
};
struct MoeSched {
    static constexpr bool HALFSKIP = true;
    const LAS int* tbl; const LAS int* cnts; int nent; const char* A; const char* W; const int* lists; int ncol  , wtile  , wexp  , atile  , G, c;
    __device__ __forceinline__ bool next(int i, pg8::Unit& u) const {
        const int un = i * (G >> 3) + (c >> 3); if (un >= nent * ncol) return false;
        const int pn = un % ncol; const int ent = __builtin_amdgcn_readfirstlane(tbl[un / ncol]), e = (ent >> 7) & 511, r = ent & 127, rt = ent >> 16;
        u.a = A + (size_t)rt * atile; u.b = W + (size_t)e * wexp + (size_t)pn * wtile; u.rows = lists + (size_t)e * 16384 + r * 256;
        u.pm = rt; u.pn = pn; u.aux = e; const int left = __builtin_amdgcn_readfirstlane(cnts[e]) - r * 256; u.nvalid = left < 256 ? left : 256; return true;
    }
};

struct EpiInproj {
    static constexpr bool PERM = true;
    static constexpr bool BJADJ = true;
    bf16_t* PROJ; float* LOGF; const float* LB; const float* ROPE; unsigned char* G8; unsigned char* QK8;
    __device__ __forceinline__ bool keep(const pg8::Unit&) const { return false; }
    __device__ __forceinline__ void operator()(f32x4 (&acc)[2][2][4][2], const pg8::Unit& u, int wr, int wc, int fr, int fq) const {
        const int pn = u.pn;
        const int mode = pn < 2 ? 0 : pn < 4 ? 1 : pn < 6 ? 0 : pn < 8 ? 2 : pn < 20 ? 3 : pn < 26 ? 5 : 4;
        const int row0 = u.pm * 256 + wr * 64 + fr, colb = pn * 256 + wc * 64 + 8 * fq;
        const bool rot3 = (mode == 3);
        const bool odd = fq & 1; const int colw = pn * 256 + wc * 64 + (fq & 1) * 32 + (fq >> 1) * 16;
#pragma unroll
        for (int ai = 0; ai < 2; ++ai)
#pragma unroll
            for (int m = 0; m < 4; ++m) {
                const int row = row0 + ai * 128 + m * 16;
                f32x4 cs0, cs1, sn0, sn1;
                if (rot3) { const f32x4* rp = (const f32x4*)(ROPE + (size_t)row * 16); cs0 = rp[0]; cs1 = rp[1]; sn0 = rp[2]; sn1 = rp[3]; }
                u32x2 p8[2];
#pragma unroll
                for (int bj = 0; bj < 2; ++bj) {
                    const int col = colb + bj * 32; const bool rot = rot3 && bj == 0;
                    f32x4 v0 = acc[ai][bj][m][0], v1 = acc[ai][bj][m][1];
                    if (mode == 1) {
                        const int cf = col - 512; const f32x4 l0 = *(const f32x4*)(LB + cf), l1 = *(const f32x4*)(LB + cf + 4);
                        f32x4 lf0, lf1;
#pragma unroll
                        for (int j = 0; j < 4; ++j) { float sg = sigmoidf_(v0[j]); float f = l0[j] + (1.f - l0[j]) * sg; lf0[j] = fast_logf(f); v0[j] = (1.f - l0[j]) * (1.f - sg);
                            sg = sigmoidf_(v1[j]); f = l1[j] + (1.f - l1[j]) * sg; lf1[j] = fast_logf(f); v1[j] = (1.f - l1[j]) * (1.f - sg); }
                        acc[ai][bj][m][0] = lf0; acc[ai][bj][m][1] = lf1;
                    } else if (mode == 2) {
#pragma unroll
                        for (int j = 0; j < 4; ++j) { v0[j] = v0[j] * sigmoidf_(v0[j]); v1[j] = v1[j] * sigmoidf_(v1[j]); }
                    } else if (mode == 4) {
#pragma unroll
                        for (int j = 0; j < 4; ++j) { v0[j] = sigmoidf_(v0[j]); v1[j] = sigmoidf_(v1[j]); }
                    } else if (rot) {
                        f32x4 p0, p1;
#pragma unroll
                        for (int j = 0; j < 4; ++j) { p0[j] = __shfl_xor(v0[j], 16); p1[j] = __shfl_xor(v1[j], 16); }
                        if (fq == 0) { v0 = v0 * cs0 - p0 * sn0; v1 = v1 * cs1 - p1 * sn1; }
                        else if (fq == 1) { v0 = v0 * cs0 + p0 * sn0; v1 = v1 * cs1 + p1 * sn1; }
                    }
                    if (mode == 4) {
                        int g0 = 0, g1 = 0;
#pragma unroll
                        for (int j = 0; j < 4; ++j) { g0 = __builtin_amdgcn_cvt_pk_u8_f32(fmaxf(v0[j] * 255.0f, 1.0f), j, g0); g1 = __builtin_amdgcn_cvt_pk_u8_f32(fmaxf(v1[j] * 255.0f, 1.0f), j, g1); }
                        p8[bj] = (u32x2){(unsigned)g0, (unsigned)g1};
                        continue; }
                    if (mode == 3 || mode == 5) {
                        p8[bj] = (u32x2){pk4_fp8(v0[0], v0[1], v0[2], v0[3]), pk4_fp8(v1[0], v1[1], v1[2], v1[3])};
                        continue; }
                    u32x4 w; w.x = pg8::cvt_pk_bf16(v0[0], v0[1]); w.y = pg8::cvt_pk_bf16(v0[2], v0[3]); w.z = pg8::cvt_pk_bf16(v1[0], v1[1]); w.w = pg8::cvt_pk_bf16(v1[2], v1[3]);
                    *(u32x4*)(PROJ + (size_t)row * INW + col) = w;
                }
                if (mode >= 3) {
                    const u32x2 snd = odd ? p8[0] : p8[1];
                    u32x2 rcv; rcv.x = (unsigned)__shfl_xor((int)snd.x, 16); rcv.y = (unsigned)__shfl_xor((int)snd.y, 16);
                    const u32x4 w = odd ? (u32x4){rcv.x, rcv.y, p8[1].x, p8[1].y} : (u32x4){p8[0].x, p8[0].y, rcv.x, rcv.y};
                    if (mode == 4) *(u32x4*)(G8 + (size_t)row * 2048 + (colw - C_GA)) = w;
                    else *(u32x4*)(QK8 + (size_t)row * 4608 + (colw - C_AQ)) = w;
                }
            }
        if (mode == 1) {
            const int lane = fq * 16 + fr;
#pragma unroll
            for (int ai = 0; ai < 2; ++ai)
#pragma unroll
                for (int bj = 0; bj < 2; ++bj)
#pragma unroll
                    for (int n = 0; n < 2; ++n)
#pragma unroll
                        for (int j = 0; j < 4; ++j) { float carry = 0.f;
#pragma unroll
                            for (int m = 0; m < 4; ++m) { float v = acc[ai][bj][m][n][j];
                                v += __builtin_bit_cast(float, __builtin_amdgcn_update_dpp(0, __builtin_bit_cast(int, v), 0x111, 0xF, 0xF, true));
                                v += __builtin_bit_cast(float, __builtin_amdgcn_update_dpp(0, __builtin_bit_cast(int, v), 0x112, 0xF, 0xF, true));
                                v += __builtin_bit_cast(float, __builtin_amdgcn_update_dpp(0, __builtin_bit_cast(int, v), 0x114, 0xF, 0xF, true));
                                v += __builtin_bit_cast(float, __builtin_amdgcn_update_dpp(0, __builtin_bit_cast(int, v), 0x118, 0xF, 0xF, true));
                                v += carry; acc[ai][bj][m][n][j] = v; carry = __shfl(v, (lane & 48) | 15); } }
#pragma unroll
            for (int ai = 0; ai < 2; ++ai)
#pragma unroll
                for (int m = 0; m < 4; ++m)
#pragma unroll
                    for (int bj = 0; bj < 2; ++bj) { float* lp = LOGF + (size_t)(row0 + ai * 128 + m * 16) * 512 + (colb + bj * 32 - 512); *(f32x4*)lp = acc[ai][bj][m][0]; *(f32x4*)(lp + 4) = acc[ai][bj][m][1]; }
        }
    }
};
__device__ __forceinline__ void gate8(u32x2 w, f32x4& lo, f32x4& hi) {
    constexpr float s = 1.0f / 255.0f;
    lo = (f32x4){(float)(w.x & 255u), (float)((w.x >> 8) & 255u), (float)((w.x >> 16) & 255u), (float)(w.x >> 24)} * s;
    hi = (f32x4){(float)(w.y & 255u), (float)((w.y >> 8) & 255u), (float)((w.y >> 16) & 255u), (float)(w.y >> 24)} * s;
}
struct EpiMixed {
    static constexpr bool PERM = true;
    const unsigned char* G8; bf16_t* MIXED;
    __device__ __forceinline__ bool keep(const pg8::Unit& u) const { return u.aux == 0; }
    __device__ __forceinline__ void operator()(f32x4 (&acc)[2][2][4][2], const pg8::Unit& u, int wr, int wc, int fr, int fq) const {
        const int row0 = u.pm * 256 + wr * 64 + fr, colb = u.pn * 256 + wc * 32 + 8 * fq;
#pragma unroll
        for (int ai = 0; ai < 2; ++ai)
#pragma unroll
            for (int m = 0; m < 4; ++m) {
                const int row = row0 + ai * 128 + m * 16;
#pragma unroll
                for (int bj = 0; bj < 2; ++bj) {
                    const int col = colb + bj * 128;
                    f32x4 b0, b1; gate8(*(const u32x2*)(G8 + (size_t)row * 2048 + 1024 + col), b0, b1);
                    if (u.aux == 0) {
                        f32x4 a0, a1; gate8(*(const u32x2*)(G8 + (size_t)row * 2048 + col), a0, a1);
#pragma unroll
                        for (int j = 0; j < 4; ++j) { acc[ai][bj][m][0][j] *= a0[j] * __builtin_amdgcn_rcpf(b0[j]); acc[ai][bj][m][1][j] *= a1[j] * __builtin_amdgcn_rcpf(b1[j]); }
                    } else {
                        const f32x4 v0 = acc[ai][bj][m][0] * b0, v1 = acc[ai][bj][m][1] * b1;
                        u32x4 w; w.x = pg8::cvt_pk_bf16(v0[0], v0[1]); w.y = pg8::cvt_pk_bf16(v0[2], v0[3]); w.z = pg8::cvt_pk_bf16(v1[0], v1[1]); w.w = pg8::cvt_pk_bf16(v1[2], v1[3]);
                        st_wt16(MIXED + (size_t)row * D + col, w);
                    }
                }
            }
    }
};
struct EpiOutproj {
    static constexpr bool PERM = true;
    const float* x; const float* MOD; bf16_t* X1;
    __device__ __forceinline__ bool keep(const pg8::Unit&) const { return false; }
    __device__ __forceinline__ void operator()(f32x4 (&acc)[2][2][4][2], const pg8::Unit& u, int wr, int wc, int fr, int fq) const {
        const int row0 = u.pm * 256 + wr * 64 + fr, colb = u.pn * 256 + wc * 32 + 8 * fq;
        const int b = (u.pm * 256) / SEQ;
#pragma unroll
        for (int bj = 0; bj < 2; ++bj) {
            const int col = colb + bj * 128;
            const f32x4 g0 = *(const f32x4*)(MOD + b * 6144 + 2048 + col), g1 = *(const f32x4*)(MOD + b * 6144 + 2048 + col + 4);
#pragma unroll
            for (int ai = 0; ai < 2; ++ai)
#pragma unroll
                for (int m = 0; m < 4; ++m) { const size_t off = (size_t)(row0 + ai * 128 + m * 16) * D + col;
                    const f32x4 v0 = *(const f32x4*)(x + off) + g0 * acc[ai][bj][m][0], v1 = *(const f32x4*)(x + off + 4) + g1 * acc[ai][bj][m][1];
                    u32x4 w; w.x = pg8::cvt_pk_bf16(v0[0], v0[1]); w.y = pg8::cvt_pk_bf16(v0[2], v0[3]); w.z = pg8::cvt_pk_bf16(v1[0], v1[1]); w.w = pg8::cvt_pk_bf16(v1[2], v1[3]);
                    st_wt16(X1 + off, w); }
        }
    }
};
struct EpiOutNorm {
    static constexpr bool PERM = true;
    const float* x; const float* MOD; const float* g2; bf16_t* X1; bf16_t* H; unsigned char* H8; float* XB; unsigned* cnt; LAS unsigned char* sl;
    __device__ __forceinline__ bool keep(const pg8::Unit&) const { return false; }
    __device__ __forceinline__ void operator()(f32x4 (&acc)[2][2][4][2], const pg8::Unit& u, int wr, int wc, int fr, int fq) const {
        const int tid = threadIdx.x;
        const int rl0 = wr * 64 + fr, row0 = u.pm * 256 + rl0, colb = u.pn * 256 + wc * 32 + 8 * fq;
        const int b = (u.pm * 256) / SEQ;
        LAS float* Pt = (LAS float*)sl; LAS float* Rs = (LAS float*)(sl + 4096);
#pragma unroll
        for (int bj = 0; bj < 2; ++bj) {
            const int col = colb + bj * 128;
            const f32x4 g0 = *(const f32x4*)(MOD + b * 6144 + 2048 + col), g1 = *(const f32x4*)(MOD + b * 6144 + 2048 + col + 4);
#pragma unroll
            for (int ai = 0; ai < 2; ++ai)
#pragma unroll
                for (int m = 0; m < 4; ++m) { const size_t off = (size_t)(row0 + ai * 128 + m * 16) * D + col;
                    acc[ai][bj][m][0] = *(const f32x4*)(x + off) + g0 * acc[ai][bj][m][0]; acc[ai][bj][m][1] = *(const f32x4*)(x + off + 4) + g1 * acc[ai][bj][m][1];
                    asm volatile("" : "+v"(acc[ai][bj][m][0]), "+v"(acc[ai][bj][m][1]));
                    if (m & 1) asm volatile("" ::: "memory"); }
        }
#pragma unroll
        for (int ai = 0; ai < 2; ++ai)
#pragma unroll
            for (int m = 0; m < 4; ++m) { float q = 0.f;
#pragma unroll
                for (int bj = 0; bj < 2; ++bj)
#pragma unroll
                    for (int n = 0; n < 2; ++n) { const f32x4 v = acc[ai][bj][m][n]; q += (v[0] * v[0] + v[1] * v[1]) + (v[2] * v[2] + v[3] * v[3]); }
                q += __shfl_xor(q, 16); q += __shfl_xor(q, 32);
                if (fq == 0) Pt[(ai * 128 + rl0 + m * 16) * 4 + wc] = q; }
        asm volatile("s_waitcnt lgkmcnt(0)" ::: "memory"); __builtin_amdgcn_s_barrier(); asm volatile("" ::: "memory");
        if (tid < 256) { const f32x4 p = *(const LAS f32x4*)(Pt + tid * 4); st_wt4(XB + ((size_t)u.pm * 256 + tid) * 4 + u.pn, __builtin_bit_cast(unsigned, (p[0] + p[1]) + (p[2] + p[3]))); }
        asm volatile("s_waitcnt vmcnt(0)" ::: "memory"); __builtin_amdgcn_s_barrier(); asm volatile("" ::: "memory");
        if (tid == 0) { unsigned* p = cnt + (size_t)u.pm * 64; (void)xb_add(p, 1u); unsigned sp = 0u;
            while (xb_ld(p) < 4u) { __builtin_amdgcn_s_sleep(2); if (++sp > (1u << 22)) break; }
            __builtin_amdgcn_fence(__ATOMIC_ACQUIRE, "agent"); asm volatile("s_waitcnt vmcnt(0)" ::: "memory"); }
        __builtin_amdgcn_s_barrier(); asm volatile("" ::: "memory");
        if (tid < 256) { const f32x4 q = *(const f32x4*)(XB + ((size_t)u.pm * 256 + tid) * 4); Rs[tid] = rsqrtf(((q[0] + q[1]) + (q[2] + q[3])) * (1.f / D) + EPS); }
        asm volatile("s_waitcnt vmcnt(0) lgkmcnt(0)" ::: "memory"); __builtin_amdgcn_s_barrier(); asm volatile("" ::: "memory");
#pragma unroll
        for (int bj = 0; bj < 2; ++bj) {
            const int col = colb + bj * 128;
            f32x4 gg[2], sc[2], sh[2];
#pragma unroll
            for (int q = 0; q < 2; ++q) { gg[q] = *(const f32x4*)(g2 + col + 4 * q); sh[q] = *(const f32x4*)(MOD + b * 6144 + 3072 + col + 4 * q); sc[q] = *(const f32x4*)(MOD + b * 6144 + 4096 + col + 4 * q) + 1.0f; gg[q] = gg[q] * sc[q]; }
#pragma unroll
            for (int ai = 0; ai < 2; ++ai)
#pragma unroll
                for (int m = 0; m < 4; ++m) { const int rl = ai * 128 + rl0 + m * 16; const size_t off = (size_t)(u.pm * 256 + rl) * D + col; const float rs = Rs[rl];
                    const f32x4 v0 = acc[ai][bj][m][0], v1 = acc[ai][bj][m][1];
                    u32x4 w; w.x = pg8::cvt_pk_bf16(v0[0], v0[1]); w.y = pg8::cvt_pk_bf16(v0[2], v0[3]); w.z = pg8::cvt_pk_bf16(v1[0], v1[1]); w.w = pg8::cvt_pk_bf16(v1[2], v1[3]);
                    *(u32x4*)(X1 + off) = w;
                    const f32x4 h0 = v0 * rs * gg[0] + sh[0], h1 = v1 * rs * gg[1] + sh[1];
                    u32x4 hw; hw.x = pg8::cvt_pk_bf16(h0[0], h0[1]); hw.y = pg8::cvt_pk_bf16(h0[2], h0[3]); hw.z = pg8::cvt_pk_bf16(h1[0], h1[1]); hw.w = pg8::cvt_pk_bf16(h1[2], h1[3]);
                    st_wt16(H + off, hw);
                    st_wt8(H8 + off, (unsigned long long)pk4_fp8(h0[0], h0[1], h0[2], h0[3]) | ((unsigned long long)pk4_fp8(h1[0], h1[1], h1[2], h1[3]) << 32));
                    asm volatile("" ::: "memory"); }
        }
    }
};
struct EpiRouter {
    static constexpr bool PERM = false;
    float* LOGITS4;
    __device__ __forceinline__ bool keep(const pg8::Unit&) const { return false; }
    __device__ __forceinline__ void operator()(f32x4 (&acc)[2][2][4][2], const pg8::Unit& u, int wr, int wc, int fr, int fq) const {
        const int row0 = u.pm * 256 + wr * 64 + fr, colb = wc * 32 + 4 * fq;
        float* base = LOGITS4 + (size_t)u.aux * T * 256;
#pragma unroll
        for (int ai = 0; ai < 2; ++ai)
#pragma unroll
            for (int m = 0; m < 4; ++m)
#pragma unroll
                for (int bj = 0; bj < 2; ++bj)
#pragma unroll
                    for (int n = 0; n < 2; ++n) st_wt16(base + (size_t)(row0 + ai * 128 + m * 16) * 256 + colb + bj * 128 + n * 16, __builtin_bit_cast(u32x4, acc[ai][bj][m][n]));
    }
};
struct RouterSched {
    static constexpr bool HALFSKIP = false;
    const char* A; const char* Bt; int G, c;
    __device__ __forceinline__ bool next(int i, pg8::Unit& u) const {
        const int L = i * G + c; if (L >= 256) return false;
        const int pm = L >> 2, ks = L & 3;
        u.a = A + (size_t)pm * 256 * 2048 + ks * 512; u.b = Bt + ks * 512; u.rows = nullptr; u.pm = pm; u.pn = 0; u.aux = ks; u.nvalid = 256; return true;
    }
};
struct EpiGU {
    static constexpr bool PERM = true;
    unsigned char* ACT;
    __device__ __forceinline__ bool keep(const pg8::Unit&) const { return false; }
    __device__ __forceinline__ void operator()(f32x4 (&acc)[2][2][4][2], const pg8::Unit& u, int wr, int wc, int fr, int fq) const {
        const int rl0 = wr * 64 + fr, col = u.pn * 128 + wc * 32 + 8 * fq;
        constexpr float is = 1.0f / WGU_SCALE;
#pragma unroll
        for (int ai = 0; ai < 2; ++ai)
#pragma unroll
            for (int m = 0; m < 4; ++m) {
                const int rl = rl0 + ai * 128 + m * 16;
                f32x4 v0, v1;
#pragma unroll
                for (int j = 0; j < 4; ++j) { const float a0 = acc[ai][0][m][0][j] * is, a1 = acc[ai][0][m][1][j] * is;
                    v0[j] = a0 * sigmoidf_(a0) * (acc[ai][1][m][0][j] * is); v1[j] = a1 * sigmoidf_(a1) * (acc[ai][1][m][1][j] * is); }
                *(u32x2*)(ACT + ((size_t)u.pm * 256 + rl) * EFF + col) = (u32x2){pk4_fp8(v0[0], v0[1], v0[2], v0[3]), pk4_fp8(v1[0], v1[1], v1[2], v1[3])};
                asm volatile("" ::: "memory");
            }
    }
};
struct EpiDown {
    static constexpr bool PERM = true;
    static constexpr bool BJADJ = true;
    unsigned char* YBUF; const float* GATEW;
    __device__ __forceinline__ bool keep(const pg8::Unit&) const { return false; }
    __device__ __forceinline__ void operator()(f32x4 (&acc)[2][2][4][2], const pg8::Unit& u, int wr, int wc, int fr, int fq) const {
        const int rl0 = wr * 64 + fr, colw = u.pn * 256 + wc * 64 + (fq & 1) * 32 + (fq >> 1) * 16;
        const bool odd = fq & 1;
#pragma unroll
        for (int ai = 0; ai < 2; ++ai)
#pragma unroll
            for (int m = 0; m < 4; ++m) {
                const int rl = rl0 + ai * 128 + m * 16;
                const bool ok = rl < u.nvalid;
                int slot = 0; float gw = 0.f;
                if (ok) { slot = u.rows[rl]; gw = GATEW[slot] * (YSCALE / WD_SCALE); }
                u32x2 p[2];
#pragma unroll
                for (int bj = 0; bj < 2; ++bj) { const f32x4 v0 = acc[ai][bj][m][0] * gw, v1 = acc[ai][bj][m][1] * gw;
                    p[bj] = (u32x2){pk4_fp8(v0[0], v0[1], v0[2], v0[3]), pk4_fp8(v1[0], v1[1], v1[2], v1[3])}; }
                const u32x2 snd = odd ? p[0] : p[1];
                u32x2 rcv; rcv.x = (unsigned)__shfl_xor((int)snd.x, 16); rcv.y = (unsigned)__shfl_xor((int)snd.y, 16);
                const u32x4 w = odd ? (u32x4){rcv.x, rcv.y, p[1].x, p[1].y} : (u32x4){p[0].x, p[0].y, rcv.x, rcv.y};
                if (ok) *(u32x4*)(YBUF + (size_t)slot * D + colw) = w;
                asm volatile("" ::: "memory");
            }
    }
};

#define MFMA16(a, b, c) __builtin_amdgcn_mfma_f32_16x16x32_bf16((a), (b), (c), 0, 0, 0)
#define MFMA32(a, b, c) __builtin_amdgcn_mfma_f32_32x32x16_bf16((a), (b), (c), 0, 0, 0)
__device__ __forceinline__ s16x4 tr16(const LAS unsigned char* p) { return __builtin_amdgcn_ds_read_tr16_b64_v4i16((LAS s16x4*)p); }
__device__ __forceinline__ bf16x8 cat8(s16x4 a, s16x4 b) { bf16x8 r; r[0] = a[0]; r[1] = a[1]; r[2] = a[2]; r[3] = a[3]; r[4] = b[0]; r[5] = b[1]; r[6] = b[2]; r[7] = b[3]; return r; }
__device__ __forceinline__ u32x4 pack8(const float (&v)[8]) { u32x4 w; w.x = pg8::cvt_pk_bf16(v[0], v[1]); w.y = pg8::cvt_pk_bf16(v[2], v[3]); w.z = pg8::cvt_pk_bf16(v[4], v[5]); w.w = pg8::cvt_pk_bf16(v[6], v[7]); return w; }
__device__ __forceinline__ void unpack8(u32x4 w, float (&v)[8]) { v[0] = bflo(w.x); v[1] = bfhi(w.x); v[2] = bflo(w.y); v[3] = bfhi(w.y); v[4] = bflo(w.z); v[5] = bfhi(w.z); v[6] = bflo(w.w); v[7] = bfhi(w.w); }
__device__ __forceinline__ int swzA(int row) { return (row & 3) | (((row >> 3) & 1) << 2); }
__device__ __forceinline__ void hgrn_kv_unit(Ctx& X, int bn) {
    const int t0 = bn * 64;
    const bf16_t* PROJ = WSP(bf16_t, WS_PROJ); const float* BC = WSP(float, WS_LOGF);
#pragma unroll 2
    for (int j = 0; j < 8; ++j) {
        const int p = X.tid + NTHREADS * j, row = p >> 6, c64 = p & 63, h = c64 >> 4, ch = c64 & 15;
        const size_t prow = (size_t)(t0 + row) * INW + h * 128 + 8 * ch;
        const u32x4 kraw = *(const u32x4*)(PROJ + prow + C_HK), vraw = *(const u32x4*)(PROJ + prow + C_HV);
        const float* bp = BC + (size_t)(t0 + row) * 512 + h * 128 + 8 * ch; const float* bl = BC + (size_t)(t0 + 63) * 512 + h * 128 + 8 * ch;
        const f32x4 b0 = *(const f32x4*)bp, b1 = *(const f32x4*)(bp + 4), l0 = *(const f32x4*)bl, l1 = *(const f32x4*)(bl + 4);
        float kv[8]; unpack8(kraw, kv);
#pragma unroll
        for (int e = 0; e < 4; ++e) { kv[e] *= __expf(l0[e] - b0[e]); kv[4 + e] *= __expf(l1[e] - b1[e]); }
        const int off = row * 256 + (((ch >> 1) ^ swzA(row)) * 32) + (ch & 1) * 16;
        *(LAS u32x4*)(X.lds + h * 32768 + off) = vraw; *(LAS u32x4*)(X.lds + h * 32768 + 16384 + off) = pack8(kv);
    }
    WSP(float, WS_DECAY)[bn * 512 + X.tid] = __expf(BC[(size_t)(t0 + 63) * 512 + X.tid]);
    __syncthreads();
    const int l = X.lane, w = X.wave, fr = l & 15, fq = l >> 4, r = fr >> 2, p4 = l & 3, h = w >> 1, vt0 = 4 * (w & 1);
    const LAS unsigned char* VI = X.lds + h * 32768; const LAS unsigned char* KI = VI + 16384;
    bf16x8 af[4][2];
#pragma unroll
    for (int vt = 0; vt < 4; ++vt)
#pragma unroll
        for (int kk = 0; kk < 2; ++kk) { const int r0 = 32 * kk + 8 * fq + r, r1 = r0 + 4;
            af[vt][kk] = cat8(tr16(VI + r0 * 256 + (((vt0 + vt) ^ swzA(r0)) * 32) + p4 * 8), tr16(VI + r1 * 256 + (((vt0 + vt) ^ swzA(r1)) * 32) + p4 * 8)); }
    bf16_t* KVT = WSP(bf16_t, WS_KVT) + (size_t)(bn * 4 + h) * 16384;
#pragma unroll 2
    for (int ct = 0; ct < 8; ++ct) {
        bf16x8 bfr[2];
#pragma unroll
        for (int kk = 0; kk < 2; ++kk) { const int r0 = 32 * kk + 8 * fq + r, r1 = r0 + 4;
            bfr[kk] = cat8(tr16(KI + r0 * 256 + ((ct ^ swzA(r0)) * 32) + p4 * 8), tr16(KI + r1 * 256 + ((ct ^ swzA(r1)) * 32) + p4 * 8)); }
#pragma unroll
        for (int vt = 0; vt < 4; ++vt) { f32x4 acc = {0.f, 0.f, 0.f, 0.f}; acc = MFMA16(bfr[0], af[vt][0], acc); acc = MFMA16(bfr[1], af[vt][1], acc);
            u32x2 wv; wv.x = pg8::cvt_pk_bf16(acc[0], acc[1]); wv.y = pg8::cvt_pk_bf16(acc[2], acc[3]);
            *(u32x2*)(KVT + (16 * (vt0 + vt) + fr) * 128 + 16 * ct + 4 * fq) = wv; }
    }
    __syncthreads();
}
__device__ __forceinline__ void hgrn_passB(Ctx& X) {
    const unsigned* KVT = WSP(unsigned, WS_KVT); const float* DECAY = WSP(float, WS_DECAY); unsigned* SPT = WSP(unsigned, WS_SPT);
    const int gt = X.wg * NTHREADS + X.tid, NGT = X.G * NTHREADS;
    for (int item = gt; item < 16 * 128 * 64; item += NGT) {
        const int bh = item >> 13, rem = item & 8191, vd = rem >> 6, c = (rem & 63) * 2, b = bh >> 2, h = bh & 3;
        float s0 = 0.f, s1 = 0.f;
#pragma unroll 8
        for (int n = 0; n < 64; ++n) {
            const int unit = (b * 64 + n) * 4 + h;
            const unsigned kw = KVT[((size_t)unit * 16384 + vd * 128 + c) >> 1]; const f32x2 kv = {bflo(kw), bfhi(kw)};
            const f32x2 dc = *(const f32x2*)(DECAY + unit * 128 + c);
            SPT[((size_t)unit * 16384 + vd * 128 + c) >> 1] = pk2(s0, s1);
            s0 = dc.x * s0 + kv.x; s1 = dc.y * s1 + kv.y;
        }
    }
}
__device__ __forceinline__ void hgrn_out_unit(Ctx& X, int u2) {
    const int bn = u2 >> 1, hp = u2 & 1, t0 = bn * 64;
    const bf16_t* PROJ = WSP(bf16_t, WS_PROJ); const float* BCg = WSP(float, WS_LOGF);
#pragma unroll 2
    for (int j = 0; j < 4; ++j) { const int p = X.tid + NTHREADS * j, row = p >> 5, c32 = p & 31, hh = c32 >> 4, ch = c32 & 15, h = 2 * hp + hh;
        const size_t prow = (size_t)(t0 + row) * INW + h * 128 + 8 * ch;
        const u32x4 qraw = *(const u32x4*)(PROJ + prow + C_HQ), kraw = *(const u32x4*)(PROJ + prow + C_HK), vraw = *(const u32x4*)(PROJ + prow + C_HV);
        const float* bp = BCg + (size_t)(t0 + row) * 512 + h * 128 + 8 * ch; const float* br = BCg + (size_t)(t0 + 32) * 512 + h * 128 + 8 * ch;
        const f32x4 b0 = *(const f32x4*)bp, b1 = *(const f32x4*)(bp + 4), r0 = *(const f32x4*)br, r1 = *(const f32x4*)(br + 4);
        float qv[8], kv[8], a[8], bq[8]; unpack8(qraw, qv); unpack8(kraw, kv);
#pragma unroll
        for (int e = 0; e < 4; ++e) { const float e0 = __expf(b0[e] - r0[e]), e1 = __expf(b1[e] - r1[e]);
            a[e] = qv[e] * e0; a[4 + e] = qv[4 + e] * e1; kv[e] *= __builtin_amdgcn_rcpf(e0); kv[4 + e] *= __builtin_amdgcn_rcpf(e1);
            bq[e] = qv[e] * __expf(b0[e]); bq[4 + e] = qv[4 + e] * __expf(b1[e]); }
        LAS unsigned char* hb = X.lds + hh * 65536; const int o16 = row * 256 + ((ch ^ (row & 15)) * 16);
        *(LAS u32x4*)(hb + o16) = pack8(a); *(LAS u32x4*)(hb + 16384 + o16) = pack8(kv); *(LAS u32x4*)(hb + 32768 + o16) = pack8(bq);
        *(LAS u32x4*)(hb + 49152 + row * 256 + (((ch >> 1) ^ (row & 7)) * 32) + (ch & 1) * 16) = vraw; }
    const int l = X.lane, w = X.wave, fr = l & 15, fq = l >> 4, r = fr >> 2, p4 = l & 3, hh = w >> 2, h = 2 * hp + hh, ti = w & 3;
    const int tq = 16 * ti + fr;
    const bf16_t* SPT = WSP(bf16_t, WS_SPT) + (size_t)(bn * 4 + h) * 16384;
    __syncthreads();
    const LAS unsigned char* QSI = X.lds + hh * 65536; const LAS unsigned char* KSI = QSI + 16384; const LAS unsigned char* QNI = QSI + 32768; const LAS unsigned char* VI = QSI + 49152;
    bf16x8 QS[4];
#pragma unroll
    for (int ks = 0; ks < 4; ++ks) QS[ks] = *(const LAS bf16x8*)(QSI + tq * 256 + (((4 * ks + fq) ^ (tq & 15)) * 16));
    f32x4 ST[4];
#pragma unroll
    for (int si = 0; si < 4; ++si) {
        f32x4 acc = {0.f, 0.f, 0.f, 0.f};
        if (si <= ti) {
            const int sr = 16 * si + fr;
#pragma unroll
            for (int ks = 0; ks < 4; ++ks) { const bf16x8 kf = *(const LAS bf16x8*)(KSI + sr * 256 + (((4 * ks + fq) ^ (sr & 15)) * 16)); acc = MFMA16(kf, QS[ks], acc); }
            if (si == ti) {
#pragma unroll
                for (int q = 0; q < 4; ++q) acc[q] = (4 * fq + q <= fr) ? acc[q] : 0.f; }
        }
        ST[si] = acc;
    }
    f32x4 o[8];
#pragma unroll
    for (int vt = 0; vt < 8; ++vt) o[vt] = (f32x4){0.f, 0.f, 0.f, 0.f};
#pragma unroll
    for (int kk = 0; kk < 2; ++kk) {
        if (2 * kk <= ti) {
            float pv[8];
#pragma unroll
            for (int q = 0; q < 4; ++q) { pv[q] = ST[2 * kk][q]; pv[4 + q] = ST[2 * kk + 1][q]; }
            const bf16x8 pf = __builtin_bit_cast(bf16x8, pack8(pv));
            const int r0 = 32 * kk + 4 * fq + r, r1 = r0 + 16;
#pragma unroll
            for (int vt = 0; vt < 8; ++vt) { const bf16x8 va = cat8(tr16(VI + r0 * 256 + ((vt ^ (r0 & 7)) * 32) + p4 * 8), tr16(VI + r1 * 256 + ((vt ^ (r1 & 7)) * 32) + p4 * 8));
                o[vt] = MFMA16(va, pf, o[vt]); }
        }
    }
#pragma unroll
    for (int ks = 0; ks < 4; ++ks) { const bf16x8 qn = *(const LAS bf16x8*)(QNI + tq * 256 + (((4 * ks + fq) ^ (tq & 15)) * 16));
#pragma unroll
        for (int vt = 0; vt < 8; ++vt) { const bf16x8 sa = *(const bf16x8*)(SPT + (16 * vt + fr) * 128 + 32 * ks + 8 * fq); o[vt] = MFMA16(sa, qn, o[vt]); } }
    float ss = 0.f;
#pragma unroll
    for (int vt = 0; vt < 8; ++vt) ss += (o[vt][0] * o[vt][0] + o[vt][1] * o[vt][1]) + (o[vt][2] * o[vt][2] + o[vt][3] * o[vt][3]);
    ss += __shfl_xor(ss, 16); ss += __shfl_xor(ss, 32);
    const float rstd = rsqrtf(ss * (1.f / 128.f) + EPS);
    bf16_t* YCAT = WSP(bf16_t, WS_YCAT);
#pragma unroll
    for (int vt = 0; vt < 8; ++vt) { const int vd = 16 * vt + 4 * fq;
        const u32x2 sg = *(const u32x2*)(PROJ + (size_t)(t0 + tq) * INW + C_HG + h * 128 + vd); const f32x4 gn = *(const f32x4*)(X.g_hgrn + h * 128 + vd);
        u32x2 wv; wv.x = pg8::cvt_pk_bf16(o[vt][0] * rstd * gn[0] * bflo(sg.x), o[vt][1] * rstd * gn[1] * bfhi(sg.x)); wv.y = pg8::cvt_pk_bf16(o[vt][2] * rstd * gn[2] * bflo(sg.y), o[vt][3] * rstd * gn[3] * bfhi(sg.y));
        *(u32x2*)(YCAT + (size_t)(t0 + tq) * D + h * 128 + vd) = wv; }
    __syncthreads();
}

template <bool HI> __device__ __forceinline__ unsigned fp8x2_bf16_(unsigned w) { const auto f = __builtin_amdgcn_cvt_pk_f32_fp8((int)w, HI); return pg8::cvt_pk_bf16(f[0], f[1]); }
__device__ __forceinline__ unsigned fp8x2_bf16(unsigned w, bool hi) { return hi ? fp8x2_bf16_<true>(w) : fp8x2_bf16_<false>(w); }
struct AttnRegs { u32x4 k[3], v[3]; long q[4]; };
__device__ __forceinline__ void attn_load(Ctx& X, int unit, AttnRegs& R) {
    const int u16 = unit & 15, h = (unit >> 4) & 7, g = (unit >> 7) % 3, b = unit / 384;
    const int d = g == 0 ? 1 : g == 1 ? 4 : 16, nblk = 16 / d, r = u16 / nblk, blk = u16 % nblk;
    const int vcol = C_AV + g * 512 + h * 64;
    const int mk0 = blk * 256 - 128;
    const unsigned char* QK8 = WSP(unsigned char, WS_QK8);
    const int q8col = g * 512 + h * 64, k8col = 1536 + q8col, v8col = 3072 + q8col;
#pragma unroll
    for (int j = 0; j < 3; ++j) { const int idx = X.tid + NTHREADS * j, row = idx >> 2, ch = idx & 3, m = mk0 + row > 0 ? mk0 + row : 0;
        const size_t tok = (size_t)b * SEQ + (size_t)m * d + r; R.k[j] = *(const u32x4*)(QK8 + tok * 4608 + k8col + ch * 16); R.v[j] = *(const u32x4*)(QK8 + tok * 4608 + v8col + ch * 16); }
    const int l = X.lane, w = X.wave, q = l & 31, hi = l >> 5;
    const size_t tokq = (size_t)b * SEQ + (size_t)(blk * 256 + 32 * w + q) * d + r;
#pragma unroll
    for (int ds = 0; ds < 4; ++ds) R.q[ds] = *(const long*)(QK8 + tokq * 4608 + q8col + ds * 16 + hi * 8);
}
__device__ __forceinline__ void attn_stage(Ctx& X, const AttnRegs& R) {
    LAS unsigned char* KL = X.lds; LAS unsigned char* VL = X.lds + 55296;
#pragma unroll
    for (int j = 0; j < 3; ++j) { const int idx = X.tid + NTHREADS * j, row = idx >> 2, ch = idx & 3;
        *(LAS u32x4*)(KL + row * 80 + ch * 16) = R.k[j];
        u32x4 lo, hi2;
        lo.x = fp8x2_bf16(R.v[j].x, false); lo.y = fp8x2_bf16(R.v[j].x, true); lo.z = fp8x2_bf16(R.v[j].y, false); lo.w = fp8x2_bf16(R.v[j].y, true);
        hi2.x = fp8x2_bf16(R.v[j].z, false); hi2.y = fp8x2_bf16(R.v[j].z, true); hi2.z = fp8x2_bf16(R.v[j].w, false); hi2.w = fp8x2_bf16(R.v[j].w, true);
        *(LAS u32x4*)(VL + row * 128 + ch * 32) = lo; *(LAS u32x4*)(VL + row * 128 + ch * 32 + 16) = hi2; }
    LAS long* QL = (LAS long*)(X.lds + 104448 + X.tid * 32);
    QL[0] = R.q[0]; QL[1] = R.q[1]; QL[2] = R.q[2]; QL[3] = R.q[3];
}
__device__ __forceinline__ void attn_compute(Ctx& X, int unit) {
    const int u16 = unit & 15, h = (unit >> 4) & 7, g = (unit >> 7) % 3, b = unit / 384;
    const int d = g == 0 ? 1 : g == 1 ? 4 : 16, nblk = 16 / d, r = u16 / nblk, blk = u16 % nblk;
    const int mk0 = blk * 256 - 128;
    LAS unsigned char* KL = X.lds; LAS unsigned char* VL = X.lds + 55296;
    const int l = X.lane, w = X.wave, q = l & 31, hi = l >> 5;
    const size_t tokq = (size_t)b * SEQ + (size_t)(blk * 256 + 32 * w + q) * d + r;
    long qf[4];
    { const LAS long* QL = (const LAS long*)(X.lds + 104448 + X.tid * 32); qf[0] = QL[0]; qf[1] = QL[1]; qf[2] = QL[2]; qf[3] = QL[3]; }
    f32x16 s[5];
#pragma unroll
    for (int kt = 0; kt < 5; ++kt) {
        f32x16 acc;
#pragma unroll
        for (int i = 0; i < 16; ++i) acc[i] = 0.f;
#pragma unroll
        for (int ds = 0; ds < 4; ++ds) { const long kf = *(const LAS long*)(KL + (32 * w + 32 * kt + q) * 80 + ds * 16 + hi * 8); acc = __builtin_amdgcn_mfma_f32_32x32x16_fp8_fp8(kf, qf[ds], acc, 0, 0, 0); }
        s[kt] = acc;
    }
    const int iq = 32 * w + q;
    const int jmin = iq > -mk0 ? iq : -mk0;
    const int tlo = jmin - (32 * w + 4 * hi), thi = iq + 128 - (32 * w + 128 + 4 * hi), tst = -mk0 - (32 * w + 4 * hi);
    float mx = -INFINITY;
#pragma unroll
    for (int kt = 0; kt < 5; ++kt) {
        const bool chk = kt == 0 || kt == 4 || (32 * w + 32 * kt < -mk0);
        if (chk) {
#pragma unroll
            for (int rg = 0; rg < 16; ++rg) { const int c = (rg & 3) + 8 * (rg >> 2);
                const bool valid = kt == 0 ? (c >= tlo) : kt == 4 ? (c <= thi) : (c + 32 * kt >= tst);
                s[kt][rg] = valid ? s[kt][rg] : -INFINITY; if ((rg & 3) == 3) __builtin_amdgcn_sched_barrier(0); }
        }
#pragma unroll
        for (int rg = 0; rg < 16; ++rg) mx = fmaxf(mx, s[kt][rg]);
    }
    mx = fmaxf(mx, __shfl_xor(mx, 32));
    const float c2 = 0.125f * 1.4426950408889634f, mxs = mx * c2;
    float lsum = 0.f;
#pragma unroll
    for (int kt = 0; kt < 5; ++kt)
#pragma unroll
        for (int rg = 0; rg < 16; ++rg) { const float p = __builtin_amdgcn_exp2f(__builtin_fmaf(s[kt][rg], c2, -mxs)); s[kt][rg] = p; lsum += p; }
    lsum += __shfl_xor(lsum, 32);
    f32x16 o[2];
#pragma unroll
    for (int dt = 0; dt < 2; ++dt)
#pragma unroll
        for (int i = 0; i < 16; ++i) o[dt][i] = 0.f;
    const int vlane = ((l & 15) >> 2) * 128 + (((l >> 4) & 1) * 16 + (l & 3) * 4) * 2;
#pragma unroll
    for (int kt = 0; kt < 5; ++kt)
#pragma unroll
        for (int s2 = 0; s2 < 2; ++s2) {
            bf16x8 pb;
#pragma unroll
            for (int j = 0; j < 8; j += 2) { const unsigned pw = pg8::cvt_pk_bf16(s[kt][8 * s2 + j], s[kt][8 * s2 + j + 1]); pb[j] = (short)(pw & 0xffffu); pb[j + 1] = (short)(pw >> 16); }
            const int key0 = 32 * w + 32 * kt + 16 * s2 + 4 * hi;
#pragma unroll
            for (int dt = 0; dt < 2; ++dt) {
                LAS unsigned char* vp = VL + key0 * 128 + dt * 64 + vlane;
                const s16x4 t0 = __builtin_amdgcn_ds_read_tr16_b64_v4i16((LAS s16x4*)vp);
                const s16x4 t1 = __builtin_amdgcn_ds_read_tr16_b64_v4i16((LAS s16x4*)(vp + 8 * 128));
                bf16x8 va; va[0] = t0[0]; va[1] = t0[1]; va[2] = t0[2]; va[3] = t0[3]; va[4] = t1[0]; va[5] = t1[1]; va[6] = t1[2]; va[7] = t1[3];
                o[dt] = MFMA32(va, pb, o[dt]);
            }
        }
    const float inv = 1.0f / lsum;
    bf16_t* OG = WSP(bf16_t, WS_OG) + (size_t)g * T * 512;
#pragma unroll
    for (int dt = 0; dt < 2; ++dt)
#pragma unroll
        for (int rg = 0; rg < 4; ++rg) { const int d0 = 32 * dt + 8 * rg + 4 * hi;
            u32x2 wv; wv.x = pg8::cvt_pk_bf16(o[dt][4 * rg] * inv, o[dt][4 * rg + 1] * inv); wv.y = pg8::cvt_pk_bf16(o[dt][4 * rg + 2] * inv, o[dt][4 * rg + 3] * inv);
            *(u32x2*)(OG + tokq * 512 + h * 64 + d0) = wv; }
    WSP(float, WS_LSE)[((size_t)g * T + tokq) * 8 + h] = mx * 0.125f + __logf(lsum);
}
__device__ __forceinline__ void attn_combine(Ctx& X) {
    const bf16_t* OG = WSP(bf16_t, WS_OG); const float* LSE = WSP(float, WS_LSE); bf16_t* YCAT = WSP(bf16_t, WS_YCAT);
    const int gt = X.wg * NTHREADS + X.tid, NGT = X.G * NTHREADS;
    for (int item = gt; item < T * 64; item += NGT) {
        const int t = item >> 6, ch = item & 63, h = ch >> 3;
        const float l0 = LSE[(size_t)t * 8 + h], l1 = LSE[((size_t)T + t) * 8 + h], l2 = LSE[((size_t)2 * T + t) * 8 + h];
        const float m = fmaxf(l0, fmaxf(l1, l2)); float w0 = __expf(l0 - m), w1 = __expf(l1 - m), w2 = __expf(l2 - m); const float inv = 1.f / (w0 + w1 + w2); w0 *= inv; w1 *= inv; w2 *= inv;
        const u32x4 a = *(const u32x4*)(OG + (size_t)t * 512 + ch * 8), bq = *(const u32x4*)(OG + ((size_t)T + t) * 512 + ch * 8), cq = *(const u32x4*)(OG + ((size_t)2 * T + t) * 512 + ch * 8);
        u32x4 o;
#pragma unroll
        for (int j = 0; j < 4; ++j) o[j] = pk2(w0 * bflo(a[j]) + w1 * bflo(bq[j]) + w2 * bflo(cq[j]), w0 * bfhi(a[j]) + w1 * bfhi(bq[j]) + w2 * bfhi(cq[j]));
        *(u32x4*)(YCAT + (size_t)t * D + 512 + ch * 8) = o;
    }
}

__device__ __forceinline__ unsigned sortable_key(float f) { const unsigned u = __builtin_bit_cast(unsigned, f); return (u & 0x80000000u) ? ~u : (u | 0x80000000u); }
__device__ __forceinline__ void moe_route(Ctx& X, bool local) {
    const float* LG = WSP(float, WS_KVT); unsigned* CNT = WSP(unsigned, WS_CTL) + CW_CNT; int* LISTS = WSP(int, WS_LISTS); float* GATEW = WSP(float, WS_GATEW);
    const int gw = X.wg * NWAVES + X.wave, NGW = X.G * NWAVES, l = X.lane, grp = l >> 3;
    const f32x4 bias = *(const f32x4*)(X.rbias + 4 * l);
    const unsigned long long ltmask = (1ull << l) - 1ull;
    const int tbeg = local ? X.wg * 64 + X.wave : gw, tend = local ? X.wg * 64 + 64 : T, tstep = local ? NWAVES : NGW;
    for (int t = tbeg; t < tend; t += tstep) {
        f32x4 lg = *(const f32x4*)(LG + (size_t)t * 256 + 4 * l);
#pragma unroll
        for (int ks = 1; ks < 4; ++ks) lg += *(const f32x4*)(LG + ((size_t)ks * T + t) * 256 + 4 * l);
        float sc[4], mb[4];
#pragma unroll
        for (int i = 0; i < 4; ++i) { sc[i] = sigmoidf_(lg[i]); mb[i] = sc[i] + bias[i]; }
        float m1 = fmaxf(mb[0], mb[1]), m2 = fminf(mb[0], mb[1]);
        { const float a1 = fmaxf(mb[2], mb[3]), a2 = fminf(mb[2], mb[3]); const float n1 = fmaxf(m1, a1), n2 = fmaxf(fminf(m1, a1), fmaxf(m2, a2)); m1 = n1; m2 = n2; }
#pragma unroll
        for (int o = 1; o < 8; o <<= 1) { const float a1 = __shfl_xor(m1, o), a2 = __shfl_xor(m2, o); const float n1 = fmaxf(m1, a1), n2 = fmaxf(fminf(m1, a1), fmaxf(m2, a2)); m1 = n1; m2 = n2; }
        const float gs = m1 + m2;
        int rank = 0;
#pragma unroll
        for (int gg = 0; gg < 8; ++gg) { const float og = __builtin_bit_cast(float, __builtin_amdgcn_readlane(__builtin_bit_cast(int, gs), gg * 8)); rank += (og > gs || (og == gs && gg < grp)) ? 1 : 0; }
        const bool sel = rank < 4;
        unsigned key[4];
#pragma unroll
        for (int i = 0; i < 4; ++i) key[i] = sel ? sortable_key(mb[i]) : 0u;
        unsigned pre = 0u;
#pragma unroll 1
        for (int bit = 31; bit >= 0; --bit) { const unsigned cand = pre | (1u << bit);
            const int cnt = __popcll(__ballot(key[0] >= cand)) + __popcll(__ballot(key[1] >= cand)) + __popcll(__ballot(key[2] >= cand)) + __popcll(__ballot(key[3] >= cand));
            if (cnt >= TOPK) pre = cand; }
        int ngt = 0, eqb = 0, tkb = 0; bool take[4];
#pragma unroll
        for (int i = 0; i < 4; ++i) ngt += __popcll(__ballot(key[i] > pre));
        const int need = TOPK - ngt;
#pragma unroll
        for (int i = 0; i < 4; ++i) eqb += __popcll(__ballot(key[i] == pre) & ltmask);
        int eqrun = eqb;
#pragma unroll
        for (int i = 0; i < 4; ++i) { const bool eq = key[i] == pre; take[i] = (key[i] > pre) || (eq && eqrun < need); eqrun += eq ? 1 : 0; }
#pragma unroll
        for (int i = 0; i < 4; ++i) tkb += __popcll(__ballot(take[i]) & ltmask);
        float part = 0.f;
#pragma unroll
        for (int i = 0; i < 4; ++i) part += take[i] ? sc[i] : 0.f;
        const float scale = 2.5f / wave_sum(part);
        int slot = tkb;
#pragma unroll
        for (int i = 0; i < 4; ++i) if (take[i]) { const int e = 4 * l + i; const unsigned pos = atomicAdd(&CNT[e * 64], 1u); LISTS[(size_t)e * 16384 + pos] = t * NSLOT + slot; GATEW[t * NSLOT + slot] = sc[i] * scale; ++slot; }
        if (l == 0) { LISTS[(size_t)NE * 16384 + t] = t * NSLOT + TOPK; GATEW[t * NSLOT + TOPK] = 1.0f; }
    }
}
__device__ __forceinline__ int moe_table(Ctx& X) {
    LAS int* tbl = (LAS int*)(X.lds + TBL_OFF); LAS int* cnts = (LAS int*)(X.lds + TCNT_OFF); LAS int* pref = cnts + 320;
    const unsigned* CNT = WSP(unsigned, WS_CTL) + CW_CNT;
    const int x = X.wg & 7;
    if (X.tid < NEX) cnts[X.tid] = X.tid < NE ? (int)__hip_atomic_load(CNT + X.tid * 64, __ATOMIC_RELAXED, __HIP_MEMORY_SCOPE_AGENT) : T;
    __syncthreads();
    if (X.tid < NEX) { int pre = 0; for (int e = 0; e < X.tid; ++e) pre += (cnts[e] + 255) >> 8; pref[X.tid] = pre; }
    __syncthreads();
    if (X.tid < 33) {
        const int i = X.tid; int lp = 0; for (int k = 0; k < i && k < 32; ++k) lp += (cnts[x + 8 * k] + 255) >> 8;
        if (i < 32) { const int e = x + 8 * i, n = (cnts[e] + 255) >> 8, p0 = pref[e]; for (int r = 0; r < n; ++r) tbl[lp + r] = ((p0 + r) << 16) | (e << 7) | r; }
        else { const int p0 = pref[NE]; for (int r8 = 0; r8 < 8; ++r8) { const int r = 8 * x + r8; tbl[lp + r8] = ((p0 + r) << 16) | (NE << 7) | r; } cnts[600] = lp + 8; }
    }
    __syncthreads();
    return __builtin_amdgcn_readfirstlane(cnts[600]);
}
__device__ __forceinline__ void final_rows(Ctx& X) {
    const bf16_t* X1 = WSP(bf16_t, WS_X1); const float* MOD = WSP(float, WS_MOD); const unsigned char* YBUF = WSP(unsigned char, WS_YBUF);
    const int gw = X.wg * NWAVES + X.wave, NGW = X.G * NWAVES, l = X.lane;
    for (int t = gw; t < T; t += NGW) {
        const int b = t / SEQ; f32x4 v[2][2]; float s = 0.f;
#pragma unroll
        for (int j = 0; j < 2; ++j) { const int col = 8 * l + 512 * j; f32x4 m0 = {0.f, 0.f, 0.f, 0.f}, m1 = {0.f, 0.f, 0.f, 0.f};
#pragma unroll
            for (int k = 0; k < NSLOT; ++k) { const u32x2 y = *(const u32x2*)(YBUF + ((size_t)t * NSLOT + k) * D + col);
                const f32x2 a = __builtin_amdgcn_cvt_pk_f32_fp8((int)y.x, false), bq = __builtin_amdgcn_cvt_pk_f32_fp8((int)y.x, true), c = __builtin_amdgcn_cvt_pk_f32_fp8((int)y.y, false), d = __builtin_amdgcn_cvt_pk_f32_fp8((int)y.y, true);
                m0.x += a[0]; m0.y += a[1]; m0.z += bq[0]; m0.w += bq[1]; m1.x += c[0]; m1.y += c[1]; m1.z += d[0]; m1.w += d[1]; }
            const f32x4 g0 = *(const f32x4*)(MOD + b * 6144 + 5120 + col) * (1.0f / YSCALE), g1 = *(const f32x4*)(MOD + b * 6144 + 5120 + col + 4) * (1.0f / YSCALE);
            const u32x4 xw = *(const u32x4*)(X1 + (size_t)t * D + col); const f32x4 x0 = {bflo(xw.x), bfhi(xw.x), bflo(xw.y), bfhi(xw.y)}, x1 = {bflo(xw.z), bfhi(xw.z), bflo(xw.w), bfhi(xw.w)};
            v[j][0] = x0 + g0 * m0; v[j][1] = x1 + g1 * m1;
#pragma unroll
            for (int q = 0; q < 2; ++q) s += (v[j][q].x * v[j][q].x + v[j][q].y * v[j][q].y) + (v[j][q].z * v[j][q].z + v[j][q].w * v[j][q].w); }
        const float rstd = rsqrtf(wave_sum(s) * (1.f / D) + EPS);
#pragma unroll
        for (int j = 0; j < 2; ++j) { const int col = 8 * l + 512 * j;
            *(f32x4*)(X.out + (size_t)t * D + col) = v[j][0] * rstd * *(const f32x4*)(X.g_final + col); *(f32x4*)(X.out + (size_t)t * D + col + 4) = v[j][1] * rstd * *(const f32x4*)(X.g_final + col + 4); }
    }
}

__device__ __forceinline__ unsigned* panel_word(Ctx& X, int bank, int pm) { return WSP(unsigned, WS_CTL) + CW_PANEL + (bank * 64 + pm) * 64; }
__device__ __forceinline__ void panel_signal(Ctx& X, int bank, int pm) {
    asm volatile("s_waitcnt vmcnt(0)" ::: "memory"); __syncthreads();
    if (X.tid == 0) (void)xb_add(panel_word(X, bank, pm), 1u);
}
__device__ __forceinline__ void panel_wait(Ctx& X, int bank, int pm, unsigned target) {
    if (X.tid == 0) { unsigned* p = panel_word(X, bank, pm); unsigned sp = 0u;
        while (xb_ld(p) < target) { __builtin_amdgcn_s_sleep(2); if (++sp > (1u << 22)) break; }
        __builtin_amdgcn_fence(__ATOMIC_ACQUIRE, "agent"); asm volatile("s_waitcnt vmcnt(0)" ::: "memory"); }
    __syncthreads();
}

constexpr int NG_INPROJ = 176;
__device__ __forceinline__ void ph_inproj(Ctx& X) {
    const int ng = X.G > NG_INPROJ + 8 ? NG_INPROJ : X.G;
    if (X.wg < ng) {
        RegSched S{(const char*)WSP(bf16_t, WS_H), (const char*)WSP(bf16_t, WS_WIN), (size_t)256 * 2048, (size_t)256 * 2048, T / 256, INW / 256, ng, X.wg};
        EpiInproj E{WSP(bf16_t, WS_PROJ), WSP(float, WS_LOGF), WSP(float, WS_LB), WSP(float, WS_ROPE), WSP(unsigned char, WS_G8), WSP(unsigned char, WS_QK8)};
        pg8::gemm_phase<EpiInproj, RegSched, true, false>(X.lds, 1024, 1024, 1024, S, E);
    }
    if (ng == X.G) expert_convert(X, X.wg, X.G);
    else if (X.wg >= ng) expert_convert(X, X.wg - ng, X.G - ng);
}
__device__ __forceinline__ void ph_mix_a(Ctx& X) {
    for (int it = X.wg; it < 256; it += X.G) hgrn_kv_unit(X, it);
    AttnRegs Ra, Rb; int unit = X.wg;
    auto clampu = [](int u) { return u < 1536 ? u : 1535; };
    attn_load(X, clampu(unit), Ra);
    __builtin_amdgcn_sched_barrier(0);
    attn_load(X, clampu(unit + X.G), Rb);
    __builtin_amdgcn_sched_barrier(0);
#define ATTN_STEP(R_) do { attn_stage(X, R_); __syncthreads(); __builtin_amdgcn_sched_barrier(0); attn_load(X, clampu(unit + 2 * X.G), R_); __builtin_amdgcn_sched_barrier(0); \
        attn_compute(X, unit); __syncthreads(); unit += X.G; } while (0)
    if (unit < 1536) {
        ATTN_STEP(Ra);
        while (unit < 1536) {
            ATTN_STEP(Rb);
            if (unit >= 1536) break;
            ATTN_STEP(Ra);
        }
    }
#undef ATTN_STEP
}
__device__ __forceinline__ void ph_mix_c(Ctx& X) { for (int it = X.wg; it < 512; it += X.G) hgrn_out_unit(X, it); attn_combine(X); }
__device__ __forceinline__ void ph_mixed(Ctx& X, bool chain) {
    TwoPartSched S{(const char*)WSP(bf16_t, WS_YCAT), (const char*)WSP(bf16_t, WS_WPA), (const char*)WSP(bf16_t, WS_WPB), T / 256, D / 256, X.G, X.wg};
    EpiMixed E{WSP(unsigned char, WS_G8), WSP(bf16_t, WS_MIXED)};
    pg8::gemm_phase<EpiMixed, TwoPartSched, false, false>(X.lds, 1024, 512, 512, S, E);
    if (chain) { int pm, pn; pg8::swz_tile(X.wg, T / 256, D / 256, pm, pn); panel_signal(X, 0, pm); }
}
__device__ __forceinline__ void ph_outproj(Ctx& X, bool chain) {
    int pm = 0, pn = 0; pg8::swz_tile(X.wg < 256 ? X.wg : 0, T / 256, D / 256, pm, pn);
    RegSched S{(const char*)WSP(bf16_t, WS_MIXED), (const char*)WSP(bf16_t, WS_WOUT), (size_t)256 * 2048, (size_t)256 * 2048, T / 256, D / 256, X.G, X.wg};
    if (chain) {
        panel_wait(X, 0, pm, 4u);
        EpiOutNorm E{X.x, WSP(float, WS_MOD), X.g2, WSP(bf16_t, WS_X1), WSP(bf16_t, WS_H), WSP(unsigned char, WS_H8), WSP(float, WS_XB), panel_word(X, 1, 0), X.lds + 139264};
        pg8::gemm_phase<EpiOutNorm, RegSched, true, false>(X.lds, 1024, 1024, 1024, S, E);
        panel_signal(X, 2, pm);
    } else {
        EpiOutproj E{X.x, WSP(float, WS_MOD), WSP(bf16_t, WS_X1)};
        pg8::gemm_phase<EpiOutproj, RegSched, false, false>(X.lds, 1024, 1024, 1024, S, E);
    }
}
__device__ __forceinline__ void ph_norm2(Ctx& X, bool chain) { if (!chain) norm_rows(X, 1); }
__device__ __forceinline__ void ph_router(Ctx& X, bool chain) {
    if (chain) panel_wait(X, 2, X.wg >> 2, 4u);
    RouterSched S{(const char*)WSP(bf16_t, WS_H), (const char*)WSP(bf16_t, WS_WR), X.G, X.wg};
    EpiRouter E{WSP(float, WS_KVT)};
    pg8::gemm_phase<EpiRouter, RouterSched, false, false>(X.lds, 1024, 1024, 256, S, E);
    if (chain) panel_signal(X, 3, X.wg >> 2);
}
__device__ __forceinline__ void ph_route(Ctx& X, bool chain) {
    if (chain) panel_wait(X, 3, X.wg >> 2, 4u);
    moe_route(X, chain);
}
__device__ __forceinline__ void ph_gu(Ctx& X) {
    const int nent = moe_table(X);
    MoeSched S{(const LAS int*)(X.lds + TBL_OFF), (const LAS int*)(X.lds + TCNT_OFF), nent, (const char*)WSP(unsigned char, WS_H8), (const char*)WSP(unsigned char, WS_WGU), WSP(int, WS_LISTS), 2, 256 * 1024, 512 * 1024, 0, X.G, X.wg};
    EpiGU E{WSP(unsigned char, WS_ACT)};
    pg8::gemm_phase<EpiGU, MoeSched, true, true, true>(X.lds, 512, 512, 512, S, E);
}
__device__ __forceinline__ void ph_down(Ctx& X) {
    const int nent = moe_table(X);
    MoeSched S{(const LAS int*)(X.lds + TBL_OFF), (const LAS int*)(X.lds + TCNT_OFF), nent, (const char*)WSP(unsigned char, WS_ACT), (const char*)WSP(unsigned char, WS_WD), WSP(int, WS_LISTS), 4, 256 * 256, 1024 * 256, 256 * 256, X.G, X.wg};
    EpiDown E{WSP(unsigned char, WS_YBUF), WSP(float, WS_GATEW)};
    pg8::gemm_phase<EpiDown, MoeSched, true, false, true>(X.lds, 128, 128, 128, S, E);
}

constexpr int NPHASE = 14;
struct Args { const void* in[20]; float* out; unsigned char* ws; int ph_lo, ph_hi; };
__global__ void __launch_bounds__(NTHREADS, 2) mega_fwd(Args args) {
    extern __shared__ __attribute__((aligned(16))) unsigned char lds_raw[];
    Ctx X;
    X.lds = (LAS unsigned char*)lds_raw;
    X.tid = threadIdx.x; X.lane = X.tid & 63; X.wave = __builtin_amdgcn_readfirstlane(X.tid >> 6); X.wg = blockIdx.x; X.G = gridDim.x;
    X.x = (const float*)args.in[0]; X.c = (const float*)args.in[1]; X.positions = (const int*)args.in[2]; X.w_ada = (const float*)args.in[3]; X.b_ada = (const float*)args.in[4];
    X.g1 = (const float*)args.in[5]; X.w_in = (const float*)args.in[6]; X.lb_logits = (const float*)args.in[7]; X.g_hgrn = (const float*)args.in[8]; X.w_pa = (const float*)args.in[9];
    X.w_pb = (const float*)args.in[10]; X.w_out = (const float*)args.in[11]; X.g2 = (const float*)args.in[12]; X.w_router = (const float*)args.in[13]; X.rbias = (const float*)args.in[14];
    X.w_egu = (const float*)args.in[15]; X.w_edown = (const float*)args.in[16]; X.w_sgu = (const float*)args.in[17]; X.w_sdown = (const float*)args.in[18]; X.g_final = (const float*)args.in[19];
    X.out = args.out; X.ws = args.ws;
    volatile LAS unsigned* MISC = (volatile LAS unsigned*)(X.lds + MISC_OFF);
    if (X.tid < 32) MISC[X.tid] = 0u;
    __syncthreads();
    const int lo = args.ph_lo, hi = args.ph_hi;
    XcdBarrier bar; bar.bar = WSP(unsigned, WS_CTL) + CW_BAR; bar.x = 0; bar.st = nullptr;
    if (hi - lo > 1) bar = xcd_barrier_post(WSP(unsigned, WS_CTL) + CW_BAR, MISC + 8);
#ifndef PH_MASK
#define PH_MASK 0xffffffffu
#endif
#define IN(k) ((((PH_MASK) >> (k)) & 1u) && lo <= (k) && (k) < hi)
#ifndef REPEAT_MASK
#define REPEAT_MASK 0u
#endif
#define SEAM(k) do { if (IN(k) && IN((k) + 1)) xcd_barrier(bar); } while (0)
#define RUN(k, call) do { if (IN(k)) { call; if (((REPEAT_MASK) >> (k)) & 1u) { xcd_barrier(bar); call; } } } while (0)

    const bool p01 = IN(0) && IN(1);
    RUN(0, p0_prologue(X));
    if (p01) { asm volatile("s_waitcnt vmcnt(0)" ::: "memory"); __syncthreads(); if (X.tid == 0) (void)xb_add(WSP(unsigned, WS_CTL) + CW_P0 + 64 * (X.wg & 7), 1u); }
    if (IN(1)) {
        small_transposes(X);
        if (p01) {
            if (X.tid == 0) { unsigned* p = WSP(unsigned, WS_CTL) + CW_P0; unsigned sp = 0u;
                for (;;) { unsigned sum = 0u;
#pragma unroll
                    for (int j = 0; j < 8; ++j) sum += xb_ld(p + 64 * j);
                    if (sum >= (unsigned)X.G) break;
                    __builtin_amdgcn_s_sleep(2); if (++sp > (1u << 22)) break; }
                __builtin_amdgcn_fence(__ATOMIC_ACQUIRE, "agent"); asm volatile("s_waitcnt vmcnt(0)" ::: "memory"); }
            __syncthreads();
        }
        norm_rows(X, 0);
    }
    SEAM(1);
    RUN(2, ph_inproj(X)); SEAM(2);
    RUN(3, ph_mix_a(X)); SEAM(3);
    RUN(4, hgrn_passB(X)); SEAM(4);
    RUN(5, ph_mix_c(X)); SEAM(5);
    const bool chain = (X.G == 256);
    RUN(6, ph_mixed(X, chain)); if (!chain) SEAM(6);
    RUN(7, ph_outproj(X, chain)); if (!chain) SEAM(7);
    RUN(8, ph_norm2(X, chain)); if (!chain) SEAM(8);
    RUN(9, ph_router(X, chain)); if (!chain) SEAM(9);
    RUN(10, ph_route(X, chain)); SEAM(10);
    RUN(11, ph_gu(X)); SEAM(11);
    RUN(12, ph_down(X)); SEAM(12);
    RUN(13, final_rows(X));
#undef IN
#undef SEAM
}

extern "C" void kernel_launch(void* const* d_in, const int* in_sizes, int n_in, void* d_out, int out_size, void* d_ws, size_t ws_size, hipStream_t stream) {
    static int grid = 0;
    if (grid == 0) {
        if (n_in != 20 || out_size != T * D || ws_size < WS_END) { fprintf(stderr, "kernel_launch: unexpected shapes (n_in %d, out %d, ws %zu); nothing launched\n", n_in, out_size, ws_size); grid = -1; return; }
        int dev = 0, cus = 0, per_cu = 0;
        if (hipGetDevice(&dev) != hipSuccess || hipDeviceGetAttribute(&cus, hipDeviceAttributeMultiprocessorCount, dev) != hipSuccess) { grid = -1; return; }
        if (hipFuncSetAttribute((const void*)mega_fwd, hipFuncAttributeMaxDynamicSharedMemorySize, LDS_BYTES) != hipSuccess) { fprintf(stderr, "kernel_launch: hipFuncSetAttribute failed\n"); grid = -1; return; }
        if (hipOccupancyMaxActiveBlocksPerMultiprocessor(&per_cu, (const void*)mega_fwd, NTHREADS, LDS_BYTES) != hipSuccess || per_cu < 1) { fprintf(stderr, "kernel_launch: occupancy query says %d blocks/CU; nothing launched\n", per_cu); (void)hipGetLastError(); grid = -1; return; }
        grid = cus;
        if (T % grid != 0 || 24576 % grid != 0 || grid % 8 != 0) { fprintf(stderr, "kernel_launch: grid %d does not divide the row count; nothing launched\n", grid); grid = -1; return; }
    }
    if (grid < 0) return;
    (void)hipMemsetAsync((char*)d_ws + WS_CTL, 0, CTL_ZERO_BYTES, stream);
    Args a{};
    for (int i = 0; i < 20; ++i) a.in[i] = d_in[i];
    a.out = (float*)d_out; a.ws = (unsigned char*)d_ws;
#if MK_PER_PHASE
    for (int p = 0; p < NPHASE; ++p) { a.ph_lo = p; a.ph_hi = p + 1; hipLaunchKernelGGL(mega_fwd, dim3(grid), dim3(NTHREADS), LDS_BYTES, stream, a); }
#else
    a.ph_lo = 0; a.ph_hi = NPHASE;
    hipLaunchKernelGGL(mega_fwd, dim3(grid), dim3(NTHREADS), LDS_BYTES, stream, a);
#endif
}
```

```cpp
#include <hip/hip_runtime.h>
#include <cstdio>
#include <cstdint>

#ifndef MK_PER_PHASE
#define MK_PER_PHASE 0
#endif

#define GAS __attribute__((address_space(1)))
#define LAS __attribute__((address_space(3)))
typedef unsigned short bf16_t;
typedef short bf16x8 __attribute__((ext_vector_type(8)));
typedef short s16x4 __attribute__((ext_vector_type(4)));
typedef float f32x4 __attribute__((ext_vector_type(4)));
typedef float f32x2 __attribute__((ext_vector_type(2)));
typedef float f32x16 __attribute__((ext_vector_type(16)));
typedef unsigned u32x4 __attribute__((ext_vector_type(4)));
typedef unsigned u32x2 __attribute__((ext_vector_type(2)));
typedef long l64x2 __attribute__((ext_vector_type(2)));

constexpr int NB = 4, SEQ = 4096, T = NB * SEQ, D = 1024, INW = 8704;
constexpr int C_HQ = 0, C_HK = 512, C_HV = 1024, C_HG = 1536, C_AQ = 2048, C_AK = 3584, C_AV = 5120, C_GA = 6656, C_GB = 7680;
constexpr int NE = 256, NEX = 257, TOPK = 8, NSLOT = 9, EFF = 256;
constexpr float EPS = 1e-6f;
constexpr float WGU_SCALE = 64.0f, WD_SCALE = 32.0f;
constexpr float YSCALE = 16.0f;
constexpr int NWAVES = 8, NTHREADS = 512;

constexpr size_t MiB = 1u << 20;
constexpr size_t WS_CTL = 0, CTL_ZERO_BYTES = 1 * MiB;
constexpr size_t WS_MODP = 2 * MiB;
constexpr size_t WS_MOD = 4 * MiB;
constexpr size_t WS_LB = 4 * MiB + 128 * 1024;
constexpr size_t WS_XB = 4 * MiB + 256 * 1024;
constexpr size_t WS_ROPE = 5 * MiB;
constexpr size_t WS_DECAY = 6 * MiB;
constexpr size_t WS_GATEW = 7 * MiB;
constexpr size_t WS_LISTS = 16 * MiB;
constexpr size_t WS_WIN = 34 * MiB;
constexpr size_t WS_WPA = 51 * MiB, WS_WPB = 52 * MiB, WS_WOUT = 53 * MiB, WS_WR = 55 * MiB;
constexpr size_t WS_H = 56 * MiB;
constexpr size_t WS_LOGF = 88 * MiB;
constexpr size_t WS_H8 = 120 * MiB;
constexpr size_t WS_MIXED = 136 * MiB;
constexpr size_t WS_YCAT = 168 * MiB;
constexpr size_t WS_X1 = 200 * MiB;
constexpr size_t WS_G8 = 232 * MiB;
constexpr size_t WS_OG = 264 * MiB;
constexpr size_t WS_LSE = 312 * MiB;
constexpr size_t WS_KVT = 314 * MiB;
constexpr size_t WS_SPT = 378 * MiB;
constexpr size_t WS_PROJ = 410 * MiB;
constexpr size_t WS_WGU = 682 * MiB;
constexpr size_t WS_QK8 = 820 * MiB;
constexpr size_t WS_WD = 939 * MiB;
constexpr size_t WS_ACT = 1068 * MiB;
constexpr size_t WS_YBUF = 1172 * MiB;
constexpr size_t WS_END = 1460 * MiB;
constexpr int CW_P0 = 2048;
constexpr int CW_BAR = 4096;
constexpr int CW_PANEL = 65536;
constexpr int CW_CNT = 16384;

constexpr int RING_BYTES = 131072;
constexpr int TBL_OFF = RING_BYTES;
constexpr int TCNT_OFF = TBL_OFF + 4096;
constexpr int MISC_OFF = TCNT_OFF + 2560;
constexpr int LDS_BYTES = 147456;

#define LDS_WAIT() asm volatile("s_waitcnt lgkmcnt(0)" ::: "memory")
#define VM_WAIT() asm volatile("s_waitcnt vmcnt(0)" ::: "memory")
__device__ __forceinline__ unsigned f2bf(float f) { unsigned u = __builtin_bit_cast(unsigned, f); return (u + 0x7fffu + ((u >> 16) & 1u)) >> 16; }
__device__ __forceinline__ float bf2f(unsigned b) { return __builtin_bit_cast(float, b << 16); }
__device__ __forceinline__ unsigned pk2(float lo, float hi) { return f2bf(lo) | (f2bf(hi) << 16); }
__device__ __forceinline__ float bflo(unsigned w) { return __builtin_bit_cast(float, w << 16); }
__device__ __forceinline__ float bfhi(unsigned w) { return __builtin_bit_cast(float, w & 0xffff0000u); }
__device__ __forceinline__ float fast_logf(float x) { return __builtin_amdgcn_logf(x) * 0.6931471805599453f; }
__device__ __forceinline__ float sigmoidf_(float x) { return __builtin_amdgcn_rcpf(1.0f + __expf(-x)); }
__device__ __forceinline__ float wave_sum(float v) {
#pragma unroll
    for (int o = 1; o < 64; o <<= 1) v += __shfl_xor(v, o);
    return v;
}

__device__ __forceinline__ float clamp_e4m3(float x) { return __builtin_amdgcn_fmed3f(x, -448.0f, 448.0f); }
__device__ __forceinline__ unsigned pk4_fp8(float a, float b, float c, float d) { int w = 0; w = __builtin_amdgcn_cvt_pk_fp8_f32(clamp_e4m3(a), clamp_e4m3(b), w, false); w = __builtin_amdgcn_cvt_pk_fp8_f32(clamp_e4m3(c), clamp_e4m3(d), w, true); return (unsigned)w; }
__device__ __forceinline__ void st_wt8(void* p, unsigned long long v) { __hip_atomic_store((unsigned long long*)p, v, __ATOMIC_RELAXED, __HIP_MEMORY_SCOPE_AGENT); }
__device__ __forceinline__ void st_wt16(void* p, u32x4 v) { asm volatile("global_store_dwordx4 %0, %1, off sc1\n\ts_nop 1" :: "v"(p), "v"(v) : "memory"); }
__device__ __forceinline__ void st_wt4(void* p, unsigned v) { __hip_atomic_store((unsigned*)p, v, __ATOMIC_RELAXED, __HIP_MEMORY_SCOPE_AGENT); }
namespace pg8 {
constexpr int BM = 256, BK = 64, HALF = 128, HTB = HALF * BK * 2, STAGE_BYTES = 8 * HTB, NXCD = 8, WGM = 8;
__host__ __device__ __forceinline__ int lds_byte(int r, int c) { const int st = (r >> 4) * 2 + (c >> 5), rr = r & 15, cc = c & 31, ob = rr * 64 + cc * 2; return st * 1024 + (ob ^ (((ob >> 9) & 1) << 5)); }
__host__ __device__ __forceinline__ void stage_rc(int b, int& R, int& C) { const int st = b / 1024, sb = b % 1024, swz = sb ^ (((sb >> 9) & 1) << 5); R = (st >> 1) * 16 + swz / 64; C = (st & 1) * 32 + (swz % 64) / 2; }
__host__ __device__ __forceinline__ int perm32(int rho) { const int n = rho >> 4, i = rho & 15; return 8 * (i >> 2) + 4 * n + (i & 3); }

struct Unit { const char* a; const char* b; const int* rows; int pm, pn, aux, nvalid; };

__device__ __forceinline__ void swz_tile(int L, int nM, int nN, int& pm, int& pn) {
    const int nwg = nM * nN; int wgid = L;
    { const int q = nwg / NXCD, r = nwg % NXCD, xcd = wgid % NXCD, off = wgid / NXCD; wgid = (xcd < r ? xcd * (q + 1) : r * (q + 1) + (xcd - r) * q) + off; }
    const int nig = WGM * nN, gid = wgid / nig, fm = gid * WGM, gsz = (nM - fm) < WGM ? (nM - fm) : WGM;
    pm = fm + ((wgid % nig) % gsz); pn = (wgid % nig) / gsz;
}

__device__ __forceinline__ unsigned cvt_pk_bf16(float lo, float hi) { unsigned r; asm volatile("v_cvt_pk_bf16_f32 %0, %1, %2" : "=v"(r) : "v"(lo), "v"(hi)); return r; }

template <bool GATHER>
__device__ __forceinline__ void gather_offs(const Unit& u, int tid, int lda, unsigned (&v)[2][2]) {
    if constexpr (GATHER) {
#pragma unroll
        for (int i = 0; i < 2; ++i) { int R, C; stage_rc(tid * 16 + i * 8192, R, C);
#pragma unroll
            for (int hh = 0; hh < 2; ++hh) { const int ri = hh * HALF + R; int slot = 0; if (ri < u.nvalid) slot = u.rows[ri];
                const unsigned tok = (unsigned)slot / 9u; v[hh][i] = (tok * (unsigned)lda + (unsigned)C) * 2u; } }
    }
}

template <class E, class = void> struct epi_bjadj { static constexpr bool v = false; };
template <class E> struct epi_bjadj<E, decltype((void)E::BJADJ)> { static constexpr bool v = E::BJADJ; };
template <class Epi, class Sched, bool ALIGN_EPI, bool GATHER, bool FP8 = false>
__device__ __forceinline__ void gemm_phase(LAS unsigned char* lds, const int lda, const int ldb, const int K, const Sched& S, const Epi& E) {
    const int tid = threadIdx.x, wid = __builtin_amdgcn_readfirstlane(tid >> 6), lane = tid & 63, wr = wid >> 2, wc = wid & 3, fr = lane & 15, fq = lane >> 4;
    const int nt = K / BK;
    unsigned voffA[2], voffB[2];
#pragma unroll
    for (int i = 0; i < 2; ++i) { int R, C; stage_rc(tid * 16 + i * 8192, R, C); const int Rb = Epi::PERM ? ((R & ~31) + perm32(R & 31)) : R;
        const int Rg = epi_bjadj<Epi>::v ? ((Rb >> 5) * 64 + (Rb & 31)) : Rb;
        voffA[i] = (unsigned)(R * lda + C) * 2u; voffB[i] = (unsigned)(Rg * ldb + C) * 2u; }
    const size_t kstep = (size_t)(BK * 2);
    const size_t hstepA = GATHER ? 0 : (size_t)HALF * lda * 2, hstepB = (size_t)(epi_bjadj<Epi>::v ? 32 : HALF) * ldb * 2;
    const unsigned ldsw = (unsigned)wid * 1024u;
    const int aoff = lds_byte(wr * 64 + fr, fq * 8), boff = lds_byte(wc * 32 + fr, fq * 8);
#define PG8_SA(b, h) (((b) * 2 + (h)) * HTB)
#define PG8_SB(b, h) ((4 + (b) * 2 + (h)) * HTB)
#define PG8_STAGE(bufoff, gbase, voff) do { _Pragma("unroll") for (int _i = 0; _i < 2; ++_i) \
        __builtin_amdgcn_global_load_lds((const unsigned*)((const char*)(gbase) + (voff)[_i]), (LAS unsigned*)(lds + (bufoff) + ldsw + _i * 8192), 16, 0, 0); } while (0)
#define PG8_STAGE_A(bufoff, gb, hh, nx) do { if constexpr (GATHER) { unsigned _v[2]; _v[0] = (nx) ? vn[hh][0] : vc[hh][0]; _v[1] = (nx) ? vn[hh][1] : vc[hh][1]; PG8_STAGE(bufoff, gb, _v); } \
        else { PG8_STAGE(bufoff, (gb) + (hh) * hstepA, voffA); } } while (0)
#define PG8_LDA(dst, b, h) do { _Pragma("unroll") for (int m = 0; m < 4; ++m) _Pragma("unroll") for (int k = 0; k < 2; ++k) dst[m][k] = *(const LAS bf16x8*)(lds + PG8_SA(b, h) + aoff + m * 2048 + k * 1024); } while (0)
#define PG8_LDB(dst, b, h) do { _Pragma("unroll") for (int n = 0; n < 2; ++n) _Pragma("unroll") for (int k = 0; k < 2; ++k) dst[n][k] = *(const LAS bf16x8*)(lds + PG8_SB(b, h) + boff + n * 2048 + k * 1024); } while (0)
#define PG8_MMA(ai, bj, At, Bt) do { __builtin_amdgcn_s_setprio(1); _Pragma("unroll") for (int m = 0; m < 4; ++m) _Pragma("unroll") for (int n = 0; n < 2; ++n) _Pragma("unroll") for (int k = 0; k < 2; ++k) { \
        if constexpr (FP8) { const l64x2 _b = __builtin_bit_cast(l64x2, Bt[n][k]), _a = __builtin_bit_cast(l64x2, At[m][k]); \
            acc[ai][bj][m][n] = __builtin_amdgcn_mfma_f32_16x16x32_fp8_fp8(_b[0], _a[0], acc[ai][bj][m][n], 0, 0, 0); acc[ai][bj][m][n] = __builtin_amdgcn_mfma_f32_16x16x32_fp8_fp8(_b[1], _a[1], acc[ai][bj][m][n], 0, 0, 0); } \
        else acc[ai][bj][m][n] = __builtin_amdgcn_mfma_f32_16x16x32_bf16(Bt[n][k], At[m][k], acc[ai][bj][m][n], 0, 0, 0); } __builtin_amdgcn_s_setprio(0); } while (0)
#define PG8_WAIT_V(n) asm volatile("s_waitcnt vmcnt(" #n ")" ::: "memory")
#define PG8_WAIT_L(n) asm volatile("s_waitcnt lgkmcnt(" #n ")" ::: "memory")
#define PG8_BAR __builtin_amdgcn_s_barrier()
#define PG8_SCHED __builtin_amdgcn_sched_barrier(0)
    Unit cur, nxt; int ui = 0;
    if (!S.next(0, cur)) return;
    unsigned vc[2][2] = {{0u, 0u}, {0u, 0u}}, vn[2][2] = {{0u, 0u}, {0u, 0u}};
    gather_offs<GATHER>(cur, tid, lda, vc);
    f32x4 acc[2][2][4][2];
#pragma unroll
    for (int a = 0; a < 2; ++a)
#pragma unroll
        for (int b = 0; b < 2; ++b)
#pragma unroll
            for (int m = 0; m < 4; ++m)
#pragma unroll
                for (int n = 0; n < 2; ++n) acc[a][b][m][n] = (f32x4){0.f, 0.f, 0.f, 0.f};
    bf16x8 At[4][2], B0[2][2], B1[2][2];
    const char* cA = cur.a; const char* cB = cur.b;
    PG8_STAGE(PG8_SB(0, 0), cB, voffB); PG8_STAGE(PG8_SB(0, 1), cB + hstepB, voffB); PG8_STAGE_A(PG8_SA(0, 0), cA, 0, false); PG8_STAGE_A(PG8_SA(0, 1), cA, 1, false);
    if (wr == 1) PG8_BAR;
    PG8_WAIT_V(2); PG8_BAR;
    PG8_STAGE(PG8_SB(1, 0), cB + kstep, voffB); PG8_STAGE_A(PG8_SA(1, 0), cA + kstep, 0, false); PG8_STAGE(PG8_SB(1, 1), cB + hstepB + kstep, voffB);
    PG8_WAIT_V(6); PG8_BAR;
    for (;;) {
        const bool has_next = S.next(ui + 1, nxt);
        if (has_next) gather_offs<GATHER>(nxt, tid, lda, vn);
        const char* nA = has_next ? nxt.a : cA; const char* nB = has_next ? nxt.b : cB;
        const bool do0 = !Sched::HALFSKIP || cur.nvalid > 64 * wr, do1 = !Sched::HALFSKIP || cur.nvalid > 128 + 64 * wr;
        for (int t = 0; t < nt; t += 2) {
            const bool last = (t == nt - 2);
            const bool lnx = last && has_next;
            const char* a1 = cA + (size_t)(t + 1) * kstep;
            const char* a2 = last ? nA : cA + (size_t)(t + 2) * kstep; const char* b2 = last ? nB : cB + (size_t)(t + 2) * kstep;
            const char* a3 = a2 + kstep; const char* b3 = b2 + kstep;
            PG8_LDB(B0, 0, 0); PG8_LDB(B1, 0, 1); PG8_SCHED; PG8_LDA(At, 0, 0); PG8_STAGE_A(PG8_SA(1, 1), a1, 1, false);
            PG8_WAIT_V(8); PG8_WAIT_L(0); PG8_BAR; if (do0) { PG8_MMA(0, 0, At, B0); PG8_MMA(0, 1, At, B1); } PG8_BAR; PG8_SCHED;
            PG8_LDA(At, 0, 1); PG8_STAGE(PG8_SB(0, 0), b2, voffB); PG8_STAGE(PG8_SB(0, 1), b2 + hstepB, voffB); PG8_STAGE_A(PG8_SA(0, 0), a2, 0, lnx);
            PG8_WAIT_V(8); PG8_WAIT_L(0); PG8_BAR; if (do1) { PG8_MMA(1, 0, At, B0); PG8_MMA(1, 1, At, B1); } PG8_BAR; PG8_SCHED;
            PG8_LDB(B0, 1, 0); PG8_LDB(B1, 1, 1); PG8_SCHED; PG8_LDA(At, 1, 0); PG8_STAGE_A(PG8_SA(0, 1), a2, 1, lnx);
            PG8_WAIT_V(8); PG8_WAIT_L(0); PG8_BAR; if (do0) { PG8_MMA(0, 0, At, B0); PG8_MMA(0, 1, At, B1); } PG8_BAR; PG8_SCHED;
            PG8_LDA(At, 1, 1); PG8_STAGE(PG8_SB(1, 0), b3, voffB); PG8_STAGE(PG8_SB(1, 1), b3 + hstepB, voffB); PG8_STAGE_A(PG8_SA(1, 0), a3, 0, lnx);
            PG8_WAIT_V(8); PG8_WAIT_L(0); PG8_BAR; if (do1) { PG8_MMA(1, 0, At, B0); PG8_MMA(1, 1, At, B1); } PG8_BAR; PG8_SCHED;
        }
        if constexpr (ALIGN_EPI) { if (wr == 0) PG8_BAR; }
        E(acc, cur, wr, wc, fr, fq);
        __builtin_amdgcn_s_waitcnt(0x0F70);
        if (!has_next) break;
        if (!E.keep(cur)) {
#pragma unroll
            for (int a = 0; a < 2; ++a)
#pragma unroll
                for (int b = 0; b < 2; ++b)
#pragma unroll
                    for (int m = 0; m < 4; ++m)
#pragma unroll
                        for (int n = 0; n < 2; ++n) acc[a][b][m][n] = (f32x4){0.f, 0.f, 0.f, 0.f};
        }
        cur = nxt; cA = nA; cB = nB; ++ui;
        if constexpr (GATHER) {
#pragma unroll
            for (int hh = 0; hh < 2; ++hh) { vc[hh][0] = vn[hh][0]; vc[hh][1] = vn[hh][1]; }
        }
        if constexpr (ALIGN_EPI) { if (wr == 1) PG8_BAR; }
    }
    PG8_WAIT_V(0);
    if constexpr (!ALIGN_EPI) { if (wr == 0) PG8_BAR; }
    PG8_BAR;
#undef PG8_SA
#undef PG8_SB
#undef PG8_STAGE
#undef PG8_STAGE_A
#undef PG8_LDA
#undef PG8_LDB
#undef PG8_MMA
#undef PG8_WAIT_V
#undef PG8_WAIT_L
#undef PG8_BAR
#undef PG8_SCHED
}
}

#define XB_TMO      128
#define XB_XCNT(j)  (256  + 64 * (j))
#define XB_XSUB(j)  (1280 + 64 * (j))
#define XB_XGEN(j)  (2304 + 64 * (j))
#define XB_TOP      3328
#define XB_TOPGEN   3392
#define XCD_BAR_WORDS 3456
#define XB_SPIN_CAP (1u << 20)
__device__ __forceinline__ unsigned xb_ld(unsigned* p)              { return __hip_atomic_load(p, __ATOMIC_RELAXED, __HIP_MEMORY_SCOPE_AGENT); }
__device__ __forceinline__ unsigned xb_add(unsigned* p, unsigned v) { return __hip_atomic_fetch_add(p, v, __ATOMIC_RELAXED, __HIP_MEMORY_SCOPE_AGENT); }
__device__ __forceinline__ unsigned xb_xcc_id() { return (unsigned)__builtin_amdgcn_s_getreg((3 << 11) | 20) & 0xFu; }
#define XB_SPIN(cond, bar) do { unsigned _sp = 0; while (cond) { __builtin_amdgcn_s_sleep(1); \
    if ((++_sp & 255u) == 0u) { if (xb_ld(&(bar)[XB_TMO])) break; if (_sp > XB_SPIN_CAP) { atomicAdd(&(bar)[XB_TMO], 1u); break; } } } } while (0)
struct XcdBarrier { unsigned* bar; unsigned x; volatile LAS unsigned* st; };
__device__ __forceinline__ XcdBarrier xcd_barrier_post(unsigned* bar, volatile LAS unsigned* st) {
    XcdBarrier b; b.bar = bar; b.x = xb_xcc_id(); b.st = st;
    if (threadIdx.x == 0) (void)xb_add(&bar[XB_XCNT(b.x)], 1u);
    return b;
}
__device__ __forceinline__ void xcd_barrier_complete(unsigned* bar, unsigned x, unsigned& nloc, unsigned& nx) {
    const unsigned G = gridDim.x * gridDim.y * gridDim.z;
    unsigned sum, cnt, mine, sp = 0u;
    for (;;) {
        sum = 0u; cnt = 0u; mine = 0u;
#pragma unroll
        for (unsigned j = 0; j < 16; ++j) { const unsigned c = xb_ld(&bar[XB_XCNT(j)]); sum += c; cnt += (c > 0u) ? 1u : 0u; mine = (j == x) ? c : mine; }
        if (sum == G) break;
        __builtin_amdgcn_s_sleep(1);
        if ((++sp & 255u) == 0u) { if (xb_ld(&bar[XB_TMO])) break; if (sp > XB_SPIN_CAP) { atomicAdd(&bar[XB_TMO], 1u); break; } }
    }
    nloc = mine > 0u ? mine : 1u; nx = cnt > 0u ? cnt : 1u;
}
__device__ __forceinline__ void xcd_barrier(const XcdBarrier& b) {
    asm volatile("s_waitcnt vmcnt(0)" ::: "memory");
    __syncthreads();
    if (threadIdx.x == 0) {
        unsigned* bar = b.bar;
        __builtin_amdgcn_s_waitcnt(0);
        unsigned nloc = b.st[0], nx = b.st[1];
        if (nloc == 0u) { xcd_barrier_complete(bar, b.x, nloc, nx); b.st[0] = nloc; b.st[1] = nx; }
        const unsigned old = xb_add(&bar[XB_XSUB(b.x)], 1u);
        const unsigned gen = old / nloc;
        if (old + 1u == (gen + 1u) * nloc) {
            __builtin_amdgcn_fence(__ATOMIC_RELEASE, "agent");
            asm volatile("s_waitcnt vmcnt(0)" ::: "memory");
            const unsigned og = xb_add(&bar[XB_TOP], 1u);
            const unsigned tg = og / nx;
            if (og + 1u == (tg + 1u) * nx) xb_add(&bar[XB_TOPGEN], 1u);
            else XB_SPIN(xb_ld(&bar[XB_TOPGEN]) == tg, bar);
            __builtin_amdgcn_fence(__ATOMIC_ACQUIRE, "agent");
            asm volatile("s_waitcnt vmcnt(0)" ::: "memory");
        } else {
            XB_SPIN(xb_ld(&bar[XB_TOPGEN]) == gen, bar);
            __builtin_amdgcn_fence(__ATOMIC_ACQUIRE, "agent");
            asm volatile("s_waitcnt vmcnt(0)" ::: "memory");
        }
    }
    __syncthreads();
}

struct Ctx {
    LAS unsigned char* lds;
    int tid, lane, wave, wg, G;
    const float *x, *c, *w_ada, *b_ada, *g1, *w_in, *lb_logits, *g_hgrn, *w_pa, *w_pb, *w_out, *g2, *w_router, *rbias, *w_egu, *w_edown, *w_sgu, *w_sdown, *g_final;
    const int* positions;
    float* out;
    unsigned char* ws;
};
#define WSP(type, off) ((type*)(X.ws + (off)))

__device__ __forceinline__ void transpose_item(const float* W, int K, int N, bf16_t* WT, int dst_row0, int src_col0, int k0, LAS float* scr, int lane) {
#pragma unroll 16
    for (int i = 0; i < 32; ++i) { const int kk = 2 * i + (lane >> 5); scr[kk * 33 + (lane & 31)] = W[(size_t)(k0 + kk) * N + src_col0 + (lane & 31)]; }
    LDS_WAIT(); asm volatile("" ::: "memory");
    const int c = lane & 7;
#pragma unroll
    for (int j = 0; j < 4; ++j) { const int n = (lane >> 3) + 8 * j; const LAS float* s = scr + (8 * c) * 33 + n;
        u32x4 o; o.x = pk2(s[0 * 33], s[1 * 33]); o.y = pk2(s[2 * 33], s[3 * 33]); o.z = pk2(s[4 * 33], s[5 * 33]); o.w = pk2(s[6 * 33], s[7 * 33]);
        *(u32x4*)(WT + (size_t)(dst_row0 + n) * K + k0 + 8 * c) = o; }
    LDS_WAIT(); asm volatile("" ::: "memory");
}
__device__ __forceinline__ void transpose_plain(const float* W, int K, int N, bf16_t* WT, int item, LAS float* scr, int lane) {
    const int nblk = N / 32, kb = item / nblk, nb = item % nblk;
    transpose_item(W, K, N, WT, nb * 32, nb * 32, kb * 64, scr, lane);
}
__device__ __forceinline__ void p0_prologue(Ctx& X) {
    LAS float* scr = (LAS float*)(X.lds + X.wave * 16384);
    const int gw = X.wg * NWAVES + X.wave, NGW = X.G * NWAVES;
    {
        float* MODP = WSP(float, WS_MODP);
        for (int it = gw; it < 96 * 16; it += NGW) {
            const int jc = it % 96, kc = it / 96, j = jc * 64 + X.lane;
            float a0 = 0.f, a1 = 0.f, a2 = 0.f, a3 = 0.f;
#pragma unroll 16
            for (int kk = 0; kk < 64; ++kk) { const int k = kc * 64 + kk; const float w = X.w_ada[(size_t)k * 6144 + j];
                const float c0 = X.c[k], c1 = X.c[1024 + k], c2 = X.c[2048 + k], c3 = X.c[3072 + k];
                a0 += c0 * sigmoidf_(c0) * w; a1 += c1 * sigmoidf_(c1) * w; a2 += c2 * sigmoidf_(c2) * w; a3 += c3 * sigmoidf_(c3) * w; }
            float* o = MODP + (size_t)kc * 24576 + j;
            st_wt4(o, __builtin_bit_cast(unsigned, a0)); st_wt4(o + 6144, __builtin_bit_cast(unsigned, a1)); st_wt4(o + 12288, __builtin_bit_cast(unsigned, a2)); st_wt4(o + 18432, __builtin_bit_cast(unsigned, a3));
        }
    }
    {
        float* ROPE = WSP(float, WS_ROPE);
        const int gt = X.wg * NTHREADS + X.tid, NGT = X.G * NTHREADS;
        for (int idx = gt; idx < T * 8; idx += NGT) { const int t = idx >> 3, i = idx & 7;
            const float inv_freq = 1.0f / powf(500000.0f, (float)(2 * i) / 16.0f);
            const float ang = (float)X.positions[t] * inv_freq;
            ROPE[t * 16 + i] = cosf(ang); ROPE[t * 16 + 8 + i] = sinf(ang); }
        if (X.wg == 0) { float* LB = WSP(float, WS_LB);
            for (int j = X.tid; j < 512; j += NTHREADS) { const float l0 = X.lb_logits[j], l1 = X.lb_logits[512 + j], m = fmaxf(l0, l1), e0 = __expf(l0 - m), e1 = __expf(l1 - m); LB[j] = e0 / (e0 + e1); } }
    }
}
struct CvtItem { const float* src; bf16_t* dst; };
template <bool GU> __device__ __forceinline__ CvtItem cvt_item(const Ctx& X, int it) {
    CvtItem c;
    if constexpr (GU) { const int e = it >> 7, q = it & 127, w8 = q & 7, sq = q >> 3, kb = 4 * (sq >> 2) + (w8 & 3), nb = 2 * (sq & 3) + (w8 >> 2);
        const int n0 = nb * 64, pn = n0 >> 8, bj = (n0 >> 7) & 1, idx = n0 & 127, srcc = bj * 256 + pn * 128 + idx;
        const float* W = (e < NE) ? X.w_egu + (size_t)e * 1024 * 512 : X.w_sgu;
        c.src = W + (size_t)(kb * 64) * 512 + srcc; c.dst = (bf16_t*)(X.ws + WS_WGU + ((size_t)e * 512 + n0) * 1024 + kb * 64); }
    else { const int e = it >> 6, q = it & 63, w8 = q & 7, sq = q >> 3, kb = w8 & 3, nb = 2 * sq + (w8 >> 2);
        const float* W = (e < NE) ? X.w_edown + (size_t)e * 256 * 1024 : X.w_sdown;
        c.src = W + (size_t)(kb * 64) * 1024 + nb * 64; c.dst = (bf16_t*)(X.ws + WS_WD + ((size_t)e * 1024 + nb * 64) * 256 + kb * 64); }
    return c;
}
template <int KB> __device__ __forceinline__ void cvt_store8(const CvtItem& c, int lane, const f32x4 (&v)[16], LAS unsigned char* tl, float sc) {
    const int kq = lane >> 4, nq = lane & 15;
#pragma unroll
    for (int i = 0; i < 4; ++i) { u32x4 w;
        w.x = pk4_fp8(v[0][i] * sc, v[1][i] * sc, v[2][i] * sc, v[3][i] * sc); w.y = pk4_fp8(v[4][i] * sc, v[5][i] * sc, v[6][i] * sc, v[7][i] * sc);
        w.z = pk4_fp8(v[8][i] * sc, v[9][i] * sc, v[10][i] * sc, v[11][i] * sc); w.w = pk4_fp8(v[12][i] * sc, v[13][i] * sc, v[14][i] * sc, v[15][i] * sc);
        *(LAS u32x4*)(tl + (4 * nq + i) * 80 + kq * 16) = w; }
    LDS_WAIT(); asm volatile("" ::: "memory");
    const int ch = lane & 3, r = lane >> 2;
    unsigned char* d8 = (unsigned char*)c.dst;
#pragma unroll
    for (int j = 0; j < 4; ++j) { const int n = 16 * j + r; const u32x4 w = *(const LAS u32x4*)(tl + n * 80 + ch * 16); __builtin_nontemporal_store(w, (u32x4*)(d8 + (size_t)n * KB + 16 * ch)); }
    LDS_WAIT(); asm volatile("" ::: "memory");
}
template <int N> __device__ __forceinline__ void cvt_load(const CvtItem& c, int lane, f32x4 (&v)[16]) {
    const float* p = c.src + (size_t)(16 * (lane >> 4)) * N + 4 * (lane & 15);
#pragma unroll
    for (int j = 0; j < 16; ++j) v[j] = __builtin_nontemporal_load((const f32x4*)(p + (size_t)j * N));
}
template <int K> __device__ __forceinline__ void cvt_store(const CvtItem& c, int lane, const f32x4 (&v)[16], LAS unsigned char* tl) {
    const int kq = lane >> 4, nq = lane & 15;
#pragma unroll
    for (int i = 0; i < 4; ++i) { u32x4 w0, w1;
        w0.x = pk2(v[0][i], v[1][i]); w0.y = pk2(v[2][i], v[3][i]); w0.z = pk2(v[4][i], v[5][i]); w0.w = pk2(v[6][i], v[7][i]);
        w1.x = pk2(v[8][i], v[9][i]); w1.y = pk2(v[10][i], v[11][i]); w1.z = pk2(v[12][i], v[13][i]); w1.w = pk2(v[14][i], v[15][i]);
        LAS unsigned char* q = tl + (4 * nq + i) * 144 + kq * 32; *(LAS u32x4*)q = w0; *(LAS u32x4*)(q + 16) = w1; }
    LDS_WAIT(); asm volatile("" ::: "memory");
    const int ch = lane & 7, r = lane >> 3;
#pragma unroll
    for (int j = 0; j < 8; ++j) { const int n = 8 * j + r; const u32x4 w = *(const LAS u32x4*)(tl + n * 144 + ch * 16); __builtin_nontemporal_store(w, (u32x4*)(c.dst + (size_t)n * K + 8 * ch)); }
    LDS_WAIT(); asm volatile("" ::: "memory");
}
struct CvtPair { const float* src; unsigned char* dst; };
template <bool GU> __device__ __forceinline__ CvtPair cvt_pair(const Ctx& X, int di) {
    CvtPair c;
    if constexpr (GU) { const int e = di >> 6, q = di & 63, nb = q & 7, kb2 = q >> 3;
        const int n0 = nb * 64, pn = n0 >> 8, bj = (n0 >> 7) & 1, idx = n0 & 127, srcc = bj * 256 + pn * 128 + idx;
        const float* W = (e < NE) ? X.w_egu + (size_t)e * 1024 * 512 : X.w_sgu;
        c.src = W + (size_t)(kb2 * 128) * 512 + srcc; c.dst = X.ws + WS_WGU + ((size_t)e * 512 + n0) * 1024 + kb2 * 128; }
    else { const int e = di >> 5, q = di & 31, nb = q & 15, kb2 = q >> 4;
        const float* W = (e < NE) ? X.w_edown + (size_t)e * 256 * 1024 : X.w_sdown;
        c.src = W + (size_t)(kb2 * 128) * 1024 + nb * 64; c.dst = X.ws + WS_WD + ((size_t)e * 1024 + nb * 64) * 256 + kb2 * 128; }
    return c;
}
template <int N> __device__ __forceinline__ void cvt_load_half(const CvtPair& c, int half, int lane, f32x4 (&v)[16]) {
    const float* p = c.src + (size_t)(64 * half + 16 * (lane >> 4)) * N + 4 * (lane & 15);
#pragma unroll
    for (int j = 0; j < 16; ++j) v[j] = __builtin_nontemporal_load((const f32x4*)(p + (size_t)j * N));
}
__device__ __forceinline__ void cvt_half_to_lds(int half, int lane, const f32x4 (&v)[16], LAS unsigned char* tl, float sc) {
    const int kq = lane >> 4, nq = lane & 15;
#pragma unroll
    for (int i = 0; i < 4; ++i) { u32x4 w;
        w.x = pk4_fp8(v[0][i] * sc, v[1][i] * sc, v[2][i] * sc, v[3][i] * sc); w.y = pk4_fp8(v[4][i] * sc, v[5][i] * sc, v[6][i] * sc, v[7][i] * sc);
        w.z = pk4_fp8(v[8][i] * sc, v[9][i] * sc, v[10][i] * sc, v[11][i] * sc); w.w = pk4_fp8(v[12][i] * sc, v[13][i] * sc, v[14][i] * sc, v[15][i] * sc);
        *(LAS u32x4*)(tl + (4 * nq + i) * 144 + half * 64 + kq * 16) = w; }
}
template <int KB> __device__ __forceinline__ void cvt_flush(const CvtPair& c, int lane, LAS unsigned char* tl) {
    LDS_WAIT(); asm volatile("" ::: "memory");
    const int ch = lane & 7, r = lane >> 3;
#pragma unroll
    for (int j = 0; j < 8; ++j) { const int n = 8 * j + r; const u32x4 w = *(const LAS u32x4*)(tl + n * 144 + ch * 16); __builtin_nontemporal_store(w, (u32x4*)(c.dst + (size_t)n * KB + 16 * ch)); }
    LDS_WAIT(); asm volatile("" ::: "memory");
}
template <bool GU> __device__ __forceinline__ void expert_convert_set(Ctx& X, int gw, int NGW, LAS unsigned char* tl) {
    constexpr int NIT = GU ? NEX * 64 : NEX * 32, N = GU ? 512 : 1024, K = GU ? 1024 : 256; constexpr float SC = GU ? WGU_SCALE : WD_SCALE;
    if (gw >= NIT) return;
    const int nmine = (NIT - gw + NGW - 1) / NGW;
    f32x4 va[16], vb[16];
    CvtPair cur = cvt_pair<GU>(X, gw);
    cvt_load_half<N>(cur, 0, X.lane, va); cvt_load_half<N>(cur, 1, X.lane, vb);
    for (int j = 0; j < nmine; ++j) {
        const CvtPair nxt = cvt_pair<GU>(X, gw + (j + 1 < nmine ? j + 1 : j) * NGW);
        __builtin_amdgcn_sched_barrier(0);
        cvt_half_to_lds(0, X.lane, va, tl, SC);
        __builtin_amdgcn_sched_barrier(0);
        cvt_load_half<N>(nxt, 0, X.lane, va);
        __builtin_amdgcn_sched_barrier(0);
        cvt_half_to_lds(1, X.lane, vb, tl, SC);
        cvt_flush<K>(cur, X.lane, tl);
        __builtin_amdgcn_sched_barrier(0);
        cvt_load_half<N>(nxt, 1, X.lane, vb);
        __builtin_amdgcn_sched_barrier(0);
        cur = nxt;
    }
}
__device__ __forceinline__ void expert_convert(Ctx& X, int cw, int ncw) {
    LAS unsigned char* tl = X.lds + X.wave * 16384;
    const int gw = cw * NWAVES + X.wave, NGW = ncw * NWAVES;
    expert_convert_set<true>(X, gw, NGW, tl);
    expert_convert_set<false>(X, gw, NGW, tl);
}

__device__ __forceinline__ void small_transposes(Ctx& X) {
    LAS float* scr = (LAS float*)(X.lds + 16384 + X.wave * 12288);
    const int gw = X.wg * NWAVES + X.wave, NGW = X.G * NWAVES;
    {
        constexpr int I_IN = 16 * 272, I_PA = 8 * 32, I_PB = 8 * 32, I_OUT = 16 * 32, I_R = 16 * 8;
        constexpr int NITEMS = I_IN + I_PA + I_PB + I_OUT + I_R;
        for (int it = gw; it < NITEMS; it += NGW) {
            int r = it;
            if (r < I_IN) { transpose_plain(X.w_in, 1024, INW, WSP(bf16_t, WS_WIN), r, scr, X.lane); continue; } r -= I_IN;
            if (r < I_PA) { transpose_plain(X.w_pa, 512, 1024, WSP(bf16_t, WS_WPA), r, scr, X.lane); continue; } r -= I_PA;
            if (r < I_PB) { transpose_plain(X.w_pb, 512, 1024, WSP(bf16_t, WS_WPB), r, scr, X.lane); continue; } r -= I_PB;
            if (r < I_OUT) { transpose_plain(X.w_out, 1024, 1024, WSP(bf16_t, WS_WOUT), r, scr, X.lane); continue; } r -= I_OUT;
            transpose_plain(X.w_router, 1024, 256, WSP(bf16_t, WS_WR), r, scr, X.lane);
        }
    }
}

__device__ __forceinline__ void norm_rows(Ctx& X, int which) {
    LAS float* sm = (LAS float*)X.lds;
    const float* MODP = WSP(float, WS_MODP); float* MOD = WSP(float, WS_MOD);
    const int rows_per_wg = T / X.G, row0 = X.wg * rows_per_wg, b = row0 / SEQ;
    if (which == 0) {
        for (int i = X.tid; i < 2048; i += NTHREADS) { const int j = b * 6144 + i; float s = X.b_ada[i];
#pragma unroll
            for (int p = 0; p < 16; ++p) s += MODP[(size_t)p * 24576 + j];
            sm[i] = s; }
        const int per = 24576 / X.G;
        for (int i = X.tid; i < per; i += NTHREADS) { const int j = X.wg * per + i; float s = X.b_ada[j % 6144];
#pragma unroll
            for (int p = 0; p < 16; ++p) s += MODP[(size_t)p * 24576 + j];
            MOD[j] = s; }
    } else {
        for (int i = X.tid; i < 2048; i += NTHREADS) sm[i] = MOD[b * 6144 + 3072 + i];
    }
    __syncthreads();
    const float* src = X.x; const bf16_t* srcb = WSP(bf16_t, WS_X1); const float* g = which == 0 ? X.g1 : X.g2;
    bf16_t* H = WSP(bf16_t, WS_H);
    for (int r = X.wave; r < rows_per_wg; r += NWAVES) {
        const int row = row0 + r;
        f32x4 v[2][2]; float s = 0.f;
#pragma unroll
        for (int j = 0; j < 2; ++j) { const int col = 8 * X.lane + 512 * j;
            if (which == 0) { v[j][0] = *(const f32x4*)(src + (size_t)row * D + col); v[j][1] = *(const f32x4*)(src + (size_t)row * D + col + 4); }
            else { const u32x4 wv = *(const u32x4*)(srcb + (size_t)row * D + col); v[j][0] = (f32x4){bflo(wv.x), bfhi(wv.x), bflo(wv.y), bfhi(wv.y)}; v[j][1] = (f32x4){bflo(wv.z), bfhi(wv.z), bflo(wv.w), bfhi(wv.w)}; }
#pragma unroll
            for (int q = 0; q < 2; ++q) s += (v[j][q].x * v[j][q].x + v[j][q].y * v[j][q].y) + (v[j][q].z * v[j][q].z + v[j][q].w * v[j][q].w); }
        const float rstd = rsqrtf(wave_sum(s) * (1.f / D) + EPS);
#pragma unroll
        for (int j = 0; j < 2; ++j) { const int col = 8 * X.lane + 512 * j; float y[8];
#pragma unroll
            for (int q = 0; q < 2; ++q) { const f32x4 gg = *(const f32x4*)(g + col + 4 * q), sh = *(const LAS f32x4*)(sm + col + 4 * q), sc = *(const LAS f32x4*)(sm + 1024 + col + 4 * q);
#pragma unroll
                for (int e = 0; e < 4; ++e) y[4 * q + e] = v[j][q][e] * rstd * gg[e] * (1.f + sc[e]) + sh[e]; }
            u32x4 hw; hw.x = pk2(y[0], y[1]); hw.y = pk2(y[2], y[3]); hw.z = pk2(y[4], y[5]); hw.w = pk2(y[6], y[7]);
            if (which == 1) { st_wt16(H + (size_t)row * D + col, hw);
                st_wt8(WSP(unsigned char, WS_H8) + (size_t)row * D + col, (unsigned long long)pk4_fp8(y[0], y[1], y[2], y[3]) | ((unsigned long long)pk4_fp8(y[4], y[5], y[6], y[7]) << 32)); }
            else *(u32x4*)(H + (size_t)row * D + col) = hw; }
    }
    __syncthreads();
}

struct RegSched {
    static constexpr bool HALFSKIP = false;
    const char* A; const char* Bt; size_t a_tile, b_tile; int nM, nN, G, c;
    __device__ __forceinline__ bool next(int i, pg8::Unit& u) const {
        const int L = i * G + c; if (L >= nM * nN) return false;
        int pm, pn; pg8::swz_tile(L, nM, nN, pm, pn);
        u.a = A + (size_t)pm * a_tile; u.b = Bt + (size_t)pn * b_tile; u.rows = nullptr; u.pm = pm; u.pn = pn; u.aux = 0; u.nvalid = 256; return true;
    }
};
struct TwoPartSched {      static constexpr bool HALFSKIP = false;
    const char* Y; const char* Wa; const char* Wb; int nM, nN, G, c;
    __device__ __forceinline__ bool next(int i, pg8::Unit& u) const {
        const int L = (i >> 1) * G + c, part = i & 1; if (L >= nM * nN) return false;
        int pm, pn; pg8::swz_tile(L, nM, nN, pm, pn);
        u.a = Y + (size_t)pm * 256 * 2048 + part * 1024; u.b = (part ? Wb : Wa) + (size_t)pn * 256 * 1024; u.rows = nullptr; u.pm = pm; u.pn = pn; u.aux = part; u.nvalid = 256; return true;
    }
};
struct MoeSched {
    static constexpr bool HALFSKIP = true;
    const LAS int* tbl; const LAS int* cnts; int nent; const char* A; const char* W; const int* lists; int ncol  , wtile  , wexp  , atile  , G, c;
    __device__ __forceinline__ bool next(int i, pg8::Unit& u) const {
        const int un = i * (G >> 3) + (c >> 3); if (un >= nent * ncol) return false;
        const int pn = un % ncol; const int ent = __builtin_amdgcn_readfirstlane(tbl[un / ncol]), e = (ent >> 7) & 511, r = ent & 127, rt = ent >> 16;
        u.a = A + (size_t)rt * atile; u.b = W + (size_t)e * wexp + (size_t)pn * wtile; u.rows = lists + (size_t)e * 16384 + r * 256;
        u.pm = rt; u.pn = pn; u.aux = e; const int left = __builtin_amdgcn_readfirstlane(cnts[e]) - r * 256; u.nvalid = left < 256 ? left : 256; return true;
    }
};

__device__ __forceinline__ unsigned dpp_xor1(unsigned x) { return (unsigned)__builtin_amdgcn_update_dpp(0, (int)x, 0xB1, 0xF, 0xF, true); }
__device__ __forceinline__ void pair_rows(const u32x4& w0, const u32x4& w1, bool oddr, u32x4& ev, u32x4& od) {
    const u32x4 snd = oddr ? w0 : w1;
    u32x4 rcv; rcv.x = dpp_xor1(snd.x); rcv.y = dpp_xor1(snd.y); rcv.z = dpp_xor1(snd.z); rcv.w = dpp_xor1(snd.w);
    ev = oddr ? rcv : w0; od = oddr ? w1 : rcv;
}
struct EpiInproj {
    static constexpr bool PERM = true;
    static constexpr bool BJADJ = true;
    bf16_t* PROJ; float* LOGF; const float* LB; const float* ROPE; unsigned char* G8; unsigned char* QK8;
    __device__ __forceinline__ bool keep(const pg8::Unit&) const { return false; }
    __device__ __forceinline__ void operator()(f32x4 (&acc)[2][2][4][2], const pg8::Unit& u, int wr, int wc, int fr, int fq) const {
        const int pn = u.pn;
        const int mode = pn < 2 ? 0 : pn < 4 ? 1 : pn < 6 ? 0 : pn < 8 ? 2 : pn < 20 ? 3 : pn < 26 ? 5 : 4;
        const int row0 = u.pm * 256 + wr * 64 + fr, colb = pn * 256 + wc * 64 + 8 * fq;
        const bool rot3 = (mode == 3);
        const bool odd = fq & 1; const int colw = pn * 256 + wc * 64 + (fq & 1) * 32 + (fq >> 1) * 16;
#pragma unroll
        for (int ai = 0; ai < 2; ++ai)
#pragma unroll
            for (int m = 0; m < 4; ++m) {
                const int row = row0 + ai * 128 + m * 16;
                f32x4 cs0, cs1, sn0, sn1;
                if (rot3) { const f32x4* rp = (const f32x4*)(ROPE + (size_t)row * 16); cs0 = rp[0]; cs1 = rp[1]; sn0 = rp[2]; sn1 = rp[3]; }
                u32x2 p8[2]; u32x4 wb[2];
#pragma unroll
                for (int bj = 0; bj < 2; ++bj) {
                    const int col = colb + bj * 32; const bool rot = rot3 && bj == 0;
                    f32x4 v0 = acc[ai][bj][m][0], v1 = acc[ai][bj][m][1];
                    if (mode == 1) {
                        const int cf = col - 512; const f32x4 l0 = *(const f32x4*)(LB + cf), l1 = *(const f32x4*)(LB + cf + 4);
                        f32x4 lf0, lf1;
#pragma unroll
                        for (int j = 0; j < 4; ++j) { float sg = sigmoidf_(v0[j]); float f = l0[j] + (1.f - l0[j]) * sg; lf0[j] = fast_logf(f); v0[j] = (1.f - l0[j]) * (1.f - sg);
                            sg = sigmoidf_(v1[j]); f = l1[j] + (1.f - l1[j]) * sg; lf1[j] = fast_logf(f); v1[j] = (1.f - l1[j]) * (1.f - sg); }
                        acc[ai][bj][m][0] = lf0; acc[ai][bj][m][1] = lf1;
                    } else if (mode == 2) {
#pragma unroll
                        for (int j = 0; j < 4; ++j) { v0[j] = v0[j] * sigmoidf_(v0[j]); v1[j] = v1[j] * sigmoidf_(v1[j]); }
                    } else if (mode == 4) {
#pragma unroll
                        for (int j = 0; j < 4; ++j) { v0[j] = sigmoidf_(v0[j]); v1[j] = sigmoidf_(v1[j]); }
                    } else if (rot) {
                        f32x4 p0, p1;
#pragma unroll
                        for (int j = 0; j < 4; ++j) { p0[j] = __shfl_xor(v0[j], 16); p1[j] = __shfl_xor(v1[j], 16); }
                        if (fq == 0) { v0 = v0 * cs0 - p0 * sn0; v1 = v1 * cs1 - p1 * sn1; }
                        else if (fq == 1) { v0 = v0 * cs0 + p0 * sn0; v1 = v1 * cs1 + p1 * sn1; }
                    }
                    if (mode == 4) {
                        int g0 = 0, g1 = 0;
#pragma unroll
                        for (int j = 0; j < 4; ++j) { g0 = __builtin_amdgcn_cvt_pk_u8_f32(fmaxf(v0[j] * 255.0f, 1.0f), j, g0); g1 = __builtin_amdgcn_cvt_pk_u8_f32(fmaxf(v1[j] * 255.0f, 1.0f), j, g1); }
                        p8[bj] = (u32x2){(unsigned)g0, (unsigned)g1};
                        continue; }
                    if (mode == 3 || mode == 5) {
                        p8[bj] = (u32x2){pk4_fp8(v0[0], v0[1], v0[2], v0[3]), pk4_fp8(v1[0], v1[1], v1[2], v1[3])};
                        continue; }
                    wb[bj].x = pg8::cvt_pk_bf16(v0[0], v0[1]); wb[bj].y = pg8::cvt_pk_bf16(v0[2], v0[3]); wb[bj].z = pg8::cvt_pk_bf16(v1[0], v1[1]); wb[bj].w = pg8::cvt_pk_bf16(v1[2], v1[3]);
                }
                if (mode < 3) {
                    u32x4 ev, od; pair_rows(wb[0], wb[1], fr & 1, ev, od);
                    bf16_t* pp = PROJ + (size_t)(row - (fr & 1)) * INW + colb + (fr & 1) * 32;
                    *(u32x4*)pp = ev; *(u32x4*)(pp + INW) = od;
                }
                if (mode >= 3) {
                    const u32x2 snd = odd ? p8[0] : p8[1];
                    u32x2 rcv; rcv.x = (unsigned)__shfl_xor((int)snd.x, 16); rcv.y = (unsigned)__shfl_xor((int)snd.y, 16);
                    const u32x4 w = odd ? (u32x4){rcv.x, rcv.y, p8[1].x, p8[1].y} : (u32x4){p8[0].x, p8[0].y, rcv.x, rcv.y};
                    if (mode == 4) *(u32x4*)(G8 + (size_t)row * 2048 + (colw - C_GA)) = w;
                    else *(u32x4*)(QK8 + (size_t)row * 4608 + (colw - C_AQ)) = w;
                }
            }
        if (mode == 1) {
            const int lane = fq * 16 + fr;
#pragma unroll
            for (int ai = 0; ai < 2; ++ai)
#pragma unroll
                for (int bj = 0; bj < 2; ++bj)
#pragma unroll
                    for (int n = 0; n < 2; ++n)
#pragma unroll
                        for (int j = 0; j < 4; ++j) { float carry = 0.f;
#pragma unroll
                            for (int m = 0; m < 4; ++m) { float v = acc[ai][bj][m][n][j];
                                v += __builtin_bit_cast(float, __builtin_amdgcn_update_dpp(0, __builtin_bit_cast(int, v), 0x111, 0xF, 0xF, true));
                                v += __builtin_bit_cast(float, __builtin_amdgcn_update_dpp(0, __builtin_bit_cast(int, v), 0x112, 0xF, 0xF, true));
                                v += __builtin_bit_cast(float, __builtin_amdgcn_update_dpp(0, __builtin_bit_cast(int, v), 0x114, 0xF, 0xF, true));
                                v += __builtin_bit_cast(float, __builtin_amdgcn_update_dpp(0, __builtin_bit_cast(int, v), 0x118, 0xF, 0xF, true));
                                v += carry; acc[ai][bj][m][n][j] = v; carry = __shfl(v, (lane & 48) | 15); } }
#pragma unroll
            for (int ai = 0; ai < 2; ++ai)
#pragma unroll
                for (int m = 0; m < 4; ++m)
#pragma unroll
                    for (int bj = 0; bj < 2; ++bj) { float* lp = LOGF + (size_t)(row0 + ai * 128 + m * 16) * 512 + (colb + bj * 32 - 512); *(f32x4*)lp = acc[ai][bj][m][0]; *(f32x4*)(lp + 4) = acc[ai][bj][m][1]; }
        }
    }
};
__device__ __forceinline__ void gate8(u32x2 w, f32x4& lo, f32x4& hi) {
    constexpr float s = 1.0f / 255.0f;
    lo = (f32x4){(float)(w.x & 255u), (float)((w.x >> 8) & 255u), (float)((w.x >> 16) & 255u), (float)(w.x >> 24)} * s;
    hi = (f32x4){(float)(w.y & 255u), (float)((w.y >> 8) & 255u), (float)((w.y >> 16) & 255u), (float)(w.y >> 24)} * s;
}
struct EpiMixed {
    static constexpr bool PERM = true;
    static constexpr bool BJADJ = true;
    const unsigned char* G8; bf16_t* MIXED;
    __device__ __forceinline__ bool keep(const pg8::Unit& u) const { return u.aux == 0; }
    __device__ __forceinline__ void operator()(f32x4 (&acc)[2][2][4][2], const pg8::Unit& u, int wr, int wc, int fr, int fq) const {
        const int row0 = u.pm * 256 + wr * 64 + fr, colb = u.pn * 256 + wc * 64 + 8 * fq;
#pragma unroll
        for (int ai = 0; ai < 2; ++ai)
#pragma unroll
            for (int m = 0; m < 4; ++m) {
                const int row = row0 + ai * 128 + m * 16;
                u32x4 wb[2];
#pragma unroll
                for (int bj = 0; bj < 2; ++bj) {
                    const int col = colb + bj * 32;
                    f32x4 b0, b1; gate8(*(const u32x2*)(G8 + (size_t)row * 2048 + 1024 + col), b0, b1);
                    if (u.aux == 0) {
                        f32x4 a0, a1; gate8(*(const u32x2*)(G8 + (size_t)row * 2048 + col), a0, a1);
#pragma unroll
                        for (int j = 0; j < 4; ++j) { acc[ai][bj][m][0][j] *= a0[j] * __builtin_amdgcn_rcpf(b0[j]); acc[ai][bj][m][1][j] *= a1[j] * __builtin_amdgcn_rcpf(b1[j]); }
                    } else {
                        const f32x4 v0 = acc[ai][bj][m][0] * b0, v1 = acc[ai][bj][m][1] * b1;
                        wb[bj].x = pg8::cvt_pk_bf16(v0[0], v0[1]); wb[bj].y = pg8::cvt_pk_bf16(v0[2], v0[3]); wb[bj].z = pg8::cvt_pk_bf16(v1[0], v1[1]); wb[bj].w = pg8::cvt_pk_bf16(v1[2], v1[3]);
                    }
                }
                if (u.aux != 0) {
                    u32x4 ev, od; pair_rows(wb[0], wb[1], fr & 1, ev, od);
                    bf16_t* pp = MIXED + (size_t)(row - (fr & 1)) * D + colb + (fr & 1) * 32;
                    st_wt16(pp, ev); st_wt16(pp + D, od);
                }
            }
    }
};
struct EpiOutproj {
    static constexpr bool PERM = true;
    const float* x; const float* MOD; bf16_t* X1;
    __device__ __forceinline__ bool keep(const pg8::Unit&) const { return false; }
    __device__ __forceinline__ void operator()(f32x4 (&acc)[2][2][4][2], const pg8::Unit& u, int wr, int wc, int fr, int fq) const {
        const int row0 = u.pm * 256 + wr * 64 + fr, colb = u.pn * 256 + wc * 32 + 8 * fq;
        const int b = (u.pm * 256) / SEQ;
#pragma unroll
        for (int bj = 0; bj < 2; ++bj) {
            const int col = colb + bj * 128;
            const f32x4 g0 = *(const f32x4*)(MOD + b * 6144 + 2048 + col), g1 = *(const f32x4*)(MOD + b * 6144 + 2048 + col + 4);
#pragma unroll
            for (int ai = 0; ai < 2; ++ai)
#pragma unroll
                for (int m = 0; m < 4; ++m) { const size_t off = (size_t)(row0 + ai * 128 + m * 16) * D + col;
                    const f32x4 v0 = *(const f32x4*)(x + off) + g0 * acc[ai][bj][m][0], v1 = *(const f32x4*)(x + off + 4) + g1 * acc[ai][bj][m][1];
                    u32x4 w; w.x = pg8::cvt_pk_bf16(v0[0], v0[1]); w.y = pg8::cvt_pk_bf16(v0[2], v0[3]); w.z = pg8::cvt_pk_bf16(v1[0], v1[1]); w.w = pg8::cvt_pk_bf16(v1[2], v1[3]);
                    st_wt16(X1 + off, w); }
        }
    }
};
struct EpiOutNorm {
    static constexpr bool PERM = true;
    const float* x; const float* MOD; const float* g2; bf16_t* X1; bf16_t* H; unsigned char* H8; float* XB; unsigned* cnt; LAS unsigned char* sl;
    __device__ __forceinline__ bool keep(const pg8::Unit&) const { return false; }
    __device__ __forceinline__ void operator()(f32x4 (&acc)[2][2][4][2], const pg8::Unit& u, int wr, int wc, int fr, int fq) const {
        const int tid = threadIdx.x;
        const int rl0 = wr * 64 + fr, row0 = u.pm * 256 + rl0, colb = u.pn * 256 + wc * 32 + 8 * fq;
        const int b = (u.pm * 256) / SEQ;
        LAS float* Pt = (LAS float*)sl; LAS float* Rs = (LAS float*)(sl + 4096);
#pragma unroll
        for (int bj = 0; bj < 2; ++bj) {
            const int col = colb + bj * 128;
            const f32x4 g0 = *(const f32x4*)(MOD + b * 6144 + 2048 + col), g1 = *(const f32x4*)(MOD + b * 6144 + 2048 + col + 4);
#pragma unroll
            for (int ai = 0; ai < 2; ++ai)
#pragma unroll
                for (int m = 0; m < 4; ++m) { const size_t off = (size_t)(row0 + ai * 128 + m * 16) * D + col;
                    acc[ai][bj][m][0] = *(const f32x4*)(x + off) + g0 * acc[ai][bj][m][0]; acc[ai][bj][m][1] = *(const f32x4*)(x + off + 4) + g1 * acc[ai][bj][m][1];
                    asm volatile("" : "+v"(acc[ai][bj][m][0]), "+v"(acc[ai][bj][m][1]));
                    if (m & 1) asm volatile("" ::: "memory"); }
        }
#pragma unroll
        for (int ai = 0; ai < 2; ++ai)
#pragma unroll
            for (int m = 0; m < 4; ++m) { float q = 0.f;
#pragma unroll
                for (int bj = 0; bj < 2; ++bj)
#pragma unroll
                    for (int n = 0; n < 2; ++n) { const f32x4 v = acc[ai][bj][m][n]; q += (v[0] * v[0] + v[1] * v[1]) + (v[2] * v[2] + v[3] * v[3]); }
                q += __shfl_xor(q, 16); q += __shfl_xor(q, 32);
                if (fq == 0) Pt[(ai * 128 + rl0 + m * 16) * 4 + wc] = q; }
        asm volatile("s_waitcnt lgkmcnt(0)" ::: "memory"); __builtin_amdgcn_s_barrier(); asm volatile("" ::: "memory");
        if (tid < 256) { const f32x4 p = *(const LAS f32x4*)(Pt + tid * 4); st_wt4(XB + ((size_t)u.pm * 256 + tid) * 4 + u.pn, __builtin_bit_cast(unsigned, (p[0] + p[1]) + (p[2] + p[3]))); }
        asm volatile("s_waitcnt vmcnt(0)" ::: "memory"); __builtin_amdgcn_s_barrier(); asm volatile("" ::: "memory");
        if (tid == 0) { unsigned* p = cnt + (size_t)u.pm * 64; (void)xb_add(p, 1u); unsigned sp = 0u;
            while (xb_ld(p) < 4u) { __builtin_amdgcn_s_sleep(2); if (++sp > (1u << 22)) break; }
            __builtin_amdgcn_fence(__ATOMIC_ACQUIRE, "agent"); asm volatile("s_waitcnt vmcnt(0)" ::: "memory"); }
        __builtin_amdgcn_s_barrier(); asm volatile("" ::: "memory");
        if (tid < 256) { const f32x4 q = *(const f32x4*)(XB + ((size_t)u.pm * 256 + tid) * 4); Rs[tid] = rsqrtf(((q[0] + q[1]) + (q[2] + q[3])) * (1.f / D) + EPS); }
        asm volatile("s_waitcnt vmcnt(0) lgkmcnt(0)" ::: "memory"); __builtin_amdgcn_s_barrier(); asm volatile("" ::: "memory");
#pragma unroll
        for (int bj = 0; bj < 2; ++bj) {
            const int col = colb + bj * 128;
            f32x4 gg[2], sc[2], sh[2];
#pragma unroll
            for (int q = 0; q < 2; ++q) { gg[q] = *(const f32x4*)(g2 + col + 4 * q); sh[q] = *(const f32x4*)(MOD + b * 6144 + 3072 + col + 4 * q); sc[q] = *(const f32x4*)(MOD + b * 6144 + 4096 + col + 4 * q) + 1.0f; gg[q] = gg[q] * sc[q]; }
#pragma unroll
            for (int ai = 0; ai < 2; ++ai)
#pragma unroll
                for (int m = 0; m < 4; ++m) { const int rl = ai * 128 + rl0 + m * 16; const size_t off = (size_t)(u.pm * 256 + rl) * D + col; const float rs = Rs[rl];
                    const f32x4 v0 = acc[ai][bj][m][0], v1 = acc[ai][bj][m][1];
                    u32x4 w; w.x = pg8::cvt_pk_bf16(v0[0], v0[1]); w.y = pg8::cvt_pk_bf16(v0[2], v0[3]); w.z = pg8::cvt_pk_bf16(v1[0], v1[1]); w.w = pg8::cvt_pk_bf16(v1[2], v1[3]);
                    *(u32x4*)(X1 + off) = w;
                    const f32x4 h0 = v0 * rs * gg[0] + sh[0], h1 = v1 * rs * gg[1] + sh[1];
                    u32x4 hw; hw.x = pg8::cvt_pk_bf16(h0[0], h0[1]); hw.y = pg8::cvt_pk_bf16(h0[2], h0[3]); hw.z = pg8::cvt_pk_bf16(h1[0], h1[1]); hw.w = pg8::cvt_pk_bf16(h1[2], h1[3]);
                    st_wt16(H + off, hw);
                    st_wt8(H8 + off, (unsigned long long)pk4_fp8(h0[0], h0[1], h0[2], h0[3]) | ((unsigned long long)pk4_fp8(h1[0], h1[1], h1[2], h1[3]) << 32));
                    asm volatile("" ::: "memory"); }
        }
    }
};
struct EpiRouter {
    static constexpr bool PERM = false;
    float* LOGITS4;
    __device__ __forceinline__ bool keep(const pg8::Unit&) const { return false; }
    __device__ __forceinline__ void operator()(f32x4 (&acc)[2][2][4][2], const pg8::Unit& u, int wr, int wc, int fr, int fq) const {
        const int row0 = u.pm * 256 + wr * 64 + fr, colb = wc * 32 + 4 * fq;
        float* base = LOGITS4 + (size_t)u.aux * T * 256;
#pragma unroll
        for (int ai = 0; ai < 2; ++ai)
#pragma unroll
            for (int m = 0; m < 4; ++m)
#pragma unroll
                for (int bj = 0; bj < 2; ++bj)
#pragma unroll
                    for (int n = 0; n < 2; ++n) st_wt16(base + (size_t)(row0 + ai * 128 + m * 16) * 256 + colb + bj * 128 + n * 16, __builtin_bit_cast(u32x4, acc[ai][bj][m][n]));
    }
};
struct RouterSched {
    static constexpr bool HALFSKIP = false;
    const char* A; const char* Bt; int G, c;
    __device__ __forceinline__ bool next(int i, pg8::Unit& u) const {
        const int L = i * G + c; if (L >= 256) return false;
        const int pm = L >> 2, ks = L & 3;
        u.a = A + (size_t)pm * 256 * 2048 + ks * 512; u.b = Bt + ks * 512; u.rows = nullptr; u.pm = pm; u.pn = 0; u.aux = ks; u.nvalid = 256; return true;
    }
};
struct EpiGU {
    static constexpr bool PERM = true;
    unsigned char* ACT;
    __device__ __forceinline__ bool keep(const pg8::Unit&) const { return false; }
    __device__ __forceinline__ void operator()(f32x4 (&acc)[2][2][4][2], const pg8::Unit& u, int wr, int wc, int fr, int fq) const {
        const int rl0 = wr * 64 + fr, col = u.pn * 128 + wc * 32 + 8 * fq;
        constexpr float is = 1.0f / WGU_SCALE;
#pragma unroll
        for (int ai = 0; ai < 2; ++ai)
#pragma unroll
            for (int m = 0; m < 4; ++m) {
                const int rl = rl0 + ai * 128 + m * 16;
                f32x4 v0, v1;
#pragma unroll
                for (int j = 0; j < 4; ++j) { const float a0 = acc[ai][0][m][0][j] * is, a1 = acc[ai][0][m][1][j] * is;
                    v0[j] = a0 * sigmoidf_(a0) * (acc[ai][1][m][0][j] * is); v1[j] = a1 * sigmoidf_(a1) * (acc[ai][1][m][1][j] * is); }
                *(u32x2*)(ACT + ((size_t)u.pm * 256 + rl) * EFF + col) = (u32x2){pk4_fp8(v0[0], v0[1], v0[2], v0[3]), pk4_fp8(v1[0], v1[1], v1[2], v1[3])};
                asm volatile("" ::: "memory");
            }
    }
};
struct EpiDown {
    static constexpr bool PERM = true;
    static constexpr bool BJADJ = true;
    unsigned char* YBUF; const float* GATEW;
    __device__ __forceinline__ bool keep(const pg8::Unit&) const { return false; }
    __device__ __forceinline__ void operator()(f32x4 (&acc)[2][2][4][2], const pg8::Unit& u, int wr, int wc, int fr, int fq) const {
        const int rl0 = wr * 64 + fr, colw = u.pn * 256 + wc * 64 + (fq & 1) * 32 + (fq >> 1) * 16;
        const bool odd = fq & 1;
#pragma unroll
        for (int ai = 0; ai < 2; ++ai)
#pragma unroll
            for (int m = 0; m < 4; ++m) {
                const int rl = rl0 + ai * 128 + m * 16;
                const bool ok = rl < u.nvalid;
                int slot = 0; float gw = 0.f;
                if (ok) { slot = u.rows[rl]; gw = GATEW[slot] * (YSCALE / WD_SCALE); }
                u32x2 p[2];
#pragma unroll
                for (int bj = 0; bj < 2; ++bj) { const f32x4 v0 = acc[ai][bj][m][0] * gw, v1 = acc[ai][bj][m][1] * gw;
                    p[bj] = (u32x2){pk4_fp8(v0[0], v0[1], v0[2], v0[3]), pk4_fp8(v1[0], v1[1], v1[2], v1[3])}; }
                const u32x2 snd = odd ? p[0] : p[1];
                u32x2 rcv; rcv.x = (unsigned)__shfl_xor((int)snd.x, 16); rcv.y = (unsigned)__shfl_xor((int)snd.y, 16);
                const u32x4 w = odd ? (u32x4){rcv.x, rcv.y, p[1].x, p[1].y} : (u32x4){p[0].x, p[0].y, rcv.x, rcv.y};
                if (ok) *(u32x4*)(YBUF + (size_t)slot * D + colw) = w;
                asm volatile("" ::: "memory");
            }
    }
};

#define MFMA16(a, b, c) __builtin_amdgcn_mfma_f32_16x16x32_bf16((a), (b), (c), 0, 0, 0)
#define MFMA32(a, b, c) __builtin_amdgcn_mfma_f32_32x32x16_bf16((a), (b), (c), 0, 0, 0)
__device__ __forceinline__ s16x4 tr16(const LAS unsigned char* p) { return __builtin_amdgcn_ds_read_tr16_b64_v4i16((LAS s16x4*)p); }
__device__ __forceinline__ bf16x8 cat8(s16x4 a, s16x4 b) { bf16x8 r; r[0] = a[0]; r[1] = a[1]; r[2] = a[2]; r[3] = a[3]; r[4] = b[0]; r[5] = b[1]; r[6] = b[2]; r[7] = b[3]; return r; }
__device__ __forceinline__ u32x4 pack8(const float (&v)[8]) { u32x4 w; w.x = pg8::cvt_pk_bf16(v[0], v[1]); w.y = pg8::cvt_pk_bf16(v[2], v[3]); w.z = pg8::cvt_pk_bf16(v[4], v[5]); w.w = pg8::cvt_pk_bf16(v[6], v[7]); return w; }
__device__ __forceinline__ void unpack8(u32x4 w, float (&v)[8]) { v[0] = bflo(w.x); v[1] = bfhi(w.x); v[2] = bflo(w.y); v[3] = bfhi(w.y); v[4] = bflo(w.z); v[5] = bfhi(w.z); v[6] = bflo(w.w); v[7] = bfhi(w.w); }
__device__ __forceinline__ int swzA(int row) { return (row & 3) | (((row >> 3) & 1) << 2); }
__device__ __forceinline__ void hgrn_kv_unit(Ctx& X, int bn) {
    const int t0 = bn * 64;
    const bf16_t* PROJ = WSP(bf16_t, WS_PROJ); const float* BC = WSP(float, WS_LOGF);
#pragma unroll 2
    for (int j = 0; j < 8; ++j) {
        const int p = X.tid + NTHREADS * j, row = p >> 6, c64 = p & 63, h = c64 >> 4, ch = c64 & 15;
        const size_t prow = (size_t)(t0 + row) * INW + h * 128 + 8 * ch;
        const u32x4 kraw = *(const u32x4*)(PROJ + prow + C_HK), vraw = *(const u32x4*)(PROJ + prow + C_HV);
        const float* bp = BC + (size_t)(t0 + row) * 512 + h * 128 + 8 * ch; const float* bl = BC + (size_t)(t0 + 63) * 512 + h * 128 + 8 * ch;
        const f32x4 b0 = *(const f32x4*)bp, b1 = *(const f32x4*)(bp + 4), l0 = *(const f32x4*)bl, l1 = *(const f32x4*)(bl + 4);
        float kv[8]; unpack8(kraw, kv);
#pragma unroll
        for (int e = 0; e < 4; ++e) { kv[e] *= __expf(l0[e] - b0[e]); kv[4 + e] *= __expf(l1[e] - b1[e]); }
        const int off = row * 256 + (((ch >> 1) ^ swzA(row)) * 32) + (ch & 1) * 16;
        *(LAS u32x4*)(X.lds + h * 32768 + off) = vraw; *(LAS u32x4*)(X.lds + h * 32768 + 16384 + off) = pack8(kv);
    }
    WSP(float, WS_DECAY)[bn * 512 + X.tid] = __expf(BC[(size_t)(t0 + 63) * 512 + X.tid]);
    __syncthreads();
    const int l = X.lane, w = X.wave, fr = l & 15, fq = l >> 4, r = fr >> 2, p4 = l & 3, h = w >> 1, vt0 = 4 * (w & 1);
    const LAS unsigned char* VI = X.lds + h * 32768; const LAS unsigned char* KI = VI + 16384;
    bf16x8 af[4][2];
#pragma unroll
    for (int vt = 0; vt < 4; ++vt)
#pragma unroll
        for (int kk = 0; kk < 2; ++kk) { const int r0 = 32 * kk + 8 * fq + r, r1 = r0 + 4;
            af[vt][kk] = cat8(tr16(VI + r0 * 256 + (((vt0 + vt) ^ swzA(r0)) * 32) + p4 * 8), tr16(VI + r1 * 256 + (((vt0 + vt) ^ swzA(r1)) * 32) + p4 * 8)); }
    bf16_t* KVT = WSP(bf16_t, WS_KVT) + (size_t)(bn * 4 + h) * 16384;
#pragma unroll 2
    for (int ct = 0; ct < 8; ++ct) {
        bf16x8 bfr[2];
#pragma unroll
        for (int kk = 0; kk < 2; ++kk) { const int r0 = 32 * kk + 8 * fq + r, r1 = r0 + 4;
            bfr[kk] = cat8(tr16(KI + r0 * 256 + ((ct ^ swzA(r0)) * 32) + p4 * 8), tr16(KI + r1 * 256 + ((ct ^ swzA(r1)) * 32) + p4 * 8)); }
#pragma unroll
        for (int vt = 0; vt < 4; ++vt) { f32x4 acc = {0.f, 0.f, 0.f, 0.f}; acc = MFMA16(bfr[0], af[vt][0], acc); acc = MFMA16(bfr[1], af[vt][1], acc);
            u32x2 wv; wv.x = pg8::cvt_pk_bf16(acc[0], acc[1]); wv.y = pg8::cvt_pk_bf16(acc[2], acc[3]);
            *(u32x2*)(KVT + (16 * (vt0 + vt) + fr) * 128 + 16 * ct + 4 * fq) = wv; }
    }
    __syncthreads();
}
__device__ __forceinline__ void hgrn_passB(Ctx& X) {
    const unsigned* KVT = WSP(unsigned, WS_KVT); const float* DECAY = WSP(float, WS_DECAY); unsigned* SPT = WSP(unsigned, WS_SPT);
    const int gt = X.wg * NTHREADS + X.tid, NGT = X.G * NTHREADS;
    for (int item = gt; item < 16 * 128 * 64; item += NGT) {
        const int bh = item >> 13, rem = item & 8191, vd = rem >> 6, c = (rem & 63) * 2, b = bh >> 2, h = bh & 3;
        float s0 = 0.f, s1 = 0.f;
#pragma unroll 8
        for (int n = 0; n < 64; ++n) {
            const int unit = (b * 64 + n) * 4 + h;
            const unsigned kw = KVT[((size_t)unit * 16384 + vd * 128 + c) >> 1]; const f32x2 kv = {bflo(kw), bfhi(kw)};
            const f32x2 dc = *(const f32x2*)(DECAY + unit * 128 + c);
            SPT[((size_t)unit * 16384 + vd * 128 + c) >> 1] = pk2(s0, s1);
            s0 = dc.x * s0 + kv.x; s1 = dc.y * s1 + kv.y;
        }
    }
}
__device__ __forceinline__ void hgrn_out_unit(Ctx& X, int u2) {
    const int bn = u2 >> 1, hp = u2 & 1, t0 = bn * 64;
    const bf16_t* PROJ = WSP(bf16_t, WS_PROJ); const float* BCg = WSP(float, WS_LOGF);
#pragma unroll 2
    for (int j = 0; j < 4; ++j) { const int p = X.tid + NTHREADS * j, row = p >> 5, c32 = p & 31, hh = c32 >> 4, ch = c32 & 15, h = 2 * hp + hh;
        const size_t prow = (size_t)(t0 + row) * INW + h * 128 + 8 * ch;
        const u32x4 qraw = *(const u32x4*)(PROJ + prow + C_HQ), kraw = *(const u32x4*)(PROJ + prow + C_HK), vraw = *(const u32x4*)(PROJ + prow + C_HV);
        const float* bp = BCg + (size_t)(t0 + row) * 512 + h * 128 + 8 * ch; const float* br = BCg + (size_t)(t0 + 32) * 512 + h * 128 + 8 * ch;
        const f32x4 b0 = *(const f32x4*)bp, b1 = *(const f32x4*)(bp + 4), r0 = *(const f32x4*)br, r1 = *(const f32x4*)(br + 4);
        float qv[8], kv[8], a[8], bq[8]; unpack8(qraw, qv); unpack8(kraw, kv);
#pragma unroll
        for (int e = 0; e < 4; ++e) { const float e0 = __expf(b0[e] - r0[e]), e1 = __expf(b1[e] - r1[e]);
            a[e] = qv[e] * e0; a[4 + e] = qv[4 + e] * e1; kv[e] *= __builtin_amdgcn_rcpf(e0); kv[4 + e] *= __builtin_amdgcn_rcpf(e1);
            bq[e] = qv[e] * __expf(b0[e]); bq[4 + e] = qv[4 + e] * __expf(b1[e]); }
        LAS unsigned char* hb = X.lds + hh * 65536; const int o16 = row * 256 + ((ch ^ (row & 15)) * 16);
        *(LAS u32x4*)(hb + o16) = pack8(a); *(LAS u32x4*)(hb + 16384 + o16) = pack8(kv); *(LAS u32x4*)(hb + 32768 + o16) = pack8(bq);
        *(LAS u32x4*)(hb + 49152 + row * 256 + (((ch >> 1) ^ (row & 7)) * 32) + (ch & 1) * 16) = vraw; }
    const int l = X.lane, w = X.wave, fr = l & 15, fq = l >> 4, r = fr >> 2, p4 = l & 3, hh = w >> 2, h = 2 * hp + hh, ti = w & 3;
    const int tq = 16 * ti + fr;
    const bf16_t* SPT = WSP(bf16_t, WS_SPT) + (size_t)(bn * 4 + h) * 16384;
    __syncthreads();
    const LAS unsigned char* QSI = X.lds + hh * 65536; const LAS unsigned char* KSI = QSI + 16384; const LAS unsigned char* QNI = QSI + 32768; const LAS unsigned char* VI = QSI + 49152;
    bf16x8 QS[4];
#pragma unroll
    for (int ks = 0; ks < 4; ++ks) QS[ks] = *(const LAS bf16x8*)(QSI + tq * 256 + (((4 * ks + fq) ^ (tq & 15)) * 16));
    f32x4 ST[4];
#pragma unroll
    for (int si = 0; si < 4; ++si) {
        f32x4 acc = {0.f, 0.f, 0.f, 0.f};
        if (si <= ti) {
            const int sr = 16 * si + fr;
#pragma unroll
            for (int ks = 0; ks < 4; ++ks) { const bf16x8 kf = *(const LAS bf16x8*)(KSI + sr * 256 + (((4 * ks + fq) ^ (sr & 15)) * 16)); acc = MFMA16(kf, QS[ks], acc); }
            if (si == ti) {
#pragma unroll
                for (int q = 0; q < 4; ++q) acc[q] = (4 * fq + q <= fr) ? acc[q] : 0.f; }
        }
        ST[si] = acc;
    }
    f32x4 o[8];
#pragma unroll
    for (int vt = 0; vt < 8; ++vt) o[vt] = (f32x4){0.f, 0.f, 0.f, 0.f};
#pragma unroll
    for (int kk = 0; kk < 2; ++kk) {
        if (2 * kk <= ti) {
            float pv[8];
#pragma unroll
            for (int q = 0; q < 4; ++q) { pv[q] = ST[2 * kk][q]; pv[4 + q] = ST[2 * kk + 1][q]; }
            const bf16x8 pf = __builtin_bit_cast(bf16x8, pack8(pv));
            const int r0 = 32 * kk + 4 * fq + r, r1 = r0 + 16;
#pragma unroll
            for (int vt = 0; vt < 8; ++vt) { const bf16x8 va = cat8(tr16(VI + r0 * 256 + ((vt ^ (r0 & 7)) * 32) + p4 * 8), tr16(VI + r1 * 256 + ((vt ^ (r1 & 7)) * 32) + p4 * 8));
                o[vt] = MFMA16(va, pf, o[vt]); }
        }
    }
#pragma unroll
    for (int ks = 0; ks < 4; ++ks) { const bf16x8 qn = *(const LAS bf16x8*)(QNI + tq * 256 + (((4 * ks + fq) ^ (tq & 15)) * 16));
#pragma unroll
        for (int vt = 0; vt < 8; ++vt) { const bf16x8 sa = *(const bf16x8*)(SPT + (16 * vt + fr) * 128 + 32 * ks + 8 * fq); o[vt] = MFMA16(sa, qn, o[vt]); } }
    float ss = 0.f;
#pragma unroll
    for (int vt = 0; vt < 8; ++vt) ss += (o[vt][0] * o[vt][0] + o[vt][1] * o[vt][1]) + (o[vt][2] * o[vt][2] + o[vt][3] * o[vt][3]);
    ss += __shfl_xor(ss, 16); ss += __shfl_xor(ss, 32);
    const float rstd = rsqrtf(ss * (1.f / 128.f) + EPS);
    bf16_t* YCAT = WSP(bf16_t, WS_YCAT);
#pragma unroll
    for (int vt = 0; vt < 8; ++vt) { const int vd = 16 * vt + 4 * fq;
        const u32x2 sg = *(const u32x2*)(PROJ + (size_t)(t0 + tq) * INW + C_HG + h * 128 + vd); const f32x4 gn = *(const f32x4*)(X.g_hgrn + h * 128 + vd);
        u32x2 wv; wv.x = pg8::cvt_pk_bf16(o[vt][0] * rstd * gn[0] * bflo(sg.x), o[vt][1] * rstd * gn[1] * bfhi(sg.x)); wv.y = pg8::cvt_pk_bf16(o[vt][2] * rstd * gn[2] * bflo(sg.y), o[vt][3] * rstd * gn[3] * bfhi(sg.y));
        *(u32x2*)(YCAT + (size_t)(t0 + tq) * D + h * 128 + vd) = wv; }
    __syncthreads();
}

template <bool HI> __device__ __forceinline__ unsigned fp8x2_bf16_(unsigned w) { const auto f = __builtin_amdgcn_cvt_pk_f32_fp8((int)w, HI); return pg8::cvt_pk_bf16(f[0], f[1]); }
__device__ __forceinline__ unsigned fp8x2_bf16(unsigned w, bool hi) { return hi ? fp8x2_bf16_<true>(w) : fp8x2_bf16_<false>(w); }
struct AttnRegs { u32x4 k[3], v[3]; long q[4]; };
__device__ __forceinline__ void attn_load(Ctx& X, int unit, AttnRegs& R) {
    const int u16 = unit & 15, h = (unit >> 4) & 7, g = (unit >> 7) % 3, b = unit / 384;
    const int d = g == 0 ? 1 : g == 1 ? 4 : 16, nblk = 16 / d, r = u16 / nblk, blk = u16 % nblk;
    const int vcol = C_AV + g * 512 + h * 64;
    const int mk0 = blk * 256 - 128;
    const unsigned char* QK8 = WSP(unsigned char, WS_QK8);
    const int q8col = g * 512 + h * 64, k8col = 1536 + q8col, v8col = 3072 + q8col;
#pragma unroll
    for (int j = 0; j < 3; ++j) { const int idx = X.tid + NTHREADS * j, row = idx >> 2, ch = idx & 3, m = mk0 + row > 0 ? mk0 + row : 0;
        const size_t tok = (size_t)b * SEQ + (size_t)m * d + r; R.k[j] = *(const u32x4*)(QK8 + tok * 4608 + k8col + ch * 16); R.v[j] = *(const u32x4*)(QK8 + tok * 4608 + v8col + ch * 16); }
    const int l = X.lane, w = X.wave, q = l & 31, hi = l >> 5;
    const size_t tokq = (size_t)b * SEQ + (size_t)(blk * 256 + 32 * w + q) * d + r;
#pragma unroll
    for (int ds = 0; ds < 4; ++ds) R.q[ds] = *(const long*)(QK8 + tokq * 4608 + q8col + ds * 16 + hi * 8);
}
__device__ __forceinline__ void attn_stage(Ctx& X, const AttnRegs& R) {
    LAS unsigned char* KL = X.lds; LAS unsigned char* VL = X.lds + 55296;
#pragma unroll
    for (int j = 0; j < 3; ++j) { const int idx = X.tid + NTHREADS * j, row = idx >> 2, ch = idx & 3;
        *(LAS u32x4*)(KL + row * 80 + ch * 16) = R.k[j];
        u32x4 lo, hi2;
        lo.x = fp8x2_bf16(R.v[j].x, false); lo.y = fp8x2_bf16(R.v[j].x, true); lo.z = fp8x2_bf16(R.v[j].y, false); lo.w = fp8x2_bf16(R.v[j].y, true);
        hi2.x = fp8x2_bf16(R.v[j].z, false); hi2.y = fp8x2_bf16(R.v[j].z, true); hi2.z = fp8x2_bf16(R.v[j].w, false); hi2.w = fp8x2_bf16(R.v[j].w, true);
        *(LAS u32x4*)(VL + row * 128 + ch * 32) = lo; *(LAS u32x4*)(VL + row * 128 + ch * 32 + 16) = hi2; }
    LAS long* QL = (LAS long*)(X.lds + 104448 + X.tid * 32);
    QL[0] = R.q[0]; QL[1] = R.q[1]; QL[2] = R.q[2]; QL[3] = R.q[3];
}
__device__ __forceinline__ void attn_compute(Ctx& X, int unit) {
    const int u16 = unit & 15, h = (unit >> 4) & 7, g = (unit >> 7) % 3, b = unit / 384;
    const int d = g == 0 ? 1 : g == 1 ? 4 : 16, nblk = 16 / d, r = u16 / nblk, blk = u16 % nblk;
    const int mk0 = blk * 256 - 128;
    LAS unsigned char* KL = X.lds; LAS unsigned char* VL = X.lds + 55296;
    const int l = X.lane, w = X.wave, q = l & 31, hi = l >> 5;
    const size_t tokq = (size_t)b * SEQ + (size_t)(blk * 256 + 32 * w + q) * d + r;
    long qf[4];
    { const LAS long* QL = (const LAS long*)(X.lds + 104448 + X.tid * 32); qf[0] = QL[0]; qf[1] = QL[1]; qf[2] = QL[2]; qf[3] = QL[3]; }
    f32x16 s[5];
#pragma unroll
    for (int kt = 0; kt < 5; ++kt) {
        f32x16 acc;
#pragma unroll
        for (int i = 0; i < 16; ++i) acc[i] = 0.f;
#pragma unroll
        for (int ds = 0; ds < 4; ++ds) { const long kf = *(const LAS long*)(KL + (32 * w + 32 * kt + q) * 80 + ds * 16 + hi * 8); acc = __builtin_amdgcn_mfma_f32_32x32x16_fp8_fp8(kf, qf[ds], acc, 0, 0, 0); }
        s[kt] = acc;
    }
    const int iq = 32 * w + q;
    const int jmin = iq > -mk0 ? iq : -mk0;
    const int tlo = jmin - (32 * w + 4 * hi), thi = iq + 128 - (32 * w + 128 + 4 * hi), tst = -mk0 - (32 * w + 4 * hi);
    float mx = -INFINITY;
#pragma unroll
    for (int kt = 0; kt < 5; ++kt) {
        const bool chk = kt == 0 || kt == 4 || (32 * w + 32 * kt < -mk0);
        if (chk) {
#pragma unroll
            for (int rg = 0; rg < 16; ++rg) { const int c = (rg & 3) + 8 * (rg >> 2);
                const bool valid = kt == 0 ? (c >= tlo) : kt == 4 ? (c <= thi) : (c + 32 * kt >= tst);
                s[kt][rg] = valid ? s[kt][rg] : -INFINITY; if ((rg & 3) == 3) __builtin_amdgcn_sched_barrier(0); }
        }
#pragma unroll
        for (int rg = 0; rg < 16; ++rg) mx = fmaxf(mx, s[kt][rg]);
    }
    mx = fmaxf(mx, __shfl_xor(mx, 32));
    const float c2 = 0.125f * 1.4426950408889634f, mxs = mx * c2;
    float lsum = 0.f;
#pragma unroll
    for (int kt = 0; kt < 5; ++kt)
#pragma unroll
        for (int rg = 0; rg < 16; ++rg) { const float p = __builtin_amdgcn_exp2f(__builtin_fmaf(s[kt][rg], c2, -mxs)); s[kt][rg] = p; lsum += p; }
    lsum += __shfl_xor(lsum, 32);
    f32x16 o[2];
#pragma unroll
    for (int dt = 0; dt < 2; ++dt)
#pragma unroll
        for (int i = 0; i < 16; ++i) o[dt][i] = 0.f;
    const int vlane = ((l & 15) >> 2) * 128 + (((l >> 4) & 1) * 16 + (l & 3) * 4) * 2;
#pragma unroll
    for (int kt = 0; kt < 5; ++kt)
#pragma unroll
        for (int s2 = 0; s2 < 2; ++s2) {
            bf16x8 pb;
#pragma unroll
            for (int j = 0; j < 8; j += 2) { const unsigned pw = pg8::cvt_pk_bf16(s[kt][8 * s2 + j], s[kt][8 * s2 + j + 1]); pb[j] = (short)(pw & 0xffffu); pb[j + 1] = (short)(pw >> 16); }
            const int key0 = 32 * w + 32 * kt + 16 * s2 + 4 * hi;
#pragma unroll
            for (int dt = 0; dt < 2; ++dt) {
                LAS unsigned char* vp = VL + key0 * 128 + dt * 64 + vlane;
                const s16x4 t0 = __builtin_amdgcn_ds_read_tr16_b64_v4i16((LAS s16x4*)vp);
                const s16x4 t1 = __builtin_amdgcn_ds_read_tr16_b64_v4i16((LAS s16x4*)(vp + 8 * 128));
                bf16x8 va; va[0] = t0[0]; va[1] = t0[1]; va[2] = t0[2]; va[3] = t0[3]; va[4] = t1[0]; va[5] = t1[1]; va[6] = t1[2]; va[7] = t1[3];
                o[dt] = MFMA32(va, pb, o[dt]);
            }
        }
    const float inv = 1.0f / lsum;
    bf16_t* OG = WSP(bf16_t, WS_OG) + (size_t)g * T * 512;
#pragma unroll
    for (int dt = 0; dt < 2; ++dt)
#pragma unroll
        for (int rg = 0; rg < 4; ++rg) { const int d0 = 32 * dt + 8 * rg + 4 * hi;
            u32x2 wv; wv.x = pg8::cvt_pk_bf16(o[dt][4 * rg] * inv, o[dt][4 * rg + 1] * inv); wv.y = pg8::cvt_pk_bf16(o[dt][4 * rg + 2] * inv, o[dt][4 * rg + 3] * inv);
            *(u32x2*)(OG + tokq * 512 + h * 64 + d0) = wv; }
    WSP(float, WS_LSE)[((size_t)g * T + tokq) * 8 + h] = mx * 0.125f + __logf(lsum);
}
__device__ __forceinline__ void attn_combine(Ctx& X) {
    const bf16_t* OG = WSP(bf16_t, WS_OG); const float* LSE = WSP(float, WS_LSE); bf16_t* YCAT = WSP(bf16_t, WS_YCAT);
    const int gt = X.wg * NTHREADS + X.tid, NGT = X.G * NTHREADS;
    for (int item = gt; item < T * 64; item += NGT) {
        const int t = item >> 6, ch = item & 63, h = ch >> 3;
        const float l0 = LSE[(size_t)t * 8 + h], l1 = LSE[((size_t)T + t) * 8 + h], l2 = LSE[((size_t)2 * T + t) * 8 + h];
        const float m = fmaxf(l0, fmaxf(l1, l2)); float w0 = __expf(l0 - m), w1 = __expf(l1 - m), w2 = __expf(l2 - m); const float inv = 1.f / (w0 + w1 + w2); w0 *= inv; w1 *= inv; w2 *= inv;
        const u32x4 a = *(const u32x4*)(OG + (size_t)t * 512 + ch * 8), bq = *(const u32x4*)(OG + ((size_t)T + t) * 512 + ch * 8), cq = *(const u32x4*)(OG + ((size_t)2 * T + t) * 512 + ch * 8);
        u32x4 o;
#pragma unroll
        for (int j = 0; j < 4; ++j) o[j] = pk2(w0 * bflo(a[j]) + w1 * bflo(bq[j]) + w2 * bflo(cq[j]), w0 * bfhi(a[j]) + w1 * bfhi(bq[j]) + w2 * bfhi(cq[j]));
        *(u32x4*)(YCAT + (size_t)t * D + 512 + ch * 8) = o;
    }
}

__device__ __forceinline__ unsigned sortable_key(float f) { const unsigned u = __builtin_bit_cast(unsigned, f); return (u & 0x80000000u) ? ~u : (u | 0x80000000u); }
__device__ __forceinline__ void moe_route(Ctx& X, bool local) {
    const float* LG = WSP(float, WS_KVT); unsigned* CNT = WSP(unsigned, WS_CTL) + CW_CNT; int* LISTS = WSP(int, WS_LISTS); float* GATEW = WSP(float, WS_GATEW);
    const int gw = X.wg * NWAVES + X.wave, NGW = X.G * NWAVES, l = X.lane, grp = l >> 3;
    const f32x4 bias = *(const f32x4*)(X.rbias + 4 * l);
    const unsigned long long ltmask = (1ull << l) - 1ull;
    const int tbeg = local ? X.wg * 64 + X.wave : gw, tend = local ? X.wg * 64 + 64 : T, tstep = local ? NWAVES : NGW;
    for (int t = tbeg; t < tend; t += tstep) {
        f32x4 lg = *(const f32x4*)(LG + (size_t)t * 256 + 4 * l);
#pragma unroll
        for (int ks = 1; ks < 4; ++ks) lg += *(const f32x4*)(LG + ((size_t)ks * T + t) * 256 + 4 * l);
        float sc[4], mb[4];
#pragma unroll
        for (int i = 0; i < 4; ++i) { sc[i] = sigmoidf_(lg[i]); mb[i] = sc[i] + bias[i]; }
        float m1 = fmaxf(mb[0], mb[1]), m2 = fminf(mb[0], mb[1]);
        { const float a1 = fmaxf(mb[2], mb[3]), a2 = fminf(mb[2], mb[3]); const float n1 = fmaxf(m1, a1), n2 = fmaxf(fminf(m1, a1), fmaxf(m2, a2)); m1 = n1; m2 = n2; }
#pragma unroll
        for (int o = 1; o < 8; o <<= 1) { const float a1 = __shfl_xor(m1, o), a2 = __shfl_xor(m2, o); const float n1 = fmaxf(m1, a1), n2 = fmaxf(fminf(m1, a1), fmaxf(m2, a2)); m1 = n1; m2 = n2; }
        const float gs = m1 + m2;
        int rank = 0;
#pragma unroll
        for (int gg = 0; gg < 8; ++gg) { const float og = __builtin_bit_cast(float, __builtin_amdgcn_readlane(__builtin_bit_cast(int, gs), gg * 8)); rank += (og > gs || (og == gs && gg < grp)) ? 1 : 0; }
        const bool sel = rank < 4;
        unsigned key[4];
#pragma unroll
        for (int i = 0; i < 4; ++i) key[i] = sel ? sortable_key(mb[i]) : 0u;
        unsigned pre = 0u;
#pragma unroll 1
        for (int bit = 31; bit >= 0; --bit) { const unsigned cand = pre | (1u << bit);
            const int cnt = __popcll(__ballot(key[0] >= cand)) + __popcll(__ballot(key[1] >= cand)) + __popcll(__ballot(key[2] >= cand)) + __popcll(__ballot(key[3] >= cand));
            if (cnt >= TOPK) pre = cand; }
        int ngt = 0, eqb = 0, tkb = 0; bool take[4];
#pragma unroll
        for (int i = 0; i < 4; ++i) ngt += __popcll(__ballot(key[i] > pre));
        const int need = TOPK - ngt;
#pragma unroll
        for (int i = 0; i < 4; ++i) eqb += __popcll(__ballot(key[i] == pre) & ltmask);
        int eqrun = eqb;
#pragma unroll
        for (int i = 0; i < 4; ++i) { const bool eq = key[i] == pre; take[i] = (key[i] > pre) || (eq && eqrun < need); eqrun += eq ? 1 : 0; }
#pragma unroll
        for (int i = 0; i < 4; ++i) tkb += __popcll(__ballot(take[i]) & ltmask);
        float part = 0.f;
#pragma unroll
        for (int i = 0; i < 4; ++i) part += take[i] ? sc[i] : 0.f;
        const float scale = 2.5f / wave_sum(part);
        int slot = tkb;
#pragma unroll
        for (int i = 0; i < 4; ++i) if (take[i]) { const int e = 4 * l + i; const unsigned pos = atomicAdd(&CNT[e * 64], 1u); LISTS[(size_t)e * 16384 + pos] = t * NSLOT + slot; GATEW[t * NSLOT + slot] = sc[i] * scale; ++slot; }
        if (l == 0) { LISTS[(size_t)NE * 16384 + t] = t * NSLOT + TOPK; GATEW[t * NSLOT + TOPK] = 1.0f; }
    }
}
__device__ __forceinline__ int moe_table(Ctx& X) {
    LAS int* tbl = (LAS int*)(X.lds + TBL_OFF); LAS int* cnts = (LAS int*)(X.lds + TCNT_OFF); LAS int* pref = cnts + 320;
    const unsigned* CNT = WSP(unsigned, WS_CTL) + CW_CNT;
    const int x = X.wg & 7;
    if (X.tid < NEX) cnts[X.tid] = X.tid < NE ? (int)__hip_atomic_load(CNT + X.tid * 64, __ATOMIC_RELAXED, __HIP_MEMORY_SCOPE_AGENT) : T;
    __syncthreads();
    if (X.tid < NEX) { int pre = 0; for (int e = 0; e < X.tid; ++e) pre += (cnts[e] + 255) >> 8; pref[X.tid] = pre; }
    __syncthreads();
    if (X.tid < 33) {
        const int i = X.tid; int lp = 0; for (int k = 0; k < i && k < 32; ++k) lp += (cnts[x + 8 * k] + 255) >> 8;
        if (i < 32) { const int e = x + 8 * i, n = (cnts[e] + 255) >> 8, p0 = pref[e]; for (int r = 0; r < n; ++r) tbl[lp + r] = ((p0 + r) << 16) | (e << 7) | r; }
        else { const int p0 = pref[NE]; for (int r8 = 0; r8 < 8; ++r8) { const int r = 8 * x + r8; tbl[lp + r8] = ((p0 + r) << 16) | (NE << 7) | r; } cnts[600] = lp + 8; }
    }
    __syncthreads();
    return __builtin_amdgcn_readfirstlane(cnts[600]);
}
__device__ __forceinline__ void final_rows(Ctx& X) {
    const bf16_t* X1 = WSP(bf16_t, WS_X1); const float* MOD = WSP(float, WS_MOD); const unsigned char* YBUF = WSP(unsigned char, WS_YBUF);
    const int gw = X.wg * NWAVES + X.wave, NGW = X.G * NWAVES, l = X.lane;
    for (int t = gw; t < T; t += NGW) {
        const int b = t / SEQ; f32x4 v[2][2]; float s = 0.f;
#pragma unroll
        for (int j = 0; j < 2; ++j) { const int col = 8 * l + 512 * j; f32x4 m0 = {0.f, 0.f, 0.f, 0.f}, m1 = {0.f, 0.f, 0.f, 0.f};
#pragma unroll
            for (int k = 0; k < NSLOT; ++k) { const u32x2 y = *(const u32x2*)(YBUF + ((size_t)t * NSLOT + k) * D + col);
                const f32x2 a = __builtin_amdgcn_cvt_pk_f32_fp8((int)y.x, false), bq = __builtin_amdgcn_cvt_pk_f32_fp8((int)y.x, true), c = __builtin_amdgcn_cvt_pk_f32_fp8((int)y.y, false), d = __builtin_amdgcn_cvt_pk_f32_fp8((int)y.y, true);
                m0.x += a[0]; m0.y += a[1]; m0.z += bq[0]; m0.w += bq[1]; m1.x += c[0]; m1.y += c[1]; m1.z += d[0]; m1.w += d[1]; }
            const f32x4 g0 = *(const f32x4*)(MOD + b * 6144 + 5120 + col) * (1.0f / YSCALE), g1 = *(const f32x4*)(MOD + b * 6144 + 5120 + col + 4) * (1.0f / YSCALE);
            const u32x4 xw = *(const u32x4*)(X1 + (size_t)t * D + col); const f32x4 x0 = {bflo(xw.x), bfhi(xw.x), bflo(xw.y), bfhi(xw.y)}, x1 = {bflo(xw.z), bfhi(xw.z), bflo(xw.w), bfhi(xw.w)};
            v[j][0] = x0 + g0 * m0; v[j][1] = x1 + g1 * m1;
#pragma unroll
            for (int q = 0; q < 2; ++q) s += (v[j][q].x * v[j][q].x + v[j][q].y * v[j][q].y) + (v[j][q].z * v[j][q].z + v[j][q].w * v[j][q].w); }
        const float rstd = rsqrtf(wave_sum(s) * (1.f / D) + EPS);
#pragma unroll
        for (int j = 0; j < 2; ++j) { const int col = 8 * l + 512 * j;
            *(f32x4*)(X.out + (size_t)t * D + col) = v[j][0] * rstd * *(const f32x4*)(X.g_final + col); *(f32x4*)(X.out + (size_t)t * D + col + 4) = v[j][1] * rstd * *(const f32x4*)(X.g_final + col + 4); }
    }
}

__device__ __forceinline__ unsigned* panel_word(Ctx& X, int bank, int pm) { return WSP(unsigned, WS_CTL) + CW_PANEL + (bank * 64 + pm) * 64; }
__device__ __forceinline__ void panel_signal(Ctx& X, int bank, int pm) {
    asm volatile("s_waitcnt vmcnt(0)" ::: "memory"); __syncthreads();
    if (X.tid == 0) (void)xb_add(panel_word(X, bank, pm), 1u);
}
__device__ __forceinline__ void panel_wait(Ctx& X, int bank, int pm, unsigned target) {
    if (X.tid == 0) { unsigned* p = panel_word(X, bank, pm); unsigned sp = 0u;
        while (xb_ld(p) < target) { __builtin_amdgcn_s_sleep(2); if (++sp > (1u << 22)) break; }
        __builtin_amdgcn_fence(__ATOMIC_ACQUIRE, "agent"); asm volatile("s_waitcnt vmcnt(0)" ::: "memory"); }
    __syncthreads();
}

constexpr int NG_INPROJ = 176;
__device__ __forceinline__ void ph_inproj(Ctx& X) {
    const int ng = X.G > NG_INPROJ + 8 ? NG_INPROJ : X.G;
    if (X.wg < ng) {
        RegSched S{(const char*)WSP(bf16_t, WS_H), (const char*)WSP(bf16_t, WS_WIN), (size_t)256 * 2048, (size_t)256 * 2048, T / 256, INW / 256, ng, X.wg};
        EpiInproj E{WSP(bf16_t, WS_PROJ), WSP(float, WS_LOGF), WSP(float, WS_LB), WSP(float, WS_ROPE), WSP(unsigned char, WS_G8), WSP(unsigned char, WS_QK8)};
        pg8::gemm_phase<EpiInproj, RegSched, true, false>(X.lds, 1024, 1024, 1024, S, E);
    }
    if (ng == X.G) expert_convert(X, X.wg, X.G);
    else if (X.wg >= ng) expert_convert(X, X.wg - ng, X.G - ng);
}
__device__ __forceinline__ void ph_mix_a(Ctx& X) {
    for (int it = X.wg; it < 256; it += X.G) hgrn_kv_unit(X, it);
    AttnRegs Ra, Rb; int unit = X.wg;
    auto clampu = [](int u) { return u < 1536 ? u : 1535; };
    attn_load(X, clampu(unit), Ra);
    __builtin_amdgcn_sched_barrier(0);
    attn_load(X, clampu(unit + X.G), Rb);
    __builtin_amdgcn_sched_barrier(0);
#define ATTN_STEP(R_) do { attn_stage(X, R_); __syncthreads(); __builtin_amdgcn_sched_barrier(0); attn_load(X, clampu(unit + 2 * X.G), R_); __builtin_amdgcn_sched_barrier(0); \
        attn_compute(X, unit); __syncthreads(); unit += X.G; } while (0)
    if (unit < 1536) {
        ATTN_STEP(Ra);
        while (unit < 1536) {
            ATTN_STEP(Rb);
            if (unit >= 1536) break;
            ATTN_STEP(Ra);
        }
    }
#undef ATTN_STEP
}
__device__ __forceinline__ void ph_mix_c(Ctx& X) { for (int it = X.wg; it < 512; it += X.G) hgrn_out_unit(X, it); attn_combine(X); }
__device__ __forceinline__ void ph_mixed(Ctx& X, bool chain) {
    TwoPartSched S{(const char*)WSP(bf16_t, WS_YCAT), (const char*)WSP(bf16_t, WS_WPA), (const char*)WSP(bf16_t, WS_WPB), T / 256, D / 256, X.G, X.wg};
    EpiMixed E{WSP(unsigned char, WS_G8), WSP(bf16_t, WS_MIXED)};
    pg8::gemm_phase<EpiMixed, TwoPartSched, false, false>(X.lds, 1024, 512, 512, S, E);
    if (chain) { int pm, pn; pg8::swz_tile(X.wg, T / 256, D / 256, pm, pn); panel_signal(X, 0, pm); }
}
__device__ __forceinline__ void ph_outproj(Ctx& X, bool chain) {
    int pm = 0, pn = 0; pg8::swz_tile(X.wg < 256 ? X.wg : 0, T / 256, D / 256, pm, pn);
    RegSched S{(const char*)WSP(bf16_t, WS_MIXED), (const char*)WSP(bf16_t, WS_WOUT), (size_t)256 * 2048, (size_t)256 * 2048, T / 256, D / 256, X.G, X.wg};
    if (chain) {
        panel_wait(X, 0, pm, 4u);
        EpiOutNorm E{X.x, WSP(float, WS_MOD), X.g2, WSP(bf16_t, WS_X1), WSP(bf16_t, WS_H), WSP(unsigned char, WS_H8), WSP(float, WS_XB), panel_word(X, 1, 0), X.lds + 139264};
        pg8::gemm_phase<EpiOutNorm, RegSched, true, false>(X.lds, 1024, 1024, 1024, S, E);
        panel_signal(X, 2, pm);
    } else {
        EpiOutproj E{X.x, WSP(float, WS_MOD), WSP(bf16_t, WS_X1)};
        pg8::gemm_phase<EpiOutproj, RegSched, false, false>(X.lds, 1024, 1024, 1024, S, E);
    }
}
__device__ __forceinline__ void ph_norm2(Ctx& X, bool chain) { if (!chain) norm_rows(X, 1); }
__device__ __forceinline__ void ph_router(Ctx& X, bool chain) {
    if (chain) panel_wait(X, 2, X.wg >> 2, 4u);
    RouterSched S{(const char*)WSP(bf16_t, WS_H), (const char*)WSP(bf16_t, WS_WR), X.G, X.wg};
    EpiRouter E{WSP(float, WS_KVT)};
    pg8::gemm_phase<EpiRouter, RouterSched, false, false>(X.lds, 1024, 1024, 256, S, E);
    if (chain) panel_signal(X, 3, X.wg >> 2);
}
__device__ __forceinline__ void ph_route(Ctx& X, bool chain) {
    if (chain) panel_wait(X, 3, X.wg >> 2, 4u);
    moe_route(X, chain);
}
__device__ __forceinline__ void ph_gu(Ctx& X) {
    const int nent = moe_table(X);
    MoeSched S{(const LAS int*)(X.lds + TBL_OFF), (const LAS int*)(X.lds + TCNT_OFF), nent, (const char*)WSP(unsigned char, WS_H8), (const char*)WSP(unsigned char, WS_WGU), WSP(int, WS_LISTS), 2, 256 * 1024, 512 * 1024, 0, X.G, X.wg};
    EpiGU E{WSP(unsigned char, WS_ACT)};
    pg8::gemm_phase<EpiGU, MoeSched, true, true, true>(X.lds, 512, 512, 512, S, E);
}
__device__ __forceinline__ void ph_down(Ctx& X) {
    const int nent = moe_table(X);
    MoeSched S{(const LAS int*)(X.lds + TBL_OFF), (const LAS int*)(X.lds + TCNT_OFF), nent, (const char*)WSP(unsigned char, WS_ACT), (const char*)WSP(unsigned char, WS_WD), WSP(int, WS_LISTS), 4, 256 * 256, 1024 * 256, 256 * 256, X.G, X.wg};
    EpiDown E{WSP(unsigned char, WS_YBUF), WSP(float, WS_GATEW)};
    pg8::gemm_phase<EpiDown, MoeSched, true, false, true>(X.lds, 128, 128, 128, S, E);
}

constexpr int NPHASE = 14;
struct Args { const void* in[20]; float* out; unsigned char* ws; int ph_lo, ph_hi; };
__global__ void __launch_bounds__(NTHREADS, 2) mega_fwd(Args args) {
    extern __shared__ __attribute__((aligned(16))) unsigned char lds_raw[];
    Ctx X;
    X.lds = (LAS unsigned char*)lds_raw;
    X.tid = threadIdx.x; X.lane = X.tid & 63; X.wave = __builtin_amdgcn_readfirstlane(X.tid >> 6); X.wg = blockIdx.x; X.G = gridDim.x;
    X.x = (const float*)args.in[0]; X.c = (const float*)args.in[1]; X.positions = (const int*)args.in[2]; X.w_ada = (const float*)args.in[3]; X.b_ada = (const float*)args.in[4];
    X.g1 = (const float*)args.in[5]; X.w_in = (const float*)args.in[6]; X.lb_logits = (const float*)args.in[7]; X.g_hgrn = (const float*)args.in[8]; X.w_pa = (const float*)args.in[9];
    X.w_pb = (const float*)args.in[10]; X.w_out = (const float*)args.in[11]; X.g2 = (const float*)args.in[12]; X.w_router = (const float*)args.in[13]; X.rbias = (const float*)args.in[14];
    X.w_egu = (const float*)args.in[15]; X.w_edown = (const float*)args.in[16]; X.w_sgu = (const float*)args.in[17]; X.w_sdown = (const float*)args.in[18]; X.g_final = (const float*)args.in[19];
    X.out = args.out; X.ws = args.ws;
    volatile LAS unsigned* MISC = (volatile LAS unsigned*)(X.lds + MISC_OFF);
    if (X.tid < 32) MISC[X.tid] = 0u;
    __syncthreads();
    const int lo = args.ph_lo, hi = args.ph_hi;
    XcdBarrier bar; bar.bar = WSP(unsigned, WS_CTL) + CW_BAR; bar.x = 0; bar.st = nullptr;
    if (hi - lo > 1) bar = xcd_barrier_post(WSP(unsigned, WS_CTL) + CW_BAR, MISC + 8);
#ifndef PH_MASK
#define PH_MASK 0xffffffffu
#endif
#define IN(k) ((((PH_MASK) >> (k)) & 1u) && lo <= (k) && (k) < hi)
#ifndef REPEAT_MASK
#define REPEAT_MASK 0u
#endif
#define SEAM(k) do { if (IN(k) && IN((k) + 1)) xcd_barrier(bar); } while (0)
#define RUN(k, call) do { if (IN(k)) { call; if (((REPEAT_MASK) >> (k)) & 1u) { xcd_barrier(bar); call; } } } while (0)

    const bool p01 = IN(0) && IN(1);
    RUN(0, p0_prologue(X));
    if (p01) { asm volatile("s_waitcnt vmcnt(0)" ::: "memory"); __syncthreads(); if (X.tid == 0) (void)xb_add(WSP(unsigned, WS_CTL) + CW_P0 + 64 * (X.wg & 7), 1u); }
    if (IN(1)) {
        small_transposes(X);
        if (p01) {
            if (X.tid == 0) { unsigned* p = WSP(unsigned, WS_CTL) + CW_P0; unsigned sp = 0u;
                for (;;) { unsigned sum = 0u;
#pragma unroll
                    for (int j = 0; j < 8; ++j) sum += xb_ld(p + 64 * j);
                    if (sum >= (unsigned)X.G) break;
                    __builtin_amdgcn_s_sleep(2); if (++sp > (1u << 22)) break; }
                __builtin_amdgcn_fence(__ATOMIC_ACQUIRE, "agent"); asm volatile("s_waitcnt vmcnt(0)" ::: "memory"); }
            __syncthreads();
        }
        norm_rows(X, 0);
    }
    SEAM(1);
    RUN(2, ph_inproj(X)); SEAM(2);
    RUN(3, ph_mix_a(X)); SEAM(3);
    RUN(4, hgrn_passB(X)); SEAM(4);
    RUN(5, ph_mix_c(X)); SEAM(5);
    const bool chain = (X.G == 256);
    RUN(6, ph_mixed(X, chain)); if (!chain) SEAM(6);
    RUN(7, ph_outproj(X, chain)); if (!chain) SEAM(7);
    RUN(8, ph_norm2(X, chain)); if (!chain) SEAM(8);
    RUN(9, ph_router(X, chain)); if (!chain) SEAM(9);
    RUN(10, ph_route(X, chain)); SEAM(10);
    RUN(11, ph_gu(X)); SEAM(11);
    RUN(12, ph_down(X)); SEAM(12);
    RUN(13, final_rows(X));
#undef IN
#undef SEAM
}

extern "C" void kernel_launch(void* const* d_in, const int* in_sizes, int n_in, void* d_out, int out_size, void* d_ws, size_t ws_size, hipStream_t stream) {
    static int grid = 0;
    if (grid == 0) {
        if (n_in != 20 || out_size != T * D || ws_size < WS_END) { fprintf(stderr, "kernel_launch: unexpected shapes (n_in %d, out %d, ws %zu); nothing launched\n", n_in, out_size, ws_size); grid = -1; return; }
        int dev = 0, cus = 0, per_cu = 0;
        if (hipGetDevice(&dev) != hipSuccess || hipDeviceGetAttribute(&cus, hipDeviceAttributeMultiprocessorCount, dev) != hipSuccess) { grid = -1; return; }
        if (hipFuncSetAttribute((const void*)mega_fwd, hipFuncAttributeMaxDynamicSharedMemorySize, LDS_BYTES) != hipSuccess) { fprintf(stderr, "kernel_launch: hipFuncSetAttribute failed\n"); grid = -1; return; }
        if (hipOccupancyMaxActiveBlocksPerMultiprocessor(&per_cu, (const void*)mega_fwd, NTHREADS, LDS_BYTES) != hipSuccess || per_cu < 1) { fprintf(stderr, "kernel_launch: occupancy query says %d blocks/CU; nothing launched\n", per_cu); (void)hipGetLastError(); grid = -1; return; }
        grid = cus;
        if (T % grid != 0 || 24576 % grid != 0 || grid % 8 != 0) { fprintf(stderr, "kernel_launch: grid %d does not divide the row count; nothing launched\n", grid); grid = -1; return; }
    }
    if (grid < 0) return;
    (void)hipMemsetAsync((char*)d_ws + WS_CTL, 0, CTL_ZERO_BYTES, stream);
    Args a{};
    for (int i = 0; i < 20; ++i) a.in[i] = d_in[i];
    a.out = (float*)d_out; a.ws = (unsigned char*)d_ws;
#if MK_PER_PHASE
    for (int p = 0; p < NPHASE; ++p) { a.ph_lo = p; a.ph_hi = p + 1; hipLaunchKernelGGL(mega_fwd, dim3(grid), dim3(NTHREADS), LDS_BYTES, stream, a); }
#else
    a.ph_lo = 0; a.ph_hi = NPHASE;
    hipLaunchKernelGGL(mega_fwd, dim3(grid), dim3(NTHREADS), LDS_BYTES, stream, a);
#endif
}
```

```cpp
#include <hip/hip_runtime.h>
#include <cstdio>
#include <cstdint>

#ifndef MK_PER_PHASE
#define MK_PER_PHASE 0
#endif

#define GAS __attribute__((address_space(1)))
#define LAS __attribute__((address_space(3)))
typedef unsigned short bf16_t;
typedef short bf16x8 __attribute__((ext_vector_type(8)));
typedef short s16x4 __attribute__((ext_vector_type(4)));
typedef float f32x4 __attribute__((ext_vector_type(4)));
typedef float f32x2 __attribute__((ext_vector_type(2)));
typedef float f32x16 __attribute__((ext_vector_type(16)));
typedef unsigned u32x4 __attribute__((ext_vector_type(4)));
typedef unsigned u32x2 __attribute__((ext_vector_type(2)));
typedef long l64x2 __attribute__((ext_vector_type(2)));

constexpr int NB = 4, SEQ = 4096, T = NB * SEQ, D = 1024, INW = 8704;
constexpr int C_HQ = 0, C_HK = 512, C_HV = 1024, C_HG = 1536, C_AQ = 2048, C_AK = 3584, C_AV = 5120, C_GA = 6656, C_GB = 7680;
constexpr int NE = 256, NEX = 257, TOPK = 8, NSLOT = 9, EFF = 256;
constexpr float EPS = 1e-6f;
constexpr float WGU_SCALE = 64.0f, WD_SCALE = 32.0f;
constexpr float YSCALE = 16.0f;
constexpr int NWAVES = 8, NTHREADS = 512;

constexpr size_t MiB = 1u << 20;
constexpr size_t WS_CTL = 0, CTL_ZERO_BYTES = 1 * MiB;
constexpr size_t WS_MODP = 2 * MiB;
constexpr size_t WS_MOD = 4 * MiB;
constexpr size_t WS_LB = 4 * MiB + 128 * 1024;
constexpr size_t WS_XB = 4 * MiB + 256 * 1024;
constexpr size_t WS_ROPE = 5 * MiB;
constexpr size_t WS_DECAY = 6 * MiB;
constexpr size_t WS_GATEW = 7 * MiB;
constexpr size_t WS_LISTS = 16 * MiB;
constexpr size_t WS_WIN = 34 * MiB;
constexpr size_t WS_WPA = 51 * MiB, WS_WPB = 52 * MiB, WS_WOUT = 53 * MiB, WS_WR = 55 * MiB;
constexpr size_t WS_H = 56 * MiB;
constexpr size_t WS_LOGF = 88 * MiB;
constexpr size_t WS_H8 = 120 * MiB;
constexpr size_t WS_MIXED = 136 * MiB;
constexpr size_t WS_YCAT = 168 * MiB;
constexpr size_t WS_X1 = 200 * MiB;
constexpr size_t WS_G8 = 232 * MiB;
constexpr size_t WS_OG = 264 * MiB;
constexpr size_t WS_LSE = 312 * MiB;
constexpr size_t WS_KVT = 314 * MiB;
constexpr size_t WS_SPT = 378 * MiB;
constexpr size_t WS_PROJ = 410 * MiB;
constexpr size_t WS_WGU = 682 * MiB;
constexpr size_t WS_QK8 = 820 * MiB;
constexpr size_t WS_WD = 939 * MiB;
constexpr size_t WS_ACT = 1068 * MiB;
constexpr size_t WS_YBUF = 1172 * MiB;
constexpr size_t WS_END = 1460 * MiB;
constexpr int CW_P0 = 2048;
constexpr int CW_BAR = 4096;
constexpr int CW_PANEL = 65536;
constexpr int CW_CNT = 16384;

constexpr int RING_BYTES = 131072;
constexpr int TBL_OFF = RING_BYTES;
constexpr int TCNT_OFF = TBL_OFF + 4096;
constexpr int MISC_OFF = TCNT_OFF + 2560;
constexpr int LDS_BYTES = 147456;

#define LDS_WAIT() asm volatile("s_waitcnt lgkmcnt(0)" ::: "memory")
#define VM_WAIT() asm volatile("s_waitcnt vmcnt(0)" ::: "memory")
__device__ __forceinline__ unsigned f2bf(float f) { unsigned u = __builtin_bit_cast(unsigned, f); return (u + 0x7fffu + ((u >> 16) & 1u)) >> 16; }
__device__ __forceinline__ float bf2f(unsigned b) { return __builtin_bit_cast(float, b << 16); }
__device__ __forceinline__ unsigned pk2(float lo, float hi) { return f2bf(lo) | (f2bf(hi) << 16); }
__device__ __forceinline__ float bflo(unsigned w) { return __builtin_bit_cast(float, w << 16); }
__device__ __forceinline__ float bfhi(unsigned w) { return __builtin_bit_cast(float, w & 0xffff0000u); }
__device__ __forceinline__ float fast_logf(float x) { return __builtin_amdgcn_logf(x) * 0.6931471805599453f; }
__device__ __forceinline__ float sigmoidf_(float x) { return __builtin_amdgcn_rcpf(1.0f + __expf(-x)); }
__device__ __forceinline__ float wave_sum(float v) {
#pragma unroll
    for (int o = 1; o < 64; o <<= 1) v += __shfl_xor(v, o);
    return v;
}

__device__ __forceinline__ float clamp_e4m3(float x) { return __builtin_amdgcn_fmed3f(x, -448.0f, 448.0f); }
__device__ __forceinline__ unsigned pk4_fp8(float a, float b, float c, float d) { int w = 0; w = __builtin_amdgcn_cvt_pk_fp8_f32(clamp_e4m3(a), clamp_e4m3(b), w, false); w = __builtin_amdgcn_cvt_pk_fp8_f32(clamp_e4m3(c), clamp_e4m3(d), w, true); return (unsigned)w; }
__device__ __forceinline__ void st_wt8(void* p, unsigned long long v) { __hip_atomic_store((unsigned long long*)p, v, __ATOMIC_RELAXED, __HIP_MEMORY_SCOPE_AGENT); }
__device__ __forceinline__ void st_wt16(void* p, u32x4 v) { asm volatile("global_store_dwordx4 %0, %1, off sc1\n\ts_nop 1" :: "v"(p), "v"(v) : "memory"); }
__device__ __forceinline__ void st_wt4(void* p, unsigned v) { __hip_atomic_store((unsigned*)p, v, __ATOMIC_RELAXED, __HIP_MEMORY_SCOPE_AGENT); }
namespace pg8 {
constexpr int BM = 256, BK = 64, HALF = 128, HTB = HALF * BK * 2, STAGE_BYTES = 8 * HTB, NXCD = 8, WGM = 8;
__host__ __device__ __forceinline__ int lds_byte(int r, int c) { const int st = (r >> 4) * 2 + (c >> 5), rr = r & 15, cc = c & 31, ob = rr * 64 + cc * 2; return st * 1024 + (ob ^ (((ob >> 9) & 1) << 5)); }
__host__ __device__ __forceinline__ void stage_rc(int b, int& R, int& C) { const int st = b / 1024, sb = b % 1024, swz = sb ^ (((sb >> 9) & 1) << 5); R = (st >> 1) * 16 + swz / 64; C = (st & 1) * 32 + (swz % 64) / 2; }
__host__ __device__ __forceinline__ int perm32(int rho) { const int n = rho >> 4, i = rho & 15; return 8 * (i >> 2) + 4 * n + (i & 3); }

struct Unit { const char* a; const char* b; const int* rows; int pm, pn, aux, nvalid; };

__device__ __forceinline__ void swz_tile(int L, int nM, int nN, int& pm, int& pn) {
    const int nwg = nM * nN; int wgid = L;
    { const int q = nwg / NXCD, r = nwg % NXCD, xcd = wgid % NXCD, off = wgid / NXCD; wgid = (xcd < r ? xcd * (q + 1) : r * (q + 1) + (xcd - r) * q) + off; }
    const int nig = WGM * nN, gid = wgid / nig, fm = gid * WGM, gsz = (nM - fm) < WGM ? (nM - fm) : WGM;
    pm = fm + ((wgid % nig) % gsz); pn = (wgid % nig) / gsz;
}

__device__ __forceinline__ unsigned cvt_pk_bf16(float lo, float hi) { unsigned r; asm volatile("v_cvt_pk_bf16_f32 %0, %1, %2" : "=v"(r) : "v"(lo), "v"(hi)); return r; }

template <bool GATHER>
__device__ __forceinline__ void gather_offs(const Unit& u, int tid, int lda, unsigned (&v)[2][2]) {
    if constexpr (GATHER) {
#pragma unroll
        for (int i = 0; i < 2; ++i) { int R, C; stage_rc(tid * 16 + i * 8192, R, C);
#pragma unroll
            for (int hh = 0; hh < 2; ++hh) { const int ri = hh * HALF + R; int slot = 0; if (ri < u.nvalid) slot = u.rows[ri];
                const unsigned tok = (unsigned)slot / 9u; v[hh][i] = (tok * (unsigned)lda + (unsigned)C) * 2u; } }
    }
}

template <class E, class = void> struct epi_bjadj { static constexpr bool v = false; };
template <class E> struct epi_bjadj<E, decltype((void)E::BJADJ)> { static constexpr bool v = E::BJADJ; };
template <class Epi, class Sched, bool ALIGN_EPI, bool GATHER, bool FP8 = false>
__device__ __forceinline__ void gemm_phase(LAS unsigned char* lds, const int lda, const int ldb, const int K, const Sched& S, const Epi& E) {
    const int tid = threadIdx.x, wid = __builtin_amdgcn_readfirstlane(tid >> 6), lane = tid & 63, wr = wid >> 2, wc = wid & 3, fr = lane & 15, fq = lane >> 4;
    const int nt = K / BK;
    unsigned voffA[2], voffB[2];
#pragma unroll
    for (int i = 0; i < 2; ++i) { int R, C; stage_rc(tid * 16 + i * 8192, R, C); const int Rb = Epi::PERM ? ((R & ~31) + perm32(R & 31)) : R;
        const int Rg = epi_bjadj<Epi>::v ? ((Rb >> 5) * 64 + (Rb & 31)) : Rb;
        voffA[i] = (unsigned)(R * lda + C) * 2u; voffB[i] = (unsigned)(Rg * ldb + C) * 2u; }
    const size_t kstep = (size_t)(BK * 2);
    const size_t hstepA = GATHER ? 0 : (size_t)HALF * lda * 2, hstepB = (size_t)(epi_bjadj<Epi>::v ? 32 : HALF) * ldb * 2;
    const unsigned ldsw = (unsigned)wid * 1024u;
    const int aoff = lds_byte(wr * 64 + fr, fq * 8), boff = lds_byte(wc * 32 + fr, fq * 8);
#define PG8_SA(b, h) (((b) * 2 + (h)) * HTB)
#define PG8_SB(b, h) ((4 + (b) * 2 + (h)) * HTB)
#define PG8_STAGE(bufoff, gbase, voff) do { _Pragma("unroll") for (int _i = 0; _i < 2; ++_i) \
        __builtin_amdgcn_global_load_lds((const unsigned*)((const char*)(gbase) + (voff)[_i]), (LAS unsigned*)(lds + (bufoff) + ldsw + _i * 8192), 16, 0, 0); } while (0)
#define PG8_STAGE_A(bufoff, gb, hh, nx) do { if constexpr (GATHER) { unsigned _v[2]; _v[0] = (nx) ? vn[hh][0] : vc[hh][0]; _v[1] = (nx) ? vn[hh][1] : vc[hh][1]; PG8_STAGE(bufoff, gb, _v); } \
        else { PG8_STAGE(bufoff, (gb) + (hh) * hstepA, voffA); } } while (0)
#define PG8_LDA(dst, b, h) do { _Pragma("unroll") for (int m = 0; m < 4; ++m) _Pragma("unroll") for (int k = 0; k < 2; ++k) dst[m][k] = *(const LAS bf16x8*)(lds + PG8_SA(b, h) + aoff + m * 2048 + k * 1024); } while (0)
#define PG8_LDB(dst, b, h) do { _Pragma("unroll") for (int n = 0; n < 2; ++n) _Pragma("unroll") for (int k = 0; k < 2; ++k) dst[n][k] = *(const LAS bf16x8*)(lds + PG8_SB(b, h) + boff + n * 2048 + k * 1024); } while (0)
#define PG8_MMA(ai, bj, At, Bt) do { __builtin_amdgcn_s_setprio(1); _Pragma("unroll") for (int m = 0; m < 4; ++m) _Pragma("unroll") for (int n = 0; n < 2; ++n) _Pragma("unroll") for (int k = 0; k < 2; ++k) { \
        if constexpr (FP8) { const l64x2 _b = __builtin_bit_cast(l64x2, Bt[n][k]), _a = __builtin_bit_cast(l64x2, At[m][k]); \
            acc[ai][bj][m][n] = __builtin_amdgcn_mfma_f32_16x16x32_fp8_fp8(_b[0], _a[0], acc[ai][bj][m][n], 0, 0, 0); acc[ai][bj][m][n] = __builtin_amdgcn_mfma_f32_16x16x32_fp8_fp8(_b[1], _a[1], acc[ai][bj][m][n], 0, 0, 0); } \
        else acc[ai][bj][m][n] = __builtin_amdgcn_mfma_f32_16x16x32_bf16(Bt[n][k], At[m][k], acc[ai][bj][m][n], 0, 0, 0); } __builtin_amdgcn_s_setprio(0); } while (0)
#define PG8_WAIT_V(n) asm volatile("s_waitcnt vmcnt(" #n ")" ::: "memory")
#define PG8_WAIT_L(n) asm volatile("s_waitcnt lgkmcnt(" #n ")" ::: "memory")
#define PG8_BAR __builtin_amdgcn_s_barrier()
#define PG8_SCHED __builtin_amdgcn_sched_barrier(0)
    Unit cur, nxt; int ui = 0;
    if (!S.next(0, cur)) return;
    unsigned vc[2][2] = {{0u, 0u}, {0u, 0u}}, vn[2][2] = {{0u, 0u}, {0u, 0u}};
    gather_offs<GATHER>(cur, tid, lda, vc);
    f32x4 acc[2][2][4][2];
#pragma unroll
    for (int a = 0; a < 2; ++a)
#pragma unroll
        for (int b = 0; b < 2; ++b)
#pragma unroll
            for (int m = 0; m < 4; ++m)
#pragma unroll
                for (int n = 0; n < 2; ++n) acc[a][b][m][n] = (f32x4){0.f, 0.f, 0.f, 0.f};
    bf16x8 At[4][2], B0[2][2], B1[2][2];
    const char* cA = cur.a; const char* cB = cur.b;
    PG8_STAGE(PG8_SB(0, 0), cB, voffB); PG8_STAGE(PG8_SB(0, 1), cB + hstepB, voffB); PG8_STAGE_A(PG8_SA(0, 0), cA, 0, false); PG8_STAGE_A(PG8_SA(0, 1), cA, 1, false);
    if (wr == 1) PG8_BAR;
    PG8_WAIT_V(2); PG8_BAR;
    PG8_STAGE(PG8_SB(1, 0), cB + kstep, voffB); PG8_STAGE_A(PG8_SA(1, 0), cA + kstep, 0, false); PG8_STAGE(PG8_SB(1, 1), cB + hstepB + kstep, voffB);
    PG8_WAIT_V(6); PG8_BAR;
    for (;;) {
        const bool has_next = S.next(ui + 1, nxt);
        if (has_next) gather_offs<GATHER>(nxt, tid, lda, vn);
        const char* nA = has_next ? nxt.a : cA; const char* nB = has_next ? nxt.b : cB;
        const bool do0 = !Sched::HALFSKIP || cur.nvalid > 64 * wr, do1 = !Sched::HALFSKIP || cur.nvalid > 128 + 64 * wr;
        for (int t = 0; t < nt; t += 2) {
            const bool last = (t == nt - 2);
            const bool lnx = last && has_next;
            const char* a1 = cA + (size_t)(t + 1) * kstep;
            const char* a2 = last ? nA : cA + (size_t)(t + 2) * kstep; const char* b2 = last ? nB : cB + (size_t)(t + 2) * kstep;
            const char* a3 = a2 + kstep; const char* b3 = b2 + kstep;
            PG8_LDB(B0, 0, 0); PG8_LDB(B1, 0, 1); PG8_SCHED; PG8_LDA(At, 0, 0); PG8_STAGE_A(PG8_SA(1, 1), a1, 1, false);
            PG8_WAIT_V(8); PG8_WAIT_L(0); PG8_BAR; if (do0) { PG8_MMA(0, 0, At, B0); PG8_MMA(0, 1, At, B1); } PG8_BAR; PG8_SCHED;
            PG8_LDA(At, 0, 1); PG8_STAGE(PG8_SB(0, 0), b2, voffB); PG8_STAGE(PG8_SB(0, 1), b2 + hstepB, voffB); PG8_STAGE_A(PG8_SA(0, 0), a2, 0, lnx);
            PG8_WAIT_V(8); PG8_WAIT_L(0); PG8_BAR; if (do1) { PG8_MMA(1, 0, At, B0); PG8_MMA(1, 1, At, B1); } PG8_BAR; PG8_SCHED;
            PG8_LDB(B0, 1, 0); PG8_LDB(B1, 1, 1); PG8_SCHED; PG8_LDA(At, 1, 0); PG8_STAGE_A(PG8_SA(0, 1), a2, 1, lnx);
            PG8_WAIT_V(8); PG8_WAIT_L(0); PG8_BAR; if (do0) { PG8_MMA(0, 0, At, B0); PG8_MMA(0, 1, At, B1); } PG8_BAR; PG8_SCHED;
            PG8_LDA(At, 1, 1); PG8_STAGE(PG8_SB(1, 0), b3, voffB); PG8_STAGE(PG8_SB(1, 1), b3 + hstepB, voffB); PG8_STAGE_A(PG8_SA(1, 0), a3, 0, lnx);
            PG8_WAIT_V(8); PG8_WAIT_L(0); PG8_BAR; if (do1) { PG8_MMA(1, 0, At, B0); PG8_MMA(1, 1, At, B1); } PG8_BAR; PG8_SCHED;
        }
        if constexpr (ALIGN_EPI) { if (wr == 0) PG8_BAR; }
        E(acc, cur, wr, wc, fr, fq);
        __builtin_amdgcn_s_waitcnt(0x0F70);
        if (!has_next) break;
        if (!E.keep(cur)) {
#pragma unroll
            for (int a = 0; a < 2; ++a)
#pragma unroll
                for (int b = 0; b < 2; ++b)
#pragma unroll
                    for (int m = 0; m < 4; ++m)
#pragma unroll
                        for (int n = 0; n < 2; ++n) acc[a][b][m][n] = (f32x4){0.f, 0.f, 0.f, 0.f};
        }
        cur = nxt; cA = nA; cB = nB; ++ui;
        if constexpr (GATHER) {
#pragma unroll
            for (int hh = 0; hh < 2; ++hh) { vc[hh][0] = vn[hh][0]; vc[hh][1] = vn[hh][1]; }
        }
        if constexpr (ALIGN_EPI) { if (wr == 1) PG8_BAR; }
    }
    PG8_WAIT_V(0);
    if constexpr (!ALIGN_EPI) { if (wr == 0) PG8_BAR; }
    PG8_BAR;
#undef PG8_SA
#undef PG8_SB
#undef PG8_STAGE
#undef PG8_STAGE_A
#undef PG8_LDA
#undef PG8_LDB
#undef PG8_MMA
#undef PG8_WAIT_V
#undef PG8_WAIT_L
#undef PG8_BAR
#undef PG8_SCHED
}
}

#define XB_TMO      128
#define XB_XCNT(j)  (256  + 64 * (j))
#define XB_XSUB(j)  (1280 + 64 * (j))
#define XB_XGEN(j)  (2304 + 64 * (j))
#define XB_TOP      3328
#define XB_TOPGEN   3392
#define XCD_BAR_WORDS 3456
#define XB_SPIN_CAP (1u << 20)
__device__ __forceinline__ unsigned xb_ld(unsigned* p)              { return __hip_atomic_load(p, __ATOMIC_RELAXED, __HIP_MEMORY_SCOPE_AGENT); }
__device__ __forceinline__ unsigned xb_add(unsigned* p, unsigned v) { return __hip_atomic_fetch_add(p, v, __ATOMIC_RELAXED, __HIP_MEMORY_SCOPE_AGENT); }
__device__ __forceinline__ unsigned xb_xcc_id() { return (unsigned)__builtin_amdgcn_s_getreg((3 << 11) | 20) & 0xFu; }
#define XB_SPIN(cond, bar) do { unsigned _sp = 0; while (cond) { __builtin_amdgcn_s_sleep(1); \
    if ((++_sp & 255u) == 0u) { if (xb_ld(&(bar)[XB_TMO])) break; if (_sp > XB_SPIN_CAP) { atomicAdd(&(bar)[XB_TMO], 1u); break; } } } } while (0)
struct XcdBarrier { unsigned* bar; unsigned x; volatile LAS unsigned* st; };
__device__ __forceinline__ XcdBarrier xcd_barrier_post(unsigned* bar, volatile LAS unsigned* st) {
    XcdBarrier b; b.bar = bar; b.x = xb_xcc_id(); b.st = st;
    if (threadIdx.x == 0) (void)xb_add(&bar[XB_XCNT(b.x)], 1u);
    return b;
}
__device__ __forceinline__ void xcd_barrier_complete(unsigned* bar, unsigned x, unsigned& nloc, unsigned& nx) {
    const unsigned G = gridDim.x * gridDim.y * gridDim.z;
    unsigned sum, cnt, mine, sp = 0u;
    for (;;) {
        sum = 0u; cnt = 0u; mine = 0u;
#pragma unroll
        for (unsigned j = 0; j < 16; ++j) { const unsigned c = xb_ld(&bar[XB_XCNT(j)]); sum += c; cnt += (c > 0u) ? 1u : 0u; mine = (j == x) ? c : mine; }
        if (sum == G) break;
        __builtin_amdgcn_s_sleep(1);
        if ((++sp & 255u) == 0u) { if (xb_ld(&bar[XB_TMO])) break; if (sp > XB_SPIN_CAP) { atomicAdd(&bar[XB_TMO], 1u); break; } }
    }
    nloc = mine > 0u ? mine : 1u; nx = cnt > 0u ? cnt : 1u;
}
__device__ __forceinline__ void xcd_barrier(const XcdBarrier& b) {
    asm volatile("s_waitcnt vmcnt(0)" ::: "memory");
    __syncthreads();
    if (threadIdx.x == 0) {
        unsigned* bar = b.bar;
        __builtin_amdgcn_s_waitcnt(0);
        unsigned nloc = b.st[0], nx = b.st[1];
        if (nloc == 0u) { xcd_barrier_complete(bar, b.x, nloc, nx); b.st[0] = nloc; b.st[1] = nx; }
        const unsigned old = xb_add(&bar[XB_XSUB(b.x)], 1u);
        const unsigned gen = old / nloc;
        if (old + 1u == (gen + 1u) * nloc) {
            __builtin_amdgcn_fence(__ATOMIC_RELEASE, "agent");
            asm volatile("s_waitcnt vmcnt(0)" ::: "memory");
            const unsigned og = xb_add(&bar[XB_TOP], 1u);
            const unsigned tg = og / nx;
            if (og + 1u == (tg + 1u) * nx) xb_add(&bar[XB_TOPGEN], 1u);
            else XB_SPIN(xb_ld(&bar[XB_TOPGEN]) == tg, bar);
            __builtin_amdgcn_fence(__ATOMIC_ACQUIRE, "agent");
            asm volatile("s_waitcnt vmcnt(0)" ::: "memory");
        } else {
            XB_SPIN(xb_ld(&bar[XB_TOPGEN]) == gen, bar);
            __builtin_amdgcn_fence(__ATOMIC_ACQUIRE, "agent");
            asm volatile("s_waitcnt vmcnt(0)" ::: "memory");
        }
    }
    __syncthreads();
}

struct Ctx {
    LAS unsigned char* lds;
    int tid, lane, wave, wg, G;
    const float *x, *c, *w_ada, *b_ada, *g1, *w_in, *lb_logits, *g_hgrn, *w_pa, *w_pb, *w_out, *g2, *w_router, *rbias, *w_egu, *w_edown, *w_sgu, *w_sdown, *g_final;
    const int* positions;
    float* out;
    unsigned char* ws;
};
#define WSP(type, off) ((type*)(X.ws + (off)))

__device__ __forceinline__ void transpose_item(const float* W, int K, int N, bf16_t* WT, int dst_row0, int src_col0, int k0, LAS float* scr, int lane) {
#pragma unroll 16
    for (int i = 0; i < 32; ++i) { const int kk = 2 * i + (lane >> 5); scr[kk * 33 + (lane & 31)] = W[(size_t)(k0 + kk) * N + src_col0 + (lane & 31)]; }
    LDS_WAIT(); asm volatile("" ::: "memory");
    const int c = lane & 7;
#pragma unroll
    for (int j = 0; j < 4; ++j) { const int n = (lane >> 3) + 8 * j; const LAS float* s = scr + (8 * c) * 33 + n;
        u32x4 o; o.x = pk2(s[0 * 33], s[1 * 33]); o.y = pk2(s[2 * 33], s[3 * 33]); o.z = pk2(s[4 * 33], s[5 * 33]); o.w = pk2(s[6 * 33], s[7 * 33]);
        *(u32x4*)(WT + (size_t)(dst_row0 + n) * K + k0 + 8 * c) = o; }
    LDS_WAIT(); asm volatile("" ::: "memory");
}
__device__ __forceinline__ void transpose_plain(const float* W, int K, int N, bf16_t* WT, int item, LAS float* scr, int lane) {
    const int nblk = N / 32, kb = item / nblk, nb = item % nblk;
    transpose_item(W, K, N, WT, nb * 32, nb * 32, kb * 64, scr, lane);
}
__device__ __forceinline__ void p0_prologue(Ctx& X) {
    LAS float* scr = (LAS float*)(X.lds + X.wave * 16384);
    const int gw = X.wg * NWAVES + X.wave, NGW = X.G * NWAVES;
    {
        float* MODP = WSP(float, WS_MODP);
        for (int it = gw; it < 96 * 16; it += NGW) {
            const int jc = it % 96, kc = it / 96, j = jc * 64 + X.lane;
            float a0 = 0.f, a1 = 0.f, a2 = 0.f, a3 = 0.f;
#pragma unroll 16
            for (int kk = 0; kk < 64; ++kk) { const int k = kc * 64 + kk; const float w = X.w_ada[(size_t)k * 6144 + j];
                const float c0 = X.c[k], c1 = X.c[1024 + k], c2 = X.c[2048 + k], c3 = X.c[3072 + k];
                a0 += c0 * sigmoidf_(c0) * w; a1 += c1 * sigmoidf_(c1) * w; a2 += c2 * sigmoidf_(c2) * w; a3 += c3 * sigmoidf_(c3) * w; }
            float* o = MODP + (size_t)kc * 24576 + j;
            st_wt4(o, __builtin_bit_cast(unsigned, a0)); st_wt4(o + 6144, __builtin_bit_cast(unsigned, a1)); st_wt4(o + 12288, __builtin_bit_cast(unsigned, a2)); st_wt4(o + 18432, __builtin_bit_cast(unsigned, a3));
        }
    }
    {
        float* ROPE = WSP(float, WS_ROPE);
        const int gt = X.wg * NTHREADS + X.tid, NGT = X.G * NTHREADS;
        for (int idx = gt; idx < T * 8; idx += NGT) { const int t = idx >> 3, i = idx & 7;
            const float inv_freq = 1.0f / powf(500000.0f, (float)(2 * i) / 16.0f);
            const float ang = (float)X.positions[t] * inv_freq;
            ROPE[t * 16 + i] = cosf(ang); ROPE[t * 16 + 8 + i] = sinf(ang); }
        if (X.wg == 0) { float* LB = WSP(float, WS_LB);
            for (int j = X.tid; j < 512; j += NTHREADS) { const float l0 = X.lb_logits[j], l1 = X.lb_logits[512 + j], m = fmaxf(l0, l1), e0 = __expf(l0 - m), e1 = __expf(l1 - m); LB[j] = e0 / (e0 + e1); } }
    }
}
struct CvtItem { const float* src; bf16_t* dst; };
template <bool GU> __device__ __forceinline__ CvtItem cvt_item(const Ctx& X, int it) {
    CvtItem c;
    if constexpr (GU) { const int e = it >> 7, q = it & 127, w8 = q & 7, sq = q >> 3, kb = 4 * (sq >> 2) + (w8 & 3), nb = 2 * (sq & 3) + (w8 >> 2);
        const int n0 = nb * 64, pn = n0 >> 8, bj = (n0 >> 7) & 1, idx = n0 & 127, srcc = bj * 256 + pn * 128 + idx;
        const float* W = (e < NE) ? X.w_egu + (size_t)e * 1024 * 512 : X.w_sgu;
        c.src = W + (size_t)(kb * 64) * 512 + srcc; c.dst = (bf16_t*)(X.ws + WS_WGU + ((size_t)e * 512 + n0) * 1024 + kb * 64); }
    else { const int e = it >> 6, q = it & 63, w8 = q & 7, sq = q >> 3, kb = w8 & 3, nb = 2 * sq + (w8 >> 2);
        const float* W = (e < NE) ? X.w_edown + (size_t)e * 256 * 1024 : X.w_sdown;
        c.src = W + (size_t)(kb * 64) * 1024 + nb * 64; c.dst = (bf16_t*)(X.ws + WS_WD + ((size_t)e * 1024 + nb * 64) * 256 + kb * 64); }
    return c;
}
template <int KB> __device__ __forceinline__ void cvt_store8(const CvtItem& c, int lane, const f32x4 (&v)[16], LAS unsigned char* tl, float sc) {
    const int kq = lane >> 4, nq = lane & 15;
#pragma unroll
    for (int i = 0; i < 4; ++i) { u32x4 w;
        w.x = pk4_fp8(v[0][i] * sc, v[1][i] * sc, v[2][i] * sc, v[3][i] * sc); w.y = pk4_fp8(v[4][i] * sc, v[5][i] * sc, v[6][i] * sc, v[7][i] * sc);
        w.z = pk4_fp8(v[8][i] * sc, v[9][i] * sc, v[10][i] * sc, v[11][i] * sc); w.w = pk4_fp8(v[12][i] * sc, v[13][i] * sc, v[14][i] * sc, v[15][i] * sc);
        *(LAS u32x4*)(tl + (4 * nq + i) * 80 + kq * 16) = w; }
    LDS_WAIT(); asm volatile("" ::: "memory");
    const int ch = lane & 3, r = lane >> 2;
    unsigned char* d8 = (unsigned char*)c.dst;
#pragma unroll
    for (int j = 0; j < 4; ++j) { const int n = 16 * j + r; const u32x4 w = *(const LAS u32x4*)(tl + n * 80 + ch * 16); __builtin_nontemporal_store(w, (u32x4*)(d8 + (size_t)n * KB + 16 * ch)); }
    LDS_WAIT(); asm volatile("" ::: "memory");
}
template <int N> __device__ __forceinline__ void cvt_load(const CvtItem& c, int lane, f32x4 (&v)[16]) {
    const float* p = c.src + (size_t)(16 * (lane >> 4)) * N + 4 * (lane & 15);
#pragma unroll
    for (int j = 0; j < 16; ++j) v[j] = __builtin_nontemporal_load((const f32x4*)(p + (size_t)j * N));
}
template <int K> __device__ __forceinline__ void cvt_store(const CvtItem& c, int lane, const f32x4 (&v)[16], LAS unsigned char* tl) {
    const int kq = lane >> 4, nq = lane & 15;
#pragma unroll
    for (int i = 0; i < 4; ++i) { u32x4 w0, w1;
        w0.x = pk2(v[0][i], v[1][i]); w0.y = pk2(v[2][i], v[3][i]); w0.z = pk2(v[4][i], v[5][i]); w0.w = pk2(v[6][i], v[7][i]);
        w1.x = pk2(v[8][i], v[9][i]); w1.y = pk2(v[10][i], v[11][i]); w1.z = pk2(v[12][i], v[13][i]); w1.w = pk2(v[14][i], v[15][i]);
        LAS unsigned char* q = tl + (4 * nq + i) * 144 + kq * 32; *(LAS u32x4*)q = w0; *(LAS u32x4*)(q + 16) = w1; }
    LDS_WAIT(); asm volatile("" ::: "memory");
    const int ch = lane & 7, r = lane >> 3;
#pragma unroll
    for (int j = 0; j < 8; ++j) { const int n = 8 * j + r; const u32x4 w = *(const LAS u32x4*)(tl + n * 144 + ch * 16); __builtin_nontemporal_store(w, (u32x4*)(c.dst + (size_t)n * K + 8 * ch)); }
    LDS_WAIT(); asm volatile("" ::: "memory");
}
struct CvtPair { const float* src; unsigned char* dst; };
template <bool GU> __device__ __forceinline__ CvtPair cvt_pair(const Ctx& X, int di) {
    CvtPair c;
    if constexpr (GU) { const int e = di >> 6, q = di & 63, nb = q & 7, kb2 = q >> 3;
        const int n0 = nb * 64, pn = n0 >> 8, bj = (n0 >> 7) & 1, idx = n0 & 127, srcc = bj * 256 + pn * 128 + idx;
        const float* W = (e < NE) ? X.w_egu + (size_t)e * 1024 * 512 : X.w_sgu;
        c.src = W + (size_t)(kb2 * 128) * 512 + srcc; c.dst = X.ws + WS_WGU + ((size_t)e * 512 + n0) * 1024 + kb2 * 128; }
    else { const int e = di >> 5, q = di & 31, nb = q & 15, kb2 = q >> 4;
        const float* W = (e < NE) ? X.w_edown + (size_t)e * 256 * 1024 : X.w_sdown;
        c.src = W + (size_t)(kb2 * 128) * 1024 + nb * 64; c.dst = X.ws + WS_WD + ((size_t)e * 1024 + nb * 64) * 256 + kb2 * 128; }
    return c;
}
template <int N> __device__ __forceinline__ void cvt_load_half(const CvtPair& c, int half, int lane, f32x4 (&v)[16]) {
    const float* p = c.src + (size_t)(64 * half + 16 * (lane >> 4)) * N + 4 * (lane & 15);
#pragma unroll
    for (int j = 0; j < 16; ++j) v[j] = __builtin_nontemporal_load((const f32x4*)(p + (size_t)j * N));
}
__device__ __forceinline__ void cvt_half_to_lds(int half, int lane, const f32x4 (&v)[16], LAS unsigned char* tl, float sc) {
    const int kq = lane >> 4, nq = lane & 15;
#pragma unroll
    for (int i = 0; i < 4; ++i) { u32x4 w;
        w.x = pk4_fp8(v[0][i] * sc, v[1][i] * sc, v[2][i] * sc, v[3][i] * sc); w.y = pk4_fp8(v[4][i] * sc, v[5][i] * sc, v[6][i] * sc, v[7][i] * sc);
        w.z = pk4_fp8(v[8][i] * sc, v[9][i] * sc, v[10][i] * sc, v[11][i] * sc); w.w = pk4_fp8(v[12][i] * sc, v[13][i] * sc, v[14][i] * sc, v[15][i] * sc);
        *(LAS u32x4*)(tl + (4 * nq + i) * 144 + half * 64 + kq * 16) = w; }
}
template <int KB> __device__ __forceinline__ void cvt_flush(const CvtPair& c, int lane, LAS unsigned char* tl) {
    LDS_WAIT(); asm volatile("" ::: "memory");
    const int ch = lane & 7, r = lane >> 3;
#pragma unroll
    for (int j = 0; j < 8; ++j) { const int n = 8 * j + r; const u32x4 w = *(const LAS u32x4*)(tl + n * 144 + ch * 16); __builtin_nontemporal_store(w, (u32x4*)(c.dst + (size_t)n * KB + 16 * ch)); }
    LDS_WAIT(); asm volatile("" ::: "memory");
}
template <bool GU> __device__ __forceinline__ void expert_convert_set(Ctx& X, int gw, int NGW, LAS unsigned char* tl) {
    constexpr int NIT = GU ? NEX * 64 : NEX * 32, N = GU ? 512 : 1024, K = GU ? 1024 : 256; constexpr float SC = GU ? WGU_SCALE : WD_SCALE;
    if (gw >= NIT) return;
    const int nmine = (NIT - gw + NGW - 1) / NGW;
    f32x4 va[16], vb[16];
    CvtPair cur = cvt_pair<GU>(X, gw);
    cvt_load_half<N>(cur, 0, X.lane, va); cvt_load_half<N>(cur, 1, X.lane, vb);
    for (int j = 0; j < nmine; ++j) {
        const CvtPair nxt = cvt_pair<GU>(X, gw + (j + 1 < nmine ? j + 1 : j) * NGW);
        __builtin_amdgcn_sched_barrier(0);
        cvt_half_to_lds(0, X.lane, va, tl, SC);
        __builtin_amdgcn_sched_barrier(0);
        cvt_load_half<N>(nxt, 0, X.lane, va);
        __builtin_amdgcn_sched_barrier(0);
        cvt_half_to_lds(1, X.lane, vb, tl, SC);
        cvt_flush<K>(cur, X.lane, tl);
        __builtin_amdgcn_sched_barrier(0);
        cvt_load_half<N>(nxt, 1, X.lane, vb);
        __builtin_amdgcn_sched_barrier(0);
        cur = nxt;
    }
}
__device__ __forceinline__ void expert_convert(Ctx& X, int cw, int ncw) {
    LAS unsigned char* tl = X.lds + X.wave * 16384;
    const int gw = cw * NWAVES + X.wave, NGW = ncw * NWAVES;
    expert_convert_set<true>(X, gw, NGW, tl);
    expert_convert_set<false>(X, gw, NGW, tl);
}

__device__ __forceinline__ void small_transposes(Ctx& X) {
    LAS float* scr = (LAS float*)(X.lds + 16384 + X.wave * 12288);
    const int gw = X.wg * NWAVES + X.wave, NGW = X.G * NWAVES;
    {
        constexpr int I_IN = 16 * 272, I_PA = 8 * 32, I_PB = 8 * 32, I_OUT = 16 * 32, I_R = 16 * 8;
        constexpr int NITEMS = I_IN + I_PA + I_PB + I_OUT + I_R;
        for (int it = gw; it < NITEMS; it += NGW) {
            int r = it;
            if (r < I_IN) { transpose_plain(X.w_in, 1024, INW, WSP(bf16_t, WS_WIN), r, scr, X.lane); continue; } r -= I_IN;
            if (r < I_PA) { transpose_plain(X.w_pa, 512, 1024, WSP(bf16_t, WS_WPA), r, scr, X.lane); continue; } r -= I_PA;
            if (r < I_PB) { transpose_plain(X.w_pb, 512, 1024, WSP(bf16_t, WS_WPB), r, scr, X.lane); continue; } r -= I_PB;
            if (r < I_OUT) { transpose_plain(X.w_out, 1024, 1024, WSP(bf16_t, WS_WOUT), r, scr, X.lane); continue; } r -= I_OUT;
            transpose_plain(X.w_router, 1024, 256, WSP(bf16_t, WS_WR), r, scr, X.lane);
        }
    }
}

__device__ __forceinline__ void norm_rows(Ctx& X, int which) {
    LAS float* sm = (LAS float*)X.lds;
    const float* MODP = WSP(float, WS_MODP); float* MOD = WSP(float, WS_MOD);
    const int rows_per_wg = T / X.G, row0 = X.wg * rows_per_wg, b = row0 / SEQ;
    if (which == 0) {
        for (int i = X.tid; i < 2048; i += NTHREADS) { const int j = b * 6144 + i; float s = X.b_ada[i];
#pragma unroll
            for (int p = 0; p < 16; ++p) s += MODP[(size_t)p * 24576 + j];
            sm[i] = s; }
        const int per = 24576 / X.G;
        for (int i = X.tid; i < per; i += NTHREADS) { const int j = X.wg * per + i; float s = X.b_ada[j % 6144];
#pragma unroll
            for (int p = 0; p < 16; ++p) s += MODP[(size_t)p * 24576 + j];
            MOD[j] = s; }
    } else {
        for (int i = X.tid; i < 2048; i += NTHREADS) sm[i] = MOD[b * 6144 + 3072 + i];
    }
    __syncthreads();
    const float* src = X.x; const bf16_t* srcb = WSP(bf16_t, WS_X1); const float* g = which == 0 ? X.g1 : X.g2;
    bf16_t* H = WSP(bf16_t, WS_H);
    for (int r = X.wave; r < rows_per_wg; r += NWAVES) {
        const int row = row0 + r;
        f32x4 v[2][2]; float s = 0.f;
#pragma unroll
        for (int j = 0; j < 2; ++j) { const int col = 8 * X.lane + 512 * j;
            if (which == 0) { v[j][0] = *(const f32x4*)(src + (size_t)row * D + col); v[j][1] = *(const f32x4*)(src + (size_t)row * D + col + 4); }
            else { const u32x4 wv = *(const u32x4*)(srcb + (size_t)row * D + col); v[j][0] = (f32x4){bflo(wv.x), bfhi(wv.x), bflo(wv.y), bfhi(wv.y)}; v[j][1] = (f32x4){bflo(wv.z), bfhi(wv.z), bflo(wv.w), bfhi(wv.w)}; }
#pragma unroll
            for (int q = 0; q < 2; ++q) s += (v[j][q].x * v[j][q].x + v[j][q].y * v[j][q].y) + (v[j][q].z * v[j][q].z + v[j][q].w * v[j][q].w); }
        const float rstd = rsqrtf(wave_sum(s) * (1.f / D) + EPS);
#pragma unroll
        for (int j = 0; j < 2; ++j) { const int col = 8 * X.lane + 512 * j; float y[8];
#pragma unroll
            for (int q = 0; q < 2; ++q) { const f32x4 gg = *(const f32x4*)(g + col + 4 * q), sh = *(const LAS f32x4*)(sm + col + 4 * q), sc = *(const LAS f32x4*)(sm + 1024 + col + 4 * q);
#pragma unroll
                for (int e = 0; e < 4; ++e) y[4 * q + e] = v[j][q][e] * rstd * gg[e] * (1.f + sc[e]) + sh[e]; }
            u32x4 hw; hw.x = pk2(y[0], y[1]); hw.y = pk2(y[2], y[3]); hw.z = pk2(y[4], y[5]); hw.w = pk2(y[6], y[7]);
            if (which == 1) { st_wt16(H + (size_t)row * D + col, hw);
                st_wt8(WSP(unsigned char, WS_H8) + (size_t)row * D + col, (unsigned long long)pk4_fp8(y[0], y[1], y[2], y[3]) | ((unsigned long long)pk4_fp8(y[4], y[5], y[6], y[7]) << 32)); }
            else *(u32x4*)(H + (size_t)row * D + col) = hw; }
    }
    __syncthreads();
}

struct RegSched {
    static constexpr bool HALFSKIP = false;
    const char* A; const char* Bt; size_t a_tile, b_tile; int nM, nN, G, c;
    __device__ __forceinline__ bool next(int i, pg8::Unit& u) const {
        const int L = i * G + c; if (L >= nM * nN) return false;
        int pm, pn; pg8::swz_tile(L, nM, nN, pm, pn);
        u.a = A + (size_t)pm * a_tile; u.b = Bt + (size_t)pn * b_tile; u.rows = nullptr; u.pm = pm; u.pn = pn; u.aux = 0; u.nvalid = 256; return true;
    }
};
struct TwoPartSched {      static constexpr bool HALFSKIP = false;
    const char* Y; const char* Wa; const char* Wb; int nM, nN, G, c;
    __device__ __forceinline__ bool next(int i, pg8::Unit& u) const {
        const int L = (i >> 1) * G + c, part = i & 1; if (L >= nM * nN) return false;
        int pm, pn; pg8::swz_tile(L, nM, nN, pm, pn);
        u.a = Y + (size_t)pm * 256 * 2048 + part * 1024; u.b = (part ? Wb : Wa) + (size_t)pn * 256 * 1024; u.rows = nullptr; u.pm = pm; u.pn = pn; u.aux = part; u.nvalid = 256; return true;
    }
};
struct MoeSched {
    static constexpr bool HALFSKIP = true;
    const LAS int* tbl; const LAS int* cnts; int nent; const char* A; const char* W; const int* lists; int ncol  , wtile  , wexp  , atile  , G, c;
    __device__ __forceinline__ bool next(int i, pg8::Unit& u) const {
        const int un = i * (G >> 3) + (c >> 3); if (un >= nent * ncol) return false;
        const int pn = un % ncol; const int ent = __builtin_amdgcn_readfirstlane(tbl[un / ncol]), e = (ent >> 7) & 511, r = ent & 127, rt = ent >> 16;
        u.a = A + (size_t)rt * atile; u.b = W + (size_t)e * wexp + (size_t)pn * wtile; u.rows = lists + (size_t)e * 16384 + r * 256;
        u.pm = rt; u.pn = pn; u.aux = e; const int left = __builtin_amdgcn_readfirstlane(cnts[e]) - r * 256; u.nvalid = left < 256 ? left : 256; return true;
    }
};

__device__ __forceinline__ unsigned dpp_xor1(unsigned x) { return (unsigned)__builtin_amdgcn_update_dpp(0, (int)x, 0xB1, 0xF, 0xF, true); }
__device__ __forceinline__ void pair_rows(const u32x4& w0, const u32x4& w1, bool oddr, u32x4& ev, u32x4& od) {
    const u32x4 snd = oddr ? w0 : w1;
    u32x4 rcv; rcv.x = dpp_xor1(snd.x); rcv.y = dpp_xor1(snd.y); rcv.z = dpp_xor1(snd.z); rcv.w = dpp_xor1(snd.w);
    ev = oddr ? rcv : w0; od = oddr ? w1 : rcv;
}
struct EpiInproj {
    static constexpr bool PERM = true;
    static constexpr bool BJADJ = true;
    bf16_t* PROJ; float* LOGF; const float* LB; const float* ROPE; unsigned char* G8; unsigned char* QK8;
    __device__ __forceinline__ bool keep(const pg8::Unit&) const { return false; }
    __device__ __forceinline__ void operator()(f32x4 (&acc)[2][2][4][2], const pg8::Unit& u, int wr, int wc, int fr, int fq) const {
        const int pn = u.pn;
        const int mode = pn < 2 ? 0 : pn < 4 ? 1 : pn < 6 ? 0 : pn < 8 ? 2 : pn < 20 ? 3 : pn < 26 ? 5 : 4;
        const int row0 = u.pm * 256 + wr * 64 + fr, colb = pn * 256 + wc * 64 + 8 * fq;
        const bool rot3 = (mode == 3);
        const bool odd = fq & 1; const int colw = pn * 256 + wc * 64 + (fq & 1) * 32 + (fq >> 1) * 16;
#pragma unroll
        for (int ai = 0; ai < 2; ++ai)
#pragma unroll
            for (int m = 0; m < 4; ++m) {
                const int row = row0 + ai * 128 + m * 16;
                f32x4 cs0, cs1, sn0, sn1;
                if (rot3) { const f32x4* rp = (const f32x4*)(ROPE + (size_t)row * 16); cs0 = rp[0]; cs1 = rp[1]; sn0 = rp[2]; sn1 = rp[3]; }
                u32x2 p8[2]; u32x4 wb[2];
#pragma unroll
                for (int bj = 0; bj < 2; ++bj) {
                    const int col = colb + bj * 32; const bool rot = rot3 && bj == 0;
                    f32x4 v0 = acc[ai][bj][m][0], v1 = acc[ai][bj][m][1];
                    if (mode == 1) {
                        const int cf = col - 512; const f32x4 l0 = *(const f32x4*)(LB + cf), l1 = *(const f32x4*)(LB + cf + 4);
                        f32x4 lf0, lf1;
#pragma unroll
                        for (int j = 0; j < 4; ++j) { float sg = sigmoidf_(v0[j]); float f = l0[j] + (1.f - l0[j]) * sg; lf0[j] = fast_logf(f); v0[j] = (1.f - l0[j]) * (1.f - sg);
                            sg = sigmoidf_(v1[j]); f = l1[j] + (1.f - l1[j]) * sg; lf1[j] = fast_logf(f); v1[j] = (1.f - l1[j]) * (1.f - sg); }
                        acc[ai][bj][m][0] = lf0; acc[ai][bj][m][1] = lf1;
                    } else if (mode == 2) {
#pragma unroll
                        for (int j = 0; j < 4; ++j) { v0[j] = v0[j] * sigmoidf_(v0[j]); v1[j] = v1[j] * sigmoidf_(v1[j]); }
                    } else if (mode == 4) {
#pragma unroll
                        for (int j = 0; j < 4; ++j) { v0[j] = sigmoidf_(v0[j]); v1[j] = sigmoidf_(v1[j]); }
                    } else if (rot) {
                        f32x4 p0, p1;
#pragma unroll
                        for (int j = 0; j < 4; ++j) { p0[j] = __shfl_xor(v0[j], 16); p1[j] = __shfl_xor(v1[j], 16); }
                        if (fq == 0) { v0 = v0 * cs0 - p0 * sn0; v1 = v1 * cs1 - p1 * sn1; }
                        else if (fq == 1) { v0 = v0 * cs0 + p0 * sn0; v1 = v1 * cs1 + p1 * sn1; }
                    }
                    if (mode == 4) {
                        int g0 = 0, g1 = 0;
#pragma unroll
                        for (int j = 0; j < 4; ++j) { g0 = __builtin_amdgcn_cvt_pk_u8_f32(fmaxf(v0[j] * 255.0f, 1.0f), j, g0); g1 = __builtin_amdgcn_cvt_pk_u8_f32(fmaxf(v1[j] * 255.0f, 1.0f), j, g1); }
                        p8[bj] = (u32x2){(unsigned)g0, (unsigned)g1};
                        continue; }
                    if (mode == 3 || mode == 5) {
                        p8[bj] = (u32x2){pk4_fp8(v0[0], v0[1], v0[2], v0[3]), pk4_fp8(v1[0], v1[1], v1[2], v1[3])};
                        continue; }
                    wb[bj].x = pg8::cvt_pk_bf16(v0[0], v0[1]); wb[bj].y = pg8::cvt_pk_bf16(v0[2], v0[3]); wb[bj].z = pg8::cvt_pk_bf16(v1[0], v1[1]); wb[bj].w = pg8::cvt_pk_bf16(v1[2], v1[3]);
                }
                if (mode < 3) {
                    u32x4 ev, od; pair_rows(wb[0], wb[1], fr & 1, ev, od);
                    bf16_t* pp = PROJ + (size_t)(row - (fr & 1)) * INW + colb + (fr & 1) * 32;
                    *(u32x4*)pp = ev; *(u32x4*)(pp + INW) = od;
                }
                if (mode >= 3) {
                    const u32x2 snd = odd ? p8[0] : p8[1];
                    u32x2 rcv; rcv.x = (unsigned)__shfl_xor((int)snd.x, 16); rcv.y = (unsigned)__shfl_xor((int)snd.y, 16);
                    const u32x4 w = odd ? (u32x4){rcv.x, rcv.y, p8[1].x, p8[1].y} : (u32x4){p8[0].x, p8[0].y, rcv.x, rcv.y};
                    if (mode == 4) *(u32x4*)(G8 + (size_t)row * 2048 + (colw - C_GA)) = w;
                    else *(u32x4*)(QK8 + (size_t)row * 4608 + (colw - C_AQ)) = w;
                }
            }
        if (mode == 1) {
            const int lane = fq * 16 + fr;
#pragma unroll
            for (int ai = 0; ai < 2; ++ai)
#pragma unroll
                for (int bj = 0; bj < 2; ++bj)
#pragma unroll
                    for (int n = 0; n < 2; ++n)
#pragma unroll
                        for (int j = 0; j < 4; ++j) { float carry = 0.f;
#pragma unroll
                            for (int m = 0; m < 4; ++m) { float v = acc[ai][bj][m][n][j];
                                v += __builtin_bit_cast(float, __builtin_amdgcn_update_dpp(0, __builtin_bit_cast(int, v), 0x111, 0xF, 0xF, true));
                                v += __builtin_bit_cast(float, __builtin_amdgcn_update_dpp(0, __builtin_bit_cast(int, v), 0x112, 0xF, 0xF, true));
                                v += __builtin_bit_cast(float, __builtin_amdgcn_update_dpp(0, __builtin_bit_cast(int, v), 0x114, 0xF, 0xF, true));
                                v += __builtin_bit_cast(float, __builtin_amdgcn_update_dpp(0, __builtin_bit_cast(int, v), 0x118, 0xF, 0xF, true));
                                v += carry; acc[ai][bj][m][n][j] = v; carry = __shfl(v, (lane & 48) | 15); } }
#pragma unroll
            for (int ai = 0; ai < 2; ++ai)
#pragma unroll
                for (int m = 0; m < 4; ++m)
#pragma unroll
                    for (int bj = 0; bj < 2; ++bj) { float* lp = LOGF + (size_t)(row0 + ai * 128 + m * 16) * 512 + (colb + bj * 32 - 512); *(f32x4*)lp = acc[ai][bj][m][0]; *(f32x4*)(lp + 4) = acc[ai][bj][m][1]; }
        }
    }
};
__device__ __forceinline__ void gate8(u32x2 w, f32x4& lo, f32x4& hi) {
    constexpr float s = 1.0f / 255.0f;
    lo = (f32x4){(float)(w.x & 255u), (float)((w.x >> 8) & 255u), (float)((w.x >> 16) & 255u), (float)(w.x >> 24)} * s;
    hi = (f32x4){(float)(w.y & 255u), (float)((w.y >> 8) & 255u), (float)((w.y >> 16) & 255u), (float)(w.y >> 24)} * s;
}
struct EpiMixed {
    static constexpr bool PERM = true;
    static constexpr bool BJADJ = true;
    const unsigned char* G8; bf16_t* MIXED;
    __device__ __forceinline__ bool keep(const pg8::Unit& u) const { return u.aux == 0; }
    __device__ __forceinline__ void operator()(f32x4 (&acc)[2][2][4][2], const pg8::Unit& u, int wr, int wc, int fr, int fq) const {
        const int row0 = u.pm * 256 + wr * 64 + fr, colb = u.pn * 256 + wc * 64 + 8 * fq;
#pragma unroll
        for (int ai = 0; ai < 2; ++ai)
#pragma unroll
            for (int m = 0; m < 4; ++m) {
                const int row = row0 + ai * 128 + m * 16;
                u32x4 wb[2];
#pragma unroll
                for (int bj = 0; bj < 2; ++bj) {
                    const int col = colb + bj * 32;
                    f32x4 b0, b1; gate8(*(const u32x2*)(G8 + (size_t)row * 2048 + 1024 + col), b0, b1);
                    if (u.aux == 0) {
                        f32x4 a0, a1; gate8(*(const u32x2*)(G8 + (size_t)row * 2048 + col), a0, a1);
#pragma unroll
                        for (int j = 0; j < 4; ++j) { acc[ai][bj][m][0][j] *= a0[j] * __builtin_amdgcn_rcpf(b0[j]); acc[ai][bj][m][1][j] *= a1[j] * __builtin_amdgcn_rcpf(b1[j]); }
                    } else {
                        const f32x4 v0 = acc[ai][bj][m][0] * b0, v1 = acc[ai][bj][m][1] * b1;
                        wb[bj].x = pg8::cvt_pk_bf16(v0[0], v0[1]); wb[bj].y = pg8::cvt_pk_bf16(v0[2], v0[3]); wb[bj].z = pg8::cvt_pk_bf16(v1[0], v1[1]); wb[bj].w = pg8::cvt_pk_bf16(v1[2], v1[3]);
                    }
                }
                if (u.aux != 0) {
                    u32x4 ev, od; pair_rows(wb[0], wb[1], fr & 1, ev, od);
                    bf16_t* pp = MIXED + (size_t)(row - (fr & 1)) * D + colb + (fr & 1) * 32;
                    st_wt16(pp, ev); st_wt16(pp + D, od);
                }
            }
    }
};
struct EpiOutproj {
    static constexpr bool PERM = true;
    const float* x; const float* MOD; bf16_t* X1;
    __device__ __forceinline__ bool keep(const pg8::Unit&) const { return false; }
    __device__ __forceinline__ void operator()(f32x4 (&acc)[2][2][4][2], const pg8::Unit& u, int wr, int wc, int fr, int fq) const {
        const int row0 = u.pm * 256 + wr * 64 + fr, colb = u.pn * 256 + wc * 32 + 8 * fq;
        const int b = (u.pm * 256) / SEQ;
#pragma unroll
        for (int bj = 0; bj < 2; ++bj) {
            const int col = colb + bj * 128;
            const f32x4 g0 = *(const f32x4*)(MOD + b * 6144 + 2048 + col), g1 = *(const f32x4*)(MOD + b * 6144 + 2048 + col + 4);
#pragma unroll
            for (int ai = 0; ai < 2; ++ai)
#pragma unroll
                for (int m = 0; m < 4; ++m) { const size_t off = (size_t)(row0 + ai * 128 + m * 16) * D + col;
                    const f32x4 v0 = *(const f32x4*)(x + off) + g0 * acc[ai][bj][m][0], v1 = *(const f32x4*)(x + off + 4) + g1 * acc[ai][bj][m][1];
                    u32x4 w; w.x = pg8::cvt_pk_bf16(v0[0], v0[1]); w.y = pg8::cvt_pk_bf16(v0[2], v0[3]); w.z = pg8::cvt_pk_bf16(v1[0], v1[1]); w.w = pg8::cvt_pk_bf16(v1[2], v1[3]);
                    st_wt16(X1 + off, w); }
        }
    }
};
struct EpiOutNorm {
    static constexpr bool PERM = true;
    static constexpr bool BJADJ = true;
    const float* x; const float* MOD; const float* g2; bf16_t* X1; bf16_t* H; unsigned char* H8; float* XB; unsigned* cnt; LAS unsigned char* sl;
    __device__ __forceinline__ bool keep(const pg8::Unit&) const { return false; }
    __device__ __forceinline__ void operator()(f32x4 (&acc)[2][2][4][2], const pg8::Unit& u, int wr, int wc, int fr, int fq) const {
        const int tid = threadIdx.x;
        const int rl0 = wr * 64 + fr, row0 = u.pm * 256 + rl0, colb = u.pn * 256 + wc * 64 + 8 * fq;
        const int b = (u.pm * 256) / SEQ;
        LAS float* Pt = (LAS float*)sl; LAS float* Rs = (LAS float*)(sl + 4096); LAS float* GS = (LAS float*)(sl + 5120); LAS float* SH = (LAS float*)(sl + 6144);
#pragma unroll
        for (int bj = 0; bj < 2; ++bj) {
            const int col = colb + bj * 32;
            const f32x4 g0 = *(const f32x4*)(MOD + b * 6144 + 2048 + col), g1 = *(const f32x4*)(MOD + b * 6144 + 2048 + col + 4);
#pragma unroll
            for (int ai = 0; ai < 2; ++ai)
#pragma unroll
                for (int m = 0; m < 4; ++m) { const size_t off = (size_t)(row0 + ai * 128 + m * 16) * D + col;
                    acc[ai][bj][m][0] = *(const f32x4*)(x + off) + g0 * acc[ai][bj][m][0]; acc[ai][bj][m][1] = *(const f32x4*)(x + off + 4) + g1 * acc[ai][bj][m][1];
                    asm volatile("" : "+v"(acc[ai][bj][m][0]), "+v"(acc[ai][bj][m][1]));
                    if (m & 1) asm volatile("" ::: "memory"); }
        }
#pragma unroll
        for (int ai = 0; ai < 2; ++ai)
#pragma unroll
            for (int m = 0; m < 4; ++m) { float q = 0.f;
#pragma unroll
                for (int bj = 0; bj < 2; ++bj)
#pragma unroll
                    for (int n = 0; n < 2; ++n) { const f32x4 v = acc[ai][bj][m][n]; q += (v[0] * v[0] + v[1] * v[1]) + (v[2] * v[2] + v[3] * v[3]); }
                q += __shfl_xor(q, 16); q += __shfl_xor(q, 32);
                if (fq == 0) Pt[(ai * 128 + rl0 + m * 16) * 4 + wc] = q; }
        asm volatile("s_waitcnt lgkmcnt(0)" ::: "memory"); __builtin_amdgcn_s_barrier(); asm volatile("" ::: "memory");
        if (tid < 256) { const f32x4 p = *(const LAS f32x4*)(Pt + tid * 4); st_wt4(XB + ((size_t)u.pm * 256 + tid) * 4 + u.pn, __builtin_bit_cast(unsigned, (p[0] + p[1]) + (p[2] + p[3]))); }
        asm volatile("s_waitcnt vmcnt(0)" ::: "memory"); __builtin_amdgcn_s_barrier(); asm volatile("" ::: "memory");
        if (tid == 0) { unsigned* p = cnt + (size_t)u.pm * 64; (void)xb_add(p, 1u); unsigned sp = 0u;
            while (xb_ld(p) < 4u) { __builtin_amdgcn_s_sleep(2); if (++sp > (1u << 22)) break; }
            __builtin_amdgcn_fence(__ATOMIC_ACQUIRE, "agent"); asm volatile("s_waitcnt vmcnt(0)" ::: "memory"); }
        __builtin_amdgcn_s_barrier(); asm volatile("" ::: "memory");
        if (tid < 256) { const f32x4 q = *(const f32x4*)(XB + ((size_t)u.pm * 256 + tid) * 4); Rs[tid] = rsqrtf(((q[0] + q[1]) + (q[2] + q[3])) * (1.f / D) + EPS); }
        else { const int c = tid - 256, col = u.pn * 256 + c; GS[c] = g2[col] * (1.0f + MOD[b * 6144 + 4096 + col]); SH[c] = MOD[b * 6144 + 3072 + col]; }
        asm volatile("s_waitcnt vmcnt(0) lgkmcnt(0)" ::: "memory"); __builtin_amdgcn_s_barrier(); asm volatile("" ::: "memory");
        const bool oddr = fr & 1, oddq = fq & 1;
#pragma unroll
        for (int ai = 0; ai < 2; ++ai)
#pragma unroll
            for (int m = 0; m < 4; ++m) { const int rl = ai * 128 + rl0 + m * 16; const float rs = Rs[rl];
                u32x4 xw[2], hw[2]; u32x2 h8[2];
#pragma unroll
                for (int bj = 0; bj < 2; ++bj) { const int cp = wc * 64 + bj * 32 + 8 * fq;
                    const f32x4 g0 = *(const LAS f32x4*)(GS + cp), g1 = *(const LAS f32x4*)(GS + cp + 4), s0 = *(const LAS f32x4*)(SH + cp), s1 = *(const LAS f32x4*)(SH + cp + 4);
                    const f32x4 v0 = acc[ai][bj][m][0], v1 = acc[ai][bj][m][1];
                    xw[bj].x = pg8::cvt_pk_bf16(v0[0], v0[1]); xw[bj].y = pg8::cvt_pk_bf16(v0[2], v0[3]); xw[bj].z = pg8::cvt_pk_bf16(v1[0], v1[1]); xw[bj].w = pg8::cvt_pk_bf16(v1[2], v1[3]);
                    const f32x4 h0 = v0 * rs * g0 + s0, h1 = v1 * rs * g1 + s1;
                    hw[bj].x = pg8::cvt_pk_bf16(h0[0], h0[1]); hw[bj].y = pg8::cvt_pk_bf16(h0[2], h0[3]); hw[bj].z = pg8::cvt_pk_bf16(h1[0], h1[1]); hw[bj].w = pg8::cvt_pk_bf16(h1[2], h1[3]);
                    h8[bj] = (u32x2){pk4_fp8(h0[0], h0[1], h0[2], h0[3]), pk4_fp8(h1[0], h1[1], h1[2], h1[3])}; }
                const size_t rowoff = (size_t)(u.pm * 256 + rl) * D + u.pn * 256 + wc * 64;
                const size_t offp = rowoff - (oddr ? D : 0) + 8 * fq + (oddr ? 32 : 0);
                u32x4 ev, od;
                pair_rows(xw[0], xw[1], oddr, ev, od); *(u32x4*)(X1 + offp) = ev; *(u32x4*)(X1 + offp + D) = od;
                pair_rows(hw[0], hw[1], oddr, ev, od); st_wt16(H + offp, ev); st_wt16(H + offp + D, od);
                const u32x2 snd = oddq ? h8[0] : h8[1];
                u32x2 rcv; rcv.x = (unsigned)__shfl_xor((int)snd.x, 16); rcv.y = (unsigned)__shfl_xor((int)snd.y, 16);
                const u32x4 w8 = oddq ? (u32x4){rcv.x, rcv.y, h8[1].x, h8[1].y} : (u32x4){h8[0].x, h8[0].y, rcv.x, rcv.y};
                st_wt16(H8 + rowoff + (fq & 1) * 32 + (fq >> 1) * 16, w8);
                asm volatile("" ::: "memory"); }
    }
};
struct EpiRouter {
    static constexpr bool PERM = false;
    float* LOGITS4;
    __device__ __forceinline__ bool keep(const pg8::Unit&) const { return false; }
    __device__ __forceinline__ void operator()(f32x4 (&acc)[2][2][4][2], const pg8::Unit& u, int wr, int wc, int fr, int fq) const {
        const int row0 = u.pm * 256 + wr * 64 + fr, colb = wc * 32 + 4 * fq;
        float* base = LOGITS4 + (size_t)u.aux * T * 256;
#pragma unroll
        for (int ai = 0; ai < 2; ++ai)
#pragma unroll
            for (int m = 0; m < 4; ++m)
#pragma unroll
                for (int bj = 0; bj < 2; ++bj)
#pragma unroll
                    for (int n = 0; n < 2; ++n) st_wt16(base + (size_t)(row0 + ai * 128 + m * 16) * 256 + colb + bj * 128 + n * 16, __builtin_bit_cast(u32x4, acc[ai][bj][m][n]));
    }
};
struct RouterSched {
    static constexpr bool HALFSKIP = false;
    const char* A; const char* Bt; int G, c;
    __device__ __forceinline__ bool next(int i, pg8::Unit& u) const {
        const int L = i * G + c; if (L >= 256) return false;
        const int pm = L >> 2, ks = L & 3;
        u.a = A + (size_t)pm * 256 * 2048 + ks * 512; u.b = Bt + ks * 512; u.rows = nullptr; u.pm = pm; u.pn = 0; u.aux = ks; u.nvalid = 256; return true;
    }
};
struct EpiGU {
    static constexpr bool PERM = true;
    unsigned char* ACT;
    __device__ __forceinline__ bool keep(const pg8::Unit&) const { return false; }
    __device__ __forceinline__ void operator()(f32x4 (&acc)[2][2][4][2], const pg8::Unit& u, int wr, int wc, int fr, int fq) const {
        const int rl0 = wr * 64 + fr, col = u.pn * 128 + wc * 32 + 8 * fq;
        constexpr float is = 1.0f / WGU_SCALE;
#pragma unroll
        for (int ai = 0; ai < 2; ++ai)
#pragma unroll
            for (int m = 0; m < 4; ++m) {
                const int rl = rl0 + ai * 128 + m * 16;
                f32x4 v0, v1;
#pragma unroll
                for (int j = 0; j < 4; ++j) { const float a0 = acc[ai][0][m][0][j] * is, a1 = acc[ai][0][m][1][j] * is;
                    v0[j] = a0 * sigmoidf_(a0) * (acc[ai][1][m][0][j] * is); v1[j] = a1 * sigmoidf_(a1) * (acc[ai][1][m][1][j] * is); }
                *(u32x2*)(ACT + ((size_t)u.pm * 256 + rl) * EFF + col) = (u32x2){pk4_fp8(v0[0], v0[1], v0[2], v0[3]), pk4_fp8(v1[0], v1[1], v1[2], v1[3])};
                asm volatile("" ::: "memory");
            }
    }
};
struct EpiDown {
    static constexpr bool PERM = true;
    static constexpr bool BJADJ = true;
    unsigned char* YBUF; const float* GATEW;
    __device__ __forceinline__ bool keep(const pg8::Unit&) const { return false; }
    __device__ __forceinline__ void operator()(f32x4 (&acc)[2][2][4][2], const pg8::Unit& u, int wr, int wc, int fr, int fq) const {
        const int rl0 = wr * 64 + fr, colw = u.pn * 256 + wc * 64 + (fq & 1) * 32 + (fq >> 1) * 16;
        const bool odd = fq & 1;
#pragma unroll
        for (int ai = 0; ai < 2; ++ai)
#pragma unroll
            for (int m = 0; m < 4; ++m) {
                const int rl = rl0 + ai * 128 + m * 16;
                const bool ok = rl < u.nvalid;
                int slot = 0; float gw = 0.f;
                if (ok) { slot = u.rows[rl]; gw = GATEW[slot] * (YSCALE / WD_SCALE); }
                u32x2 p[2];
#pragma unroll
                for (int bj = 0; bj < 2; ++bj) { const f32x4 v0 = acc[ai][bj][m][0] * gw, v1 = acc[ai][bj][m][1] * gw;
                    p[bj] = (u32x2){pk4_fp8(v0[0], v0[1], v0[2], v0[3]), pk4_fp8(v1[0], v1[1], v1[2], v1[3])}; }
                const u32x2 snd = odd ? p[0] : p[1];
                u32x2 rcv; rcv.x = (unsigned)__shfl_xor((int)snd.x, 16); rcv.y = (unsigned)__shfl_xor((int)snd.y, 16);
                const u32x4 w = odd ? (u32x4){rcv.x, rcv.y, p[1].x, p[1].y} : (u32x4){p[0].x, p[0].y, rcv.x, rcv.y};
                if (ok) *(u32x4*)(YBUF + (size_t)slot * D + colw) = w;
                asm volatile("" ::: "memory");
            }
    }
};

#define MFMA16(a, b, c) __builtin_amdgcn_mfma_f32_16x16x32_bf16((a), (b), (c), 0, 0, 0)
#define MFMA32(a, b, c) __builtin_amdgcn_mfma_f32_32x32x16_bf16((a), (b), (c), 0, 0, 0)
__device__ __forceinline__ s16x4 tr16(const LAS unsigned char* p) { return __builtin_amdgcn_ds_read_tr16_b64_v4i16((LAS s16x4*)p); }
__device__ __forceinline__ bf16x8 cat8(s16x4 a, s16x4 b) { bf16x8 r; r[0] = a[0]; r[1] = a[1]; r[2] = a[2]; r[3] = a[3]; r[4] = b[0]; r[5] = b[1]; r[6] = b[2]; r[7] = b[3]; return r; }
__device__ __forceinline__ u32x4 pack8(const float (&v)[8]) { u32x4 w; w.x = pg8::cvt_pk_bf16(v[0], v[1]); w.y = pg8::cvt_pk_bf16(v[2], v[3]); w.z = pg8::cvt_pk_bf16(v[4], v[5]); w.w = pg8::cvt_pk_bf16(v[6], v[7]); return w; }
__device__ __forceinline__ void unpack8(u32x4 w, float (&v)[8]) { v[0] = bflo(w.x); v[1] = bfhi(w.x); v[2] = bflo(w.y); v[3] = bfhi(w.y); v[4] = bflo(w.z); v[5] = bfhi(w.z); v[6] = bflo(w.w); v[7] = bfhi(w.w); }
__device__ __forceinline__ int swzA(int row) { return (row & 3) | (((row >> 3) & 1) << 2); }
__device__ __forceinline__ void hgrn_kv_unit(Ctx& X, int bn) {
    const int t0 = bn * 64;
    const bf16_t* PROJ = WSP(bf16_t, WS_PROJ); const float* BC = WSP(float, WS_LOGF);
#pragma unroll 2
    for (int j = 0; j < 8; ++j) {
        const int p = X.tid + NTHREADS * j, row = p >> 6, c64 = p & 63, h = c64 >> 4, ch = c64 & 15;
        const size_t prow = (size_t)(t0 + row) * INW + h * 128 + 8 * ch;
        const u32x4 kraw = *(const u32x4*)(PROJ + prow + C_HK), vraw = *(const u32x4*)(PROJ + prow + C_HV);
        const float* bp = BC + (size_t)(t0 + row) * 512 + h * 128 + 8 * ch; const float* bl = BC + (size_t)(t0 + 63) * 512 + h * 128 + 8 * ch;
        const f32x4 b0 = *(const f32x4*)bp, b1 = *(const f32x4*)(bp + 4), l0 = *(const f32x4*)bl, l1 = *(const f32x4*)(bl + 4);
        float kv[8]; unpack8(kraw, kv);
#pragma unroll
        for (int e = 0; e < 4; ++e) { kv[e] *= __expf(l0[e] - b0[e]); kv[4 + e] *= __expf(l1[e] - b1[e]); }
        const int off = row * 256 + (((ch >> 1) ^ swzA(row)) * 32) + (ch & 1) * 16;
        *(LAS u32x4*)(X.lds + h * 32768 + off) = vraw; *(LAS u32x4*)(X.lds + h * 32768 + 16384 + off) = pack8(kv);
    }
    WSP(float, WS_DECAY)[bn * 512 + X.tid] = __expf(BC[(size_t)(t0 + 63) * 512 + X.tid]);
    __syncthreads();
    const int l = X.lane, w = X.wave, fr = l & 15, fq = l >> 4, r = fr >> 2, p4 = l & 3, h = w >> 1, vt0 = 4 * (w & 1);
    const LAS unsigned char* VI = X.lds + h * 32768; const LAS unsigned char* KI = VI + 16384;
    bf16x8 af[4][2];
#pragma unroll
    for (int vt = 0; vt < 4; ++vt)
#pragma unroll
        for (int kk = 0; kk < 2; ++kk) { const int r0 = 32 * kk + 8 * fq + r, r1 = r0 + 4;
            af[vt][kk] = cat8(tr16(VI + r0 * 256 + (((vt0 + vt) ^ swzA(r0)) * 32) + p4 * 8), tr16(VI + r1 * 256 + (((vt0 + vt) ^ swzA(r1)) * 32) + p4 * 8)); }
    bf16_t* KVT = WSP(bf16_t, WS_KVT) + (size_t)(bn * 4 + h) * 16384;
#pragma unroll 2
    for (int ct = 0; ct < 8; ++ct) {
        bf16x8 bfr[2];
#pragma unroll
        for (int kk = 0; kk < 2; ++kk) { const int r0 = 32 * kk + 8 * fq + r, r1 = r0 + 4;
            bfr[kk] = cat8(tr16(KI + r0 * 256 + ((ct ^ swzA(r0)) * 32) + p4 * 8), tr16(KI + r1 * 256 + ((ct ^ swzA(r1)) * 32) + p4 * 8)); }
#pragma unroll
        for (int vt = 0; vt < 4; ++vt) { f32x4 acc = {0.f, 0.f, 0.f, 0.f}; acc = MFMA16(bfr[0], af[vt][0], acc); acc = MFMA16(bfr[1], af[vt][1], acc);
            u32x2 wv; wv.x = pg8::cvt_pk_bf16(acc[0], acc[1]); wv.y = pg8::cvt_pk_bf16(acc[2], acc[3]);
            *(u32x2*)(KVT + (16 * (vt0 + vt) + fr) * 128 + 16 * ct + 4 * fq) = wv; }
    }
    __syncthreads();
}
__device__ __forceinline__ void hgrn_passB(Ctx& X) {
    const unsigned* KVT = WSP(unsigned, WS_KVT); const float* DECAY = WSP(float, WS_DECAY); unsigned* SPT = WSP(unsigned, WS_SPT);
    const int gt = X.wg * NTHREADS + X.tid, NGT = X.G * NTHREADS;
    for (int item = gt; item < 16 * 128 * 64; item += NGT) {
        const int bh = item >> 13, rem = item & 8191, vd = rem >> 6, c = (rem & 63) * 2, b = bh >> 2, h = bh & 3;
        float s0 = 0.f, s1 = 0.f;
#pragma unroll 8
        for (int n = 0; n < 64; ++n) {
            const int unit = (b * 64 + n) * 4 + h;
            const unsigned kw = KVT[((size_t)unit * 16384 + vd * 128 + c) >> 1]; const f32x2 kv = {bflo(kw), bfhi(kw)};
            const f32x2 dc = *(const f32x2*)(DECAY + unit * 128 + c);
            SPT[((size_t)unit * 16384 + vd * 128 + c) >> 1] = pk2(s0, s1);
            s0 = dc.x * s0 + kv.x; s1 = dc.y * s1 + kv.y;
        }
    }
}
__device__ __forceinline__ void hgrn_out_unit(Ctx& X, int u2) {
    const int bn = u2 >> 1, hp = u2 & 1, t0 = bn * 64;
    const bf16_t* PROJ = WSP(bf16_t, WS_PROJ); const float* BCg = WSP(float, WS_LOGF);
#pragma unroll 2
    for (int j = 0; j < 4; ++j) { const int p = X.tid + NTHREADS * j, row = p >> 5, c32 = p & 31, hh = c32 >> 4, ch = c32 & 15, h = 2 * hp + hh;
        const size_t prow = (size_t)(t0 + row) * INW + h * 128 + 8 * ch;
        const u32x4 qraw = *(const u32x4*)(PROJ + prow + C_HQ), kraw = *(const u32x4*)(PROJ + prow + C_HK), vraw = *(const u32x4*)(PROJ + prow + C_HV);
        const float* bp = BCg + (size_t)(t0 + row) * 512 + h * 128 + 8 * ch; const float* br = BCg + (size_t)(t0 + 32) * 512 + h * 128 + 8 * ch;
        const f32x4 b0 = *(const f32x4*)bp, b1 = *(const f32x4*)(bp + 4), r0 = *(const f32x4*)br, r1 = *(const f32x4*)(br + 4);
        float qv[8], kv[8], a[8], bq[8]; unpack8(qraw, qv); unpack8(kraw, kv);
#pragma unroll
        for (int e = 0; e < 4; ++e) { const float e0 = __expf(b0[e] - r0[e]), e1 = __expf(b1[e] - r1[e]);
            a[e] = qv[e] * e0; a[4 + e] = qv[4 + e] * e1; kv[e] *= __builtin_amdgcn_rcpf(e0); kv[4 + e] *= __builtin_amdgcn_rcpf(e1);
            bq[e] = qv[e] * __expf(b0[e]); bq[4 + e] = qv[4 + e] * __expf(b1[e]); }
        LAS unsigned char* hb = X.lds + hh * 65536; const int o16 = row * 256 + ((ch ^ (row & 15)) * 16);
        *(LAS u32x4*)(hb + o16) = pack8(a); *(LAS u32x4*)(hb + 16384 + o16) = pack8(kv); *(LAS u32x4*)(hb + 32768 + o16) = pack8(bq);
        *(LAS u32x4*)(hb + 49152 + row * 256 + (((ch >> 1) ^ (row & 7)) * 32) + (ch & 1) * 16) = vraw; }
    const int l = X.lane, w = X.wave, fr = l & 15, fq = l >> 4, r = fr >> 2, p4 = l & 3, hh = w >> 2, h = 2 * hp + hh, ti = w & 3;
    const int tq = 16 * ti + fr;
    const bf16_t* SPT = WSP(bf16_t, WS_SPT) + (size_t)(bn * 4 + h) * 16384;
    __syncthreads();
    const LAS unsigned char* QSI = X.lds + hh * 65536; const LAS unsigned char* KSI = QSI + 16384; const LAS unsigned char* QNI = QSI + 32768; const LAS unsigned char* VI = QSI + 49152;
    bf16x8 QS[4];
#pragma unroll
    for (int ks = 0; ks < 4; ++ks) QS[ks] = *(const LAS bf16x8*)(QSI + tq * 256 + (((4 * ks + fq) ^ (tq & 15)) * 16));
    f32x4 ST[4];
#pragma unroll
    for (int si = 0; si < 4; ++si) {
        f32x4 acc = {0.f, 0.f, 0.f, 0.f};
        if (si <= ti) {
            const int sr = 16 * si + fr;
#pragma unroll
            for (int ks = 0; ks < 4; ++ks) { const bf16x8 kf = *(const LAS bf16x8*)(KSI + sr * 256 + (((4 * ks + fq) ^ (sr & 15)) * 16)); acc = MFMA16(kf, QS[ks], acc); }
            if (si == ti) {
#pragma unroll
                for (int q = 0; q < 4; ++q) acc[q] = (4 * fq + q <= fr) ? acc[q] : 0.f; }
        }
        ST[si] = acc;
    }
    f32x4 o[8];
#pragma unroll
    for (int vt = 0; vt < 8; ++vt) o[vt] = (f32x4){0.f, 0.f, 0.f, 0.f};
#pragma unroll
    for (int kk = 0; kk < 2; ++kk) {
        if (2 * kk <= ti) {
            float pv[8];
#pragma unroll
            for (int q = 0; q < 4; ++q) { pv[q] = ST[2 * kk][q]; pv[4 + q] = ST[2 * kk + 1][q]; }
            const bf16x8 pf = __builtin_bit_cast(bf16x8, pack8(pv));
            const int r0 = 32 * kk + 4 * fq + r, r1 = r0 + 16;
#pragma unroll
            for (int vt = 0; vt < 8; ++vt) { const bf16x8 va = cat8(tr16(VI + r0 * 256 + ((vt ^ (r0 & 7)) * 32) + p4 * 8), tr16(VI + r1 * 256 + ((vt ^ (r1 & 7)) * 32) + p4 * 8));
                o[vt] = MFMA16(va, pf, o[vt]); }
        }
    }
#pragma unroll
    for (int ks = 0; ks < 4; ++ks) { const bf16x8 qn = *(const LAS bf16x8*)(QNI + tq * 256 + (((4 * ks + fq) ^ (tq & 15)) * 16));
#pragma unroll
        for (int vt = 0; vt < 8; ++vt) { const bf16x8 sa = *(const bf16x8*)(SPT + (16 * vt + fr) * 128 + 32 * ks + 8 * fq); o[vt] = MFMA16(sa, qn, o[vt]); } }
    float ss = 0.f;
#pragma unroll
    for (int vt = 0; vt < 8; ++vt) ss += (o[vt][0] * o[vt][0] + o[vt][1] * o[vt][1]) + (o[vt][2] * o[vt][2] + o[vt][3] * o[vt][3]);
    ss += __shfl_xor(ss, 16); ss += __shfl_xor(ss, 32);
    const float rstd = rsqrtf(ss * (1.f / 128.f) + EPS);
    bf16_t* YCAT = WSP(bf16_t, WS_YCAT);
#pragma unroll
    for (int vt = 0; vt < 8; ++vt) { const int vd = 16 * vt + 4 * fq;
        const u32x2 sg = *(const u32x2*)(PROJ + (size_t)(t0 + tq) * INW + C_HG + h * 128 + vd); const f32x4 gn = *(const f32x4*)(X.g_hgrn + h * 128 + vd);
        u32x2 wv; wv.x = pg8::cvt_pk_bf16(o[vt][0] * rstd * gn[0] * bflo(sg.x), o[vt][1] * rstd * gn[1] * bfhi(sg.x)); wv.y = pg8::cvt_pk_bf16(o[vt][2] * rstd * gn[2] * bflo(sg.y), o[vt][3] * rstd * gn[3] * bfhi(sg.y));
        *(u32x2*)(YCAT + (size_t)(t0 + tq) * D + h * 128 + vd) = wv; }
    __syncthreads();
}

template <bool HI> __device__ __forceinline__ unsigned fp8x2_bf16_(unsigned w) { const auto f = __builtin_amdgcn_cvt_pk_f32_fp8((int)w, HI); return pg8::cvt_pk_bf16(f[0], f[1]); }
__device__ __forceinline__ unsigned fp8x2_bf16(unsigned w, bool hi) { return hi ? fp8x2_bf16_<true>(w) : fp8x2_bf16_<false>(w); }
struct AttnRegs { u32x4 k[3], v[3]; long q[4]; };
__device__ __forceinline__ void attn_load(Ctx& X, int unit, AttnRegs& R) {
    const int u16 = unit & 15, h = (unit >> 4) & 7, g = (unit >> 7) % 3, b = unit / 384;
    const int d = g == 0 ? 1 : g == 1 ? 4 : 16, nblk = 16 / d, r = u16 / nblk, blk = u16 % nblk;
    const int vcol = C_AV + g * 512 + h * 64;
    const int mk0 = blk * 256 - 128;
    const unsigned char* QK8 = WSP(unsigned char, WS_QK8);
    const int q8col = g * 512 + h * 64, k8col = 1536 + q8col, v8col = 3072 + q8col;
#pragma unroll
    for (int j = 0; j < 3; ++j) { const int idx = X.tid + NTHREADS * j, row = idx >> 2, ch = idx & 3, m = mk0 + row > 0 ? mk0 + row : 0;
        const size_t tok = (size_t)b * SEQ + (size_t)m * d + r; R.k[j] = *(const u32x4*)(QK8 + tok * 4608 + k8col + ch * 16); R.v[j] = *(const u32x4*)(QK8 + tok * 4608 + v8col + ch * 16); }
    const int l = X.lane, w = X.wave, q = l & 31, hi = l >> 5;
    const size_t tokq = (size_t)b * SEQ + (size_t)(blk * 256 + 32 * w + q) * d + r;
#pragma unroll
    for (int ds = 0; ds < 4; ++ds) R.q[ds] = *(const long*)(QK8 + tokq * 4608 + q8col + ds * 16 + hi * 8);
}
__device__ __forceinline__ void attn_stage(Ctx& X, const AttnRegs& R) {
    LAS unsigned char* KL = X.lds; LAS unsigned char* VL = X.lds + 55296;
#pragma unroll
    for (int j = 0; j < 3; ++j) { const int idx = X.tid + NTHREADS * j, row = idx >> 2, ch = idx & 3;
        *(LAS u32x4*)(KL + row * 80 + ch * 16) = R.k[j];
        u32x4 lo, hi2;
        lo.x = fp8x2_bf16(R.v[j].x, false); lo.y = fp8x2_bf16(R.v[j].x, true); lo.z = fp8x2_bf16(R.v[j].y, false); lo.w = fp8x2_bf16(R.v[j].y, true);
        hi2.x = fp8x2_bf16(R.v[j].z, false); hi2.y = fp8x2_bf16(R.v[j].z, true); hi2.z = fp8x2_bf16(R.v[j].w, false); hi2.w = fp8x2_bf16(R.v[j].w, true);
        *(LAS u32x4*)(VL + row * 128 + ch * 32) = lo; *(LAS u32x4*)(VL + row * 128 + ch * 32 + 16) = hi2; }
    LAS long* QL = (LAS long*)(X.lds + 104448 + X.tid * 32);
    QL[0] = R.q[0]; QL[1] = R.q[1]; QL[2] = R.q[2]; QL[3] = R.q[3];
}
__device__ __forceinline__ void attn_compute(Ctx& X, int unit) {
    const int u16 = unit & 15, h = (unit >> 4) & 7, g = (unit >> 7) % 3, b = unit / 384;
    const int d = g == 0 ? 1 : g == 1 ? 4 : 16, nblk = 16 / d, r = u16 / nblk, blk = u16 % nblk;
    const int mk0 = blk * 256 - 128;
    LAS unsigned char* KL = X.lds; LAS unsigned char* VL = X.lds + 55296;
    const int l = X.lane, w = X.wave, q = l & 31, hi = l >> 5;
    const size_t tokq = (size_t)b * SEQ + (size_t)(blk * 256 + 32 * w + q) * d + r;
    long qf[4];
    { const LAS long* QL = (const LAS long*)(X.lds + 104448 + X.tid * 32); qf[0] = QL[0]; qf[1] = QL[1]; qf[2] = QL[2]; qf[3] = QL[3]; }
    f32x16 s[5];
#pragma unroll
    for (int kt = 0; kt < 5; ++kt) {
        f32x16 acc;
#pragma unroll
        for (int i = 0; i < 16; ++i) acc[i] = 0.f;
#pragma unroll
        for (int ds = 0; ds < 4; ++ds) { const long kf = *(const LAS long*)(KL + (32 * w + 32 * kt + q) * 80 + ds * 16 + hi * 8); acc = __builtin_amdgcn_mfma_f32_32x32x16_fp8_fp8(kf, qf[ds], acc, 0, 0, 0); }
        s[kt] = acc;
    }
    const int iq = 32 * w + q;
    const int jmin = iq > -mk0 ? iq : -mk0;
    const int tlo = jmin - (32 * w + 4 * hi), thi = iq + 128 - (32 * w + 128 + 4 * hi), tst = -mk0 - (32 * w + 4 * hi);
    float mx = -INFINITY;
#pragma unroll
    for (int kt = 0; kt < 5; ++kt) {
        const bool chk = kt == 0 || kt == 4 || (32 * w + 32 * kt < -mk0);
        if (chk) {
#pragma unroll
            for (int rg = 0; rg < 16; ++rg) { const int c = (rg & 3) + 8 * (rg >> 2);
                const bool valid = kt == 0 ? (c >= tlo) : kt == 4 ? (c <= thi) : (c + 32 * kt >= tst);
                s[kt][rg] = valid ? s[kt][rg] : -INFINITY; if ((rg & 3) == 3) __builtin_amdgcn_sched_barrier(0); }
        }
#pragma unroll
        for (int rg = 0; rg < 16; ++rg) mx = fmaxf(mx, s[kt][rg]);
    }
    mx = fmaxf(mx, __shfl_xor(mx, 32));
    const float c2 = 0.125f * 1.4426950408889634f, mxs = mx * c2;
    float lsum = 0.f;
#pragma unroll
    for (int kt = 0; kt < 5; ++kt)
#pragma unroll
        for (int rg = 0; rg < 16; ++rg) { const float p = __builtin_amdgcn_exp2f(__builtin_fmaf(s[kt][rg], c2, -mxs)); s[kt][rg] = p; lsum += p; }
    lsum += __shfl_xor(lsum, 32);
    f32x16 o[2];
#pragma unroll
    for (int dt = 0; dt < 2; ++dt)
#pragma unroll
        for (int i = 0; i < 16; ++i) o[dt][i] = 0.f;
    const int vlane = ((l & 15) >> 2) * 128 + (((l >> 4) & 1) * 16 + (l & 3) * 4) * 2;
#pragma unroll
    for (int kt = 0; kt < 5; ++kt)
#pragma unroll
        for (int s2 = 0; s2 < 2; ++s2) {
            bf16x8 pb;
#pragma unroll
            for (int j = 0; j < 8; j += 2) { const unsigned pw = pg8::cvt_pk_bf16(s[kt][8 * s2 + j], s[kt][8 * s2 + j + 1]); pb[j] = (short)(pw & 0xffffu); pb[j + 1] = (short)(pw >> 16); }
            const int key0 = 32 * w + 32 * kt + 16 * s2 + 4 * hi;
#pragma unroll
            for (int dt = 0; dt < 2; ++dt) {
                LAS unsigned char* vp = VL + key0 * 128 + dt * 64 + vlane;
                const s16x4 t0 = __builtin_amdgcn_ds_read_tr16_b64_v4i16((LAS s16x4*)vp);
                const s16x4 t1 = __builtin_amdgcn_ds_read_tr16_b64_v4i16((LAS s16x4*)(vp + 8 * 128));
                bf16x8 va; va[0] = t0[0]; va[1] = t0[1]; va[2] = t0[2]; va[3] = t0[3]; va[4] = t1[0]; va[5] = t1[1]; va[6] = t1[2]; va[7] = t1[3];
                o[dt] = MFMA32(va, pb, o[dt]);
            }
        }
    const float inv = 1.0f / lsum;
    bf16_t* OG = WSP(bf16_t, WS_OG) + (size_t)g * T * 512;
#pragma unroll
    for (int dt = 0; dt < 2; ++dt)
#pragma unroll
        for (int rg = 0; rg < 4; ++rg) { const int d0 = 32 * dt + 8 * rg + 4 * hi;
            u32x2 wv; wv.x = pg8::cvt_pk_bf16(o[dt][4 * rg] * inv, o[dt][4 * rg + 1] * inv); wv.y = pg8::cvt_pk_bf16(o[dt][4 * rg + 2] * inv, o[dt][4 * rg + 3] * inv);
            *(u32x2*)(OG + tokq * 512 + h * 64 + d0) = wv; }
    WSP(float, WS_LSE)[((size_t)g * T + tokq) * 8 + h] = mx * 0.125f + __logf(lsum);
}
__device__ __forceinline__ void attn_combine(Ctx& X) {
    const bf16_t* OG = WSP(bf16_t, WS_OG); const float* LSE = WSP(float, WS_LSE); bf16_t* YCAT = WSP(bf16_t, WS_YCAT);
    const int gt = X.wg * NTHREADS + X.tid, NGT = X.G * NTHREADS;
    for (int item = gt; item < T * 64; item += NGT) {
        const int t = item >> 6, ch = item & 63, h = ch >> 3;
        const float l0 = LSE[(size_t)t * 8 + h], l1 = LSE[((size_t)T + t) * 8 + h], l2 = LSE[((size_t)2 * T + t) * 8 + h];
        const float m = fmaxf(l0, fmaxf(l1, l2)); float w0 = __expf(l0 - m), w1 = __expf(l1 - m), w2 = __expf(l2 - m); const float inv = 1.f / (w0 + w1 + w2); w0 *= inv; w1 *= inv; w2 *= inv;
        const u32x4 a = *(const u32x4*)(OG + (size_t)t * 512 + ch * 8), bq = *(const u32x4*)(OG + ((size_t)T + t) * 512 + ch * 8), cq = *(const u32x4*)(OG + ((size_t)2 * T + t) * 512 + ch * 8);
        u32x4 o;
#pragma unroll
        for (int j = 0; j < 4; ++j) o[j] = pk2(w0 * bflo(a[j]) + w1 * bflo(bq[j]) + w2 * bflo(cq[j]), w0 * bfhi(a[j]) + w1 * bfhi(bq[j]) + w2 * bfhi(cq[j]));
        *(u32x4*)(YCAT + (size_t)t * D + 512 + ch * 8) = o;
    }
}

__device__ __forceinline__ unsigned sortable_key(float f) { const unsigned u = __builtin_bit_cast(unsigned, f); return (u & 0x80000000u) ? ~u : (u | 0x80000000u); }
__device__ __forceinline__ void moe_route(Ctx& X, bool local) {
    const float* LG = WSP(float, WS_KVT); unsigned* CNT = WSP(unsigned, WS_CTL) + CW_CNT; int* LISTS = WSP(int, WS_LISTS); float* GATEW = WSP(float, WS_GATEW);
    const int gw = X.wg * NWAVES + X.wave, NGW = X.G * NWAVES, l = X.lane, grp = l >> 3;
    const f32x4 bias = *(const f32x4*)(X.rbias + 4 * l);
    const unsigned long long ltmask = (1ull << l) - 1ull;
    const int tbeg = local ? X.wg * 64 + X.wave : gw, tend = local ? X.wg * 64 + 64 : T, tstep = local ? NWAVES : NGW;
    for (int t = tbeg; t < tend; t += tstep) {
        f32x4 lg = *(const f32x4*)(LG + (size_t)t * 256 + 4 * l);
#pragma unroll
        for (int ks = 1; ks < 4; ++ks) lg += *(const f32x4*)(LG + ((size_t)ks * T + t) * 256 + 4 * l);
        float sc[4], mb[4];
#pragma unroll
        for (int i = 0; i < 4; ++i) { sc[i] = sigmoidf_(lg[i]); mb[i] = sc[i] + bias[i]; }
        float m1 = fmaxf(mb[0], mb[1]), m2 = fminf(mb[0], mb[1]);
        { const float a1 = fmaxf(mb[2], mb[3]), a2 = fminf(mb[2], mb[3]); const float n1 = fmaxf(m1, a1), n2 = fmaxf(fminf(m1, a1), fmaxf(m2, a2)); m1 = n1; m2 = n2; }
#pragma unroll
        for (int o = 1; o < 8; o <<= 1) { const float a1 = __shfl_xor(m1, o), a2 = __shfl_xor(m2, o); const float n1 = fmaxf(m1, a1), n2 = fmaxf(fminf(m1, a1), fmaxf(m2, a2)); m1 = n1; m2 = n2; }
        const float gs = m1 + m2;
        int rank = 0;
#pragma unroll
        for (int gg = 0; gg < 8; ++gg) { const float og = __builtin_bit_cast(float, __builtin_amdgcn_readlane(__builtin_bit_cast(int, gs), gg * 8)); rank += (og > gs || (og == gs && gg < grp)) ? 1 : 0; }
        const bool sel = rank < 4;
        unsigned key[4];
#pragma unroll
        for (int i = 0; i < 4; ++i) key[i] = sel ? sortable_key(mb[i]) : 0u;
        unsigned pre = 0u;
#pragma unroll 1
        for (int bit = 31; bit >= 0; --bit) { const unsigned cand = pre | (1u << bit);
            const int cnt = __popcll(__ballot(key[0] >= cand)) + __popcll(__ballot(key[1] >= cand)) + __popcll(__ballot(key[2] >= cand)) + __popcll(__ballot(key[3] >= cand));
            if (cnt >= TOPK) pre = cand; }
        int ngt = 0, eqb = 0, tkb = 0; bool take[4];
#pragma unroll
        for (int i = 0; i < 4; ++i) ngt += __popcll(__ballot(key[i] > pre));
        const int need = TOPK - ngt;
#pragma unroll
        for (int i = 0; i < 4; ++i) eqb += __popcll(__ballot(key[i] == pre) & ltmask);
        int eqrun = eqb;
#pragma unroll
        for (int i = 0; i < 4; ++i) { const bool eq = key[i] == pre; take[i] = (key[i] > pre) || (eq && eqrun < need); eqrun += eq ? 1 : 0; }
#pragma unroll
        for (int i = 0; i < 4; ++i) tkb += __popcll(__ballot(take[i]) & ltmask);
        float part = 0.f;
#pragma unroll
        for (int i = 0; i < 4; ++i) part += take[i] ? sc[i] : 0.f;
        const float scale = 2.5f / wave_sum(part);
        int slot = tkb;
#pragma unroll
        for (int i = 0; i < 4; ++i) if (take[i]) { const int e = 4 * l + i; const unsigned pos = atomicAdd(&CNT[e * 64], 1u); LISTS[(size_t)e * 16384 + pos] = t * NSLOT + slot; GATEW[t * NSLOT + slot] = sc[i] * scale; ++slot; }
        if (l == 0) { LISTS[(size_t)NE * 16384 + t] = t * NSLOT + TOPK; GATEW[t * NSLOT + TOPK] = 1.0f; }
    }
}
__device__ __forceinline__ int moe_table(Ctx& X) {
    LAS int* tbl = (LAS int*)(X.lds + TBL_OFF); LAS int* cnts = (LAS int*)(X.lds + TCNT_OFF); LAS int* pref = cnts + 320;
    const unsigned* CNT = WSP(unsigned, WS_CTL) + CW_CNT;
    const int x = X.wg & 7;
    if (X.tid < NEX) cnts[X.tid] = X.tid < NE ? (int)__hip_atomic_load(CNT + X.tid * 64, __ATOMIC_RELAXED, __HIP_MEMORY_SCOPE_AGENT) : T;
    __syncthreads();
    if (X.tid < NEX) { int pre = 0; for (int e = 0; e < X.tid; ++e) pre += (cnts[e] + 255) >> 8; pref[X.tid] = pre; }
    __syncthreads();
    if (X.tid < 33) {
        const int i = X.tid; int lp = 0; for (int k = 0; k < i && k < 32; ++k) lp += (cnts[x + 8 * k] + 255) >> 8;
        if (i < 32) { const int e = x + 8 * i, n = (cnts[e] + 255) >> 8, p0 = pref[e]; for (int r = 0; r < n; ++r) tbl[lp + r] = ((p0 + r) << 16) | (e << 7) | r; }
        else { const int p0 = pref[NE]; for (int r8 = 0; r8 < 8; ++r8) { const int r = 8 * x + r8; tbl[lp + r8] = ((p0 + r) << 16) | (NE << 7) | r; } cnts[600] = lp + 8; }
    }
    __syncthreads();
    return __builtin_amdgcn_readfirstlane(cnts[600]);
}
__device__ __forceinline__ void final_rows(Ctx& X) {
    const bf16_t* X1 = WSP(bf16_t, WS_X1); const float* MOD = WSP(float, WS_MOD); const unsigned char* YBUF = WSP(unsigned char, WS_YBUF);
    const int gw = X.wg * NWAVES + X.wave, NGW = X.G * NWAVES, l = X.lane;
    for (int t = gw; t < T; t += NGW) {
        const int b = t / SEQ; f32x4 v[2][2]; float s = 0.f;
#pragma unroll
        for (int j = 0; j < 2; ++j) { const int col = 8 * l + 512 * j; f32x4 m0 = {0.f, 0.f, 0.f, 0.f}, m1 = {0.f, 0.f, 0.f, 0.f};
#pragma unroll
            for (int k = 0; k < NSLOT; ++k) { const u32x2 y = *(const u32x2*)(YBUF + ((size_t)t * NSLOT + k) * D + col);
                const f32x2 a = __builtin_amdgcn_cvt_pk_f32_fp8((int)y.x, false), bq = __builtin_amdgcn_cvt_pk_f32_fp8((int)y.x, true), c = __builtin_amdgcn_cvt_pk_f32_fp8((int)y.y, false), d = __builtin_amdgcn_cvt_pk_f32_fp8((int)y.y, true);
                m0.x += a[0]; m0.y += a[1]; m0.z += bq[0]; m0.w += bq[1]; m1.x += c[0]; m1.y += c[1]; m1.z += d[0]; m1.w += d[1]; }
            const f32x4 g0 = *(const f32x4*)(MOD + b * 6144 + 5120 + col) * (1.0f / YSCALE), g1 = *(const f32x4*)(MOD + b * 6144 + 5120 + col + 4) * (1.0f / YSCALE);
            const u32x4 xw = *(const u32x4*)(X1 + (size_t)t * D + col); const f32x4 x0 = {bflo(xw.x), bfhi(xw.x), bflo(xw.y), bfhi(xw.y)}, x1 = {bflo(xw.z), bfhi(xw.z), bflo(xw.w), bfhi(xw.w)};
            v[j][0] = x0 + g0 * m0; v[j][1] = x1 + g1 * m1;
#pragma unroll
            for (int q = 0; q < 2; ++q) s += (v[j][q].x * v[j][q].x + v[j][q].y * v[j][q].y) + (v[j][q].z * v[j][q].z + v[j][q].w * v[j][q].w); }
        const float rstd = rsqrtf(wave_sum(s) * (1.f / D) + EPS);
#pragma unroll
        for (int j = 0; j < 2; ++j) { const int col = 8 * l + 512 * j;
            *(f32x4*)(X.out + (size_t)t * D + col) = v[j][0] * rstd * *(const f32x4*)(X.g_final + col); *(f32x4*)(X.out + (size_t)t * D + col + 4) = v[j][1] * rstd * *(const f32x4*)(X.g_final + col + 4); }
    }
}

__device__ __forceinline__ unsigned* panel_word(Ctx& X, int bank, int pm) { return WSP(unsigned, WS_CTL) + CW_PANEL + (bank * 64 + pm) * 64; }
__device__ __forceinline__ void panel_signal(Ctx& X, int bank, int pm) {
    asm volatile("s_waitcnt vmcnt(0)" ::: "memory"); __syncthreads();
    if (X.tid == 0) (void)xb_add(panel_word(X, bank, pm), 1u);
}
__device__ __forceinline__ void panel_wait(Ctx& X, int bank, int pm, unsigned target) {
    if (X.tid == 0) { unsigned* p = panel_word(X, bank, pm); unsigned sp = 0u;
        while (xb_ld(p) < target) { __builtin_amdgcn_s_sleep(2); if (++sp > (1u << 22)) break; }
        __builtin_amdgcn_fence(__ATOMIC_ACQUIRE, "agent"); asm volatile("s_waitcnt vmcnt(0)" ::: "memory"); }
    __syncthreads();
}

constexpr int NG_INPROJ = 176;
__device__ __forceinline__ void ph_inproj(Ctx& X) {
    const int ng = X.G > NG_INPROJ + 8 ? NG_INPROJ : X.G;
    if (X.wg < ng) {
        RegSched S{(const char*)WSP(bf16_t, WS_H), (const char*)WSP(bf16_t, WS_WIN), (size_t)256 * 2048, (size_t)256 * 2048, T / 256, INW / 256, ng, X.wg};
        EpiInproj E{WSP(bf16_t, WS_PROJ), WSP(float, WS_LOGF), WSP(float, WS_LB), WSP(float, WS_ROPE), WSP(unsigned char, WS_G8), WSP(unsigned char, WS_QK8)};
        pg8::gemm_phase<EpiInproj, RegSched, true, false>(X.lds, 1024, 1024, 1024, S, E);
    }
    if (ng == X.G) expert_convert(X, X.wg, X.G);
    else if (X.wg >= ng) expert_convert(X, X.wg - ng, X.G - ng);
}
__device__ __forceinline__ void ph_mix_a(Ctx& X) {
    for (int it = X.wg; it < 256; it += X.G) hgrn_kv_unit(X, it);
    AttnRegs Ra, Rb; int unit = X.wg;
    auto clampu = [](int u) { return u < 1536 ? u : 1535; };
    attn_load(X, clampu(unit), Ra);
    __builtin_amdgcn_sched_barrier(0);
    attn_load(X, clampu(unit + X.G), Rb);
    __builtin_amdgcn_sched_barrier(0);
#define ATTN_STEP(R_) do { attn_stage(X, R_); __syncthreads(); __builtin_amdgcn_sched_barrier(0); attn_load(X, clampu(unit + 2 * X.G), R_); __builtin_amdgcn_sched_barrier(0); \
        attn_compute(X, unit); __syncthreads(); unit += X.G; } while (0)
    if (unit < 1536) {
        ATTN_STEP(Ra);
        while (unit < 1536) {
            ATTN_STEP(Rb);
            if (unit >= 1536) break;
            ATTN_STEP(Ra);
        }
    }
#undef ATTN_STEP
}
__device__ __forceinline__ void ph_mix_c(Ctx& X) { for (int it = X.wg; it < 512; it += X.G) hgrn_out_unit(X, it); attn_combine(X); }
__device__ __forceinline__ void ph_mixed(Ctx& X, bool chain) {
    TwoPartSched S{(const char*)WSP(bf16_t, WS_YCAT), (const char*)WSP(bf16_t, WS_WPA), (const char*)WSP(bf16_t, WS_WPB), T / 256, D / 256, X.G, X.wg};
    EpiMixed E{WSP(unsigned char, WS_G8), WSP(bf16_t, WS_MIXED)};
    pg8::gemm_phase<EpiMixed, TwoPartSched, false, false>(X.lds, 1024, 512, 512, S, E);
    if (chain) { int pm, pn; pg8::swz_tile(X.wg, T / 256, D / 256, pm, pn); panel_signal(X, 0, pm); }
}
__device__ __forceinline__ void ph_outproj(Ctx& X, bool chain) {
    int pm = 0, pn = 0; pg8::swz_tile(X.wg < 256 ? X.wg : 0, T / 256, D / 256, pm, pn);
    RegSched S{(const char*)WSP(bf16_t, WS_MIXED), (const char*)WSP(bf16_t, WS_WOUT), (size_t)256 * 2048, (size_t)256 * 2048, T / 256, D / 256, X.G, X.wg};
    if (chain) {
        panel_wait(X, 0, pm, 4u);
        EpiOutNorm E{X.x, WSP(float, WS_MOD), X.g2, WSP(bf16_t, WS_X1), WSP(bf16_t, WS_H), WSP(unsigned char, WS_H8), WSP(float, WS_XB), panel_word(X, 1, 0), X.lds + 139264};
        pg8::gemm_phase<EpiOutNorm, RegSched, true, false>(X.lds, 1024, 1024, 1024, S, E);
        panel_signal(X, 2, pm);
    } else {
        EpiOutproj E{X.x, WSP(float, WS_MOD), WSP(bf16_t, WS_X1)};
        pg8::gemm_phase<EpiOutproj, RegSched, false, false>(X.lds, 1024, 1024, 1024, S, E);
    }
}
__device__ __forceinline__ void ph_norm2(Ctx& X, bool chain) { if (!chain) norm_rows(X, 1); }
__device__ __forceinline__ void ph_router(Ctx& X, bool chain) {
    if (chain) panel_wait(X, 2, X.wg >> 2, 4u);
    RouterSched S{(const char*)WSP(bf16_t, WS_H), (const char*)WSP(bf16_t, WS_WR), X.G, X.wg};
    EpiRouter E{WSP(float, WS_KVT)};
    pg8::gemm_phase<EpiRouter, RouterSched, false, false>(X.lds, 1024, 1024, 256, S, E);
    if (chain) panel_signal(X, 3, X.wg >> 2);
}
__device__ __forceinline__ void ph_route(Ctx& X, bool chain) {
    if (chain) panel_wait(X, 3, X.wg >> 2, 4u);
    moe_route(X, chain);
}
__device__ __forceinline__ void ph_gu(Ctx& X) {
    const int nent = moe_table(X);
    MoeSched S{(const LAS int*)(X.lds + TBL_OFF), (const LAS int*)(X.lds + TCNT_OFF), nent, (const char*)WSP(unsigned char, WS_H8), (const char*)WSP(unsigned char, WS_WGU), WSP(int, WS_LISTS), 2, 256 * 1024, 512 * 1024, 0, X.G, X.wg};
    EpiGU E{WSP(unsigned char, WS_ACT)};
    pg8::gemm_phase<EpiGU, MoeSched, true, true, true>(X.lds, 512, 512, 512, S, E);
}
__device__ __forceinline__ void ph_down(Ctx& X) {
    const int nent = moe_table(X);
    MoeSched S{(const LAS int*)(X.lds + TBL_OFF), (const LAS int*)(X.lds + TCNT_OFF), nent, (const char*)WSP(unsigned char, WS_ACT), (const char*)WSP(unsigned char, WS_WD), WSP(int, WS_LISTS), 4, 256 * 256, 1024 * 256, 256 * 256, X.G, X.wg};
    EpiDown E{WSP(unsigned char, WS_YBUF), WSP(float, WS_GATEW)};
    pg8::gemm_phase<EpiDown, MoeSched, true, false, true>(X.lds, 128, 128, 128, S, E);
}

constexpr int NPHASE = 14;
struct Args { const void* in[20]; float* out; unsigned char* ws; int ph_lo, ph_hi; };
__global__ void __launch_bounds__(NTHREADS, 2) mega_fwd(Args args) {
    extern __shared__ __attribute__((aligned(16))) unsigned char lds_raw[];
    Ctx X;
    X.lds = (LAS unsigned char*)lds_raw;
    X.tid = threadIdx.x; X.lane = X.tid & 63; X.wave = __builtin_amdgcn_readfirstlane(X.tid >> 6); X.wg = blockIdx.x; X.G = gridDim.x;
    X.x = (const float*)args.in[0]; X.c = (const float*)args.in[1]; X.positions = (const int*)args.in[2]; X.w_ada = (const float*)args.in[3]; X.b_ada = (const float*)args.in[4];
    X.g1 = (const float*)args.in[5]; X.w_in = (const float*)args.in[6]; X.lb_logits = (const float*)args.in[7]; X.g_hgrn = (const float*)args.in[8]; X.w_pa = (const float*)args.in[9];
    X.w_pb = (const float*)args.in[10]; X.w_out = (const float*)args.in[11]; X.g2 = (const float*)args.in[12]; X.w_router = (const float*)args.in[13]; X.rbias = (const float*)args.in[14];
    X.w_egu = (const float*)args.in[15]; X.w_edown = (const float*)args.in[16]; X.w_sgu = (const float*)args.in[17]; X.w_sdown = (const float*)args.in[18]; X.g_final = (const float*)args.in[19];
    X.out = args.out; X.ws = args.ws;
    volatile LAS unsigned* MISC = (volatile LAS unsigned*)(X.lds + MISC_OFF);
    if (X.tid < 32) MISC[X.tid] = 0u;
    __syncthreads();
    const int lo = args.ph_lo, hi = args.ph_hi;
    XcdBarrier bar; bar.bar = WSP(unsigned, WS_CTL) + CW_BAR; bar.x = 0; bar.st = nullptr;
    if (hi - lo > 1) bar = xcd_barrier_post(WSP(unsigned, WS_CTL) + CW_BAR, MISC + 8);
#ifndef PH_MASK
#define PH_MASK 0xffffffffu
#endif
#define IN(k) ((((PH_MASK) >> (k)) & 1u) && lo <= (k) && (k) < hi)
#ifndef REPEAT_MASK
#define REPEAT_MASK 0u
#endif
#define SEAM(k) do { if (IN(k) && IN((k) + 1)) xcd_barrier(bar); } while (0)
#define RUN(k, call) do { if (IN(k)) { call; if (((REPEAT_MASK) >> (k)) & 1u) { xcd_barrier(bar); call; } } } while (0)

    const bool p01 = IN(0) && IN(1);
    RUN(0, p0_prologue(X));
    if (p01) { asm volatile("s_waitcnt vmcnt(0)" ::: "memory"); __syncthreads(); if (X.tid == 0) (void)xb_add(WSP(unsigned, WS_CTL) + CW_P0 + 64 * (X.wg & 7), 1u); }
    if (IN(1)) {
        small_transposes(X);
        if (p01) {
            if (X.tid == 0) { unsigned* p = WSP(unsigned, WS_CTL) + CW_P0; unsigned sp = 0u;
                for (;;) { unsigned sum = 0u;
#pragma unroll
                    for (int j = 0; j < 8; ++j) sum += xb_ld(p + 64 * j);
                    if (sum >= (unsigned)X.G) break;
                    __builtin_amdgcn_s_sleep(2); if (++sp > (1u << 22)) break; }
                __builtin_amdgcn_fence(__ATOMIC_ACQUIRE, "agent"); asm volatile("s_waitcnt vmcnt(0)" ::: "memory"); }
            __syncthreads();
        }
        norm_rows(X, 0);
    }
    SEAM(1);
    RUN(2, ph_inproj(X)); SEAM(2);
    RUN(3, ph_mix_a(X)); SEAM(3);
    RUN(4, hgrn_passB(X)); SEAM(4);
    RUN(5, ph_mix_c(X)); SEAM(5);
    const bool chain = (X.G == 256);
    RUN(6, ph_mixed(X, chain)); if (!chain) SEAM(6);
    RUN(7, ph_outproj(X, chain)); if (!chain) SEAM(7);
    RUN(8, ph_norm2(X, chain)); if (!chain) SEAM(8);
    RUN(9, ph_router(X, chain)); if (!chain) SEAM(9);
    RUN(10, ph_route(X, chain)); SEAM(10);
    RUN(11, ph_gu(X)); SEAM(11);
    RUN(12, ph_down(X)); SEAM(12);
    RUN(13, final_rows(X));
#undef IN
#undef SEAM
}

extern "C" void kernel_launch(void* const* d_in, const int* in_sizes, int n_in, void* d_out, int out_size, void* d_ws, size_t ws_size, hipStream_t stream) {
    static int grid = 0;
    if (grid == 0) {
        if (n_in != 20 || out_size != T * D || ws_size < WS_END) { fprintf(stderr, "kernel_launch: unexpected shapes (n_in %d, out %d, ws %zu); nothing launched\n", n_in, out_size, ws_size); grid = -1; return; }
        int dev = 0, cus = 0, per_cu = 0;
        if (hipGetDevice(&dev) != hipSuccess || hipDeviceGetAttribute(&cus, hipDeviceAttributeMultiprocessorCount, dev) != hipSuccess) { grid = -1; return; }
        if (hipFuncSetAttribute((const void*)mega_fwd, hipFuncAttributeMaxDynamicSharedMemorySize, LDS_BYTES) != hipSuccess) { fprintf(stderr, "kernel_launch: hipFuncSetAttribute failed\n"); grid = -1; return; }
        if (hipOccupancyMaxActiveBlocksPerMultiprocessor(&per_cu, (const void*)mega_fwd, NTHREADS, LDS_BYTES) != hipSuccess || per_cu < 1) { fprintf(stderr, "kernel_launch: occupancy query says %d blocks/CU; nothing launched\n", per_cu); (void)hipGetLastError(); grid = -1; return; }
        grid = cus;
        if (T % grid != 0 || 24576 % grid != 0 || grid % 8 != 0) { fprintf(stderr, "kernel_launch: grid %d does not divide the row count; nothing launched\n", grid); grid = -1; return; }
    }
    if (grid < 0) return;
    (void)hipMemsetAsync((char*)d_ws + WS_CTL, 0, CTL_ZERO_BYTES, stream);
    Args a{};
    for (int i = 0; i < 20; ++i) a.in[i] = d_in[i];
    a.out = (float*)d_out; a.ws = (unsigned char*)d_ws;
#if MK_PER_PHASE
    for (int p = 0; p < NPHASE; ++p) { a.ph_lo = p; a.ph_hi = p + 1; hipLaunchKernelGGL(mega_fwd, dim3(grid), dim3(NTHREADS), LDS_BYTES, stream, a); }
#else
    a.ph_lo = 0; a.ph_hi = NPHASE;
    hipLaunchKernelGGL(mega_fwd, dim3(grid), dim3(NTHREADS), LDS_BYTES, stream, a);
#endif
}
```

```cpp
#include <hip/hip_runtime.h>
#include <cstdio>
#include <cstdint>

#ifndef MK_PER_PHASE
#define MK_PER_PHASE 0
#endif

#define GAS __attribute__((address_space(1)))
#define LAS __attribute__((address_space(3)))
typedef unsigned short bf16_t;
typedef short bf16x8 __attribute__((ext_vector_type(8)));
typedef short s16x4 __attribute__((ext_vector_type(4)));
typedef float f32x4 __attribute__((ext_vector_type(4)));
typedef float f32x2 __attribute__((ext_vector_type(2)));
typedef float f32x16 __attribute__((ext_vector_type(16)));
typedef unsigned u32x4 __attribute__((ext_vector_type(4)));
typedef unsigned u32x2 __attribute__((ext_vector_type(2)));
typedef long l64x2 __attribute__((ext_vector_type(2)));

constexpr int NB = 4, SEQ = 4096, T = NB * SEQ, D = 1024, INW = 8704;
constexpr int C_HQ = 0, C_HK = 512, C_HV = 1024, C_HG = 1536, C_AQ = 2048, C_AK = 3584, C_AV = 5120, C_GA = 6656, C_GB = 7680;
constexpr int NE = 256, NEX = 257, TOPK = 8, NSLOT = 9, EFF = 256;
constexpr float EPS = 1e-6f;
constexpr float WGU_SCALE = 64.0f, WD_SCALE = 32.0f;
constexpr float YSCALE = 16.0f;
constexpr int NWAVES = 8, NTHREADS = 512;

constexpr size_t MiB = 1u << 20;
constexpr size_t WS_CTL = 0, CTL_ZERO_BYTES = 1 * MiB;
constexpr size_t WS_MODP = 2 * MiB;
constexpr size_t WS_MOD = 4 * MiB;
constexpr size_t WS_LB = 4 * MiB + 128 * 1024;
constexpr size_t WS_XB = 4 * MiB + 256 * 1024;
constexpr size_t WS_ROPE = 5 * MiB;
constexpr size_t WS_DECAY = 6 * MiB;
constexpr size_t WS_GATEW = 7 * MiB;
constexpr size_t WS_LISTS = 16 * MiB;
constexpr size_t WS_WIN = 34 * MiB;
constexpr size_t WS_WPA = 51 * MiB, WS_WPB = 52 * MiB, WS_WOUT = 53 * MiB, WS_WR = 55 * MiB;
constexpr size_t WS_H = 56 * MiB;
constexpr size_t WS_LOGF = 88 * MiB;
constexpr size_t WS_H8 = 120 * MiB;
constexpr size_t WS_MIXED = 136 * MiB;
constexpr size_t WS_YCAT = 168 * MiB;
constexpr size_t WS_X1 = 200 * MiB;
constexpr size_t WS_G8 = 232 * MiB;
constexpr size_t WS_OG = 264 * MiB;
constexpr size_t WS_LSE = 312 * MiB;
constexpr size_t WS_KVT = 314 * MiB;
constexpr size_t WS_SPT = 378 * MiB;
constexpr size_t WS_PROJ = 410 * MiB;
constexpr size_t WS_WGU = 682 * MiB;
constexpr size_t WS_QK8 = 820 * MiB;
constexpr size_t WS_WD = 939 * MiB;
constexpr size_t WS_ACT = 1068 * MiB;
constexpr size_t WS_YBUF = 1172 * MiB;
constexpr size_t WS_END = 1460 * MiB;
constexpr int CW_P0 = 2048;
constexpr int CW_BAR = 4096;
constexpr int CW_PANEL = 65536;
constexpr int CW_CNT = 16384;

constexpr int RING_BYTES = 131072;
constexpr int TBL_OFF = RING_BYTES;
constexpr int TCNT_OFF = TBL_OFF + 4096;
constexpr int MISC_OFF = TCNT_OFF + 2560;
constexpr int LDS_BYTES = 147456;

#define LDS_WAIT() asm volatile("s_waitcnt lgkmcnt(0)" ::: "memory")
#define VM_WAIT() asm volatile("s_waitcnt vmcnt(0)" ::: "memory")
__device__ __forceinline__ unsigned f2bf(float f) { unsigned u = __builtin_bit_cast(unsigned, f); return (u + 0x7fffu + ((u >> 16) & 1u)) >> 16; }
__device__ __forceinline__ float bf2f(unsigned b) { return __builtin_bit_cast(float, b << 16); }
__device__ __forceinline__ unsigned pk2(float lo, float hi) { return f2bf(lo) | (f2bf(hi) << 16); }
__device__ __forceinline__ float bflo(unsigned w) { return __builtin_bit_cast(float, w << 16); }
__device__ __forceinline__ float bfhi(unsigned w) { return __builtin_bit_cast(float, w & 0xffff0000u); }
__device__ __forceinline__ float fast_logf(float x) { return __builtin_amdgcn_logf(x) * 0.6931471805599453f; }
__device__ __forceinline__ float sigmoidf_(float x) { return __builtin_amdgcn_rcpf(1.0f + __expf(-x)); }
__device__ __forceinline__ float wave_sum(float v) {
#pragma unroll
    for (int o = 1; o < 64; o <<= 1) v += __shfl_xor(v, o);
    return v;
}

__device__ __forceinline__ float clamp_e4m3(float x) { return __builtin_amdgcn_fmed3f(x, -448.0f, 448.0f); }
__device__ __forceinline__ unsigned pk4_fp8(float a, float b, float c, float d) { int w = 0; w = __builtin_amdgcn_cvt_pk_fp8_f32(clamp_e4m3(a), clamp_e4m3(b), w, false); w = __builtin_amdgcn_cvt_pk_fp8_f32(clamp_e4m3(c), clamp_e4m3(d), w, true); return (unsigned)w; }
__device__ __forceinline__ void st_wt8(void* p, unsigned long long v) { __hip_atomic_store((unsigned long long*)p, v, __ATOMIC_RELAXED, __HIP_MEMORY_SCOPE_AGENT); }
__device__ __forceinline__ void st_wt16(void* p, u32x4 v) { asm volatile("global_store_dwordx4 %0, %1, off sc1\n\ts_nop 1" :: "v"(p), "v"(v) : "memory"); }
__device__ __forceinline__ void st_wt4(void* p, unsigned v) { __hip_atomic_store((unsigned*)p, v, __ATOMIC_RELAXED, __HIP_MEMORY_SCOPE_AGENT); }
namespace pg8 {
constexpr int BM = 256, BK = 64, HALF = 128, HTB = HALF * BK * 2, STAGE_BYTES = 8 * HTB, NXCD = 8, WGM = 8;
__host__ __device__ __forceinline__ int lds_byte(int r, int c) { const int st = (r >> 4) * 2 + (c >> 5), rr = r & 15, cc = c & 31, ob = rr * 64 + cc * 2; return st * 1024 + (ob ^ (((ob >> 9) & 1) << 5)); }
__host__ __device__ __forceinline__ void stage_rc(int b, int& R, int& C) { const int st = b / 1024, sb = b % 1024, swz = sb ^ (((sb >> 9) & 1) << 5); R = (st >> 1) * 16 + swz / 64; C = (st & 1) * 32 + (swz % 64) / 2; }
__host__ __device__ __forceinline__ int perm32(int rho) { const int n = rho >> 4, i = rho & 15; return 8 * (i >> 2) + 4 * n + (i & 3); }

struct Unit { const char* a; const char* b; const int* rows; int pm, pn, aux, nvalid; };

__device__ __forceinline__ void swz_tile(int L, int nM, int nN, int& pm, int& pn) {
    const int nwg = nM * nN; int wgid = L;
    { const int q = nwg / NXCD, r = nwg % NXCD, xcd = wgid % NXCD, off = wgid / NXCD; wgid = (xcd < r ? xcd * (q + 1) : r * (q + 1) + (xcd - r) * q) + off; }
    const int nig = WGM * nN, gid = wgid / nig, fm = gid * WGM, gsz = (nM - fm) < WGM ? (nM - fm) : WGM;
    pm = fm + ((wgid % nig) % gsz); pn = (wgid % nig) / gsz;
}

__device__ __forceinline__ unsigned cvt_pk_bf16(float lo, float hi) { unsigned r; asm volatile("v_cvt_pk_bf16_f32 %0, %1, %2" : "=v"(r) : "v"(lo), "v"(hi)); return r; }

template <bool GATHER>
__device__ __forceinline__ void gather_offs(const Unit& u, int tid, int lda, unsigned (&v)[2][2]) {
    if constexpr (GATHER) {
#pragma unroll
        for (int i = 0; i < 2; ++i) { int R, C; stage_rc(tid * 16 + i * 8192, R, C);
#pragma unroll
            for (int hh = 0; hh < 2; ++hh) { const int ri = hh * HALF + R; int slot = 0; if (ri < u.nvalid) slot = u.rows[ri];
                const unsigned tok = (unsigned)slot / 9u; v[hh][i] = (tok * (unsigned)lda + (unsigned)C) * 2u; } }
    }
}

template <class E, class = void> struct epi_bjadj { static constexpr bool v = false; };
template <class E> struct epi_bjadj<E, decltype((void)E::BJADJ)> { static constexpr bool v = E::BJADJ; };
template <class Epi, class Sched, bool ALIGN_EPI, bool GATHER, bool FP8 = false>
__device__ __forceinline__ void gemm_phase(LAS unsigned char* lds, const int lda, const int ldb, const int K, const Sched& S, const Epi& E) {
    const int tid = threadIdx.x, wid = __builtin_amdgcn_readfirstlane(tid >> 6), lane = tid & 63, wr = wid >> 2, wc = wid & 3, fr = lane & 15, fq = lane >> 4;
    const int nt = K / BK;
    unsigned voffA[2], voffB[2];
#pragma unroll
    for (int i = 0; i < 2; ++i) { int R, C; stage_rc(tid * 16 + i * 8192, R, C); const int Rb = Epi::PERM ? ((R & ~31) + perm32(R & 31)) : R;
        const int Rg = epi_bjadj<Epi>::v ? ((Rb >> 5) * 64 + (Rb & 31)) : Rb;
        voffA[i] = (unsigned)(R * lda + C) * 2u; voffB[i] = (unsigned)(Rg * ldb + C) * 2u; }
    const size_t kstep = (size_t)(BK * 2);
    const size_t hstepA = GATHER ? 0 : (size_t)HALF * lda * 2, hstepB = (size_t)(epi_bjadj<Epi>::v ? 32 : HALF) * ldb * 2;
    const unsigned ldsw = (unsigned)wid * 1024u;
    const int aoff = lds_byte(wr * 64 + fr, fq * 8), boff = lds_byte(wc * 32 + fr, fq * 8);
#define PG8_SA(b, h) (((b) * 2 + (h)) * HTB)
#define PG8_SB(b, h) ((4 + (b) * 2 + (h)) * HTB)
#define PG8_STAGE(bufoff, gbase, voff) do { _Pragma("unroll") for (int _i = 0; _i < 2; ++_i) \
        __builtin_amdgcn_global_load_lds((const unsigned*)((const char*)(gbase) + (voff)[_i]), (LAS unsigned*)(lds + (bufoff) + ldsw + _i * 8192), 16, 0, 0); } while (0)
#define PG8_STAGE_A(bufoff, gb, hh, nx) do { if constexpr (GATHER) { unsigned _v[2]; _v[0] = (nx) ? vn[hh][0] : vc[hh][0]; _v[1] = (nx) ? vn[hh][1] : vc[hh][1]; PG8_STAGE(bufoff, gb, _v); } \
        else { PG8_STAGE(bufoff, (gb) + (hh) * hstepA, voffA); } } while (0)
#define PG8_LDA(dst, b, h) do { _Pragma("unroll") for (int m = 0; m < 4; ++m) _Pragma("unroll") for (int k = 0; k < 2; ++k) dst[m][k] = *(const LAS bf16x8*)(lds + PG8_SA(b, h) + aoff + m * 2048 + k * 1024); } while (0)
#define PG8_LDB(dst, b, h) do { _Pragma("unroll") for (int n = 0; n < 2; ++n) _Pragma("unroll") for (int k = 0; k < 2; ++k) dst[n][k] = *(const LAS bf16x8*)(lds + PG8_SB(b, h) + boff + n * 2048 + k * 1024); } while (0)
#define PG8_MMA(ai, bj, At, Bt) do { __builtin_amdgcn_s_setprio(1); _Pragma("unroll") for (int m = 0; m < 4; ++m) _Pragma("unroll") for (int n = 0; n < 2; ++n) _Pragma("unroll") for (int k = 0; k < 2; ++k) { \
        if constexpr (FP8) { const l64x2 _b = __builtin_bit_cast(l64x2, Bt[n][k]), _a = __builtin_bit_cast(l64x2, At[m][k]); \
            acc[ai][bj][m][n] = __builtin_amdgcn_mfma_f32_16x16x32_fp8_fp8(_b[0], _a[0], acc[ai][bj][m][n], 0, 0, 0); acc[ai][bj][m][n] = __builtin_amdgcn_mfma_f32_16x16x32_fp8_fp8(_b[1], _a[1], acc[ai][bj][m][n], 0, 0, 0); } \
        else acc[ai][bj][m][n] = __builtin_amdgcn_mfma_f32_16x16x32_bf16(Bt[n][k], At[m][k], acc[ai][bj][m][n], 0, 0, 0); } __builtin_amdgcn_s_setprio(0); } while (0)
#define PG8_WAIT_V(n) asm volatile("s_waitcnt vmcnt(" #n ")" ::: "memory")
#define PG8_WAIT_L(n) asm volatile("s_waitcnt lgkmcnt(" #n ")" ::: "memory")
#define PG8_BAR __builtin_amdgcn_s_barrier()
#define PG8_SCHED __builtin_amdgcn_sched_barrier(0)
    Unit cur, nxt; int ui = 0;
    if (!S.next(0, cur)) return;
    unsigned vc[2][2] = {{0u, 0u}, {0u, 0u}}, vn[2][2] = {{0u, 0u}, {0u, 0u}};
    gather_offs<GATHER>(cur, tid, lda, vc);
    f32x4 acc[2][2][4][2];
#pragma unroll
    for (int a = 0; a < 2; ++a)
#pragma unroll
        for (int b = 0; b < 2; ++b)
#pragma unroll
            for (int m = 0; m < 4; ++m)
#pragma unroll
                for (int n = 0; n < 2; ++n) acc[a][b][m][n] = (f32x4){0.f, 0.f, 0.f, 0.f};
    bf16x8 At[4][2], B0[2][2], B1[2][2];
    const char* cA = cur.a; const char* cB = cur.b;
    PG8_STAGE(PG8_SB(0, 0), cB, voffB); PG8_STAGE(PG8_SB(0, 1), cB + hstepB, voffB); PG8_STAGE_A(PG8_SA(0, 0), cA, 0, false); PG8_STAGE_A(PG8_SA(0, 1), cA, 1, false);
    if (wr == 1) PG8_BAR;
    PG8_WAIT_V(2); PG8_BAR;
    PG8_STAGE(PG8_SB(1, 0), cB + kstep, voffB); PG8_STAGE_A(PG8_SA(1, 0), cA + kstep, 0, false); PG8_STAGE(PG8_SB(1, 1), cB + hstepB + kstep, voffB);
    PG8_WAIT_V(6); PG8_BAR;
    for (;;) {
        const bool has_next = S.next(ui + 1, nxt);
        if (has_next) gather_offs<GATHER>(nxt, tid, lda, vn);
        const char* nA = has_next ? nxt.a : cA; const char* nB = has_next ? nxt.b : cB;
        const bool do0 = !Sched::HALFSKIP || cur.nvalid > 64 * wr, do1 = !Sched::HALFSKIP || cur.nvalid > 128 + 64 * wr;
        for (int t = 0; t < nt; t += 2) {
            const bool last = (t == nt - 2);
            const bool lnx = last && has_next;
            const char* a1 = cA + (size_t)(t + 1) * kstep;
            const char* a2 = last ? nA : cA + (size_t)(t + 2) * kstep; const char* b2 = last ? nB : cB + (size_t)(t + 2) * kstep;
            const char* a3 = a2 + kstep; const char* b3 = b2 + kstep;
            PG8_LDB(B0, 0, 0); PG8_LDB(B1, 0, 1); PG8_SCHED; PG8_LDA(At, 0, 0); PG8_STAGE_A(PG8_SA(1, 1), a1, 1, false);
            PG8_WAIT_V(8); PG8_WAIT_L(0); PG8_BAR; if (do0) { PG8_MMA(0, 0, At, B0); PG8_MMA(0, 1, At, B1); } PG8_BAR; PG8_SCHED;
            PG8_LDA(At, 0, 1); PG8_STAGE(PG8_SB(0, 0), b2, voffB); PG8_STAGE(PG8_SB(0, 1), b2 + hstepB, voffB); PG8_STAGE_A(PG8_SA(0, 0), a2, 0, lnx);
            PG8_WAIT_V(8); PG8_WAIT_L(0); PG8_BAR; if (do1) { PG8_MMA(1, 0, At, B0); PG8_MMA(1, 1, At, B1); } PG8_BAR; PG8_SCHED;
            PG8_LDB(B0, 1, 0); PG8_LDB(B1, 1, 1); PG8_SCHED; PG8_LDA(At, 1, 0); PG8_STAGE_A(PG8_SA(0, 1), a2, 1, lnx);
            PG8_WAIT_V(8); PG8_WAIT_L(0); PG8_BAR; if (do0) { PG8_MMA(0, 0, At, B0); PG8_MMA(0, 1, At, B1); } PG8_BAR; PG8_SCHED;
            PG8_LDA(At, 1, 1); PG8_STAGE(PG8_SB(1, 0), b3, voffB); PG8_STAGE(PG8_SB(1, 1), b3 + hstepB, voffB); PG8_STAGE_A(PG8_SA(1, 0), a3, 0, lnx);
            PG8_WAIT_V(8); PG8_WAIT_L(0); PG8_BAR; if (do1) { PG8_MMA(1, 0, At, B0); PG8_MMA(1, 1, At, B1); } PG8_BAR; PG8_SCHED;
        }
        if constexpr (ALIGN_EPI) { if (wr == 0) PG8_BAR; }
        E(acc, cur, wr, wc, fr, fq);
        __builtin_amdgcn_s_waitcnt(0x0F70);
        if (!has_next) break;
        if (!E.keep(cur)) {
#pragma unroll
            for (int a = 0; a < 2; ++a)
#pragma unroll
                for (int b = 0; b < 2; ++b)
#pragma unroll
                    for (int m = 0; m < 4; ++m)
#pragma unroll
                        for (int n = 0; n < 2; ++n) acc[a][b][m][n] = (f32x4){0.f, 0.f, 0.f, 0.f};
        }
        cur = nxt; cA = nA; cB = nB; ++ui;
        if constexpr (GATHER) {
#pragma unroll
            for (int hh = 0; hh < 2; ++hh) { vc[hh][0] = vn[hh][0]; vc[hh][1] = vn[hh][1]; }
        }
        if constexpr (ALIGN_EPI) { if (wr == 1) PG8_BAR; }
    }
    PG8_WAIT_V(0);
    if constexpr (!ALIGN_EPI) { if (wr == 0) PG8_BAR; }
    PG8_BAR;
#undef PG8_SA
#undef PG8_SB
#undef PG8_STAGE
#undef PG8_STAGE_A
#undef PG8_LDA
#undef PG8_LDB
#undef PG8_MMA
#undef PG8_WAIT_V
#undef PG8_WAIT_L
#undef PG8_BAR
#undef PG8_SCHED
}
}

#define XB_TMO      128
#define XB_XCNT(j)  (256  + 64 * (j))
#define XB_XSUB(j)  (1280 + 64 * (j))
#define XB_XGEN(j)  (2304 + 64 * (j))
#define XB_TOP      3328
#define XB_TOPGEN   3392
#define XCD_BAR_WORDS 3456
#define XB_SPIN_CAP (1u << 20)
__device__ __forceinline__ unsigned xb_ld(unsigned* p)              { return __hip_atomic_load(p, __ATOMIC_RELAXED, __HIP_MEMORY_SCOPE_AGENT); }
__device__ __forceinline__ unsigned xb_add(unsigned* p, unsigned v) { return __hip_atomic_fetch_add(p, v, __ATOMIC_RELAXED, __HIP_MEMORY_SCOPE_AGENT); }
__device__ __forceinline__ unsigned xb_xcc_id() { return (unsigned)__builtin_amdgcn_s_getreg((3 << 11) | 20) & 0xFu; }
#define XB_SPIN(cond, bar) do { unsigned _sp = 0; while (cond) { __builtin_amdgcn_s_sleep(1); \
    if ((++_sp & 255u) == 0u) { if (xb_ld(&(bar)[XB_TMO])) break; if (_sp > XB_SPIN_CAP) { atomicAdd(&(bar)[XB_TMO], 1u); break; } } } } while (0)
struct XcdBarrier { unsigned* bar; unsigned x; volatile LAS unsigned* st; };
__device__ __forceinline__ XcdBarrier xcd_barrier_post(unsigned* bar, volatile LAS unsigned* st) {
    XcdBarrier b; b.bar = bar; b.x = xb_xcc_id(); b.st = st;
    if (threadIdx.x == 0) (void)xb_add(&bar[XB_XCNT(b.x)], 1u);
    return b;
}
__device__ __forceinline__ void xcd_barrier_complete(unsigned* bar, unsigned x, unsigned& nloc, unsigned& nx) {
    const unsigned G = gridDim.x * gridDim.y * gridDim.z;
    unsigned sum, cnt, mine, sp = 0u;
    for (;;) {
        sum = 0u; cnt = 0u; mine = 0u;
#pragma unroll
        for (unsigned j = 0; j < 16; ++j) { const unsigned c = xb_ld(&bar[XB_XCNT(j)]); sum += c; cnt += (c > 0u) ? 1u : 0u; mine = (j == x) ? c : mine; }
        if (sum == G) break;
        __builtin_amdgcn_s_sleep(1);
        if ((++sp & 255u) == 0u) { if (xb_ld(&bar[XB_TMO])) break; if (sp > XB_SPIN_CAP) { atomicAdd(&bar[XB_TMO], 1u); break; } }
    }
    nloc = mine > 0u ? mine : 1u; nx = cnt > 0u ? cnt : 1u;
}
__device__ __forceinline__ void xcd_barrier(const XcdBarrier& b) {
    asm volatile("s_waitcnt vmcnt(0)" ::: "memory");
    __syncthreads();
    if (threadIdx.x == 0) {
        unsigned* bar = b.bar;
        __builtin_amdgcn_s_waitcnt(0);
        unsigned nloc = b.st[0], nx = b.st[1];
        if (nloc == 0u) { xcd_barrier_complete(bar, b.x, nloc, nx); b.st[0] = nloc; b.st[1] = nx; }
        const unsigned old = xb_add(&bar[XB_XSUB(b.x)], 1u);
        const unsigned gen = old / nloc;
        if (old + 1u == (gen + 1u) * nloc) {
            __builtin_amdgcn_fence(__ATOMIC_RELEASE, "agent");
            asm volatile("s_waitcnt vmcnt(0)" ::: "memory");
            const unsigned og = xb_add(&bar[XB_TOP], 1u);
            const unsigned tg = og / nx;
            if (og + 1u == (tg + 1u) * nx) xb_add(&bar[XB_TOPGEN], 1u);
            else XB_SPIN(xb_ld(&bar[XB_TOPGEN]) == tg, bar);
            __builtin_amdgcn_fence(__ATOMIC_ACQUIRE, "agent");
            asm volatile("s_waitcnt vmcnt(0)" ::: "memory");
        } else {
            XB_SPIN(xb_ld(&bar[XB_TOPGEN]) == gen, bar);
            __builtin_amdgcn_fence(__ATOMIC_ACQUIRE, "agent");
            asm volatile("s_waitcnt vmcnt(0)" ::: "memory");
        }
    }
    __syncthreads();
}

struct Ctx {
    LAS unsigned char* lds;
    int tid, lane, wave, wg, G;
    const float *x, *c, *w_ada, *b_ada, *g1, *w_in, *lb_logits, *g_hgrn, *w_pa, *w_pb, *w_out, *g2, *w_router, *rbias, *w_egu, *w_edown, *w_sgu, *w_sdown, *g_final;
    const int* positions;
    float* out;
    unsigned char* ws;
};
#define WSP(type, off) ((type*)(X.ws + (off)))

__device__ __forceinline__ void transpose_item(const float* W, int K, int N, bf16_t* WT, int dst_row0, int src_col0, int k0, LAS float* scr, int lane) {
#pragma unroll 16
    for (int i = 0; i < 32; ++i) { const int kk = 2 * i + (lane >> 5); scr[kk * 33 + (lane & 31)] = W[(size_t)(k0 + kk) * N + src_col0 + (lane & 31)]; }
    LDS_WAIT(); asm volatile("" ::: "memory");
    const int c = lane & 7;
#pragma unroll
    for (int j = 0; j < 4; ++j) { const int n = (lane >> 3) + 8 * j; const LAS float* s = scr + (8 * c) * 33 + n;
        u32x4 o; o.x = pk2(s[0 * 33], s[1 * 33]); o.y = pk2(s[2 * 33], s[3 * 33]); o.z = pk2(s[4 * 33], s[5 * 33]); o.w = pk2(s[6 * 33], s[7 * 33]);
        *(u32x4*)(WT + (size_t)(dst_row0 + n) * K + k0 + 8 * c) = o; }
    LDS_WAIT(); asm volatile("" ::: "memory");
}
__device__ __forceinline__ void transpose_plain(const float* W, int K, int N, bf16_t* WT, int item, LAS float* scr, int lane) {
    const int nblk = N / 32, kb = item / nblk, nb = item % nblk;
    transpose_item(W, K, N, WT, nb * 32, nb * 32, kb * 64, scr, lane);
}
__device__ __forceinline__ void p0_prologue(Ctx& X) {
    LAS float* scr = (LAS float*)(X.lds + X.wave * 16384);
    const int gw = X.wg * NWAVES + X.wave, NGW = X.G * NWAVES;
    {
        float* MODP = WSP(float, WS_MODP);
        for (int it = gw; it < 96 * 16; it += NGW) {
            const int jc = it % 96, kc = it / 96, j = jc * 64 + X.lane;
            float a0 = 0.f, a1 = 0.f, a2 = 0.f, a3 = 0.f;
#pragma unroll 16
            for (int kk = 0; kk < 64; ++kk) { const int k = kc * 64 + kk; const float w = X.w_ada[(size_t)k * 6144 + j];
                const float c0 = X.c[k], c1 = X.c[1024 + k], c2 = X.c[2048 + k], c3 = X.c[3072 + k];
                a0 += c0 * sigmoidf_(c0) * w; a1 += c1 * sigmoidf_(c1) * w; a2 += c2 * sigmoidf_(c2) * w; a3 += c3 * sigmoidf_(c3) * w; }
            float* o = MODP + (size_t)kc * 24576 + j;
            st_wt4(o, __builtin_bit_cast(unsigned, a0)); st_wt4(o + 6144, __builtin_bit_cast(unsigned, a1)); st_wt4(o + 12288, __builtin_bit_cast(unsigned, a2)); st_wt4(o + 18432, __builtin_bit_cast(unsigned, a3));
        }
    }
    {
        float* ROPE = WSP(float, WS_ROPE);
        const int gt = X.wg * NTHREADS + X.tid, NGT = X.G * NTHREADS;
        for (int idx = gt; idx < T * 8; idx += NGT) { const int t = idx >> 3, i = idx & 7;
            const float inv_freq = 1.0f / powf(500000.0f, (float)(2 * i) / 16.0f);
            const float ang = (float)X.positions[t] * inv_freq;
            ROPE[t * 16 + i] = cosf(ang); ROPE[t * 16 + 8 + i] = sinf(ang); }
        if (X.wg == 0) { float* LB = WSP(float, WS_LB);
            for (int j = X.tid; j < 512; j += NTHREADS) { const float l0 = X.lb_logits[j], l1 = X.lb_logits[512 + j], m = fmaxf(l0, l1), e0 = __expf(l0 - m), e1 = __expf(l1 - m); LB[j] = e0 / (e0 + e1); } }
    }
}
struct CvtItem { const float* src; bf16_t* dst; };
template <bool GU> __device__ __forceinline__ CvtItem cvt_item(const Ctx& X, int it) {
    CvtItem c;
    if constexpr (GU) { const int e = it >> 7, q = it & 127, w8 = q & 7, sq = q >> 3, kb = 4 * (sq >> 2) + (w8 & 3), nb = 2 * (sq & 3) + (w8 >> 2);
        const int n0 = nb * 64, pn = n0 >> 8, bj = (n0 >> 7) & 1, idx = n0 & 127, srcc = bj * 256 + pn * 128 + idx;
        const float* W = (e < NE) ? X.w_egu + (size_t)e * 1024 * 512 : X.w_sgu;
        c.src = W + (size_t)(kb * 64) * 512 + srcc; c.dst = (bf16_t*)(X.ws + WS_WGU + ((size_t)e * 512 + n0) * 1024 + kb * 64); }
    else { const int e = it >> 6, q = it & 63, w8 = q & 7, sq = q >> 3, kb = w8 & 3, nb = 2 * sq + (w8 >> 2);
        const float* W = (e < NE) ? X.w_edown + (size_t)e * 256 * 1024 : X.w_sdown;
        c.src = W + (size_t)(kb * 64) * 1024 + nb * 64; c.dst = (bf16_t*)(X.ws + WS_WD + ((size_t)e * 1024 + nb * 64) * 256 + kb * 64); }
    return c;
}
template <int KB> __device__ __forceinline__ void cvt_store8(const CvtItem& c, int lane, const f32x4 (&v)[16], LAS unsigned char* tl, float sc) {
    const int kq = lane >> 4, nq = lane & 15;
#pragma unroll
    for (int i = 0; i < 4; ++i) { u32x4 w;
        w.x = pk4_fp8(v[0][i] * sc, v[1][i] * sc, v[2][i] * sc, v[3][i] * sc); w.y = pk4_fp8(v[4][i] * sc, v[5][i] * sc, v[6][i] * sc, v[7][i] * sc);
        w.z = pk4_fp8(v[8][i] * sc, v[9][i] * sc, v[10][i] * sc, v[11][i] * sc); w.w = pk4_fp8(v[12][i] * sc, v[13][i] * sc, v[14][i] * sc, v[15][i] * sc);
        *(LAS u32x4*)(tl + (4 * nq + i) * 80 + kq * 16) = w; }
    LDS_WAIT(); asm volatile("" ::: "memory");
    const int ch = lane & 3, r = lane >> 2;
    unsigned char* d8 = (unsigned char*)c.dst;
#pragma unroll
    for (int j = 0; j < 4; ++j) { const int n = 16 * j + r; const u32x4 w = *(const LAS u32x4*)(tl + n * 80 + ch * 16); __builtin_nontemporal_store(w, (u32x4*)(d8 + (size_t)n * KB + 16 * ch)); }
    LDS_WAIT(); asm volatile("" ::: "memory");
}
template <int N> __device__ __forceinline__ void cvt_load(const CvtItem& c, int lane, f32x4 (&v)[16]) {
    const float* p = c.src + (size_t)(16 * (lane >> 4)) * N + 4 * (lane & 15);
#pragma unroll
    for (int j = 0; j < 16; ++j) v[j] = __builtin_nontemporal_load((const f32x4*)(p + (size_t)j * N));
}
template <int K> __device__ __forceinline__ void cvt_store(const CvtItem& c, int lane, const f32x4 (&v)[16], LAS unsigned char* tl) {
    const int kq = lane >> 4, nq = lane & 15;
#pragma unroll
    for (int i = 0; i < 4; ++i) { u32x4 w0, w1;
        w0.x = pk2(v[0][i], v[1][i]); w0.y = pk2(v[2][i], v[3][i]); w0.z = pk2(v[4][i], v[5][i]); w0.w = pk2(v[6][i], v[7][i]);
        w1.x = pk2(v[8][i], v[9][i]); w1.y = pk2(v[10][i], v[11][i]); w1.z = pk2(v[12][i], v[13][i]); w1.w = pk2(v[14][i], v[15][i]);
        LAS unsigned char* q = tl + (4 * nq + i) * 144 + kq * 32; *(LAS u32x4*)q = w0; *(LAS u32x4*)(q + 16) = w1; }
    LDS_WAIT(); asm volatile("" ::: "memory");
    const int ch = lane & 7, r = lane >> 3;
#pragma unroll
    for (int j = 0; j < 8; ++j) { const int n = 8 * j + r; const u32x4 w = *(const LAS u32x4*)(tl + n * 144 + ch * 16); __builtin_nontemporal_store(w, (u32x4*)(c.dst + (size_t)n * K + 8 * ch)); }
    LDS_WAIT(); asm volatile("" ::: "memory");
}
struct CvtPair { const float* src; unsigned char* dst; };
template <bool GU> __device__ __forceinline__ CvtPair cvt_pair(const Ctx& X, int di) {
    CvtPair c;
    if constexpr (GU) { const int e = di >> 6, q = di & 63, nb = q & 7, kb2 = q >> 3;
        const int n0 = nb * 64, pn = n0 >> 8, bj = (n0 >> 7) & 1, idx = n0 & 127, srcc = bj * 256 + pn * 128 + idx;
        const float* W = (e < NE) ? X.w_egu + (size_t)e * 1024 * 512 : X.w_sgu;
        c.src = W + (size_t)(kb2 * 128) * 512 + srcc; c.dst = X.ws + WS_WGU + ((size_t)e * 512 + n0) * 1024 + kb2 * 128; }
    else { const int e = di >> 5, q = di & 31, nb = q & 15, kb2 = q >> 4;
        const float* W = (e < NE) ? X.w_edown + (size_t)e * 256 * 1024 : X.w_sdown;
        c.src = W + (size_t)(kb2 * 128) * 1024 + nb * 64; c.dst = X.ws + WS_WD + ((size_t)e * 1024 + nb * 64) * 256 + kb2 * 128; }
    return c;
}
template <int N> __device__ __forceinline__ void cvt_load_half(const CvtPair& c, int half, int lane, f32x4 (&v)[16]) {
    const float* p = c.src + (size_t)(64 * half + 16 * (lane >> 4)) * N + 4 * (lane & 15);
#pragma unroll
    for (int j = 0; j < 16; ++j) v[j] = __builtin_nontemporal_load((const f32x4*)(p + (size_t)j * N));
}
__device__ __forceinline__ void cvt_half_to_lds(int half, int lane, const f32x4 (&v)[16], LAS unsigned char* tl, float sc) {
    const int kq = lane >> 4, nq = lane & 15;
#pragma unroll
    for (int i = 0; i < 4; ++i) { u32x4 w;
        w.x = pk4_fp8(v[0][i] * sc, v[1][i] * sc, v[2][i] * sc, v[3][i] * sc); w.y = pk4_fp8(v[4][i] * sc, v[5][i] * sc, v[6][i] * sc, v[7][i] * sc);
        w.z = pk4_fp8(v[8][i] * sc, v[9][i] * sc, v[10][i] * sc, v[11][i] * sc); w.w = pk4_fp8(v[12][i] * sc, v[13][i] * sc, v[14][i] * sc, v[15][i] * sc);
        *(LAS u32x4*)(tl + (4 * nq + i) * 144 + half * 64 + kq * 16) = w; }
}
template <int KB> __device__ __forceinline__ void cvt_flush(const CvtPair& c, int lane, LAS unsigned char* tl) {
    LDS_WAIT(); asm volatile("" ::: "memory");
    const int ch = lane & 7, r = lane >> 3;
#pragma unroll
    for (int j = 0; j < 8; ++j) { const int n = 8 * j + r; const u32x4 w = *(const LAS u32x4*)(tl + n * 144 + ch * 16); __builtin_nontemporal_store(w, (u32x4*)(c.dst + (size_t)n * KB + 16 * ch)); }
    LDS_WAIT(); asm volatile("" ::: "memory");
}
template <bool GU> __device__ __forceinline__ void expert_convert_set(Ctx& X, int gw, int NGW, LAS unsigned char* tl) {
    constexpr int NIT = GU ? NEX * 64 : NEX * 32, N = GU ? 512 : 1024, K = GU ? 1024 : 256; constexpr float SC = GU ? WGU_SCALE : WD_SCALE;
    if (gw >= NIT) return;
    const int nmine = (NIT - gw + NGW - 1) / NGW;
    f32x4 va[16], vb[16];
    CvtPair cur = cvt_pair<GU>(X, gw);
    cvt_load_half<N>(cur, 0, X.lane, va); cvt_load_half<N>(cur, 1, X.lane, vb);
    for (int j = 0; j < nmine; ++j) {
        const CvtPair nxt = cvt_pair<GU>(X, gw + (j + 1 < nmine ? j + 1 : j) * NGW);
        __builtin_amdgcn_sched_barrier(0);
        cvt_half_to_lds(0, X.lane, va, tl, SC);
        __builtin_amdgcn_sched_barrier(0);
        cvt_load_half<N>(nxt, 0, X.lane, va);
        __builtin_amdgcn_sched_barrier(0);
        cvt_half_to_lds(1, X.lane, vb, tl, SC);
        cvt_flush<K>(cur, X.lane, tl);
        __builtin_amdgcn_sched_barrier(0);
        cvt_load_half<N>(nxt, 1, X.lane, vb);
        __builtin_amdgcn_sched_barrier(0);
        cur = nxt;
    }
}
__device__ __forceinline__ void expert_convert(Ctx& X, int cw, int ncw) {
    LAS unsigned char* tl = X.lds + X.wave * 16384;
    const int gw = cw * NWAVES + X.wave, NGW = ncw * NWAVES;
    expert_convert_set<true>(X, gw, NGW, tl);
    expert_convert_set<false>(X, gw, NGW, tl);
}

__device__ __forceinline__ void small_transposes(Ctx& X) {
    LAS float* scr = (LAS float*)(X.lds + 16384 + X.wave * 12288);
    const int gw = X.wg * NWAVES + X.wave, NGW = X.G * NWAVES;
    {
        constexpr int I_IN = 16 * 272, I_PA = 8 * 32, I_PB = 8 * 32, I_OUT = 16 * 32, I_R = 16 * 8;
        constexpr int NITEMS = I_IN + I_PA + I_PB + I_OUT + I_R;
        for (int it = gw; it < NITEMS; it += NGW) {
            int r = it;
            if (r < I_IN) { transpose_plain(X.w_in, 1024, INW, WSP(bf16_t, WS_WIN), r, scr, X.lane); continue; } r -= I_IN;
            if (r < I_PA) { transpose_plain(X.w_pa, 512, 1024, WSP(bf16_t, WS_WPA), r, scr, X.lane); continue; } r -= I_PA;
            if (r < I_PB) { transpose_plain(X.w_pb, 512, 1024, WSP(bf16_t, WS_WPB), r, scr, X.lane); continue; } r -= I_PB;
            if (r < I_OUT) { transpose_plain(X.w_out, 1024, 1024, WSP(bf16_t, WS_WOUT), r, scr, X.lane); continue; } r -= I_OUT;
            transpose_plain(X.w_router, 1024, 256, WSP(bf16_t, WS_WR), r, scr, X.lane);
        }
    }
}

__device__ __forceinline__ void norm_rows(Ctx& X, int which) {
    LAS float* sm = (LAS float*)X.lds;
    const float* MODP = WSP(float, WS_MODP); float* MOD = WSP(float, WS_MOD);
    const int rows_per_wg = T / X.G, row0 = X.wg * rows_per_wg, b = row0 / SEQ;
    if (which == 0) {
        for (int i = X.tid; i < 2048; i += NTHREADS) { const int j = b * 6144 + i; float s = X.b_ada[i];
#pragma unroll
            for (int p = 0; p < 16; ++p) s += MODP[(size_t)p * 24576 + j];
            sm[i] = s; }
        const int per = 24576 / X.G;
        for (int i = X.tid; i < per; i += NTHREADS) { const int j = X.wg * per + i; float s = X.b_ada[j % 6144];
#pragma unroll
            for (int p = 0; p < 16; ++p) s += MODP[(size_t)p * 24576 + j];
            MOD[j] = s; }
    } else {
        for (int i = X.tid; i < 2048; i += NTHREADS) sm[i] = MOD[b * 6144 + 3072 + i];
    }
    __syncthreads();
    const float* src = X.x; const bf16_t* srcb = WSP(bf16_t, WS_X1); const float* g = which == 0 ? X.g1 : X.g2;
    bf16_t* H = WSP(bf16_t, WS_H);
    for (int r = X.wave; r < rows_per_wg; r += NWAVES) {
        const int row = row0 + r;
        f32x4 v[2][2]; float s = 0.f;
#pragma unroll
        for (int j = 0; j < 2; ++j) { const int col = 8 * X.lane + 512 * j;
            if (which == 0) { v[j][0] = *(const f32x4*)(src + (size_t)row * D + col); v[j][1] = *(const f32x4*)(src + (size_t)row * D + col + 4); }
            else { const u32x4 wv = *(const u32x4*)(srcb + (size_t)row * D + col); v[j][0] = (f32x4){bflo(wv.x), bfhi(wv.x), bflo(wv.y), bfhi(wv.y)}; v[j][1] = (f32x4){bflo(wv.z), bfhi(wv.z), bflo(wv.w), bfhi(wv.w)}; }
#pragma unroll
            for (int q = 0; q < 2; ++q) s += (v[j][q].x * v[j][q].x + v[j][q].y * v[j][q].y) + (v[j][q].z * v[j][q].z + v[j][q].w * v[j][q].w); }
        const float rstd = rsqrtf(wave_sum(s) * (1.f / D) + EPS);
#pragma unroll
        for (int j = 0; j < 2; ++j) { const int col = 8 * X.lane + 512 * j; float y[8];
#pragma unroll
            for (int q = 0; q < 2; ++q) { const f32x4 gg = *(const f32x4*)(g + col + 4 * q), sh = *(const LAS f32x4*)(sm + col + 4 * q), sc = *(const LAS f32x4*)(sm + 1024 + col + 4 * q);
#pragma unroll
                for (int e = 0; e < 4; ++e) y[4 * q + e] = v[j][q][e] * rstd * gg[e] * (1.f + sc[e]) + sh[e]; }
            u32x4 hw; hw.x = pk2(y[0], y[1]); hw.y = pk2(y[2], y[3]); hw.z = pk2(y[4], y[5]); hw.w = pk2(y[6], y[7]);
            if (which == 1) { st_wt16(H + (size_t)row * D + col, hw);
                st_wt8(WSP(unsigned char, WS_H8) + (size_t)row * D + col, (unsigned long long)pk4_fp8(y[0], y[1], y[2], y[3]) | ((unsigned long long)pk4_fp8(y[4], y[5], y[6], y[7]) << 32)); }
            else *(u32x4*)(H + (size_t)row * D + col) = hw; }
    }
    __syncthreads();
}

struct RegSched {
    static constexpr bool HALFSKIP = false;
    const char* A; const char* Bt; size_t a_tile, b_tile; int nM, nN, G, c;
    __device__ __forceinline__ bool next(int i, pg8::Unit& u) const {
        const int L = i * G + c; if (L >= nM * nN) return false;
        int pm, pn; pg8::swz_tile(L, nM, nN, pm, pn);
        u.a = A + (size_t)pm * a_tile; u.b = Bt + (size_t)pn * b_tile; u.rows = nullptr; u.pm = pm; u.pn = pn; u.aux = 0; u.nvalid = 256; return true;
    }
};
struct TwoPartSched {      static constexpr bool HALFSKIP = false;
    const char* Y; const char* Wa; const char* Wb; int nM, nN, G, c;
    __device__ __forceinline__ bool next(int i, pg8::Unit& u) const {
        const int L = (i >> 1) * G + c, part = i & 1; if (L >= nM * nN) return false;
        int pm, pn; pg8::swz_tile(L, nM, nN, pm, pn);
        u.a = Y + (size_t)pm * 256 * 2048 + part * 1024; u.b = (part ? Wb : Wa) + (size_t)pn * 256 * 1024; u.rows = nullptr; u.pm = pm; u.pn = pn; u.aux = part; u.nvalid = 256; return true;
    }
};
struct MoeSched {
    static constexpr bool HALFSKIP = true;
    const LAS int* tbl; const LAS int* cnts; int nent; const char* A; const char* W; const int* lists; int ncol  , wtile  , wexp  , atile  , G, c;
    __device__ __forceinline__ bool next(int i, pg8::Unit& u) const {
        const int un = i * (G >> 3) + (c >> 3); if (un >= nent * ncol) return false;
        const int pn = un % ncol; const int ent = __builtin_amdgcn_readfirstlane(tbl[un / ncol]), e = (ent >> 7) & 511, r = ent & 127, rt = ent >> 16;
        u.a = A + (size_t)rt * atile; u.b = W + (size_t)e * wexp + (size_t)pn * wtile; u.rows = lists + (size_t)e * 16384 + r * 256;
        u.pm = rt; u.pn = pn; u.aux = e; const int left = __builtin_amdgcn_readfirstlane(cnts[e]) - r * 256; u.nvalid = left < 256 ? left : 256; return true;
    }
};

__device__ __forceinline__ unsigned dpp_xor1(unsigned x) { return (unsigned)__builtin_amdgcn_update_dpp(0, (int)x, 0xB1, 0xF, 0xF, true); }
__device__ __forceinline__ void pair_rows(const u32x4& w0, const u32x4& w1, bool oddr, u32x4& ev, u32x4& od) {
    const u32x4 snd = oddr ? w0 : w1;
    u32x4 rcv; rcv.x = dpp_xor1(snd.x); rcv.y = dpp_xor1(snd.y); rcv.z = dpp_xor1(snd.z); rcv.w = dpp_xor1(snd.w);
    ev = oddr ? rcv : w0; od = oddr ? w1 : rcv;
}
struct EpiInproj {
    static constexpr bool PERM = true;
    static constexpr bool BJADJ = true;
    bf16_t* PROJ; float* LOGF; const float* LB; const float* ROPE; unsigned char* G8; unsigned char* QK8;
    __device__ __forceinline__ bool keep(const pg8::Unit&) const { return false; }
    __device__ __forceinline__ void operator()(f32x4 (&acc)[2][2][4][2], const pg8::Unit& u, int wr, int wc, int fr, int fq) const {
        const int pn = u.pn;
        const int mode = pn < 2 ? 0 : pn < 4 ? 1 : pn < 6 ? 0 : pn < 8 ? 2 : pn < 20 ? 3 : pn < 26 ? 5 : 4;
        const int row0 = u.pm * 256 + wr * 64 + fr, colb = pn * 256 + wc * 64 + 8 * fq;
        const bool rot3 = (mode == 3);
        const bool odd = fq & 1; const int colw = pn * 256 + wc * 64 + (fq & 1) * 32 + (fq >> 1) * 16;
#pragma unroll
        for (int ai = 0; ai < 2; ++ai)
#pragma unroll
            for (int m = 0; m < 4; ++m) {
                const int row = row0 + ai * 128 + m * 16;
                f32x4 cs0, cs1, sn0, sn1;
                if (rot3) { const f32x4* rp = (const f32x4*)(ROPE + (size_t)row * 16); cs0 = rp[0]; cs1 = rp[1]; sn0 = rp[2]; sn1 = rp[3]; }
                u32x2 p8[2]; u32x4 wb[2];
#pragma unroll
                for (int bj = 0; bj < 2; ++bj) {
                    const int col = colb + bj * 32; const bool rot = rot3 && bj == 0;
                    f32x4 v0 = acc[ai][bj][m][0], v1 = acc[ai][bj][m][1];
                    if (mode == 1) {
                        const int cf = col - 512; const f32x4 l0 = *(const f32x4*)(LB + cf), l1 = *(const f32x4*)(LB + cf + 4);
                        f32x4 lf0, lf1;
#pragma unroll
                        for (int j = 0; j < 4; ++j) { float sg = sigmoidf_(v0[j]); float f = l0[j] + (1.f - l0[j]) * sg; lf0[j] = fast_logf(f); v0[j] = (1.f - l0[j]) * (1.f - sg);
                            sg = sigmoidf_(v1[j]); f = l1[j] + (1.f - l1[j]) * sg; lf1[j] = fast_logf(f); v1[j] = (1.f - l1[j]) * (1.f - sg); }
                        acc[ai][bj][m][0] = lf0; acc[ai][bj][m][1] = lf1;
                    } else if (mode == 2) {
#pragma unroll
                        for (int j = 0; j < 4; ++j) { v0[j] = v0[j] * sigmoidf_(v0[j]); v1[j] = v1[j] * sigmoidf_(v1[j]); }
                    } else if (mode == 4) {
#pragma unroll
                        for (int j = 0; j < 4; ++j) { v0[j] = sigmoidf_(v0[j]); v1[j] = sigmoidf_(v1[j]); }
                    } else if (rot) {
                        f32x4 p0, p1;
#pragma unroll
                        for (int j = 0; j < 4; ++j) { p0[j] = __shfl_xor(v0[j], 16); p1[j] = __shfl_xor(v1[j], 16); }
                        if (fq == 0) { v0 = v0 * cs0 - p0 * sn0; v1 = v1 * cs1 - p1 * sn1; }
                        else if (fq == 1) { v0 = v0 * cs0 + p0 * sn0; v1 = v1 * cs1 + p1 * sn1; }
                    }
                    if (mode == 4) {
                        int g0 = 0, g1 = 0;
#pragma unroll
                        for (int j = 0; j < 4; ++j) { g0 = __builtin_amdgcn_cvt_pk_u8_f32(fmaxf(v0[j] * 255.0f, 1.0f), j, g0); g1 = __builtin_amdgcn_cvt_pk_u8_f32(fmaxf(v1[j] * 255.0f, 1.0f), j, g1); }
                        p8[bj] = (u32x2){(unsigned)g0, (unsigned)g1};
                        continue; }
                    if (mode == 3 || mode == 5) {
                        p8[bj] = (u32x2){pk4_fp8(v0[0], v0[1], v0[2], v0[3]), pk4_fp8(v1[0], v1[1], v1[2], v1[3])};
                        continue; }
                    wb[bj].x = pg8::cvt_pk_bf16(v0[0], v0[1]); wb[bj].y = pg8::cvt_pk_bf16(v0[2], v0[3]); wb[bj].z = pg8::cvt_pk_bf16(v1[0], v1[1]); wb[bj].w = pg8::cvt_pk_bf16(v1[2], v1[3]);
                }
                if (mode < 3) {
                    u32x4 ev, od; pair_rows(wb[0], wb[1], fr & 1, ev, od);
                    bf16_t* pp = PROJ + (size_t)(row - (fr & 1)) * INW + colb + (fr & 1) * 32;
                    *(u32x4*)pp = ev; *(u32x4*)(pp + INW) = od;
                }
                if (mode >= 3) {
                    const u32x2 snd = odd ? p8[0] : p8[1];
                    u32x2 rcv; rcv.x = (unsigned)__shfl_xor((int)snd.x, 16); rcv.y = (unsigned)__shfl_xor((int)snd.y, 16);
                    const u32x4 w = odd ? (u32x4){rcv.x, rcv.y, p8[1].x, p8[1].y} : (u32x4){p8[0].x, p8[0].y, rcv.x, rcv.y};
                    if (mode == 4) *(u32x4*)(G8 + (size_t)row * 2048 + (colw - C_GA)) = w;
                    else *(u32x4*)(QK8 + (size_t)row * 4608 + (colw - C_AQ)) = w;
                }
            }
        if (mode == 1) {
            const int lane = fq * 16 + fr;
#pragma unroll
            for (int ai = 0; ai < 2; ++ai)
#pragma unroll
                for (int bj = 0; bj < 2; ++bj)
#pragma unroll
                    for (int n = 0; n < 2; ++n)
#pragma unroll
                        for (int j = 0; j < 4; ++j) { float carry = 0.f;
#pragma unroll
                            for (int m = 0; m < 4; ++m) { float v = acc[ai][bj][m][n][j];
                                v += __builtin_bit_cast(float, __builtin_amdgcn_update_dpp(0, __builtin_bit_cast(int, v), 0x111, 0xF, 0xF, true));
                                v += __builtin_bit_cast(float, __builtin_amdgcn_update_dpp(0, __builtin_bit_cast(int, v), 0x112, 0xF, 0xF, true));
                                v += __builtin_bit_cast(float, __builtin_amdgcn_update_dpp(0, __builtin_bit_cast(int, v), 0x114, 0xF, 0xF, true));
                                v += __builtin_bit_cast(float, __builtin_amdgcn_update_dpp(0, __builtin_bit_cast(int, v), 0x118, 0xF, 0xF, true));
                                v += carry; acc[ai][bj][m][n][j] = v; carry = __shfl(v, (lane & 48) | 15); } }
#pragma unroll
            for (int ai = 0; ai < 2; ++ai)
#pragma unroll
                for (int m = 0; m < 4; ++m)
#pragma unroll
                    for (int bj = 0; bj < 2; ++bj) { float* lp = LOGF + (size_t)(row0 + ai * 128 + m * 16) * 512 + (colb + bj * 32 - 512); *(f32x4*)lp = acc[ai][bj][m][0]; *(f32x4*)(lp + 4) = acc[ai][bj][m][1]; }
        }
    }
};
__device__ __forceinline__ void gate8(u32x2 w, f32x4& lo, f32x4& hi) {
    constexpr float s = 1.0f / 255.0f;
    lo = (f32x4){(float)(w.x & 255u), (float)((w.x >> 8) & 255u), (float)((w.x >> 16) & 255u), (float)(w.x >> 24)} * s;
    hi = (f32x4){(float)(w.y & 255u), (float)((w.y >> 8) & 255u), (float)((w.y >> 16) & 255u), (float)(w.y >> 24)} * s;
}
struct EpiMixed {
    static constexpr bool PERM = true;
    static constexpr bool BJADJ = true;
    const unsigned char* G8; bf16_t* MIXED;
    __device__ __forceinline__ bool keep(const pg8::Unit& u) const { return u.aux == 0; }
    __device__ __forceinline__ void operator()(f32x4 (&acc)[2][2][4][2], const pg8::Unit& u, int wr, int wc, int fr, int fq) const {
        const int row0 = u.pm * 256 + wr * 64 + fr, colb = u.pn * 256 + wc * 64 + 8 * fq;
#pragma unroll
        for (int ai = 0; ai < 2; ++ai)
#pragma unroll
            for (int m = 0; m < 4; ++m) {
                const int row = row0 + ai * 128 + m * 16;
                u32x4 wb[2];
#pragma unroll
                for (int bj = 0; bj < 2; ++bj) {
                    const int col = colb + bj * 32;
                    f32x4 b0, b1; gate8(*(const u32x2*)(G8 + (size_t)row * 2048 + 1024 + col), b0, b1);
                    if (u.aux == 0) {
                        f32x4 a0, a1; gate8(*(const u32x2*)(G8 + (size_t)row * 2048 + col), a0, a1);
#pragma unroll
                        for (int j = 0; j < 4; ++j) { acc[ai][bj][m][0][j] *= a0[j] * __builtin_amdgcn_rcpf(b0[j]); acc[ai][bj][m][1][j] *= a1[j] * __builtin_amdgcn_rcpf(b1[j]); }
                    } else {
                        const f32x4 v0 = acc[ai][bj][m][0] * b0, v1 = acc[ai][bj][m][1] * b1;
                        wb[bj].x = pg8::cvt_pk_bf16(v0[0], v0[1]); wb[bj].y = pg8::cvt_pk_bf16(v0[2], v0[3]); wb[bj].z = pg8::cvt_pk_bf16(v1[0], v1[1]); wb[bj].w = pg8::cvt_pk_bf16(v1[2], v1[3]);
                    }
                }
                if (u.aux != 0) {
                    u32x4 ev, od; pair_rows(wb[0], wb[1], fr & 1, ev, od);
                    bf16_t* pp = MIXED + (size_t)(row - (fr & 1)) * D + colb + (fr & 1) * 32;
                    st_wt16(pp, ev); st_wt16(pp + D, od);
                }
            }
    }
};
struct EpiOutproj {
    static constexpr bool PERM = true;
    const float* x; const float* MOD; bf16_t* X1;
    __device__ __forceinline__ bool keep(const pg8::Unit&) const { return false; }
    __device__ __forceinline__ void operator()(f32x4 (&acc)[2][2][4][2], const pg8::Unit& u, int wr, int wc, int fr, int fq) const {
        const int row0 = u.pm * 256 + wr * 64 + fr, colb = u.pn * 256 + wc * 32 + 8 * fq;
        const int b = (u.pm * 256) / SEQ;
#pragma unroll
        for (int bj = 0; bj < 2; ++bj) {
            const int col = colb + bj * 128;
            const f32x4 g0 = *(const f32x4*)(MOD + b * 6144 + 2048 + col), g1 = *(const f32x4*)(MOD + b * 6144 + 2048 + col + 4);
#pragma unroll
            for (int ai = 0; ai < 2; ++ai)
#pragma unroll
                for (int m = 0; m < 4; ++m) { const size_t off = (size_t)(row0 + ai * 128 + m * 16) * D + col;
                    const f32x4 v0 = *(const f32x4*)(x + off) + g0 * acc[ai][bj][m][0], v1 = *(const f32x4*)(x + off + 4) + g1 * acc[ai][bj][m][1];
                    u32x4 w; w.x = pg8::cvt_pk_bf16(v0[0], v0[1]); w.y = pg8::cvt_pk_bf16(v0[2], v0[3]); w.z = pg8::cvt_pk_bf16(v1[0], v1[1]); w.w = pg8::cvt_pk_bf16(v1[2], v1[3]);
                    st_wt16(X1 + off, w); }
        }
    }
};
struct EpiOutNorm {
    static constexpr bool PERM = true;
    static constexpr bool BJADJ = true;
    const float* x; const float* MOD; const float* g2; bf16_t* X1; bf16_t* H; unsigned char* H8; float* XB; unsigned* cnt; LAS unsigned char* sl;
    __device__ __forceinline__ bool keep(const pg8::Unit&) const { return false; }
    __device__ __forceinline__ void operator()(f32x4 (&acc)[2][2][4][2], const pg8::Unit& u, int wr, int wc, int fr, int fq) const {
        const int tid = threadIdx.x;
        const int rl0 = wr * 64 + fr, row0 = u.pm * 256 + rl0, colb = u.pn * 256 + wc * 64 + 8 * fq;
        const int b = (u.pm * 256) / SEQ;
        LAS float* Pt = (LAS float*)sl; LAS float* Rs = (LAS float*)(sl + 4096); LAS float* GS = (LAS float*)(sl + 5120); LAS float* SH = (LAS float*)(sl + 6144);
#pragma unroll
        for (int bj = 0; bj < 2; ++bj) {
            const int col = colb + bj * 32;
            const f32x4 g0 = *(const f32x4*)(MOD + b * 6144 + 2048 + col), g1 = *(const f32x4*)(MOD + b * 6144 + 2048 + col + 4);
#pragma unroll
            for (int ai = 0; ai < 2; ++ai)
#pragma unroll
                for (int m = 0; m < 4; ++m) { const size_t off = (size_t)(row0 + ai * 128 + m * 16) * D + col;
                    acc[ai][bj][m][0] = *(const f32x4*)(x + off) + g0 * acc[ai][bj][m][0]; acc[ai][bj][m][1] = *(const f32x4*)(x + off + 4) + g1 * acc[ai][bj][m][1];
                    asm volatile("" : "+v"(acc[ai][bj][m][0]), "+v"(acc[ai][bj][m][1]));
                    if (m & 1) asm volatile("" ::: "memory"); }
        }
#pragma unroll
        for (int ai = 0; ai < 2; ++ai)
#pragma unroll
            for (int m = 0; m < 4; ++m) { float q = 0.f;
#pragma unroll
                for (int bj = 0; bj < 2; ++bj)
#pragma unroll
                    for (int n = 0; n < 2; ++n) { const f32x4 v = acc[ai][bj][m][n]; q += (v[0] * v[0] + v[1] * v[1]) + (v[2] * v[2] + v[3] * v[3]); }
                q += __shfl_xor(q, 16); q += __shfl_xor(q, 32);
                if (fq == 0) Pt[(ai * 128 + rl0 + m * 16) * 4 + wc] = q; }
        asm volatile("s_waitcnt lgkmcnt(0)" ::: "memory"); __builtin_amdgcn_s_barrier(); asm volatile("" ::: "memory");
        if (tid < 256) { const f32x4 p = *(const LAS f32x4*)(Pt + tid * 4); st_wt4(XB + ((size_t)u.pm * 256 + tid) * 4 + u.pn, __builtin_bit_cast(unsigned, (p[0] + p[1]) + (p[2] + p[3]))); }
        asm volatile("s_waitcnt vmcnt(0)" ::: "memory"); __builtin_amdgcn_s_barrier(); asm volatile("" ::: "memory");
        if (tid == 0) { unsigned* p = cnt + (size_t)u.pm * 64; (void)xb_add(p, 1u); unsigned sp = 0u;
            while (xb_ld(p) < 4u) { __builtin_amdgcn_s_sleep(2); if (++sp > (1u << 22)) break; }
            __builtin_amdgcn_fence(__ATOMIC_ACQUIRE, "agent"); asm volatile("s_waitcnt vmcnt(0)" ::: "memory"); }
        __builtin_amdgcn_s_barrier(); asm volatile("" ::: "memory");
        if (tid < 256) { const f32x4 q = *(const f32x4*)(XB + ((size_t)u.pm * 256 + tid) * 4); Rs[tid] = rsqrtf(((q[0] + q[1]) + (q[2] + q[3])) * (1.f / D) + EPS); }
        else { const int c = tid - 256, col = u.pn * 256 + c; GS[c] = g2[col] * (1.0f + MOD[b * 6144 + 4096 + col]); SH[c] = MOD[b * 6144 + 3072 + col]; }
        asm volatile("s_waitcnt vmcnt(0) lgkmcnt(0)" ::: "memory"); __builtin_amdgcn_s_barrier(); asm volatile("" ::: "memory");
        const bool oddr = fr & 1, oddq = fq & 1;
#pragma unroll
        for (int ai = 0; ai < 2; ++ai)
#pragma unroll
            for (int m = 0; m < 4; ++m) { const int rl = ai * 128 + rl0 + m * 16; const float rs = Rs[rl];
                u32x4 xw[2], hw[2]; u32x2 h8[2];
#pragma unroll
                for (int bj = 0; bj < 2; ++bj) { const int cp = wc * 64 + bj * 32 + 8 * fq;
                    const f32x4 g0 = *(const LAS f32x4*)(GS + cp), g1 = *(const LAS f32x4*)(GS + cp + 4), s0 = *(const LAS f32x4*)(SH + cp), s1 = *(const LAS f32x4*)(SH + cp + 4);
                    const f32x4 v0 = acc[ai][bj][m][0], v1 = acc[ai][bj][m][1];
                    xw[bj].x = pg8::cvt_pk_bf16(v0[0], v0[1]); xw[bj].y = pg8::cvt_pk_bf16(v0[2], v0[3]); xw[bj].z = pg8::cvt_pk_bf16(v1[0], v1[1]); xw[bj].w = pg8::cvt_pk_bf16(v1[2], v1[3]);
                    const f32x4 h0 = v0 * rs * g0 + s0, h1 = v1 * rs * g1 + s1;
                    hw[bj].x = pg8::cvt_pk_bf16(h0[0], h0[1]); hw[bj].y = pg8::cvt_pk_bf16(h0[2], h0[3]); hw[bj].z = pg8::cvt_pk_bf16(h1[0], h1[1]); hw[bj].w = pg8::cvt_pk_bf16(h1[2], h1[3]);
                    h8[bj] = (u32x2){pk4_fp8(h0[0], h0[1], h0[2], h0[3]), pk4_fp8(h1[0], h1[1], h1[2], h1[3])}; }
                const size_t rowoff = (size_t)(u.pm * 256 + rl) * D + u.pn * 256 + wc * 64;
                const size_t offp = rowoff - (oddr ? D : 0) + 8 * fq + (oddr ? 32 : 0);
                u32x4 ev, od;
                pair_rows(xw[0], xw[1], oddr, ev, od); *(u32x4*)(X1 + offp) = ev; *(u32x4*)(X1 + offp + D) = od;
                pair_rows(hw[0], hw[1], oddr, ev, od); st_wt16(H + offp, ev); st_wt16(H + offp + D, od);
                const u32x2 snd = oddq ? h8[0] : h8[1];
                u32x2 rcv; rcv.x = (unsigned)__shfl_xor((int)snd.x, 16); rcv.y = (unsigned)__shfl_xor((int)snd.y, 16);
                const u32x4 w8 = oddq ? (u32x4){rcv.x, rcv.y, h8[1].x, h8[1].y} : (u32x4){h8[0].x, h8[0].y, rcv.x, rcv.y};
                st_wt16(H8 + rowoff + (fq & 1) * 32 + (fq >> 1) * 16, w8);
                asm volatile("" ::: "memory"); }
    }
};
typedef _Float16 h16x2 __attribute__((ext_vector_type(2)));
__device__ __forceinline__ unsigned pk_f16(float a, float b) { const h16x2 v = {(_Float16)a, (_Float16)b}; return __builtin_bit_cast(unsigned, v); }
__device__ __forceinline__ float f16lo(unsigned w) { return (float)__builtin_bit_cast(h16x2, w)[0]; }
__device__ __forceinline__ float f16hi(unsigned w) { return (float)__builtin_bit_cast(h16x2, w)[1]; }
struct EpiRouter {
    static constexpr bool PERM = true;
    static constexpr bool BJADJ = true;
    unsigned short* LOGITS4;
    __device__ __forceinline__ bool keep(const pg8::Unit&) const { return false; }
    __device__ __forceinline__ void operator()(f32x4 (&acc)[2][2][4][2], const pg8::Unit& u, int wr, int wc, int fr, int fq) const {
        const int row0 = u.pm * 256 + wr * 64 + fr, colb = wc * 64 + 8 * fq;
        unsigned short* base = LOGITS4 + (size_t)u.aux * T * 256;
#pragma unroll
        for (int ai = 0; ai < 2; ++ai)
#pragma unroll
            for (int m = 0; m < 4; ++m) { const int row = row0 + ai * 128 + m * 16;
                u32x4 wb[2];
#pragma unroll
                for (int bj = 0; bj < 2; ++bj) { const f32x4 v0 = acc[ai][bj][m][0], v1 = acc[ai][bj][m][1];
                    wb[bj].x = pk_f16(v0[0], v0[1]); wb[bj].y = pk_f16(v0[2], v0[3]); wb[bj].z = pk_f16(v1[0], v1[1]); wb[bj].w = pk_f16(v1[2], v1[3]); }
                u32x4 ev, od; pair_rows(wb[0], wb[1], fr & 1, ev, od);
                unsigned short* pp = base + (size_t)(row - (fr & 1)) * 256 + colb + (fr & 1) * 32;
                st_wt16(pp, ev); st_wt16(pp + 256, od); }
    }
};
struct RouterSched {
    static constexpr bool HALFSKIP = false;
    const char* A; const char* Bt; int G, c;
    __device__ __forceinline__ bool next(int i, pg8::Unit& u) const {
        const int L = i * G + c; if (L >= 256) return false;
        const int pm = L >> 2, ks = L & 3;
        u.a = A + (size_t)pm * 256 * 2048 + ks * 512; u.b = Bt + ks * 512; u.rows = nullptr; u.pm = pm; u.pn = 0; u.aux = ks; u.nvalid = 256; return true;
    }
};
struct EpiGU {
    static constexpr bool PERM = true;
    unsigned char* ACT;
    __device__ __forceinline__ bool keep(const pg8::Unit&) const { return false; }
    __device__ __forceinline__ void operator()(f32x4 (&acc)[2][2][4][2], const pg8::Unit& u, int wr, int wc, int fr, int fq) const {
        const int rl0 = wr * 64 + fr, col = u.pn * 128 + wc * 32 + 8 * fq;
        constexpr float is = 1.0f / WGU_SCALE;
#pragma unroll
        for (int ai = 0; ai < 2; ++ai)
#pragma unroll
            for (int m = 0; m < 4; ++m) {
                const int rl = rl0 + ai * 128 + m * 16;
                f32x4 v0, v1;
#pragma unroll
                for (int j = 0; j < 4; ++j) { const float a0 = acc[ai][0][m][0][j] * is, a1 = acc[ai][0][m][1][j] * is;
                    v0[j] = a0 * sigmoidf_(a0) * (acc[ai][1][m][0][j] * is); v1[j] = a1 * sigmoidf_(a1) * (acc[ai][1][m][1][j] * is); }
                *(u32x2*)(ACT + ((size_t)u.pm * 256 + rl) * EFF + col) = (u32x2){pk4_fp8(v0[0], v0[1], v0[2], v0[3]), pk4_fp8(v1[0], v1[1], v1[2], v1[3])};
                asm volatile("" ::: "memory");
            }
    }
};
struct EpiDown {
    static constexpr bool PERM = true;
    static constexpr bool BJADJ = true;
    unsigned char* YBUF; const float* GATEW;
    __device__ __forceinline__ bool keep(const pg8::Unit&) const { return false; }
    __device__ __forceinline__ void operator()(f32x4 (&acc)[2][2][4][2], const pg8::Unit& u, int wr, int wc, int fr, int fq) const {
        const int rl0 = wr * 64 + fr, colw = u.pn * 256 + wc * 64 + (fq & 1) * 32 + (fq >> 1) * 16;
        const bool odd = fq & 1;
#pragma unroll
        for (int ai = 0; ai < 2; ++ai)
#pragma unroll
            for (int m = 0; m < 4; ++m) {
                const int rl = rl0 + ai * 128 + m * 16;
                const bool ok = rl < u.nvalid;
                int slot = 0; float gw = 0.f;
                if (ok) { slot = u.rows[rl]; gw = GATEW[slot] * (YSCALE / WD_SCALE); }
                u32x2 p[2];
#pragma unroll
                for (int bj = 0; bj < 2; ++bj) { const f32x4 v0 = acc[ai][bj][m][0] * gw, v1 = acc[ai][bj][m][1] * gw;
                    p[bj] = (u32x2){pk4_fp8(v0[0], v0[1], v0[2], v0[3]), pk4_fp8(v1[0], v1[1], v1[2], v1[3])}; }
                const u32x2 snd = odd ? p[0] : p[1];
                u32x2 rcv; rcv.x = (unsigned)__shfl_xor((int)snd.x, 16); rcv.y = (unsigned)__shfl_xor((int)snd.y, 16);
                const u32x4 w = odd ? (u32x4){rcv.x, rcv.y, p[1].x, p[1].y} : (u32x4){p[0].x, p[0].y, rcv.x, rcv.y};
                if (ok) *(u32x4*)(YBUF + (size_t)slot * D + colw) = w;
                asm volatile("" ::: "memory");
            }
    }
};

#define MFMA16(a, b, c) __builtin_amdgcn_mfma_f32_16x16x32_bf16((a), (b), (c), 0, 0, 0)
#define MFMA32(a, b, c) __builtin_amdgcn_mfma_f32_32x32x16_bf16((a), (b), (c), 0, 0, 0)
__device__ __forceinline__ s16x4 tr16(const LAS unsigned char* p) { return __builtin_amdgcn_ds_read_tr16_b64_v4i16((LAS s16x4*)p); }
__device__ __forceinline__ bf16x8 cat8(s16x4 a, s16x4 b) { bf16x8 r; r[0] = a[0]; r[1] = a[1]; r[2] = a[2]; r[3] = a[3]; r[4] = b[0]; r[5] = b[1]; r[6] = b[2]; r[7] = b[3]; return r; }
__device__ __forceinline__ u32x4 pack8(const float (&v)[8]) { u32x4 w; w.x = pg8::cvt_pk_bf16(v[0], v[1]); w.y = pg8::cvt_pk_bf16(v[2], v[3]); w.z = pg8::cvt_pk_bf16(v[4], v[5]); w.w = pg8::cvt_pk_bf16(v[6], v[7]); return w; }
__device__ __forceinline__ void unpack8(u32x4 w, float (&v)[8]) { v[0] = bflo(w.x); v[1] = bfhi(w.x); v[2] = bflo(w.y); v[3] = bfhi(w.y); v[4] = bflo(w.z); v[5] = bfhi(w.z); v[6] = bflo(w.w); v[7] = bfhi(w.w); }
__device__ __forceinline__ int swzA(int row) { return (row & 3) | (((row >> 3) & 1) << 2); }
__device__ __forceinline__ void hgrn_kv_unit(Ctx& X, int bn) {
    const int t0 = bn * 64;
    const bf16_t* PROJ = WSP(bf16_t, WS_PROJ); const float* BC = WSP(float, WS_LOGF);
#pragma unroll 2
    for (int j = 0; j < 8; ++j) {
        const int p = X.tid + NTHREADS * j, row = p >> 6, c64 = p & 63, h = c64 >> 4, ch = c64 & 15;
        const size_t prow = (size_t)(t0 + row) * INW + h * 128 + 8 * ch;
        const u32x4 kraw = *(const u32x4*)(PROJ + prow + C_HK), vraw = *(const u32x4*)(PROJ + prow + C_HV);
        const float* bp = BC + (size_t)(t0 + row) * 512 + h * 128 + 8 * ch; const float* bl = BC + (size_t)(t0 + 63) * 512 + h * 128 + 8 * ch;
        const f32x4 b0 = *(const f32x4*)bp, b1 = *(const f32x4*)(bp + 4), l0 = *(const f32x4*)bl, l1 = *(const f32x4*)(bl + 4);
        float kv[8]; unpack8(kraw, kv);
#pragma unroll
        for (int e = 0; e < 4; ++e) { kv[e] *= __expf(l0[e] - b0[e]); kv[4 + e] *= __expf(l1[e] - b1[e]); }
        const int off = row * 256 + (((ch >> 1) ^ swzA(row)) * 32) + (ch & 1) * 16;
        *(LAS u32x4*)(X.lds + h * 32768 + off) = vraw; *(LAS u32x4*)(X.lds + h * 32768 + 16384 + off) = pack8(kv);
    }
    WSP(float, WS_DECAY)[bn * 512 + X.tid] = __expf(BC[(size_t)(t0 + 63) * 512 + X.tid]);
    __syncthreads();
    const int l = X.lane, w = X.wave, fr = l & 15, fq = l >> 4, r = fr >> 2, p4 = l & 3, h = w >> 1, vt0 = 4 * (w & 1);
    const LAS unsigned char* VI = X.lds + h * 32768; const LAS unsigned char* KI = VI + 16384;
    bf16x8 af[4][2];
#pragma unroll
    for (int vt = 0; vt < 4; ++vt)
#pragma unroll
        for (int kk = 0; kk < 2; ++kk) { const int r0 = 32 * kk + 8 * fq + r, r1 = r0 + 4;
            af[vt][kk] = cat8(tr16(VI + r0 * 256 + (((vt0 + vt) ^ swzA(r0)) * 32) + p4 * 8), tr16(VI + r1 * 256 + (((vt0 + vt) ^ swzA(r1)) * 32) + p4 * 8)); }
    bf16_t* KVT = WSP(bf16_t, WS_KVT) + (size_t)(bn * 4 + h) * 16384;
#pragma unroll 2
    for (int ct = 0; ct < 8; ++ct) {
        bf16x8 bfr[2];
#pragma unroll
        for (int kk = 0; kk < 2; ++kk) { const int r0 = 32 * kk + 8 * fq + r, r1 = r0 + 4;
            bfr[kk] = cat8(tr16(KI + r0 * 256 + ((ct ^ swzA(r0)) * 32) + p4 * 8), tr16(KI + r1 * 256 + ((ct ^ swzA(r1)) * 32) + p4 * 8)); }
#pragma unroll
        for (int vt = 0; vt < 4; ++vt) { f32x4 acc = {0.f, 0.f, 0.f, 0.f}; acc = MFMA16(bfr[0], af[vt][0], acc); acc = MFMA16(bfr[1], af[vt][1], acc);
            u32x2 wv; wv.x = pg8::cvt_pk_bf16(acc[0], acc[1]); wv.y = pg8::cvt_pk_bf16(acc[2], acc[3]);
            *(u32x2*)(KVT + (16 * (vt0 + vt) + fr) * 128 + 16 * ct + 4 * fq) = wv; }
    }
    __syncthreads();
}
__device__ __forceinline__ void hgrn_passB(Ctx& X) {
    const unsigned* KVT = WSP(unsigned, WS_KVT); const float* DECAY = WSP(float, WS_DECAY); unsigned* SPT = WSP(unsigned, WS_SPT);
    const int gt = X.wg * NTHREADS + X.tid, NGT = X.G * NTHREADS;
    for (int item = gt; item < 16 * 128 * 64; item += NGT) {
        const int bh = item >> 13, rem = item & 8191, vd = rem >> 6, c = (rem & 63) * 2, b = bh >> 2, h = bh & 3;
        float s0 = 0.f, s1 = 0.f;
#pragma unroll 8
        for (int n = 0; n < 64; ++n) {
            const int unit = (b * 64 + n) * 4 + h;
            const unsigned kw = KVT[((size_t)unit * 16384 + vd * 128 + c) >> 1]; const f32x2 kv = {bflo(kw), bfhi(kw)};
            const f32x2 dc = *(const f32x2*)(DECAY + unit * 128 + c);
            SPT[((size_t)unit * 16384 + vd * 128 + c) >> 1] = pk2(s0, s1);
            s0 = dc.x * s0 + kv.x; s1 = dc.y * s1 + kv.y;
        }
    }
}
__device__ __forceinline__ void hgrn_out_unit(Ctx& X, int u2) {
    const int bn = u2 >> 1, hp = u2 & 1, t0 = bn * 64;
    const bf16_t* PROJ = WSP(bf16_t, WS_PROJ); const float* BCg = WSP(float, WS_LOGF);
#pragma unroll 2
    for (int j = 0; j < 4; ++j) { const int p = X.tid + NTHREADS * j, row = p >> 5, c32 = p & 31, hh = c32 >> 4, ch = c32 & 15, h = 2 * hp + hh;
        const size_t prow = (size_t)(t0 + row) * INW + h * 128 + 8 * ch;
        const u32x4 qraw = *(const u32x4*)(PROJ + prow + C_HQ), kraw = *(const u32x4*)(PROJ + prow + C_HK), vraw = *(const u32x4*)(PROJ + prow + C_HV);
        const float* bp = BCg + (size_t)(t0 + row) * 512 + h * 128 + 8 * ch; const float* br = BCg + (size_t)(t0 + 32) * 512 + h * 128 + 8 * ch;
        const f32x4 b0 = *(const f32x4*)bp, b1 = *(const f32x4*)(bp + 4), r0 = *(const f32x4*)br, r1 = *(const f32x4*)(br + 4);
        float qv[8], kv[8], a[8], bq[8]; unpack8(qraw, qv); unpack8(kraw, kv);
#pragma unroll
        for (int e = 0; e < 4; ++e) { const float e0 = __expf(b0[e] - r0[e]), e1 = __expf(b1[e] - r1[e]);
            a[e] = qv[e] * e0; a[4 + e] = qv[4 + e] * e1; kv[e] *= __builtin_amdgcn_rcpf(e0); kv[4 + e] *= __builtin_amdgcn_rcpf(e1);
            bq[e] = qv[e] * __expf(b0[e]); bq[4 + e] = qv[4 + e] * __expf(b1[e]); }
        LAS unsigned char* hb = X.lds + hh * 65536; const int o16 = row * 256 + ((ch ^ (row & 15)) * 16);
        *(LAS u32x4*)(hb + o16) = pack8(a); *(LAS u32x4*)(hb + 16384 + o16) = pack8(kv); *(LAS u32x4*)(hb + 32768 + o16) = pack8(bq);
        *(LAS u32x4*)(hb + 49152 + row * 256 + (((ch >> 1) ^ (row & 7)) * 32) + (ch & 1) * 16) = vraw; }
    const int l = X.lane, w = X.wave, fr = l & 15, fq = l >> 4, r = fr >> 2, p4 = l & 3, hh = w >> 2, h = 2 * hp + hh, ti = w & 3;
    const int tq = 16 * ti + fr;
    const bf16_t* SPT = WSP(bf16_t, WS_SPT) + (size_t)(bn * 4 + h) * 16384;
    __syncthreads();
    const LAS unsigned char* QSI = X.lds + hh * 65536; const LAS unsigned char* KSI = QSI + 16384; const LAS unsigned char* QNI = QSI + 32768; const LAS unsigned char* VI = QSI + 49152;
    bf16x8 QS[4];
#pragma unroll
    for (int ks = 0; ks < 4; ++ks) QS[ks] = *(const LAS bf16x8*)(QSI + tq * 256 + (((4 * ks + fq) ^ (tq & 15)) * 16));
    f32x4 ST[4];
#pragma unroll
    for (int si = 0; si < 4; ++si) {
        f32x4 acc = {0.f, 0.f, 0.f, 0.f};
        if (si <= ti) {
            const int sr = 16 * si + fr;
#pragma unroll
            for (int ks = 0; ks < 4; ++ks) { const bf16x8 kf = *(const LAS bf16x8*)(KSI + sr * 256 + (((4 * ks + fq) ^ (sr & 15)) * 16)); acc = MFMA16(kf, QS[ks], acc); }
            if (si == ti) {
#pragma unroll
                for (int q = 0; q < 4; ++q) acc[q] = (4 * fq + q <= fr) ? acc[q] : 0.f; }
        }
        ST[si] = acc;
    }
    f32x4 o[8];
#pragma unroll
    for (int vt = 0; vt < 8; ++vt) o[vt] = (f32x4){0.f, 0.f, 0.f, 0.f};
#pragma unroll
    for (int kk = 0; kk < 2; ++kk) {
        if (2 * kk <= ti) {
            float pv[8];
#pragma unroll
            for (int q = 0; q < 4; ++q) { pv[q] = ST[2 * kk][q]; pv[4 + q] = ST[2 * kk + 1][q]; }
            const bf16x8 pf = __builtin_bit_cast(bf16x8, pack8(pv));
            const int r0 = 32 * kk + 4 * fq + r, r1 = r0 + 16;
#pragma unroll
            for (int vt = 0; vt < 8; ++vt) { const bf16x8 va = cat8(tr16(VI + r0 * 256 + ((vt ^ (r0 & 7)) * 32) + p4 * 8), tr16(VI + r1 * 256 + ((vt ^ (r1 & 7)) * 32) + p4 * 8));
                o[vt] = MFMA16(va, pf, o[vt]); }
        }
    }
#pragma unroll
    for (int ks = 0; ks < 4; ++ks) { const bf16x8 qn = *(const LAS bf16x8*)(QNI + tq * 256 + (((4 * ks + fq) ^ (tq & 15)) * 16));
#pragma unroll
        for (int vt = 0; vt < 8; ++vt) { const bf16x8 sa = *(const bf16x8*)(SPT + (16 * vt + fr) * 128 + 32 * ks + 8 * fq); o[vt] = MFMA16(sa, qn, o[vt]); } }
    float ss = 0.f;
#pragma unroll
    for (int vt = 0; vt < 8; ++vt) ss += (o[vt][0] * o[vt][0] + o[vt][1] * o[vt][1]) + (o[vt][2] * o[vt][2] + o[vt][3] * o[vt][3]);
    ss += __shfl_xor(ss, 16); ss += __shfl_xor(ss, 32);
    const float rstd = rsqrtf(ss * (1.f / 128.f) + EPS);
    bf16_t* YCAT = WSP(bf16_t, WS_YCAT);
#pragma unroll
    for (int vt = 0; vt < 8; ++vt) { const int vd = 16 * vt + 4 * fq;
        const u32x2 sg = *(const u32x2*)(PROJ + (size_t)(t0 + tq) * INW + C_HG + h * 128 + vd); const f32x4 gn = *(const f32x4*)(X.g_hgrn + h * 128 + vd);
        u32x2 wv; wv.x = pg8::cvt_pk_bf16(o[vt][0] * rstd * gn[0] * bflo(sg.x), o[vt][1] * rstd * gn[1] * bfhi(sg.x)); wv.y = pg8::cvt_pk_bf16(o[vt][2] * rstd * gn[2] * bflo(sg.y), o[vt][3] * rstd * gn[3] * bfhi(sg.y));
        *(u32x2*)(YCAT + (size_t)(t0 + tq) * D + h * 128 + vd) = wv; }
    __syncthreads();
}

template <bool HI> __device__ __forceinline__ unsigned fp8x2_bf16_(unsigned w) { const auto f = __builtin_amdgcn_cvt_pk_f32_fp8((int)w, HI); return pg8::cvt_pk_bf16(f[0], f[1]); }
__device__ __forceinline__ unsigned fp8x2_bf16(unsigned w, bool hi) { return hi ? fp8x2_bf16_<true>(w) : fp8x2_bf16_<false>(w); }
struct AttnRegs { u32x4 k[3], v[3]; long q[4]; };
__device__ __forceinline__ void attn_load(Ctx& X, int unit, AttnRegs& R) {
    const int u16 = unit & 15, h = (unit >> 4) & 7, g = (unit >> 7) % 3, b = unit / 384;
    const int d = g == 0 ? 1 : g == 1 ? 4 : 16, nblk = 16 / d, r = u16 / nblk, blk = u16 % nblk;
    const int vcol = C_AV + g * 512 + h * 64;
    const int mk0 = blk * 256 - 128;
    const unsigned char* QK8 = WSP(unsigned char, WS_QK8);
    const int q8col = g * 512 + h * 64, k8col = 1536 + q8col, v8col = 3072 + q8col;
#pragma unroll
    for (int j = 0; j < 3; ++j) { const int idx = X.tid + NTHREADS * j, row = idx >> 2, ch = idx & 3, m = mk0 + row > 0 ? mk0 + row : 0;
        const size_t tok = (size_t)b * SEQ + (size_t)m * d + r; R.k[j] = *(const u32x4*)(QK8 + tok * 4608 + k8col + ch * 16); R.v[j] = *(const u32x4*)(QK8 + tok * 4608 + v8col + ch * 16); }
    const int l = X.lane, w = X.wave, q = l & 31, hi = l >> 5;
    const size_t tokq = (size_t)b * SEQ + (size_t)(blk * 256 + 32 * w + q) * d + r;
#pragma unroll
    for (int ds = 0; ds < 4; ++ds) R.q[ds] = *(const long*)(QK8 + tokq * 4608 + q8col + ds * 16 + hi * 8);
}
__device__ __forceinline__ void attn_stage(Ctx& X, const AttnRegs& R) {
    LAS unsigned char* KL = X.lds; LAS unsigned char* VL = X.lds + 55296;
#pragma unroll
    for (int j = 0; j < 3; ++j) { const int idx = X.tid + NTHREADS * j, row = idx >> 2, ch = idx & 3;
        *(LAS u32x4*)(KL + row * 80 + ch * 16) = R.k[j];
        u32x4 lo, hi2;
        lo.x = fp8x2_bf16(R.v[j].x, false); lo.y = fp8x2_bf16(R.v[j].x, true); lo.z = fp8x2_bf16(R.v[j].y, false); lo.w = fp8x2_bf16(R.v[j].y, true);
        hi2.x = fp8x2_bf16(R.v[j].z, false); hi2.y = fp8x2_bf16(R.v[j].z, true); hi2.z = fp8x2_bf16(R.v[j].w, false); hi2.w = fp8x2_bf16(R.v[j].w, true);
        *(LAS u32x4*)(VL + row * 128 + ch * 32) = lo; *(LAS u32x4*)(VL + row * 128 + ch * 32 + 16) = hi2; }
    LAS long* QL = (LAS long*)(X.lds + 104448 + X.tid * 32);
    QL[0] = R.q[0]; QL[1] = R.q[1]; QL[2] = R.q[2]; QL[3] = R.q[3];
}
__device__ __forceinline__ void attn_compute(Ctx& X, int unit) {
    const int u16 = unit & 15, h = (unit >> 4) & 7, g = (unit >> 7) % 3, b = unit / 384;
    const int d = g == 0 ? 1 : g == 1 ? 4 : 16, nblk = 16 / d, r = u16 / nblk, blk = u16 % nblk;
    const int mk0 = blk * 256 - 128;
    LAS unsigned char* KL = X.lds; LAS unsigned char* VL = X.lds + 55296;
    const int l = X.lane, w = X.wave, q = l & 31, hi = l >> 5;
    const size_t tokq = (size_t)b * SEQ + (size_t)(blk * 256 + 32 * w + q) * d + r;
    long qf[4];
    { const LAS long* QL = (const LAS long*)(X.lds + 104448 + X.tid * 32); qf[0] = QL[0]; qf[1] = QL[1]; qf[2] = QL[2]; qf[3] = QL[3]; }
    f32x16 s[5];
#pragma unroll
    for (int kt = 0; kt < 5; ++kt) {
        f32x16 acc;
#pragma unroll
        for (int i = 0; i < 16; ++i) acc[i] = 0.f;
#pragma unroll
        for (int ds = 0; ds < 4; ++ds) { const long kf = *(const LAS long*)(KL + (32 * w + 32 * kt + q) * 80 + ds * 16 + hi * 8); acc = __builtin_amdgcn_mfma_f32_32x32x16_fp8_fp8(kf, qf[ds], acc, 0, 0, 0); }
        s[kt] = acc;
    }
    const int iq = 32 * w + q;
    const int jmin = iq > -mk0 ? iq : -mk0;
    const int tlo = jmin - (32 * w + 4 * hi), thi = iq + 128 - (32 * w + 128 + 4 * hi), tst = -mk0 - (32 * w + 4 * hi);
    float mx = -INFINITY;
#pragma unroll
    for (int kt = 0; kt < 5; ++kt) {
        const bool chk = kt == 0 || kt == 4 || (32 * w + 32 * kt < -mk0);
        if (chk) {
#pragma unroll
            for (int rg = 0; rg < 16; ++rg) { const int c = (rg & 3) + 8 * (rg >> 2);
                const bool valid = kt == 0 ? (c >= tlo) : kt == 4 ? (c <= thi) : (c + 32 * kt >= tst);
                s[kt][rg] = valid ? s[kt][rg] : -INFINITY; if ((rg & 3) == 3) __builtin_amdgcn_sched_barrier(0); }
        }
#pragma unroll
        for (int rg = 0; rg < 16; ++rg) mx = fmaxf(mx, s[kt][rg]);
    }
    mx = fmaxf(mx, __shfl_xor(mx, 32));
    const float c2 = 0.125f * 1.4426950408889634f, mxs = mx * c2;
    float lsum = 0.f;
#pragma unroll
    for (int kt = 0; kt < 5; ++kt)
#pragma unroll
        for (int rg = 0; rg < 16; ++rg) { const float p = __builtin_amdgcn_exp2f(__builtin_fmaf(s[kt][rg], c2, -mxs)); s[kt][rg] = p; lsum += p; }
    lsum += __shfl_xor(lsum, 32);
    f32x16 o[2];
#pragma unroll
    for (int dt = 0; dt < 2; ++dt)
#pragma unroll
        for (int i = 0; i < 16; ++i) o[dt][i] = 0.f;
    const int vlane = ((l & 15) >> 2) * 128 + (((l >> 4) & 1) * 16 + (l & 3) * 4) * 2;
#pragma unroll
    for (int kt = 0; kt < 5; ++kt)
#pragma unroll
        for (int s2 = 0; s2 < 2; ++s2) {
            bf16x8 pb;
#pragma unroll
            for (int j = 0; j < 8; j += 2) { const unsigned pw = pg8::cvt_pk_bf16(s[kt][8 * s2 + j], s[kt][8 * s2 + j + 1]); pb[j] = (short)(pw & 0xffffu); pb[j + 1] = (short)(pw >> 16); }
            const int key0 = 32 * w + 32 * kt + 16 * s2 + 4 * hi;
#pragma unroll
            for (int dt = 0; dt < 2; ++dt) {
                LAS unsigned char* vp = VL + key0 * 128 + dt * 64 + vlane;
                const s16x4 t0 = __builtin_amdgcn_ds_read_tr16_b64_v4i16((LAS s16x4*)vp);
                const s16x4 t1 = __builtin_amdgcn_ds_read_tr16_b64_v4i16((LAS s16x4*)(vp + 8 * 128));
                bf16x8 va; va[0] = t0[0]; va[1] = t0[1]; va[2] = t0[2]; va[3] = t0[3]; va[4] = t1[0]; va[5] = t1[1]; va[6] = t1[2]; va[7] = t1[3];
                o[dt] = MFMA32(va, pb, o[dt]);
            }
        }
    const float inv = 1.0f / lsum;
    bf16_t* OG = WSP(bf16_t, WS_OG) + (size_t)g * T * 512;
#pragma unroll
    for (int dt = 0; dt < 2; ++dt)
#pragma unroll
        for (int rg = 0; rg < 4; ++rg) { const int d0 = 32 * dt + 8 * rg + 4 * hi;
            u32x2 wv; wv.x = pg8::cvt_pk_bf16(o[dt][4 * rg] * inv, o[dt][4 * rg + 1] * inv); wv.y = pg8::cvt_pk_bf16(o[dt][4 * rg + 2] * inv, o[dt][4 * rg + 3] * inv);
            *(u32x2*)(OG + tokq * 512 + h * 64 + d0) = wv; }
    WSP(float, WS_LSE)[((size_t)g * T + tokq) * 8 + h] = mx * 0.125f + __logf(lsum);
}
__device__ __forceinline__ void attn_combine(Ctx& X) {
    const bf16_t* OG = WSP(bf16_t, WS_OG); const float* LSE = WSP(float, WS_LSE); bf16_t* YCAT = WSP(bf16_t, WS_YCAT);
    const int gt = X.wg * NTHREADS + X.tid, NGT = X.G * NTHREADS;
    for (int item = gt; item < T * 64; item += NGT) {
        const int t = item >> 6, ch = item & 63, h = ch >> 3;
        const float l0 = LSE[(size_t)t * 8 + h], l1 = LSE[((size_t)T + t) * 8 + h], l2 = LSE[((size_t)2 * T + t) * 8 + h];
        const float m = fmaxf(l0, fmaxf(l1, l2)); float w0 = __expf(l0 - m), w1 = __expf(l1 - m), w2 = __expf(l2 - m); const float inv = 1.f / (w0 + w1 + w2); w0 *= inv; w1 *= inv; w2 *= inv;
        const u32x4 a = *(const u32x4*)(OG + (size_t)t * 512 + ch * 8), bq = *(const u32x4*)(OG + ((size_t)T + t) * 512 + ch * 8), cq = *(const u32x4*)(OG + ((size_t)2 * T + t) * 512 + ch * 8);
        u32x4 o;
#pragma unroll
        for (int j = 0; j < 4; ++j) o[j] = pk2(w0 * bflo(a[j]) + w1 * bflo(bq[j]) + w2 * bflo(cq[j]), w0 * bfhi(a[j]) + w1 * bfhi(bq[j]) + w2 * bfhi(cq[j]));
        *(u32x4*)(YCAT + (size_t)t * D + 512 + ch * 8) = o;
    }
}

__device__ __forceinline__ unsigned sortable_key(float f) { const unsigned u = __builtin_bit_cast(unsigned, f); return (u & 0x80000000u) ? ~u : (u | 0x80000000u); }
__device__ __forceinline__ void moe_route(Ctx& X, bool local) {
    const unsigned short* LG = WSP(unsigned short, WS_KVT); unsigned* CNT = WSP(unsigned, WS_CTL) + CW_CNT; int* LISTS = WSP(int, WS_LISTS); float* GATEW = WSP(float, WS_GATEW);
    const int gw = X.wg * NWAVES + X.wave, NGW = X.G * NWAVES, l = X.lane, grp = l >> 3;
    const f32x4 bias = *(const f32x4*)(X.rbias + 4 * l);
    const unsigned long long ltmask = (1ull << l) - 1ull;
    const int tbeg = local ? X.wg * 64 + X.wave : gw, tend = local ? X.wg * 64 + 64 : T, tstep = local ? NWAVES : NGW;
    for (int t = tbeg; t < tend; t += tstep) {
        f32x4 lg = {0.f, 0.f, 0.f, 0.f};
#pragma unroll
        for (int ks = 0; ks < 4; ++ks) { const u32x2 w = *(const u32x2*)(LG + ((size_t)ks * T + t) * 256 + 4 * l); lg += (f32x4){f16lo(w.x), f16hi(w.x), f16lo(w.y), f16hi(w.y)}; }
        float sc[4], mb[4];
#pragma unroll
        for (int i = 0; i < 4; ++i) { sc[i] = sigmoidf_(lg[i]); mb[i] = sc[i] + bias[i]; }
        float m1 = fmaxf(mb[0], mb[1]), m2 = fminf(mb[0], mb[1]);
        { const float a1 = fmaxf(mb[2], mb[3]), a2 = fminf(mb[2], mb[3]); const float n1 = fmaxf(m1, a1), n2 = fmaxf(fminf(m1, a1), fmaxf(m2, a2)); m1 = n1; m2 = n2; }
#pragma unroll
        for (int o = 1; o < 8; o <<= 1) { const float a1 = __shfl_xor(m1, o), a2 = __shfl_xor(m2, o); const float n1 = fmaxf(m1, a1), n2 = fmaxf(fminf(m1, a1), fmaxf(m2, a2)); m1 = n1; m2 = n2; }
        const float gs = m1 + m2;
        int rank = 0;
#pragma unroll
        for (int gg = 0; gg < 8; ++gg) { const float og = __builtin_bit_cast(float, __builtin_amdgcn_readlane(__builtin_bit_cast(int, gs), gg * 8)); rank += (og > gs || (og == gs && gg < grp)) ? 1 : 0; }
        const bool sel = rank < 4;
        unsigned key[4];
#pragma unroll
        for (int i = 0; i < 4; ++i) key[i] = sel ? sortable_key(mb[i]) : 0u;
        unsigned pre = 0u;
#pragma unroll 1
        for (int bit = 31; bit >= 0; --bit) { const unsigned cand = pre | (1u << bit);
            const int cnt = __popcll(__ballot(key[0] >= cand)) + __popcll(__ballot(key[1] >= cand)) + __popcll(__ballot(key[2] >= cand)) + __popcll(__ballot(key[3] >= cand));
            if (cnt >= TOPK) pre = cand; }
        int ngt = 0, eqb = 0, tkb = 0; bool take[4];
#pragma unroll
        for (int i = 0; i < 4; ++i) ngt += __popcll(__ballot(key[i] > pre));
        const int need = TOPK - ngt;
#pragma unroll
        for (int i = 0; i < 4; ++i) eqb += __popcll(__ballot(key[i] == pre) & ltmask);
        int eqrun = eqb;
#pragma unroll
        for (int i = 0; i < 4; ++i) { const bool eq = key[i] == pre; take[i] = (key[i] > pre) || (eq && eqrun < need); eqrun += eq ? 1 : 0; }
#pragma unroll
        for (int i = 0; i < 4; ++i) tkb += __popcll(__ballot(take[i]) & ltmask);
        float part = 0.f;
#pragma unroll
        for (int i = 0; i < 4; ++i) part += take[i] ? sc[i] : 0.f;
        const float scale = 2.5f / wave_sum(part);
        int slot = tkb;
#pragma unroll
        for (int i = 0; i < 4; ++i) if (take[i]) { const int e = 4 * l + i; const unsigned pos = atomicAdd(&CNT[e * 64], 1u); LISTS[(size_t)e * 16384 + pos] = t * NSLOT + slot; GATEW[t * NSLOT + slot] = sc[i] * scale; ++slot; }
        if (l == 0) { LISTS[(size_t)NE * 16384 + t] = t * NSLOT + TOPK; GATEW[t * NSLOT + TOPK] = 1.0f; }
    }
}
__device__ __forceinline__ int moe_table(Ctx& X) {
    LAS int* tbl = (LAS int*)(X.lds + TBL_OFF); LAS int* cnts = (LAS int*)(X.lds + TCNT_OFF); LAS int* pref = cnts + 320;
    const unsigned* CNT = WSP(unsigned, WS_CTL) + CW_CNT;
    const int x = X.wg & 7;
    if (X.tid < NEX) cnts[X.tid] = X.tid < NE ? (int)__hip_atomic_load(CNT + X.tid * 64, __ATOMIC_RELAXED, __HIP_MEMORY_SCOPE_AGENT) : T;
    __syncthreads();
    if (X.tid < NEX) { int pre = 0; for (int e = 0; e < X.tid; ++e) pre += (cnts[e] + 255) >> 8; pref[X.tid] = pre; }
    __syncthreads();
    if (X.tid < 33) {
        const int i = X.tid; int lp = 0; for (int k = 0; k < i && k < 32; ++k) lp += (cnts[x + 8 * k] + 255) >> 8;
        if (i < 32) { const int e = x + 8 * i, n = (cnts[e] + 255) >> 8, p0 = pref[e]; for (int r = 0; r < n; ++r) tbl[lp + r] = ((p0 + r) << 16) | (e << 7) | r; }
        else { const int p0 = pref[NE]; for (int r8 = 0; r8 < 8; ++r8) { const int r = 8 * x + r8; tbl[lp + r8] = ((p0 + r) << 16) | (NE << 7) | r; } cnts[600] = lp + 8; }
    }
    __syncthreads();
    return __builtin_amdgcn_readfirstlane(cnts[600]);
}
__device__ __forceinline__ void final_rows(Ctx& X) {
    const bf16_t* X1 = WSP(bf16_t, WS_X1); const float* MOD = WSP(float, WS_MOD); const unsigned char* YBUF = WSP(unsigned char, WS_YBUF);
    const int gw = X.wg * NWAVES + X.wave, NGW = X.G * NWAVES, l = X.lane;
    for (int t = gw; t < T; t += NGW) {
        const int b = t / SEQ; f32x4 v[2][2]; float s = 0.f;
#pragma unroll
        for (int j = 0; j < 2; ++j) { const int col = 8 * l + 512 * j; f32x4 m0 = {0.f, 0.f, 0.f, 0.f}, m1 = {0.f, 0.f, 0.f, 0.f};
#pragma unroll
            for (int k = 0; k < NSLOT; ++k) { const u32x2 y = *(const u32x2*)(YBUF + ((size_t)t * NSLOT + k) * D + col);
                const f32x2 a = __builtin_amdgcn_cvt_pk_f32_fp8((int)y.x, false), bq = __builtin_amdgcn_cvt_pk_f32_fp8((int)y.x, true), c = __builtin_amdgcn_cvt_pk_f32_fp8((int)y.y, false), d = __builtin_amdgcn_cvt_pk_f32_fp8((int)y.y, true);
                m0.x += a[0]; m0.y += a[1]; m0.z += bq[0]; m0.w += bq[1]; m1.x += c[0]; m1.y += c[1]; m1.z += d[0]; m1.w += d[1]; }
            const f32x4 g0 = *(const f32x4*)(MOD + b * 6144 + 5120 + col) * (1.0f / YSCALE), g1 = *(const f32x4*)(MOD + b * 6144 + 5120 + col + 4) * (1.0f / YSCALE);
            const u32x4 xw = *(const u32x4*)(X1 + (size_t)t * D + col); const f32x4 x0 = {bflo(xw.x), bfhi(xw.x), bflo(xw.y), bfhi(xw.y)}, x1 = {bflo(xw.z), bfhi(xw.z), bflo(xw.w), bfhi(xw.w)};
            v[j][0] = x0 + g0 * m0; v[j][1] = x1 + g1 * m1;
#pragma unroll
            for (int q = 0; q < 2; ++q) s += (v[j][q].x * v[j][q].x + v[j][q].y * v[j][q].y) + (v[j][q].z * v[j][q].z + v[j][q].w * v[j][q].w); }
        const float rstd = rsqrtf(wave_sum(s) * (1.f / D) + EPS);
#pragma unroll
        for (int j = 0; j < 2; ++j) { const int col = 8 * l + 512 * j;
            *(f32x4*)(X.out + (size_t)t * D + col) = v[j][0] * rstd * *(const f32x4*)(X.g_final + col); *(f32x4*)(X.out + (size_t)t * D + col + 4) = v[j][1] * rstd * *(const f32x4*)(X.g_final + col + 4); }
    }
}

__device__ __forceinline__ unsigned* panel_word(Ctx& X, int bank, int pm) { return WSP(unsigned, WS_CTL) + CW_PANEL + (bank * 64 + pm) * 64; }
__device__ __forceinline__ void panel_signal(Ctx& X, int bank, int pm) {
    asm volatile("s_waitcnt vmcnt(0)" ::: "memory"); __syncthreads();
    if (X.tid == 0) (void)xb_add(panel_word(X, bank, pm), 1u);
}
__device__ __forceinline__ void panel_wait(Ctx& X, int bank, int pm, unsigned target) {
    if (X.tid == 0) { unsigned* p = panel_word(X, bank, pm); unsigned sp = 0u;
        while (xb_ld(p) < target) { __builtin_amdgcn_s_sleep(2); if (++sp > (1u << 22)) break; }
        __builtin_amdgcn_fence(__ATOMIC_ACQUIRE, "agent"); asm volatile("s_waitcnt vmcnt(0)" ::: "memory"); }
    __syncthreads();
}

constexpr int NG_INPROJ = 176;
__device__ __forceinline__ void ph_inproj(Ctx& X) {
    const int ng = X.G > NG_INPROJ + 8 ? NG_INPROJ : X.G;
    if (X.wg < ng) {
        RegSched S{(const char*)WSP(bf16_t, WS_H), (const char*)WSP(bf16_t, WS_WIN), (size_t)256 * 2048, (size_t)256 * 2048, T / 256, INW / 256, ng, X.wg};
        EpiInproj E{WSP(bf16_t, WS_PROJ), WSP(float, WS_LOGF), WSP(float, WS_LB), WSP(float, WS_ROPE), WSP(unsigned char, WS_G8), WSP(unsigned char, WS_QK8)};
        pg8::gemm_phase<EpiInproj, RegSched, true, false>(X.lds, 1024, 1024, 1024, S, E);
    }
    if (ng == X.G) expert_convert(X, X.wg, X.G);
    else if (X.wg >= ng) expert_convert(X, X.wg - ng, X.G - ng);
}
__device__ __forceinline__ void ph_mix_a(Ctx& X) {
    for (int it = X.wg; it < 256; it += X.G) hgrn_kv_unit(X, it);
    AttnRegs Ra, Rb; int unit = X.wg;
    auto clampu = [](int u) { return u < 1536 ? u : 1535; };
    attn_load(X, clampu(unit), Ra);
    __builtin_amdgcn_sched_barrier(0);
    attn_load(X, clampu(unit + X.G), Rb);
    __builtin_amdgcn_sched_barrier(0);
#define ATTN_STEP(R_) do { attn_stage(X, R_); __syncthreads(); __builtin_amdgcn_sched_barrier(0); attn_load(X, clampu(unit + 2 * X.G), R_); __builtin_amdgcn_sched_barrier(0); \
        attn_compute(X, unit); __syncthreads(); unit += X.G; } while (0)
    if (unit < 1536) {
        ATTN_STEP(Ra);
        while (unit < 1536) {
            ATTN_STEP(Rb);
            if (unit >= 1536) break;
            ATTN_STEP(Ra);
        }
    }
#undef ATTN_STEP
}
__device__ __forceinline__ void ph_mix_c(Ctx& X) { for (int it = X.wg; it < 512; it += X.G) hgrn_out_unit(X, it); attn_combine(X); }
__device__ __forceinline__ void ph_mixed(Ctx& X, bool chain) {
    TwoPartSched S{(const char*)WSP(bf16_t, WS_YCAT), (const char*)WSP(bf16_t, WS_WPA), (const char*)WSP(bf16_t, WS_WPB), T / 256, D / 256, X.G, X.wg};
    EpiMixed E{WSP(unsigned char, WS_G8), WSP(bf16_t, WS_MIXED)};
    pg8::gemm_phase<EpiMixed, TwoPartSched, false, false>(X.lds, 1024, 512, 512, S, E);
    if (chain) { int pm, pn; pg8::swz_tile(X.wg, T / 256, D / 256, pm, pn); panel_signal(X, 0, pm); }
}
__device__ __forceinline__ void ph_outproj(Ctx& X, bool chain) {
    int pm = 0, pn = 0; pg8::swz_tile(X.wg < 256 ? X.wg : 0, T / 256, D / 256, pm, pn);
    RegSched S{(const char*)WSP(bf16_t, WS_MIXED), (const char*)WSP(bf16_t, WS_WOUT), (size_t)256 * 2048, (size_t)256 * 2048, T / 256, D / 256, X.G, X.wg};
    if (chain) {
        panel_wait(X, 0, pm, 4u);
        EpiOutNorm E{X.x, WSP(float, WS_MOD), X.g2, WSP(bf16_t, WS_X1), WSP(bf16_t, WS_H), WSP(unsigned char, WS_H8), WSP(float, WS_XB), panel_word(X, 1, 0), X.lds + 139264};
        pg8::gemm_phase<EpiOutNorm, RegSched, true, false>(X.lds, 1024, 1024, 1024, S, E);
        panel_signal(X, 2, pm);
    } else {
        EpiOutproj E{X.x, WSP(float, WS_MOD), WSP(bf16_t, WS_X1)};
        pg8::gemm_phase<EpiOutproj, RegSched, false, false>(X.lds, 1024, 1024, 1024, S, E);
    }
}
__device__ __forceinline__ void ph_norm2(Ctx& X, bool chain) { if (!chain) norm_rows(X, 1); }
__device__ __forceinline__ void ph_router(Ctx& X, bool chain) {
    if (chain) panel_wait(X, 2, X.wg >> 2, 4u);
    RouterSched S{(const char*)WSP(bf16_t, WS_H), (const char*)WSP(bf16_t, WS_WR), X.G, X.wg};
    EpiRouter E{WSP(unsigned short, WS_KVT)};
    pg8::gemm_phase<EpiRouter, RouterSched, false, false>(X.lds, 1024, 1024, 256, S, E);
    if (chain) panel_signal(X, 3, X.wg >> 2);
}
__device__ __forceinline__ void ph_route(Ctx& X, bool chain) {
    if (chain) panel_wait(X, 3, X.wg >> 2, 4u);
    moe_route(X, chain);
}
__device__ __forceinline__ void ph_gu(Ctx& X) {
    const int nent = moe_table(X);
    MoeSched S{(const LAS int*)(X.lds + TBL_OFF), (const LAS int*)(X.lds + TCNT_OFF), nent, (const char*)WSP(unsigned char, WS_H8), (const char*)WSP(unsigned char, WS_WGU), WSP(int, WS_LISTS), 2, 256 * 1024, 512 * 1024, 0, X.G, X.wg};
    EpiGU E{WSP(unsigned char, WS_ACT)};
    pg8::gemm_phase<EpiGU, MoeSched, true, true, true>(X.lds, 512, 512, 512, S, E);
}
__device__ __forceinline__ void ph_down(Ctx& X) {
    const int nent = moe_table(X);
    MoeSched S{(const LAS int*)(X.lds + TBL_OFF), (const LAS int*)(X.lds + TCNT_OFF), nent, (const char*)WSP(unsigned char, WS_ACT), (const char*)WSP(unsigned char, WS_WD), WSP(int, WS_LISTS), 4, 256 * 256, 1024 * 256, 256 * 256, X.G, X.wg};
    EpiDown E{WSP(unsigned char, WS_YBUF), WSP(float, WS_GATEW)};
    pg8::gemm_phase<EpiDown, MoeSched, true, false, true>(X.lds, 128, 128, 128, S, E);
}

constexpr int NPHASE = 14;
struct Args { const void* in[20]; float* out; unsigned char* ws; int ph_lo, ph_hi; };
__global__ void __launch_bounds__(NTHREADS, 2) mega_fwd(Args args) {
    extern __shared__ __attribute__((aligned(16))) unsigned char lds_raw[];
    Ctx X;
    X.lds = (LAS unsigned char*)lds_raw;
    X.tid = threadIdx.x; X.lane = X.tid & 63; X.wave = __builtin_amdgcn_readfirstlane(X.tid >> 6); X.wg = blockIdx.x; X.G = gridDim.x;
    X.x = (const float*)args.in[0]; X.c = (const float*)args.in[1]; X.positions = (const int*)args.in[2]; X.w_ada = (const float*)args.in[3]; X.b_ada = (const float*)args.in[4];
    X.g1 = (const float*)args.in[5]; X.w_in = (const float*)args.in[6]; X.lb_logits = (const float*)args.in[7]; X.g_hgrn = (const float*)args.in[8]; X.w_pa = (const float*)args.in[9];
    X.w_pb = (const float*)args.in[10]; X.w_out = (const float*)args.in[11]; X.g2 = (const float*)args.in[12]; X.w_router = (const float*)args.in[13]; X.rbias = (const float*)args.in[14];
    X.w_egu = (const float*)args.in[15]; X.w_edown = (const float*)args.in[16]; X.w_sgu = (const float*)args.in[17]; X.w_sdown = (const float*)args.in[18]; X.g_final = (const float*)args.in[19];
    X.out = args.out; X.ws = args.ws;
    volatile LAS unsigned* MISC = (volatile LAS unsigned*)(X.lds + MISC_OFF);
    if (X.tid < 32) MISC[X.tid] = 0u;
    __syncthreads();
    const int lo = args.ph_lo, hi = args.ph_hi;
    XcdBarrier bar; bar.bar = WSP(unsigned, WS_CTL) + CW_BAR; bar.x = 0; bar.st = nullptr;
    if (hi - lo > 1) bar = xcd_barrier_post(WSP(unsigned, WS_CTL) + CW_BAR, MISC + 8);
#ifndef PH_MASK
#define PH_MASK 0xffffffffu
#endif
#define IN(k) ((((PH_MASK) >> (k)) & 1u) && lo <= (k) && (k) < hi)
#ifndef REPEAT_MASK
#define REPEAT_MASK 0u
#endif
#define SEAM(k) do { if (IN(k) && IN((k) + 1)) xcd_barrier(bar); } while (0)
#define RUN(k, call) do { if (IN(k)) { call; if (((REPEAT_MASK) >> (k)) & 1u) { xcd_barrier(bar); call; } } } while (0)

    const bool p01 = IN(0) && IN(1);
    RUN(0, p0_prologue(X));
    if (p01) { asm volatile("s_waitcnt vmcnt(0)" ::: "memory"); __syncthreads(); if (X.tid == 0) (void)xb_add(WSP(unsigned, WS_CTL) + CW_P0 + 64 * (X.wg & 7), 1u); }
    if (IN(1)) {
        small_transposes(X);
        if (p01) {
            if (X.tid == 0) { unsigned* p = WSP(unsigned, WS_CTL) + CW_P0; unsigned sp = 0u;
                for (;;) { unsigned sum = 0u;
#pragma unroll
                    for (int j = 0; j < 8; ++j) sum += xb_ld(p + 64 * j);
                    if (sum >= (unsigned)X.G) break;
                    __builtin_amdgcn_s_sleep(2); if (++sp > (1u << 22)) break; }
                __builtin_amdgcn_fence(__ATOMIC_ACQUIRE, "agent"); asm volatile("s_waitcnt vmcnt(0)" ::: "memory"); }
            __syncthreads();
        }
        norm_rows(X, 0);
    }
    SEAM(1);
    RUN(2, ph_inproj(X)); SEAM(2);
    RUN(3, ph_mix_a(X)); SEAM(3);
    RUN(4, hgrn_passB(X)); SEAM(4);
    RUN(5, ph_mix_c(X)); SEAM(5);
    const bool chain = (X.G == 256);
    RUN(6, ph_mixed(X, chain)); if (!chain) SEAM(6);
    RUN(7, ph_outproj(X, chain)); if (!chain) SEAM(7);
    RUN(8, ph_norm2(X, chain)); if (!chain) SEAM(8);
    RUN(9, ph_router(X, chain)); if (!chain) SEAM(9);
    RUN(10, ph_route(X, chain)); SEAM(10);
    RUN(11, ph_gu(X)); SEAM(11);
    RUN(12, ph_down(X)); SEAM(12);
    RUN(13, final_rows(X));
#undef IN
#undef SEAM
}

extern "C" void kernel_launch(void* const* d_in, const int* in_sizes, int n_in, void* d_out, int out_size, void* d_ws, size_t ws_size, hipStream_t stream) {
    static int grid = 0;
    if (grid == 0) {
        if (n_in != 20 || out_size != T * D || ws_size < WS_END) { fprintf(stderr, "kernel_launch: unexpected shapes (n_in %d, out %d, ws %zu); nothing launched\n", n_in, out_size, ws_size); grid = -1; return; }
        int dev = 0, cus = 0, per_cu = 0;
        if (hipGetDevice(&dev) != hipSuccess || hipDeviceGetAttribute(&cus, hipDeviceAttributeMultiprocessorCount, dev) != hipSuccess) { grid = -1; return; }
        if (hipFuncSetAttribute((const void*)mega_fwd, hipFuncAttributeMaxDynamicSharedMemorySize, LDS_BYTES) != hipSuccess) { fprintf(stderr, "kernel_launch: hipFuncSetAttribute failed\n"); grid = -1; return; }
        if (hipOccupancyMaxActiveBlocksPerMultiprocessor(&per_cu, (const void*)mega_fwd, NTHREADS, LDS_BYTES) != hipSuccess || per_cu < 1) { fprintf(stderr, "kernel_launch: occupancy query says %d blocks/CU; nothing launched\n", per_cu); (void)hipGetLastError(); grid = -1; return; }
        grid = cus;
        if (T % grid != 0 || 24576 % grid != 0 || grid % 8 != 0) { fprintf(stderr, "kernel_launch: grid %d does not divide the row count; nothing launched\n", grid); grid = -1; return; }
    }
    if (grid < 0) return;
    (void)hipMemsetAsync((char*)d_ws + WS_CTL, 0, CTL_ZERO_BYTES, stream);
    Args a{};
    for (int i = 0; i < 20; ++i) a.in[i] = d_in[i];
    a.out = (float*)d_out; a.ws = (unsigned char*)d_ws;
#if MK_PER_PHASE
    for (int p = 0; p < NPHASE; ++p) { a.ph_lo = p; a.ph_hi = p + 1; hipLaunchKernelGGL(mega_fwd, dim3(grid), dim3(NTHREADS), LDS_BYTES, stream, a); }
#else
    a.ph_lo = 0; a.ph_hi = NPHASE;
    hipLaunchKernelGGL(mega_fwd, dim3(grid), dim3(NTHREADS), LDS_BYTES, stream, a);
#endif
}
```

```cpp
#include <hip/hip_runtime.h>
#include <cstdio>
#include <cstdint>

#ifndef MK_PER_PHASE
#define MK_PER_PHASE 0
#endif

#define GAS __attribute__((address_space(1)))
#define LAS __attribute__((address_space(3)))
typedef unsigned short bf16_t;
typedef short bf16x8 __attribute__((ext_vector_type(8)));
typedef short s16x4 __attribute__((ext_vector_type(4)));
typedef float f32x4 __attribute__((ext_vector_type(4)));
typedef float f32x2 __attribute__((ext_vector_type(2)));
typedef float f32x16 __attribute__((ext_vector_type(16)));
typedef unsigned u32x4 __attribute__((ext_vector_type(4)));
typedef unsigned u32x2 __attribute__((ext_vector_type(2)));
typedef long l64x2 __attribute__((ext_vector_type(2)));

constexpr int NB = 4, SEQ = 4096, T = NB * SEQ, D = 1024, INW = 8704;
constexpr int C_HQ = 0, C_HK = 512, C_HV = 1024, C_HG = 1536, C_AQ = 2048, C_AK = 3584, C_AV = 5120, C_GA = 6656, C_GB = 7680;
constexpr int NE = 256, NEX = 257, TOPK = 8, NSLOT = 9, EFF = 256;
constexpr float EPS = 1e-6f;
constexpr float WGU_SCALE = 64.0f, WD_SCALE = 32.0f;
constexpr float YSCALE = 16.0f;
constexpr int NWAVES = 8, NTHREADS = 512;

constexpr size_t MiB = 1u << 20;
constexpr size_t WS_CTL = 0, CTL_ZERO_BYTES = 1 * MiB;
constexpr size_t WS_MODP = 2 * MiB;
constexpr size_t WS_MOD = 4 * MiB;
constexpr size_t WS_LB = 4 * MiB + 128 * 1024;
constexpr size_t WS_XB = 4 * MiB + 256 * 1024;
constexpr size_t WS_ROPE = 5 * MiB;
constexpr size_t WS_DECAY = 6 * MiB;
constexpr size_t WS_GATEW = 7 * MiB;
constexpr size_t WS_LISTS = 16 * MiB;
constexpr size_t WS_WIN = 34 * MiB;
constexpr size_t WS_WPA = 51 * MiB, WS_WPB = 52 * MiB, WS_WOUT = 53 * MiB, WS_WR = 55 * MiB;
constexpr size_t WS_H = 56 * MiB;
constexpr size_t WS_LOGF = 88 * MiB;
constexpr size_t WS_H8 = 120 * MiB;
constexpr size_t WS_MIXED = 136 * MiB;
constexpr size_t WS_YCAT = 168 * MiB;
constexpr size_t WS_X1 = 200 * MiB;
constexpr size_t WS_G8 = 232 * MiB;
constexpr size_t WS_OG = 264 * MiB;
constexpr size_t WS_LSE = 312 * MiB;
constexpr size_t WS_KVT = 314 * MiB;
constexpr size_t WS_SPT = 378 * MiB;
constexpr size_t WS_PROJ = 410 * MiB;
constexpr size_t WS_WGU = 682 * MiB;
constexpr size_t WS_QK8 = 820 * MiB;
constexpr size_t WS_HQ8 = 410 * MiB;
constexpr size_t WS_GWL = 921 * MiB;
constexpr size_t WS_WD = 939 * MiB;
constexpr size_t WS_ACT = 1068 * MiB;
constexpr size_t WS_YBUF = 1172 * MiB;
constexpr size_t WS_END = 1460 * MiB;
constexpr int CW_READY = 1024;
constexpr int CW_ZERO_LO = 2048, CW_ZERO_HI = 65536 + 5 * 64 * 64;
constexpr unsigned long long CTL_MAGIC = 0x9E3779B97F4A7C15ull;
constexpr int CW_P0 = 2048;
constexpr int CW_BAR = 4096;
constexpr int CW_PANEL = 65536;
constexpr int CW_CNT = 16384;

constexpr int RING_BYTES = 131072;
constexpr int TBL_OFF = RING_BYTES;
constexpr int TCNT_OFF = TBL_OFF + 4096;
constexpr int MISC_OFF = TCNT_OFF + 2560;
constexpr int LDS_BYTES = 147456;

#define LDS_WAIT() asm volatile("s_waitcnt lgkmcnt(0)" ::: "memory")
#define VM_WAIT() asm volatile("s_waitcnt vmcnt(0)" ::: "memory")
__device__ __forceinline__ unsigned f2bf(float f) { unsigned u = __builtin_bit_cast(unsigned, f); return (u + 0x7fffu + ((u >> 16) & 1u)) >> 16; }
__device__ __forceinline__ float bf2f(unsigned b) { return __builtin_bit_cast(float, b << 16); }
__device__ __forceinline__ unsigned pk2(float lo, float hi) { return f2bf(lo) | (f2bf(hi) << 16); }
__device__ __forceinline__ float bflo(unsigned w) { return __builtin_bit_cast(float, w << 16); }
__device__ __forceinline__ float bfhi(unsigned w) { return __builtin_bit_cast(float, w & 0xffff0000u); }
__device__ __forceinline__ float fast_logf(float x) { return __builtin_amdgcn_logf(x) * 0.6931471805599453f; }
__device__ __forceinline__ float sigmoidf_(float x) { return __builtin_amdgcn_rcpf(1.0f + __expf(-x)); }
__device__ __forceinline__ float wave_sum(float v) {
#pragma unroll
    for (int o = 1; o < 64; o <<= 1) v += __shfl_xor(v, o);
    return v;
}

__device__ __forceinline__ float clamp_e4m3(float x) { return __builtin_amdgcn_fmed3f(x, -448.0f, 448.0f); }
__device__ __forceinline__ unsigned pk4_fp8(float a, float b, float c, float d) { int w = 0; w = __builtin_amdgcn_cvt_pk_fp8_f32(clamp_e4m3(a), clamp_e4m3(b), w, false); w = __builtin_amdgcn_cvt_pk_fp8_f32(clamp_e4m3(c), clamp_e4m3(d), w, true); return (unsigned)w; }
__device__ __forceinline__ void st_wt8(void* p, unsigned long long v) { __hip_atomic_store((unsigned long long*)p, v, __ATOMIC_RELAXED, __HIP_MEMORY_SCOPE_AGENT); }
__device__ __forceinline__ void st_wt16(void* p, u32x4 v) { asm volatile("global_store_dwordx4 %0, %1, off sc1\n\ts_nop 1" :: "v"(p), "v"(v) : "memory"); }
__device__ __forceinline__ void st_wt4(void* p, unsigned v) { __hip_atomic_store((unsigned*)p, v, __ATOMIC_RELAXED, __HIP_MEMORY_SCOPE_AGENT); }
namespace pg8 {
constexpr int BM = 256, BK = 64, HALF = 128, HTB = HALF * BK * 2, STAGE_BYTES = 8 * HTB, NXCD = 8, WGM = 8;
__host__ __device__ __forceinline__ int lds_byte(int r, int c) { const int st = (r >> 4) * 2 + (c >> 5), rr = r & 15, cc = c & 31, ob = rr * 64 + cc * 2; return st * 1024 + (ob ^ (((ob >> 9) & 1) << 5)); }
__host__ __device__ __forceinline__ void stage_rc(int b, int& R, int& C) { const int st = b / 1024, sb = b % 1024, swz = sb ^ (((sb >> 9) & 1) << 5); R = (st >> 1) * 16 + swz / 64; C = (st & 1) * 32 + (swz % 64) / 2; }
__host__ __device__ __forceinline__ int perm32(int rho) { const int n = rho >> 4, i = rho & 15; return 8 * (i >> 2) + 4 * n + (i & 3); }

struct Unit { const char* a; const char* b; const int* rows; int pm, pn, aux, nvalid; };

__device__ __forceinline__ void swz_tile(int L, int nM, int nN, int& pm, int& pn) {
    const int nwg = nM * nN; int wgid = L;
    { const int q = nwg / NXCD, r = nwg % NXCD, xcd = wgid % NXCD, off = wgid / NXCD; wgid = (xcd < r ? xcd * (q + 1) : r * (q + 1) + (xcd - r) * q) + off; }
    const int nig = WGM * nN, gid = wgid / nig, fm = gid * WGM, gsz = (nM - fm) < WGM ? (nM - fm) : WGM;
    pm = fm + ((wgid % nig) % gsz); pn = (wgid % nig) / gsz;
}

__device__ __forceinline__ unsigned cvt_pk_bf16(float lo, float hi) { unsigned r; asm volatile("v_cvt_pk_bf16_f32 %0, %1, %2" : "=v"(r) : "v"(lo), "v"(hi)); return r; }

template <bool GATHER>
__device__ __forceinline__ void gather_offs(const Unit& u, int tid, int lda, unsigned (&v)[2][2]) {
    if constexpr (GATHER) {
#pragma unroll
        for (int i = 0; i < 2; ++i) { int R, C; stage_rc(tid * 16 + i * 8192, R, C);
#pragma unroll
            for (int hh = 0; hh < 2; ++hh) { const int ri = hh * HALF + R; const int slot = u.rows[ri < u.nvalid ? ri : 0];
                const unsigned tok = (unsigned)slot / 9u; v[hh][i] = (tok * (unsigned)lda + (unsigned)C) * 2u; } }
    }
}

template <class E, class = void> struct epi_noloads { static constexpr bool v = false; };
template <class E> struct epi_noloads<E, decltype((void)E::NO_LOADS)> { static constexpr bool v = E::NO_LOADS; };
template <class E, class = void> struct epi_bjadj { static constexpr bool v = false; };
template <class E> struct epi_bjadj<E, decltype((void)E::BJADJ)> { static constexpr bool v = E::BJADJ; };
template <class Epi, class Sched, bool ALIGN_EPI, bool GATHER, bool FP8 = false>
__device__ __forceinline__ void gemm_phase(LAS unsigned char* lds, const int lda, const int ldb, const int K, const Sched& S, const Epi& E) {
    const int tid = threadIdx.x, wid = __builtin_amdgcn_readfirstlane(tid >> 6), lane = tid & 63, wr = wid >> 2, wc = wid & 3, fr = lane & 15, fq = lane >> 4;
    const int nt = K / BK;
    unsigned voffA[2], voffB[2];
#pragma unroll
    for (int i = 0; i < 2; ++i) { int R, C; stage_rc(tid * 16 + i * 8192, R, C); const int Rb = Epi::PERM ? ((R & ~31) + perm32(R & 31)) : R;
        const int Rg = epi_bjadj<Epi>::v ? ((Rb >> 5) * 64 + (Rb & 31)) : Rb;
        voffA[i] = (unsigned)(R * lda + C) * 2u; voffB[i] = (unsigned)(Rg * ldb + C) * 2u; }
    const size_t kstep = (size_t)(BK * 2);
    const size_t hstepA = GATHER ? 0 : (size_t)HALF * lda * 2, hstepB = (size_t)(epi_bjadj<Epi>::v ? 32 : HALF) * ldb * 2;
    const unsigned ldsw = (unsigned)wid * 1024u;
    const int aoff = lds_byte(wr * 64 + fr, fq * 8), boff = lds_byte(wc * 32 + fr, fq * 8);
#define PG8_SA(b, h) (((b) * 2 + (h)) * HTB)
#define PG8_SB(b, h) ((4 + (b) * 2 + (h)) * HTB)
#define PG8_STAGE(bufoff, gbase, voff) do { _Pragma("unroll") for (int _i = 0; _i < 2; ++_i) \
        __builtin_amdgcn_global_load_lds((const unsigned*)((const char*)(gbase) + (voff)[_i]), (LAS unsigned*)(lds + (bufoff) + ldsw + _i * 8192), 16, 0, 0); } while (0)
#define PG8_STAGE_A(bufoff, gb, hh, nx) do { if constexpr (GATHER) { unsigned _v[2]; _v[0] = (nx) ? vn[hh][0] : vc[hh][0]; _v[1] = (nx) ? vn[hh][1] : vc[hh][1]; PG8_STAGE(bufoff, gb, _v); } \
        else { PG8_STAGE(bufoff, (gb) + (hh) * hstepA, voffA); } } while (0)
#define PG8_LDA(dst, b, h) do { _Pragma("unroll") for (int m = 0; m < 4; ++m) _Pragma("unroll") for (int k = 0; k < 2; ++k) dst[m][k] = *(const LAS bf16x8*)(lds + PG8_SA(b, h) + aoff + m * 2048 + k * 1024); } while (0)
#define PG8_LDB(dst, b, h) do { _Pragma("unroll") for (int n = 0; n < 2; ++n) _Pragma("unroll") for (int k = 0; k < 2; ++k) dst[n][k] = *(const LAS bf16x8*)(lds + PG8_SB(b, h) + boff + n * 2048 + k * 1024); } while (0)
#define PG8_MMA(ai, bj, At, Bt) do { __builtin_amdgcn_s_setprio(1); _Pragma("unroll") for (int m = 0; m < 4; ++m) _Pragma("unroll") for (int n = 0; n < 2; ++n) _Pragma("unroll") for (int k = 0; k < 2; ++k) { \
        if constexpr (FP8) { const l64x2 _b = __builtin_bit_cast(l64x2, Bt[n][k]), _a = __builtin_bit_cast(l64x2, At[m][k]); \
            acc[ai][bj][m][n] = __builtin_amdgcn_mfma_f32_16x16x32_fp8_fp8(_b[0], _a[0], acc[ai][bj][m][n], 0, 0, 0); acc[ai][bj][m][n] = __builtin_amdgcn_mfma_f32_16x16x32_fp8_fp8(_b[1], _a[1], acc[ai][bj][m][n], 0, 0, 0); } \
        else acc[ai][bj][m][n] = __builtin_amdgcn_mfma_f32_16x16x32_bf16(Bt[n][k], At[m][k], acc[ai][bj][m][n], 0, 0, 0); } __builtin_amdgcn_s_setprio(0); } while (0)
#define PG8_WAIT_V(n) asm volatile("s_waitcnt vmcnt(" #n ")" ::: "memory")
#define PG8_WAIT_L(n) asm volatile("s_waitcnt lgkmcnt(" #n ")" ::: "memory")
#define PG8_BAR __builtin_amdgcn_s_barrier()
#define PG8_SCHED __builtin_amdgcn_sched_barrier(0)
    Unit cur, nxt; int ui = 0;
    if (!S.next(0, cur)) return;
    unsigned vc[2][2] = {{0u, 0u}, {0u, 0u}}, vn[2][2] = {{0u, 0u}, {0u, 0u}};
    gather_offs<GATHER>(cur, tid, lda, vc);
    f32x4 acc[2][2][4][2];
#pragma unroll
    for (int a = 0; a < 2; ++a)
#pragma unroll
        for (int b = 0; b < 2; ++b)
#pragma unroll
            for (int m = 0; m < 4; ++m)
#pragma unroll
                for (int n = 0; n < 2; ++n) acc[a][b][m][n] = (f32x4){0.f, 0.f, 0.f, 0.f};
    bf16x8 At[4][2], B0[2][2], B1[2][2];
    const char* cA = cur.a; const char* cB = cur.b;
    PG8_STAGE(PG8_SB(0, 0), cB, voffB); PG8_STAGE(PG8_SB(0, 1), cB + hstepB, voffB); PG8_STAGE_A(PG8_SA(0, 0), cA, 0, false); PG8_STAGE_A(PG8_SA(0, 1), cA, 1, false);
    if (wr == 1) PG8_BAR;
    PG8_WAIT_V(2); PG8_BAR;
    PG8_STAGE(PG8_SB(1, 0), cB + kstep, voffB); PG8_STAGE_A(PG8_SA(1, 0), cA + kstep, 0, false); PG8_STAGE(PG8_SB(1, 1), cB + hstepB + kstep, voffB);
    PG8_WAIT_V(6); PG8_BAR;
    for (;;) {
        const bool has_next = S.next(ui + 1, nxt);
        if (has_next) gather_offs<GATHER>(nxt, tid, lda, vn);
        const char* nA = has_next ? nxt.a : cA; const char* nB = has_next ? nxt.b : cB;
        const bool do0 = !Sched::HALFSKIP || cur.nvalid > 64 * wr, do1 = !Sched::HALFSKIP || cur.nvalid > 128 + 64 * wr;
        for (int t = 0; t < nt; t += 2) {
            const bool last = (t == nt - 2);
            const bool lnx = last && has_next;
            const char* a1 = cA + (size_t)(t + 1) * kstep;
            const char* a2 = last ? nA : cA + (size_t)(t + 2) * kstep; const char* b2 = last ? nB : cB + (size_t)(t + 2) * kstep;
            const char* a3 = a2 + kstep; const char* b3 = b2 + kstep;
            PG8_LDB(B0, 0, 0); PG8_LDB(B1, 0, 1); PG8_SCHED; PG8_LDA(At, 0, 0); PG8_STAGE_A(PG8_SA(1, 1), a1, 1, false);
            PG8_WAIT_V(8); PG8_WAIT_L(0); PG8_BAR; if (do0) { PG8_MMA(0, 0, At, B0); PG8_MMA(0, 1, At, B1); } PG8_BAR; PG8_SCHED;
            PG8_LDA(At, 0, 1); PG8_STAGE(PG8_SB(0, 0), b2, voffB); PG8_STAGE(PG8_SB(0, 1), b2 + hstepB, voffB); PG8_STAGE_A(PG8_SA(0, 0), a2, 0, lnx);
            PG8_WAIT_V(8); PG8_WAIT_L(0); PG8_BAR; if (do1) { PG8_MMA(1, 0, At, B0); PG8_MMA(1, 1, At, B1); } PG8_BAR; PG8_SCHED;
            PG8_LDB(B0, 1, 0); PG8_LDB(B1, 1, 1); PG8_SCHED; PG8_LDA(At, 1, 0); PG8_STAGE_A(PG8_SA(0, 1), a2, 1, lnx);
            PG8_WAIT_V(8); PG8_WAIT_L(0); PG8_BAR; if (do0) { PG8_MMA(0, 0, At, B0); PG8_MMA(0, 1, At, B1); } PG8_BAR; PG8_SCHED;
            PG8_LDA(At, 1, 1); PG8_STAGE(PG8_SB(1, 0), b3, voffB); PG8_STAGE(PG8_SB(1, 1), b3 + hstepB, voffB); PG8_STAGE_A(PG8_SA(1, 0), a3, 0, lnx);
            PG8_WAIT_V(8); PG8_WAIT_L(0); PG8_BAR; if (do1) { PG8_MMA(1, 0, At, B0); PG8_MMA(1, 1, At, B1); } PG8_BAR; PG8_SCHED;
        }
        if constexpr (ALIGN_EPI) { if (wr == 0) PG8_BAR; }
        E(acc, cur, wr, wc, fr, fq);
        if constexpr (!epi_noloads<Epi>::v) __builtin_amdgcn_s_waitcnt(0x0F70);
        if (!has_next) break;
        if (!E.keep(cur)) {
#pragma unroll
            for (int a = 0; a < 2; ++a)
#pragma unroll
                for (int b = 0; b < 2; ++b)
#pragma unroll
                    for (int m = 0; m < 4; ++m)
#pragma unroll
                        for (int n = 0; n < 2; ++n) acc[a][b][m][n] = (f32x4){0.f, 0.f, 0.f, 0.f};
        }
        cur = nxt; cA = nA; cB = nB; ++ui;
        if constexpr (GATHER) {
#pragma unroll
            for (int hh = 0; hh < 2; ++hh) { vc[hh][0] = vn[hh][0]; vc[hh][1] = vn[hh][1]; }
        }
        if constexpr (ALIGN_EPI) { if (wr == 1) PG8_BAR; }
    }
    PG8_WAIT_V(0);
    if constexpr (!ALIGN_EPI) { if (wr == 0) PG8_BAR; }
    PG8_BAR;
#undef PG8_SA
#undef PG8_SB
#undef PG8_STAGE
#undef PG8_STAGE_A
#undef PG8_LDA
#undef PG8_LDB
#undef PG8_MMA
#undef PG8_WAIT_V
#undef PG8_WAIT_L
#undef PG8_BAR
#undef PG8_SCHED
}
}

#define XB_TMO      128
#define XB_XCNT(j)  (256  + 64 * (j))
#define XB_XSUB(j)  (1280 + 64 * (j))
#define XB_XGEN(j)  (2304 + 64 * (j))
#define XB_TOP      3328
#define XB_TOPGEN   3392
#define XCD_BAR_WORDS 3456
#define XB_SPIN_CAP (1u << 20)
__device__ __forceinline__ unsigned xb_ld(unsigned* p)              { return __hip_atomic_load(p, __ATOMIC_RELAXED, __HIP_MEMORY_SCOPE_AGENT); }
__device__ __forceinline__ unsigned xb_add(unsigned* p, unsigned v) { return __hip_atomic_fetch_add(p, v, __ATOMIC_RELAXED, __HIP_MEMORY_SCOPE_AGENT); }
__device__ __forceinline__ unsigned xb_xcc_id() { return (unsigned)__builtin_amdgcn_s_getreg((3 << 11) | 20) & 0xFu; }
#define XB_SPIN(cond, bar) do { unsigned _sp = 0; while (cond) { __builtin_amdgcn_s_sleep(1); \
    if ((++_sp & 255u) == 0u) { if (xb_ld(&(bar)[XB_TMO])) break; if (_sp > XB_SPIN_CAP) { atomicAdd(&(bar)[XB_TMO], 1u); break; } } } } while (0)
struct XcdBarrier { unsigned* bar; unsigned x; volatile LAS unsigned* st; };
__device__ __forceinline__ XcdBarrier xcd_barrier_post(unsigned* bar, volatile LAS unsigned* st) {
    XcdBarrier b; b.bar = bar; b.x = xb_xcc_id(); b.st = st;
    if (threadIdx.x == 0) (void)xb_add(&bar[XB_XCNT(b.x)], 1u);
    return b;
}
__device__ __forceinline__ void xcd_barrier_complete(unsigned* bar, unsigned x, unsigned& nloc, unsigned& nx) {
    const unsigned G = gridDim.x * gridDim.y * gridDim.z;
    unsigned sum, cnt, mine, sp = 0u;
    for (;;) {
        sum = 0u; cnt = 0u; mine = 0u;
#pragma unroll
        for (unsigned j = 0; j < 16; ++j) { const unsigned c = xb_ld(&bar[XB_XCNT(j)]); sum += c; cnt += (c > 0u) ? 1u : 0u; mine = (j == x) ? c : mine; }
        if (sum == G) break;
        __builtin_amdgcn_s_sleep(1);
        if ((++sp & 255u) == 0u) { if (xb_ld(&bar[XB_TMO])) break; if (sp > XB_SPIN_CAP) { atomicAdd(&bar[XB_TMO], 1u); break; } }
    }
    nloc = mine > 0u ? mine : 1u; nx = cnt > 0u ? cnt : 1u;
}
__device__ __forceinline__ void xcd_barrier(const XcdBarrier& b) {
    asm volatile("s_waitcnt vmcnt(0)" ::: "memory");
    __syncthreads();
    if (threadIdx.x == 0) {
        unsigned* bar = b.bar;
        __builtin_amdgcn_s_waitcnt(0);
        unsigned nloc = b.st[0], nx = b.st[1];
        if (nloc == 0u) { xcd_barrier_complete(bar, b.x, nloc, nx); b.st[0] = nloc; b.st[1] = nx; }
        const unsigned old = xb_add(&bar[XB_XSUB(b.x)], 1u);
        const unsigned gen = old / nloc;
        if (old + 1u == (gen + 1u) * nloc) {
            __builtin_amdgcn_fence(__ATOMIC_RELEASE, "agent");
            asm volatile("s_waitcnt vmcnt(0)" ::: "memory");
            const unsigned og = xb_add(&bar[XB_TOP], 1u);
            const unsigned tg = og / nx;
            if (og + 1u == (tg + 1u) * nx) xb_add(&bar[XB_TOPGEN], 1u);
            else XB_SPIN(xb_ld(&bar[XB_TOPGEN]) == tg, bar);
            __builtin_amdgcn_fence(__ATOMIC_ACQUIRE, "agent");
            asm volatile("s_waitcnt vmcnt(0)" ::: "memory");
        } else {
            XB_SPIN(xb_ld(&bar[XB_TOPGEN]) == gen, bar);
            __builtin_amdgcn_fence(__ATOMIC_ACQUIRE, "agent");
            asm volatile("s_waitcnt vmcnt(0)" ::: "memory");
        }
    }
    __syncthreads();
}

struct Ctx {
    LAS unsigned char* lds;
    int tid, lane, wave, wg, G;
    const float *x, *c, *w_ada, *b_ada, *g1, *w_in, *lb_logits, *g_hgrn, *w_pa, *w_pb, *w_out, *g2, *w_router, *rbias, *w_egu, *w_edown, *w_sgu, *w_sdown, *g_final;
    const int* positions;
    float* out;
    unsigned char* ws;
};
#define WSP(type, off) ((type*)(X.ws + (off)))

__device__ __forceinline__ void transpose_item(const float* W, int K, int N, bf16_t* WT, int dst_row0, int src_col0, int k0, LAS float* scr, int lane) {
#pragma unroll 16
    for (int i = 0; i < 32; ++i) { const int kk = 2 * i + (lane >> 5); scr[kk * 33 + (lane & 31)] = __builtin_nontemporal_load(W + (size_t)(k0 + kk) * N + src_col0 + (lane & 31)); }
    LDS_WAIT(); asm volatile("" ::: "memory");
    const int c = lane & 7;
#pragma unroll
    for (int j = 0; j < 4; ++j) { const int n = (lane >> 3) + 8 * j; const LAS float* s = scr + (8 * c) * 33 + n;
        u32x4 o; o.x = pk2(s[0 * 33], s[1 * 33]); o.y = pk2(s[2 * 33], s[3 * 33]); o.z = pk2(s[4 * 33], s[5 * 33]); o.w = pk2(s[6 * 33], s[7 * 33]);
        *(u32x4*)(WT + (size_t)(dst_row0 + n) * K + k0 + 8 * c) = o; }
    LDS_WAIT(); asm volatile("" ::: "memory");
}
__device__ __forceinline__ void transpose_plain(const float* W, int K, int N, bf16_t* WT, int item, LAS float* scr, int lane) {
    const int nblk = N / 32, kb = item / nblk, nb = item % nblk;
    transpose_item(W, K, N, WT, nb * 32, nb * 32, kb * 64, scr, lane);
}
__device__ __forceinline__ void p0_prologue(Ctx& X) {
    LAS float* scr = (LAS float*)(X.lds + X.wave * 16384);
    const int gw = X.wg * NWAVES + X.wave, NGW = X.G * NWAVES;
    {
        float* MODP = WSP(float, WS_MODP);
        for (int it = gw; it < 96 * 16; it += NGW) {
            const int jc = it % 96, kc = it / 96, j = jc * 64 + X.lane;
            float a0 = 0.f, a1 = 0.f, a2 = 0.f, a3 = 0.f;
#pragma unroll 16
            for (int kk = 0; kk < 64; ++kk) { const int k = kc * 64 + kk; const float w = __builtin_nontemporal_load(X.w_ada + (size_t)k * 6144 + j);
                const float c0 = X.c[k], c1 = X.c[1024 + k], c2 = X.c[2048 + k], c3 = X.c[3072 + k];
                a0 += c0 * sigmoidf_(c0) * w; a1 += c1 * sigmoidf_(c1) * w; a2 += c2 * sigmoidf_(c2) * w; a3 += c3 * sigmoidf_(c3) * w; }
            float* o = MODP + (size_t)kc * 24576 + j;
            st_wt4(o, __builtin_bit_cast(unsigned, a0)); st_wt4(o + 6144, __builtin_bit_cast(unsigned, a1)); st_wt4(o + 12288, __builtin_bit_cast(unsigned, a2)); st_wt4(o + 18432, __builtin_bit_cast(unsigned, a3));
        }
    }
    {
        float* ROPE = WSP(float, WS_ROPE);
        const int gt = X.wg * NTHREADS + X.tid, NGT = X.G * NTHREADS;
        for (int idx = gt; idx < T * 8; idx += NGT) { const int t = idx >> 3, i = idx & 7;
            const float inv_freq = 1.0f / powf(500000.0f, (float)(2 * i) / 16.0f);
            const float ang = (float)X.positions[t] * inv_freq;
            ROPE[t * 16 + i] = cosf(ang); ROPE[t * 16 + 8 + i] = sinf(ang); }
        if (X.wg == 0) { float* LB = WSP(float, WS_LB);
            for (int j = X.tid; j < 512; j += NTHREADS) { const float l0 = X.lb_logits[j], l1 = X.lb_logits[512 + j], m = fmaxf(l0, l1), e0 = __expf(l0 - m), e1 = __expf(l1 - m); LB[j] = e0 / (e0 + e1); } }
    }
}
struct CvtItem { const float* src; bf16_t* dst; };
template <bool GU> __device__ __forceinline__ CvtItem cvt_item(const Ctx& X, int it) {
    CvtItem c;
    if constexpr (GU) { const int e = it >> 7, q = it & 127, w8 = q & 7, sq = q >> 3, kb = 4 * (sq >> 2) + (w8 & 3), nb = 2 * (sq & 3) + (w8 >> 2);
        const int n0 = nb * 64, pn = n0 >> 8, bj = (n0 >> 7) & 1, idx = n0 & 127, srcc = bj * 256 + pn * 128 + idx;
        const float* W = (e < NE) ? X.w_egu + (size_t)e * 1024 * 512 : X.w_sgu;
        c.src = W + (size_t)(kb * 64) * 512 + srcc; c.dst = (bf16_t*)(X.ws + WS_WGU + ((size_t)e * 512 + n0) * 1024 + kb * 64); }
    else { const int e = it >> 6, q = it & 63, w8 = q & 7, sq = q >> 3, kb = w8 & 3, nb = 2 * sq + (w8 >> 2);
        const float* W = (e < NE) ? X.w_edown + (size_t)e * 256 * 1024 : X.w_sdown;
        c.src = W + (size_t)(kb * 64) * 1024 + nb * 64; c.dst = (bf16_t*)(X.ws + WS_WD + ((size_t)e * 1024 + nb * 64) * 256 + kb * 64); }
    return c;
}
template <int KB> __device__ __forceinline__ void cvt_store8(const CvtItem& c, int lane, const f32x4 (&v)[16], LAS unsigned char* tl, float sc) {
    const int kq = lane >> 4, nq = lane & 15;
#pragma unroll
    for (int i = 0; i < 4; ++i) { u32x4 w;
        w.x = pk4_fp8(v[0][i] * sc, v[1][i] * sc, v[2][i] * sc, v[3][i] * sc); w.y = pk4_fp8(v[4][i] * sc, v[5][i] * sc, v[6][i] * sc, v[7][i] * sc);
        w.z = pk4_fp8(v[8][i] * sc, v[9][i] * sc, v[10][i] * sc, v[11][i] * sc); w.w = pk4_fp8(v[12][i] * sc, v[13][i] * sc, v[14][i] * sc, v[15][i] * sc);
        *(LAS u32x4*)(tl + (4 * nq + i) * 80 + kq * 16) = w; }
    LDS_WAIT(); asm volatile("" ::: "memory");
    const int ch = lane & 3, r = lane >> 2;
    unsigned char* d8 = (unsigned char*)c.dst;
#pragma unroll
    for (int j = 0; j < 4; ++j) { const int n = 16 * j + r; const u32x4 w = *(const LAS u32x4*)(tl + n * 80 + ch * 16); __builtin_nontemporal_store(w, (u32x4*)(d8 + (size_t)n * KB + 16 * ch)); }
    LDS_WAIT(); asm volatile("" ::: "memory");
}
template <int N> __device__ __forceinline__ void cvt_load(const CvtItem& c, int lane, f32x4 (&v)[16]) {
    const float* p = c.src + (size_t)(16 * (lane >> 4)) * N + 4 * (lane & 15);
#pragma unroll
    for (int j = 0; j < 16; ++j) v[j] = __builtin_nontemporal_load((const f32x4*)(p + (size_t)j * N));
}
template <int K> __device__ __forceinline__ void cvt_store(const CvtItem& c, int lane, const f32x4 (&v)[16], LAS unsigned char* tl) {
    const int kq = lane >> 4, nq = lane & 15;
#pragma unroll
    for (int i = 0; i < 4; ++i) { u32x4 w0, w1;
        w0.x = pk2(v[0][i], v[1][i]); w0.y = pk2(v[2][i], v[3][i]); w0.z = pk2(v[4][i], v[5][i]); w0.w = pk2(v[6][i], v[7][i]);
        w1.x = pk2(v[8][i], v[9][i]); w1.y = pk2(v[10][i], v[11][i]); w1.z = pk2(v[12][i], v[13][i]); w1.w = pk2(v[14][i], v[15][i]);
        LAS unsigned char* q = tl + (4 * nq + i) * 144 + kq * 32; *(LAS u32x4*)q = w0; *(LAS u32x4*)(q + 16) = w1; }
    LDS_WAIT(); asm volatile("" ::: "memory");
    const int ch = lane & 7, r = lane >> 3;
#pragma unroll
    for (int j = 0; j < 8; ++j) { const int n = 8 * j + r; const u32x4 w = *(const LAS u32x4*)(tl + n * 144 + ch * 16); __builtin_nontemporal_store(w, (u32x4*)(c.dst + (size_t)n * K + 8 * ch)); }
    LDS_WAIT(); asm volatile("" ::: "memory");
}
struct CvtPair { const float* src; unsigned char* dst; };
template <bool GU> __device__ __forceinline__ CvtPair cvt_pair(const Ctx& X, int di) {
    CvtPair c;
    if constexpr (GU) { const int e = di >> 6, q = di & 63, nb = q & 7, kb2 = q >> 3;
        const int n0 = nb * 64, pn = n0 >> 8, bj = (n0 >> 7) & 1, idx = n0 & 127, srcc = bj * 256 + pn * 128 + idx;
        const float* W = (e < NE) ? X.w_egu + (size_t)e * 1024 * 512 : X.w_sgu;
        c.src = W + (size_t)(kb2 * 128) * 512 + srcc; c.dst = X.ws + WS_WGU + ((size_t)e * 512 + n0) * 1024 + kb2 * 128; }
    else { const int e = di >> 5, q = di & 31, nb = q & 15, kb2 = q >> 4;
        const float* W = (e < NE) ? X.w_edown + (size_t)e * 256 * 1024 : X.w_sdown;
        c.src = W + (size_t)(kb2 * 128) * 1024 + nb * 64; c.dst = X.ws + WS_WD + ((size_t)e * 1024 + nb * 64) * 256 + kb2 * 128; }
    return c;
}
template <int N> __device__ __forceinline__ void cvt_load_half(const CvtPair& c, int half, int lane, f32x4 (&v)[16]) {
    const float* p = c.src + (size_t)(64 * half + 16 * (lane >> 4)) * N + 4 * (lane & 15);
#pragma unroll
    for (int j = 0; j < 16; ++j) v[j] = __builtin_nontemporal_load((const f32x4*)(p + (size_t)j * N));
}
__device__ __forceinline__ void cvt_half_to_lds(int half, int lane, const f32x4 (&v)[16], LAS unsigned char* tl, float sc) {
    const int kq = lane >> 4, nq = lane & 15;
#pragma unroll
    for (int i = 0; i < 4; ++i) { u32x4 w;
        w.x = pk4_fp8(v[0][i] * sc, v[1][i] * sc, v[2][i] * sc, v[3][i] * sc); w.y = pk4_fp8(v[4][i] * sc, v[5][i] * sc, v[6][i] * sc, v[7][i] * sc);
        w.z = pk4_fp8(v[8][i] * sc, v[9][i] * sc, v[10][i] * sc, v[11][i] * sc); w.w = pk4_fp8(v[12][i] * sc, v[13][i] * sc, v[14][i] * sc, v[15][i] * sc);
        *(LAS u32x4*)(tl + (4 * nq + i) * 144 + half * 64 + kq * 16) = w; }
}
template <int KB> __device__ __forceinline__ void cvt_flush(const CvtPair& c, int lane, LAS unsigned char* tl) {
    LDS_WAIT(); asm volatile("" ::: "memory");
    const int ch = lane & 7, r = lane >> 3;
#pragma unroll
    for (int j = 0; j < 8; ++j) { const int n = 8 * j + r; const u32x4 w = *(const LAS u32x4*)(tl + n * 144 + ch * 16); __builtin_nontemporal_store(w, (u32x4*)(c.dst + (size_t)n * KB + 16 * ch)); }
    LDS_WAIT(); asm volatile("" ::: "memory");
}
template <bool GU> __device__ __forceinline__ void expert_convert_set(Ctx& X, int gw, int NGW, LAS unsigned char* tl) {
    constexpr int NIT = GU ? NEX * 64 : NEX * 32, N = GU ? 512 : 1024, K = GU ? 1024 : 256; constexpr float SC = GU ? WGU_SCALE : WD_SCALE;
    if (gw >= NIT) return;
    const int nmine = (NIT - gw + NGW - 1) / NGW;
    f32x4 va[16], vb[16];
    CvtPair cur = cvt_pair<GU>(X, gw);
    cvt_load_half<N>(cur, 0, X.lane, va); cvt_load_half<N>(cur, 1, X.lane, vb);
    for (int j = 0; j < nmine; ++j) {
        const CvtPair nxt = cvt_pair<GU>(X, gw + (j + 1 < nmine ? j + 1 : j) * NGW);
        __builtin_amdgcn_sched_barrier(0);
        cvt_half_to_lds(0, X.lane, va, tl, SC);
        __builtin_amdgcn_sched_barrier(0);
        cvt_load_half<N>(nxt, 0, X.lane, va);
        __builtin_amdgcn_sched_barrier(0);
        cvt_half_to_lds(1, X.lane, vb, tl, SC);
        cvt_flush<K>(cur, X.lane, tl);
        __builtin_amdgcn_sched_barrier(0);
        cvt_load_half<N>(nxt, 1, X.lane, vb);
        __builtin_amdgcn_sched_barrier(0);
        cur = nxt;
    }
}
__device__ __forceinline__ void expert_convert(Ctx& X, int cw, int ncw) {
    LAS unsigned char* tl = X.lds + X.wave * 16384;
    const int gw = cw * NWAVES + X.wave, NGW = ncw * NWAVES;
    expert_convert_set<true>(X, gw, NGW, tl);
    expert_convert_set<false>(X, gw, NGW, tl);
}

__device__ __forceinline__ void small_transposes(Ctx& X) {
    LAS float* scr = (LAS float*)(X.lds + 16384 + X.wave * 12288);
    const int gw = X.wg * NWAVES + X.wave, NGW = X.G * NWAVES;
    {
        constexpr int I_IN = 16 * 272, I_PA = 8 * 32, I_PB = 8 * 32, I_OUT = 16 * 32, I_R = 16 * 8;
        constexpr int NITEMS = I_IN + I_PA + I_PB + I_OUT + I_R;
        for (int it = gw; it < NITEMS; it += NGW) {
            int r = it;
            if (r < I_IN) { transpose_plain(X.w_in, 1024, INW, WSP(bf16_t, WS_WIN), r, scr, X.lane); continue; } r -= I_IN;
            if (r < I_PA) { transpose_plain(X.w_pa, 512, 1024, WSP(bf16_t, WS_WPA), r, scr, X.lane); continue; } r -= I_PA;
            if (r < I_PB) { transpose_plain(X.w_pb, 512, 1024, WSP(bf16_t, WS_WPB), r, scr, X.lane); continue; } r -= I_PB;
            if (r < I_OUT) { transpose_plain(X.w_out, 1024, 1024, WSP(bf16_t, WS_WOUT), r, scr, X.lane); continue; } r -= I_OUT;
            transpose_plain(X.w_router, 1024, 256, WSP(bf16_t, WS_WR), r, scr, X.lane);
        }
    }
}

__device__ __forceinline__ void norm_rows(Ctx& X, int which) {
    LAS float* sm = (LAS float*)X.lds;
    const float* MODP = WSP(float, WS_MODP); float* MOD = WSP(float, WS_MOD);
    const int rows_per_wg = T / X.G, row0 = X.wg * rows_per_wg, b = row0 / SEQ;
    if (which == 0) {
        for (int i = X.tid; i < 2048; i += NTHREADS) { const int j = b * 6144 + i; float s = X.b_ada[i];
#pragma unroll
            for (int p = 0; p < 16; ++p) s += MODP[(size_t)p * 24576 + j];
            sm[i] = s; }
        const int per = 24576 / X.G;
        for (int i = X.tid; i < per; i += NTHREADS) { const int j = X.wg * per + i; float s = X.b_ada[j % 6144];
#pragma unroll
            for (int p = 0; p < 16; ++p) s += MODP[(size_t)p * 24576 + j];
            MOD[j] = s; }
    } else {
        for (int i = X.tid; i < 2048; i += NTHREADS) sm[i] = MOD[b * 6144 + 3072 + i];
    }
    __syncthreads();
    const float* src = X.x; const bf16_t* srcb = WSP(bf16_t, WS_X1); const float* g = which == 0 ? X.g1 : X.g2;
    bf16_t* H = WSP(bf16_t, WS_H);
    for (int r0 = X.wave; r0 < rows_per_wg; r0 += 4 * NWAVES) {
        f32x4 vv[4][2][2];
#pragma unroll
        for (int k = 0; k < 4; ++k) { const int rr = r0 + k * NWAVES < rows_per_wg ? r0 + k * NWAVES : r0; const int row = row0 + rr;
#pragma unroll
            for (int j = 0; j < 2; ++j) { const int col = 8 * X.lane + 512 * j;
                if (which == 0) { vv[k][j][0] = __builtin_nontemporal_load((const f32x4*)(src + (size_t)row * D + col)); vv[k][j][1] = __builtin_nontemporal_load((const f32x4*)(src + (size_t)row * D + col + 4)); }
                else { const u32x4 wv = *(const u32x4*)(srcb + (size_t)row * D + col); vv[k][j][0] = (f32x4){bflo(wv.x), bfhi(wv.x), bflo(wv.y), bfhi(wv.y)}; vv[k][j][1] = (f32x4){bflo(wv.z), bfhi(wv.z), bflo(wv.w), bfhi(wv.w)}; } } }
#pragma unroll
        for (int k = 0; k < 4; ++k) { const int r = r0 + k * NWAVES; if (r >= rows_per_wg) break;
        const int row = row0 + r;
        f32x4 (&v)[2][2] = vv[k]; float s = 0.f;
#pragma unroll
        for (int j = 0; j < 2; ++j) {
#pragma unroll
            for (int q = 0; q < 2; ++q) s += (v[j][q].x * v[j][q].x + v[j][q].y * v[j][q].y) + (v[j][q].z * v[j][q].z + v[j][q].w * v[j][q].w); }
        const float rstd = rsqrtf(wave_sum(s) * (1.f / D) + EPS);
#pragma unroll
        for (int j = 0; j < 2; ++j) { const int col = 8 * X.lane + 512 * j; float y[8];
#pragma unroll
            for (int q = 0; q < 2; ++q) { const f32x4 gg = *(const f32x4*)(g + col + 4 * q), sh = *(const LAS f32x4*)(sm + col + 4 * q), sc = *(const LAS f32x4*)(sm + 1024 + col + 4 * q);
#pragma unroll
                for (int e = 0; e < 4; ++e) y[4 * q + e] = v[j][q][e] * rstd * gg[e] * (1.f + sc[e]) + sh[e]; }
            u32x4 hw; hw.x = pk2(y[0], y[1]); hw.y = pk2(y[2], y[3]); hw.z = pk2(y[4], y[5]); hw.w = pk2(y[6], y[7]);
            if (which == 1) { st_wt16(H + (size_t)row * D + col, hw);
                st_wt8(WSP(unsigned char, WS_H8) + (size_t)row * D + col, (unsigned long long)pk4_fp8(y[0], y[1], y[2], y[3]) | ((unsigned long long)pk4_fp8(y[4], y[5], y[6], y[7]) << 32)); }
            else *(u32x4*)(H + (size_t)row * D + col) = hw; }
        }
    }
    __syncthreads();
}

struct RegSched {
    static constexpr bool HALFSKIP = false;
    const char* A; const char* Bt; size_t a_tile, b_tile; int nM, nN, G, c;
    __device__ __forceinline__ bool next(int i, pg8::Unit& u) const {
        const int L = i * G + c; if (L >= nM * nN) return false;
        int pm, pn; pg8::swz_tile(L, nM, nN, pm, pn);
        u.a = A + (size_t)pm * a_tile; u.b = Bt + (size_t)pn * b_tile; u.rows = nullptr; u.pm = pm; u.pn = pn; u.aux = 0; u.nvalid = 256; return true;
    }
};
struct RoundsSched {
    static constexpr bool HALFSKIP = false;
    const char* A; const char* Bt; size_t a_tile, b_tile; int nM, nN, G, c, Lmax;
    __device__ __forceinline__ bool next(int i, pg8::Unit& u) const {
        const int L = i * G + c; if (L >= Lmax) return false;
        int pm, pn; pg8::swz_tile(L, nM, nN, pm, pn);
        u.a = A + (size_t)pm * a_tile; u.b = Bt + (size_t)pn * b_tile; u.rows = nullptr; u.pm = pm; u.pn = pn; u.aux = 0; u.nvalid = 256; return true;
    }
};
struct TailSched {
    static constexpr bool HALFSKIP = true;
    const char* A; const char* Bt; size_t a_tile, b_tile; int nM, nN, G, c, L0, rem;
    __device__ __forceinline__ bool next(int i, pg8::Unit& u) const {
        if (i > 0) return false;
        int L, half = -1;
        if (2 * rem <= G) { if (c >= 2 * rem) return false; L = L0 + (c >> 1); half = c & 1; } else { if (c >= rem) return false; L = L0 + c; }
        int pm, pn; pg8::swz_tile(L, nM, nN, pm, pn);
        u.a = A + (size_t)pm * a_tile; u.b = Bt + (size_t)pn * b_tile; u.rows = nullptr; u.pm = pm; u.pn = pn; u.aux = 0; u.nvalid = 256;
        if (half >= 0) { u.aux = 1 + half; u.nvalid = 128; u.a += (size_t)half * (a_tile >> 1); }
        return true;
    }
};
struct TwoPartSched {      static constexpr bool HALFSKIP = false;
    const char* Y; const char* Wa; const char* Wb; int nM, nN, G, c;
    __device__ __forceinline__ bool next(int i, pg8::Unit& u) const {
        const int L = (i >> 1) * G + c, part = i & 1; if (L >= nM * nN) return false;
        int pm, pn; pg8::swz_tile(L, nM, nN, pm, pn);
        u.a = Y + (size_t)pm * 256 * 2048 + part * 1024; u.b = (part ? Wb : Wa) + (size_t)pn * 256 * 1024; u.rows = nullptr; u.pm = pm; u.pn = pn; u.aux = part; u.nvalid = 256; return true;
    }
};
struct MoeSched {
    static constexpr bool HALFSKIP = true;
    const LAS int* tbl; const LAS int* cnts; int nent; const char* A; const char* W; const int* lists; int ncol  , wtile  , wexp  , atile  , G, c;
    __device__ __forceinline__ bool next(int i, pg8::Unit& u) const {
        const int un = i * (G >> 3) + (c >> 3); if (un >= nent * ncol) return false;
        const int pn = un % ncol; const int ent = __builtin_amdgcn_readfirstlane(tbl[un / ncol]), e = (ent >> 7) & 511, r = ent & 127, rt = ent >> 16;
        u.a = A + (size_t)rt * atile; u.b = W + (size_t)e * wexp + (size_t)pn * wtile; u.rows = lists + (size_t)e * 16384 + r * 256;
        u.pm = rt; u.pn = pn; u.aux = e; const int left = __builtin_amdgcn_readfirstlane(cnts[e]) - r * 256; u.nvalid = left < 256 ? left : 256; return true;
    }
};

typedef _Float16 h16x2 __attribute__((ext_vector_type(2)));
__device__ __forceinline__ unsigned pk_f16(float a, float b) { const h16x2 v = {(_Float16)a, (_Float16)b}; return __builtin_bit_cast(unsigned, v); }
__device__ __forceinline__ float f16lo(unsigned w) { return (float)__builtin_bit_cast(h16x2, w)[0]; }
__device__ __forceinline__ float f16hi(unsigned w) { return (float)__builtin_bit_cast(h16x2, w)[1]; }
__device__ __forceinline__ unsigned pkz_f16(float a, float b) { return __builtin_bit_cast(unsigned, __builtin_amdgcn_cvt_pkrtz(a, b)); }
__device__ __forceinline__ void f16x8_f32(u32x4 w, f32x4& lo, f32x4& hi) { lo = (f32x4){f16lo(w.x), f16hi(w.x), f16lo(w.y), f16hi(w.y)}; hi = (f32x4){f16lo(w.z), f16hi(w.z), f16lo(w.w), f16hi(w.w)}; }
__device__ __forceinline__ unsigned dpp_xor1(unsigned x) { return (unsigned)__builtin_amdgcn_update_dpp(0, (int)x, 0xB1, 0xF, 0xF, true); }
__device__ __forceinline__ void pair_rows(const u32x4& w0, const u32x4& w1, bool oddr, u32x4& ev, u32x4& od) {
    const u32x4 snd = oddr ? w0 : w1;
    u32x4 rcv; rcv.x = dpp_xor1(snd.x); rcv.y = dpp_xor1(snd.y); rcv.z = dpp_xor1(snd.z); rcv.w = dpp_xor1(snd.w);
    ev = oddr ? rcv : w0; od = oddr ? w1 : rcv;
}
template <bool TAIL> struct EpiInprojT {
    static constexpr bool PERM = true;
    static constexpr bool BJADJ = true;
    bf16_t* PROJ; float* LOGF; const float* LB; const float* ROPE; unsigned char* G8; unsigned char* QK8; unsigned char* HQ8;
    __device__ __forceinline__ bool keep(const pg8::Unit&) const { return false; }
    __device__ __forceinline__ void operator()(f32x4 (&acc)[2][2][4][2], const pg8::Unit& u, int wr, int wc, int fr, int fq) const {
        const int pn = u.pn;
        const int mode = pn < 2 ? 6 : pn < 4 ? 1 : pn < 6 ? 6 : pn < 8 ? 2 : pn < 20 ? 3 : pn < 26 ? 5 : 4;
        const int row0 = u.pm * 256 + (TAIL && u.aux == 2 ? 128 : 0) + wr * 64 + fr, colb = pn * 256 + wc * 64 + 8 * fq;
        const int nai = (TAIL && u.aux != 0) ? 1 : 2;
        const bool rot3 = (mode == 3);
        const bool odd = fq & 1; const int colw = pn * 256 + wc * 64 + (fq & 1) * 32 + (fq >> 1) * 16;
#pragma unroll
        for (int ai = 0; ai < 2; ++ai) if (!TAIL || ai < nai)
#pragma unroll
            for (int m = 0; m < 4; ++m) {
                const int row = row0 + ai * 128 + m * 16;
                f32x4 cs0, cs1, sn0, sn1;
                if (rot3) { const f32x4* rp = (const f32x4*)(ROPE + (size_t)row * 16); cs0 = rp[0]; cs1 = rp[1]; sn0 = rp[2]; sn1 = rp[3]; }
                u32x2 p8[2];
#pragma unroll
                for (int bj = 0; bj < 2; ++bj) {
                    const int col = colb + bj * 32; const bool rot = rot3 && bj == 0;
                    f32x4 v0 = acc[ai][bj][m][0], v1 = acc[ai][bj][m][1];
                    if (mode == 1) {
                        const int cf = col - 512; const f32x4 l0 = *(const f32x4*)(LB + cf), l1 = *(const f32x4*)(LB + cf + 4);
                        f32x4 lf0, lf1;
#pragma unroll
                        for (int j = 0; j < 4; ++j) { float sg = sigmoidf_(v0[j]); float f = l0[j] + (1.f - l0[j]) * sg; lf0[j] = fast_logf(f); v0[j] = (1.f - l0[j]) * (1.f - sg);
                            sg = sigmoidf_(v1[j]); f = l1[j] + (1.f - l1[j]) * sg; lf1[j] = fast_logf(f); v1[j] = (1.f - l1[j]) * (1.f - sg); }
                        acc[ai][bj][m][0] = lf0; acc[ai][bj][m][1] = lf1;
                    } else if (mode == 2) {
#pragma unroll
                        for (int j = 0; j < 4; ++j) { v0[j] = v0[j] * sigmoidf_(v0[j]); v1[j] = v1[j] * sigmoidf_(v1[j]); }
                    } else if (mode == 4) {
#pragma unroll
                        for (int j = 0; j < 4; ++j) { v0[j] = sigmoidf_(v0[j]); v1[j] = sigmoidf_(v1[j]); }
                    } else if (rot) {
                        f32x4 p0, p1;
#pragma unroll
                        for (int j = 0; j < 4; ++j) { p0[j] = __shfl_xor(v0[j], 16); p1[j] = __shfl_xor(v1[j], 16); }
                        if (fq == 0) { v0 = v0 * cs0 - p0 * sn0; v1 = v1 * cs1 - p1 * sn1; }
                        else if (fq == 1) { v0 = v0 * cs0 + p0 * sn0; v1 = v1 * cs1 + p1 * sn1; }
                    }
                    if (mode == 4) {
                        int g0 = 0, g1 = 0;
#pragma unroll
                        for (int j = 0; j < 4; ++j) { g0 = __builtin_amdgcn_cvt_pk_u8_f32(fmaxf(v0[j] * 255.0f, 1.0f), j, g0); g1 = __builtin_amdgcn_cvt_pk_u8_f32(fmaxf(v1[j] * 255.0f, 1.0f), j, g1); }
                        p8[bj] = (u32x2){(unsigned)g0, (unsigned)g1};
                        continue; }
                    if (mode == 2 || mode == 3 || mode == 5 || mode == 6) {
                        p8[bj] = (u32x2){pk4_fp8(v0[0], v0[1], v0[2], v0[3]), pk4_fp8(v1[0], v1[1], v1[2], v1[3])};
                        continue; }
                    if (mode == 1) {
                        int g0 = 0, g1 = 0;
#pragma unroll
                        for (int j = 0; j < 4; ++j) { g0 = __builtin_amdgcn_cvt_pk_u8_f32(v0[j] * 255.0f, j, g0); g1 = __builtin_amdgcn_cvt_pk_u8_f32(v1[j] * 255.0f, j, g1); }
                        p8[bj] = (u32x2){(unsigned)g0, (unsigned)g1};
                        continue; }
                }
                {
                    const u32x2 snd = odd ? p8[0] : p8[1];
                    u32x2 rcv; rcv.x = (unsigned)__shfl_xor((int)snd.x, 16); rcv.y = (unsigned)__shfl_xor((int)snd.y, 16);
                    const u32x4 w = odd ? (u32x4){rcv.x, rcv.y, p8[1].x, p8[1].y} : (u32x4){p8[0].x, p8[0].y, rcv.x, rcv.y};
                    if (mode == 4) *(u32x4*)(G8 + (size_t)row * 2048 + (colw - C_GA)) = w;
                    else if (mode == 1 || mode == 6 || mode == 2) *(u32x4*)(HQ8 + (size_t)row * 2048 + colw) = w;
                    else *(u32x4*)(QK8 + (size_t)row * 4608 + (colw - C_AQ)) = w;
                }
            }
        if (mode == 1) {
            const int lane = fq * 16 + fr;
#pragma unroll
            for (int ai = 0; ai < 2; ++ai) if (!TAIL || ai < nai)
#pragma unroll
                for (int bj = 0; bj < 2; ++bj)
#pragma unroll
                    for (int n = 0; n < 2; ++n)
#pragma unroll
                        for (int j = 0; j < 4; ++j) { float carry = 0.f;
#pragma unroll
                            for (int m = 0; m < 4; ++m) { float v = acc[ai][bj][m][n][j];
                                v += __builtin_bit_cast(float, __builtin_amdgcn_update_dpp(0, __builtin_bit_cast(int, v), 0x111, 0xF, 0xF, true));
                                v += __builtin_bit_cast(float, __builtin_amdgcn_update_dpp(0, __builtin_bit_cast(int, v), 0x112, 0xF, 0xF, true));
                                v += __builtin_bit_cast(float, __builtin_amdgcn_update_dpp(0, __builtin_bit_cast(int, v), 0x114, 0xF, 0xF, true));
                                v += __builtin_bit_cast(float, __builtin_amdgcn_update_dpp(0, __builtin_bit_cast(int, v), 0x118, 0xF, 0xF, true));
                                v += carry; acc[ai][bj][m][n][j] = v; carry = __shfl(v, (lane & 48) | 15); } }
#pragma unroll
            for (int ai = 0; ai < 2; ++ai) if (!TAIL || ai < nai)
#pragma unroll
                for (int m = 0; m < 4; ++m)
#pragma unroll
                    for (int bj = 0; bj < 2; ++bj) { unsigned short* lp = (unsigned short*)LOGF + (size_t)(row0 + ai * 128 + m * 16) * 512 + (colb + bj * 32 - 512); const f32x4 v0 = acc[ai][bj][m][0], v1 = acc[ai][bj][m][1];
                        *(u32x4*)lp = (u32x4){pkz_f16(v0[0], v0[1]), pkz_f16(v0[2], v0[3]), pkz_f16(v1[0], v1[1]), pkz_f16(v1[2], v1[3])}; }
        }
    }
};
typedef EpiInprojT<false> EpiInproj;
__device__ __forceinline__ void gate8(u32x2 w, f32x4& lo, f32x4& hi) {
    constexpr float s = 1.0f / 255.0f;
    lo = (f32x4){(float)(w.x & 255u), (float)((w.x >> 8) & 255u), (float)((w.x >> 16) & 255u), (float)(w.x >> 24)} * s;
    hi = (f32x4){(float)(w.y & 255u), (float)((w.y >> 8) & 255u), (float)((w.y >> 16) & 255u), (float)(w.y >> 24)} * s;
}
struct EpiMixed {
    static constexpr bool PERM = true;
    static constexpr bool BJADJ = true;
    const unsigned char* G8; bf16_t* MIXED;
    __device__ __forceinline__ bool keep(const pg8::Unit& u) const { return u.aux == 0; }
    __device__ __forceinline__ void operator()(f32x4 (&acc)[2][2][4][2], const pg8::Unit& u, int wr, int wc, int fr, int fq) const {
        const int row0 = u.pm * 256 + wr * 64 + fr, colb = u.pn * 256 + wc * 64 + 8 * fq;
        u32x2 gbn[2], gan[2];
#pragma unroll
        for (int bj = 0; bj < 2; ++bj) { gbn[bj] = *(const u32x2*)(G8 + (size_t)row0 * 2048 + 1024 + colb + bj * 32); gan[bj] = gbn[bj]; if (u.aux == 0) gan[bj] = *(const u32x2*)(G8 + (size_t)row0 * 2048 + colb + bj * 32); }
#pragma unroll
        for (int ai = 0; ai < 2; ++ai)
#pragma unroll
            for (int m = 0; m < 4; ++m) {
                const int row = row0 + ai * 128 + m * 16;
                u32x2 gb[2] = {gbn[0], gbn[1]}, ga[2] = {gan[0], gan[1]};
                if (ai * 4 + m < 7) { const int nrow = row0 + ((ai * 4 + m + 1) >> 2) * 128 + ((ai * 4 + m + 1) & 3) * 16;
#pragma unroll
                    for (int bj = 0; bj < 2; ++bj) { gbn[bj] = *(const u32x2*)(G8 + (size_t)nrow * 2048 + 1024 + colb + bj * 32); if (u.aux == 0) gan[bj] = *(const u32x2*)(G8 + (size_t)nrow * 2048 + colb + bj * 32); } }
                u32x4 wb[2];
#pragma unroll
                for (int bj = 0; bj < 2; ++bj) {
                    f32x4 b0, b1; gate8(gb[bj], b0, b1);
                    if (u.aux == 0) {
                        f32x4 a0, a1; gate8(ga[bj], a0, a1);
#pragma unroll
                        for (int j = 0; j < 4; ++j) { acc[ai][bj][m][0][j] *= a0[j] * __builtin_amdgcn_rcpf(b0[j]); acc[ai][bj][m][1][j] *= a1[j] * __builtin_amdgcn_rcpf(b1[j]); }
                    } else {
                        const f32x4 v0 = acc[ai][bj][m][0] * b0, v1 = acc[ai][bj][m][1] * b1;
                        wb[bj].x = pg8::cvt_pk_bf16(v0[0], v0[1]); wb[bj].y = pg8::cvt_pk_bf16(v0[2], v0[3]); wb[bj].z = pg8::cvt_pk_bf16(v1[0], v1[1]); wb[bj].w = pg8::cvt_pk_bf16(v1[2], v1[3]);
                    }
                }
                if (u.aux != 0) {
                    u32x4 ev, od; pair_rows(wb[0], wb[1], fr & 1, ev, od);
                    bf16_t* pp = MIXED + (size_t)(row - (fr & 1)) * D + colb + (fr & 1) * 32;
                    st_wt16(pp, ev); st_wt16(pp + D, od);
                }
            }
    }
};
struct EpiOutproj {
    static constexpr bool PERM = true;
    const float* x; const float* MOD; bf16_t* X1;
    __device__ __forceinline__ bool keep(const pg8::Unit&) const { return false; }
    __device__ __forceinline__ void operator()(f32x4 (&acc)[2][2][4][2], const pg8::Unit& u, int wr, int wc, int fr, int fq) const {
        const int row0 = u.pm * 256 + wr * 64 + fr, colb = u.pn * 256 + wc * 32 + 8 * fq;
        const int b = (u.pm * 256) / SEQ;
#pragma unroll
        for (int bj = 0; bj < 2; ++bj) {
            const int col = colb + bj * 128;
            const f32x4 g0 = *(const f32x4*)(MOD + b * 6144 + 2048 + col), g1 = *(const f32x4*)(MOD + b * 6144 + 2048 + col + 4);
#pragma unroll
            for (int ai = 0; ai < 2; ++ai)
#pragma unroll
                for (int m = 0; m < 4; ++m) { const size_t off = (size_t)(row0 + ai * 128 + m * 16) * D + col;
                    const f32x4 v0 = *(const f32x4*)(x + off) + g0 * acc[ai][bj][m][0], v1 = *(const f32x4*)(x + off + 4) + g1 * acc[ai][bj][m][1];
                    u32x4 w; w.x = pg8::cvt_pk_bf16(v0[0], v0[1]); w.y = pg8::cvt_pk_bf16(v0[2], v0[3]); w.z = pg8::cvt_pk_bf16(v1[0], v1[1]); w.w = pg8::cvt_pk_bf16(v1[2], v1[3]);
                    st_wt16(X1 + off, w); }
        }
    }
};
struct EpiOutNorm {
    static constexpr bool PERM = true;
    static constexpr bool BJADJ = true;
    const float* x; const float* MOD; const float* g2; bf16_t* X1; bf16_t* H; unsigned char* H8; float* XB; unsigned* cnt; LAS unsigned char* sl;
    __device__ __forceinline__ bool keep(const pg8::Unit&) const { return false; }
    __device__ __forceinline__ void operator()(f32x4 (&acc)[2][2][4][2], const pg8::Unit& u, int wr, int wc, int fr, int fq) const {
        const int tid = threadIdx.x;
        const int rl0 = wr * 64 + fr, row0 = u.pm * 256 + rl0, colb = u.pn * 256 + wc * 64 + 8 * fq;
        const int b = (u.pm * 256) / SEQ;
        LAS float* Pt = (LAS float*)sl; LAS float* Rs = (LAS float*)(sl + 4096); LAS float* GS = (LAS float*)(sl + 5120); LAS float* SH = (LAS float*)(sl + 6144);
        {
            f32x4 g[2][2];
#pragma unroll
            for (int bj = 0; bj < 2; ++bj) { g[bj][0] = *(const f32x4*)(MOD + b * 6144 + 2048 + colb + bj * 32); g[bj][1] = *(const f32x4*)(MOD + b * 6144 + 2048 + colb + bj * 32 + 4); }
            f32x4 xr[2][2][2];
            auto xload = [&](int k, f32x4 (&d)[2][2]) { const int bj = k >> 2, ai = (k >> 1) & 1, mp = k & 1;
#pragma unroll
                for (int mm = 0; mm < 2; ++mm) { const size_t off = (size_t)(row0 + ai * 128 + (2 * mp + mm) * 16) * D + colb + bj * 32; d[mm][0] = *(const f32x4*)(x + off); d[mm][1] = *(const f32x4*)(x + off + 4); } };
            xload(0, xr[0]);
#pragma unroll
            for (int k = 0; k < 8; ++k) { const int bj = k >> 2, ai = (k >> 1) & 1, mp = k & 1;
                if (k < 7) xload(k + 1, xr[(k + 1) & 1]);
#pragma unroll
                for (int mm = 0; mm < 2; ++mm) { const int m = 2 * mp + mm;
                    acc[ai][bj][m][0] = xr[k & 1][mm][0] + g[bj][0] * acc[ai][bj][m][0]; acc[ai][bj][m][1] = xr[k & 1][mm][1] + g[bj][1] * acc[ai][bj][m][1];
                    asm volatile("" : "+v"(acc[ai][bj][m][0]), "+v"(acc[ai][bj][m][1])); }
                asm volatile("" ::: "memory"); }
        }
#pragma unroll
        for (int ai = 0; ai < 2; ++ai)
#pragma unroll
            for (int m = 0; m < 4; ++m) { float q = 0.f;
#pragma unroll
                for (int bj = 0; bj < 2; ++bj)
#pragma unroll
                    for (int n = 0; n < 2; ++n) { const f32x4 v = acc[ai][bj][m][n]; q += (v[0] * v[0] + v[1] * v[1]) + (v[2] * v[2] + v[3] * v[3]); }
                q += __shfl_xor(q, 16); q += __shfl_xor(q, 32);
                if (fq == 0) Pt[(ai * 128 + rl0 + m * 16) * 4 + wc] = q; }
        asm volatile("s_waitcnt lgkmcnt(0)" ::: "memory"); __builtin_amdgcn_s_barrier(); asm volatile("" ::: "memory");
        if (tid < 256) { const f32x4 p = *(const LAS f32x4*)(Pt + tid * 4); st_wt4(XB + ((size_t)u.pm * 256 + tid) * 4 + u.pn, __builtin_bit_cast(unsigned, (p[0] + p[1]) + (p[2] + p[3]))); }
        asm volatile("s_waitcnt vmcnt(0)" ::: "memory"); __builtin_amdgcn_s_barrier(); asm volatile("" ::: "memory");
        if (tid == 0) { unsigned* p = cnt + (size_t)u.pm * 64; (void)xb_add(p, 1u); unsigned sp = 0u;
            while (xb_ld(p) < 4u) { __builtin_amdgcn_s_sleep(2); if (++sp > (1u << 22)) break; }
            __builtin_amdgcn_fence(__ATOMIC_ACQUIRE, "agent"); asm volatile("s_waitcnt vmcnt(0)" ::: "memory"); }
        __builtin_amdgcn_s_barrier(); asm volatile("" ::: "memory");
        if (tid < 256) { const f32x4 q = *(const f32x4*)(XB + ((size_t)u.pm * 256 + tid) * 4); Rs[tid] = rsqrtf(((q[0] + q[1]) + (q[2] + q[3])) * (1.f / D) + EPS); }
        else { const int c = tid - 256, col = u.pn * 256 + c; GS[c] = g2[col] * (1.0f + MOD[b * 6144 + 4096 + col]); SH[c] = MOD[b * 6144 + 3072 + col]; }
        asm volatile("s_waitcnt vmcnt(0) lgkmcnt(0)" ::: "memory"); __builtin_amdgcn_s_barrier(); asm volatile("" ::: "memory");
        const bool oddr = fr & 1, oddq = fq & 1;
#pragma unroll
        for (int ai = 0; ai < 2; ++ai)
#pragma unroll
            for (int m = 0; m < 4; ++m) { const int rl = ai * 128 + rl0 + m * 16; const float rs = Rs[rl];
                u32x4 xw[2], hw[2]; u32x2 h8[2];
#pragma unroll
                for (int bj = 0; bj < 2; ++bj) { const int cp = wc * 64 + bj * 32 + 8 * fq;
                    const f32x4 g0 = *(const LAS f32x4*)(GS + cp), g1 = *(const LAS f32x4*)(GS + cp + 4), s0 = *(const LAS f32x4*)(SH + cp), s1 = *(const LAS f32x4*)(SH + cp + 4);
                    const f32x4 v0 = acc[ai][bj][m][0], v1 = acc[ai][bj][m][1];
                    xw[bj].x = pg8::cvt_pk_bf16(v0[0], v0[1]); xw[bj].y = pg8::cvt_pk_bf16(v0[2], v0[3]); xw[bj].z = pg8::cvt_pk_bf16(v1[0], v1[1]); xw[bj].w = pg8::cvt_pk_bf16(v1[2], v1[3]);
                    const f32x4 h0 = v0 * rs * g0 + s0, h1 = v1 * rs * g1 + s1;
                    hw[bj].x = pg8::cvt_pk_bf16(h0[0], h0[1]); hw[bj].y = pg8::cvt_pk_bf16(h0[2], h0[3]); hw[bj].z = pg8::cvt_pk_bf16(h1[0], h1[1]); hw[bj].w = pg8::cvt_pk_bf16(h1[2], h1[3]);
                    h8[bj] = (u32x2){pk4_fp8(h0[0], h0[1], h0[2], h0[3]), pk4_fp8(h1[0], h1[1], h1[2], h1[3])}; }
                const size_t rowoff = (size_t)(u.pm * 256 + rl) * D + u.pn * 256 + wc * 64;
                const size_t offp = rowoff - (oddr ? D : 0) + 8 * fq + (oddr ? 32 : 0);
                u32x4 ev, od;
                pair_rows(xw[0], xw[1], oddr, ev, od); *(u32x4*)(X1 + offp) = ev; *(u32x4*)(X1 + offp + D) = od;
                pair_rows(hw[0], hw[1], oddr, ev, od); st_wt16(H + offp, ev); st_wt16(H + offp + D, od);
                const u32x2 snd = oddq ? h8[0] : h8[1];
                u32x2 rcv; rcv.x = (unsigned)__shfl_xor((int)snd.x, 16); rcv.y = (unsigned)__shfl_xor((int)snd.y, 16);
                const u32x4 w8 = oddq ? (u32x4){rcv.x, rcv.y, h8[1].x, h8[1].y} : (u32x4){h8[0].x, h8[0].y, rcv.x, rcv.y};
                st_wt16(H8 + rowoff + (fq & 1) * 32 + (fq >> 1) * 16, w8);
                asm volatile("" ::: "memory"); }
    }
};
struct EpiRouter {
    static constexpr bool PERM = true;
    static constexpr bool BJADJ = true;
    unsigned short* LOGITS4;
    __device__ __forceinline__ bool keep(const pg8::Unit&) const { return false; }
    __device__ __forceinline__ void operator()(f32x4 (&acc)[2][2][4][2], const pg8::Unit& u, int wr, int wc, int fr, int fq) const {
        const int row0 = u.pm * 256 + wr * 64 + fr, colb = wc * 64 + 8 * fq;
        unsigned short* base = LOGITS4 + (size_t)u.aux * T * 256;
#pragma unroll
        for (int ai = 0; ai < 2; ++ai)
#pragma unroll
            for (int m = 0; m < 4; ++m) { const int row = row0 + ai * 128 + m * 16;
                u32x4 wb[2];
#pragma unroll
                for (int bj = 0; bj < 2; ++bj) { const f32x4 v0 = acc[ai][bj][m][0], v1 = acc[ai][bj][m][1];
                    wb[bj].x = pk_f16(v0[0], v0[1]); wb[bj].y = pk_f16(v0[2], v0[3]); wb[bj].z = pk_f16(v1[0], v1[1]); wb[bj].w = pk_f16(v1[2], v1[3]); }
                u32x4 ev, od; pair_rows(wb[0], wb[1], fr & 1, ev, od);
                unsigned short* pp = base + (size_t)(row - (fr & 1)) * 256 + colb + (fr & 1) * 32;
                st_wt16(pp, ev); st_wt16(pp + 256, od); }
    }
};
struct RouterSched {
    static constexpr bool HALFSKIP = false;
    const char* A; const char* Bt; int G, c; bool own;
    __device__ __forceinline__ bool next(int i, pg8::Unit& u) const {
        const int L = i * G + c; if (L >= 256) return false;
        int pm = L >> 2, ks = L & 3;
        if (own) pg8::swz_tile(L, T / 256, D / 256, pm, ks);
        u.a = A + (size_t)pm * 256 * 2048 + ks * 512; u.b = Bt + ks * 512; u.rows = nullptr; u.pm = pm; u.pn = 0; u.aux = ks; u.nvalid = 256; return true;
    }
};
struct EpiGU {
    static constexpr bool PERM = true;
    static constexpr bool NO_LOADS = true;
    unsigned char* ACT;
    __device__ __forceinline__ bool keep(const pg8::Unit&) const { return false; }
    __device__ __forceinline__ void operator()(f32x4 (&acc)[2][2][4][2], const pg8::Unit& u, int wr, int wc, int fr, int fq) const {
        const int rl0 = wr * 64 + fr, col = u.pn * 128 + wc * 32 + 8 * fq;
        constexpr float is = 1.0f / WGU_SCALE;
#pragma unroll
        for (int ai = 0; ai < 2; ++ai)
#pragma unroll
            for (int m = 0; m < 4; ++m) {
                const int rl = rl0 + ai * 128 + m * 16;
                f32x4 v0, v1;
#pragma unroll
                for (int j = 0; j < 4; ++j) { const float a0 = acc[ai][0][m][0][j] * is, a1 = acc[ai][0][m][1][j] * is;
                    v0[j] = a0 * sigmoidf_(a0) * (acc[ai][1][m][0][j] * is); v1[j] = a1 * sigmoidf_(a1) * (acc[ai][1][m][1][j] * is); }
                *(u32x2*)(ACT + ((size_t)u.pm * 256 + rl) * EFF + col) = (u32x2){pk4_fp8(v0[0], v0[1], v0[2], v0[3]), pk4_fp8(v1[0], v1[1], v1[2], v1[3])};
                asm volatile("" ::: "memory");
            }
    }
};
struct EpiDown {
    static constexpr bool PERM = true;
    static constexpr bool NO_LOADS = true;
    static constexpr bool BJADJ = true;
    unsigned char* YBUF; const float* GWL; const int* LISTS;
    __device__ __forceinline__ bool keep(const pg8::Unit&) const { return false; }
    __device__ __forceinline__ void operator()(f32x4 (&acc)[2][2][4][2], const pg8::Unit& u, int wr, int wc, int fr, int fq) const {
        const int rl0 = wr * 64 + fr, colw = u.pn * 256 + wc * 64 + (fq & 1) * 32 + (fq >> 1) * 16;
        const bool odd = fq & 1;
        int slot[8]; float gw[8];
        const float* gwl = GWL + (u.rows - LISTS);
#pragma unroll
        for (int i = 0; i < 8; ++i) { const int rl = rl0 + (i >> 2) * 128 + (i & 3) * 16, ix = rl < u.nvalid ? rl : 0; slot[i] = u.rows[ix]; gw[i] = gwl[ix] * (YSCALE / WD_SCALE); }
#pragma unroll
        for (int ai = 0; ai < 2; ++ai)
#pragma unroll
            for (int m = 0; m < 4; ++m) {
                const int i = ai * 4 + m, rl = rl0 + ai * 128 + m * 16;
                const bool ok = rl < u.nvalid;
                u32x2 p[2];
#pragma unroll
                for (int bj = 0; bj < 2; ++bj) { const f32x4 v0 = acc[ai][bj][m][0] * gw[i], v1 = acc[ai][bj][m][1] * gw[i];
                    p[bj] = (u32x2){pk4_fp8(v0[0], v0[1], v0[2], v0[3]), pk4_fp8(v1[0], v1[1], v1[2], v1[3])}; }
                const u32x2 snd = odd ? p[0] : p[1];
                u32x2 rcv; rcv.x = (unsigned)__shfl_xor((int)snd.x, 16); rcv.y = (unsigned)__shfl_xor((int)snd.y, 16);
                const u32x4 w = odd ? (u32x4){rcv.x, rcv.y, p[1].x, p[1].y} : (u32x4){p[0].x, p[0].y, rcv.x, rcv.y};
                if (ok) *(u32x4*)(YBUF + (size_t)slot[i] * D + colw) = w;
            }
    }
};

template <bool HI> __device__ __forceinline__ unsigned fp8x2_bf16_(unsigned w) { const auto f = __builtin_amdgcn_cvt_pk_f32_fp8((int)w, HI); return pg8::cvt_pk_bf16(f[0], f[1]); }
__device__ __forceinline__ unsigned fp8x2_bf16(unsigned w, bool hi) { return hi ? fp8x2_bf16_<true>(w) : fp8x2_bf16_<false>(w); }
__device__ __forceinline__ u32x4 fp8x8_bf16(u32x2 w) { return (u32x4){fp8x2_bf16(w.x, false), fp8x2_bf16(w.x, true), fp8x2_bf16(w.y, false), fp8x2_bf16(w.y, true)}; }
__device__ __forceinline__ void fp8x8_f32(u32x2 w, float (&v)[8]) { const auto a = __builtin_amdgcn_cvt_pk_f32_fp8((int)w.x, false), b = __builtin_amdgcn_cvt_pk_f32_fp8((int)w.x, true), c = __builtin_amdgcn_cvt_pk_f32_fp8((int)w.y, false), d = __builtin_amdgcn_cvt_pk_f32_fp8((int)w.y, true);
    v[0] = a[0]; v[1] = a[1]; v[2] = b[0]; v[3] = b[1]; v[4] = c[0]; v[5] = c[1]; v[6] = d[0]; v[7] = d[1]; }
__device__ __forceinline__ void u8x8_f32(u32x2 w, float (&v)[8]) { constexpr float s = 1.0f / 255.0f;
    v[0] = (float)(w.x & 255u) * s; v[1] = (float)((w.x >> 8) & 255u) * s; v[2] = (float)((w.x >> 16) & 255u) * s; v[3] = (float)(w.x >> 24) * s;
    v[4] = (float)(w.y & 255u) * s; v[5] = (float)((w.y >> 8) & 255u) * s; v[6] = (float)((w.y >> 16) & 255u) * s; v[7] = (float)(w.y >> 24) * s; }
#define MFMA16(a, b, c) __builtin_amdgcn_mfma_f32_16x16x32_bf16((a), (b), (c), 0, 0, 0)
#define MFMA32(a, b, c) __builtin_amdgcn_mfma_f32_32x32x16_bf16((a), (b), (c), 0, 0, 0)
__device__ __forceinline__ s16x4 tr16(const LAS unsigned char* p) { return __builtin_amdgcn_ds_read_tr16_b64_v4i16((LAS s16x4*)p); }
__device__ __forceinline__ bf16x8 cat8(s16x4 a, s16x4 b) { bf16x8 r; r[0] = a[0]; r[1] = a[1]; r[2] = a[2]; r[3] = a[3]; r[4] = b[0]; r[5] = b[1]; r[6] = b[2]; r[7] = b[3]; return r; }
__device__ __forceinline__ u32x4 pack8(const float (&v)[8]) { u32x4 w; w.x = pg8::cvt_pk_bf16(v[0], v[1]); w.y = pg8::cvt_pk_bf16(v[2], v[3]); w.z = pg8::cvt_pk_bf16(v[4], v[5]); w.w = pg8::cvt_pk_bf16(v[6], v[7]); return w; }
__device__ __forceinline__ void unpack8(u32x4 w, float (&v)[8]) { v[0] = bflo(w.x); v[1] = bfhi(w.x); v[2] = bflo(w.y); v[3] = bfhi(w.y); v[4] = bflo(w.z); v[5] = bfhi(w.z); v[6] = bflo(w.w); v[7] = bfhi(w.w); }
__device__ __forceinline__ int swzA(int row) { return (row & 3) | (((row >> 3) & 1) << 2); }
__device__ __forceinline__ void hgrn_kv_unit(Ctx& X, int bn) {
    const int t0 = bn * 64;
    const bf16_t* PROJ = WSP(bf16_t, WS_PROJ); const unsigned short* BC = WSP(unsigned short, WS_LOGF);
#pragma unroll 4
    for (int j = 0; j < 8; ++j) {
        const int p = X.tid + NTHREADS * j, row = p >> 6, c64 = p & 63, h = c64 >> 4, ch = c64 & 15;
        const size_t prow = (size_t)(t0 + row) * INW + h * 128 + 8 * ch;
        const unsigned char* h8 = WSP(unsigned char, WS_HQ8) + (size_t)(t0 + row) * 2048 + h * 128 + 8 * ch;
        const u32x2 k8 = *(const u32x2*)(h8 + C_HK), v8 = *(const u32x2*)(h8 + C_HV); const u32x4 vraw = fp8x8_bf16(v8);
        const unsigned short* bp = BC + (size_t)(t0 + row) * 512 + h * 128 + 8 * ch; const unsigned short* bl = BC + (size_t)(t0 + 63) * 512 + h * 128 + 8 * ch;
        f32x4 b0, b1, l0, l1; f16x8_f32(*(const u32x4*)bp, b0, b1); f16x8_f32(*(const u32x4*)bl, l0, l1);
        float kv[8]; u8x8_f32(k8, kv);
#pragma unroll
        for (int e = 0; e < 4; ++e) { kv[e] *= __expf(l0[e] - b0[e]); kv[4 + e] *= __expf(l1[e] - b1[e]); }
        const int off = row * 256 + (((ch >> 1) ^ swzA(row)) * 32) + (ch & 1) * 16;
        *(LAS u32x4*)(X.lds + h * 32768 + off) = vraw; *(LAS u32x4*)(X.lds + h * 32768 + 16384 + off) = pack8(kv);
    }
    WSP(float, WS_DECAY)[bn * 512 + X.tid] = __expf((float)*(const _Float16*)(BC + (size_t)(t0 + 63) * 512 + X.tid));
    __syncthreads();
    const int l = X.lane, w = X.wave, fr = l & 15, fq = l >> 4, r = fr >> 2, p4 = l & 3, h = w >> 1, vt0 = 4 * (w & 1);
    const LAS unsigned char* VI = X.lds + h * 32768; const LAS unsigned char* KI = VI + 16384;
    bf16x8 af[4][2];
#pragma unroll
    for (int vt = 0; vt < 4; ++vt)
#pragma unroll
        for (int kk = 0; kk < 2; ++kk) { const int r0 = 32 * kk + 8 * fq + r, r1 = r0 + 4;
            af[vt][kk] = cat8(tr16(VI + r0 * 256 + (((vt0 + vt) ^ swzA(r0)) * 32) + p4 * 8), tr16(VI + r1 * 256 + (((vt0 + vt) ^ swzA(r1)) * 32) + p4 * 8)); }
    unsigned char* KVT = WSP(unsigned char, WS_KVT) + (size_t)(bn * 4 + h) * 16384;
#pragma unroll 2
    for (int ct = 0; ct < 8; ++ct) {
        bf16x8 bfr[2];
#pragma unroll
        for (int kk = 0; kk < 2; ++kk) { const int r0 = 32 * kk + 8 * fq + r, r1 = r0 + 4;
            bfr[kk] = cat8(tr16(KI + r0 * 256 + ((ct ^ swzA(r0)) * 32) + p4 * 8), tr16(KI + r1 * 256 + ((ct ^ swzA(r1)) * 32) + p4 * 8)); }
#pragma unroll
        for (int vt = 0; vt < 4; ++vt) { f32x4 acc = {0.f, 0.f, 0.f, 0.f}; acc = MFMA16(bfr[0], af[vt][0], acc); acc = MFMA16(bfr[1], af[vt][1], acc);
            *(unsigned*)(KVT + (16 * (vt0 + vt) + fr) * 128 + 16 * ct + 4 * fq) = pk4_fp8(acc[0], acc[1], acc[2], acc[3]); }
    }
    __syncthreads();
}
__device__ __forceinline__ void hgrn_passB(Ctx& X) {
    const unsigned short* KVT = WSP(unsigned short, WS_KVT)  ; const float* DECAY = WSP(float, WS_DECAY); unsigned* SPT = WSP(unsigned, WS_SPT);
    const int gt = X.wg * NTHREADS + X.tid, NGT = X.G * NTHREADS;
    for (int item = gt; item < 16 * 128 * 64; item += NGT) {
        const int bh = item >> 13, rem = item & 8191, vd = rem >> 6, c = (rem & 63) * 2, b = bh >> 2, h = bh & 3;
        float s0 = 0.f, s1 = 0.f;
        unsigned kw[2][8]; f32x2 dc[2][8];
#pragma unroll
        for (int i = 0; i < 8; ++i) { const int unit = (b * 64 + i) * 4 + h; kw[0][i] = KVT[((size_t)unit * 16384 + vd * 128 + c) >> 1]; dc[0][i] = *(const f32x2*)(DECAY + unit * 128 + c); }
#pragma unroll
        for (int nb = 0; nb < 8; ++nb) {
            if (nb < 7) {
#pragma unroll
                for (int i = 0; i < 8; ++i) { const int unit = (b * 64 + 8 * (nb + 1) + i) * 4 + h; kw[(nb + 1) & 1][i] = KVT[((size_t)unit * 16384 + vd * 128 + c) >> 1]; dc[(nb + 1) & 1][i] = *(const f32x2*)(DECAY + unit * 128 + c); } }
#pragma unroll
            for (int i = 0; i < 8; ++i) { const int unit = (b * 64 + 8 * nb + i) * 4 + h;
                SPT[((size_t)unit * 16384 + vd * 128 + c) >> 1] = pk2(s0, s1);
                const auto kv2 = __builtin_amdgcn_cvt_pk_f32_fp8((int)kw[nb & 1][i], false); s0 = dc[nb & 1][i].x * s0 + kv2[0]; s1 = dc[nb & 1][i].y * s1 + kv2[1]; }
        }
    }
}
__device__ __forceinline__ void hgrn_out_unit(Ctx& X, int u2) {
    const int bn = u2 >> 1, hp = u2 & 1, t0 = bn * 64;
    const bf16_t* PROJ = WSP(bf16_t, WS_PROJ); const unsigned short* BCg = WSP(unsigned short, WS_LOGF);
    const int l = X.lane, w = X.wave, fr = l & 15, fq = l >> 4, r = fr >> 2, p4 = l & 3, hh = w >> 2, h = 2 * hp + hh, ti = w & 3;
    const int tq = 16 * ti + fr;
    const bf16_t* SPT = WSP(bf16_t, WS_SPT) + (size_t)(bn * 4 + h) * 16384;
    bf16x8 sa[4][8];
#pragma unroll
    for (int ks = 0; ks < 4; ++ks)
#pragma unroll
        for (int vt = 0; vt < 8; ++vt) sa[ks][vt] = *(const bf16x8*)(SPT + (16 * vt + fr) * 128 + 32 * ks + 8 * fq);
    unsigned sgv[8];
#pragma unroll
    for (int vt = 0; vt < 8; ++vt) sgv[vt] = *(const unsigned*)(WSP(unsigned char, WS_HQ8) + (size_t)(t0 + tq) * 2048 + C_HG + h * 128 + 16 * vt + 4 * fq);
#pragma unroll 4
    for (int j = 0; j < 4; ++j) { const int p = X.tid + NTHREADS * j, row = p >> 5, c32 = p & 31, hh_ = c32 >> 4, ch = c32 & 15, h_ = 2 * hp + hh_;
        const size_t prow = (size_t)(t0 + row) * INW + h_ * 128 + 8 * ch;
        const unsigned char* h8 = WSP(unsigned char, WS_HQ8) + (size_t)(t0 + row) * 2048 + h_ * 128 + 8 * ch;
        const u32x2 q8 = *(const u32x2*)(h8 + C_HQ), k8 = *(const u32x2*)(h8 + C_HK), v8 = *(const u32x2*)(h8 + C_HV); const u32x4 vraw = fp8x8_bf16(v8);
        const unsigned short* bp = BCg + (size_t)(t0 + row) * 512 + h_ * 128 + 8 * ch; const unsigned short* br = BCg + (size_t)(t0 + 32) * 512 + h_ * 128 + 8 * ch;
        f32x4 b0, b1, r0, r1; f16x8_f32(*(const u32x4*)bp, b0, b1); f16x8_f32(*(const u32x4*)br, r0, r1);
        float qv[8], kv[8], a[8], bq[8]; fp8x8_f32(q8, qv); u8x8_f32(k8, kv);
#pragma unroll
        for (int e = 0; e < 4; ++e) { const float e0 = __expf(b0[e] - r0[e]), e1 = __expf(b1[e] - r1[e]);
            a[e] = qv[e] * e0; a[4 + e] = qv[4 + e] * e1; kv[e] *= __builtin_amdgcn_rcpf(e0); kv[4 + e] *= __builtin_amdgcn_rcpf(e1);
            bq[e] = qv[e] * __expf(b0[e]); bq[4 + e] = qv[4 + e] * __expf(b1[e]); }
        LAS unsigned char* hb = X.lds + hh_ * 65536; const int o16 = row * 256 + ((ch ^ (row & 15)) * 16);
        *(LAS u32x4*)(hb + o16) = pack8(a); *(LAS u32x4*)(hb + 16384 + o16) = pack8(kv); *(LAS u32x4*)(hb + 32768 + o16) = pack8(bq);
        *(LAS u32x4*)(hb + 49152 + row * 256 + (((ch >> 1) ^ (row & 7)) * 32) + (ch & 1) * 16) = vraw; }
    __syncthreads();
    const LAS unsigned char* QSI = X.lds + hh * 65536; const LAS unsigned char* KSI = QSI + 16384; const LAS unsigned char* QNI = QSI + 32768; const LAS unsigned char* VI = QSI + 49152;
    bf16x8 QS[4];
#pragma unroll
    for (int ks = 0; ks < 4; ++ks) QS[ks] = *(const LAS bf16x8*)(QSI + tq * 256 + (((4 * ks + fq) ^ (tq & 15)) * 16));
    f32x4 ST[4];
#pragma unroll
    for (int si = 0; si < 4; ++si) {
        f32x4 acc = {0.f, 0.f, 0.f, 0.f};
        if (si <= ti) {
            const int sr = 16 * si + fr;
#pragma unroll
            for (int ks = 0; ks < 4; ++ks) { const bf16x8 kf = *(const LAS bf16x8*)(KSI + sr * 256 + (((4 * ks + fq) ^ (sr & 15)) * 16)); acc = MFMA16(kf, QS[ks], acc); }
            if (si == ti) {
#pragma unroll
                for (int q = 0; q < 4; ++q) acc[q] = (4 * fq + q <= fr) ? acc[q] : 0.f; }
        }
        ST[si] = acc;
    }
    f32x4 o[8];
#pragma unroll
    for (int vt = 0; vt < 8; ++vt) o[vt] = (f32x4){0.f, 0.f, 0.f, 0.f};
#pragma unroll
    for (int kk = 0; kk < 2; ++kk) {
        if (2 * kk <= ti) {
            float pv[8];
#pragma unroll
            for (int q = 0; q < 4; ++q) { pv[q] = ST[2 * kk][q]; pv[4 + q] = ST[2 * kk + 1][q]; }
            const bf16x8 pf = __builtin_bit_cast(bf16x8, pack8(pv));
            const int r0 = 32 * kk + 4 * fq + r, r1 = r0 + 16;
#pragma unroll
            for (int vt = 0; vt < 8; ++vt) { const bf16x8 va = cat8(tr16(VI + r0 * 256 + ((vt ^ (r0 & 7)) * 32) + p4 * 8), tr16(VI + r1 * 256 + ((vt ^ (r1 & 7)) * 32) + p4 * 8));
                o[vt] = MFMA16(va, pf, o[vt]); }
        }
    }
#pragma unroll
    for (int ks = 0; ks < 4; ++ks) { const bf16x8 qn = *(const LAS bf16x8*)(QNI + tq * 256 + (((4 * ks + fq) ^ (tq & 15)) * 16));
#pragma unroll
        for (int vt = 0; vt < 8; ++vt) o[vt] = MFMA16(sa[ks][vt], qn, o[vt]); }
    float ss = 0.f;
#pragma unroll
    for (int vt = 0; vt < 8; ++vt) ss += (o[vt][0] * o[vt][0] + o[vt][1] * o[vt][1]) + (o[vt][2] * o[vt][2] + o[vt][3] * o[vt][3]);
    ss += __shfl_xor(ss, 16); ss += __shfl_xor(ss, 32);
    const float rstd = rsqrtf(ss * (1.f / 128.f) + EPS);
    bf16_t* YCAT = WSP(bf16_t, WS_YCAT);
    f32x4 gnv[8];
#pragma unroll
    for (int vt = 0; vt < 8; ++vt) gnv[vt] = *(const f32x4*)(X.g_hgrn + h * 128 + 16 * vt + 4 * fq);
#pragma unroll
    for (int vt = 0; vt < 8; ++vt) { const int vd = 16 * vt + 4 * fq;
        const auto sg0 = __builtin_amdgcn_cvt_pk_f32_fp8((int)sgv[vt], false), sg1 = __builtin_amdgcn_cvt_pk_f32_fp8((int)sgv[vt], true); const f32x4 gn = gnv[vt];
        u32x2 wv; wv.x = pg8::cvt_pk_bf16(o[vt][0] * rstd * gn[0] * sg0[0], o[vt][1] * rstd * gn[1] * sg0[1]); wv.y = pg8::cvt_pk_bf16(o[vt][2] * rstd * gn[2] * sg1[0], o[vt][3] * rstd * gn[3] * sg1[1]);
        *(u32x2*)(YCAT + (size_t)(t0 + tq) * D + h * 128 + vd) = wv; }
    __syncthreads();
}

struct AttnRegs { u32x4 k[3], v[3]; long q[4]; };
__device__ __forceinline__ void attn_load(Ctx& X, int unit, AttnRegs& R) {
    const int u16 = unit & 15, h = (unit >> 4) & 7, g = (unit >> 7) % 3, b = unit / 384;
    const int d = g == 0 ? 1 : g == 1 ? 4 : 16, nblk = 16 / d, r = u16 / nblk, blk = u16 % nblk;
    const int vcol = C_AV + g * 512 + h * 64;
    const int mk0 = blk * 256 - 128;
    const unsigned char* QK8 = WSP(unsigned char, WS_QK8);
    const int q8col = g * 512 + h * 64, k8col = 1536 + q8col, v8col = 3072 + q8col;
#pragma unroll
    for (int j = 0; j < 3; ++j) { const int idx = X.tid + NTHREADS * j, row = idx >> 2, ch = idx & 3, m = mk0 + row > 0 ? mk0 + row : 0;
        const size_t tok = (size_t)b * SEQ + (size_t)m * d + r; R.k[j] = *(const u32x4*)(QK8 + tok * 4608 + k8col + ch * 16); R.v[j] = *(const u32x4*)(QK8 + tok * 4608 + v8col + ch * 16); }
    const int l = X.lane, w = X.wave, q = l & 31, hi = l >> 5;
    const size_t tokq = (size_t)b * SEQ + (size_t)(blk * 256 + 32 * w + q) * d + r;
#pragma unroll
    for (int ds = 0; ds < 4; ++ds) R.q[ds] = *(const long*)(QK8 + tokq * 4608 + q8col + ds * 16 + hi * 8);
}
__device__ __forceinline__ void attn_stage(Ctx& X, const AttnRegs& R) {
    LAS unsigned char* KL = X.lds; LAS unsigned char* VL = X.lds + 55296;
#pragma unroll
    for (int j = 0; j < 3; ++j) { const int idx = X.tid + NTHREADS * j, row = idx >> 2, ch = idx & 3;
        *(LAS u32x4*)(KL + row * 80 + ch * 16) = R.k[j];
        u32x4 lo, hi2;
        lo.x = fp8x2_bf16(R.v[j].x, false); lo.y = fp8x2_bf16(R.v[j].x, true); lo.z = fp8x2_bf16(R.v[j].y, false); lo.w = fp8x2_bf16(R.v[j].y, true);
        hi2.x = fp8x2_bf16(R.v[j].z, false); hi2.y = fp8x2_bf16(R.v[j].z, true); hi2.z = fp8x2_bf16(R.v[j].w, false); hi2.w = fp8x2_bf16(R.v[j].w, true);
        *(LAS u32x4*)(VL + row * 128 + ch * 32) = lo; *(LAS u32x4*)(VL + row * 128 + ch * 32 + 16) = hi2; }
    LAS long* QL = (LAS long*)(X.lds + 104448 + X.tid * 32);
    QL[0] = R.q[0]; QL[1] = R.q[1]; QL[2] = R.q[2]; QL[3] = R.q[3];
}
__device__ __forceinline__ void attn_compute(Ctx& X, int unit) {
    const int u16 = unit & 15, h = (unit >> 4) & 7, g = (unit >> 7) % 3, b = unit / 384;
    const int d = g == 0 ? 1 : g == 1 ? 4 : 16, nblk = 16 / d, r = u16 / nblk, blk = u16 % nblk;
    const int mk0 = blk * 256 - 128;
    LAS unsigned char* KL = X.lds; LAS unsigned char* VL = X.lds + 55296;
    const int l = X.lane, w = X.wave, q = l & 31, hi = l >> 5;
    const size_t tokq = (size_t)b * SEQ + (size_t)(blk * 256 + 32 * w + q) * d + r;
    long qf[4];
    { const LAS long* QL = (const LAS long*)(X.lds + 104448 + X.tid * 32); qf[0] = QL[0]; qf[1] = QL[1]; qf[2] = QL[2]; qf[3] = QL[3]; }
    f32x16 s[5];
#pragma unroll
    for (int kt = 0; kt < 5; ++kt) {
        f32x16 acc;
#pragma unroll
        for (int i = 0; i < 16; ++i) acc[i] = 0.f;
#pragma unroll
        for (int ds = 0; ds < 4; ++ds) { const long kf = *(const LAS long*)(KL + (32 * w + 32 * kt + q) * 80 + ds * 16 + hi * 8); acc = __builtin_amdgcn_mfma_f32_32x32x16_fp8_fp8(kf, qf[ds], acc, 0, 0, 0); }
        s[kt] = acc;
    }
    const int iq = 32 * w + q;
    const int jmin = iq > -mk0 ? iq : -mk0;
    const int tlo = jmin - (32 * w + 4 * hi), thi = iq + 128 - (32 * w + 128 + 4 * hi), tst = -mk0 - (32 * w + 4 * hi);
    float mx = -INFINITY;
#pragma unroll
    for (int kt = 0; kt < 5; ++kt) {
        const bool chk = kt == 0 || kt == 4 || (32 * w + 32 * kt < -mk0);
        if (chk) {
#pragma unroll
            for (int rg = 0; rg < 16; ++rg) { const int c = (rg & 3) + 8 * (rg >> 2);
                const bool valid = kt == 0 ? (c >= tlo) : kt == 4 ? (c <= thi) : (c + 32 * kt >= tst);
                s[kt][rg] = valid ? s[kt][rg] : -INFINITY; if ((rg & 3) == 3) __builtin_amdgcn_sched_barrier(0); }
        }
#pragma unroll
        for (int rg = 0; rg < 16; ++rg) mx = fmaxf(mx, s[kt][rg]);
    }
    mx = fmaxf(mx, __shfl_xor(mx, 32));
    const float c2 = 0.125f * 1.4426950408889634f, mxs = mx * c2;
    float lsum = 0.f;
#pragma unroll
    for (int kt = 0; kt < 5; ++kt)
#pragma unroll
        for (int rg = 0; rg < 16; ++rg) { const float p = __builtin_amdgcn_exp2f(__builtin_fmaf(s[kt][rg], c2, -mxs)); s[kt][rg] = p; lsum += p; }
    lsum += __shfl_xor(lsum, 32);
    f32x16 o[2];
#pragma unroll
    for (int dt = 0; dt < 2; ++dt)
#pragma unroll
        for (int i = 0; i < 16; ++i) o[dt][i] = 0.f;
    const int vlane = ((l & 15) >> 2) * 128 + (((l >> 4) & 1) * 16 + (l & 3) * 4) * 2;
#pragma unroll
    for (int kt = 0; kt < 5; ++kt)
#pragma unroll
        for (int s2 = 0; s2 < 2; ++s2) {
            bf16x8 pb;
#pragma unroll
            for (int j = 0; j < 8; j += 2) { const unsigned pw = pg8::cvt_pk_bf16(s[kt][8 * s2 + j], s[kt][8 * s2 + j + 1]); pb[j] = (short)(pw & 0xffffu); pb[j + 1] = (short)(pw >> 16); }
            const int key0 = 32 * w + 32 * kt + 16 * s2 + 4 * hi;
#pragma unroll
            for (int dt = 0; dt < 2; ++dt) {
                LAS unsigned char* vp = VL + key0 * 128 + dt * 64 + vlane;
                const s16x4 t0 = __builtin_amdgcn_ds_read_tr16_b64_v4i16((LAS s16x4*)vp);
                const s16x4 t1 = __builtin_amdgcn_ds_read_tr16_b64_v4i16((LAS s16x4*)(vp + 8 * 128));
                bf16x8 va; va[0] = t0[0]; va[1] = t0[1]; va[2] = t0[2]; va[3] = t0[3]; va[4] = t1[0]; va[5] = t1[1]; va[6] = t1[2]; va[7] = t1[3];
                o[dt] = MFMA32(va, pb, o[dt]);
            }
        }
    const float inv = 1.0f / lsum;
    unsigned char* OG = WSP(unsigned char, WS_OG) + (size_t)g * T * 512;
#pragma unroll
    for (int dt = 0; dt < 2; ++dt)
#pragma unroll
        for (int pp = 0; pp < 2; ++pp) {
            f32x4 mine, snd;
#pragma unroll
            for (int i = 0; i < 4; ++i) { const float e = o[dt][4 * (2 * pp) + i] * inv, od = o[dt][4 * (2 * pp + 1) + i] * inv; mine[i] = hi ? od : e; snd[i] = hi ? e : od; }
            f32x4 rcv;
#pragma unroll
            for (int i = 0; i < 4; ++i) rcv[i] = __shfl_xor(snd[i], 32);
            const f32x4 lo4 = hi ? rcv : mine, hi4 = hi ? mine : rcv;
            *(u32x2*)(OG + tokq * 512 + h * 64 + 32 * dt + 16 * pp + 8 * hi) = (u32x2){pk4_fp8(lo4[0], lo4[1], lo4[2], lo4[3]), pk4_fp8(hi4[0], hi4[1], hi4[2], hi4[3])};
        }
    WSP(float, WS_LSE)[((size_t)g * T + tokq) * 8 + h] = mx * 0.125f + __logf(lsum);
}
__device__ __forceinline__ void attn_combine(Ctx& X) {
    const unsigned char* OG = WSP(unsigned char, WS_OG); const float* LSE = WSP(float, WS_LSE); bf16_t* YCAT = WSP(bf16_t, WS_YCAT);
    const int gt = X.wg * NTHREADS + X.tid, NGT = X.G * NTHREADS;
    for (int item0 = gt; item0 < T * 64; item0 += 4 * NGT) {
        u32x2 a[4], bq[4], cq[4]; float l0[4], l1[4], l2[4];
#pragma unroll
        for (int k = 0; k < 4; ++k) { const int item = item0 + k * NGT < T * 64 ? item0 + k * NGT : item0; const int t = item >> 6, ch = item & 63, h = ch >> 3;
            l0[k] = LSE[(size_t)t * 8 + h]; l1[k] = LSE[((size_t)T + t) * 8 + h]; l2[k] = LSE[((size_t)2 * T + t) * 8 + h];
            a[k] = *(const u32x2*)(OG + (size_t)t * 512 + ch * 8); bq[k] = *(const u32x2*)(OG + ((size_t)T + t) * 512 + ch * 8); cq[k] = *(const u32x2*)(OG + ((size_t)2 * T + t) * 512 + ch * 8); }
#pragma unroll
        for (int k = 0; k < 4; ++k) { const int item = item0 + k * NGT; if (item >= T * 64) break; const int t = item >> 6, ch = item & 63;
            const float m = fmaxf(l0[k], fmaxf(l1[k], l2[k])); float w0 = __expf(l0[k] - m), w1 = __expf(l1[k] - m), w2 = __expf(l2[k] - m); const float inv = __builtin_amdgcn_rcpf(w0 + w1 + w2); w0 *= inv; w1 *= inv; w2 *= inv;
            float fa[8], fb[8], fc[8]; fp8x8_f32(a[k], fa); fp8x8_f32(bq[k], fb); fp8x8_f32(cq[k], fc);
            u32x4 o;
#pragma unroll
            for (int j = 0; j < 4; ++j) o[j] = pk2(w0 * fa[2 * j] + w1 * fb[2 * j] + w2 * fc[2 * j], w0 * fa[2 * j + 1] + w1 * fb[2 * j + 1] + w2 * fc[2 * j + 1]);
            *(u32x4*)(YCAT + (size_t)t * D + 512 + ch * 8) = o; }
    }
}

__device__ __forceinline__ unsigned sortable_key(float f) { const unsigned u = __builtin_bit_cast(unsigned, f); return (u & 0x80000000u) ? ~u : (u | 0x80000000u); }
template <bool LOCAL> __device__ __forceinline__ void moe_route_t(Ctx& X) {
    constexpr bool local = LOCAL;
    const unsigned short* LG = WSP(unsigned short, WS_KVT); unsigned* CNT = WSP(unsigned, WS_CTL) + CW_CNT; int* LISTS = WSP(int, WS_LISTS); float* GWL = WSP(float, WS_GWL);
    const int gw = X.wg * NWAVES + X.wave, NGW = X.G * NWAVES, l = X.lane, grp = l >> 3;
    const f32x4 bias = *(const f32x4*)(X.rbias + 4 * l);
    const unsigned long long ltmask = (1ull << l) - 1ull;
    const int tbeg = local ? X.wg * 64 + X.wave : gw, tend = local ? X.wg * 64 + 64 : T, tstep = local ? NWAVES : NGW;
    LAS int* hist = (LAS int*)X.lds; LAS int* ent = (LAS int*)(X.lds + 2048); LAS float* entw = (LAS float*)(X.lds + 4096);
    if (LOCAL) { if (X.tid < 256) hist[X.tid] = 0; __syncthreads(); }
    u32x2 wn[4];
#pragma unroll
    for (int ks = 0; ks < 4; ++ks) wn[ks] = *(const u32x2*)(LG + ((size_t)ks * T + (tbeg < tend ? tbeg : 0)) * 256 + 4 * l);
    for (int t = tbeg; t < tend; t += tstep) {
        f32x4 lg = {0.f, 0.f, 0.f, 0.f};
#pragma unroll
        for (int ks = 0; ks < 4; ++ks) lg += (f32x4){f16lo(wn[ks].x), f16hi(wn[ks].x), f16lo(wn[ks].y), f16hi(wn[ks].y)};
        { const int tn = t + tstep < tend ? t + tstep : t;
#pragma unroll
          for (int ks = 0; ks < 4; ++ks) wn[ks] = *(const u32x2*)(LG + ((size_t)ks * T + tn) * 256 + 4 * l); }
        float sc[4], mb[4];
#pragma unroll
        for (int i = 0; i < 4; ++i) { sc[i] = sigmoidf_(lg[i]); mb[i] = sc[i] + bias[i]; }
        float m1 = fmaxf(mb[0], mb[1]), m2 = fminf(mb[0], mb[1]);
        { const float a1 = fmaxf(mb[2], mb[3]), a2 = fminf(mb[2], mb[3]); const float n1 = fmaxf(m1, a1), n2 = fmaxf(fminf(m1, a1), fmaxf(m2, a2)); m1 = n1; m2 = n2; }
#pragma unroll
        for (int o = 1; o < 8; o <<= 1) { const float a1 = __shfl_xor(m1, o), a2 = __shfl_xor(m2, o); const float n1 = fmaxf(m1, a1), n2 = fmaxf(fminf(m1, a1), fmaxf(m2, a2)); m1 = n1; m2 = n2; }
        const float gs = m1 + m2;
        int rank = 0;
#pragma unroll
        for (int gg = 0; gg < 8; ++gg) { const float og = __builtin_bit_cast(float, __builtin_amdgcn_readlane(__builtin_bit_cast(int, gs), gg * 8)); rank += (og > gs || (og == gs && gg < grp)) ? 1 : 0; }
        const bool sel = rank < 4;
        unsigned key[4];
#pragma unroll
        for (int i = 0; i < 4; ++i) key[i] = sel ? sortable_key(mb[i]) : 0u;
        int tkb = 0; bool take[4] = {false, false, false, false};
#pragma unroll 2
        for (int r = 0; r < TOPK; ++r) {
            unsigned m = key[0] > key[1] ? key[0] : key[1]; { const unsigned m2 = key[2] > key[3] ? key[2] : key[3]; m = m > m2 ? m : m2; }
#define DPPMAX(ctrl, rmask) { const unsigned o = (unsigned)__builtin_amdgcn_update_dpp(0, (int)m, ctrl, rmask, 0xF, false); m = m > o ? m : o; }
            DPPMAX(0x111, 0xF) DPPMAX(0x112, 0xF) DPPMAX(0x114, 0xF) DPPMAX(0x118, 0xF) DPPMAX(0x142, 0xA) DPPMAX(0x143, 0xC)
#undef DPPMAX
            const unsigned mx = (unsigned)__builtin_amdgcn_readlane((int)m, 63);
            const unsigned long long any = __ballot(key[0] == mx || key[1] == mx || key[2] == mx || key[3] == mx);
            const int ln = __ffsll((long long)any) - 1;
            if (l == ln) {
                if (key[0] == mx) { take[0] = true; key[0] = 0u; } else if (key[1] == mx) { take[1] = true; key[1] = 0u; }
                else if (key[2] == mx) { take[2] = true; key[2] = 0u; } else { take[3] = true; key[3] = 0u; } }
        }
#pragma unroll
        for (int i = 0; i < 4; ++i) tkb += __popcll(__ballot(take[i]) & ltmask);
        float part = 0.f;
#pragma unroll
        for (int i = 0; i < 4; ++i) part += take[i] ? sc[i] : 0.f;
        const float scale = 2.5f / wave_sum(part);
        int slot = tkb;
#pragma unroll
        for (int i = 0; i < 4; ++i) if (take[i]) { const int e = 4 * l + i;
            if (LOCAL) { const int rk = __hip_atomic_fetch_add(hist + e, 1, __ATOMIC_RELAXED, __HIP_MEMORY_SCOPE_WORKGROUP); ent[(t - X.wg * 64) * 8 + slot] = e | (rk << 16); entw[(t - X.wg * 64) * 8 + slot] = sc[i] * scale; }
            else { const unsigned pos = atomicAdd(&CNT[e * 64], 1u); LISTS[(size_t)e * 16384 + pos] = t * NSLOT + slot; GWL[(size_t)e * 16384 + pos] = sc[i] * scale; }
            ++slot; }
        if (l == 0) { LISTS[(size_t)NE * 16384 + t] = t * NSLOT + TOPK; GWL[(size_t)NE * 16384 + t] = 1.0f; }
    }
    if (LOCAL) {
        __syncthreads();
        if (X.tid < 256) { const int c = hist[X.tid]; hist[X.tid] = c > 0 ? (int)atomicAdd(&CNT[X.tid * 64], (unsigned)c) : 0; }
        __syncthreads();
        { const int en = ent[X.tid], e = en & 0xffff, rk = en >> 16; const size_t at = (size_t)e * 16384 + hist[e] + rk; LISTS[at] = (X.wg * 64 + (X.tid >> 3)) * NSLOT + (X.tid & 7); GWL[at] = entw[X.tid]; }
        __syncthreads();
    }
}
__device__ __forceinline__ void moe_route(Ctx& X, bool local) { if (local) moe_route_t<true>(X); else moe_route_t<false>(X); }
__device__ __forceinline__ int moe_table(Ctx& X) {
    LAS int* tbl = (LAS int*)(X.lds + TBL_OFF); LAS int* cnts = (LAS int*)(X.lds + TCNT_OFF); LAS int* pref = cnts + 320;
    const unsigned* CNT = WSP(unsigned, WS_CTL) + CW_CNT;
    const int x = X.wg & 7;
    if (X.tid < NEX) cnts[X.tid] = X.tid < NE ? (int)__hip_atomic_load(CNT + X.tid * 64, __ATOMIC_RELAXED, __HIP_MEMORY_SCOPE_AGENT) : T;
    __syncthreads();
    if (X.tid < NEX) { int pre = 0; for (int e = 0; e < X.tid; ++e) pre += (cnts[e] + 255) >> 8; pref[X.tid] = pre; }
    __syncthreads();
    if (X.tid < 33) {
        const int i = X.tid; int lp = 0; for (int k = 0; k < i && k < 32; ++k) lp += (cnts[x + 8 * k] + 255) >> 8;
        if (i < 32) { const int e = x + 8 * i, n = (cnts[e] + 255) >> 8, p0 = pref[e]; for (int r = 0; r < n; ++r) tbl[lp + r] = ((p0 + r) << 16) | (e << 7) | r; }
        else { const int p0 = pref[NE]; for (int r8 = 0; r8 < 8; ++r8) { const int r = 8 * x + r8; tbl[lp + r8] = ((p0 + r) << 16) | (NE << 7) | r; } cnts[600] = lp + 8; }
    }
    __syncthreads();
    return __builtin_amdgcn_readfirstlane(cnts[600]);
}
__device__ __forceinline__ void final_rows(Ctx& X) {
    const bf16_t* X1 = WSP(bf16_t, WS_X1); const float* MOD = WSP(float, WS_MOD); const unsigned char* YBUF = WSP(unsigned char, WS_YBUF);
    const int gw = X.wg * NWAVES + X.wave, NGW = X.G * NWAVES, l = X.lane;
    for (int t = gw; t < T; t += NGW) {
        const int b = t / SEQ; f32x4 v[2][2]; float s = 0.f;
#pragma unroll
        for (int j = 0; j < 2; ++j) { const int col = 8 * l + 512 * j; f32x4 m0 = {0.f, 0.f, 0.f, 0.f}, m1 = {0.f, 0.f, 0.f, 0.f};
#pragma unroll
            for (int k = 0; k < NSLOT; ++k) { const u32x2 y = __builtin_nontemporal_load((const u32x2*)(YBUF + ((size_t)t * NSLOT + k) * D + col));
                const f32x2 a = __builtin_amdgcn_cvt_pk_f32_fp8((int)y.x, false), bq = __builtin_amdgcn_cvt_pk_f32_fp8((int)y.x, true), c = __builtin_amdgcn_cvt_pk_f32_fp8((int)y.y, false), d = __builtin_amdgcn_cvt_pk_f32_fp8((int)y.y, true);
                m0.x += a[0]; m0.y += a[1]; m0.z += bq[0]; m0.w += bq[1]; m1.x += c[0]; m1.y += c[1]; m1.z += d[0]; m1.w += d[1]; }
            const f32x4 g0 = *(const f32x4*)(MOD + b * 6144 + 5120 + col) * (1.0f / YSCALE), g1 = *(const f32x4*)(MOD + b * 6144 + 5120 + col + 4) * (1.0f / YSCALE);
            const u32x4 xw = *(const u32x4*)(X1 + (size_t)t * D + col); const f32x4 x0 = {bflo(xw.x), bfhi(xw.x), bflo(xw.y), bfhi(xw.y)}, x1 = {bflo(xw.z), bfhi(xw.z), bflo(xw.w), bfhi(xw.w)};
            v[j][0] = x0 + g0 * m0; v[j][1] = x1 + g1 * m1;
#pragma unroll
            for (int q = 0; q < 2; ++q) s += (v[j][q].x * v[j][q].x + v[j][q].y * v[j][q].y) + (v[j][q].z * v[j][q].z + v[j][q].w * v[j][q].w); }
        const float rstd = rsqrtf(wave_sum(s) * (1.f / D) + EPS);
#pragma unroll
        for (int j = 0; j < 2; ++j) { const int col = 8 * l + 512 * j;
            *(f32x4*)(X.out + (size_t)t * D + col) = v[j][0] * rstd * *(const f32x4*)(X.g_final + col); *(f32x4*)(X.out + (size_t)t * D + col + 4) = v[j][1] * rstd * *(const f32x4*)(X.g_final + col + 4); }
    }
}

__device__ __forceinline__ unsigned* panel_word(Ctx& X, int bank, int pm) { return WSP(unsigned, WS_CTL) + CW_PANEL + (bank * 64 + pm) * 64; }
__device__ __forceinline__ void panel_signal(Ctx& X, int bank, int pm) {
    asm volatile("s_waitcnt vmcnt(0)" ::: "memory"); __syncthreads();
    if (X.tid == 0) (void)xb_add(panel_word(X, bank, pm), 1u);
}
__device__ __forceinline__ void panel_wait(Ctx& X, int bank, int pm, unsigned target) {
    if (X.tid == 0) { unsigned* p = panel_word(X, bank, pm); unsigned sp = 0u;
        while (xb_ld(p) < target) { __builtin_amdgcn_s_sleep(2); if (++sp > (1u << 22)) break; }
        __builtin_amdgcn_fence(__ATOMIC_ACQUIRE, "agent"); asm volatile("s_waitcnt vmcnt(0)" ::: "memory"); }
    __syncthreads();
}

constexpr int NG_INPROJ = 176;
__device__ __forceinline__ void ph_inproj(Ctx& X) {
    const int ng = X.G > NG_INPROJ + 8 ? NG_INPROJ : X.G;
    if (X.wg < ng) {
        constexpr int NT = (T / 256) * (INW / 256);
        const int R = NT / ng, rem = NT - R * ng;
        RoundsSched S{(const char*)WSP(bf16_t, WS_H), (const char*)WSP(bf16_t, WS_WIN), (size_t)256 * 2048, (size_t)256 * 2048, T / 256, INW / 256, ng, X.wg, R * ng};
        EpiInproj E{WSP(bf16_t, WS_PROJ), WSP(float, WS_LOGF), WSP(float, WS_LB), WSP(float, WS_ROPE), WSP(unsigned char, WS_G8), WSP(unsigned char, WS_QK8), WSP(unsigned char, WS_HQ8)};
        pg8::gemm_phase<EpiInproj, RoundsSched, true, false>(X.lds, 1024, 1024, 1024, S, E);
        if (rem > 0) {
            TailSched S2{(const char*)WSP(bf16_t, WS_H), (const char*)WSP(bf16_t, WS_WIN), (size_t)256 * 2048, (size_t)256 * 2048, T / 256, INW / 256, ng, X.wg, R * ng, rem};
            EpiInprojT<true> E2{WSP(bf16_t, WS_PROJ), WSP(float, WS_LOGF), WSP(float, WS_LB), WSP(float, WS_ROPE), WSP(unsigned char, WS_G8), WSP(unsigned char, WS_QK8), WSP(unsigned char, WS_HQ8)};
            pg8::gemm_phase<EpiInprojT<true>, TailSched, true, false>(X.lds, 1024, 1024, 1024, S2, E2);
        }
    }
    if (ng == X.G) expert_convert(X, X.wg, X.G);
    else if (X.wg >= ng) expert_convert(X, X.wg - ng, X.G - ng);
}
__device__ __forceinline__ void ph_mix_a(Ctx& X) {
    for (int it = X.wg; it < 256; it += X.G) hgrn_kv_unit(X, it);
    AttnRegs Ra, Rb; int unit = X.wg;
    auto clampu = [](int u) { return u < 1536 ? u : 1535; };
    attn_load(X, clampu(unit), Ra);
    __builtin_amdgcn_sched_barrier(0);
    attn_load(X, clampu(unit + X.G), Rb);
    __builtin_amdgcn_sched_barrier(0);
#define ATTN_STEP(R_) do { attn_stage(X, R_); __syncthreads(); __builtin_amdgcn_sched_barrier(0); attn_load(X, clampu(unit + 2 * X.G), R_); __builtin_amdgcn_sched_barrier(0); \
        attn_compute(X, unit); __syncthreads(); unit += X.G; } while (0)
    if (unit < 1536) {
        ATTN_STEP(Ra);
        while (unit < 1536) {
            ATTN_STEP(Rb);
            if (unit >= 1536) break;
            ATTN_STEP(Ra);
        }
    }
#undef ATTN_STEP
}
__device__ __forceinline__ void ph_mix_c(Ctx& X) { for (int it = X.wg; it < 512; it += X.G) hgrn_out_unit(X, it); attn_combine(X); }
__device__ __forceinline__ void ph_mixed(Ctx& X, bool chain) {
    TwoPartSched S{(const char*)WSP(bf16_t, WS_YCAT), (const char*)WSP(bf16_t, WS_WPA), (const char*)WSP(bf16_t, WS_WPB), T / 256, D / 256, X.G, X.wg};
    EpiMixed E{WSP(unsigned char, WS_G8), WSP(bf16_t, WS_MIXED)};
    pg8::gemm_phase<EpiMixed, TwoPartSched, true, false>(X.lds, 1024, 512, 512, S, E);
    if (chain) { int pm, pn; pg8::swz_tile(X.wg, T / 256, D / 256, pm, pn); panel_signal(X, 0, pm); }
}
__device__ __forceinline__ void ph_outproj(Ctx& X, bool chain) {
    int pm = 0, pn = 0; pg8::swz_tile(X.wg < 256 ? X.wg : 0, T / 256, D / 256, pm, pn);
    RegSched S{(const char*)WSP(bf16_t, WS_MIXED), (const char*)WSP(bf16_t, WS_WOUT), (size_t)256 * 2048, (size_t)256 * 2048, T / 256, D / 256, X.G, X.wg};
    if (chain) {
        panel_wait(X, 0, pm, 4u);
        EpiOutNorm E{X.x, WSP(float, WS_MOD), X.g2, WSP(bf16_t, WS_X1), WSP(bf16_t, WS_H), WSP(unsigned char, WS_H8), WSP(float, WS_XB), panel_word(X, 1, 0), X.lds + 139264};
        pg8::gemm_phase<EpiOutNorm, RegSched, true, false>(X.lds, 1024, 1024, 1024, S, E);
        panel_signal(X, 2, pm);
    } else {
        EpiOutproj E{X.x, WSP(float, WS_MOD), WSP(bf16_t, WS_X1)};
        pg8::gemm_phase<EpiOutproj, RegSched, false, false>(X.lds, 1024, 1024, 1024, S, E);
    }
}
__device__ __forceinline__ void ph_norm2(Ctx& X, bool chain) { if (!chain) norm_rows(X, 1); }
__device__ __forceinline__ void ph_router(Ctx& X, bool chain) {
    RouterSched S{(const char*)WSP(bf16_t, WS_H), (const char*)WSP(bf16_t, WS_WR), X.G, X.wg, chain};
    EpiRouter E{WSP(unsigned short, WS_KVT)};
    pg8::gemm_phase<EpiRouter, RouterSched, false, false>(X.lds, 1024, 1024, 256, S, E);
    if (chain) { int pm, pn; pg8::swz_tile(X.wg, T / 256, D / 256, pm, pn); panel_signal(X, 3, pm); }
}
__device__ __forceinline__ void ph_route(Ctx& X, bool chain) {
    if (chain) panel_wait(X, 3, X.wg >> 2, 4u);
    moe_route(X, chain);
}
__device__ __forceinline__ void ph_gu(Ctx& X) {
    const int nent = moe_table(X);
    MoeSched S{(const LAS int*)(X.lds + TBL_OFF), (const LAS int*)(X.lds + TCNT_OFF), nent, (const char*)WSP(unsigned char, WS_H8), (const char*)WSP(unsigned char, WS_WGU), WSP(int, WS_LISTS), 2, 256 * 1024, 512 * 1024, 0, X.G, X.wg};
    EpiGU E{WSP(unsigned char, WS_ACT)};
    pg8::gemm_phase<EpiGU, MoeSched, true, true, true>(X.lds, 512, 512, 512, S, E);
}
__device__ __forceinline__ void ph_down(Ctx& X, bool table_in_lds) {
    const int nent = table_in_lds ? __builtin_amdgcn_readfirstlane(((const LAS int*)(X.lds + TCNT_OFF))[600]) : moe_table(X);
    MoeSched S{(const LAS int*)(X.lds + TBL_OFF), (const LAS int*)(X.lds + TCNT_OFF), nent, (const char*)WSP(unsigned char, WS_ACT), (const char*)WSP(unsigned char, WS_WD), WSP(int, WS_LISTS), 4, 256 * 256, 1024 * 256, 256 * 256, X.G, X.wg};
    EpiDown E{WSP(unsigned char, WS_YBUF), WSP(float, WS_GWL), WSP(int, WS_LISTS)};
    pg8::gemm_phase<EpiDown, MoeSched, true, false, true>(X.lds, 128, 128, 128, S, E);
}

constexpr int NPHASE = 14;
struct Args { const void* in[20]; float* out; unsigned char* ws; int ph_lo, ph_hi; };
__device__ __forceinline__ void ctl_init(Ctx& X) {
    unsigned* ctl = WSP(unsigned, WS_CTL);
    for (int w = CW_ZERO_LO + 4 * X.tid; w < CW_ZERO_HI; w += 4 * NTHREADS) st_wt16(ctl + w, (u32x4){0u, 0u, 0u, 0u});
    asm volatile("s_waitcnt vmcnt(0)" ::: "memory"); __syncthreads();
    if (X.tid == 0) { __builtin_amdgcn_fence(__ATOMIC_RELEASE, "agent"); __hip_atomic_store((unsigned long long*)(ctl + CW_READY), CTL_MAGIC, __ATOMIC_RELAXED, __HIP_MEMORY_SCOPE_AGENT); }
}
__device__ __forceinline__ void ctl_wait(Ctx& X) {
    if (X.tid == 0) { unsigned long long* p = (unsigned long long*)(WSP(unsigned, WS_CTL) + CW_READY); unsigned sp = 0u;
        while (__hip_atomic_load(p, __ATOMIC_RELAXED, __HIP_MEMORY_SCOPE_AGENT) != CTL_MAGIC) { __builtin_amdgcn_s_sleep(2); if (++sp > (1u << 24)) break; }
        __builtin_amdgcn_fence(__ATOMIC_ACQUIRE, "agent"); asm volatile("s_waitcnt vmcnt(0)" ::: "memory"); }
    __syncthreads();
}
__global__ void __launch_bounds__(NTHREADS, 2) mega_fwd(Args args) {
    extern __shared__ __attribute__((aligned(16))) unsigned char lds_raw[];
    Ctx X;
    X.lds = (LAS unsigned char*)lds_raw;
    X.tid = threadIdx.x; X.lane = X.tid & 63; X.wave = __builtin_amdgcn_readfirstlane(X.tid >> 6); X.wg = blockIdx.x; X.G = gridDim.x;
    X.x = (const float*)args.in[0]; X.c = (const float*)args.in[1]; X.positions = (const int*)args.in[2]; X.w_ada = (const float*)args.in[3]; X.b_ada = (const float*)args.in[4];
    X.g1 = (const float*)args.in[5]; X.w_in = (const float*)args.in[6]; X.lb_logits = (const float*)args.in[7]; X.g_hgrn = (const float*)args.in[8]; X.w_pa = (const float*)args.in[9];
    X.w_pb = (const float*)args.in[10]; X.w_out = (const float*)args.in[11]; X.g2 = (const float*)args.in[12]; X.w_router = (const float*)args.in[13]; X.rbias = (const float*)args.in[14];
    X.w_egu = (const float*)args.in[15]; X.w_edown = (const float*)args.in[16]; X.w_sgu = (const float*)args.in[17]; X.w_sdown = (const float*)args.in[18]; X.g_final = (const float*)args.in[19];
    X.out = args.out; X.ws = args.ws;
    volatile LAS unsigned* MISC = (volatile LAS unsigned*)(X.lds + MISC_OFF);
    if (X.tid < 32) MISC[X.tid] = 0u;
    __syncthreads();
    const int lo = args.ph_lo, hi = args.ph_hi;
    XcdBarrier bar; bar.bar = WSP(unsigned, WS_CTL) + CW_BAR; bar.x = 0; bar.st = nullptr;
    const bool one = (lo == 0 && hi - lo > 1);
    if (one && X.wg == 0) ctl_init(X);
    if (!one && hi - lo > 1) bar = xcd_barrier_post(WSP(unsigned, WS_CTL) + CW_BAR, MISC + 8);
#ifndef PH_MASK
#define PH_MASK 0xffffffffu
#endif
#define IN(k) ((((PH_MASK) >> (k)) & 1u) && lo <= (k) && (k) < hi)
#ifndef REPEAT_MASK
#define REPEAT_MASK 0u
#endif
#define SEAM(k) do { if (IN(k) && IN((k) + 1)) xcd_barrier(bar); } while (0)
#define RUN(k, call) do { if (IN(k)) { call; if (((REPEAT_MASK) >> (k)) & 1u) { xcd_barrier(bar); call; } } } while (0)

    const bool p01 = IN(0) && IN(1);
    RUN(0, p0_prologue(X));
    if (one) { ctl_wait(X); bar = xcd_barrier_post(WSP(unsigned, WS_CTL) + CW_BAR, MISC + 8); }
    if (p01) { asm volatile("s_waitcnt vmcnt(0)" ::: "memory"); __syncthreads(); if (X.tid == 0) (void)xb_add(WSP(unsigned, WS_CTL) + CW_P0 + 64 * (X.wg & 7), 1u); }
    if (IN(1)) {
        small_transposes(X);
        if (p01) {
            if (X.tid == 0) { unsigned* p = WSP(unsigned, WS_CTL) + CW_P0; unsigned sp = 0u;
                for (;;) { unsigned sum = 0u;
#pragma unroll
                    for (int j = 0; j < 8; ++j) sum += xb_ld(p + 64 * j);
                    if (sum >= (unsigned)X.G) break;
                    __builtin_amdgcn_s_sleep(2); if (++sp > (1u << 22)) break; }
                __builtin_amdgcn_fence(__ATOMIC_ACQUIRE, "agent"); asm volatile("s_waitcnt vmcnt(0)" ::: "memory"); }
            __syncthreads();
        }
        norm_rows(X, 0);
    }
    SEAM(1);
    RUN(2, ph_inproj(X)); SEAM(2);
    RUN(3, ph_mix_a(X)); SEAM(3);
    RUN(4, hgrn_passB(X)); SEAM(4);
    RUN(5, ph_mix_c(X)); SEAM(5);
    const bool chain = (X.G == 256);
    RUN(6, ph_mixed(X, chain)); if (!chain) SEAM(6);
    RUN(7, ph_outproj(X, chain)); if (!chain) SEAM(7);
    RUN(8, ph_norm2(X, chain)); if (!chain) SEAM(8);
    RUN(9, ph_router(X, chain)); if (!chain) SEAM(9);
    RUN(10, ph_route(X, chain)); SEAM(10);
    RUN(11, ph_gu(X)); SEAM(11);
    RUN(12, ph_down(X, IN(11))); SEAM(12);
    if (one && X.wg == 0 && X.tid == 0) __hip_atomic_store((unsigned long long*)(WSP(unsigned, WS_CTL) + CW_READY), 0ull, __ATOMIC_RELAXED, __HIP_MEMORY_SCOPE_AGENT);
    RUN(13, final_rows(X));
#undef IN
#undef SEAM
}

extern "C" void kernel_launch(void* const* d_in, const int* in_sizes, int n_in, void* d_out, int out_size, void* d_ws, size_t ws_size, hipStream_t stream) {
    static int grid = 0;
    if (grid == 0) {
        if (n_in != 20 || out_size != T * D || ws_size < WS_END) { fprintf(stderr, "kernel_launch: unexpected shapes (n_in %d, out %d, ws %zu); nothing launched\n", n_in, out_size, ws_size); grid = -1; return; }
        int dev = 0, cus = 0, per_cu = 0;
        if (hipGetDevice(&dev) != hipSuccess || hipDeviceGetAttribute(&cus, hipDeviceAttributeMultiprocessorCount, dev) != hipSuccess) { grid = -1; return; }
        if (hipFuncSetAttribute((const void*)mega_fwd, hipFuncAttributeMaxDynamicSharedMemorySize, LDS_BYTES) != hipSuccess) { fprintf(stderr, "kernel_launch: hipFuncSetAttribute failed\n"); grid = -1; return; }
        if (hipOccupancyMaxActiveBlocksPerMultiprocessor(&per_cu, (const void*)mega_fwd, NTHREADS, LDS_BYTES) != hipSuccess || per_cu < 1) { fprintf(stderr, "kernel_launch: occupancy query says %d blocks/CU; nothing launched\n", per_cu); (void)hipGetLastError(); grid = -1; return; }
        grid = cus;
        if (T % grid != 0 || 24576 % grid != 0 || grid % 8 != 0) { fprintf(stderr, "kernel_launch: grid %d does not divide the row count; nothing launched\n", grid); grid = -1; return; }
    }
    if (grid < 0) return;
#if MK_PER_PHASE
    (void)hipMemsetAsync((char*)d_ws + WS_CTL, 0, CTL_ZERO_BYTES, stream);
#endif
    Args a{};
    for (int i = 0; i < 20; ++i) a.in[i] = d_in[i];
    a.out = (float*)d_out; a.ws = (unsigned char*)d_ws;
#if MK_PER_PHASE
    for (int p = 0; p < NPHASE; ++p) { a.ph_lo = p; a.ph_hi = p + 1; hipLaunchKernelGGL(mega_fwd, dim3(grid), dim3(NTHREADS), LDS_BYTES, stream, a); }
#else
    a.ph_lo = 0; a.ph_hi = NPHASE;
    hipLaunchKernelGGL(mega_fwd, dim3(grid), dim3(NTHREADS), LDS_BYTES, stream, a);
#endif
}
```
